# Optimizing an MI355X kernel written in HIP

```python
import jax, jax.numpy as jnp
from jax import lax
import numpy as np

D_MODEL = 1024
BATCH = 4
SEQ = 4096
DEPTH = 4

HEAD_DIM = 64
ATTN_HEADS = D_MODEL // 2 // HEAD_DIM
RWKV_HEADS = D_MODEL // 2 // HEAD_DIM
ATTN_WIDTH = ATTN_HEADS * HEAD_DIM
RWKV_WIDTH = RWKV_HEADS * HEAD_DIM
ATTN_BRANCHES = ((128, 1), (512, 4), (2048, 16))
DECAY_LORA = 64
AAA_LORA = 64
GATE_LORA = 128
RWKV_PROJ = 3 * RWKV_WIDTH + DECAY_LORA + AAA_LORA + GATE_LORA
IN_PROJ = 3 * ATTN_WIDTH + RWKV_PROJ
D_FF = 4 * D_MODEL
NORM_EPS = 1e-6
GN_EPS = HEAD_DIM * 1e-5
NEG_INF = -1e30

kernel_name = 'hybrid_dilated_attn_rwkv7_encoder'


def _rms_norm(x, g):
    xf = x.astype(jnp.float32)
    y = xf * lax.rsqrt(jnp.mean(xf * xf, axis=-1, keepdims=True) + NORM_EPS)
    return (y * g.astype(jnp.float32)).astype(x.dtype)


def _alibi_slopes(n):
    return jnp.exp2(-8.0 * jnp.arange(1, n + 1, dtype=jnp.float32) / n)


def _strided_band_attention(q, k, v, slopes, radius, dilation):
    B, S, H, HD = q.shape
    L = S // dilation
    N = B * dilation
    blk = radius
    nb = -(-L // blk)
    Lp = nb * blk

    def to_sub(t):
        return t.reshape(B, L, dilation, H, HD).transpose(0, 2, 1, 3, 4).reshape(N, L, H, HD)

    qb = jnp.pad(to_sub(q), ((0, 0), (0, Lp - L), (0, 0), (0, 0))).reshape(N, nb, blk, H, HD)

    def band(t):
        tp = jnp.pad(to_sub(t), ((0, 0), (blk, Lp - L + blk), (0, 0), (0, 0))).reshape(N, nb + 2, blk, H, HD)
        return jnp.concatenate([tp[:, :-2], tp[:, 1:-1], tp[:, 2:]], axis=2)

    kb, vb = band(k), band(v)
    s = jnp.einsum('nbqhd,nbkhd->nbhqk', qb, kb, preferred_element_type=jnp.float32)
    q_idx = jnp.arange(nb)[:, None] * blk + jnp.arange(blk)[None, :]
    k_idx = jnp.arange(nb)[:, None] * blk - blk + jnp.arange(3 * blk)[None, :]
    dist = jnp.abs(k_idx[:, None, :] - q_idx[:, :, None])
    valid = (dist <= radius) & (k_idx[:, None, :] >= 0) & (k_idx[:, None, :] < L)
    alibi = -slopes[None, :, None, None] * (dilation * dist).astype(jnp.float32)[:, None]
    s = jnp.where(valid[:, None], s + alibi, NEG_INF)
    m = jnp.max(s, axis=-1)
    p = jnp.exp(s - m[..., None])
    l = jnp.sum(p, axis=-1)
    o = jnp.einsum('nbhqk,nbkhd->nbqhd', p, vb.astype(jnp.float32)) / jnp.swapaxes(l, 2, 3)[..., None]

    def from_sub(t):
        t = t.reshape((N, Lp) + t.shape[3:])[:, :L]
        t = t.reshape((B, dilation, L) + t.shape[2:])
        return jnp.swapaxes(t, 1, 2).reshape((B, S) + t.shape[3:])

    return from_sub(o), from_sub(jnp.swapaxes(m, 2, 3)), from_sub(jnp.swapaxes(l, 2, 3))


def _dilated_window_attention(q, k, v, q_g, k_g):
    B, S, _ = q.shape
    shp = (B, S, ATTN_HEADS, HEAD_DIM)
    q = _rms_norm(q.reshape(shp), q_g) * (HEAD_DIM ** -0.5)
    k = _rms_norm(k.reshape(shp), k_g)
    v = v.reshape(shp)
    slopes = _alibi_slopes(ATTN_HEADS)
    outs, maxes, sums = [], [], []
    for window, dilation in ATTN_BRANCHES:
        o, m, l = _strided_band_attention(q, k, v, slopes, window // (2 * dilation), dilation)
        outs.append(o)
        maxes.append(m)
        sums.append(l)
    o = jnp.stack(outs)
    m = jnp.stack(maxes)
    l = jnp.stack(sums)
    wts = l * jnp.exp(m - jnp.max(m, axis=0, keepdims=True))
    wts = wts / jnp.sum(wts, axis=0, keepdims=True)
    out = jnp.sum(wts[..., None] * o, axis=0)
    return out.reshape(B, S, ATTN_WIDTH).astype(v.dtype)


def _wkv7_scan(r, w, k, v, kk, a, reverse):
    B, S, H, N = r.shape
    xs = tuple(jnp.moveaxis(t, 1, 0) for t in (r, w, k, v, kk, a))

    def step(state, inp):
        r_t, w_t, k_t, v_t, kk_t, a_t = inp
        s_kk = jnp.einsum('bhvk,bhk->bhv', state, kk_t)
        state = (state * w_t[:, :, None, :]
                 - s_kk[..., None] * (kk_t * a_t)[:, :, None, :]
                 + v_t[..., None] * k_t[:, :, None, :])
        return state, jnp.einsum('bhvk,bhk->bhv', state, r_t)

    init = jnp.zeros((B, H, N, N), jnp.float32)
    _, ys = lax.scan(step, init, xs, reverse=reverse)
    return jnp.moveaxis(ys, 0, 1)


def _rwkv7_bidirectional(u, shift_prev, shift_next, w0, w2, a0, a2, g2, k_k, k_a, r_k, gn_w, gn_b):
    B, S, _ = u.shape
    u_prev = jnp.pad(u, ((0, 0), (1, 0), (0, 0)))[:, :-1]
    u_next = jnp.pad(u, ((0, 0), (0, 1), (0, 0)))[:, 1:]
    u = (u + shift_prev * (u_prev - u) + shift_next * (u_next - u)).astype(jnp.float32)
    c1 = RWKV_WIDTH
    c4 = 3 * RWKV_WIDTH + DECAY_LORA
    r, k, v, xw, xa, xg = jnp.split(u, [c1, 2 * c1, 3 * c1, c4, c4 + AAA_LORA], axis=-1)
    shp = (B, S, RWKV_HEADS, HEAD_DIM)

    def heads(t):
        return t.reshape(shp)

    g = jax.nn.sigmoid(xg) @ g2
    kk = heads(k * k_k)
    kk = kk * lax.rsqrt(jnp.sum(kk * kk, axis=-1, keepdims=True) + 1e-12)
    tw = jnp.tanh(xw)
    ys, kts = [], []
    for direction, reverse in ((0, False), (1, True)):
        wlog = -jax.nn.softplus(-(w0[direction] + tw @ w2[direction])) - 0.5
        decay = jnp.exp(-jnp.exp(wlog))
        a = jax.nn.sigmoid(a0[direction] + xa @ a2[direction])
        kt = k * (1.0 + (a - 1.0) * k_a)
        ys.append(_wkv7_scan(heads(r), heads(decay), heads(kt), heads(v), kk, heads(a), reverse))
        kts.append(kt)
    y = ys[0] + ys[1]
    mu = jnp.mean(y, axis=-1, keepdims=True)
    var = jnp.mean(jnp.square(y - mu), axis=-1, keepdims=True)
    y = ((y - mu) * lax.rsqrt(var + GN_EPS)).reshape(B, S, RWKV_WIDTH) * gn_w + gn_b
    bonus = jnp.sum(heads(r) * heads(kts[0] + kts[1]) * r_k, axis=-1, keepdims=True) * heads(v)
    return (y + bonus.reshape(B, S, RWKV_WIDTH)) * g


def setup_inputs(seed: int = 0) -> dict:
    key = jax.random.key(seed)
    ks = jax.random.split(key, 21)
    f = jnp.float32
    L = DEPTH

    def nrm(k, shape, scale):
        return jax.random.normal(k, shape, f) * scale

    return {
        'x': nrm(ks[0], (BATCH, SEQ, D_MODEL), 1.0),
        'ln1_g': 1.0 + nrm(ks[1], (L, D_MODEL), 0.02),
        'w_in': nrm(ks[2], (L, D_MODEL, IN_PROJ), D_MODEL ** -0.5),
        'q_norm_g': 1.0 + nrm(ks[3], (L, HEAD_DIM), 0.02),
        'k_norm_g': 1.0 + nrm(ks[4], (L, HEAD_DIM), 0.02),
        'tshift_prev': jax.random.uniform(ks[5], (L, RWKV_PROJ), f, 0.0, 0.5),
        'tshift_next': jax.random.uniform(ks[6], (L, RWKV_PROJ), f, 0.0, 0.5),
        'rwkv_w0': jax.random.uniform(ks[7], (L, 2, RWKV_WIDTH), f, -4.0, 1.0),
        'rwkv_w2': nrm(ks[8], (L, 2, DECAY_LORA, RWKV_WIDTH), 0.5 * DECAY_LORA ** -0.5),
        'rwkv_a0': nrm(ks[9], (L, 2, RWKV_WIDTH), 0.1),
        'rwkv_a2': nrm(ks[10], (L, 2, AAA_LORA, RWKV_WIDTH), 0.5 * AAA_LORA ** -0.5),
        'rwkv_g2': nrm(ks[11], (L, GATE_LORA, RWKV_WIDTH), GATE_LORA ** -0.5),
        'rwkv_k_k': 0.85 + nrm(ks[12], (L, RWKV_WIDTH), 0.02),
        'rwkv_k_a': 1.0 + nrm(ks[13], (L, RWKV_WIDTH), 0.02),
        'rwkv_r_k': nrm(ks[14], (L, RWKV_HEADS, HEAD_DIM), 0.1),
        'rwkv_gn_w': 1.0 + nrm(ks[15], (L, RWKV_WIDTH), 0.02),
        'rwkv_gn_b': nrm(ks[16], (L, RWKV_WIDTH), 0.02),
        'w_out': nrm(ks[17], (L, D_MODEL, D_MODEL), 0.5 * D_MODEL ** -0.5),
        'ln2_g': 1.0 + nrm(ks[18], (L, D_MODEL), 0.02),
        'w_up': nrm(ks[19], (L, D_MODEL, D_FF), D_MODEL ** -0.5),
        'w_down': nrm(ks[20], (L, D_FF, D_MODEL), 0.5 * D_FF ** -0.5),
    }


def reference(x, ln1_g, w_in, q_norm_g, k_norm_g, tshift_prev, tshift_next, rwkv_w0, rwkv_w2,
              rwkv_a0, rwkv_a2, rwkv_g2, rwkv_k_k, rwkv_k_a, rwkv_r_k, rwkv_gn_w, rwkv_gn_b,
              w_out, ln2_g, w_up, w_down):
    for layer in range(DEPTH):
        h = _rms_norm(x, ln1_g[layer])
        proj = h @ w_in[layer]
        q = proj[..., :ATTN_WIDTH]
        k = proj[..., ATTN_WIDTH:2 * ATTN_WIDTH]
        v = proj[..., 2 * ATTN_WIDTH:3 * ATTN_WIDTH]
        u = proj[..., 3 * ATTN_WIDTH:]
        attn = _dilated_window_attention(q, k, v, q_norm_g[layer], k_norm_g[layer])
        rwkv = _rwkv7_bidirectional(u, tshift_prev[layer], tshift_next[layer], rwkv_w0[layer],
                                    rwkv_w2[layer], rwkv_a0[layer], rwkv_a2[layer], rwkv_g2[layer],
                                    rwkv_k_k[layer], rwkv_k_a[layer], rwkv_r_k[layer],
                                    rwkv_gn_w[layer], rwkv_gn_b[layer]).astype(x.dtype)
        x = x + jnp.concatenate([attn, rwkv], axis=-1) @ w_out[layer]
        h = _rms_norm(x, ln2_g[layer])
        x = x + jnp.square(jax.nn.relu(h @ w_up[layer])) @ w_down[layer]
    return x
```

```cpp
#include <hip/hip_runtime.h>
#include <cstdio>
#include <cstdint>
namespace pg8 {
#define PG8_LAS __attribute__((address_space(3)))
typedef unsigned short bf16_t;
typedef short bf16x8 __attribute__((ext_vector_type(8)));
typedef float f32x4 __attribute__((ext_vector_type(4)));
typedef unsigned u32x4 __attribute__((ext_vector_type(4)));
constexpr int BM = 256, BK = 64, HALF = 128, HTB = HALF * BK * 2  , STAGE_BYTES = 8 * HTB, NXCD = 8, WGM = 8;

__host__ __device__ __forceinline__ int lds_byte(int r, int c) { const int st = (r >> 4) * 2 + (c >> 5), rr = r & 15, cc = c & 31, ob = rr * 64 + cc * 2; return st * 1024 + (ob ^ (((ob >> 9) & 1) << 5)); }
__host__ __device__ __forceinline__ void stage_rc(int b, int& R, int& C) { const int st = b / 1024, sb = b % 1024, swz = sb ^ (((sb >> 9) & 1) << 5); R = (st >> 1) * 16 + swz / 64; C = (st & 1) * 32 + (swz % 64) / 2; }
__host__ __device__ __forceinline__ int perm32(int rho) { const int n = rho >> 4, i = rho & 15; return 8 * (i >> 2) + 4 * n + (i & 3); }

struct Unit { int pm, pn; };
struct Gemm { const bf16_t* A; const bf16_t* Bt; int M, N, K; };

struct StaticOrder {
    int nM, nN, nwg, G, c;
    __host__ __device__ void init(int M, int N, int G_, int c_) { nM = M / BM; nN = N / BM; nwg = nM * nN; G = G_; c = c_; }
    __host__ __device__ bool next(int i, Unit& u) const {
        const long L = (long)i * G + c; if (L >= nwg) return false;
        int wgid = (int)L; { const int q = nwg / NXCD, r = nwg % NXCD, xcd = wgid % NXCD, off = wgid / NXCD; wgid = (xcd < r ? xcd * (q + 1) : r * (q + 1) + (xcd - r) * q) + off; }
        const int nig = WGM * nN, gid = wgid / nig, fm = gid * WGM, gsz = (nM - fm) < WGM ? (nM - fm) : WGM;
        u.pm = fm + ((wgid % nig) % gsz); u.pn = (wgid % nig) / gsz; return true;
    }
    __device__ __forceinline__ void a_ready(const Unit&) const {}
    __device__ __forceinline__ void done(const Unit&) const {}
};

__device__ __forceinline__ unsigned cvt_pk_bf16(float lo, float hi) { unsigned r; asm volatile("v_cvt_pk_bf16_f32 %0, %1, %2" : "=v"(r) : "v"(lo), "v"(hi)); return r; }
typedef unsigned u32x2 __attribute__((ext_vector_type(2)));

__device__ __forceinline__ float row_rs(const float* ss, int row, int fq) {
    const f32x4 p = *(const f32x4*)(ss + (size_t)row * 16 + 4 * fq);
    float s = (p[0] + p[1]) + (p[2] + p[3]);
    s += __shfl_xor(s, 16); s += __shfl_xor(s, 32);
    return 1.0f / sqrtf(s * (1.0f / 1024.0f) + 1e-6f);
}

struct EpiProj {
    static constexpr bool PERM = true, AFTER_DRAIN = false;
    bf16_t* base0; const float* ss; const float* qg; const float* kg;
    __device__ __forceinline__ void operator()(const f32x4 (&acc)[2][2][4][2], const Unit& u, int wr, int wc, int fr, int fq) const {
        const int tile = u.pn, di = tile >> 1;
        bf16_t* base = base0 + (size_t)di * (8u << 20); const int ldc = (di == 6) ? 256 : 512; const int cb = (di == 6) ? 0 : (tile & 1) * 256;
        const bool nrm = tile < 4; const float* gsrc = (tile < 2) ? qg : kg; const float post = (tile < 2) ? 0.125f : 1.0f;
        f32x4 g[2][2];
#pragma unroll
        for (int bj = 0; bj < 2; ++bj)
#pragma unroll
            for (int n = 0; n < 2; ++n) g[bj][n] = nrm ? *(const f32x4*)(gsrc + 32 * bj + 8 * fq + 4 * n) * post : (f32x4){1.f, 1.f, 1.f, 1.f};
#pragma unroll
        for (int ai = 0; ai < 2; ++ai)
#pragma unroll
            for (int m = 0; m < 4; ++m) {
                const int row = u.pm * BM + ai * HALF + wr * 64 + m * 16 + fr;
                const float rs = row_rs(ss, row, fq);
                f32x4 v[2][2]; float q = 0.f;
#pragma unroll
                for (int bj = 0; bj < 2; ++bj)
#pragma unroll
                    for (int n = 0; n < 2; ++n) { v[bj][n] = acc[ai][bj][m][n] * rs; const f32x4 t = v[bj][n]; q += (t[0] * t[0] + t[1] * t[1]) + (t[2] * t[2] + t[3] * t[3]); }
                q += __shfl_xor(q, 16); q += __shfl_xor(q, 32);
                const float inv = nrm ? 1.0f / sqrtf(q * (1.0f / 64.0f) + 1e-6f) : 1.0f;
                bf16_t* rowp = base + (size_t)row * ldc + cb + 64 * wc + 8 * fq;
#pragma unroll
                for (int bj = 0; bj < 2; ++bj) { const f32x4 v0 = v[bj][0] * inv * g[bj][0], v1 = v[bj][1] * inv * g[bj][1];
                    u32x4 w; w.x = cvt_pk_bf16(v0[0], v0[1]); w.y = cvt_pk_bf16(v0[2], v0[3]); w.z = cvt_pk_bf16(v1[0], v1[1]); w.w = cvt_pk_bf16(v1[2], v1[3]);
                    *(u32x4*)(rowp + 32 * bj) = w; }
                asm volatile("" ::: "memory");
            }
    }
};
struct EpiUp {
    static constexpr bool PERM = true, AFTER_DRAIN = false;
    bf16_t* O; const float* ss;
    __device__ __forceinline__ void operator()(const f32x4 (&acc)[2][2][4][2], const Unit& u, int wr, int wc, int fr, int fq) const {
#pragma unroll
        for (int ai = 0; ai < 2; ++ai)
#pragma unroll
            for (int m = 0; m < 4; ++m) {
                const int row = u.pm * BM + ai * HALF + wr * 64 + m * 16 + fr;
                const float rs = row_rs(ss, row, fq);
                bf16_t* rowp = O + (size_t)row * 4096 + u.pn * BM + wc * 32 + 8 * fq;
#pragma unroll
                for (int bj = 0; bj < 2; ++bj) { f32x4 v0 = acc[ai][bj][m][0] * rs, v1 = acc[ai][bj][m][1] * rs;
                    v0 = __builtin_elementwise_max(v0, (f32x4){0.f, 0.f, 0.f, 0.f}); v1 = __builtin_elementwise_max(v1, (f32x4){0.f, 0.f, 0.f, 0.f}); v0 = v0 * v0; v1 = v1 * v1;
                    u32x4 w; w.x = cvt_pk_bf16(v0[0], v0[1]); w.y = cvt_pk_bf16(v0[2], v0[3]); w.z = cvt_pk_bf16(v1[0], v1[1]); w.w = cvt_pk_bf16(v1[2], v1[3]);
                    *(u32x4*)(rowp + bj * HALF) = w; }
                asm volatile("" ::: "memory");
            }
    }
};
struct EpiRes {
    static constexpr bool PERM = false, AFTER_DRAIN = false;
    float* x; bf16_t* xb; float* ss;
    __device__ __forceinline__ void operator()(const f32x4 (&acc)[2][2][4][2], const Unit& u, int wr, int wc, int fr, int fq) const {
        const int col0 = u.pn * BM + wc * 32 + 4 * fq;
#pragma unroll
        for (int ai = 0; ai < 2; ++ai)
#pragma unroll
            for (int m = 0; m < 4; ++m) {
                const int row = u.pm * BM + ai * HALF + wr * 64 + m * 16 + fr; const size_t off = (size_t)row * 1024 + col0; float q = 0.f;
#pragma unroll
                for (int bj = 0; bj < 2; ++bj)
#pragma unroll
                    for (int n = 0; n < 2; ++n) { const size_t o = off + bj * HALF + n * 16; const f32x4 t = *(const f32x4*)(x + o) + acc[ai][bj][m][n];
                        *(f32x4*)(x + o) = t; u32x2 w; w.x = cvt_pk_bf16(t[0], t[1]); w.y = cvt_pk_bf16(t[2], t[3]); *(u32x2*)(xb + o) = w;
                        q += (t[0] * t[0] + t[1] * t[1]) + (t[2] * t[2] + t[3] * t[3]); }
                q += __shfl_xor(q, 16); q += __shfl_xor(q, 32);
                if (fq == 0) ss[(size_t)row * 16 + 4 * u.pn + wc] = q;
                asm volatile("" ::: "memory");
            }
    }
};

template <class Epi, class Sched, bool ALIGN_EPI = false, bool SP2 = false>
__device__ __forceinline__ void gemm_phase(PG8_LAS unsigned char* lds, const Gemm g, const Sched& S, const Epi& E, int wave_in, int lane_in) {
    int lane_o = lane_in; asm volatile("" : "+v"(lane_o)); const int tid_ = wave_in * 64 + lane_o;
    const int tid = tid_, wid = wave_in, lane = lane_o, wr = wid >> 2, wc = wid & 3, fr = lane & 15, fq = lane >> 4;
    const int K = g.K, nt = K / BK;
    unsigned voffA[2], voffB[2];
#pragma unroll
    for (int i = 0; i < 2; ++i) { int R, C; stage_rc(tid * 16 + i * 8192, R, C); const int Rb = Epi::PERM ? ((R & ~31) + perm32(R & 31)) : R;
        voffA[i] = (unsigned)(R * K + C) * 2u; voffB[i] = (unsigned)(Rb * K + C) * 2u; }
    const size_t kstep = (size_t)(BK * 2);
    const size_t hstep = (size_t)HALF * K * 2;
    const size_t tstep = 2 * hstep;
    const unsigned ldsw = (unsigned)wid * 1024u;
    const int aoff = lds_byte(wr * 64 + fr, fq * 8), boff = lds_byte(wc * 32 + fr, fq * 8);
#define PG8_SA(b, h) (((b) * 2 + (h)) * HTB)
#define PG8_SB(b, h) ((4 + (b) * 2 + (h)) * HTB)
#define PG8_STAGE(bufoff, gbase, voff) do { _Pragma("unroll") for (int _i = 0; _i < 2; ++_i) \
        __builtin_amdgcn_global_load_lds((const unsigned*)((const char*)(gbase) + (voff)[_i]), (PG8_LAS unsigned*)(lds + (bufoff) + ldsw + _i * 8192), 16, 0, 0); } while (0)
#define PG8_LDA(dst, b, h) do { _Pragma("unroll") for (int m = 0; m < 4; ++m) _Pragma("unroll") for (int k = 0; k < 2; ++k) dst[m][k] = *(const PG8_LAS bf16x8*)(lds + PG8_SA(b, h) + aoff + m * 2048 + k * 1024); } while (0)
#define PG8_LDB(dst, b, h) do { _Pragma("unroll") for (int n = 0; n < 2; ++n) _Pragma("unroll") for (int k = 0; k < 2; ++k) dst[n][k] = *(const PG8_LAS bf16x8*)(lds + PG8_SB(b, h) + boff + n * 2048 + k * 1024); } while (0)
#define PG8_MMA(ai, bj, At, Bt) do { __builtin_amdgcn_s_setprio(1); _Pragma("unroll") for (int m = 0; m < 4; ++m) _Pragma("unroll") for (int n = 0; n < 2; ++n) _Pragma("unroll") for (int k = 0; k < 2; ++k) \
        acc[ai][bj][m][n] = __builtin_amdgcn_mfma_f32_16x16x32_bf16(Bt[n][k], At[m][k], acc[ai][bj][m][n], 0, 0, 0); __builtin_amdgcn_s_setprio(0); } while (0)
#define PG8_WAIT_V(n) asm volatile("s_waitcnt vmcnt(" #n ")" ::: "memory")
#define PG8_WAIT_L(n) asm volatile("s_waitcnt lgkmcnt(" #n ")" ::: "memory")
#define PG8_BAR __builtin_amdgcn_s_barrier()
#define PG8_SCHED __builtin_amdgcn_sched_barrier(0)
    Unit cur, nxt; int ui = 0;
    if (!S.next(0, cur)) return;
    f32x4 acc[2][2][4][2];
#pragma unroll
    for (int a = 0; a < 2; ++a)
#pragma unroll
        for (int b = 0; b < 2; ++b)
#pragma unroll
            for (int m = 0; m < 4; ++m)
#pragma unroll
                for (int n = 0; n < 2; ++n) acc[a][b][m][n] = (f32x4){0.f, 0.f, 0.f, 0.f};
    bf16x8 At[4][2], B0[2][2], B1[2][2];
    const char* cA = (const char*)g.A + (size_t)cur.pm * tstep; const char* cB = (const char*)g.Bt + (size_t)cur.pn * tstep;
    S.a_ready(cur);
    if constexpr (SP2) {
        PG8_STAGE(PG8_SB(0, 0), cB, voffB); PG8_STAGE(PG8_SB(0, 1), cB + hstep, voffB); PG8_STAGE(PG8_SA(0, 0), cA, voffA); PG8_STAGE(PG8_SA(0, 1), cA + hstep, voffA);
        if (wr == 1) PG8_BAR;
        PG8_WAIT_V(2); PG8_BAR;
        PG8_STAGE(PG8_SB(1, 0), cB + kstep, voffB); PG8_STAGE(PG8_SA(1, 0), cA + kstep, voffA); PG8_STAGE(PG8_SB(1, 1), cB + hstep + kstep, voffB);
        PG8_WAIT_V(6); PG8_BAR;
    } else {
        PG8_STAGE(PG8_SB(0, 0), cB, voffB); PG8_STAGE(PG8_SA(0, 0), cA, voffA); PG8_STAGE(PG8_SB(0, 1), cB + hstep, voffB); PG8_STAGE(PG8_SA(0, 1), cA + hstep, voffA);
        if (wr == 1) PG8_BAR;
        PG8_WAIT_V(4); PG8_BAR;
        PG8_STAGE(PG8_SB(1, 0), cB + kstep, voffB); PG8_STAGE(PG8_SA(1, 0), cA + kstep, voffA); PG8_STAGE(PG8_SB(1, 1), cB + hstep + kstep, voffB);
        PG8_WAIT_V(6); PG8_BAR;
    }
    for (;;) {
        const bool has_next = S.next(ui + 1, nxt);
        const char* nA = has_next ? (const char*)g.A + (size_t)nxt.pm * tstep : cA; const char* nB = has_next ? (const char*)g.Bt + (size_t)nxt.pn * tstep : cB;
        for (int t = 0; t < nt; t += 2) {
            const bool last = (t == nt - 2);
            const char* a1 = cA + (size_t)(t + 1) * kstep;
            const char* a2 = last ? nA : cA + (size_t)(t + 2) * kstep; const char* b2 = last ? nB : cB + (size_t)(t + 2) * kstep;
            const char* a3 = a2 + kstep; const char* b3 = b2 + kstep;
            if (last && has_next) S.a_ready(nxt);
            if constexpr (SP2) {
            PG8_LDB(B0, 0, 0); PG8_LDB(B1, 0, 1); PG8_SCHED; PG8_LDA(At, 0, 0); PG8_STAGE(PG8_SA(1, 1), a1 + hstep, voffA);
            PG8_WAIT_V(8); PG8_WAIT_L(0); PG8_BAR; PG8_MMA(0, 0, At, B0); PG8_MMA(0, 1, At, B1); PG8_BAR; PG8_SCHED;
            PG8_LDA(At, 0, 1); PG8_STAGE(PG8_SB(0, 0), b2, voffB); PG8_STAGE(PG8_SB(0, 1), b2 + hstep, voffB); PG8_STAGE(PG8_SA(0, 0), a2, voffA);
            PG8_WAIT_V(8); PG8_WAIT_L(0); PG8_BAR; PG8_MMA(1, 0, At, B0); PG8_MMA(1, 1, At, B1); PG8_BAR; PG8_SCHED;
            PG8_LDB(B0, 1, 0); PG8_LDB(B1, 1, 1); PG8_SCHED; PG8_LDA(At, 1, 0); PG8_STAGE(PG8_SA(0, 1), a2 + hstep, voffA);
            PG8_WAIT_V(8); PG8_WAIT_L(0); PG8_BAR; PG8_MMA(0, 0, At, B0); PG8_MMA(0, 1, At, B1); PG8_BAR; PG8_SCHED;
            PG8_LDA(At, 1, 1); PG8_STAGE(PG8_SB(1, 0), b3, voffB); PG8_STAGE(PG8_SB(1, 1), b3 + hstep, voffB); PG8_STAGE(PG8_SA(1, 0), a3, voffA);
            PG8_WAIT_V(8); PG8_WAIT_L(0); PG8_BAR; PG8_MMA(1, 0, At, B0); PG8_MMA(1, 1, At, B1); PG8_BAR; PG8_SCHED;
            } else {
            PG8_LDB(B0, 0, 0); PG8_SCHED; PG8_LDA(At, 0, 0); PG8_STAGE(PG8_SA(1, 1), a1 + hstep, voffA);
            PG8_WAIT_L(8); PG8_BAR; PG8_WAIT_L(0); PG8_MMA(0, 0, At, B0); PG8_BAR; PG8_SCHED;
            PG8_LDB(B1, 0, 1); PG8_STAGE(PG8_SB(0, 0), b2, voffB);
            PG8_BAR; PG8_WAIT_L(0); PG8_MMA(0, 1, At, B1); PG8_BAR;
            PG8_LDA(At, 0, 1); PG8_STAGE(PG8_SA(0, 0), a2, voffA);
            PG8_BAR; PG8_WAIT_L(0); PG8_MMA(1, 0, At, B0); PG8_BAR; PG8_SCHED;
            PG8_STAGE(PG8_SB(0, 1), b2 + hstep, voffB);
            PG8_WAIT_V(6); PG8_BAR; PG8_MMA(1, 1, At, B1); PG8_BAR;
            PG8_LDB(B0, 1, 0); PG8_SCHED; PG8_LDA(At, 1, 0); PG8_STAGE(PG8_SA(0, 1), a2 + hstep, voffA);
            PG8_WAIT_L(8); PG8_BAR; PG8_WAIT_L(0); PG8_MMA(0, 0, At, B0); PG8_BAR; PG8_SCHED;
            PG8_LDB(B1, 1, 1); PG8_STAGE(PG8_SB(1, 0), b3, voffB);
            PG8_BAR; PG8_WAIT_L(0); PG8_MMA(0, 1, At, B1); PG8_BAR;
            PG8_LDA(At, 1, 1); PG8_STAGE(PG8_SA(1, 0), a3, voffA);
            PG8_BAR; PG8_WAIT_L(0); PG8_MMA(1, 0, At, B0); PG8_BAR; PG8_SCHED;
            PG8_STAGE(PG8_SB(1, 1), b3 + hstep, voffB);
            PG8_WAIT_V(6); PG8_BAR; PG8_MMA(1, 1, At, B1); PG8_BAR;
            }
        }
        if constexpr (ALIGN_EPI) { if (wr == 0) PG8_BAR; }
        if constexpr (!Epi::AFTER_DRAIN) { E(acc, cur, wr, wc, fr, fq); S.done(cur); }
        if (!has_next) break;
#pragma unroll
        for (int a = 0; a < 2; ++a)
#pragma unroll
            for (int b = 0; b < 2; ++b)
#pragma unroll
                for (int m = 0; m < 4; ++m)
#pragma unroll
                    for (int n = 0; n < 2; ++n) acc[a][b][m][n] = (f32x4){0.f, 0.f, 0.f, 0.f};
        cur = nxt; cA = nA; cB = nB; ++ui;
        if constexpr (ALIGN_EPI) { if (wr == 1) PG8_BAR; }
    }
    PG8_WAIT_V(0);
    if constexpr (!ALIGN_EPI) { if (wr == 0) PG8_BAR; }
    PG8_BAR;
    if constexpr (Epi::AFTER_DRAIN) { E.fused(acc, cur, wr, wc, fr, fq, lds, wid, lane); S.done(cur); }
#undef PG8_SA
#undef PG8_SB
#undef PG8_STAGE
#undef PG8_LDA
#undef PG8_LDB
#undef PG8_MMA
#undef PG8_WAIT_V
#undef PG8_WAIT_L
#undef PG8_BAR
#undef PG8_SCHED
}
}
constexpr int NWAVES = 8, NTHR = 512;
constexpr int BATCH = 4, SEQ = 4096, D = 1024, DEPTH = 4, H = 8, HD = 64, FF = 4096, NPROJ = 3328, RPROJ = 1792;
constexpr int M = BATCH * SEQ;
constexpr float GN_EPS = 64e-5f;
enum { I_X = 0, I_LN1, I_WIN, I_QG, I_KG, I_TSP, I_TSN, I_W0, I_W2, I_A0, I_A2, I_G2, I_KK, I_KA, I_RK, I_GNW, I_GNB, I_WOUT, I_LN2, I_WUP, I_WDN, N_IN };
constexpr size_t MiB = 1u << 20;
constexpr size_t WS_CTL = 0, CTL_ZERO_BYTES = 64 * 1024;
constexpr size_t WS_SS1 = 1 * MiB, WS_SS2 = 2 * MiB;
constexpr size_t WS_WIN = 3 * MiB, WS_WOUT = WS_WIN + (size_t)NPROJ * D * 2, WS_WUP = WS_WOUT + (size_t)D * D * 2, WS_WDN = WS_WUP + (size_t)FF * D * 2;
constexpr size_t WS_R0 = 28 * MiB;
static_assert(WS_WDN + (size_t)D * FF * 2 <= WS_R0, "weights");
constexpr size_t R_Q = WS_R0 + 0 * MiB, R_K = WS_R0 + 16 * MiB, R_V = WS_R0 + 32 * MiB;
constexpr size_t R_RR = WS_R0 + 48 * MiB, R_KR = WS_R0 + 64 * MiB, R_VR = WS_R0 + 80 * MiB, R_XL = WS_R0 + 96 * MiB;
constexpr size_t R_HID = WS_R0;
constexpr size_t R_XB = WS_R0 + 128 * MiB;
constexpr size_t R_Y0 = WS_R0 + 104 * MiB, R_Y1 = WS_R0 + 136 * MiB;
constexpr size_t R_MIX = WS_R0 + 168 * MiB;
constexpr size_t R_BN = WS_R0 + 200 * MiB;
constexpr size_t WS_END = WS_R0 + 202 * MiB;
constexpr int CW_BAR = 1024;
constexpr int RING_OFF = 0, RING_BYTES = 131072;
constexpr int LDSCTL_OFF = RING_BYTES, MISC_OFF = LDSCTL_OFF + 320;
constexpr int LDS_BYTES = 147456;
#define GAS __attribute__((address_space(1)))
#define LAS __attribute__((address_space(3)))
typedef unsigned short bf16;
typedef unsigned v4u __attribute__((ext_vector_type(4)));
typedef float f32x4 __attribute__((ext_vector_type(4)));
typedef short bf16x8 __attribute__((ext_vector_type(8)));
typedef GAS unsigned gu32;
typedef GAS unsigned long long gu64;
#define RLX_AGENT __ATOMIC_RELAXED, __HIP_MEMORY_SCOPE_AGENT
#define LDS_WAIT() asm volatile("s_waitcnt lgkmcnt(0)" ::: "memory")
#define VM_WAIT() asm volatile("s_waitcnt vmcnt(0)" ::: "memory")
__device__ __forceinline__ unsigned long long rt() { return __builtin_amdgcn_s_memrealtime(); }
__device__ __forceinline__ unsigned f2bf(float f) { unsigned u = __builtin_bit_cast(unsigned, f); return (u + 0x7fffu + ((u >> 16) & 1u)) >> 16; }
__device__ __forceinline__ unsigned pk2(float lo, float hi) { return f2bf(lo) | (f2bf(hi) << 16); }

#define XB_TMO      128
#define XB_XCNT(j)  (256  + 64 * (j))
#define XB_XSUB(j)  (1280 + 64 * (j))
#define XB_XGEN(j)  (2304 + 64 * (j))
#define XB_TOP      3328
#define XB_TOPGEN   3392
#define XCD_BAR_WORDS 3456
#define XB_SPIN_CAP (1u << 18)

__device__ __forceinline__ unsigned xb_ld(unsigned* p)              { return __hip_atomic_load(p, __ATOMIC_RELAXED, __HIP_MEMORY_SCOPE_AGENT); }
__device__ __forceinline__ unsigned xb_add(unsigned* p, unsigned v) { return __hip_atomic_fetch_add(p, v, __ATOMIC_RELAXED, __HIP_MEMORY_SCOPE_AGENT); }
__device__ __forceinline__ unsigned xb_xcc_id() { return (unsigned)__builtin_amdgcn_s_getreg((3 << 11) | 20) & 0xFu; }
#define XB_SPIN(cond, bar) do { unsigned _sp = 0; while (cond) { __builtin_amdgcn_s_sleep(1); \
    if ((++_sp & 255u) == 0u) { if (xb_ld(&(bar)[XB_TMO])) break; if (_sp > XB_SPIN_CAP) { atomicAdd(&(bar)[XB_TMO], 1u); break; } } } } while (0)

struct XcdBarrier {
    unsigned* bar; unsigned x;
    volatile LAS unsigned* st;
};

__device__ __forceinline__ XcdBarrier xcd_barrier_post(unsigned* bar, volatile LAS unsigned* st, bool tid0) {
    XcdBarrier b; b.bar = bar; b.x = xb_xcc_id(); b.st = st;
    if (tid0) (void)xb_add(&bar[XB_XCNT(b.x)], 1u);
    return b;
}
__device__ __forceinline__ void xcd_barrier_complete(unsigned* bar, unsigned x, unsigned& nloc, unsigned& nx) {
    const unsigned G = gridDim.x * gridDim.y * gridDim.z;
    unsigned sum, cnt, mine, sp = 0u;
    for (;;) {
        sum = 0u; cnt = 0u; mine = 0u;
#pragma unroll
        for (unsigned j = 0; j < 16; ++j) { const unsigned c = xb_ld(&bar[XB_XCNT(j)]); sum += c; cnt += (c > 0u) ? 1u : 0u; mine = (j == x) ? c : mine; }
        if (sum == G) break;
        __builtin_amdgcn_s_sleep(1);
        if ((++sp & 255u) == 0u) { if (xb_ld(&bar[XB_TMO])) break; if (sp > XB_SPIN_CAP) { atomicAdd(&bar[XB_TMO], 1u); break; } }
    }
    nloc = mine > 0u ? mine : 1u; nx = cnt > 0u ? cnt : 1u;
}

__device__ __forceinline__ void xcd_barrier(const XcdBarrier& b, bool tid0) {
    asm volatile("s_waitcnt vmcnt(0)" ::: "memory");
    __syncthreads();
    if (tid0) {
        unsigned* bar = b.bar; asm volatile("" : "+v"(bar));
        __builtin_amdgcn_s_waitcnt(0);
        unsigned nloc = b.st[0], nx = b.st[1];
        if (nloc == 0u) { xcd_barrier_complete(bar, b.x, nloc, nx); b.st[0] = nloc; b.st[1] = nx; }
        const unsigned old = xb_add(&bar[XB_XSUB(b.x)], 1u);
        const unsigned gen = old / nloc;
        if (old + 1u == (gen + 1u) * nloc) {
            __builtin_amdgcn_fence(__ATOMIC_RELEASE, "agent");
            asm volatile("s_waitcnt vmcnt(0)" ::: "memory");
            const unsigned og = xb_add(&bar[XB_TOP], 1u);
            const unsigned tg = og / nx;
            if (og + 1u == (tg + 1u) * nx) xb_add(&bar[XB_TOPGEN], 1u);
            else XB_SPIN(xb_ld(&bar[XB_TOPGEN]) == tg, bar);
            __builtin_amdgcn_fence(__ATOMIC_ACQUIRE, "agent");
            xb_add(&bar[XB_XGEN(b.x)], 1u);
            asm volatile("s_waitcnt vmcnt(0)" ::: "memory");
        } else {
            XB_SPIN(xb_ld(&bar[XB_XGEN(b.x)]) == gen, bar);
            __builtin_amdgcn_fence(__ATOMIC_ACQUIRE, "agent");
            asm volatile("s_waitcnt vmcnt(0)" ::: "memory");
        }
    }
    __syncthreads();
}
__device__ __forceinline__ float bf2f(bf16 v) { return __uint_as_float(((unsigned)v) << 16); }
__device__ __forceinline__ bf16 f2bf_s(float f) { return (bf16)f2bf(f); }
__device__ __forceinline__ float wave_sum(float v) {
#pragma unroll
    for (int o = 1; o < 64; o <<= 1) v += __shfl_xor(v, o);
    return v;
}
__device__ __forceinline__ float sigmoidf_(float z) { return 1.0f / (1.0f + __expf(-z)); }

struct Args { const float* in[N_IN]; float* out; unsigned char* ws; };
typedef const __attribute__((address_space(4))) Args CArgs;
__device__ __forceinline__ const CArgs* kargs() { const CArgs* p = (const CArgs*)__builtin_amdgcn_kernarg_segment_ptr(); asm volatile("" : "+s"(p)); return p; }
__device__ __forceinline__ unsigned char* kws() { return kargs()->ws; }
__device__ __forceinline__ float* kout() { return kargs()->out; }
__device__ __forceinline__ const float* karg(int i) { return kargs()->in[i]; }
__device__ __forceinline__ int lane_id() { return (int)__builtin_amdgcn_mbcnt_hi(~0u, __builtin_amdgcn_mbcnt_lo(~0u, 0u)); }
struct Frame {
    LAS unsigned char* lds;
    volatile LAS unsigned* MISC;
    gu32* ctl;
    int vcu, G, wv;
};

__device__ __forceinline__ float ushift(const bf16* buf, int ldc, int col, int row, int t, float sp, float sn) {
    const bf16* p = buf + (size_t)row * ldc + col;
    const float u0 = bf2f(p[0]);
    const float up = (t > 0) ? bf2f(p[-ldc]) : 0.f;
    const float un = (t < SEQ - 1) ? bf2f(p[ldc]) : 0.f;
    return u0 + sp * (up - u0) + sn * (un - u0);
}

__device__ __forceinline__ void transpose_item(const float* W, int K, int N, bf16* WT, const float* gain, bool headperm, LAS float* scr, int item, int lane) {
    const int nblk = N / 32, kb = item / nblk, nb = item % nblk, k0 = 64 * kb, n0 = 32 * nb;
#pragma unroll 8
    for (int i = 0; i < 32; ++i) { const int kk = 2 * i + (lane >> 5); float w = W[(size_t)(k0 + kk) * N + n0 + (lane & 31)]; if (gain) w *= gain[k0 + kk]; scr[kk * 33 + (lane & 31)] = w; }
    LDS_WAIT(); asm volatile("" ::: "memory");
    const int c = lane & 7;
    const int p0 = headperm ? ((n0 & ~255) + 128 * ((n0 >> 5) & 1) + 32 * ((n0 >> 6) & 3)) : n0;
#pragma unroll
    for (int j = 0; j < 4; ++j) { const int n = (lane >> 3) + 8 * j; const LAS float* s = scr + (8 * c) * 33 + n;
        v4u o; o.x = pk2(s[0 * 33], s[1 * 33]); o.y = pk2(s[2 * 33], s[3 * 33]); o.z = pk2(s[4 * 33], s[5 * 33]); o.w = pk2(s[6 * 33], s[7 * 33]);
        *(GAS v4u*)(WT + (size_t)(p0 + n) * K + k0 + 8 * c) = o; }
    LDS_WAIT(); asm volatile("" ::: "memory");
}
__device__ __forceinline__ void wconv_phase(Frame& F, int layer) {
    unsigned char* const ws = kws();
    int lane_ = lane_id(); asm volatile("" : "+v"(lane_)); const int wave_ = F.wv, tid_ = wave_ * 64 + lane_;
    LAS float* scr = (LAS float*)(F.lds + RING_OFF + wave_ * 16384);
    const int gw = F.vcu * NWAVES + wave_, NGW = F.G * NWAVES;
    constexpr int I_1 = (D / 64) * (NPROJ / 32), I_2 = (D / 64) * (D / 32), I_3 = (D / 64) * (FF / 32), I_4 = (FF / 64) * (D / 32);
    const float* win = karg(I_WIN) + (size_t)layer * D * NPROJ; const float* wout = karg(I_WOUT) + (size_t)layer * D * D;
    const float* wup = karg(I_WUP) + (size_t)layer * D * FF; const float* wdn = karg(I_WDN) + (size_t)layer * FF * D;
    const float* g1 = karg(I_LN1) + layer * D; const float* g2 = karg(I_LN2) + layer * D;
    for (int it = gw; it < I_1 + I_2 + I_3 + I_4; it += NGW) {
        int r = it;
        if (r < I_1) { transpose_item(win, D, NPROJ, (bf16*)(ws + WS_WIN), g1, true, scr, r, lane_); continue; } r -= I_1;
        if (r < I_2) { transpose_item(wout, D, D, (bf16*)(ws + WS_WOUT), nullptr, false, scr, r, lane_); continue; } r -= I_2;
        if (r < I_3) { transpose_item(wup, D, FF, (bf16*)(ws + WS_WUP), g2, false, scr, r, lane_); continue; } r -= I_3;
        transpose_item(wdn, FF, D, (bf16*)(ws + WS_WDN), nullptr, false, scr, r, lane_);
    }
}
__device__ __forceinline__ void x_prologue(Frame& F) {
    unsigned char* const ws = kws();
    int lane_ = lane_id(); asm volatile("" : "+v"(lane_)); const int wave_ = F.wv, tid_ = wave_ * 64 + lane_;
    const int gw = F.vcu * NWAVES + wave_, NGW = F.G * NWAVES;
    const float* x = karg(I_X); bf16* xb = (bf16*)(ws + R_XB); float* ss = (float*)(ws + WS_SS1);
    for (int m = gw; m < M; m += NGW) {
        const GAS f32x4* xr = (const GAS f32x4*)(x + (size_t)m * D) + lane_; GAS f32x4* orow = (GAS f32x4*)(kout() + (size_t)m * D) + lane_;
        GAS unsigned long long* o8 = (GAS unsigned long long*)(xb + (size_t)m * D) + lane_;
        float s = 0.f;
#pragma unroll
        for (int j = 0; j < 4; ++j) { const f32x4 v = xr[64 * j]; orow[64 * j] = v; s += (v.x * v.x + v.y * v.y) + (v.z * v.z + v.w * v.w);
            o8[64 * j] = (unsigned long long)pk2(v.x, v.y) | ((unsigned long long)pk2(v.z, v.w) << 32); }
        s = wave_sum(s);
        if (lane_ < 16) ss[(size_t)m * 16 + lane_] = (lane_ == 0) ? s : 0.f;
    }
}

__device__ __forceinline__ void attn_naive(Frame& F, int layer, int wg, int nwg) {
    unsigned char* const ws = kws();
    int lane_ = lane_id(); asm volatile("" : "+v"(lane_)); const int wave_ = F.wv, tid_ = wave_ * 64 + lane_;
    const bf16* Q = (const bf16*)(ws + R_Q); const bf16* K = (const bf16*)(ws + R_K); const bf16* V = (const bf16*)(ws + R_V); bf16* MIX = (bf16*)(ws + R_MIX);
    LAS float* qs = (LAS float*)(F.lds + RING_OFF + wave_ * 4096); LAS float* pb = qs + 64;
    float bound;
    { const float* qg = karg(I_QG) + layer * HD; const float* kg = karg(I_KG) + layer * HD; float mq = 0.f, mk = 0.f;
      for (int i = 0; i < HD; ++i) { mq = fmaxf(mq, fabsf(qg[i])); mk = fmaxf(mk, fabsf(kg[i])); }
      bound = 8.0f * mq * mk + 0.25f; }
    const int lane = lane_;
    for (int unit = wg; unit < BATCH * H * (SEQ / 8); unit += nwg) {
        const int tg = unit % (SEQ / 8), bh = unit / (SEQ / 8), h = bh % H, b = bh / H;
        const int t = tg * 8 + wave_; const size_t row = (size_t)b * SEQ + t;
        qs[lane] = bf2f(Q[row * 512 + h * HD + lane]);
        LDS_WAIT(); asm volatile("" ::: "memory");
        float qv[HD];
#pragma unroll
        for (int i = 0; i < HD; ++i) qv[i] = qs[i];
        const float slope = exp2f(-(float)(h + 1));
        float lsum = 0.f;
        for (int bi = 0; bi < 3; ++bi) { const int d = 1 << (2 * bi);
            for (int pass = 0; pass < 3; ++pass) { const int jj = pass * 64 + lane; const bool act = jj <= 128; const int j = jj - 64; const int pos = t + j * d; const bool valid = act && pos >= 0 && pos < SEQ;
                float p = 0.f;
                if (valid) { const v4u* kr = (const v4u*)(K + ((size_t)b * SEQ + pos) * 512 + h * HD); float dot = 0.f;
#pragma unroll
                    for (int c = 0; c < 8; ++c) { const v4u w = kr[c];
                        dot += qv[8 * c + 0] * __uint_as_float(w.x << 16) + qv[8 * c + 1] * __uint_as_float(w.x & 0xffff0000u) + qv[8 * c + 2] * __uint_as_float(w.y << 16) + qv[8 * c + 3] * __uint_as_float(w.y & 0xffff0000u)
                             + qv[8 * c + 4] * __uint_as_float(w.z << 16) + qv[8 * c + 5] * __uint_as_float(w.z & 0xffff0000u) + qv[8 * c + 6] * __uint_as_float(w.w << 16) + qv[8 * c + 7] * __uint_as_float(w.w & 0xffff0000u); }
                    const float s = dot - slope * fabsf((float)(j * d)); p = __expf(s - bound); }
                if (act) pb[bi * 129 + jj] = p;
                lsum += p; } }
        lsum = wave_sum(lsum);
        LDS_WAIT(); asm volatile("" ::: "memory");
        float o = 0.f;
        for (int bi = 0; bi < 3; ++bi) { const int d = 1 << (2 * bi);
            for (int jj = 0; jj < 129; ++jj) { const float p = pb[bi * 129 + jj];
                if (p != 0.f) { const int pos = t + (jj - 64) * d; o += p * bf2f(V[((size_t)b * SEQ + pos) * 512 + h * HD + lane]); } } }
        MIX[row * 1024 + h * HD + lane] = f2bf_s(o / lsum);
        LDS_WAIT(); asm volatile("" ::: "memory");
    }
}

__device__ __forceinline__ void rwkv_scan_naive(Frame& F, int layer, int chain) {
    unsigned char* const ws = kws();
    int lane_ = lane_id(); asm volatile("" : "+v"(lane_)); const int wave_ = F.wv, tid_ = wave_ * 64 + lane_;
    const int b = chain / 16, h = (chain >> 1) & 7, dir = chain & 1;
    const int lane = lane_, w = wave_, c = h * HD + lane;
    LAS float* L = (LAS float*)(F.lds + RING_OFF);
    LAS float *Wd = L, *KKs = L + 4096, *KKA = L + 8192, *KT = L + 12288, *Rs = L + 16384, *Vs = L + 20480, *TW = L + 24576, *XA = L + 28672;
    const bf16* Rr = (const bf16*)(ws + R_RR); const bf16* Kr = (const bf16*)(ws + R_KR); const bf16* Vr = (const bf16*)(ws + R_VR); const bf16* XL = (const bf16*)(ws + R_XL);
    float* Y = (float*)(ws + (dir ? R_Y1 : R_Y0)); float* BN = (float*)(ws + R_BN) + (size_t)dir * M * 8;
    const float* sp = karg(I_TSP) + layer * RPROJ; const float* sn = karg(I_TSN) + layer * RPROJ;
    const float sp_r = sp[c], sn_r = sn[c], sp_k = sp[512 + c], sn_k = sn[512 + c], sp_v = sp[1024 + c], sn_v = sn[1024 + c];
    const float sp_w = sp[1536 + lane], sn_w = sn[1536 + lane], sp_a = sp[1600 + lane], sn_a = sn[1600 + lane];
    const float w0c = karg(I_W0)[(layer * 2 + dir) * 512 + c], a0c = karg(I_A0)[(layer * 2 + dir) * 512 + c];
    const float kkc = karg(I_KK)[layer * 512 + c], kac = karg(I_KA)[layer * 512 + c], rkc = karg(I_RK)[layer * 512 + c];
    const float* w2 = karg(I_W2) + (size_t)(layer * 2 + dir) * 64 * 512 + c; const float* a2 = karg(I_A2) + (size_t)(layer * 2 + dir) * 64 * 512 + c;
    float S[HD];
#pragma unroll
    for (int k = 0; k < HD; ++k) S[k] = 0.f;
    for (int blk = 0; blk < SEQ / 64; ++blk) {
        const int tb = dir ? (SEQ / 64 - 1 - blk) * 64 : blk * 64;
        float kreg[8], rreg[8];
#pragma unroll
        for (int i = 0; i < 8; ++i) { const int li = 8 * w + i, t = tb + li, row = b * SEQ + t;
            TW[li * 64 + lane] = tanhf(ushift(XL, 256, lane, row, t, sp_w, sn_w));
            XA[li * 64 + lane] = ushift(XL, 256, 64 + lane, row, t, sp_a, sn_a);
            rreg[i] = ushift(Rr, 512, c, row, t, sp_r, sn_r); Rs[li * 64 + lane] = rreg[i];
            kreg[i] = ushift(Kr, 512, c, row, t, sp_k, sn_k);
            Vs[li * 64 + lane] = ushift(Vr, 512, c, row, t, sp_v, sn_v); }
        __syncthreads();
        float zw[8], za[8];
#pragma unroll
        for (int i = 0; i < 8; ++i) { zw[i] = w0c; za[i] = a0c; }
        for (int k = 0; k < 64; ++k) { const float w2v = w2[(size_t)k * 512], a2v = a2[(size_t)k * 512];
#pragma unroll
            for (int i = 0; i < 8; ++i) { zw[i] += TW[(8 * w + i) * 64 + k] * w2v; za[i] += XA[(8 * w + i) * 64 + k] * a2v; } }
#pragma unroll
        for (int i = 0; i < 8; ++i) { const int li = 8 * w + i, row = b * SEQ + tb + li;
            const float decay = __expf(-0.6065306597f * sigmoidf_(zw[i])), a = sigmoidf_(za[i]);
            const float kx = kreg[i] * kkc; const float nrm = wave_sum(kx * kx); const float kkn = kx / sqrtf(nrm + 1e-12f);
            const float kt = kreg[i] * (1.0f + (a - 1.0f) * kac);
            Wd[li * 64 + lane] = decay; KKs[li * 64 + lane] = kkn; KKA[li * 64 + lane] = kkn * a; KT[li * 64 + lane] = kt;
            const float bn = wave_sum(rreg[i] * kt * rkc);
            if (lane == 0) BN[(size_t)row * 8 + h] = bn; }
        __syncthreads();
        if (w == 0) {
            for (int s = 0; s < 64; ++s) { const int li = dir ? 63 - s : s;
                const LAS f32x4* pkk = (const LAS f32x4*)(KKs + li * 64); const LAS f32x4* pw = (const LAS f32x4*)(Wd + li * 64); const LAS f32x4* pka = (const LAS f32x4*)(KKA + li * 64);
                const LAS f32x4* pkt = (const LAS f32x4*)(KT + li * 64); const LAS f32x4* pr = (const LAS f32x4*)(Rs + li * 64);
                const float vv = Vs[li * 64 + lane];
                float s0 = 0.f, s1 = 0.f, s2 = 0.f, s3 = 0.f;
#pragma unroll
                for (int q = 0; q < 16; ++q) { const f32x4 kk4 = pkk[q]; s0 += S[4 * q] * kk4[0]; s1 += S[4 * q + 1] * kk4[1]; s2 += S[4 * q + 2] * kk4[2]; s3 += S[4 * q + 3] * kk4[3]; }
                const float skk = (s0 + s1) + (s2 + s3);
                float y0 = 0.f, y1 = 0.f, y2 = 0.f, y3 = 0.f;
#pragma unroll
                for (int q = 0; q < 16; ++q) { const f32x4 w4 = pw[q], ka4 = pka[q], kt4 = pkt[q], r4 = pr[q];
                    S[4 * q + 0] = S[4 * q + 0] * w4[0] - skk * ka4[0] + vv * kt4[0]; y0 += S[4 * q + 0] * r4[0];
                    S[4 * q + 1] = S[4 * q + 1] * w4[1] - skk * ka4[1] + vv * kt4[1]; y1 += S[4 * q + 1] * r4[1];
                    S[4 * q + 2] = S[4 * q + 2] * w4[2] - skk * ka4[2] + vv * kt4[2]; y2 += S[4 * q + 2] * r4[2];
                    S[4 * q + 3] = S[4 * q + 3] * w4[3] - skk * ka4[3] + vv * kt4[3]; y3 += S[4 * q + 3] * r4[3]; }
                Y[(size_t)(b * SEQ + tb + li) * 512 + c] = (y0 + y1) + (y2 + y3);
            }
        }
        __syncthreads();
    }
}

__device__ __forceinline__ void rwkv_finalize_naive(Frame& F, int layer) {
    unsigned char* const ws = kws();
    int lane_ = lane_id(); asm volatile("" : "+v"(lane_)); const int wave_ = F.wv, tid_ = wave_ * 64 + lane_;
    const int col = tid_, h = wave_;
    LAS float* SG = (LAS float*)(F.lds + RING_OFF);
    const bf16* Vr = (const bf16*)(ws + R_VR); const bf16* XL = (const bf16*)(ws + R_XL); bf16* MIX = (bf16*)(ws + R_MIX);
    const float* Y0 = (const float*)(ws + R_Y0); const float* Y1 = (const float*)(ws + R_Y1); const float* BN0 = (const float*)(ws + R_BN); const float* BN1 = BN0 + (size_t)M * 8;
    const float* sp = karg(I_TSP) + layer * RPROJ; const float* sn = karg(I_TSN) + layer * RPROJ;
    const float* g2 = karg(I_G2) + (size_t)layer * 128 * 512 + col;
    const float gnw = karg(I_GNW)[layer * 512 + col], gnb = karg(I_GNB)[layer * 512 + col], sp_v = sp[1024 + col], sn_v = sn[1024 + col];
    int vz = 0; asm volatile("" : "+v"(vz));
    for (int tile = F.vcu; tile < M / 16; tile += F.G) { const int r0 = tile * 16;
#pragma unroll
        for (int i = 0; i < 4; ++i) { const int e = tid_ + 512 * i, tok = e >> 7, k = e & 127, row = r0 + tok, t = row % SEQ;
            SG[e] = sigmoidf_(ushift(XL, 256, 128 + k, row, t, sp[1664 + k], sn[1664 + k])); }
        __syncthreads();
        float g[16];
#pragma unroll
        for (int i = 0; i < 16; ++i) g[i] = 0.f;
        for (int k = 0; k < 128; ++k) { const float gw = g2[(size_t)k * 512];
#pragma unroll
            for (int i = 0; i < 16; ++i) g[i] += SG[i * 128 + k] * gw; }
#pragma unroll
        for (int i = 0; i < 16; ++i) { const int row = r0 + i, t = row % SEQ;
            const float y = Y0[(size_t)row * 512 + col] + Y1[(size_t)row * 512 + col];
            const float mu = wave_sum(y) * (1.0f / 64.0f); const float dl = y - mu; const float var = wave_sum(dl * dl) * (1.0f / 64.0f);
            const float yn = dl / sqrtf(var + GN_EPS) * gnw + gnb;
            const float vs = ushift(Vr, 512, col, row, t, sp_v, sn_v);
            const float bonus = (BN0[(size_t)row * 8 + h + vz] + BN1[(size_t)row * 8 + h + vz]) * vs;
            MIX[(size_t)row * 1024 + 512 + col] = f2bf_s((yn + bonus) * g[i]); }
        __syncthreads();
    }
}

__global__ void __launch_bounds__(NTHR, 2) mk_fwd(Args args) {
    extern __shared__ __attribute__((aligned(16))) unsigned char lds[];
    Frame F;
    F.lds = (LAS unsigned char*)lds;
    F.MISC = (volatile LAS unsigned*)(F.lds + MISC_OFF);
    F.wv = __builtin_amdgcn_readfirstlane((int)threadIdx.x >> 6);
    F.G = gridDim.x; { const int bx = blockIdx.x; F.vcu = (F.G % 8 == 0) ? (bx % 8) * (F.G / 8) + bx / 8 : bx; }
    F.ctl = (gu32*)(kws() + WS_CTL);
    for (int u = F.wv * 64 + lane_id(); u < (LDS_BYTES - LDSCTL_OFF) / 4; u += NTHR) ((LAS unsigned*)(F.lds + LDSCTL_OFF))[u] = 0u;
    __syncthreads();
    XcdBarrier bar = xcd_barrier_post((unsigned*)(F.ctl + CW_BAR), F.MISC + 8, F.wv == 0 && lane_id() == 0);
#define GRID_BAR() xcd_barrier(bar, F.wv == 0 && lane_id() == 0)
#define XB ((bf16*)(ws + R_XB))
#define MIXB ((bf16*)(ws + R_MIX))
#define HID ((bf16*)(ws + R_HID))
#define SS1 ((float*)(ws + WS_SS1))
#define SS2 ((float*)(ws + WS_SS2))

    for (int step = 0; step < 7 * DEPTH; ++step) {
        const int layer = step / 7, kind = step - 7 * layer;
        if (kind == 0) {
            if (layer == 0) x_prologue(F);
            wconv_phase(F, layer);
        } else if (kind == 1) {
            unsigned char* const ws = kws();
            pg8::Gemm g{XB, (const bf16*)(ws + WS_WIN), M, NPROJ, D}; pg8::StaticOrder S; S.init(M, NPROJ, F.G, (int)blockIdx.x);
            pg8::EpiProj E; E.base0 = (bf16*)(ws + WS_R0); E.ss = SS1; E.qg = karg(I_QG) + layer * HD; E.kg = karg(I_KG) + layer * HD;
            pg8::gemm_phase<pg8::EpiProj, pg8::StaticOrder, true, true>(F.lds + RING_OFF, g, S, E, F.wv, lane_id());
        } else if (kind == 2) {
            if (blockIdx.x < BATCH * H * 2) rwkv_scan_naive(F, layer, (int)blockIdx.x);
            else attn_naive(F, layer, (int)blockIdx.x - BATCH * H * 2, F.G - BATCH * H * 2);
        } else if (kind == 3) {
            rwkv_finalize_naive(F, layer);
        } else if (kind == 4 || kind == 6) {
            unsigned char* const ws = kws(); float* const xo = kout();
            pg8::Gemm g{kind == 4 ? MIXB : HID, (const bf16*)(ws + (kind == 4 ? WS_WOUT : WS_WDN)), M, D, kind == 4 ? D : FF}; pg8::StaticOrder S; S.init(M, D, F.G, (int)blockIdx.x);
            pg8::EpiRes E{xo, XB, kind == 4 ? SS2 : SS1};
            pg8::gemm_phase<pg8::EpiRes, pg8::StaticOrder, false, true>(F.lds + RING_OFF, g, S, E, F.wv, lane_id());
        } else {
            unsigned char* const ws = kws();
            pg8::Gemm g{XB, (const bf16*)(ws + WS_WUP), M, FF, D}; pg8::StaticOrder S; S.init(M, FF, F.G, (int)blockIdx.x);
            pg8::EpiUp E{HID, SS2};
            pg8::gemm_phase<pg8::EpiUp, pg8::StaticOrder, true, true>(F.lds + RING_OFF, g, S, E, F.wv, lane_id());
        }
        if (step + 1 < 7 * DEPTH) GRID_BAR();
    }
}

extern "C" void kernel_launch(void* const* d_in, const int* in_sizes, int n_in, void* d_out, int out_size, void* d_ws, size_t ws_size, hipStream_t stream) {
    static int grid = 0;
    if (grid == 0) {
        if (n_in != N_IN || in_sizes[0] != M * D || out_size != M * D || ws_size < WS_END) { fprintf(stderr, "kernel_launch: unexpected shapes (n_in %d, in0 %d, out %d, ws %zu)\n", n_in, n_in > 0 ? in_sizes[0] : -1, out_size, ws_size); grid = -1; return; }
        int dev = 0, cus = 0;
        if (hipGetDevice(&dev) != hipSuccess || hipDeviceGetAttribute(&cus, hipDeviceAttributeMultiprocessorCount, dev) != hipSuccess) { grid = -1; return; }
        if (hipFuncSetAttribute((const void*)mk_fwd, hipFuncAttributeMaxDynamicSharedMemorySize, LDS_BYTES) != hipSuccess) { fprintf(stderr, "kernel_launch: hipFuncSetAttribute failed\n"); grid = -1; return; }
        int per_cu = 0;
        (void)hipOccupancyMaxActiveBlocksPerMultiprocessor(&per_cu, (const void*)mk_fwd, NTHR, LDS_BYTES);
        (void)hipGetLastError();
        grid = cus;
    }
    if (grid < 0) return;
    (void)hipMemsetAsync((char*)d_ws + WS_CTL, 0, CTL_ZERO_BYTES, stream);
    Args a{};
    for (int i = 0; i < N_IN; ++i) a.in[i] = (const float*)d_in[i];
    a.out = (float*)d_out; a.ws = (unsigned char*)d_ws;
    hipLaunchKernelGGL(mk_fwd, dim3(grid), dim3(NTHR), LDS_BYTES, stream, a);
}
```

```cpp
#include <hip/hip_runtime.h>
#include <cstdio>
#include <cstdint>
namespace pg8 {
#define PG8_LAS __attribute__((address_space(3)))
typedef unsigned short bf16_t;
typedef short bf16x8 __attribute__((ext_vector_type(8)));
typedef float f32x4 __attribute__((ext_vector_type(4)));
typedef unsigned u32x4 __attribute__((ext_vector_type(4)));
constexpr int BM = 256, BK = 64, HALF = 128, HTB = HALF * BK * 2  , STAGE_BYTES = 8 * HTB, NXCD = 8, WGM = 8;

__host__ __device__ __forceinline__ int lds_byte(int r, int c) { const int st = (r >> 4) * 2 + (c >> 5), rr = r & 15, cc = c & 31, ob = rr * 64 + cc * 2; return st * 1024 + (ob ^ (((ob >> 9) & 1) << 5)); }
__host__ __device__ __forceinline__ void stage_rc(int b, int& R, int& C) { const int st = b / 1024, sb = b % 1024, swz = sb ^ (((sb >> 9) & 1) << 5); R = (st >> 1) * 16 + swz / 64; C = (st & 1) * 32 + (swz % 64) / 2; }
__host__ __device__ __forceinline__ int perm32(int rho) { const int n = rho >> 4, i = rho & 15; return 8 * (i >> 2) + 4 * n + (i & 3); }

struct Unit { int pm, pn; };
struct Gemm { const bf16_t* A; const bf16_t* Bt; int M, N, K; };

struct StaticOrder {
    int nM, nN, nwg, G, c;
    __host__ __device__ void init(int M, int N, int G_, int c_) { nM = M / BM; nN = N / BM; nwg = nM * nN; G = G_; c = c_; }
    __host__ __device__ bool next(int i, Unit& u) const {
        const long L = (long)i * G + c; if (L >= nwg) return false;
        int wgid = (int)L; { const int q = nwg / NXCD, r = nwg % NXCD, xcd = wgid % NXCD, off = wgid / NXCD; wgid = (xcd < r ? xcd * (q + 1) : r * (q + 1) + (xcd - r) * q) + off; }
        const int nig = WGM * nN, gid = wgid / nig, fm = gid * WGM, gsz = (nM - fm) < WGM ? (nM - fm) : WGM;
        u.pm = fm + ((wgid % nig) % gsz); u.pn = (wgid % nig) / gsz; return true;
    }
    __device__ __forceinline__ void a_ready(const Unit&) const {}
    __device__ __forceinline__ void done(const Unit&) const {}
};

__device__ __forceinline__ unsigned cvt_pk_bf16(float lo, float hi) { unsigned r; asm volatile("v_cvt_pk_bf16_f32 %0, %1, %2" : "=v"(r) : "v"(lo), "v"(hi)); return r; }
typedef unsigned u32x2 __attribute__((ext_vector_type(2)));

__device__ __forceinline__ float shx(float v, int m, int lane) { return __int_as_float(__builtin_amdgcn_ds_bpermute((lane ^ m) << 2, __float_as_int(v))); }
__device__ __forceinline__ float row_rs(const float* ss, int row, int fq, int lane) {
    const f32x4 p = *(const f32x4*)(ss + (size_t)row * 16 + 4 * fq);
    float s = (p[0] + p[1]) + (p[2] + p[3]);
    s += shx(s, 16, lane); s += shx(s, 32, lane);
    return 1.0f / sqrtf(s * (1.0f / 1024.0f) + 1e-6f);
}

struct EpiProj {
    static constexpr bool PERM = true, AFTER_DRAIN = false;
    bf16_t* base0; const float* ss; const float* qg; const float* kg;
    __device__ __forceinline__ void operator()(const f32x4 (&acc)[2][2][4][2], const Unit& u, int wr, int wc, int fr, int fq) const {
        const int tile = u.pn, di = tile >> 1;
        bf16_t* base = base0 + (di < 2 ? (size_t)di * 512 : (size_t)di * (8u << 20)); const int ldc = (di < 2) ? 1024 : ((di == 6) ? 256 : 512); const int cb = (di == 6) ? 0 : (tile & 1) * 256;
        const bool nrm = tile < 4; const float* gsrc = (tile < 2) ? qg : kg; const float post = (tile < 2) ? 0.125f : 1.0f;
        f32x4 g[2][2];
#pragma unroll
        for (int bj = 0; bj < 2; ++bj)
#pragma unroll
            for (int n = 0; n < 2; ++n) g[bj][n] = nrm ? *(const f32x4*)(gsrc + 32 * bj + 8 * fq + 4 * n) * post : (f32x4){1.f, 1.f, 1.f, 1.f};
#pragma unroll
        for (int ai = 0; ai < 2; ++ai)
#pragma unroll
            for (int m = 0; m < 4; ++m) {
                const int row = u.pm * BM + ai * HALF + wr * 64 + m * 16 + fr;
                const float rs = row_rs(ss, row, fq, 16 * fq + fr);
                f32x4 v[2][2]; float q = 0.f;
#pragma unroll
                for (int bj = 0; bj < 2; ++bj)
#pragma unroll
                    for (int n = 0; n < 2; ++n) { v[bj][n] = acc[ai][bj][m][n] * rs; const f32x4 t = v[bj][n]; q += (t[0] * t[0] + t[1] * t[1]) + (t[2] * t[2] + t[3] * t[3]); }
                q += shx(q, 16, 16 * fq + fr); q += shx(q, 32, 16 * fq + fr);
                const float inv = nrm ? 1.0f / sqrtf(q * (1.0f / 64.0f) + 1e-6f) : 1.0f;
                bf16_t* rowp = base + (size_t)row * ldc + cb + 64 * wc + 8 * fq;
#pragma unroll
                for (int bj = 0; bj < 2; ++bj) { const f32x4 v0 = v[bj][0] * inv * g[bj][0], v1 = v[bj][1] * inv * g[bj][1];
                    u32x4 w; w.x = cvt_pk_bf16(v0[0], v0[1]); w.y = cvt_pk_bf16(v0[2], v0[3]); w.z = cvt_pk_bf16(v1[0], v1[1]); w.w = cvt_pk_bf16(v1[2], v1[3]);
                    *(u32x4*)(rowp + 32 * bj) = w; }
                asm volatile("" ::: "memory");
            }
    }
};
struct EpiUp {
    static constexpr bool PERM = true, AFTER_DRAIN = false;
    bf16_t* O; const float* ss;
    __device__ __forceinline__ void operator()(const f32x4 (&acc)[2][2][4][2], const Unit& u, int wr, int wc, int fr, int fq) const {
#pragma unroll
        for (int ai = 0; ai < 2; ++ai)
#pragma unroll
            for (int m = 0; m < 4; ++m) {
                const int row = u.pm * BM + ai * HALF + wr * 64 + m * 16 + fr;
                const float rs = row_rs(ss, row, fq, 16 * fq + fr);
                bf16_t* rowp = O + (size_t)row * 4096 + u.pn * BM + wc * 32 + 8 * fq;
#pragma unroll
                for (int bj = 0; bj < 2; ++bj) { f32x4 v0 = acc[ai][bj][m][0] * rs, v1 = acc[ai][bj][m][1] * rs;
                    v0 = __builtin_elementwise_max(v0, (f32x4){0.f, 0.f, 0.f, 0.f}); v1 = __builtin_elementwise_max(v1, (f32x4){0.f, 0.f, 0.f, 0.f}); v0 = v0 * v0; v1 = v1 * v1;
                    u32x4 w; w.x = cvt_pk_bf16(v0[0], v0[1]); w.y = cvt_pk_bf16(v0[2], v0[3]); w.z = cvt_pk_bf16(v1[0], v1[1]); w.w = cvt_pk_bf16(v1[2], v1[3]);
                    *(u32x4*)(rowp + bj * HALF) = w; }
                asm volatile("" ::: "memory");
            }
    }
};
struct EpiRes {
    static constexpr bool PERM = false, AFTER_DRAIN = false;
    float* x; bf16_t* xb; float* ss;
    __device__ __forceinline__ void operator()(const f32x4 (&acc)[2][2][4][2], const Unit& u, int wr, int wc, int fr, int fq) const {
        const int col0 = u.pn * BM + wc * 32 + 4 * fq;
#pragma unroll
        for (int ai = 0; ai < 2; ++ai)
#pragma unroll
            for (int m = 0; m < 4; ++m) {
                const int row = u.pm * BM + ai * HALF + wr * 64 + m * 16 + fr; const size_t off = (size_t)row * 1024 + col0; float q = 0.f;
#pragma unroll
                for (int bj = 0; bj < 2; ++bj)
#pragma unroll
                    for (int n = 0; n < 2; ++n) { const size_t o = off + bj * HALF + n * 16; const f32x4 t = *(const f32x4*)(x + o) + acc[ai][bj][m][n];
                        *(f32x4*)(x + o) = t; u32x2 w; w.x = cvt_pk_bf16(t[0], t[1]); w.y = cvt_pk_bf16(t[2], t[3]); *(u32x2*)(xb + o) = w;
                        q += (t[0] * t[0] + t[1] * t[1]) + (t[2] * t[2] + t[3] * t[3]); }
                q += shx(q, 16, 16 * fq + fr); q += shx(q, 32, 16 * fq + fr);
                if (fq == 0) ss[(size_t)row * 16 + 4 * u.pn + wc] = q;
                asm volatile("" ::: "memory");
            }
    }
};

template <class Epi, class Sched, bool ALIGN_EPI = false, bool SP2 = false>
__device__ __forceinline__ void gemm_phase(PG8_LAS unsigned char* lds, const Gemm g, const Sched& S, const Epi& E, int wave_in, int lane_in) {
    int lane_o = lane_in, wave_o = wave_in; asm volatile("" : "+v"(lane_o)); asm volatile("" : "+s"(wave_o)); const int tid_ = wave_o * 64 + lane_o;
    const int tid = tid_, wid = wave_o, lane = lane_o, wr = wid >> 2, wc = wid & 3, fr = lane & 15, fq = lane >> 4;
    const int K = g.K, nt = K / BK;
    unsigned voffA[2], voffB[2];
#pragma unroll
    for (int i = 0; i < 2; ++i) { int R, C; stage_rc(tid * 16 + i * 8192, R, C); const int Rb = Epi::PERM ? ((R & ~31) + perm32(R & 31)) : R;
        voffA[i] = (unsigned)(R * K + C) * 2u; voffB[i] = (unsigned)(Rb * K + C) * 2u; }
    const size_t kstep = (size_t)(BK * 2);
    const size_t hstep = (size_t)HALF * K * 2;
    const size_t tstep = 2 * hstep;
    const unsigned ldsw = (unsigned)wid * 1024u;
    const int aoff = lds_byte(wr * 64 + fr, fq * 8), boff = lds_byte(wc * 32 + fr, fq * 8);
#define PG8_SA(b, h) (((b) * 2 + (h)) * HTB)
#define PG8_SB(b, h) ((4 + (b) * 2 + (h)) * HTB)
#define PG8_STAGE(bufoff, gbase, voff) do { _Pragma("unroll") for (int _i = 0; _i < 2; ++_i) \
        __builtin_amdgcn_global_load_lds((const unsigned*)((const char*)(gbase) + (voff)[_i]), (PG8_LAS unsigned*)(lds + (bufoff) + ldsw + _i * 8192), 16, 0, 0); } while (0)
#define PG8_LDA(dst, b, h) do { _Pragma("unroll") for (int m = 0; m < 4; ++m) _Pragma("unroll") for (int k = 0; k < 2; ++k) dst[m][k] = *(const PG8_LAS bf16x8*)(lds + PG8_SA(b, h) + aoff + m * 2048 + k * 1024); } while (0)
#define PG8_LDB(dst, b, h) do { _Pragma("unroll") for (int n = 0; n < 2; ++n) _Pragma("unroll") for (int k = 0; k < 2; ++k) dst[n][k] = *(const PG8_LAS bf16x8*)(lds + PG8_SB(b, h) + boff + n * 2048 + k * 1024); } while (0)
#define PG8_MMA(ai, bj, At, Bt) do { __builtin_amdgcn_s_setprio(1); _Pragma("unroll") for (int m = 0; m < 4; ++m) _Pragma("unroll") for (int n = 0; n < 2; ++n) _Pragma("unroll") for (int k = 0; k < 2; ++k) \
        acc[ai][bj][m][n] = __builtin_amdgcn_mfma_f32_16x16x32_bf16(Bt[n][k], At[m][k], acc[ai][bj][m][n], 0, 0, 0); __builtin_amdgcn_s_setprio(0); } while (0)
#define PG8_WAIT_V(n) asm volatile("s_waitcnt vmcnt(" #n ")" ::: "memory")
#define PG8_WAIT_L(n) asm volatile("s_waitcnt lgkmcnt(" #n ")" ::: "memory")
#define PG8_BAR __builtin_amdgcn_s_barrier()
#define PG8_SCHED __builtin_amdgcn_sched_barrier(0)
    Unit cur, nxt; int ui = 0;
    if (!S.next(0, cur)) return;
    f32x4 acc[2][2][4][2];
#pragma unroll
    for (int a = 0; a < 2; ++a)
#pragma unroll
        for (int b = 0; b < 2; ++b)
#pragma unroll
            for (int m = 0; m < 4; ++m)
#pragma unroll
                for (int n = 0; n < 2; ++n) acc[a][b][m][n] = (f32x4){0.f, 0.f, 0.f, 0.f};
    bf16x8 At[4][2], B0[2][2], B1[2][2];
    const char* cA = (const char*)g.A + (size_t)cur.pm * tstep; const char* cB = (const char*)g.Bt + (size_t)cur.pn * tstep;
    S.a_ready(cur);
    if constexpr (SP2) {
        PG8_STAGE(PG8_SB(0, 0), cB, voffB); PG8_STAGE(PG8_SB(0, 1), cB + hstep, voffB); PG8_STAGE(PG8_SA(0, 0), cA, voffA); PG8_STAGE(PG8_SA(0, 1), cA + hstep, voffA);
        if (wr == 1) PG8_BAR;
        PG8_WAIT_V(2); PG8_BAR;
        PG8_STAGE(PG8_SB(1, 0), cB + kstep, voffB); PG8_STAGE(PG8_SA(1, 0), cA + kstep, voffA); PG8_STAGE(PG8_SB(1, 1), cB + hstep + kstep, voffB);
        PG8_WAIT_V(6); PG8_BAR;
    } else {
        PG8_STAGE(PG8_SB(0, 0), cB, voffB); PG8_STAGE(PG8_SA(0, 0), cA, voffA); PG8_STAGE(PG8_SB(0, 1), cB + hstep, voffB); PG8_STAGE(PG8_SA(0, 1), cA + hstep, voffA);
        if (wr == 1) PG8_BAR;
        PG8_WAIT_V(4); PG8_BAR;
        PG8_STAGE(PG8_SB(1, 0), cB + kstep, voffB); PG8_STAGE(PG8_SA(1, 0), cA + kstep, voffA); PG8_STAGE(PG8_SB(1, 1), cB + hstep + kstep, voffB);
        PG8_WAIT_V(6); PG8_BAR;
    }
    for (;;) {
        const bool has_next = S.next(ui + 1, nxt);
        const char* nA = has_next ? (const char*)g.A + (size_t)nxt.pm * tstep : cA; const char* nB = has_next ? (const char*)g.Bt + (size_t)nxt.pn * tstep : cB;
        for (int t = 0; t < nt; t += 2) {
            const bool last = (t == nt - 2);
            const char* a1 = cA + (size_t)(t + 1) * kstep;
            const char* a2 = last ? nA : cA + (size_t)(t + 2) * kstep; const char* b2 = last ? nB : cB + (size_t)(t + 2) * kstep;
            const char* a3 = a2 + kstep; const char* b3 = b2 + kstep;
            if (last && has_next) S.a_ready(nxt);
            if constexpr (SP2) {
            PG8_LDB(B0, 0, 0); PG8_LDB(B1, 0, 1); PG8_SCHED; PG8_LDA(At, 0, 0); PG8_STAGE(PG8_SA(1, 1), a1 + hstep, voffA);
            PG8_WAIT_V(8); PG8_WAIT_L(0); PG8_BAR; PG8_MMA(0, 0, At, B0); PG8_MMA(0, 1, At, B1); PG8_BAR; PG8_SCHED;
            PG8_LDA(At, 0, 1); PG8_STAGE(PG8_SB(0, 0), b2, voffB); PG8_STAGE(PG8_SB(0, 1), b2 + hstep, voffB); PG8_STAGE(PG8_SA(0, 0), a2, voffA);
            PG8_WAIT_V(8); PG8_WAIT_L(0); PG8_BAR; PG8_MMA(1, 0, At, B0); PG8_MMA(1, 1, At, B1); PG8_BAR; PG8_SCHED;
            PG8_LDB(B0, 1, 0); PG8_LDB(B1, 1, 1); PG8_SCHED; PG8_LDA(At, 1, 0); PG8_STAGE(PG8_SA(0, 1), a2 + hstep, voffA);
            PG8_WAIT_V(8); PG8_WAIT_L(0); PG8_BAR; PG8_MMA(0, 0, At, B0); PG8_MMA(0, 1, At, B1); PG8_BAR; PG8_SCHED;
            PG8_LDA(At, 1, 1); PG8_STAGE(PG8_SB(1, 0), b3, voffB); PG8_STAGE(PG8_SB(1, 1), b3 + hstep, voffB); PG8_STAGE(PG8_SA(1, 0), a3, voffA);
            PG8_WAIT_V(8); PG8_WAIT_L(0); PG8_BAR; PG8_MMA(1, 0, At, B0); PG8_MMA(1, 1, At, B1); PG8_BAR; PG8_SCHED;
            } else {
            PG8_LDB(B0, 0, 0); PG8_SCHED; PG8_LDA(At, 0, 0); PG8_STAGE(PG8_SA(1, 1), a1 + hstep, voffA);
            PG8_WAIT_L(8); PG8_BAR; PG8_WAIT_L(0); PG8_MMA(0, 0, At, B0); PG8_BAR; PG8_SCHED;
            PG8_LDB(B1, 0, 1); PG8_STAGE(PG8_SB(0, 0), b2, voffB);
            PG8_BAR; PG8_WAIT_L(0); PG8_MMA(0, 1, At, B1); PG8_BAR;
            PG8_LDA(At, 0, 1); PG8_STAGE(PG8_SA(0, 0), a2, voffA);
            PG8_BAR; PG8_WAIT_L(0); PG8_MMA(1, 0, At, B0); PG8_BAR; PG8_SCHED;
            PG8_STAGE(PG8_SB(0, 1), b2 + hstep, voffB);
            PG8_WAIT_V(6); PG8_BAR; PG8_MMA(1, 1, At, B1); PG8_BAR;
            PG8_LDB(B0, 1, 0); PG8_SCHED; PG8_LDA(At, 1, 0); PG8_STAGE(PG8_SA(0, 1), a2 + hstep, voffA);
            PG8_WAIT_L(8); PG8_BAR; PG8_WAIT_L(0); PG8_MMA(0, 0, At, B0); PG8_BAR; PG8_SCHED;
            PG8_LDB(B1, 1, 1); PG8_STAGE(PG8_SB(1, 0), b3, voffB);
            PG8_BAR; PG8_WAIT_L(0); PG8_MMA(0, 1, At, B1); PG8_BAR;
            PG8_LDA(At, 1, 1); PG8_STAGE(PG8_SA(1, 0), a3, voffA);
            PG8_BAR; PG8_WAIT_L(0); PG8_MMA(1, 0, At, B0); PG8_BAR; PG8_SCHED;
            PG8_STAGE(PG8_SB(1, 1), b3 + hstep, voffB);
            PG8_WAIT_V(6); PG8_BAR; PG8_MMA(1, 1, At, B1); PG8_BAR;
            }
        }
        if constexpr (ALIGN_EPI) { if (wr == 0) PG8_BAR; }
        if constexpr (!Epi::AFTER_DRAIN) { E(acc, cur, wr, wc, fr, fq); S.done(cur); }
        if (!has_next) break;
#pragma unroll
        for (int a = 0; a < 2; ++a)
#pragma unroll
            for (int b = 0; b < 2; ++b)
#pragma unroll
                for (int m = 0; m < 4; ++m)
#pragma unroll
                    for (int n = 0; n < 2; ++n) acc[a][b][m][n] = (f32x4){0.f, 0.f, 0.f, 0.f};
        cur = nxt; cA = nA; cB = nB; ++ui;
        if constexpr (ALIGN_EPI) { if (wr == 1) PG8_BAR; }
    }
    PG8_WAIT_V(0);
    if constexpr (!ALIGN_EPI) { if (wr == 0) PG8_BAR; }
    PG8_BAR;
    if constexpr (Epi::AFTER_DRAIN) { E.fused(acc, cur, wr, wc, fr, fq, lds, wid, lane); S.done(cur); }
#undef PG8_SA
#undef PG8_SB
#undef PG8_STAGE
#undef PG8_LDA
#undef PG8_LDB
#undef PG8_MMA
#undef PG8_WAIT_V
#undef PG8_WAIT_L
#undef PG8_BAR
#undef PG8_SCHED
}
}
constexpr int NWAVES = 8, NTHR = 512;
constexpr int BATCH = 4, SEQ = 4096, D = 1024, DEPTH = 4, H = 8, HD = 64, FF = 4096, NPROJ = 3328, RPROJ = 1792;
constexpr int M = BATCH * SEQ;
constexpr float GN_EPS = 64e-5f;
enum { I_X = 0, I_LN1, I_WIN, I_QG, I_KG, I_TSP, I_TSN, I_W0, I_W2, I_A0, I_A2, I_G2, I_KK, I_KA, I_RK, I_GNW, I_GNB, I_WOUT, I_LN2, I_WUP, I_WDN, N_IN };
constexpr size_t MiB = 1u << 20;
constexpr size_t WS_CTL = 0, CTL_ZERO_BYTES = 64 * 1024;
constexpr size_t WS_SS1 = 1 * MiB, WS_SS2 = 2 * MiB;
constexpr size_t WS_WIN = 3 * MiB, WS_WOUT = WS_WIN + (size_t)NPROJ * D * 2, WS_WUP = WS_WOUT + (size_t)D * D * 2, WS_WDN = WS_WUP + (size_t)FF * D * 2;
constexpr size_t WS_R0 = 28 * MiB;
constexpr size_t R_MIX = WS_R0 + 0 * MiB;
constexpr size_t R_V = WS_R0 + 32 * MiB;
constexpr size_t R_RR = WS_R0 + 48 * MiB, R_KR = WS_R0 + 64 * MiB, R_VR = WS_R0 + 80 * MiB, R_XL = WS_R0 + 96 * MiB;
constexpr size_t R_Y0 = R_RR, R_Y1 = R_KR;
constexpr size_t R_PRE = WS_R0 + 104 * MiB;
constexpr size_t R_HID = WS_R0;
constexpr size_t R_XB = WS_R0 + 128 * MiB;
constexpr size_t R_BN = WS_R0 + 232 * MiB;
constexpr size_t WS_END = WS_R0 + 233 * MiB;
constexpr size_t WS_LORA = WS_WDN + (size_t)D * FF * 2;
static_assert(WS_LORA + 4 * 512 * 64 * 2 <= WS_R0, "lora");
constexpr int CW_BAR = 1024;
constexpr int RING_OFF = 0, RING_BYTES = 131072;
constexpr int LDSCTL_OFF = 155648, MISC_OFF = LDSCTL_OFF + 320;
constexpr int LDS_BYTES = 163840;
#define GAS __attribute__((address_space(1)))
#define LAS __attribute__((address_space(3)))
typedef unsigned short bf16;
typedef unsigned v4u __attribute__((ext_vector_type(4)));
typedef float f32x4 __attribute__((ext_vector_type(4)));
typedef short bf16x8 __attribute__((ext_vector_type(8)));
typedef GAS unsigned gu32;
typedef GAS unsigned long long gu64;
#define RLX_AGENT __ATOMIC_RELAXED, __HIP_MEMORY_SCOPE_AGENT
#define LDS_WAIT() asm volatile("s_waitcnt lgkmcnt(0)" ::: "memory")
#define VM_WAIT() asm volatile("s_waitcnt vmcnt(0)" ::: "memory")
__device__ __forceinline__ unsigned long long rt() { return __builtin_amdgcn_s_memrealtime(); }
__device__ __forceinline__ unsigned f2bf(float f) { unsigned u = __builtin_bit_cast(unsigned, f); return (u + 0x7fffu + ((u >> 16) & 1u)) >> 16; }
__device__ __forceinline__ unsigned pk2(float lo, float hi) { return f2bf(lo) | (f2bf(hi) << 16); }

#define XB_TMO      128
#define XB_XCNT(j)  (256  + 64 * (j))
#define XB_XSUB(j)  (1280 + 64 * (j))
#define XB_XGEN(j)  (2304 + 64 * (j))
#define XB_TOP      3328
#define XB_TOPGEN   3392
#define XCD_BAR_WORDS 3456
#define XB_SPIN_CAP (1u << 18)

__device__ __forceinline__ unsigned xb_ld(unsigned* p)              { return __hip_atomic_load(p, __ATOMIC_RELAXED, __HIP_MEMORY_SCOPE_AGENT); }
__device__ __forceinline__ unsigned xb_add(unsigned* p, unsigned v) { return __hip_atomic_fetch_add(p, v, __ATOMIC_RELAXED, __HIP_MEMORY_SCOPE_AGENT); }
__device__ __forceinline__ unsigned xb_xcc_id() { return (unsigned)__builtin_amdgcn_s_getreg((3 << 11) | 20) & 0xFu; }
#define XB_SPIN(cond, bar) do { unsigned _sp = 0; while (cond) { __builtin_amdgcn_s_sleep(1); \
    if ((++_sp & 255u) == 0u) { if (xb_ld(&(bar)[XB_TMO])) break; if (_sp > XB_SPIN_CAP) { atomicAdd(&(bar)[XB_TMO], 1u); break; } } } } while (0)

struct XcdBarrier {
    unsigned* bar; unsigned x;
    volatile LAS unsigned* st;
};

__device__ __forceinline__ XcdBarrier xcd_barrier_post(unsigned* bar, volatile LAS unsigned* st, bool tid0) {
    XcdBarrier b; b.bar = bar; b.x = xb_xcc_id(); b.st = st;
    if (tid0) (void)xb_add(&bar[XB_XCNT(b.x)], 1u);
    return b;
}
__device__ __forceinline__ void xcd_barrier_complete(unsigned* bar, unsigned x, unsigned& nloc, unsigned& nx) {
    const unsigned G = gridDim.x * gridDim.y * gridDim.z;
    unsigned sum, cnt, mine, sp = 0u;
    for (;;) {
        sum = 0u; cnt = 0u; mine = 0u;
#pragma unroll
        for (unsigned j = 0; j < 16; ++j) { const unsigned c = xb_ld(&bar[XB_XCNT(j)]); sum += c; cnt += (c > 0u) ? 1u : 0u; mine = (j == x) ? c : mine; }
        if (sum == G) break;
        __builtin_amdgcn_s_sleep(1);
        if ((++sp & 255u) == 0u) { if (xb_ld(&bar[XB_TMO])) break; if (sp > XB_SPIN_CAP) { atomicAdd(&bar[XB_TMO], 1u); break; } }
    }
    nloc = mine > 0u ? mine : 1u; nx = cnt > 0u ? cnt : 1u;
}

__device__ __forceinline__ void xcd_barrier(const XcdBarrier& b, bool tid0) {
    asm volatile("s_waitcnt vmcnt(0)" ::: "memory");
    __syncthreads();
    if (tid0) {
        unsigned* bar = b.bar; asm volatile("" : "+v"(bar));
        __builtin_amdgcn_s_waitcnt(0);
        unsigned nloc = b.st[0], nx = b.st[1];
        if (nloc == 0u) { xcd_barrier_complete(bar, b.x, nloc, nx); b.st[0] = nloc; b.st[1] = nx; }
        const unsigned old = xb_add(&bar[XB_XSUB(b.x)], 1u);
        const unsigned gen = old / nloc;
        if (old + 1u == (gen + 1u) * nloc) {
            __builtin_amdgcn_fence(__ATOMIC_RELEASE, "agent");
            asm volatile("s_waitcnt vmcnt(0)" ::: "memory");
            const unsigned og = xb_add(&bar[XB_TOP], 1u);
            const unsigned tg = og / nx;
            if (og + 1u == (tg + 1u) * nx) xb_add(&bar[XB_TOPGEN], 1u);
            else XB_SPIN(xb_ld(&bar[XB_TOPGEN]) == tg, bar);
            __builtin_amdgcn_fence(__ATOMIC_ACQUIRE, "agent");
            xb_add(&bar[XB_XGEN(b.x)], 1u);
            asm volatile("s_waitcnt vmcnt(0)" ::: "memory");
        } else {
            XB_SPIN(xb_ld(&bar[XB_XGEN(b.x)]) == gen, bar);
            __builtin_amdgcn_fence(__ATOMIC_ACQUIRE, "agent");
            asm volatile("s_waitcnt vmcnt(0)" ::: "memory");
        }
    }
    __syncthreads();
}
__device__ __forceinline__ float bf2f(bf16 v) { return __uint_as_float(((unsigned)v) << 16); }
__device__ __forceinline__ bf16 f2bf_s(float f) { return (bf16)f2bf(f); }
__device__ __forceinline__ float wave_sum(float v, int lane) {
#pragma unroll
    for (int o = 1; o < 64; o <<= 1) v += pg8::shx(v, o, lane);
    return v;
}
__device__ __forceinline__ float sigmoidf_(float z) { return 1.0f / (1.0f + __expf(-z)); }
__device__ __forceinline__ float tanh_fast(float x) { return 1.0f - 2.0f / (__expf(2.0f * x) + 1.0f); }

struct Args { const float* in[N_IN]; float* out; unsigned char* ws; };
typedef const __attribute__((address_space(4))) Args CArgs;
__device__ __forceinline__ const CArgs* kargs() { const CArgs* p = (const CArgs*)__builtin_amdgcn_kernarg_segment_ptr(); asm volatile("" : "+s"(p)); return p; }
__device__ __forceinline__ unsigned char* kws() { return kargs()->ws; }
__device__ __forceinline__ float* kout() { return kargs()->out; }
__device__ __forceinline__ const float* karg(int i) { return kargs()->in[i]; }
__device__ __forceinline__ int lane_id() { int l; asm volatile("v_mbcnt_lo_u32_b32 %0, -1, 0\n\tv_mbcnt_hi_u32_b32 %0, -1, %0" : "=v"(l)); return l; }
struct Frame {
    LAS unsigned char* lds;
    volatile LAS unsigned* MISC;
    gu32* ctl;
    int vcu, G, wv;
};

__device__ __forceinline__ float ushift(const bf16* buf, int ldc, int col, int row, int t, float sp, float sn) {
    const bf16* p = buf + (size_t)row * ldc + col;
    const float u0 = bf2f(p[0]);
    const float up = (t > 0) ? bf2f(p[-ldc]) : 0.f;
    const float un = (t < SEQ - 1) ? bf2f(p[ldc]) : 0.f;
    return u0 + sp * (up - u0) + sn * (un - u0);
}

__device__ __forceinline__ void transpose_item(const float* W, int K, int N, bf16* WT, const float* gain, bool headperm, LAS float* scr, int item, int lane) {
    const int nblk = N / 32, kb = item / nblk, nb = item % nblk, k0 = 64 * kb, n0 = 32 * nb;
#pragma unroll 8
    for (int i = 0; i < 32; ++i) { const int kk = 2 * i + (lane >> 5); float w = W[(size_t)(k0 + kk) * N + n0 + (lane & 31)]; if (gain) w *= gain[k0 + kk]; scr[kk * 33 + (lane & 31)] = w; }
    LDS_WAIT(); asm volatile("" ::: "memory");
    const int c = lane & 7;
    const int p0 = headperm ? ((n0 & ~255) + 128 * ((n0 >> 5) & 1) + 32 * ((n0 >> 6) & 3)) : n0;
#pragma unroll
    for (int j = 0; j < 4; ++j) { const int n = (lane >> 3) + 8 * j; const LAS float* s = scr + (8 * c) * 33 + n;
        v4u o; o.x = pk2(s[0 * 33], s[1 * 33]); o.y = pk2(s[2 * 33], s[3 * 33]); o.z = pk2(s[4 * 33], s[5 * 33]); o.w = pk2(s[6 * 33], s[7 * 33]);
        *(GAS v4u*)(WT + (size_t)(p0 + n) * K + k0 + 8 * c) = o; }
    LDS_WAIT(); asm volatile("" ::: "memory");
}
__device__ __forceinline__ void wconv_phase(Frame& F, int layer) {
    unsigned char* const ws = kws();
    int lane_ = lane_id(); asm volatile("" : "+v"(lane_)); int wave_o = F.wv; asm volatile("" : "+s"(wave_o)); const int wave_ = wave_o, tid_ = wave_ * 64 + lane_;
    LAS float* scr = (LAS float*)(F.lds + RING_OFF + wave_ * 16384);
    const int gw = F.vcu * NWAVES + wave_, NGW = F.G * NWAVES;
    constexpr int I_1 = (D / 64) * (NPROJ / 32), I_2 = (D / 64) * (D / 32), I_3 = (D / 64) * (FF / 32), I_4 = (FF / 64) * (D / 32);
    const float* win = karg(I_WIN) + (size_t)layer * D * NPROJ; const float* wout = karg(I_WOUT) + (size_t)layer * D * D;
    const float* wup = karg(I_WUP) + (size_t)layer * D * FF; const float* wdn = karg(I_WDN) + (size_t)layer * FF * D;
    const float* g1 = karg(I_LN1) + layer * D; const float* g2 = karg(I_LN2) + layer * D;
    for (int it = gw; it < I_1 + I_2 + I_3 + I_4 + 64; it += NGW) {
        int r = it;
        if (r < I_1) { transpose_item(win, D, NPROJ, (bf16*)(ws + WS_WIN), g1, true, scr, r, lane_); continue; } r -= I_1;
        if (r < I_2) { transpose_item(wout, D, D, (bf16*)(ws + WS_WOUT), nullptr, false, scr, r, lane_); continue; } r -= I_2;
        if (r < I_3) { transpose_item(wup, D, FF, (bf16*)(ws + WS_WUP), g2, false, scr, r, lane_); continue; } r -= I_3;
        if (r < I_4) { transpose_item(wdn, FF, D, (bf16*)(ws + WS_WDN), nullptr, false, scr, r, lane_); continue; } r -= I_4;
        { const int mat = r >> 4, it16 = r & 15;
          const float* src = (mat < 2 ? karg(I_W2) : karg(I_A2)) + (size_t)(layer * 2 + (mat & 1)) * 64 * 512;
          transpose_item(src, 64, 512, (bf16*)(ws + WS_LORA) + (size_t)mat * 512 * 64, nullptr, false, scr, it16, lane_); }
    }
}
__device__ __forceinline__ void x_prologue(Frame& F) {
    unsigned char* const ws = kws();
    int lane_ = lane_id(); asm volatile("" : "+v"(lane_)); int wave_o = F.wv; asm volatile("" : "+s"(wave_o)); const int wave_ = wave_o, tid_ = wave_ * 64 + lane_;
    const int gw = F.vcu * NWAVES + wave_, NGW = F.G * NWAVES;
    const float* x = karg(I_X); bf16* xb = (bf16*)(ws + R_XB); float* ss = (float*)(ws + WS_SS1);
    for (int m = gw; m < M; m += NGW) {
        const GAS f32x4* xr = (const GAS f32x4*)(x + (size_t)m * D) + lane_; GAS f32x4* orow = (GAS f32x4*)(kout() + (size_t)m * D) + lane_;
        GAS unsigned long long* o8 = (GAS unsigned long long*)(xb + (size_t)m * D) + lane_;
        float s = 0.f;
#pragma unroll
        for (int j = 0; j < 4; ++j) { const f32x4 v = xr[64 * j]; orow[64 * j] = v; s += (v.x * v.x + v.y * v.y) + (v.z * v.z + v.w * v.w);
            o8[64 * j] = (unsigned long long)pk2(v.x, v.y) | ((unsigned long long)pk2(v.z, v.w) << 32); }
        s = wave_sum(s, lane_);
        if (lane_ < 16) ss[(size_t)m * 16 + lane_] = (lane_ == 0) ? s : 0.f;
    }
}

__device__ __forceinline__ void attn_naive(Frame& F, int layer, int aw, int naw) {
    unsigned char* const ws = kws();
    int lane_ = lane_id(); asm volatile("" : "+v"(lane_)); int wave_o = F.wv; asm volatile("" : "+s"(wave_o)); const int wave_ = wave_o, tid_ = wave_ * 64 + lane_;
    bf16* MIX = (bf16*)(ws + R_MIX); const bf16* Q = MIX; const bf16* K = MIX + 512; const bf16* V = (const bf16*)(ws + R_V);
    LAS float* qs = (LAS float*)(F.lds + RING_OFF + wave_ * 4096); LAS float* pb = qs + 64;
    float bound;
    { const float* qg = karg(I_QG) + layer * HD; const float* kg = karg(I_KG) + layer * HD; float mq = 0.f, mk = 0.f;
      for (int i = 0; i < HD; ++i) { mq = fmaxf(mq, fabsf(qg[i])); mk = fmaxf(mk, fabsf(kg[i])); }
      bound = 8.0f * mq * mk + 0.25f; }
    const int lane = lane_;
    for (int unit = aw; unit < BATCH * H * SEQ; unit += naw) {
        const int t = unit % SEQ, bh = unit / SEQ, h = bh % H, b = bh / H; const size_t row = (size_t)b * SEQ + t;
        qs[lane] = bf2f(Q[row * 1024 + h * HD + lane]);
        LDS_WAIT(); asm volatile("" ::: "memory");
        float qv[HD];
#pragma unroll
        for (int i = 0; i < HD; ++i) qv[i] = qs[i];
        const float slope = exp2f(-(float)(h + 1));
        float lsum = 0.f;
        for (int bi = 0; bi < 3; ++bi) { const int d = 1 << (2 * bi);
            for (int pass = 0; pass < 3; ++pass) { const int jj = pass * 64 + lane; const bool act = jj <= 128; const int j = jj - 64; const int pos = t + j * d; const bool valid = act && pos >= 0 && pos < SEQ;
                float p = 0.f;
                if (valid) { const v4u* kr = (const v4u*)(K + ((size_t)b * SEQ + pos) * 1024 + h * HD); float dot = 0.f;
#pragma unroll
                    for (int c = 0; c < 8; ++c) { const v4u w = kr[c];
                        dot += qv[8 * c + 0] * __uint_as_float(w.x << 16) + qv[8 * c + 1] * __uint_as_float(w.x & 0xffff0000u) + qv[8 * c + 2] * __uint_as_float(w.y << 16) + qv[8 * c + 3] * __uint_as_float(w.y & 0xffff0000u)
                             + qv[8 * c + 4] * __uint_as_float(w.z << 16) + qv[8 * c + 5] * __uint_as_float(w.z & 0xffff0000u) + qv[8 * c + 6] * __uint_as_float(w.w << 16) + qv[8 * c + 7] * __uint_as_float(w.w & 0xffff0000u); }
                    const float s = dot - slope * fabsf((float)(j * d)); p = __expf(s - bound); }
                if (act) pb[bi * 129 + jj] = p;
                lsum += p; } }
        lsum = wave_sum(lsum, lane_);
        LDS_WAIT(); asm volatile("" ::: "memory");
        float o = 0.f;
        for (int bi = 0; bi < 3; ++bi) { const int d = 1 << (2 * bi);
            for (int jj = 0; jj < 129; ++jj) { const float p = pb[bi * 129 + jj];
                if (p != 0.f) { const int pos = t + (jj - 64) * d; o += p * bf2f(V[((size_t)b * SEQ + pos) * 512 + h * HD + lane]); } } }
        MIX[row * 1024 + h * HD + lane] = f2bf_s(o / lsum);
        LDS_WAIT(); asm volatile("" ::: "memory");
    }
}

typedef float f32x16 __attribute__((ext_vector_type(16)));
typedef short s16x4 __attribute__((ext_vector_type(4)));
typedef short v4i16_t __attribute__((ext_vector_type(4)));
typedef unsigned u32x2_t __attribute__((ext_vector_type(2)));
typedef float f32x2_t __attribute__((ext_vector_type(2))); typedef __bf16 bf16x2_t __attribute__((ext_vector_type(2)));
__device__ __forceinline__ unsigned cvtpk(float lo, float hi) { f32x2_t v = {lo, hi}; bf16x2_t b = __builtin_convertvector(v, bf16x2_t); return __builtin_bit_cast(unsigned, b); }
typedef _Float16 h16x2_t __attribute__((ext_vector_type(2))); typedef _Float16 h16x8 __attribute__((ext_vector_type(8)));
__device__ __forceinline__ unsigned cvtpk_h(float lo, float hi) { f32x2_t v = {lo, hi}; h16x2_t b = __builtin_convertvector(v, h16x2_t); return __builtin_bit_cast(unsigned, b); }
__device__ __forceinline__ f32x2_t unpk_h(unsigned w) { return __builtin_convertvector(__builtin_bit_cast(h16x2_t, w), f32x2_t); }
#define MFMA32H(nf, mf, acc) __builtin_amdgcn_mfma_f32_32x32x16_f16(__builtin_bit_cast(h16x8, (nf)), __builtin_bit_cast(h16x8, (mf)), (acc), 0, 0, 0)
constexpr int TSB = 144, TILE_B = 64 * TSB;
constexpr int PRE_TW = 14 * TILE_B, PRE_XA = 15 * TILE_B, PRE_INVN = 16 * TILE_B, PRE_GC = PRE_INVN + 256, PRE_BON = PRE_GC + 512, PRE_LDS_END = PRE_BON + 1024;
static_assert(PRE_LDS_END <= LDSCTL_OFF, "PRE LDS map");
__device__ __forceinline__ bf16x8 frag_row(const LAS unsigned char* tile, int row, int ks, int hi) {
    return *(const LAS bf16x8*)(tile + row * TSB + (16 * ks + 8 * hi) * 2);
}
__device__ __forceinline__ s16x4 tr4(const LAS unsigned char* p) { return __builtin_bit_cast(s16x4, __builtin_amdgcn_ds_read_tr16_b64_v4i16((LAS v4i16_t*)p)); }
__device__ __forceinline__ bf16x8 frag_tr(const LAS unsigned char* tile, int idx0, int ks, int lane) {
    const int hi = lane >> 5, g1 = (lane >> 4) & 1, i = lane & 15;
    const LAS unsigned char* p = tile + (16 * ks + 8 * hi + (i >> 2)) * TSB + (idx0 + 16 * g1 + 4 * (i & 3)) * 2;
    const s16x4 lo = tr4(p), h4 = tr4(p + 4 * TSB);
    return (bf16x8){lo[0], lo[1], lo[2], lo[3], h4[0], h4[1], h4[2], h4[3]};
}
__device__ __forceinline__ void store_quad(LAS unsigned char* tile, int row, int n0, int hi, const f32x16& a) {
#pragma unroll
    for (int q = 0; q < 4; ++q) { u32x2_t w; w.x = cvtpk(a[4 * q], a[4 * q + 1]); w.y = cvtpk(a[4 * q + 2], a[4 * q + 3]); *(LAS u32x2_t*)(tile + row * TSB + (n0 + 8 * q + 4 * hi) * 2) = w; }
}
__device__ __forceinline__ void store_quad_h(LAS unsigned char* tile, int row, int n0, int hi, const f32x16& a) {
#pragma unroll
    for (int q = 0; q < 4; ++q) { u32x2_t w; w.x = cvtpk_h(a[4 * q], a[4 * q + 1]); w.y = cvtpk_h(a[4 * q + 2], a[4 * q + 3]); *(LAS u32x2_t*)(tile + row * TSB + (n0 + 8 * q + 4 * hi) * 2) = w; }
}
__device__ __forceinline__ f32x16 load_quad(const LAS unsigned char* tile, int row, int n0, int hi) {
    f32x16 a;
#pragma unroll
    for (int q = 0; q < 4; ++q) { const u32x2_t w = *(const LAS u32x2_t*)(tile + row * TSB + (n0 + 8 * q + 4 * hi) * 2);
        a[4 * q] = __uint_as_float(w.x << 16); a[4 * q + 1] = __uint_as_float(w.x & 0xffff0000u); a[4 * q + 2] = __uint_as_float(w.y << 16); a[4 * q + 3] = __uint_as_float(w.y & 0xffff0000u); }
    return a;
}
#define MFMA32(nf, mf, acc) __builtin_amdgcn_mfma_f32_32x32x16_bf16((nf), (mf), (acc), 0, 0, 0)
#define WG_BAR() do { asm volatile("s_waitcnt vmcnt(0) lgkmcnt(0)" ::: "memory"); __builtin_amdgcn_s_barrier(); asm volatile("" ::: "memory"); } while (0)
__device__ __forceinline__ void shift8(const bf16* buf, int ldc, int col, int row, int t, const float* sp, const float* sn, float (&out)[8]) {
    const bf16* p = buf + (size_t)row * ldc + col;
    const v4u c = *(const v4u*)p; v4u pv = (v4u){0u, 0u, 0u, 0u}, nv = (v4u){0u, 0u, 0u, 0u};
    if (t > 0) pv = *(const v4u*)(p - ldc);
    if (t < SEQ - 1) nv = *(const v4u*)(p + ldc);
    const f32x4 sp0 = *(const f32x4*)sp, sp1 = *(const f32x4*)(sp + 4), sn0 = *(const f32x4*)sn, sn1 = *(const f32x4*)(sn + 4);
#pragma unroll
    for (int j = 0; j < 8; ++j) { const unsigned cw = c[j >> 1], pw = pv[j >> 1], nw = nv[j >> 1];
        const float u0 = (j & 1) ? __uint_as_float(cw & 0xffff0000u) : __uint_as_float(cw << 16), up = (j & 1) ? __uint_as_float(pw & 0xffff0000u) : __uint_as_float(pw << 16), un = (j & 1) ? __uint_as_float(nw & 0xffff0000u) : __uint_as_float(nw << 16);
        const float a = (j < 4) ? sp0[j & 3] : sp1[j & 3], bq = (j < 4) ? sn0[j & 3] : sn1[j & 3];
        out[j] = u0 + a * (up - u0) + bq * (un - u0); }
}
__device__ __forceinline__ f32x4 shift4(const bf16* buf, int ldc, int col, int row, int t, const float* sp, const float* sn) {
    const bf16* p = buf + (size_t)row * ldc + col;
    const u32x2_t c = *(const u32x2_t*)p; u32x2_t pv = (u32x2_t){0u, 0u}, nv = (u32x2_t){0u, 0u};
    if (t > 0) pv = *(const u32x2_t*)(p - ldc);
    if (t < SEQ - 1) nv = *(const u32x2_t*)(p + ldc);
    const f32x4 a = *(const f32x4*)sp, bq = *(const f32x4*)sn;
    const f32x4 u0 = (f32x4){__uint_as_float(c.x << 16), __uint_as_float(c.x & 0xffff0000u), __uint_as_float(c.y << 16), __uint_as_float(c.y & 0xffff0000u)};
    const f32x4 up = (f32x4){__uint_as_float(pv.x << 16), __uint_as_float(pv.x & 0xffff0000u), __uint_as_float(pv.y << 16), __uint_as_float(pv.y & 0xffff0000u)};
    const f32x4 un = (f32x4){__uint_as_float(nv.x << 16), __uint_as_float(nv.x & 0xffff0000u), __uint_as_float(nv.y << 16), __uint_as_float(nv.y & 0xffff0000u)};
    return u0 + a * (up - u0) + bq * (un - u0);
}

__device__ __forceinline__ void rwkv_pre_phase(Frame& F, int layer) {
    unsigned char* const ws = kws();
    int lane_ = lane_id(); asm volatile("" : "+v"(lane_)); int wave_o = F.wv; asm volatile("" : "+s"(wave_o)); const int wave_ = wave_o, tid_ = wave_ * 64 + lane_;
    const int d = wave_ >> 2, qm = (wave_ >> 1) & 1, qn = wave_ & 1, m0 = 32 * qm, n0 = 32 * qn;
#define LANE_VARS int lane = lane_; asm volatile("" : "+v"(lane)); const int hi = lane >> 5, l31 = lane & 31, mrow = m0 + l31; (void)hi; (void)l31; (void)mrow;
    LAS unsigned char* const L = F.lds;
    LAS unsigned char* const T0 = L + (d * 7 + 0) * TILE_B; LAS unsigned char* const T1 = L + (d * 7 + 1) * TILE_B; LAS unsigned char* const T2 = L + (d * 7 + 2) * TILE_B; LAS unsigned char* const T3 = L + (d * 7 + 3) * TILE_B;
    LAS unsigned char* const T4 = L + (d * 7 + 4) * TILE_B; LAS unsigned char* const T5 = L + (d * 7 + 5) * TILE_B; LAS unsigned char* const T6 = L + (d * 7 + 6) * TILE_B;
    LAS unsigned char* const TWt = L + PRE_TW; LAS unsigned char* const XAt = L + PRE_XA;
    LAS float* const invn = (LAS float*)(L + PRE_INVN); LAS float* const gcs = (LAS float*)(L + PRE_GC) + d * 64; LAS float* const bon = (LAS float*)(L + PRE_BON);
    const bf16* Rr = (const bf16*)(ws + R_RR); const bf16* Kr = (const bf16*)(ws + R_KR); const bf16* Vr = (const bf16*)(ws + R_VR); const bf16* XL = (const bf16*)(ws + R_XL);
    const bf16* W2T = (const bf16*)(ws + WS_LORA) + (size_t)d * 512 * 64; const bf16* A2T = (const bf16*)(ws + WS_LORA) + (size_t)(2 + d) * 512 * 64;
    float* BN = (float*)(ws + R_BN) + (size_t)d * M * 8;
    const float* sp = karg(I_TSP) + layer * RPROJ; const float* sn = karg(I_TSN) + layer * RPROJ;
    const float* w0 = karg(I_W0) + (layer * 2 + d) * 512; const float* a0 = karg(I_A0) + (layer * 2 + d) * 512;
    const float* kkp = karg(I_KK) + layer * 512; const float* kap = karg(I_KA) + layer * 512; const float* rkp = karg(I_RK) + layer * 512;
    for (int item = F.vcu; item < BATCH * H * (SEQ / 64); item += F.G) {
        const int cn = item & 63, h = (item >> 6) & 7, b = item >> 9, t0 = cn * 64, hc = h * HD;
#define SNAT (d ? 63 - mrow : mrow)
        { LANE_VARS; const int tidl = wave_ * 64 + lane; const int tok = tidl >> 3, oct = tidl & 7, t = t0 + tok, row = b * SEQ + t; float v8[8];
          shift8(XL, 256, 8 * oct, row, t, sp + 1536 + 8 * oct, sn + 1536 + 8 * oct, v8);
          { v4u w; w.x = cvtpk(tanh_fast(v8[0]), tanh_fast(v8[1])); w.y = cvtpk(tanh_fast(v8[2]), tanh_fast(v8[3])); w.z = cvtpk(tanh_fast(v8[4]), tanh_fast(v8[5])); w.w = cvtpk(tanh_fast(v8[6]), tanh_fast(v8[7])); *(LAS v4u*)(TWt + tok * TSB + 16 * oct) = w; }
          shift8(XL, 256, 64 + 8 * oct, row, t, sp + 1600 + 8 * oct, sn + 1600 + 8 * oct, v8);
          { v4u w; w.x = cvtpk(v8[0], v8[1]); w.y = cvtpk(v8[2], v8[3]); w.z = cvtpk(v8[4], v8[5]); w.w = cvtpk(v8[6], v8[7]); *(LAS v4u*)(XAt + tok * TSB + 16 * oct) = w; }
          shift8(Kr, 512, hc + 8 * oct, row, t, sp + 512 + hc + 8 * oct, sn + 512 + hc + 8 * oct, v8);
          const f32x4 k0 = *(const f32x4*)(kkp + hc + 8 * oct), k1 = *(const f32x4*)(kkp + hc + 8 * oct + 4); float ssq = 0.f;
#pragma unroll
          for (int j = 0; j < 8; ++j) { const float kx = v8[j] * ((j < 4) ? k0[j & 3] : k1[j & 3]); ssq += kx * kx; }
          ssq += pg8::shx(ssq, 1, lane); ssq += pg8::shx(ssq, 2, lane); ssq += pg8::shx(ssq, 4, lane);
          if (oct == 0) invn[tok] = 1.0f / sqrtf(ssq + 1e-12f); }
        WG_BAR();
        f32x16 zw, za, lw, av, cum;
        { LANE_VARS; const int snat = SNAT;
#pragma unroll
        for (int r = 0; r < 16; ++r) { zw[r] = 0.f; za[r] = 0.f; }
#pragma unroll
        for (int ks = 0; ks < 4; ++ks) { const size_t wo = (size_t)(hc + n0 + l31) * 64 + 16 * ks + 8 * hi;
            const bf16x8 wf = *(const bf16x8*)(W2T + wo), af = *(const bf16x8*)(A2T + wo);
            zw = MFMA32(wf, frag_row(TWt, snat, ks, hi), zw); za = MFMA32(af, frag_row(XAt, snat, ks, hi), za); }
#pragma unroll
        for (int q = 0; q < 4; ++q) { const f32x4 w0v = *(const f32x4*)(w0 + hc + n0 + 8 * q + 4 * hi), a0v = *(const f32x4*)(a0 + hc + n0 + 8 * q + 4 * hi);
#pragma unroll
            for (int i = 0; i < 4; ++i) { lw[4 * q + i] = -0.6065306597f * sigmoidf_(zw[4 * q + i] + w0v[i]); av[4 * q + i] = sigmoidf_(za[4 * q + i] + a0v[i]); } }
        { f32x16 lh, ll;
#pragma unroll
          for (int r = 0; r < 16; ++r) { lh[r] = __uint_as_float(cvtpk(lw[r], 0.f) << 16); ll[r] = lw[r] - lh[r]; }
          store_quad(T4, mrow, n0, hi, lh); store_quad(T5, mrow, n0, hi, ll); } }
        WG_BAR();
        { LANE_VARS;
#pragma unroll
        for (int r = 0; r < 16; ++r) cum[r] = 0.f;
#pragma unroll
        for (int ks = 0; ks < 4; ++ks) { bf16x8 tf;
#pragma unroll
            for (int j = 0; j < 8; ++j) tf[j] = (16 * ks + 8 * hi + j <= mrow) ? (short)0x3f80 : (short)0;
            cum = MFMA32(frag_tr(T4, n0, ks, lane), tf, cum); cum = MFMA32(frag_tr(T5, n0, ks, lane), tf, cum); } }
        f32x16 rh, kc, mrk;
        { LANE_VARS; const int snat = SNAT; const int tnat = t0 + snat, row = b * SEQ + tnat; const float inv = invn[snat];
          f32x16 kh, bc; float bsum = 0.f;
#pragma unroll
          for (int q = 0; q < 4; ++q) { const int cg = hc + n0 + 8 * q + 4 * hi;
              const f32x4 r4 = shift4(Rr, 512, cg, row, tnat, sp + cg, sn + cg), k4 = shift4(Kr, 512, cg, row, tnat, sp + 512 + cg, sn + 512 + cg);
              const f32x4 kk4 = *(const f32x4*)(kkp + cg), ka4 = *(const f32x4*)(kap + cg), rk4 = *(const f32x4*)(rkp + cg);
#pragma unroll
              for (int i = 0; i < 4; ++i) { const int e = 4 * q + i; const float a = av[e], cs = cum[e];
                  const float g = __expf(cs), gx = __expf(cs - lw[e]), gi = __expf(-cs);
                  const float kkn = k4[i] * kk4[i] * inv, kt = k4[i] * (1.0f + (a - 1.0f) * ka4[i]);
                  kh[e] = gx * kkn; rh[e] = g * r4[i]; bc[e] = a * kkn * gi; kc[e] = kt * gi; bsum += r4[i] * kt * rk4[i];
                  if (mrow == 63) gcs[n0 + 8 * q + 4 * hi + i] = g; } }
          store_quad(T0, mrow, n0, hi, kh); store_quad(T1, mrow, n0, hi, rh); store_quad(T2, mrow, n0, hi, bc); store_quad(T3, mrow, n0, hi, kc);
          { f32x16 rl, kl;
#pragma unroll
            for (int e = 0; e < 16; ++e) { rl[e] = rh[e] - __uint_as_float(cvtpk(rh[e], 0.f) << 16); kl[e] = kc[e] - __uint_as_float(cvtpk(kc[e], 0.f) << 16); }
            store_quad(T4, mrow, n0, hi, rl); store_quad(T5, mrow, n0, hi, kl); }
          bsum += pg8::shx(bsum, 32, lane);
          if (hi == 0) bon[(d * 2 + qn) * 64 + snat] = bsum; }
        WG_BAR();
        { LANE_VARS; const int snat = SNAT; if (qn == 0 && hi == 0) BN[(size_t)(b * SEQ + t0 + snat) * 8 + h] = bon[(d * 2) * 64 + snat] + bon[(d * 2 + 1) * 64 + snat]; }
        { LANE_VARS;
#pragma unroll
          for (int r = 0; r < 16; ++r) mrk[r] = 0.f;
#pragma unroll
          for (int ks = 0; ks < 4; ++ks) { const bf16x8 rhi = frag_row(T1, mrow, ks, hi), khi = frag_row(T3, n0 + l31, ks, hi);
              mrk = MFMA32(khi, rhi, mrk); mrk = MFMA32(frag_row(T5, n0 + l31, ks, hi), rhi, mrk); mrk = MFMA32(khi, frag_row(T4, mrow, ks, hi), mrk); }
#pragma unroll
          for (int q = 0; q < 4; ++q)
#pragma unroll
              for (int i = 0; i < 4; ++i) { const int e = 4 * q + i, n = n0 + 8 * q + 4 * hi + i; mrk[e] = (n <= mrow) ? mrk[e] : 0.f; } }
        WG_BAR();
        { LANE_VARS; f32x16 x, mk, zz;
          float z0 = 0.f; asm volatile("" : "+v"(z0));
#pragma unroll
          for (int r = 0; r < 16; ++r) { x[r] = 0.f; mk[r] = 0.f; zz[r] = z0; }
#pragma unroll
          for (int ks = 0; ks < 4; ++ks) { const bf16x8 mf = frag_row(T0, mrow, ks, hi);
              x = MFMA32(frag_row(T2, n0 + l31, ks, hi), mf, x); mk = MFMA32(frag_row(T3, n0 + l31, ks, hi), mf, mk); }
#pragma unroll
          for (int q = 0; q < 4; ++q)
#pragma unroll
              for (int i = 0; i < 4; ++i) { const int e = 4 * q + i, n = n0 + 8 * q + 4 * hi + i; const bool lo = n < mrow; x[e] = lo ? -x[e] : 0.f; mk[e] = lo ? mk[e] : 0.f; }
          store_quad(T4, mrow, n0, hi, x); store_quad(T5, mrow, n0, hi, zz); store_quad(T6, mrow, n0, hi, mk); }
        WG_BAR();
        if ((wave_ & 3) == 0) { LANE_VARS; const int blk = lane >> 4, c = lane & 15; float t[16];
#pragma unroll
            for (int r = 0; r < 16; ++r) { const LAS unsigned char* xr = T4 + (16 * blk + r) * TSB + 32 * blk; const v4u w0_ = *(const LAS v4u*)xr, w1_ = *(const LAS v4u*)(xr + 16);
                float acc0 = (r == c) ? 1.0f : 0.f, acc1 = 0.f;
#pragma unroll
                for (int j = 0; j < r; ++j) { const unsigned w = (j < 8) ? w0_[j >> 1] : w1_[(j - 8) >> 1]; const float xv = (j & 1) ? __uint_as_float(w & 0xffff0000u) : __uint_as_float(w << 16);
                    if (j & 1) acc1 += xv * t[j]; else acc0 += xv * t[j]; }
                t[r] = acc0 + acc1; }
#pragma unroll
            for (int r = 0; r < 16; ++r) *(LAS unsigned short*)(T5 + (16 * blk + r) * TSB + (16 * blk + c) * 2) = (unsigned short)(cvtpk(t[r], 0.f) & 0xffffu); }
        WG_BAR();
        { LANE_VARS; LAS unsigned char* const scr = qm ? T5 : T4;
          if (qm == qn) {
              f32x16 w;
#pragma unroll
              for (int r = 0; r < 16; ++r) w[r] = 0.f;
              bf16x8 mf = frag_row(T4, m0 + l31, 2 * qm, hi);
              if (l31 < 16) mf = (bf16x8){0, 0, 0, 0, 0, 0, 0, 0};
              w = MFMA32(frag_tr(T5, m0, 2 * qm, lane), mf, w);
              store_quad(scr, l31, 32, hi, w); } }
        WG_BAR();
        { LANE_VARS; LAS unsigned char* const scr = qm ? T5 : T4;
          if (qm == qn) {
              f32x16 tq = load_quad(T5, mrow, m0, hi);
#pragma unroll
              for (int ks = 0; ks < 2; ++ks) tq = MFMA32(frag_tr(scr, 32, ks, lane), frag_row(T5, mrow, 2 * qm + ks, hi), tq);
              store_quad(T5, mrow, m0, hi, tq); } }
        WG_BAR();
        { LANE_VARS;
          if (qm == 1 && qn == 0) {
              f32x16 w;
#pragma unroll
              for (int r = 0; r < 16; ++r) w[r] = 0.f;
#pragma unroll
              for (int ks = 0; ks < 2; ++ks) w = MFMA32(frag_tr(T5, 0, ks, lane), frag_row(T4, 32 + l31, ks, hi), w);
              store_quad(T4, l31, 32, hi, w); }
          if (qm == 0 && qn == 1) { f32x16 zz; float z0 = 0.f; asm volatile("" : "+v"(z0));
#pragma unroll
              for (int r = 0; r < 16; ++r) zz[r] = z0;
              store_quad(T5, l31, 32, hi, zz); } }
        WG_BAR();
        { LANE_VARS;
          if (qm == 1 && qn == 0) {
              f32x16 t21;
#pragma unroll
              for (int r = 0; r < 16; ++r) t21[r] = 0.f;
#pragma unroll
              for (int ks = 0; ks < 2; ++ks) t21 = MFMA32(frag_tr(T4, 32, ks, lane), frag_row(T5, 32 + l31, 2 + ks, hi), t21);
              store_quad(T5, 32 + l31, 0, hi, t21); } }
        WG_BAR();
        { LANE_VARS; f32x16 kp, tk;
#pragma unroll
          for (int r = 0; r < 16; ++r) { kp[r] = 0.f; tk[r] = 0.f; }
#pragma unroll
          for (int ks = 0; ks < 4; ++ks) { const bf16x8 mf = frag_row(T5, mrow, ks, hi);
              kp = MFMA32(frag_tr(T0, n0, ks, lane), mf, kp); tk = MFMA32(frag_tr(T6, n0, ks, lane), mf, tk); }
          WG_BAR();
          store_quad(T0, mrow, n0, hi, kp); store_quad(T6, mrow, n0, hi, tk); }
        { LANE_VARS; f32x16 rb;
#pragma unroll
          for (int r = 0; r < 16; ++r) rb[r] = 0.f;
#pragma unroll
          for (int ks = 0; ks < 4; ++ks) rb = MFMA32(frag_row(T2, n0 + l31, ks, hi), frag_row(T1, mrow, ks, hi), rb);
#pragma unroll
          for (int q = 0; q < 4; ++q)
#pragma unroll
              for (int i = 0; i < 4; ++i) { const int e = 4 * q + i, n = n0 + 8 * q + 4 * hi + i; rb[e] = (n <= mrow) ? rb[e] : 0.f; }
          store_quad(T4, mrow, n0, hi, rb); }
        WG_BAR();
        const int cd = d ? 63 - cn : cn;
        bf16* const pre = (bf16*)(ws + R_PRE) + ((size_t)(((b * 8 + h) * 2 + d) * 64 + cd)) * 16384;
        { LANE_VARS; f32x16 rp, ml, pm, kq;
#pragma unroll
          for (int r = 0; r < 16; ++r) { rp[r] = 0.f; ml[r] = 0.f; pm[r] = 0.f; kq[r] = 0.f; }
#pragma unroll
          for (int ks = 0; ks < 4; ++ks) { const bf16x8 mrbf = frag_row(T4, mrow, ks, hi), khn = frag_tr(T0, n0, ks, lane), bcn = frag_tr(T2, n0, ks, lane);
              rp = MFMA32(khn, mrbf, rp); ml = MFMA32(frag_tr(T6, n0, ks, lane), mrbf, ml);
              pm = MFMA32(khn, frag_tr(T2, m0, ks, lane), pm); kq = MFMA32(bcn, frag_tr(T6, m0, ks, lane), kq); }
          const float gm = gcs[mrow];
#pragma unroll
          for (int q = 0; q < 4; ++q)
#pragma unroll
              for (int i = 0; i < 4; ++i) { const int e = 4 * q + i, n = n0 + 8 * q + 4 * hi + i;
                  rp[e] = rh[e] - rp[e]; ml[e] = mrk[e] - ml[e]; pm[e] = gm * (((n == mrow) ? 1.0f : 0.f) - pm[e]); kq[e] = (kc[e] - kq[e]) * gcs[n]; }
#pragma unroll
          for (int q = 0; q < 4; ++q) { const int pc = n0 + 16 * (q >> 1) + 8 * hi + 4 * (q & 1);
              u32x2_t w; w.x = cvtpk_h(pm[4 * q], pm[4 * q + 1]); w.y = cvtpk_h(pm[4 * q + 2], pm[4 * q + 3]); *(u32x2_t*)(pre + mrow * 64 + pc) = w;
              w.x = cvtpk_h(rp[4 * q], rp[4 * q + 1]); w.y = cvtpk_h(rp[4 * q + 2], rp[4 * q + 3]); *(u32x2_t*)(pre + 4096 + mrow * 64 + pc) = w; }
          WG_BAR();
          store_quad_h(T4, mrow, n0, hi, ml); store_quad_h(T5, mrow, n0, hi, kq); }
        { LANE_VARS; const int tt = (wave_ * 64 + lane) & 255, s = tt >> 2, cg4 = (tt & 3) * 16, sn_ = d ? 63 - s : s, t = t0 + sn_, row = b * SEQ + t; float v8[8];
#pragma unroll
          for (int hlf = 0; hlf < 2; ++hlf) { const int c8 = cg4 + 8 * hlf;
              shift8(Vr, 512, hc + c8, row, t, sp + 1024 + hc + c8, sn + 1024 + hc + c8, v8);
              v4u w; w.x = cvtpk_h(v8[0], v8[1]); w.y = cvtpk_h(v8[2], v8[3]); w.z = cvtpk_h(v8[4], v8[5]); w.w = cvtpk_h(v8[6], v8[7]); *(LAS v4u*)(T1 + s * TSB + 2 * c8) = w; } }
        WG_BAR();
        { LANE_VARS; f32x16 qt, yt;
#pragma unroll
          for (int r = 0; r < 16; ++r) { qt[r] = 0.f; yt[r] = 0.f; }
#pragma unroll
          for (int ks = 0; ks < 4; ++ks) { const bf16x8 vf = frag_tr(T1, m0, ks, lane);
              qt = MFMA32H(frag_tr(T5, n0, ks, lane), vf, qt); yt = MFMA32H(frag_row(T4, n0 + l31, ks, hi), vf, yt); }
          v4u w0_, w1_;
          w0_.x = cvtpk_h(qt[0], qt[1]); w0_.y = cvtpk_h(qt[2], qt[3]); w0_.z = cvtpk_h(qt[4], qt[5]); w0_.w = cvtpk_h(qt[6], qt[7]); w1_.x = cvtpk_h(qt[8], qt[9]); w1_.y = cvtpk_h(qt[10], qt[11]); w1_.z = cvtpk_h(qt[12], qt[13]); w1_.w = cvtpk_h(qt[14], qt[15]);
          { bf16* dst = pre + 8192 + ((qn * 64 + mrow) * 2 + hi) * 16; *(v4u*)dst = w0_; *(v4u*)(dst + 8) = w1_; }
          w0_.x = cvtpk_h(yt[0], yt[1]); w0_.y = cvtpk_h(yt[2], yt[3]); w0_.z = cvtpk_h(yt[4], yt[5]); w0_.w = cvtpk_h(yt[6], yt[7]); w1_.x = cvtpk_h(yt[8], yt[9]); w1_.y = cvtpk_h(yt[10], yt[11]); w1_.z = cvtpk_h(yt[12], yt[13]); w1_.w = cvtpk_h(yt[14], yt[15]);
          { bf16* dst = pre + 12288 + ((qn * 64 + mrow) * 2 + hi) * 16; *(v4u*)dst = w0_; *(v4u*)(dst + 8) = w1_; } }
        WG_BAR();
    }
#undef LANE_VARS
#undef SNAT
}

__device__ __forceinline__ void rwkv_scan_chunk(Frame& F, int unit) {
    unsigned char* const ws = kws();
    int lane_ = lane_id(); asm volatile("" : "+v"(lane_));
    const int lane = lane_, hi = lane >> 5, l31 = lane & 31;
    const int chain = unit >> 1, vh = unit & 1, d = chain & 1, h = (chain >> 1) & 7, b = chain >> 4, v = 32 * vh + l31;
    const bf16* pre = (const bf16*)(ws + R_PRE) + (size_t)chain * 64 * 16384;
    bf16* Y = (bf16*)(ws + (d ? R_Y1 : R_Y0));
    f32x16 X0, X1;
#pragma unroll
    for (int r = 0; r < 16; ++r) { X0[r] = 0.f; X1[r] = 0.f; }
#pragma unroll 1
    for (int c = 0; c < 64; ++c, pre += 16384) {
        bf16x8 xb[2][2], xl[2][2];
#pragma unroll
        for (int kt = 0; kt < 2; ++kt)
#pragma unroll
            for (int s = 0; s < 2; ++s) { v4u w, wl;
#pragma unroll
                for (int j = 0; j < 4; ++j) { const float a0 = kt ? X1[8 * s + 2 * j] : X0[8 * s + 2 * j], a1 = kt ? X1[8 * s + 2 * j + 1] : X0[8 * s + 2 * j + 1];
                    const unsigned hw = cvtpk_h(a0, a1); const f32x2_t hf = unpk_h(hw); w[j] = hw; wl[j] = cvtpk_h(a0 - hf.x, a1 - hf.y); }
                xb[kt][s] = __builtin_bit_cast(bf16x8, w); xl[kt][s] = __builtin_bit_cast(bf16x8, wl); }
        f32x16 acc[4];
#pragma unroll
        for (int o = 0; o < 4; ++o) { const bf16* src = pre + (o < 2 ? 8192 : 12288) + (((o & 1) * 64 + v) * 2 + hi) * 16; const v4u w0_ = *(const v4u*)src, w1_ = *(const v4u*)(src + 8);
#pragma unroll
            for (int j = 0; j < 4; ++j) { const f32x2_t u0 = unpk_h(w0_[j]), u1 = unpk_h(w1_[j]); acc[o][2 * j] = u0.x; acc[o][2 * j + 1] = u0.y; acc[o][8 + 2 * j] = u1.x; acc[o][8 + 2 * j + 1] = u1.y; } }
#pragma unroll
        for (int o = 0; o < 4; ++o) { const bf16* arow = pre + (o < 2 ? 0 : 4096) + (32 * (o & 1) + l31) * 64 + 8 * hi;
#pragma unroll
            for (int kt = 0; kt < 2; ++kt)
#pragma unroll
                for (int s = 0; s < 2; ++s) { const bf16x8 af = *(const bf16x8*)(arow + 32 * kt + 16 * s); acc[o] = MFMA32H(af, xb[kt][s], acc[o]); acc[o] = MFMA32H(af, xl[kt][s], acc[o]); } }
#pragma unroll
        for (int st = 0; st < 2; ++st)
#pragma unroll
            for (int r = 0; r < 16; ++r) { const int s = 32 * st + (r & 3) + 8 * (r >> 2) + 4 * hi; const int tnat = d ? (63 - c) * 64 + 63 - s : c * 64 + s;
                Y[(size_t)(b * SEQ + tnat) * 512 + h * HD + v] = (bf16)(cvtpk_h(acc[2 + st][r], 0.f) & 0xffffu); }
        X0 = acc[0]; X1 = acc[1];
    }
}

__device__ __forceinline__ void rwkv_finalize_naive(Frame& F, int layer) {
    unsigned char* const ws = kws();
    int lane_ = lane_id(); asm volatile("" : "+v"(lane_)); int wave_o = F.wv; asm volatile("" : "+s"(wave_o)); const int wave_ = wave_o, tid_ = wave_ * 64 + lane_;
    const int col = tid_, h = wave_;
    LAS float* SG = (LAS float*)(F.lds + RING_OFF);
    const bf16* Vr = (const bf16*)(ws + R_VR); const bf16* XL = (const bf16*)(ws + R_XL); bf16* MIX = (bf16*)(ws + R_MIX);
    const bf16* Y0 = (const bf16*)(ws + R_Y0); const bf16* Y1 = (const bf16*)(ws + R_Y1); const float* BN0 = (const float*)(ws + R_BN); const float* BN1 = BN0 + (size_t)M * 8;
    const float* sp = karg(I_TSP) + layer * RPROJ; const float* sn = karg(I_TSN) + layer * RPROJ;
    const float* g2 = karg(I_G2) + (size_t)layer * 128 * 512 + col;
    const float gnw = karg(I_GNW)[layer * 512 + col], gnb = karg(I_GNB)[layer * 512 + col], sp_v = sp[1024 + col], sn_v = sn[1024 + col];
    int vz = 0; asm volatile("" : "+v"(vz));
    for (int tile = F.vcu; tile < M / 16; tile += F.G) { const int r0 = tile * 16;
#pragma unroll
        for (int i = 0; i < 4; ++i) { const int e = tid_ + 512 * i, tok = e >> 7, k = e & 127, row = r0 + tok, t = row % SEQ;
            SG[e] = sigmoidf_(ushift(XL, 256, 128 + k, row, t, sp[1664 + k], sn[1664 + k])); }
        __syncthreads();
        float g[16];
#pragma unroll
        for (int i = 0; i < 16; ++i) g[i] = 0.f;
        for (int k = 0; k < 128; ++k) { const float gw = g2[(size_t)k * 512];
#pragma unroll
            for (int i = 0; i < 16; ++i) g[i] += SG[i * 128 + k] * gw; }
#pragma unroll
        for (int i = 0; i < 16; ++i) { const int row = r0 + i, t = row % SEQ;
            const float y = unpk_h(Y0[(size_t)row * 512 + col]).x + unpk_h(Y1[(size_t)row * 512 + col]).x;
            const float mu = wave_sum(y, lane_) * (1.0f / 64.0f); const float dl = y - mu; const float var = wave_sum(dl * dl, lane_) * (1.0f / 64.0f);
            const float yn = dl / sqrtf(var + GN_EPS) * gnw + gnb;
            const float vs = ushift(Vr, 512, col, row, t, sp_v, sn_v);
            const float bonus = (BN0[(size_t)row * 8 + h + vz] + BN1[(size_t)row * 8 + h + vz]) * vs;
            MIX[(size_t)row * 1024 + 512 + col] = f2bf_s((yn + bonus) * g[i]); }
        __syncthreads();
    }
}

__global__ void __launch_bounds__(NTHR, 2) mk_fwd(Args args) {
    extern __shared__ __attribute__((aligned(16))) unsigned char lds[];
    Frame F;
    F.lds = (LAS unsigned char*)lds;
    F.MISC = (volatile LAS unsigned*)(F.lds + MISC_OFF);
    F.wv = __builtin_amdgcn_readfirstlane((int)threadIdx.x >> 6);
    F.G = gridDim.x; { const int bx = blockIdx.x; F.vcu = (F.G % 8 == 0) ? (bx % 8) * (F.G / 8) + bx / 8 : bx; }
    F.ctl = (gu32*)(kws() + WS_CTL);
    for (int u = F.wv * 64 + lane_id(); u < (LDS_BYTES - LDSCTL_OFF) / 4; u += NTHR) ((LAS unsigned*)(F.lds + LDSCTL_OFF))[u] = 0u;
    __syncthreads();
    XcdBarrier bar = xcd_barrier_post((unsigned*)(F.ctl + CW_BAR), F.MISC + 8, F.wv == 0 && lane_id() == 0);
#define GRID_BAR() xcd_barrier(bar, F.wv == 0 && lane_id() == 0)
#define XB ((bf16*)(ws + R_XB))
#define MIXB ((bf16*)(ws + R_MIX))
#define HID ((bf16*)(ws + R_HID))
#define SS1 ((float*)(ws + WS_SS1))
#define SS2 ((float*)(ws + WS_SS2))

    for (int step = 0; step < 8 * DEPTH; ++step) {
        const int layer = step >> 3, kind = step & 7;
        if (kind == 0) {
            if (layer == 0) x_prologue(F);
            wconv_phase(F, layer);
        } else if (kind == 1) {
            unsigned char* const ws = kws();
            pg8::Gemm g{XB, (const bf16*)(ws + WS_WIN), M, NPROJ, D}; pg8::StaticOrder S; S.init(M, NPROJ, F.G, (int)blockIdx.x);
            pg8::EpiProj E; E.base0 = (bf16*)(ws + WS_R0); E.ss = SS1; E.qg = karg(I_QG) + layer * HD; E.kg = karg(I_KG) + layer * HD;
            pg8::gemm_phase<pg8::EpiProj, pg8::StaticOrder, true, true>(F.lds + RING_OFF, g, S, E, F.wv, lane_id());
        } else if (kind == 2) {
            rwkv_pre_phase(F, layer);
        } else if (kind == 3) {
            const int bx = (int)blockIdx.x;
            if (bx < 128 && F.wv == 0) rwkv_scan_chunk(F, bx);
            else attn_naive(F, layer, bx < 128 ? bx * 7 + F.wv - 1 : 896 + (bx - 128) * 8 + F.wv, 896 + (F.G - 128) * 8);
        } else if (kind == 4) {
            rwkv_finalize_naive(F, layer);
        } else if (kind == 5 || kind == 7) {
            unsigned char* const ws = kws(); float* const xo = kout();
            pg8::Gemm g{kind == 5 ? MIXB : HID, (const bf16*)(ws + (kind == 5 ? WS_WOUT : WS_WDN)), M, D, kind == 5 ? D : FF}; pg8::StaticOrder S; S.init(M, D, F.G, (int)blockIdx.x);
            pg8::EpiRes E{xo, XB, kind == 5 ? SS2 : SS1};
            pg8::gemm_phase<pg8::EpiRes, pg8::StaticOrder, false, true>(F.lds + RING_OFF, g, S, E, F.wv, lane_id());
        } else {
            unsigned char* const ws = kws();
            pg8::Gemm g{XB, (const bf16*)(ws + WS_WUP), M, FF, D}; pg8::StaticOrder S; S.init(M, FF, F.G, (int)blockIdx.x);
            pg8::EpiUp E{HID, SS2};
            pg8::gemm_phase<pg8::EpiUp, pg8::StaticOrder, true, true>(F.lds + RING_OFF, g, S, E, F.wv, lane_id());
        }
        if (step + 1 < 8 * DEPTH) GRID_BAR();
    }
}

extern "C" void kernel_launch(void* const* d_in, const int* in_sizes, int n_in, void* d_out, int out_size, void* d_ws, size_t ws_size, hipStream_t stream) {
    static int grid = 0;
    if (grid == 0) {
        if (n_in != N_IN || in_sizes[0] != M * D || out_size != M * D || ws_size < WS_END) { fprintf(stderr, "kernel_launch: unexpected shapes (n_in %d, in0 %d, out %d, ws %zu)\n", n_in, n_in > 0 ? in_sizes[0] : -1, out_size, ws_size); grid = -1; return; }
        int dev = 0, cus = 0;
        if (hipGetDevice(&dev) != hipSuccess || hipDeviceGetAttribute(&cus, hipDeviceAttributeMultiprocessorCount, dev) != hipSuccess) { grid = -1; return; }
        if (hipFuncSetAttribute((const void*)mk_fwd, hipFuncAttributeMaxDynamicSharedMemorySize, LDS_BYTES) != hipSuccess) { fprintf(stderr, "kernel_launch: hipFuncSetAttribute failed\n"); grid = -1; return; }
        int per_cu = 0;
        (void)hipOccupancyMaxActiveBlocksPerMultiprocessor(&per_cu, (const void*)mk_fwd, NTHR, LDS_BYTES);
        (void)hipGetLastError();
        grid = cus;
    }
    if (grid < 0) return;
    (void)hipMemsetAsync((char*)d_ws + WS_CTL, 0, CTL_ZERO_BYTES, stream);
    Args a{};
    for (int i = 0; i < N_IN; ++i) a.in[i] = (const float*)d_in[i];
    a.out = (float*)d_out; a.ws = (unsigned char*)d_ws;
    hipLaunchKernelGGL(mk_fwd, dim3(grid), dim3(NTHR), LDS_BYTES, stream, a);
}
```

```cpp
#include <hip/hip_runtime.h>
#include <cstdio>
#include <cstdint>
namespace pg8 {
#define PG8_LAS __attribute__((address_space(3)))
typedef unsigned short bf16_t;
typedef short bf16x8 __attribute__((ext_vector_type(8)));
typedef float f32x4 __attribute__((ext_vector_type(4)));
typedef unsigned u32x4 __attribute__((ext_vector_type(4)));
constexpr int BM = 256, BK = 64, HALF = 128, HTB = HALF * BK * 2  , STAGE_BYTES = 8 * HTB, NXCD = 8, WGM = 8;

__host__ __device__ __forceinline__ int lds_byte(int r, int c) { const int st = (r >> 4) * 2 + (c >> 5), rr = r & 15, cc = c & 31, ob = rr * 64 + cc * 2; return st * 1024 + (ob ^ (((ob >> 9) & 1) << 5)); }
__host__ __device__ __forceinline__ void stage_rc(int b, int& R, int& C) { const int st = b / 1024, sb = b % 1024, swz = sb ^ (((sb >> 9) & 1) << 5); R = (st >> 1) * 16 + swz / 64; C = (st & 1) * 32 + (swz % 64) / 2; }
__host__ __device__ __forceinline__ int perm32(int rho) { const int n = rho >> 4, i = rho & 15; return 8 * (i >> 2) + 4 * n + (i & 3); }

struct Unit { int pm, pn; };
struct Gemm { const bf16_t* A; const bf16_t* Bt; int M, N, K; };

struct StaticOrder {
    int nM, nN, nwg, G, c;
    __host__ __device__ void init(int M, int N, int G_, int c_) { nM = M / BM; nN = N / BM; nwg = nM * nN; G = G_; c = c_; }
    __host__ __device__ bool next(int i, Unit& u) const {
        const long L = (long)i * G + c; if (L >= nwg) return false;
        int wgid = (int)L; { const int q = nwg / NXCD, r = nwg % NXCD, xcd = wgid % NXCD, off = wgid / NXCD; wgid = (xcd < r ? xcd * (q + 1) : r * (q + 1) + (xcd - r) * q) + off; }
        const int nig = WGM * nN, gid = wgid / nig, fm = gid * WGM, gsz = (nM - fm) < WGM ? (nM - fm) : WGM;
        u.pm = fm + ((wgid % nig) % gsz); u.pn = (wgid % nig) / gsz; return true;
    }
    __device__ __forceinline__ void a_ready(const Unit&) const {}
    __device__ __forceinline__ void done(const Unit&) const {}
};

__device__ __forceinline__ unsigned cvt_pk_bf16(float lo, float hi) { unsigned r; asm volatile("v_cvt_pk_bf16_f32 %0, %1, %2" : "=v"(r) : "v"(lo), "v"(hi)); return r; }
typedef unsigned u32x2 __attribute__((ext_vector_type(2)));

__device__ __forceinline__ float shx(float v, int m, int lane) { return __int_as_float(__builtin_amdgcn_ds_bpermute((lane ^ m) << 2, __float_as_int(v))); }
__device__ __forceinline__ float row_rs(const float* ss, int row, int fq, int lane) {
    const f32x4 p = *(const f32x4*)(ss + (size_t)row * 16 + 4 * fq);
    float s = (p[0] + p[1]) + (p[2] + p[3]);
    s += shx(s, 16, lane); s += shx(s, 32, lane);
    return 1.0f / sqrtf(s * (1.0f / 1024.0f) + 1e-6f);
}

struct EpiProj {
    static constexpr bool PERM = true, AFTER_DRAIN = false;
    bf16_t* base0; const float* ss; const float* qg; const float* kg;
    __device__ __forceinline__ void operator()(const f32x4 (&acc)[2][2][4][2], const Unit& u, int wr, int wc, int fr, int fq) const {
        const int tile = u.pn, di = tile >> 1;
        bf16_t* base = base0 + (di < 2 ? (size_t)di * 512 : (size_t)di * (8u << 20)); const int ldc = (di < 2) ? 1024 : ((di == 6) ? 256 : 512); const int cb = (di == 6) ? 0 : (tile & 1) * 256;
        const bool nrm = tile < 4; const float* gsrc = (tile < 2) ? qg : kg; const float post = (tile < 2) ? 0.125f : 1.0f;
        f32x4 g[2][2];
#pragma unroll
        for (int bj = 0; bj < 2; ++bj)
#pragma unroll
            for (int n = 0; n < 2; ++n) g[bj][n] = nrm ? *(const f32x4*)(gsrc + 32 * bj + 8 * fq + 4 * n) * post : (f32x4){1.f, 1.f, 1.f, 1.f};
#pragma unroll
        for (int ai = 0; ai < 2; ++ai)
#pragma unroll
            for (int m = 0; m < 4; ++m) {
                const int row = u.pm * BM + ai * HALF + wr * 64 + m * 16 + fr;
                const float rs = row_rs(ss, row, fq, 16 * fq + fr);
                f32x4 v[2][2]; float q = 0.f;
#pragma unroll
                for (int bj = 0; bj < 2; ++bj)
#pragma unroll
                    for (int n = 0; n < 2; ++n) { v[bj][n] = acc[ai][bj][m][n] * rs; const f32x4 t = v[bj][n]; q += (t[0] * t[0] + t[1] * t[1]) + (t[2] * t[2] + t[3] * t[3]); }
                q += shx(q, 16, 16 * fq + fr); q += shx(q, 32, 16 * fq + fr);
                const float inv = nrm ? 1.0f / sqrtf(q * (1.0f / 64.0f) + 1e-6f) : 1.0f;
                bf16_t* rowp = base + (size_t)row * ldc + cb + 64 * wc + 8 * fq;
#pragma unroll
                for (int bj = 0; bj < 2; ++bj) { const f32x4 v0 = v[bj][0] * inv * g[bj][0], v1 = v[bj][1] * inv * g[bj][1];
                    u32x4 w; w.x = cvt_pk_bf16(v0[0], v0[1]); w.y = cvt_pk_bf16(v0[2], v0[3]); w.z = cvt_pk_bf16(v1[0], v1[1]); w.w = cvt_pk_bf16(v1[2], v1[3]);
                    *(u32x4*)(rowp + 32 * bj) = w; }
                asm volatile("" ::: "memory");
            }
    }
};
struct EpiUp {
    static constexpr bool PERM = true, AFTER_DRAIN = false;
    bf16_t* O; const float* ss;
    __device__ __forceinline__ void operator()(const f32x4 (&acc)[2][2][4][2], const Unit& u, int wr, int wc, int fr, int fq) const {
#pragma unroll
        for (int ai = 0; ai < 2; ++ai)
#pragma unroll
            for (int m = 0; m < 4; ++m) {
                const int row = u.pm * BM + ai * HALF + wr * 64 + m * 16 + fr;
                const float rs = row_rs(ss, row, fq, 16 * fq + fr);
                bf16_t* rowp = O + (size_t)row * 4096 + u.pn * BM + wc * 32 + 8 * fq;
#pragma unroll
                for (int bj = 0; bj < 2; ++bj) { f32x4 v0 = acc[ai][bj][m][0] * rs, v1 = acc[ai][bj][m][1] * rs;
                    v0 = __builtin_elementwise_max(v0, (f32x4){0.f, 0.f, 0.f, 0.f}); v1 = __builtin_elementwise_max(v1, (f32x4){0.f, 0.f, 0.f, 0.f}); v0 = v0 * v0; v1 = v1 * v1;
                    u32x4 w; w.x = cvt_pk_bf16(v0[0], v0[1]); w.y = cvt_pk_bf16(v0[2], v0[3]); w.z = cvt_pk_bf16(v1[0], v1[1]); w.w = cvt_pk_bf16(v1[2], v1[3]);
                    *(u32x4*)(rowp + bj * HALF) = w; }
                asm volatile("" ::: "memory");
            }
    }
};
struct EpiRes {
    static constexpr bool PERM = false, AFTER_DRAIN = false;
    float* x; bf16_t* xb; float* ss;
    __device__ __forceinline__ void operator()(const f32x4 (&acc)[2][2][4][2], const Unit& u, int wr, int wc, int fr, int fq) const {
        const int col0 = u.pn * BM + wc * 32 + 4 * fq;
#pragma unroll
        for (int ai = 0; ai < 2; ++ai)
#pragma unroll
            for (int m = 0; m < 4; ++m) {
                const int row = u.pm * BM + ai * HALF + wr * 64 + m * 16 + fr; const size_t off = (size_t)row * 1024 + col0; float q = 0.f;
#pragma unroll
                for (int bj = 0; bj < 2; ++bj)
#pragma unroll
                    for (int n = 0; n < 2; ++n) { const size_t o = off + bj * HALF + n * 16; const f32x4 t = *(const f32x4*)(x + o) + acc[ai][bj][m][n];
                        *(f32x4*)(x + o) = t; u32x2 w; w.x = cvt_pk_bf16(t[0], t[1]); w.y = cvt_pk_bf16(t[2], t[3]); *(u32x2*)(xb + o) = w;
                        q += (t[0] * t[0] + t[1] * t[1]) + (t[2] * t[2] + t[3] * t[3]); }
                q += shx(q, 16, 16 * fq + fr); q += shx(q, 32, 16 * fq + fr);
                if (fq == 0) ss[(size_t)row * 16 + 4 * u.pn + wc] = q;
                asm volatile("" ::: "memory");
            }
    }
};

template <class Epi, class Sched, bool ALIGN_EPI = false, bool SP2 = false>
__device__ __forceinline__ void gemm_phase(PG8_LAS unsigned char* lds, const Gemm g, const Sched& S, const Epi& E, int wave_in, int lane_in) {
    int lane_o = lane_in, wave_o = wave_in; asm volatile("" : "+v"(lane_o)); asm volatile("" : "+s"(wave_o)); const int tid_ = wave_o * 64 + lane_o;
    const int tid = tid_, wid = wave_o, lane = lane_o, wr = wid >> 2, wc = wid & 3, fr = lane & 15, fq = lane >> 4;
    const int K = g.K, nt = K / BK;
    unsigned voffA[2], voffB[2];
#pragma unroll
    for (int i = 0; i < 2; ++i) { int R, C; stage_rc(tid * 16 + i * 8192, R, C); const int Rb = Epi::PERM ? ((R & ~31) + perm32(R & 31)) : R;
        voffA[i] = (unsigned)(R * K + C) * 2u; voffB[i] = (unsigned)(Rb * K + C) * 2u; }
    const size_t kstep = (size_t)(BK * 2);
    const size_t hstep = (size_t)HALF * K * 2;
    const size_t tstep = 2 * hstep;
    const unsigned ldsw = (unsigned)wid * 1024u;
    const int aoff = lds_byte(wr * 64 + fr, fq * 8), boff = lds_byte(wc * 32 + fr, fq * 8);
#define PG8_SA(b, h) (((b) * 2 + (h)) * HTB)
#define PG8_SB(b, h) ((4 + (b) * 2 + (h)) * HTB)
#define PG8_STAGE(bufoff, gbase, voff) do { _Pragma("unroll") for (int _i = 0; _i < 2; ++_i) \
        __builtin_amdgcn_global_load_lds((const unsigned*)((const char*)(gbase) + (voff)[_i]), (PG8_LAS unsigned*)(lds + (bufoff) + ldsw + _i * 8192), 16, 0, 0); } while (0)
#define PG8_LDA(dst, b, h) do { _Pragma("unroll") for (int m = 0; m < 4; ++m) _Pragma("unroll") for (int k = 0; k < 2; ++k) dst[m][k] = *(const PG8_LAS bf16x8*)(lds + PG8_SA(b, h) + aoff + m * 2048 + k * 1024); } while (0)
#define PG8_LDB(dst, b, h) do { _Pragma("unroll") for (int n = 0; n < 2; ++n) _Pragma("unroll") for (int k = 0; k < 2; ++k) dst[n][k] = *(const PG8_LAS bf16x8*)(lds + PG8_SB(b, h) + boff + n * 2048 + k * 1024); } while (0)
#define PG8_MMA(ai, bj, At, Bt) do { __builtin_amdgcn_s_setprio(1); _Pragma("unroll") for (int m = 0; m < 4; ++m) _Pragma("unroll") for (int n = 0; n < 2; ++n) _Pragma("unroll") for (int k = 0; k < 2; ++k) \
        acc[ai][bj][m][n] = __builtin_amdgcn_mfma_f32_16x16x32_bf16(Bt[n][k], At[m][k], acc[ai][bj][m][n], 0, 0, 0); __builtin_amdgcn_s_setprio(0); } while (0)
#define PG8_WAIT_V(n) asm volatile("s_waitcnt vmcnt(" #n ")" ::: "memory")
#define PG8_WAIT_L(n) asm volatile("s_waitcnt lgkmcnt(" #n ")" ::: "memory")
#define PG8_BAR __builtin_amdgcn_s_barrier()
#define PG8_SCHED __builtin_amdgcn_sched_barrier(0)
    Unit cur, nxt; int ui = 0;
    if (!S.next(0, cur)) return;
    f32x4 acc[2][2][4][2];
#pragma unroll
    for (int a = 0; a < 2; ++a)
#pragma unroll
        for (int b = 0; b < 2; ++b)
#pragma unroll
            for (int m = 0; m < 4; ++m)
#pragma unroll
                for (int n = 0; n < 2; ++n) acc[a][b][m][n] = (f32x4){0.f, 0.f, 0.f, 0.f};
    bf16x8 At[4][2], B0[2][2], B1[2][2];
    const char* cA = (const char*)g.A + (size_t)cur.pm * tstep; const char* cB = (const char*)g.Bt + (size_t)cur.pn * tstep;
    S.a_ready(cur);
    if constexpr (SP2) {
        PG8_STAGE(PG8_SB(0, 0), cB, voffB); PG8_STAGE(PG8_SB(0, 1), cB + hstep, voffB); PG8_STAGE(PG8_SA(0, 0), cA, voffA); PG8_STAGE(PG8_SA(0, 1), cA + hstep, voffA);
        if (wr == 1) PG8_BAR;
        PG8_WAIT_V(2); PG8_BAR;
        PG8_STAGE(PG8_SB(1, 0), cB + kstep, voffB); PG8_STAGE(PG8_SA(1, 0), cA + kstep, voffA); PG8_STAGE(PG8_SB(1, 1), cB + hstep + kstep, voffB);
        PG8_WAIT_V(6); PG8_BAR;
    } else {
        PG8_STAGE(PG8_SB(0, 0), cB, voffB); PG8_STAGE(PG8_SA(0, 0), cA, voffA); PG8_STAGE(PG8_SB(0, 1), cB + hstep, voffB); PG8_STAGE(PG8_SA(0, 1), cA + hstep, voffA);
        if (wr == 1) PG8_BAR;
        PG8_WAIT_V(4); PG8_BAR;
        PG8_STAGE(PG8_SB(1, 0), cB + kstep, voffB); PG8_STAGE(PG8_SA(1, 0), cA + kstep, voffA); PG8_STAGE(PG8_SB(1, 1), cB + hstep + kstep, voffB);
        PG8_WAIT_V(6); PG8_BAR;
    }
    for (;;) {
        const bool has_next = S.next(ui + 1, nxt);
        const char* nA = has_next ? (const char*)g.A + (size_t)nxt.pm * tstep : cA; const char* nB = has_next ? (const char*)g.Bt + (size_t)nxt.pn * tstep : cB;
        for (int t = 0; t < nt; t += 2) {
            const bool last = (t == nt - 2);
            const char* a1 = cA + (size_t)(t + 1) * kstep;
            const char* a2 = last ? nA : cA + (size_t)(t + 2) * kstep; const char* b2 = last ? nB : cB + (size_t)(t + 2) * kstep;
            const char* a3 = a2 + kstep; const char* b3 = b2 + kstep;
            if (last && has_next) S.a_ready(nxt);
            if constexpr (SP2) {
            PG8_LDB(B0, 0, 0); PG8_LDB(B1, 0, 1); PG8_SCHED; PG8_LDA(At, 0, 0); PG8_STAGE(PG8_SA(1, 1), a1 + hstep, voffA);
            PG8_WAIT_V(8); PG8_WAIT_L(0); PG8_BAR; PG8_MMA(0, 0, At, B0); PG8_MMA(0, 1, At, B1); PG8_BAR; PG8_SCHED;
            PG8_LDA(At, 0, 1); PG8_STAGE(PG8_SB(0, 0), b2, voffB); PG8_STAGE(PG8_SB(0, 1), b2 + hstep, voffB); PG8_STAGE(PG8_SA(0, 0), a2, voffA);
            PG8_WAIT_V(8); PG8_WAIT_L(0); PG8_BAR; PG8_MMA(1, 0, At, B0); PG8_MMA(1, 1, At, B1); PG8_BAR; PG8_SCHED;
            PG8_LDB(B0, 1, 0); PG8_LDB(B1, 1, 1); PG8_SCHED; PG8_LDA(At, 1, 0); PG8_STAGE(PG8_SA(0, 1), a2 + hstep, voffA);
            PG8_WAIT_V(8); PG8_WAIT_L(0); PG8_BAR; PG8_MMA(0, 0, At, B0); PG8_MMA(0, 1, At, B1); PG8_BAR; PG8_SCHED;
            PG8_LDA(At, 1, 1); PG8_STAGE(PG8_SB(1, 0), b3, voffB); PG8_STAGE(PG8_SB(1, 1), b3 + hstep, voffB); PG8_STAGE(PG8_SA(1, 0), a3, voffA);
            PG8_WAIT_V(8); PG8_WAIT_L(0); PG8_BAR; PG8_MMA(1, 0, At, B0); PG8_MMA(1, 1, At, B1); PG8_BAR; PG8_SCHED;
            } else {
            PG8_LDB(B0, 0, 0); PG8_SCHED; PG8_LDA(At, 0, 0); PG8_STAGE(PG8_SA(1, 1), a1 + hstep, voffA);
            PG8_WAIT_L(8); PG8_BAR; PG8_WAIT_L(0); PG8_MMA(0, 0, At, B0); PG8_BAR; PG8_SCHED;
            PG8_LDB(B1, 0, 1); PG8_STAGE(PG8_SB(0, 0), b2, voffB);
            PG8_BAR; PG8_WAIT_L(0); PG8_MMA(0, 1, At, B1); PG8_BAR;
            PG8_LDA(At, 0, 1); PG8_STAGE(PG8_SA(0, 0), a2, voffA);
            PG8_BAR; PG8_WAIT_L(0); PG8_MMA(1, 0, At, B0); PG8_BAR; PG8_SCHED;
            PG8_STAGE(PG8_SB(0, 1), b2 + hstep, voffB);
            PG8_WAIT_V(6); PG8_BAR; PG8_MMA(1, 1, At, B1); PG8_BAR;
            PG8_LDB(B0, 1, 0); PG8_SCHED; PG8_LDA(At, 1, 0); PG8_STAGE(PG8_SA(0, 1), a2 + hstep, voffA);
            PG8_WAIT_L(8); PG8_BAR; PG8_WAIT_L(0); PG8_MMA(0, 0, At, B0); PG8_BAR; PG8_SCHED;
            PG8_LDB(B1, 1, 1); PG8_STAGE(PG8_SB(1, 0), b3, voffB);
            PG8_BAR; PG8_WAIT_L(0); PG8_MMA(0, 1, At, B1); PG8_BAR;
            PG8_LDA(At, 1, 1); PG8_STAGE(PG8_SA(1, 0), a3, voffA);
            PG8_BAR; PG8_WAIT_L(0); PG8_MMA(1, 0, At, B0); PG8_BAR; PG8_SCHED;
            PG8_STAGE(PG8_SB(1, 1), b3 + hstep, voffB);
            PG8_WAIT_V(6); PG8_BAR; PG8_MMA(1, 1, At, B1); PG8_BAR;
            }
        }
        if constexpr (ALIGN_EPI) { if (wr == 0) PG8_BAR; }
        if constexpr (!Epi::AFTER_DRAIN) { E(acc, cur, wr, wc, fr, fq); S.done(cur); }
        if (!has_next) break;
#pragma unroll
        for (int a = 0; a < 2; ++a)
#pragma unroll
            for (int b = 0; b < 2; ++b)
#pragma unroll
                for (int m = 0; m < 4; ++m)
#pragma unroll
                    for (int n = 0; n < 2; ++n) acc[a][b][m][n] = (f32x4){0.f, 0.f, 0.f, 0.f};
        cur = nxt; cA = nA; cB = nB; ++ui;
        if constexpr (ALIGN_EPI) { if (wr == 1) PG8_BAR; }
    }
    PG8_WAIT_V(0);
    if constexpr (!ALIGN_EPI) { if (wr == 0) PG8_BAR; }
    PG8_BAR;
    if constexpr (Epi::AFTER_DRAIN) { E.fused(acc, cur, wr, wc, fr, fq, lds, wid, lane); S.done(cur); }
#undef PG8_SA
#undef PG8_SB
#undef PG8_STAGE
#undef PG8_LDA
#undef PG8_LDB
#undef PG8_MMA
#undef PG8_WAIT_V
#undef PG8_WAIT_L
#undef PG8_BAR
#undef PG8_SCHED
}
}
constexpr int NWAVES = 8, NTHR = 512;
constexpr int BATCH = 4, SEQ = 4096, D = 1024, DEPTH = 4, H = 8, HD = 64, FF = 4096, NPROJ = 3328, RPROJ = 1792;
constexpr int M = BATCH * SEQ;
constexpr float GN_EPS = 64e-5f;
enum { I_X = 0, I_LN1, I_WIN, I_QG, I_KG, I_TSP, I_TSN, I_W0, I_W2, I_A0, I_A2, I_G2, I_KK, I_KA, I_RK, I_GNW, I_GNB, I_WOUT, I_LN2, I_WUP, I_WDN, N_IN };
constexpr size_t MiB = 1u << 20;
constexpr size_t WS_CTL = 0, CTL_ZERO_BYTES = 64 * 1024;
constexpr size_t WS_SS1 = 1 * MiB, WS_SS2 = 2 * MiB;
constexpr size_t WS_WIN = 3 * MiB, WS_WOUT = WS_WIN + (size_t)NPROJ * D * 2, WS_WUP = WS_WOUT + (size_t)D * D * 2, WS_WDN = WS_WUP + (size_t)FF * D * 2;
constexpr size_t WS_R0 = 28 * MiB;
constexpr size_t R_MIX = WS_R0 + 0 * MiB;
constexpr size_t R_V = WS_R0 + 32 * MiB;
constexpr size_t R_RR = WS_R0 + 48 * MiB, R_KR = WS_R0 + 64 * MiB, R_VR = WS_R0 + 80 * MiB, R_XL = WS_R0 + 96 * MiB;
constexpr size_t R_Y0 = R_RR, R_Y1 = R_KR;
constexpr size_t R_PRE = WS_R0 + 104 * MiB;
constexpr size_t R_HID = WS_R0;
constexpr size_t R_XB = WS_R0 + 128 * MiB;
constexpr size_t R_BN = WS_R0 + 232 * MiB;
constexpr size_t WS_END = WS_R0 + 233 * MiB;
constexpr size_t WS_LORA = WS_WDN + (size_t)D * FF * 2;
static_assert(WS_LORA + 4 * 512 * 64 * 2 <= WS_R0, "lora");
constexpr int CW_BAR = 1024;
constexpr int RING_OFF = 0, RING_BYTES = 131072;
constexpr int LDSCTL_OFF = 155648, MISC_OFF = LDSCTL_OFF + 320;
constexpr int LDS_BYTES = 163840;
#define GAS __attribute__((address_space(1)))
#define LAS __attribute__((address_space(3)))
typedef unsigned short bf16;
typedef unsigned v4u __attribute__((ext_vector_type(4)));
typedef float f32x4 __attribute__((ext_vector_type(4)));
typedef short bf16x8 __attribute__((ext_vector_type(8)));
typedef GAS unsigned gu32;
typedef GAS unsigned long long gu64;
#define RLX_AGENT __ATOMIC_RELAXED, __HIP_MEMORY_SCOPE_AGENT
#define LDS_WAIT() asm volatile("s_waitcnt lgkmcnt(0)" ::: "memory")
#define VM_WAIT() asm volatile("s_waitcnt vmcnt(0)" ::: "memory")
__device__ __forceinline__ unsigned long long rt() { return __builtin_amdgcn_s_memrealtime(); }
__device__ __forceinline__ unsigned f2bf(float f) { unsigned u = __builtin_bit_cast(unsigned, f); return (u + 0x7fffu + ((u >> 16) & 1u)) >> 16; }
__device__ __forceinline__ unsigned pk2(float lo, float hi) { return f2bf(lo) | (f2bf(hi) << 16); }

#define XB_TMO      128
#define XB_XCNT(j)  (256  + 64 * (j))
#define XB_XSUB(j)  (1280 + 64 * (j))
#define XB_XGEN(j)  (2304 + 64 * (j))
#define XB_TOP      3328
#define XB_TOPGEN   3392
#define XCD_BAR_WORDS 3456
#define XB_SPIN_CAP (1u << 18)

__device__ __forceinline__ unsigned xb_ld(unsigned* p)              { return __hip_atomic_load(p, __ATOMIC_RELAXED, __HIP_MEMORY_SCOPE_AGENT); }
__device__ __forceinline__ unsigned xb_add(unsigned* p, unsigned v) { return __hip_atomic_fetch_add(p, v, __ATOMIC_RELAXED, __HIP_MEMORY_SCOPE_AGENT); }
__device__ __forceinline__ unsigned xb_xcc_id() { return (unsigned)__builtin_amdgcn_s_getreg((3 << 11) | 20) & 0xFu; }
#define XB_SPIN(cond, bar) do { unsigned _sp = 0; while (cond) { __builtin_amdgcn_s_sleep(1); \
    if ((++_sp & 255u) == 0u) { if (xb_ld(&(bar)[XB_TMO])) break; if (_sp > XB_SPIN_CAP) { atomicAdd(&(bar)[XB_TMO], 1u); break; } } } } while (0)

struct XcdBarrier {
    unsigned* bar; unsigned x;
    volatile LAS unsigned* st;
};

__device__ __forceinline__ XcdBarrier xcd_barrier_post(unsigned* bar, volatile LAS unsigned* st, bool tid0) {
    XcdBarrier b; b.bar = bar; b.x = xb_xcc_id(); b.st = st;
    if (tid0) (void)xb_add(&bar[XB_XCNT(b.x)], 1u);
    return b;
}
__device__ __forceinline__ void xcd_barrier_complete(unsigned* bar, unsigned x, unsigned& nloc, unsigned& nx) {
    const unsigned G = gridDim.x * gridDim.y * gridDim.z;
    unsigned sum, cnt, mine, sp = 0u;
    for (;;) {
        sum = 0u; cnt = 0u; mine = 0u;
#pragma unroll
        for (unsigned j = 0; j < 16; ++j) { const unsigned c = xb_ld(&bar[XB_XCNT(j)]); sum += c; cnt += (c > 0u) ? 1u : 0u; mine = (j == x) ? c : mine; }
        if (sum == G) break;
        __builtin_amdgcn_s_sleep(1);
        if ((++sp & 255u) == 0u) { if (xb_ld(&bar[XB_TMO])) break; if (sp > XB_SPIN_CAP) { atomicAdd(&bar[XB_TMO], 1u); break; } }
    }
    nloc = mine > 0u ? mine : 1u; nx = cnt > 0u ? cnt : 1u;
}

__device__ __forceinline__ void xcd_barrier(const XcdBarrier& b, bool tid0) {
    asm volatile("s_waitcnt vmcnt(0)" ::: "memory");
    __syncthreads();
    if (tid0) {
        unsigned* bar = b.bar; asm volatile("" : "+v"(bar));
        __builtin_amdgcn_s_waitcnt(0);
        unsigned nloc = b.st[0], nx = b.st[1];
        if (nloc == 0u) { xcd_barrier_complete(bar, b.x, nloc, nx); b.st[0] = nloc; b.st[1] = nx; }
        const unsigned old = xb_add(&bar[XB_XSUB(b.x)], 1u);
        const unsigned gen = old / nloc;
        if (old + 1u == (gen + 1u) * nloc) {
            __builtin_amdgcn_fence(__ATOMIC_RELEASE, "agent");
            asm volatile("s_waitcnt vmcnt(0)" ::: "memory");
            const unsigned og = xb_add(&bar[XB_TOP], 1u);
            const unsigned tg = og / nx;
            if (og + 1u == (tg + 1u) * nx) xb_add(&bar[XB_TOPGEN], 1u);
            else XB_SPIN(xb_ld(&bar[XB_TOPGEN]) == tg, bar);
            __builtin_amdgcn_fence(__ATOMIC_ACQUIRE, "agent");
            xb_add(&bar[XB_XGEN(b.x)], 1u);
            asm volatile("s_waitcnt vmcnt(0)" ::: "memory");
        } else {
            XB_SPIN(xb_ld(&bar[XB_XGEN(b.x)]) == gen, bar);
            __builtin_amdgcn_fence(__ATOMIC_ACQUIRE, "agent");
            asm volatile("s_waitcnt vmcnt(0)" ::: "memory");
        }
    }
    __syncthreads();
}
__device__ __forceinline__ float bf2f(bf16 v) { return __uint_as_float(((unsigned)v) << 16); }
__device__ __forceinline__ bf16 f2bf_s(float f) { return (bf16)f2bf(f); }
__device__ __forceinline__ float wave_sum(float v, int lane) {
#pragma unroll
    for (int o = 1; o < 64; o <<= 1) v += pg8::shx(v, o, lane);
    return v;
}
__device__ __forceinline__ float sigmoidf_(float z) { return 1.0f / (1.0f + __expf(-z)); }
__device__ __forceinline__ float tanh_fast(float x) { return 1.0f - 2.0f / (__expf(2.0f * x) + 1.0f); }

struct Args { const float* in[N_IN]; float* out; unsigned char* ws; };
typedef const __attribute__((address_space(4))) Args CArgs;
__device__ __forceinline__ const CArgs* kargs() { const CArgs* p = (const CArgs*)__builtin_amdgcn_kernarg_segment_ptr(); asm volatile("" : "+s"(p)); return p; }
__device__ __forceinline__ unsigned char* kws() { return kargs()->ws; }
__device__ __forceinline__ float* kout() { return kargs()->out; }
__device__ __forceinline__ const float* karg(int i) { return kargs()->in[i]; }
__device__ __forceinline__ int lane_id() { int l; asm volatile("v_mbcnt_lo_u32_b32 %0, -1, 0\n\tv_mbcnt_hi_u32_b32 %0, -1, %0" : "=v"(l)); return l; }
struct Frame {
    LAS unsigned char* lds;
    volatile LAS unsigned* MISC;
    gu32* ctl;
    int vcu, G, wv;
};

__device__ __forceinline__ float ushift(const bf16* buf, int ldc, int col, int row, int t, float sp, float sn) {
    const bf16* p = buf + (size_t)row * ldc + col;
    const float u0 = bf2f(p[0]);
    const float up = (t > 0) ? bf2f(p[-ldc]) : 0.f;
    const float un = (t < SEQ - 1) ? bf2f(p[ldc]) : 0.f;
    return u0 + sp * (up - u0) + sn * (un - u0);
}

__device__ __forceinline__ void transpose_item(const float* W, int K, int N, bf16* WT, const float* gain, bool headperm, LAS float* scr, int item, int lane) {
    const int nblk = N / 32, kb = item / nblk, nb = item % nblk, k0 = 64 * kb, n0 = 32 * nb;
#pragma unroll 8
    for (int i = 0; i < 32; ++i) { const int kk = 2 * i + (lane >> 5); float w = W[(size_t)(k0 + kk) * N + n0 + (lane & 31)]; if (gain) w *= gain[k0 + kk]; scr[kk * 33 + (lane & 31)] = w; }
    LDS_WAIT(); asm volatile("" ::: "memory");
    const int c = lane & 7;
    const int p0 = headperm ? ((n0 & ~255) + 128 * ((n0 >> 5) & 1) + 32 * ((n0 >> 6) & 3)) : n0;
#pragma unroll
    for (int j = 0; j < 4; ++j) { const int n = (lane >> 3) + 8 * j; const LAS float* s = scr + (8 * c) * 33 + n;
        v4u o; o.x = pk2(s[0 * 33], s[1 * 33]); o.y = pk2(s[2 * 33], s[3 * 33]); o.z = pk2(s[4 * 33], s[5 * 33]); o.w = pk2(s[6 * 33], s[7 * 33]);
        *(GAS v4u*)(WT + (size_t)(p0 + n) * K + k0 + 8 * c) = o; }
    LDS_WAIT(); asm volatile("" ::: "memory");
}
__device__ __forceinline__ void wconv_phase(Frame& F, int layer) {
    unsigned char* const ws = kws();
    int lane_ = lane_id(); asm volatile("" : "+v"(lane_)); int wave_o = F.wv; asm volatile("" : "+s"(wave_o)); const int wave_ = wave_o, tid_ = wave_ * 64 + lane_;
    LAS float* scr = (LAS float*)(F.lds + RING_OFF + wave_ * 16384);
    const int gw = F.vcu * NWAVES + wave_, NGW = F.G * NWAVES;
    constexpr int I_1 = (D / 64) * (NPROJ / 32), I_2 = (D / 64) * (D / 32), I_3 = (D / 64) * (FF / 32), I_4 = (FF / 64) * (D / 32);
    const float* win = karg(I_WIN) + (size_t)layer * D * NPROJ; const float* wout = karg(I_WOUT) + (size_t)layer * D * D;
    const float* wup = karg(I_WUP) + (size_t)layer * D * FF; const float* wdn = karg(I_WDN) + (size_t)layer * FF * D;
    const float* g1 = karg(I_LN1) + layer * D; const float* g2 = karg(I_LN2) + layer * D;
    for (int it = gw; it < I_1 + I_2 + I_3 + I_4 + 64; it += NGW) {
        int r = it;
        if (r < I_1) { transpose_item(win, D, NPROJ, (bf16*)(ws + WS_WIN), g1, true, scr, r, lane_); continue; } r -= I_1;
        if (r < I_2) { transpose_item(wout, D, D, (bf16*)(ws + WS_WOUT), nullptr, false, scr, r, lane_); continue; } r -= I_2;
        if (r < I_3) { transpose_item(wup, D, FF, (bf16*)(ws + WS_WUP), g2, false, scr, r, lane_); continue; } r -= I_3;
        if (r < I_4) { transpose_item(wdn, FF, D, (bf16*)(ws + WS_WDN), nullptr, false, scr, r, lane_); continue; } r -= I_4;
        { const int mat = r >> 4, it16 = r & 15;
          const float* src = (mat < 2 ? karg(I_W2) : karg(I_A2)) + (size_t)(layer * 2 + (mat & 1)) * 64 * 512;
          transpose_item(src, 64, 512, (bf16*)(ws + WS_LORA) + (size_t)mat * 512 * 64, nullptr, false, scr, it16, lane_); }
    }
}
__device__ __forceinline__ void x_prologue(Frame& F) {
    unsigned char* const ws = kws();
    int lane_ = lane_id(); asm volatile("" : "+v"(lane_)); int wave_o = F.wv; asm volatile("" : "+s"(wave_o)); const int wave_ = wave_o, tid_ = wave_ * 64 + lane_;
    const int gw = F.vcu * NWAVES + wave_, NGW = F.G * NWAVES;
    const float* x = karg(I_X); bf16* xb = (bf16*)(ws + R_XB); float* ss = (float*)(ws + WS_SS1);
    for (int m = gw; m < M; m += NGW) {
        const GAS f32x4* xr = (const GAS f32x4*)(x + (size_t)m * D) + lane_; GAS f32x4* orow = (GAS f32x4*)(kout() + (size_t)m * D) + lane_;
        GAS unsigned long long* o8 = (GAS unsigned long long*)(xb + (size_t)m * D) + lane_;
        float s = 0.f;
#pragma unroll
        for (int j = 0; j < 4; ++j) { const f32x4 v = xr[64 * j]; orow[64 * j] = v; s += (v.x * v.x + v.y * v.y) + (v.z * v.z + v.w * v.w);
            o8[64 * j] = (unsigned long long)pk2(v.x, v.y) | ((unsigned long long)pk2(v.z, v.w) << 32); }
        s = wave_sum(s, lane_);
        if (lane_ < 16) ss[(size_t)m * 16 + lane_] = (lane_ == 0) ? s : 0.f;
    }
}

__device__ __forceinline__ void attn_naive(Frame& F, int layer, int aw, int naw) {
    unsigned char* const ws = kws();
    int lane_ = lane_id(); asm volatile("" : "+v"(lane_)); int wave_o = F.wv; asm volatile("" : "+s"(wave_o)); const int wave_ = wave_o, tid_ = wave_ * 64 + lane_;
    bf16* MIX = (bf16*)(ws + R_MIX); const bf16* Q = MIX; const bf16* K = MIX + 512; const bf16* V = (const bf16*)(ws + R_V);
    LAS float* qs = (LAS float*)(F.lds + RING_OFF + wave_ * 4096); LAS float* pb = qs + 64;
    float bound;
    { const float* qg = karg(I_QG) + layer * HD; const float* kg = karg(I_KG) + layer * HD; float mq = 0.f, mk = 0.f;
      for (int i = 0; i < HD; ++i) { mq = fmaxf(mq, fabsf(qg[i])); mk = fmaxf(mk, fabsf(kg[i])); }
      bound = 8.0f * mq * mk + 0.25f; }
    const int lane = lane_;
    for (int unit = aw; unit < BATCH * H * SEQ; unit += naw) {
        const int t = unit % SEQ, bh = unit / SEQ, h = bh % H, b = bh / H; const size_t row = (size_t)b * SEQ + t;
        qs[lane] = bf2f(Q[row * 1024 + h * HD + lane]);
        LDS_WAIT(); asm volatile("" ::: "memory");
        float qv[HD];
#pragma unroll
        for (int i = 0; i < HD; ++i) qv[i] = qs[i];
        const float slope = exp2f(-(float)(h + 1));
        float lsum = 0.f;
        for (int bi = 0; bi < 3; ++bi) { const int d = 1 << (2 * bi);
            for (int pass = 0; pass < 3; ++pass) { const int jj = pass * 64 + lane; const bool act = jj <= 128; const int j = jj - 64; const int pos = t + j * d; const bool valid = act && pos >= 0 && pos < SEQ;
                float p = 0.f;
                if (valid) { const v4u* kr = (const v4u*)(K + ((size_t)b * SEQ + pos) * 1024 + h * HD); float dot = 0.f;
#pragma unroll
                    for (int c = 0; c < 8; ++c) { const v4u w = kr[c];
                        dot += qv[8 * c + 0] * __uint_as_float(w.x << 16) + qv[8 * c + 1] * __uint_as_float(w.x & 0xffff0000u) + qv[8 * c + 2] * __uint_as_float(w.y << 16) + qv[8 * c + 3] * __uint_as_float(w.y & 0xffff0000u)
                             + qv[8 * c + 4] * __uint_as_float(w.z << 16) + qv[8 * c + 5] * __uint_as_float(w.z & 0xffff0000u) + qv[8 * c + 6] * __uint_as_float(w.w << 16) + qv[8 * c + 7] * __uint_as_float(w.w & 0xffff0000u); }
                    const float s = dot - slope * fabsf((float)(j * d)); p = __expf(s - bound); }
                if (act) pb[bi * 129 + jj] = p;
                lsum += p; } }
        lsum = wave_sum(lsum, lane_);
        LDS_WAIT(); asm volatile("" ::: "memory");
        float o = 0.f;
        for (int bi = 0; bi < 3; ++bi) { const int d = 1 << (2 * bi);
            for (int jj = 0; jj < 129; ++jj) { const float p = pb[bi * 129 + jj];
                if (p != 0.f) { const int pos = t + (jj - 64) * d; o += p * bf2f(V[((size_t)b * SEQ + pos) * 512 + h * HD + lane]); } } }
        MIX[row * 1024 + h * HD + lane] = f2bf_s(o / lsum);
        LDS_WAIT(); asm volatile("" ::: "memory");
    }
}

typedef float f32x16 __attribute__((ext_vector_type(16)));
typedef short s16x4 __attribute__((ext_vector_type(4)));
typedef short v4i16_t __attribute__((ext_vector_type(4)));
typedef unsigned u32x2_t __attribute__((ext_vector_type(2)));
typedef float f32x2_t __attribute__((ext_vector_type(2))); typedef __bf16 bf16x2_t __attribute__((ext_vector_type(2)));
__device__ __forceinline__ unsigned cvtpk(float lo, float hi) { f32x2_t v = {lo, hi}; bf16x2_t b = __builtin_convertvector(v, bf16x2_t); return __builtin_bit_cast(unsigned, b); }
typedef _Float16 h16x2_t __attribute__((ext_vector_type(2))); typedef _Float16 h16x8 __attribute__((ext_vector_type(8)));
__device__ __forceinline__ unsigned cvtpk_h(float lo, float hi) { f32x2_t v = {lo, hi}; h16x2_t b = __builtin_convertvector(v, h16x2_t); return __builtin_bit_cast(unsigned, b); }
__device__ __forceinline__ f32x2_t unpk_h(unsigned w) { return __builtin_convertvector(__builtin_bit_cast(h16x2_t, w), f32x2_t); }
#define MFMA32H(nf, mf, acc) __builtin_amdgcn_mfma_f32_32x32x16_f16(__builtin_bit_cast(h16x8, (nf)), __builtin_bit_cast(h16x8, (mf)), (acc), 0, 0, 0)
constexpr int TSB = 144, TILE_B = 64 * TSB;
constexpr int PRE_TW = 14 * TILE_B, PRE_XA = 15 * TILE_B, PRE_INVN = 16 * TILE_B, PRE_GC = PRE_INVN + 256, PRE_BON = PRE_GC + 512, PRE_LDS_END = PRE_BON + 1024;
static_assert(PRE_LDS_END <= LDSCTL_OFF, "PRE LDS map");
__device__ __forceinline__ bf16x8 frag_row(const LAS unsigned char* tile, int row, int ks, int hi) {
    return *(const LAS bf16x8*)(tile + row * TSB + (16 * ks + 8 * hi) * 2);
}
__device__ __forceinline__ s16x4 tr4(const LAS unsigned char* p) { return __builtin_bit_cast(s16x4, __builtin_amdgcn_ds_read_tr16_b64_v4i16((LAS v4i16_t*)p)); }
__device__ __forceinline__ bf16x8 frag_tr(const LAS unsigned char* tile, int idx0, int ks, int lane) {
    const int hi = lane >> 5, g1 = (lane >> 4) & 1, i = lane & 15;
    const LAS unsigned char* p = tile + (16 * ks + 8 * hi + (i >> 2)) * TSB + (idx0 + 16 * g1 + 4 * (i & 3)) * 2;
    const s16x4 lo = tr4(p), h4 = tr4(p + 4 * TSB);
    return (bf16x8){lo[0], lo[1], lo[2], lo[3], h4[0], h4[1], h4[2], h4[3]};
}
__device__ __forceinline__ void store_quad(LAS unsigned char* tile, int row, int n0, int hi, const f32x16& a) {
#pragma unroll
    for (int q = 0; q < 4; ++q) { u32x2_t w; w.x = cvtpk(a[4 * q], a[4 * q + 1]); w.y = cvtpk(a[4 * q + 2], a[4 * q + 3]); *(LAS u32x2_t*)(tile + row * TSB + (n0 + 8 * q + 4 * hi) * 2) = w; }
}
__device__ __forceinline__ void store_quad_h(LAS unsigned char* tile, int row, int n0, int hi, const f32x16& a) {
#pragma unroll
    for (int q = 0; q < 4; ++q) { u32x2_t w; w.x = cvtpk_h(a[4 * q], a[4 * q + 1]); w.y = cvtpk_h(a[4 * q + 2], a[4 * q + 3]); *(LAS u32x2_t*)(tile + row * TSB + (n0 + 8 * q + 4 * hi) * 2) = w; }
}
__device__ __forceinline__ f32x16 load_quad(const LAS unsigned char* tile, int row, int n0, int hi) {
    f32x16 a;
#pragma unroll
    for (int q = 0; q < 4; ++q) { const u32x2_t w = *(const LAS u32x2_t*)(tile + row * TSB + (n0 + 8 * q + 4 * hi) * 2);
        a[4 * q] = __uint_as_float(w.x << 16); a[4 * q + 1] = __uint_as_float(w.x & 0xffff0000u); a[4 * q + 2] = __uint_as_float(w.y << 16); a[4 * q + 3] = __uint_as_float(w.y & 0xffff0000u); }
    return a;
}
#define MFMA32(nf, mf, acc) __builtin_amdgcn_mfma_f32_32x32x16_bf16((nf), (mf), (acc), 0, 0, 0)
#define WG_BAR() do { asm volatile("s_waitcnt vmcnt(0) lgkmcnt(0)" ::: "memory"); __builtin_amdgcn_s_barrier(); asm volatile("" ::: "memory"); } while (0)
__device__ __forceinline__ void shift8(const bf16* buf, int ldc, int col, int row, int t, const float* sp, const float* sn, float (&out)[8]) {
    const bf16* p = buf + (size_t)row * ldc + col;
    const v4u c = *(const v4u*)p; v4u pv = (v4u){0u, 0u, 0u, 0u}, nv = (v4u){0u, 0u, 0u, 0u};
    if (t > 0) pv = *(const v4u*)(p - ldc);
    if (t < SEQ - 1) nv = *(const v4u*)(p + ldc);
    const f32x4 sp0 = *(const f32x4*)sp, sp1 = *(const f32x4*)(sp + 4), sn0 = *(const f32x4*)sn, sn1 = *(const f32x4*)(sn + 4);
#pragma unroll
    for (int j = 0; j < 8; ++j) { const unsigned cw = c[j >> 1], pw = pv[j >> 1], nw = nv[j >> 1];
        const float u0 = (j & 1) ? __uint_as_float(cw & 0xffff0000u) : __uint_as_float(cw << 16), up = (j & 1) ? __uint_as_float(pw & 0xffff0000u) : __uint_as_float(pw << 16), un = (j & 1) ? __uint_as_float(nw & 0xffff0000u) : __uint_as_float(nw << 16);
        const float a = (j < 4) ? sp0[j & 3] : sp1[j & 3], bq = (j < 4) ? sn0[j & 3] : sn1[j & 3];
        out[j] = u0 + a * (up - u0) + bq * (un - u0); }
}
__device__ __forceinline__ f32x4 shift4(const bf16* buf, int ldc, int col, int row, int t, const float* sp, const float* sn) {
    const bf16* p = buf + (size_t)row * ldc + col;
    const u32x2_t c = *(const u32x2_t*)p; u32x2_t pv = (u32x2_t){0u, 0u}, nv = (u32x2_t){0u, 0u};
    if (t > 0) pv = *(const u32x2_t*)(p - ldc);
    if (t < SEQ - 1) nv = *(const u32x2_t*)(p + ldc);
    const f32x4 a = *(const f32x4*)sp, bq = *(const f32x4*)sn;
    const f32x4 u0 = (f32x4){__uint_as_float(c.x << 16), __uint_as_float(c.x & 0xffff0000u), __uint_as_float(c.y << 16), __uint_as_float(c.y & 0xffff0000u)};
    const f32x4 up = (f32x4){__uint_as_float(pv.x << 16), __uint_as_float(pv.x & 0xffff0000u), __uint_as_float(pv.y << 16), __uint_as_float(pv.y & 0xffff0000u)};
    const f32x4 un = (f32x4){__uint_as_float(nv.x << 16), __uint_as_float(nv.x & 0xffff0000u), __uint_as_float(nv.y << 16), __uint_as_float(nv.y & 0xffff0000u)};
    return u0 + a * (up - u0) + bq * (un - u0);
}

__device__ __forceinline__ void rwkv_pre_phase(Frame& F, int layer) {
    unsigned char* const ws = kws();
    int lane_ = lane_id(); asm volatile("" : "+v"(lane_)); int wave_o = F.wv; asm volatile("" : "+s"(wave_o)); const int wave_ = wave_o, tid_ = wave_ * 64 + lane_;
    const int d = wave_ >> 2, qm = (wave_ >> 1) & 1, qn = wave_ & 1, m0 = 32 * qm, n0 = 32 * qn;
#define LANE_VARS int lane = lane_; asm volatile("" : "+v"(lane)); const int hi = lane >> 5, l31 = lane & 31, mrow = m0 + l31; (void)hi; (void)l31; (void)mrow;
    LAS unsigned char* const L = F.lds;
    LAS unsigned char* const T0 = L + (d * 7 + 0) * TILE_B; LAS unsigned char* const T1 = L + (d * 7 + 1) * TILE_B; LAS unsigned char* const T2 = L + (d * 7 + 2) * TILE_B; LAS unsigned char* const T3 = L + (d * 7 + 3) * TILE_B;
    LAS unsigned char* const T4 = L + (d * 7 + 4) * TILE_B; LAS unsigned char* const T5 = L + (d * 7 + 5) * TILE_B; LAS unsigned char* const T6 = L + (d * 7 + 6) * TILE_B;
    LAS unsigned char* const TWt = L + PRE_TW; LAS unsigned char* const XAt = L + PRE_XA;
    LAS float* const invn = (LAS float*)(L + PRE_INVN); LAS float* const gcs = (LAS float*)(L + PRE_GC) + d * 64; LAS float* const bon = (LAS float*)(L + PRE_BON);
    const bf16* Rr = (const bf16*)(ws + R_RR); const bf16* Kr = (const bf16*)(ws + R_KR); const bf16* Vr = (const bf16*)(ws + R_VR); const bf16* XL = (const bf16*)(ws + R_XL);
    const bf16* W2T = (const bf16*)(ws + WS_LORA) + (size_t)d * 512 * 64; const bf16* A2T = (const bf16*)(ws + WS_LORA) + (size_t)(2 + d) * 512 * 64;
    float* BN = (float*)(ws + R_BN) + (size_t)d * M * 8;
    const float* sp = karg(I_TSP) + layer * RPROJ; const float* sn = karg(I_TSN) + layer * RPROJ;
    const float* w0 = karg(I_W0) + (layer * 2 + d) * 512; const float* a0 = karg(I_A0) + (layer * 2 + d) * 512;
    const float* kkp = karg(I_KK) + layer * 512; const float* kap = karg(I_KA) + layer * 512; const float* rkp = karg(I_RK) + layer * 512;
    for (int item = F.vcu; item < BATCH * H * (SEQ / 64); item += F.G) {
        const int cn = item & 63, h = (item >> 6) & 7, b = item >> 9, t0 = cn * 64, hc = h * HD;
#define SNAT (d ? 63 - mrow : mrow)
        { LANE_VARS; const int tidl = wave_ * 64 + lane; const int tok = tidl >> 3, oct = tidl & 7, t = t0 + tok, row = b * SEQ + t; float v8[8];
          shift8(XL, 256, 8 * oct, row, t, sp + 1536 + 8 * oct, sn + 1536 + 8 * oct, v8);
          { v4u w; w.x = cvtpk(tanh_fast(v8[0]), tanh_fast(v8[1])); w.y = cvtpk(tanh_fast(v8[2]), tanh_fast(v8[3])); w.z = cvtpk(tanh_fast(v8[4]), tanh_fast(v8[5])); w.w = cvtpk(tanh_fast(v8[6]), tanh_fast(v8[7])); *(LAS v4u*)(TWt + tok * TSB + 16 * oct) = w; }
          shift8(XL, 256, 64 + 8 * oct, row, t, sp + 1600 + 8 * oct, sn + 1600 + 8 * oct, v8);
          { v4u w; w.x = cvtpk(v8[0], v8[1]); w.y = cvtpk(v8[2], v8[3]); w.z = cvtpk(v8[4], v8[5]); w.w = cvtpk(v8[6], v8[7]); *(LAS v4u*)(XAt + tok * TSB + 16 * oct) = w; }
          shift8(Kr, 512, hc + 8 * oct, row, t, sp + 512 + hc + 8 * oct, sn + 512 + hc + 8 * oct, v8);
          const f32x4 k0 = *(const f32x4*)(kkp + hc + 8 * oct), k1 = *(const f32x4*)(kkp + hc + 8 * oct + 4); float ssq = 0.f;
#pragma unroll
          for (int j = 0; j < 8; ++j) { const float kx = v8[j] * ((j < 4) ? k0[j & 3] : k1[j & 3]); ssq += kx * kx; }
          ssq += pg8::shx(ssq, 1, lane); ssq += pg8::shx(ssq, 2, lane); ssq += pg8::shx(ssq, 4, lane);
          if (oct == 0) invn[tok] = 1.0f / sqrtf(ssq + 1e-12f); }
        WG_BAR();
        f32x16 zw, za, lw, av, cum;
        { LANE_VARS; const int snat = SNAT;
#pragma unroll
        for (int r = 0; r < 16; ++r) { zw[r] = 0.f; za[r] = 0.f; }
#pragma unroll
        for (int ks = 0; ks < 4; ++ks) { const size_t wo = (size_t)(hc + n0 + l31) * 64 + 16 * ks + 8 * hi;
            const bf16x8 wf = *(const bf16x8*)(W2T + wo), af = *(const bf16x8*)(A2T + wo);
            zw = MFMA32(wf, frag_row(TWt, snat, ks, hi), zw); za = MFMA32(af, frag_row(XAt, snat, ks, hi), za); }
#pragma unroll
        for (int q = 0; q < 4; ++q) { const f32x4 w0v = *(const f32x4*)(w0 + hc + n0 + 8 * q + 4 * hi), a0v = *(const f32x4*)(a0 + hc + n0 + 8 * q + 4 * hi);
#pragma unroll
            for (int i = 0; i < 4; ++i) { lw[4 * q + i] = -0.6065306597f * sigmoidf_(zw[4 * q + i] + w0v[i]); av[4 * q + i] = sigmoidf_(za[4 * q + i] + a0v[i]); } }
        { f32x16 lh, ll;
#pragma unroll
          for (int r = 0; r < 16; ++r) { lh[r] = __uint_as_float(cvtpk(lw[r], 0.f) << 16); ll[r] = lw[r] - lh[r]; }
          store_quad(T4, mrow, n0, hi, lh); store_quad(T5, mrow, n0, hi, ll); } }
        WG_BAR();
        { LANE_VARS;
#pragma unroll
        for (int r = 0; r < 16; ++r) cum[r] = 0.f;
#pragma unroll
        for (int ks = 0; ks < 4; ++ks) { bf16x8 tf;
#pragma unroll
            for (int j = 0; j < 8; ++j) tf[j] = (16 * ks + 8 * hi + j <= mrow) ? (short)0x3f80 : (short)0;
            cum = MFMA32(frag_tr(T4, n0, ks, lane), tf, cum); cum = MFMA32(frag_tr(T5, n0, ks, lane), tf, cum); } }
        f32x16 rh, kc, mrk;
        { LANE_VARS; const int snat = SNAT; const int tnat = t0 + snat, row = b * SEQ + tnat; const float inv = invn[snat];
          float bsum = 0.f;
#pragma unroll
          for (int q = 0; q < 4; ++q) { const int cg = hc + n0 + 8 * q + 4 * hi;
              const f32x4 r4 = shift4(Rr, 512, cg, row, tnat, sp + cg, sn + cg), k4 = shift4(Kr, 512, cg, row, tnat, sp + 512 + cg, sn + 512 + cg);
              const f32x4 kk4 = *(const f32x4*)(kkp + cg), ka4 = *(const f32x4*)(kap + cg), rk4 = *(const f32x4*)(rkp + cg);
              float kh4[4], bc4[4], rl4[4], kl4[4];
#pragma unroll
              for (int i = 0; i < 4; ++i) { const int e = 4 * q + i; const float a = av[e], cs = cum[e];
                  const float g = __expf(cs), gx = __expf(cs - lw[e]), gi = __expf(-cs);
                  const float kkn = k4[i] * kk4[i] * inv, kt = k4[i] * (1.0f + (a - 1.0f) * ka4[i]);
                  kh4[i] = gx * kkn; rh[e] = g * r4[i]; bc4[i] = a * kkn * gi; kc[e] = kt * gi; bsum += r4[i] * kt * rk4[i];
                  rl4[i] = rh[e] - __uint_as_float(cvtpk(rh[e], 0.f) << 16); kl4[i] = kc[e] - __uint_as_float(cvtpk(kc[e], 0.f) << 16);
                  if (mrow == 63) gcs[n0 + 8 * q + 4 * hi + i] = g; }
              const int off = mrow * TSB + (n0 + 8 * q + 4 * hi) * 2; u32x2_t w;
              w.x = cvtpk(kh4[0], kh4[1]); w.y = cvtpk(kh4[2], kh4[3]); *(LAS u32x2_t*)(T0 + off) = w;
              w.x = cvtpk(rh[4 * q], rh[4 * q + 1]); w.y = cvtpk(rh[4 * q + 2], rh[4 * q + 3]); *(LAS u32x2_t*)(T1 + off) = w;
              w.x = cvtpk(bc4[0], bc4[1]); w.y = cvtpk(bc4[2], bc4[3]); *(LAS u32x2_t*)(T2 + off) = w;
              w.x = cvtpk(kc[4 * q], kc[4 * q + 1]); w.y = cvtpk(kc[4 * q + 2], kc[4 * q + 3]); *(LAS u32x2_t*)(T3 + off) = w;
              w.x = cvtpk(rl4[0], rl4[1]); w.y = cvtpk(rl4[2], rl4[3]); *(LAS u32x2_t*)(T4 + off) = w;
              w.x = cvtpk(kl4[0], kl4[1]); w.y = cvtpk(kl4[2], kl4[3]); *(LAS u32x2_t*)(T5 + off) = w; }
          bsum += pg8::shx(bsum, 32, lane);
          if (hi == 0) bon[(d * 2 + qn) * 64 + snat] = bsum; }
        WG_BAR();
        { LANE_VARS; const int snat = SNAT; if (qn == 0 && hi == 0) BN[(size_t)(b * SEQ + t0 + snat) * 8 + h] = bon[(d * 2) * 64 + snat] + bon[(d * 2 + 1) * 64 + snat]; }
        { LANE_VARS;
#pragma unroll
          for (int r = 0; r < 16; ++r) mrk[r] = 0.f;
#pragma unroll
          for (int ks = 0; ks < 4; ++ks) { const bf16x8 rhi = frag_row(T1, mrow, ks, hi), khi = frag_row(T3, n0 + l31, ks, hi);
              mrk = MFMA32(khi, rhi, mrk); mrk = MFMA32(frag_row(T5, n0 + l31, ks, hi), rhi, mrk); mrk = MFMA32(khi, frag_row(T4, mrow, ks, hi), mrk); }
#pragma unroll
          for (int q = 0; q < 4; ++q)
#pragma unroll
              for (int i = 0; i < 4; ++i) { const int e = 4 * q + i, n = n0 + 8 * q + 4 * hi + i; mrk[e] = (n <= mrow) ? mrk[e] : 0.f; } }
        WG_BAR();
        { LANE_VARS; f32x16 x, mk, zz;
          float z0 = 0.f; asm volatile("" : "+v"(z0));
#pragma unroll
          for (int r = 0; r < 16; ++r) { x[r] = 0.f; mk[r] = 0.f; zz[r] = z0; }
#pragma unroll
          for (int ks = 0; ks < 4; ++ks) { const bf16x8 mf = frag_row(T0, mrow, ks, hi);
              x = MFMA32(frag_row(T2, n0 + l31, ks, hi), mf, x); mk = MFMA32(frag_row(T3, n0 + l31, ks, hi), mf, mk); }
#pragma unroll
          for (int q = 0; q < 4; ++q)
#pragma unroll
              for (int i = 0; i < 4; ++i) { const int e = 4 * q + i, n = n0 + 8 * q + 4 * hi + i; const bool lo = n < mrow; x[e] = lo ? -x[e] : 0.f; mk[e] = lo ? mk[e] : 0.f; }
          store_quad(T4, mrow, n0, hi, x); store_quad(T5, mrow, n0, hi, zz); store_quad(T6, mrow, n0, hi, mk); }
        WG_BAR();
        if ((wave_ & 3) == 0) { LANE_VARS; const int blk = lane >> 4, c = lane & 15; float t[16];
#pragma unroll
            for (int r = 0; r < 16; ++r) { const LAS unsigned char* xr = T4 + (16 * blk + r) * TSB + 32 * blk; const v4u w0_ = *(const LAS v4u*)xr, w1_ = *(const LAS v4u*)(xr + 16);
                float acc0 = (r == c) ? 1.0f : 0.f, acc1 = 0.f;
#pragma unroll
                for (int j = 0; j < r; ++j) { const unsigned w = (j < 8) ? w0_[j >> 1] : w1_[(j - 8) >> 1]; const float xv = (j & 1) ? __uint_as_float(w & 0xffff0000u) : __uint_as_float(w << 16);
                    if (j & 1) acc1 += xv * t[j]; else acc0 += xv * t[j]; }
                t[r] = acc0 + acc1; }
#pragma unroll
            for (int r = 0; r < 16; ++r) *(LAS unsigned short*)(T5 + (16 * blk + r) * TSB + (16 * blk + c) * 2) = (unsigned short)(cvtpk(t[r], 0.f) & 0xffffu); }
        WG_BAR();
        { LANE_VARS; LAS unsigned char* const scr = qm ? T5 : T4;
          if (qm == qn) {
              f32x16 w;
#pragma unroll
              for (int r = 0; r < 16; ++r) w[r] = 0.f;
              bf16x8 mf = frag_row(T4, m0 + l31, 2 * qm, hi);
              if (l31 < 16) mf = (bf16x8){0, 0, 0, 0, 0, 0, 0, 0};
              w = MFMA32(frag_tr(T5, m0, 2 * qm, lane), mf, w);
              store_quad(scr, l31, 32, hi, w); } }
        WG_BAR();
        { LANE_VARS; LAS unsigned char* const scr = qm ? T5 : T4;
          if (qm == qn) {
              f32x16 tq = load_quad(T5, mrow, m0, hi);
#pragma unroll
              for (int ks = 0; ks < 2; ++ks) tq = MFMA32(frag_tr(scr, 32, ks, lane), frag_row(T5, mrow, 2 * qm + ks, hi), tq);
              store_quad(T5, mrow, m0, hi, tq); } }
        WG_BAR();
        { LANE_VARS;
          if (qm == 1 && qn == 0) {
              f32x16 w;
#pragma unroll
              for (int r = 0; r < 16; ++r) w[r] = 0.f;
#pragma unroll
              for (int ks = 0; ks < 2; ++ks) w = MFMA32(frag_tr(T5, 0, ks, lane), frag_row(T4, 32 + l31, ks, hi), w);
              store_quad(T4, l31, 32, hi, w); }
          if (qm == 0 && qn == 1) { f32x16 zz; float z0 = 0.f; asm volatile("" : "+v"(z0));
#pragma unroll
              for (int r = 0; r < 16; ++r) zz[r] = z0;
              store_quad(T5, l31, 32, hi, zz); } }
        WG_BAR();
        { LANE_VARS;
          if (qm == 1 && qn == 0) {
              f32x16 t21;
#pragma unroll
              for (int r = 0; r < 16; ++r) t21[r] = 0.f;
#pragma unroll
              for (int ks = 0; ks < 2; ++ks) t21 = MFMA32(frag_tr(T4, 32, ks, lane), frag_row(T5, 32 + l31, 2 + ks, hi), t21);
              store_quad(T5, 32 + l31, 0, hi, t21); } }
        WG_BAR();
        { LANE_VARS; f32x16 kp, tk;
#pragma unroll
          for (int r = 0; r < 16; ++r) { kp[r] = 0.f; tk[r] = 0.f; }
#pragma unroll
          for (int ks = 0; ks < 4; ++ks) { const bf16x8 mf = frag_row(T5, mrow, ks, hi);
              kp = MFMA32(frag_tr(T0, n0, ks, lane), mf, kp); tk = MFMA32(frag_tr(T6, n0, ks, lane), mf, tk); }
          WG_BAR();
          store_quad(T0, mrow, n0, hi, kp); store_quad(T6, mrow, n0, hi, tk); }
        { LANE_VARS; f32x16 rb;
#pragma unroll
          for (int r = 0; r < 16; ++r) rb[r] = 0.f;
#pragma unroll
          for (int ks = 0; ks < 4; ++ks) rb = MFMA32(frag_row(T2, n0 + l31, ks, hi), frag_row(T1, mrow, ks, hi), rb);
#pragma unroll
          for (int q = 0; q < 4; ++q)
#pragma unroll
              for (int i = 0; i < 4; ++i) { const int e = 4 * q + i, n = n0 + 8 * q + 4 * hi + i; rb[e] = (n <= mrow) ? rb[e] : 0.f; }
          store_quad(T4, mrow, n0, hi, rb); }
        WG_BAR();
        const int cd = d ? 63 - cn : cn;
        bf16* const pre = (bf16*)(ws + R_PRE) + ((size_t)(((b * 8 + h) * 2 + d) * 64 + cd)) * 16384;
        { LANE_VARS; f32x16 rp, ml, pm, kq;
#pragma unroll
          for (int r = 0; r < 16; ++r) { rp[r] = 0.f; ml[r] = 0.f; pm[r] = 0.f; kq[r] = 0.f; }
#pragma unroll
          for (int ks = 0; ks < 4; ++ks) { const bf16x8 mrbf = frag_row(T4, mrow, ks, hi), khn = frag_tr(T0, n0, ks, lane), bcn = frag_tr(T2, n0, ks, lane);
              rp = MFMA32(khn, mrbf, rp); ml = MFMA32(frag_tr(T6, n0, ks, lane), mrbf, ml);
              pm = MFMA32(khn, frag_tr(T2, m0, ks, lane), pm); kq = MFMA32(bcn, frag_tr(T6, m0, ks, lane), kq); }
          const float gm = gcs[mrow];
#pragma unroll
          for (int q = 0; q < 4; ++q)
#pragma unroll
              for (int i = 0; i < 4; ++i) { const int e = 4 * q + i, n = n0 + 8 * q + 4 * hi + i;
                  rp[e] = rh[e] - rp[e]; ml[e] = mrk[e] - ml[e]; pm[e] = gm * (((n == mrow) ? 1.0f : 0.f) - pm[e]); kq[e] = (kc[e] - kq[e]) * gcs[n]; }
#pragma unroll
          for (int q = 0; q < 4; ++q) { const int pc = n0 + 16 * (q >> 1) + 8 * hi + 4 * (q & 1);
              u32x2_t w; w.x = cvtpk_h(pm[4 * q], pm[4 * q + 1]); w.y = cvtpk_h(pm[4 * q + 2], pm[4 * q + 3]); *(u32x2_t*)(pre + mrow * 64 + pc) = w;
              w.x = cvtpk_h(rp[4 * q], rp[4 * q + 1]); w.y = cvtpk_h(rp[4 * q + 2], rp[4 * q + 3]); *(u32x2_t*)(pre + 4096 + mrow * 64 + pc) = w; }
          WG_BAR();
          store_quad_h(T4, mrow, n0, hi, ml); store_quad_h(T5, mrow, n0, hi, kq); }
        { LANE_VARS; const int tt = (wave_ * 64 + lane) & 255, s = tt >> 2, cg4 = (tt & 3) * 16, sn_ = d ? 63 - s : s, t = t0 + sn_, row = b * SEQ + t; float v8[8];
#pragma unroll
          for (int hlf = 0; hlf < 2; ++hlf) { const int c8 = cg4 + 8 * hlf;
              shift8(Vr, 512, hc + c8, row, t, sp + 1024 + hc + c8, sn + 1024 + hc + c8, v8);
              v4u w; w.x = cvtpk_h(v8[0], v8[1]); w.y = cvtpk_h(v8[2], v8[3]); w.z = cvtpk_h(v8[4], v8[5]); w.w = cvtpk_h(v8[6], v8[7]); *(LAS v4u*)(T1 + s * TSB + 2 * c8) = w; } }
        WG_BAR();
        { LANE_VARS; f32x16 qt, yt;
#pragma unroll
          for (int r = 0; r < 16; ++r) { qt[r] = 0.f; yt[r] = 0.f; }
#pragma unroll
          for (int ks = 0; ks < 4; ++ks) { const bf16x8 vf = frag_tr(T1, m0, ks, lane);
              qt = MFMA32H(frag_tr(T5, n0, ks, lane), vf, qt); yt = MFMA32H(frag_row(T4, n0 + l31, ks, hi), vf, yt); }
          v4u w0_, w1_;
          w0_.x = cvtpk_h(qt[0], qt[1]); w0_.y = cvtpk_h(qt[2], qt[3]); w0_.z = cvtpk_h(qt[4], qt[5]); w0_.w = cvtpk_h(qt[6], qt[7]); w1_.x = cvtpk_h(qt[8], qt[9]); w1_.y = cvtpk_h(qt[10], qt[11]); w1_.z = cvtpk_h(qt[12], qt[13]); w1_.w = cvtpk_h(qt[14], qt[15]);
          { bf16* dst = pre + 8192 + ((qn * 64 + mrow) * 2 + hi) * 16; *(v4u*)dst = w0_; *(v4u*)(dst + 8) = w1_; }
          w0_.x = cvtpk_h(yt[0], yt[1]); w0_.y = cvtpk_h(yt[2], yt[3]); w0_.z = cvtpk_h(yt[4], yt[5]); w0_.w = cvtpk_h(yt[6], yt[7]); w1_.x = cvtpk_h(yt[8], yt[9]); w1_.y = cvtpk_h(yt[10], yt[11]); w1_.z = cvtpk_h(yt[12], yt[13]); w1_.w = cvtpk_h(yt[14], yt[15]);
          { bf16* dst = pre + 12288 + ((qn * 64 + mrow) * 2 + hi) * 16; *(v4u*)dst = w0_; *(v4u*)(dst + 8) = w1_; } }
        WG_BAR();
    }
#undef LANE_VARS
#undef SNAT
}

__device__ __forceinline__ void rwkv_scan_chunk(Frame& F, int unit) {
    unsigned char* const ws = kws();
    int lane_ = lane_id(); asm volatile("" : "+v"(lane_));
    const int lane = lane_, hi = lane >> 5, l31 = lane & 31;
    const int chain = unit >> 1, vh = unit & 1, d = chain & 1, h = (chain >> 1) & 7, b = chain >> 4, v = 32 * vh + l31;
    const bf16* pre = (const bf16*)(ws + R_PRE) + (size_t)chain * 64 * 16384;
    bf16* Y = (bf16*)(ws + (d ? R_Y1 : R_Y0));
    f32x16 X0, X1;
#pragma unroll
    for (int r = 0; r < 16; ++r) { X0[r] = 0.f; X1[r] = 0.f; }
#pragma unroll 1
    for (int c = 0; c < 64; ++c, pre += 16384) {
        bf16x8 xb[2][2], xl[2][2];
#pragma unroll
        for (int kt = 0; kt < 2; ++kt)
#pragma unroll
            for (int s = 0; s < 2; ++s) { v4u w, wl;
#pragma unroll
                for (int j = 0; j < 4; ++j) { const float a0 = kt ? X1[8 * s + 2 * j] : X0[8 * s + 2 * j], a1 = kt ? X1[8 * s + 2 * j + 1] : X0[8 * s + 2 * j + 1];
                    const unsigned hw = cvtpk_h(a0, a1); const f32x2_t hf = unpk_h(hw); w[j] = hw; wl[j] = cvtpk_h(a0 - hf.x, a1 - hf.y); }
                xb[kt][s] = __builtin_bit_cast(bf16x8, w); xl[kt][s] = __builtin_bit_cast(bf16x8, wl); }
        f32x16 acc[4];
#pragma unroll
        for (int o = 0; o < 4; ++o) { const bf16* src = pre + (o < 2 ? 8192 : 12288) + (((o & 1) * 64 + v) * 2 + hi) * 16; const v4u w0_ = *(const v4u*)src, w1_ = *(const v4u*)(src + 8);
#pragma unroll
            for (int j = 0; j < 4; ++j) { const f32x2_t u0 = unpk_h(w0_[j]), u1 = unpk_h(w1_[j]); acc[o][2 * j] = u0.x; acc[o][2 * j + 1] = u0.y; acc[o][8 + 2 * j] = u1.x; acc[o][8 + 2 * j + 1] = u1.y; } }
#pragma unroll
        for (int o = 0; o < 4; ++o) { const bf16* arow = pre + (o < 2 ? 0 : 4096) + (32 * (o & 1) + l31) * 64 + 8 * hi;
#pragma unroll
            for (int kt = 0; kt < 2; ++kt)
#pragma unroll
                for (int s = 0; s < 2; ++s) { const bf16x8 af = *(const bf16x8*)(arow + 32 * kt + 16 * s); acc[o] = MFMA32H(af, xb[kt][s], acc[o]); acc[o] = MFMA32H(af, xl[kt][s], acc[o]); } }
#pragma unroll
        for (int st = 0; st < 2; ++st)
#pragma unroll
            for (int r = 0; r < 16; ++r) { const int s = 32 * st + (r & 3) + 8 * (r >> 2) + 4 * hi; const int tnat = d ? (63 - c) * 64 + 63 - s : c * 64 + s;
                Y[(size_t)(b * SEQ + tnat) * 512 + h * HD + v] = (bf16)(cvtpk_h(acc[2 + st][r], 0.f) & 0xffffu); }
        X0 = acc[0]; X1 = acc[1];
    }
}

constexpr int ATT_O = 0, ATT_L = 65536, ATT_V = 67584, ATT_VT = 32 * TSB;
static_assert(ATT_V + NWAVES * ATT_VT <= LDSCTL_OFF, "attention LDS map");
__device__ __forceinline__ bf16x8 frag_tr_pv(const LAS unsigned char* tile, int d0, int s, int lane) {
    const int hi = lane >> 5, g1 = (lane >> 4) & 1, i = lane & 15;
    const LAS unsigned char* p = tile + (16 * s + 4 * hi + (i >> 2)) * TSB + (d0 + 16 * g1 + 4 * (i & 3)) * 2;
    const s16x4 lo = tr4(p), h4 = tr4(p + 8 * TSB);
    return (bf16x8){lo[0], lo[1], lo[2], lo[3], h4[0], h4[1], h4[2], h4[3]};
}
template <int NQH>
__device__ __forceinline__ void attn_block(const bf16* MIX, const bf16* V, LAS unsigned char* lds, LAS unsigned char* vt, int b, int h, int T0, int tq0, int d, float slope_d, float bound, bool first, int lane) {
    const int hi = lane >> 5, l31 = lane & 31;
    const int jlo = -(tq0 / d), jhi = (SEQ - 1 - tq0) / d;
    bf16x8 qf[NQH][4];
#pragma unroll
    for (int qh = 0; qh < NQH; ++qh) { const bf16* qp = MIX + ((size_t)b * SEQ + tq0 + d * (32 * qh + l31)) * 1024 + h * HD + 8 * hi;
#pragma unroll
        for (int ks = 0; ks < 4; ++ks) qf[qh][ks] = *(const bf16x8*)(qp + 16 * ks); }
    f32x16 o[NQH][2]; float lsum[NQH];
#pragma unroll
    for (int qh = 0; qh < NQH; ++qh) { lsum[qh] = 0.f;
#pragma unroll
        for (int r = 0; r < 16; ++r) { o[qh][0][r] = 0.f; o[qh][1][r] = 0.f; } }
    constexpr int NT = NQH == 2 ? 6 : 5;
#pragma unroll 1
    for (int jt = 0; jt < NT; ++jt) {
        { const int kr = lane >> 1, hf = lane & 1; int pos = tq0 + d * (32 * jt + kr - 64); pos = pos < 0 ? 0 : (pos > SEQ - 1 ? SEQ - 1 : pos);
          const v4u* src = (const v4u*)(V + ((size_t)b * SEQ + pos) * 512 + h * HD + 32 * hf); LAS v4u* dst = (LAS v4u*)(vt + kr * TSB + 64 * hf);
          const v4u a0 = src[0], a1 = src[1], a2 = src[2], a3 = src[3]; dst[0] = a0; dst[1] = a1; dst[2] = a2; dst[3] = a3; }
        bf16x8 kf[4];
        { int pos = tq0 + d * (32 * jt + l31 - 64); pos = pos < 0 ? 0 : (pos > SEQ - 1 ? SEQ - 1 : pos);
          const bf16* kp = MIX + ((size_t)b * SEQ + pos) * 1024 + 512 + h * HD + 8 * hi;
#pragma unroll
          for (int ks = 0; ks < 4; ++ks) kf[ks] = *(const bf16x8*)(kp + 16 * ks); }
        asm volatile("s_waitcnt lgkmcnt(0)" ::: "memory");
#pragma unroll
        for (int qh = 0; qh < NQH; ++qh) {
            if (NQH == 2 && ((qh == 0 && jt == 5) || (qh == 1 && jt == 0))) continue;
            f32x16 s;
#pragma unroll
            for (int r = 0; r < 16; ++r) s[r] = 0.f;
#pragma unroll
            for (int ks = 0; ks < 4; ++ks) s = MFMA32(kf[ks], qf[qh][ks], s);
            const int iq = 32 * qh + l31;
            v4u pk[2];
#pragma unroll
            for (int r = 0; r < 16; r += 2) { float p2[2];
#pragma unroll
                for (int e = 0; e < 2; ++e) { const int rr = r + e, jj = 32 * jt + (rr & 3) + 8 * (rr >> 2) + 4 * hi - 64; const int dl = iq - jj, ad = dl < 0 ? -dl : dl;
                    const bool valid = (ad <= 64) && (jj >= jlo) && (jj <= jhi);
                    p2[e] = valid ? __expf(s[rr] - slope_d * (float)ad - bound) : 0.f; lsum[qh] += p2[e]; }
                pk[r >> 3][(r >> 1) & 3] = cvtpk(p2[0], p2[1]); }
#pragma unroll
            for (int dt = 0; dt < 2; ++dt)
#pragma unroll
                for (int s2 = 0; s2 < 2; ++s2) o[qh][dt] = MFMA32(frag_tr_pv(vt, 32 * dt, s2, lane), __builtin_bit_cast(bf16x8, pk[s2]), o[qh][dt]);
        }
        asm volatile("s_waitcnt lgkmcnt(0)" ::: "memory");
    }
#pragma unroll
    for (int qh = 0; qh < NQH; ++qh) {
        const int qi = (tq0 - T0) + d * (32 * qh + l31);
        const float lt = lsum[qh] + pg8::shx(lsum[qh], 32, lane);
        if (hi == 0) { LAS float* lp = (LAS float*)(lds + ATT_L) + qi; *lp = first ? lt : (*lp + lt); }
#pragma unroll
        for (int dt = 0; dt < 2; ++dt)
#pragma unroll
            for (int q = 0; q < 4; ++q) { const int d0 = 32 * dt + 8 * q + 4 * hi; LAS u32x2_t* op = (LAS u32x2_t*)(lds + ATT_O + qi * 128 + ((((d0 >> 3) ^ (qi & 7)) << 4) | ((d0 & 4) << 1)));
                float v0 = o[qh][dt][4 * q], v1 = o[qh][dt][4 * q + 1], v2 = o[qh][dt][4 * q + 2], v3 = o[qh][dt][4 * q + 3];
                if (!first) { const u32x2_t w = *op; v0 += __uint_as_float(w.x << 16); v1 += __uint_as_float(w.x & 0xffff0000u); v2 += __uint_as_float(w.y << 16); v3 += __uint_as_float(w.y & 0xffff0000u); }
                u32x2_t w; w.x = cvtpk(v0, v1); w.y = cvtpk(v2, v3); *op = w; }
    }
}
__device__ __forceinline__ void attn_phase_mfma(Frame& F, int layer, int unit0, int nunit, int ustride) {
    unsigned char* const ws = kws();
    int lane_ = lane_id(); asm volatile("" : "+v"(lane_)); int wave_o = F.wv; asm volatile("" : "+s"(wave_o)); const int wave_ = wave_o, lane = lane_;
    bf16* MIX = (bf16*)(ws + R_MIX); const bf16* V = (const bf16*)(ws + R_V);
    LAS unsigned char* const lds = F.lds; LAS unsigned char* const vt = lds + ATT_V + wave_ * ATT_VT;
    float bound;
    { const float* qg = karg(I_QG) + layer * HD; const float* kg = karg(I_KG) + layer * HD; float mq = 0.f, mk = 0.f;
      for (int i = 0; i < HD; ++i) { mq = fmaxf(mq, fabsf(qg[i])); mk = fmaxf(mk, fabsf(kg[i])); }
      bound = 8.0f * mq * mk + 0.25f; }
    for (int unit = unit0; unit < nunit; unit += ustride) {
        const int st = unit & 7, h = (unit >> 3) & 7, b = unit >> 6, T0 = st * 512;
        const float slope = exp2f(-(float)(h + 1));
        attn_block<2>(MIX, V, lds, vt, b, h, T0, T0 + 64 * wave_, 1, slope, bound, true, lane);
        WG_BAR();
        attn_block<2>(MIX, V, lds, vt, b, h, T0, T0 + (wave_ & 3) + 256 * (wave_ >> 2), 4, slope * 4.f, bound, false, lane);
        WG_BAR();
        attn_block<1>(MIX, V, lds, vt, b, h, T0, T0 + 2 * wave_, 16, slope * 16.f, bound, false, lane);
        attn_block<1>(MIX, V, lds, vt, b, h, T0, T0 + 2 * wave_ + 1, 16, slope * 16.f, bound, false, lane);
        WG_BAR();
        { const int tid = wave_ * 64 + lane;
#pragma unroll
          for (int k = 0; k < 8; ++k) { const int item = tid + 512 * k, qi = item >> 3, c16 = item & 7;
              const v4u w = *(const LAS v4u*)(lds + ATT_O + qi * 128 + ((c16 ^ (qi & 7)) << 4)); const float il = 1.0f / ((const LAS float*)(lds + ATT_L))[qi];
              v4u o;
#pragma unroll
              for (int j = 0; j < 4; ++j) o[j] = cvtpk(__uint_as_float(w[j] << 16) * il, __uint_as_float(w[j] & 0xffff0000u) * il);
              *(v4u*)(MIX + ((size_t)b * SEQ + T0 + qi) * 1024 + h * HD + 8 * c16) = o; } }
        WG_BAR();
    }
}

__device__ __forceinline__ void rwkv_finalize_naive(Frame& F, int layer) {
    unsigned char* const ws = kws();
    int lane_ = lane_id(); asm volatile("" : "+v"(lane_)); int wave_o = F.wv; asm volatile("" : "+s"(wave_o)); const int wave_ = wave_o, tid_ = wave_ * 64 + lane_;
    const int col = tid_, h = wave_;
    LAS float* SG = (LAS float*)(F.lds + RING_OFF);
    const bf16* Vr = (const bf16*)(ws + R_VR); const bf16* XL = (const bf16*)(ws + R_XL); bf16* MIX = (bf16*)(ws + R_MIX);
    const bf16* Y0 = (const bf16*)(ws + R_Y0); const bf16* Y1 = (const bf16*)(ws + R_Y1); const float* BN0 = (const float*)(ws + R_BN); const float* BN1 = BN0 + (size_t)M * 8;
    const float* sp = karg(I_TSP) + layer * RPROJ; const float* sn = karg(I_TSN) + layer * RPROJ;
    const float* g2 = karg(I_G2) + (size_t)layer * 128 * 512 + col;
    const float gnw = karg(I_GNW)[layer * 512 + col], gnb = karg(I_GNB)[layer * 512 + col], sp_v = sp[1024 + col], sn_v = sn[1024 + col];
    int vz = 0; asm volatile("" : "+v"(vz));
    for (int tile = F.vcu; tile < M / 16; tile += F.G) { const int r0 = tile * 16;
#pragma unroll
        for (int i = 0; i < 4; ++i) { const int e = tid_ + 512 * i, tok = e >> 7, k = e & 127, row = r0 + tok, t = row % SEQ;
            SG[e] = sigmoidf_(ushift(XL, 256, 128 + k, row, t, sp[1664 + k], sn[1664 + k])); }
        __syncthreads();
        float g[16];
#pragma unroll
        for (int i = 0; i < 16; ++i) g[i] = 0.f;
        for (int k = 0; k < 128; ++k) { const float gw = g2[(size_t)k * 512];
#pragma unroll
            for (int i = 0; i < 16; ++i) g[i] += SG[i * 128 + k] * gw; }
#pragma unroll
        for (int i = 0; i < 16; ++i) { const int row = r0 + i, t = row % SEQ;
            const float y = unpk_h(Y0[(size_t)row * 512 + col]).x + unpk_h(Y1[(size_t)row * 512 + col]).x;
            const float mu = wave_sum(y, lane_) * (1.0f / 64.0f); const float dl = y - mu; const float var = wave_sum(dl * dl, lane_) * (1.0f / 64.0f);
            const float yn = dl / sqrtf(var + GN_EPS) * gnw + gnb;
            const float vs = ushift(Vr, 512, col, row, t, sp_v, sn_v);
            const float bonus = (BN0[(size_t)row * 8 + h + vz] + BN1[(size_t)row * 8 + h + vz]) * vs;
            MIX[(size_t)row * 1024 + 512 + col] = f2bf_s((yn + bonus) * g[i]); }
        __syncthreads();
    }
}

__global__ void __launch_bounds__(NTHR, 2) mk_fwd(Args args) {
    extern __shared__ __attribute__((aligned(16))) unsigned char lds[];
    Frame F;
    F.lds = (LAS unsigned char*)lds;
    F.MISC = (volatile LAS unsigned*)(F.lds + MISC_OFF);
    F.wv = __builtin_amdgcn_readfirstlane((int)threadIdx.x >> 6);
    F.G = gridDim.x; { const int bx = blockIdx.x; F.vcu = (F.G % 8 == 0) ? (bx % 8) * (F.G / 8) + bx / 8 : bx; }
    F.ctl = (gu32*)(kws() + WS_CTL);
    for (int u = F.wv * 64 + lane_id(); u < (LDS_BYTES - LDSCTL_OFF) / 4; u += NTHR) ((LAS unsigned*)(F.lds + LDSCTL_OFF))[u] = 0u;
    __syncthreads();
    XcdBarrier bar = xcd_barrier_post((unsigned*)(F.ctl + CW_BAR), F.MISC + 8, F.wv == 0 && lane_id() == 0);
#define GRID_BAR() xcd_barrier(bar, F.wv == 0 && lane_id() == 0)
#define XB ((bf16*)(ws + R_XB))
#define MIXB ((bf16*)(ws + R_MIX))
#define HID ((bf16*)(ws + R_HID))
#define SS1 ((float*)(ws + WS_SS1))
#define SS2 ((float*)(ws + WS_SS2))

    for (int step = 0; step < 8 * DEPTH; ++step) {
        const int layer = step >> 3, kind = step & 7;
        if (kind == 0) {
            if (layer == 0) x_prologue(F);
            wconv_phase(F, layer);
        } else if (kind == 1) {
            unsigned char* const ws = kws();
            pg8::Gemm g{XB, (const bf16*)(ws + WS_WIN), M, NPROJ, D}; pg8::StaticOrder S; S.init(M, NPROJ, F.G, (int)blockIdx.x);
            pg8::EpiProj E; E.base0 = (bf16*)(ws + WS_R0); E.ss = SS1; E.qg = karg(I_QG) + layer * HD; E.kg = karg(I_KG) + layer * HD;
            pg8::gemm_phase<pg8::EpiProj, pg8::StaticOrder, true, true>(F.lds + RING_OFF, g, S, E, F.wv, lane_id());
        } else if (kind == 2) {
            rwkv_pre_phase(F, layer);
        } else if (kind == 3) {
            const int bx = (int)blockIdx.x;
            if (bx < 128) { if (F.wv == 0) rwkv_scan_chunk(F, bx); }
            else attn_phase_mfma(F, layer, bx - 128, BATCH * H * 8, F.G - 128);
        } else if (kind == 4) {
            rwkv_finalize_naive(F, layer);
        } else if (kind == 5 || kind == 7) {
            unsigned char* const ws = kws(); float* const xo = kout();
            pg8::Gemm g{kind == 5 ? MIXB : HID, (const bf16*)(ws + (kind == 5 ? WS_WOUT : WS_WDN)), M, D, kind == 5 ? D : FF}; pg8::StaticOrder S; S.init(M, D, F.G, (int)blockIdx.x);
            pg8::EpiRes E{xo, XB, kind == 5 ? SS2 : SS1};
            pg8::gemm_phase<pg8::EpiRes, pg8::StaticOrder, false, true>(F.lds + RING_OFF, g, S, E, F.wv, lane_id());
        } else {
            unsigned char* const ws = kws();
            pg8::Gemm g{XB, (const bf16*)(ws + WS_WUP), M, FF, D}; pg8::StaticOrder S; S.init(M, FF, F.G, (int)blockIdx.x);
            pg8::EpiUp E{HID, SS2};
            pg8::gemm_phase<pg8::EpiUp, pg8::StaticOrder, true, true>(F.lds + RING_OFF, g, S, E, F.wv, lane_id());
        }
        if (step + 1 < 8 * DEPTH) GRID_BAR();
    }
}

extern "C" void kernel_launch(void* const* d_in, const int* in_sizes, int n_in, void* d_out, int out_size, void* d_ws, size_t ws_size, hipStream_t stream) {
    static int grid = 0;
    if (grid == 0) {
        if (n_in != N_IN || in_sizes[0] != M * D || out_size != M * D || ws_size < WS_END) { fprintf(stderr, "kernel_launch: unexpected shapes (n_in %d, in0 %d, out %d, ws %zu)\n", n_in, n_in > 0 ? in_sizes[0] : -1, out_size, ws_size); grid = -1; return; }
        int dev = 0, cus = 0;
        if (hipGetDevice(&dev) != hipSuccess || hipDeviceGetAttribute(&cus, hipDeviceAttributeMultiprocessorCount, dev) != hipSuccess) { grid = -1; return; }
        if (hipFuncSetAttribute((const void*)mk_fwd, hipFuncAttributeMaxDynamicSharedMemorySize, LDS_BYTES) != hipSuccess) { fprintf(stderr, "kernel_launch: hipFuncSetAttribute failed\n"); grid = -1; return; }
        int per_cu = 0;
        (void)hipOccupancyMaxActiveBlocksPerMultiprocessor(&per_cu, (const void*)mk_fwd, NTHR, LDS_BYTES);
        (void)hipGetLastError();
        grid = cus;
    }
    if (grid < 0) return;
    (void)hipMemsetAsync((char*)d_ws + WS_CTL, 0, CTL_ZERO_BYTES, stream);
    Args a{};
    for (int i = 0; i < N_IN; ++i) a.in[i] = (const float*)d_in[i];
    a.out = (float*)d_out; a.ws = (unsigned char*)d_ws;
    hipLaunchKernelGGL(mk_fwd, dim3(grid), dim3(NTHR), LDS_BYTES, stream, a);
}
```

```cpp
#include <hip/hip_runtime.h>
#include <cstdio>
#include <cstdint>
namespace pg8 {
#define PG8_LAS __attribute__((address_space(3)))
typedef unsigned short bf16_t;
typedef short bf16x8 __attribute__((ext_vector_type(8)));
typedef float f32x4 __attribute__((ext_vector_type(4)));
typedef unsigned u32x4 __attribute__((ext_vector_type(4)));
constexpr int BM = 256, BK = 64, HALF = 128, HTB = HALF * BK * 2  , STAGE_BYTES = 8 * HTB, NXCD = 8, WGM = 8;

__host__ __device__ __forceinline__ int lds_byte(int r, int c) { const int st = (r >> 4) * 2 + (c >> 5), rr = r & 15, cc = c & 31, ob = rr * 64 + cc * 2; return st * 1024 + (ob ^ (((ob >> 9) & 1) << 5)); }
__host__ __device__ __forceinline__ void stage_rc(int b, int& R, int& C) { const int st = b / 1024, sb = b % 1024, swz = sb ^ (((sb >> 9) & 1) << 5); R = (st >> 1) * 16 + swz / 64; C = (st & 1) * 32 + (swz % 64) / 2; }
__host__ __device__ __forceinline__ int perm32(int rho) { const int n = rho >> 4, i = rho & 15; return 8 * (i >> 2) + 4 * n + (i & 3); }

struct Unit { int pm, pn; };
struct Gemm { const bf16_t* A; const bf16_t* Bt; int M, N, K; };

struct StaticOrder {
    int nM, nN, nwg, G, c;
    __host__ __device__ void init(int M, int N, int G_, int c_) { nM = M / BM; nN = N / BM; nwg = nM * nN; G = G_; c = c_; }
    __host__ __device__ bool next(int i, Unit& u) const {
        const long L = (long)i * G + c; if (L >= nwg) return false;
        int wgid = (int)L; { const int q = nwg / NXCD, r = nwg % NXCD, xcd = wgid % NXCD, off = wgid / NXCD; wgid = (xcd < r ? xcd * (q + 1) : r * (q + 1) + (xcd - r) * q) + off; }
        const int nig = WGM * nN, gid = wgid / nig, fm = gid * WGM, gsz = (nM - fm) < WGM ? (nM - fm) : WGM;
        u.pm = fm + ((wgid % nig) % gsz); u.pn = (wgid % nig) / gsz; return true;
    }
    __device__ __forceinline__ void a_ready(const Unit&) const {}
    __device__ __forceinline__ void done(const Unit&) const {}
};

__device__ __forceinline__ unsigned cvt_pk_bf16(float lo, float hi) { unsigned r; asm volatile("v_cvt_pk_bf16_f32 %0, %1, %2" : "=v"(r) : "v"(lo), "v"(hi)); return r; }
typedef unsigned u32x2 __attribute__((ext_vector_type(2)));

__device__ __forceinline__ float shx(float v, int m, int lane) { return __int_as_float(__builtin_amdgcn_ds_bpermute((lane ^ m) << 2, __float_as_int(v))); }
__device__ __forceinline__ float row_rs(const float* ss, int row, int fq, int lane) {
    const f32x4 p = *(const f32x4*)(ss + (size_t)row * 16 + 4 * fq);
    float s = (p[0] + p[1]) + (p[2] + p[3]);
    s += shx(s, 16, lane); s += shx(s, 32, lane);
    return 1.0f / sqrtf(s * (1.0f / 1024.0f) + 1e-6f);
}

struct EpiProj {
    static constexpr bool PERM = true, AFTER_DRAIN = false;
    bf16_t* base0; const float* ss; const float* qg; const float* kg;
    __device__ __forceinline__ void operator()(const f32x4 (&acc)[2][2][4][2], const Unit& u, int wr, int wc, int fr, int fq) const {
        const int tile = u.pn, di = tile >> 1;
        bf16_t* base = base0 + (di < 2 ? (size_t)di * 512 : (size_t)di * (8u << 20)); const int ldc = (di < 2) ? 1024 : ((di == 6) ? 256 : 512); const int cb = (di == 6) ? 0 : (tile & 1) * 256;
        const bool nrm = tile < 4; const float* gsrc = (tile < 2) ? qg : kg; const float post = (tile < 2) ? 0.125f : 1.0f;
        f32x4 g[2][2];
#pragma unroll
        for (int bj = 0; bj < 2; ++bj)
#pragma unroll
            for (int n = 0; n < 2; ++n) g[bj][n] = nrm ? *(const f32x4*)(gsrc + 32 * bj + 8 * fq + 4 * n) * post : (f32x4){1.f, 1.f, 1.f, 1.f};
#pragma unroll
        for (int ai = 0; ai < 2; ++ai)
#pragma unroll
            for (int m = 0; m < 4; ++m) {
                const int row = u.pm * BM + ai * HALF + wr * 64 + m * 16 + fr;
                const float rs = row_rs(ss, row, fq, 16 * fq + fr);
                f32x4 v[2][2]; float q = 0.f;
#pragma unroll
                for (int bj = 0; bj < 2; ++bj)
#pragma unroll
                    for (int n = 0; n < 2; ++n) { v[bj][n] = acc[ai][bj][m][n] * rs; const f32x4 t = v[bj][n]; q += (t[0] * t[0] + t[1] * t[1]) + (t[2] * t[2] + t[3] * t[3]); }
                q += shx(q, 16, 16 * fq + fr); q += shx(q, 32, 16 * fq + fr);
                const float inv = nrm ? 1.0f / sqrtf(q * (1.0f / 64.0f) + 1e-6f) : 1.0f;
                bf16_t* rowp = base + (size_t)row * ldc + cb + 64 * wc + 8 * fq;
#pragma unroll
                for (int bj = 0; bj < 2; ++bj) { const f32x4 v0 = v[bj][0] * inv * g[bj][0], v1 = v[bj][1] * inv * g[bj][1];
                    u32x4 w; w.x = cvt_pk_bf16(v0[0], v0[1]); w.y = cvt_pk_bf16(v0[2], v0[3]); w.z = cvt_pk_bf16(v1[0], v1[1]); w.w = cvt_pk_bf16(v1[2], v1[3]);
                    *(u32x4*)(rowp + 32 * bj) = w; }
                asm volatile("" ::: "memory");
            }
    }
};
struct EpiUp {
    static constexpr bool PERM = true, AFTER_DRAIN = false;
    bf16_t* O; const float* ss;
    __device__ __forceinline__ void operator()(const f32x4 (&acc)[2][2][4][2], const Unit& u, int wr, int wc, int fr, int fq) const {
#pragma unroll
        for (int ai = 0; ai < 2; ++ai)
#pragma unroll
            for (int m = 0; m < 4; ++m) {
                const int row = u.pm * BM + ai * HALF + wr * 64 + m * 16 + fr;
                const float rs = row_rs(ss, row, fq, 16 * fq + fr);
                bf16_t* rowp = O + (size_t)row * 4096 + u.pn * BM + wc * 32 + 8 * fq;
#pragma unroll
                for (int bj = 0; bj < 2; ++bj) { f32x4 v0 = acc[ai][bj][m][0] * rs, v1 = acc[ai][bj][m][1] * rs;
                    v0 = __builtin_elementwise_max(v0, (f32x4){0.f, 0.f, 0.f, 0.f}); v1 = __builtin_elementwise_max(v1, (f32x4){0.f, 0.f, 0.f, 0.f}); v0 = v0 * v0; v1 = v1 * v1;
                    u32x4 w; w.x = cvt_pk_bf16(v0[0], v0[1]); w.y = cvt_pk_bf16(v0[2], v0[3]); w.z = cvt_pk_bf16(v1[0], v1[1]); w.w = cvt_pk_bf16(v1[2], v1[3]);
                    *(u32x4*)(rowp + bj * HALF) = w; }
                asm volatile("" ::: "memory");
            }
    }
};
struct EpiRes {
    static constexpr bool PERM = false, AFTER_DRAIN = false;
    float* x; bf16_t* xb; float* ss;
    __device__ __forceinline__ void operator()(const f32x4 (&acc)[2][2][4][2], const Unit& u, int wr, int wc, int fr, int fq) const {
        const int col0 = u.pn * BM + wc * 32 + 4 * fq;
#pragma unroll
        for (int ai = 0; ai < 2; ++ai)
#pragma unroll
            for (int m = 0; m < 4; ++m) {
                const int row = u.pm * BM + ai * HALF + wr * 64 + m * 16 + fr; const size_t off = (size_t)row * 1024 + col0; float q = 0.f;
#pragma unroll
                for (int bj = 0; bj < 2; ++bj)
#pragma unroll
                    for (int n = 0; n < 2; ++n) { const size_t o = off + bj * HALF + n * 16; const f32x4 t = *(const f32x4*)(x + o) + acc[ai][bj][m][n];
                        *(f32x4*)(x + o) = t; u32x2 w; w.x = cvt_pk_bf16(t[0], t[1]); w.y = cvt_pk_bf16(t[2], t[3]); *(u32x2*)(xb + o) = w;
                        q += (t[0] * t[0] + t[1] * t[1]) + (t[2] * t[2] + t[3] * t[3]); }
                q += shx(q, 16, 16 * fq + fr); q += shx(q, 32, 16 * fq + fr);
                if (fq == 0) ss[(size_t)row * 16 + 4 * u.pn + wc] = q;
                asm volatile("" ::: "memory");
            }
    }
};

template <class Epi, class Sched, bool ALIGN_EPI = false, bool SP2 = false>
__device__ __forceinline__ void gemm_phase(PG8_LAS unsigned char* lds, const Gemm g, const Sched& S, const Epi& E, int wave_in, int lane_in) {
    int lane_o = lane_in, wave_o = wave_in; asm volatile("" : "+v"(lane_o)); asm volatile("" : "+s"(wave_o)); const int tid_ = wave_o * 64 + lane_o;
    const int tid = tid_, wid = wave_o, lane = lane_o, wr = wid >> 2, wc = wid & 3, fr = lane & 15, fq = lane >> 4;
    const int K = g.K, nt = K / BK;
    unsigned voffA[2], voffB[2];
#pragma unroll
    for (int i = 0; i < 2; ++i) { int R, C; stage_rc(tid * 16 + i * 8192, R, C); const int Rb = Epi::PERM ? ((R & ~31) + perm32(R & 31)) : R;
        voffA[i] = (unsigned)(R * K + C) * 2u; voffB[i] = (unsigned)(Rb * K + C) * 2u; }
    const size_t kstep = (size_t)(BK * 2);
    const size_t hstep = (size_t)HALF * K * 2;
    const size_t tstep = 2 * hstep;
    const unsigned ldsw = (unsigned)wid * 1024u;
    const int aoff = lds_byte(wr * 64 + fr, fq * 8), boff = lds_byte(wc * 32 + fr, fq * 8);
#define PG8_SA(b, h) (((b) * 2 + (h)) * HTB)
#define PG8_SB(b, h) ((4 + (b) * 2 + (h)) * HTB)
#define PG8_STAGE(bufoff, gbase, voff) do { _Pragma("unroll") for (int _i = 0; _i < 2; ++_i) \
        __builtin_amdgcn_global_load_lds((const unsigned*)((const char*)(gbase) + (voff)[_i]), (PG8_LAS unsigned*)(lds + (bufoff) + ldsw + _i * 8192), 16, 0, 0); } while (0)
#define PG8_LDA(dst, b, h) do { _Pragma("unroll") for (int m = 0; m < 4; ++m) _Pragma("unroll") for (int k = 0; k < 2; ++k) dst[m][k] = *(const PG8_LAS bf16x8*)(lds + PG8_SA(b, h) + aoff + m * 2048 + k * 1024); } while (0)
#define PG8_LDB(dst, b, h) do { _Pragma("unroll") for (int n = 0; n < 2; ++n) _Pragma("unroll") for (int k = 0; k < 2; ++k) dst[n][k] = *(const PG8_LAS bf16x8*)(lds + PG8_SB(b, h) + boff + n * 2048 + k * 1024); } while (0)
#define PG8_MMA(ai, bj, At, Bt) do { __builtin_amdgcn_s_setprio(1); _Pragma("unroll") for (int m = 0; m < 4; ++m) _Pragma("unroll") for (int n = 0; n < 2; ++n) _Pragma("unroll") for (int k = 0; k < 2; ++k) \
        acc[ai][bj][m][n] = __builtin_amdgcn_mfma_f32_16x16x32_bf16(Bt[n][k], At[m][k], acc[ai][bj][m][n], 0, 0, 0); __builtin_amdgcn_s_setprio(0); } while (0)
#define PG8_WAIT_V(n) asm volatile("s_waitcnt vmcnt(" #n ")" ::: "memory")
#define PG8_WAIT_L(n) asm volatile("s_waitcnt lgkmcnt(" #n ")" ::: "memory")
#define PG8_BAR __builtin_amdgcn_s_barrier()
#define PG8_SCHED __builtin_amdgcn_sched_barrier(0)
    Unit cur, nxt; int ui = 0;
    if (!S.next(0, cur)) return;
    f32x4 acc[2][2][4][2];
#pragma unroll
    for (int a = 0; a < 2; ++a)
#pragma unroll
        for (int b = 0; b < 2; ++b)
#pragma unroll
            for (int m = 0; m < 4; ++m)
#pragma unroll
                for (int n = 0; n < 2; ++n) acc[a][b][m][n] = (f32x4){0.f, 0.f, 0.f, 0.f};
    bf16x8 At[4][2], B0[2][2], B1[2][2];
    const char* cA = (const char*)g.A + (size_t)cur.pm * tstep; const char* cB = (const char*)g.Bt + (size_t)cur.pn * tstep;
    S.a_ready(cur);
    if constexpr (SP2) {
        PG8_STAGE(PG8_SB(0, 0), cB, voffB); PG8_STAGE(PG8_SB(0, 1), cB + hstep, voffB); PG8_STAGE(PG8_SA(0, 0), cA, voffA); PG8_STAGE(PG8_SA(0, 1), cA + hstep, voffA);
        if (wr == 1) PG8_BAR;
        PG8_WAIT_V(2); PG8_BAR;
        PG8_STAGE(PG8_SB(1, 0), cB + kstep, voffB); PG8_STAGE(PG8_SA(1, 0), cA + kstep, voffA); PG8_STAGE(PG8_SB(1, 1), cB + hstep + kstep, voffB);
        PG8_WAIT_V(6); PG8_BAR;
    } else {
        PG8_STAGE(PG8_SB(0, 0), cB, voffB); PG8_STAGE(PG8_SA(0, 0), cA, voffA); PG8_STAGE(PG8_SB(0, 1), cB + hstep, voffB); PG8_STAGE(PG8_SA(0, 1), cA + hstep, voffA);
        if (wr == 1) PG8_BAR;
        PG8_WAIT_V(4); PG8_BAR;
        PG8_STAGE(PG8_SB(1, 0), cB + kstep, voffB); PG8_STAGE(PG8_SA(1, 0), cA + kstep, voffA); PG8_STAGE(PG8_SB(1, 1), cB + hstep + kstep, voffB);
        PG8_WAIT_V(6); PG8_BAR;
    }
    for (;;) {
        const bool has_next = S.next(ui + 1, nxt);
        const char* nA = has_next ? (const char*)g.A + (size_t)nxt.pm * tstep : cA; const char* nB = has_next ? (const char*)g.Bt + (size_t)nxt.pn * tstep : cB;
        for (int t = 0; t < nt; t += 2) {
            const bool last = (t == nt - 2);
            const char* a1 = cA + (size_t)(t + 1) * kstep;
            const char* a2 = last ? nA : cA + (size_t)(t + 2) * kstep; const char* b2 = last ? nB : cB + (size_t)(t + 2) * kstep;
            const char* a3 = a2 + kstep; const char* b3 = b2 + kstep;
            if (last && has_next) S.a_ready(nxt);
            if constexpr (SP2) {
            PG8_LDB(B0, 0, 0); PG8_LDB(B1, 0, 1); PG8_SCHED; PG8_LDA(At, 0, 0); PG8_STAGE(PG8_SA(1, 1), a1 + hstep, voffA);
            PG8_WAIT_V(8); PG8_WAIT_L(0); PG8_BAR; PG8_MMA(0, 0, At, B0); PG8_MMA(0, 1, At, B1); PG8_BAR; PG8_SCHED;
            PG8_LDA(At, 0, 1); PG8_STAGE(PG8_SB(0, 0), b2, voffB); PG8_STAGE(PG8_SB(0, 1), b2 + hstep, voffB); PG8_STAGE(PG8_SA(0, 0), a2, voffA);
            PG8_WAIT_V(8); PG8_WAIT_L(0); PG8_BAR; PG8_MMA(1, 0, At, B0); PG8_MMA(1, 1, At, B1); PG8_BAR; PG8_SCHED;
            PG8_LDB(B0, 1, 0); PG8_LDB(B1, 1, 1); PG8_SCHED; PG8_LDA(At, 1, 0); PG8_STAGE(PG8_SA(0, 1), a2 + hstep, voffA);
            PG8_WAIT_V(8); PG8_WAIT_L(0); PG8_BAR; PG8_MMA(0, 0, At, B0); PG8_MMA(0, 1, At, B1); PG8_BAR; PG8_SCHED;
            PG8_LDA(At, 1, 1); PG8_STAGE(PG8_SB(1, 0), b3, voffB); PG8_STAGE(PG8_SB(1, 1), b3 + hstep, voffB); PG8_STAGE(PG8_SA(1, 0), a3, voffA);
            PG8_WAIT_V(8); PG8_WAIT_L(0); PG8_BAR; PG8_MMA(1, 0, At, B0); PG8_MMA(1, 1, At, B1); PG8_BAR; PG8_SCHED;
            } else {
            PG8_LDB(B0, 0, 0); PG8_SCHED; PG8_LDA(At, 0, 0); PG8_STAGE(PG8_SA(1, 1), a1 + hstep, voffA);
            PG8_WAIT_L(8); PG8_BAR; PG8_WAIT_L(0); PG8_MMA(0, 0, At, B0); PG8_BAR; PG8_SCHED;
            PG8_LDB(B1, 0, 1); PG8_STAGE(PG8_SB(0, 0), b2, voffB);
            PG8_BAR; PG8_WAIT_L(0); PG8_MMA(0, 1, At, B1); PG8_BAR;
            PG8_LDA(At, 0, 1); PG8_STAGE(PG8_SA(0, 0), a2, voffA);
            PG8_BAR; PG8_WAIT_L(0); PG8_MMA(1, 0, At, B0); PG8_BAR; PG8_SCHED;
            PG8_STAGE(PG8_SB(0, 1), b2 + hstep, voffB);
            PG8_WAIT_V(6); PG8_BAR; PG8_MMA(1, 1, At, B1); PG8_BAR;
            PG8_LDB(B0, 1, 0); PG8_SCHED; PG8_LDA(At, 1, 0); PG8_STAGE(PG8_SA(0, 1), a2 + hstep, voffA);
            PG8_WAIT_L(8); PG8_BAR; PG8_WAIT_L(0); PG8_MMA(0, 0, At, B0); PG8_BAR; PG8_SCHED;
            PG8_LDB(B1, 1, 1); PG8_STAGE(PG8_SB(1, 0), b3, voffB);
            PG8_BAR; PG8_WAIT_L(0); PG8_MMA(0, 1, At, B1); PG8_BAR;
            PG8_LDA(At, 1, 1); PG8_STAGE(PG8_SA(1, 0), a3, voffA);
            PG8_BAR; PG8_WAIT_L(0); PG8_MMA(1, 0, At, B0); PG8_BAR; PG8_SCHED;
            PG8_STAGE(PG8_SB(1, 1), b3 + hstep, voffB);
            PG8_WAIT_V(6); PG8_BAR; PG8_MMA(1, 1, At, B1); PG8_BAR;
            }
        }
        if constexpr (ALIGN_EPI) { if (wr == 0) PG8_BAR; }
        if constexpr (!Epi::AFTER_DRAIN) { E(acc, cur, wr, wc, fr, fq); S.done(cur); }
        if (!has_next) break;
#pragma unroll
        for (int a = 0; a < 2; ++a)
#pragma unroll
            for (int b = 0; b < 2; ++b)
#pragma unroll
                for (int m = 0; m < 4; ++m)
#pragma unroll
                    for (int n = 0; n < 2; ++n) acc[a][b][m][n] = (f32x4){0.f, 0.f, 0.f, 0.f};
        cur = nxt; cA = nA; cB = nB; ++ui;
        if constexpr (ALIGN_EPI) { if (wr == 1) PG8_BAR; }
    }
    PG8_WAIT_V(0);
    if constexpr (!ALIGN_EPI) { if (wr == 0) PG8_BAR; }
    PG8_BAR;
    if constexpr (Epi::AFTER_DRAIN) { E.fused(acc, cur, wr, wc, fr, fq, lds, wid, lane); S.done(cur); }
#undef PG8_SA
#undef PG8_SB
#undef PG8_STAGE
#undef PG8_LDA
#undef PG8_LDB
#undef PG8_MMA
#undef PG8_WAIT_V
#undef PG8_WAIT_L
#undef PG8_BAR
#undef PG8_SCHED
}
}
constexpr int NWAVES = 8, NTHR = 512;
constexpr int BATCH = 4, SEQ = 4096, D = 1024, DEPTH = 4, H = 8, HD = 64, FF = 4096, NPROJ = 3328, RPROJ = 1792;
constexpr int M = BATCH * SEQ;
constexpr float GN_EPS = 64e-5f;
enum { I_X = 0, I_LN1, I_WIN, I_QG, I_KG, I_TSP, I_TSN, I_W0, I_W2, I_A0, I_A2, I_G2, I_KK, I_KA, I_RK, I_GNW, I_GNB, I_WOUT, I_LN2, I_WUP, I_WDN, N_IN };
constexpr size_t MiB = 1u << 20;
constexpr size_t WS_CTL = 0, CTL_ZERO_BYTES = 64 * 1024;
constexpr size_t WS_SS1 = 1 * MiB, WS_SS2 = 2 * MiB;
constexpr size_t WS_WIN = 3 * MiB, WS_WOUT = WS_WIN + (size_t)NPROJ * D * 2, WS_WUP = WS_WOUT + (size_t)D * D * 2, WS_WDN = WS_WUP + (size_t)FF * D * 2;
constexpr size_t WS_R0 = 28 * MiB;
constexpr size_t R_MIX = WS_R0 + 0 * MiB;
constexpr size_t R_V = WS_R0 + 32 * MiB;
constexpr size_t R_RR = WS_R0 + 48 * MiB, R_KR = WS_R0 + 64 * MiB, R_VR = WS_R0 + 80 * MiB, R_XL = WS_R0 + 96 * MiB;
constexpr size_t R_SD = R_RR;
constexpr size_t R_PRE = WS_R0 + 104 * MiB;
constexpr size_t R_HID = WS_R0;
constexpr size_t R_XB = WS_R0 + 128 * MiB;
constexpr size_t R_BN = WS_R0 + 232 * MiB;
constexpr size_t WS_END = WS_R0 + 233 * MiB;
constexpr size_t WS_LORA = WS_WDN + (size_t)D * FF * 2;
constexpr size_t WS_G2T = WS_LORA + 4 * 512 * 64 * 2;
static_assert(WS_G2T + 512 * 128 * 2 <= WS_R0, "lora");
constexpr int CW_BAR = 1024;
constexpr int RING_OFF = 0, RING_BYTES = 131072;
constexpr int LDSCTL_OFF = 155648, MISC_OFF = LDSCTL_OFF + 320;
constexpr int LDS_BYTES = 163840;
#define GAS __attribute__((address_space(1)))
#define LAS __attribute__((address_space(3)))
typedef unsigned short bf16;
typedef unsigned v4u __attribute__((ext_vector_type(4)));
typedef float f32x4 __attribute__((ext_vector_type(4)));
typedef short bf16x8 __attribute__((ext_vector_type(8)));
typedef GAS unsigned gu32;
typedef GAS unsigned long long gu64;
#define RLX_AGENT __ATOMIC_RELAXED, __HIP_MEMORY_SCOPE_AGENT
#define LDS_WAIT() asm volatile("s_waitcnt lgkmcnt(0)" ::: "memory")
#define VM_WAIT() asm volatile("s_waitcnt vmcnt(0)" ::: "memory")
__device__ __forceinline__ unsigned long long rt() { return __builtin_amdgcn_s_memrealtime(); }
__device__ __forceinline__ unsigned f2bf(float f) { unsigned u = __builtin_bit_cast(unsigned, f); return (u + 0x7fffu + ((u >> 16) & 1u)) >> 16; }
__device__ __forceinline__ unsigned pk2(float lo, float hi) { return f2bf(lo) | (f2bf(hi) << 16); }

#define XB_TMO      128
#define XB_XCNT(j)  (256  + 64 * (j))
#define XB_XSUB(j)  (1280 + 64 * (j))
#define XB_XGEN(j)  (2304 + 64 * (j))
#define XB_TOP      3328
#define XB_TOPGEN   3392
#define XCD_BAR_WORDS 3456
#define XB_SPIN_CAP (1u << 18)

__device__ __forceinline__ unsigned xb_ld(unsigned* p)              { return __hip_atomic_load(p, __ATOMIC_RELAXED, __HIP_MEMORY_SCOPE_AGENT); }
__device__ __forceinline__ unsigned xb_add(unsigned* p, unsigned v) { return __hip_atomic_fetch_add(p, v, __ATOMIC_RELAXED, __HIP_MEMORY_SCOPE_AGENT); }
__device__ __forceinline__ unsigned xb_xcc_id() { return (unsigned)__builtin_amdgcn_s_getreg((3 << 11) | 20) & 0xFu; }
#define XB_SPIN(cond, bar) do { unsigned _sp = 0; while (cond) { __builtin_amdgcn_s_sleep(1); \
    if ((++_sp & 255u) == 0u) { if (xb_ld(&(bar)[XB_TMO])) break; if (_sp > XB_SPIN_CAP) { atomicAdd(&(bar)[XB_TMO], 1u); break; } } } } while (0)

struct XcdBarrier {
    unsigned* bar; unsigned x;
    volatile LAS unsigned* st;
};

__device__ __forceinline__ XcdBarrier xcd_barrier_post(unsigned* bar, volatile LAS unsigned* st, bool tid0) {
    XcdBarrier b; b.bar = bar; b.x = xb_xcc_id(); b.st = st;
    if (tid0) (void)xb_add(&bar[XB_XCNT(b.x)], 1u);
    return b;
}
__device__ __forceinline__ void xcd_barrier_complete(unsigned* bar, unsigned x, unsigned& nloc, unsigned& nx) {
    const unsigned G = gridDim.x * gridDim.y * gridDim.z;
    unsigned sum, cnt, mine, sp = 0u;
    for (;;) {
        sum = 0u; cnt = 0u; mine = 0u;
#pragma unroll
        for (unsigned j = 0; j < 16; ++j) { const unsigned c = xb_ld(&bar[XB_XCNT(j)]); sum += c; cnt += (c > 0u) ? 1u : 0u; mine = (j == x) ? c : mine; }
        if (sum == G) break;
        __builtin_amdgcn_s_sleep(1);
        if ((++sp & 255u) == 0u) { if (xb_ld(&bar[XB_TMO])) break; if (sp > XB_SPIN_CAP) { atomicAdd(&bar[XB_TMO], 1u); break; } }
    }
    nloc = mine > 0u ? mine : 1u; nx = cnt > 0u ? cnt : 1u;
}

__device__ __forceinline__ void xcd_barrier(const XcdBarrier& b, bool tid0) {
    asm volatile("s_waitcnt vmcnt(0)" ::: "memory");
    __syncthreads();
    if (tid0) {
        unsigned* bar = b.bar; asm volatile("" : "+v"(bar));
        __builtin_amdgcn_s_waitcnt(0);
        unsigned nloc = b.st[0], nx = b.st[1];
        if (nloc == 0u) { xcd_barrier_complete(bar, b.x, nloc, nx); b.st[0] = nloc; b.st[1] = nx; }
        const unsigned old = xb_add(&bar[XB_XSUB(b.x)], 1u);
        const unsigned gen = old / nloc;
        if (old + 1u == (gen + 1u) * nloc) {
            __builtin_amdgcn_fence(__ATOMIC_RELEASE, "agent");
            asm volatile("s_waitcnt vmcnt(0)" ::: "memory");
            const unsigned og = xb_add(&bar[XB_TOP], 1u);
            const unsigned tg = og / nx;
            if (og + 1u == (tg + 1u) * nx) xb_add(&bar[XB_TOPGEN], 1u);
            else XB_SPIN(xb_ld(&bar[XB_TOPGEN]) == tg, bar);
            __builtin_amdgcn_fence(__ATOMIC_ACQUIRE, "agent");
            xb_add(&bar[XB_XGEN(b.x)], 1u);
            asm volatile("s_waitcnt vmcnt(0)" ::: "memory");
        } else {
            XB_SPIN(xb_ld(&bar[XB_XGEN(b.x)]) == gen, bar);
            __builtin_amdgcn_fence(__ATOMIC_ACQUIRE, "agent");
            asm volatile("s_waitcnt vmcnt(0)" ::: "memory");
        }
    }
    __syncthreads();
}
__device__ __forceinline__ float bf2f(bf16 v) { return __uint_as_float(((unsigned)v) << 16); }
__device__ __forceinline__ bf16 f2bf_s(float f) { return (bf16)f2bf(f); }
__device__ __forceinline__ float wave_sum(float v, int lane) {
#pragma unroll
    for (int o = 1; o < 64; o <<= 1) v += pg8::shx(v, o, lane);
    return v;
}
__device__ __forceinline__ float sigmoidf_(float z) { return 1.0f / (1.0f + __expf(-z)); }
__device__ __forceinline__ float tanh_fast(float x) { return 1.0f - 2.0f / (__expf(2.0f * x) + 1.0f); }

struct Args { const float* in[N_IN]; float* out; unsigned char* ws; };
typedef const __attribute__((address_space(4))) Args CArgs;
__device__ __forceinline__ const CArgs* kargs() { const CArgs* p = (const CArgs*)__builtin_amdgcn_kernarg_segment_ptr(); asm volatile("" : "+s"(p)); return p; }
__device__ __forceinline__ unsigned char* kws() { return kargs()->ws; }
__device__ __forceinline__ float* kout() { return kargs()->out; }
__device__ __forceinline__ const float* karg(int i) { return kargs()->in[i]; }
__device__ __forceinline__ int lane_id() { int l; asm volatile("v_mbcnt_lo_u32_b32 %0, -1, 0\n\tv_mbcnt_hi_u32_b32 %0, -1, %0" : "=v"(l)); return l; }
struct Frame {
    LAS unsigned char* lds;
    volatile LAS unsigned* MISC;
    gu32* ctl;
    int vcu, G, wv;
};

__device__ __forceinline__ float ushift(const bf16* buf, int ldc, int col, int row, int t, float sp, float sn) {
    const bf16* p = buf + (size_t)row * ldc + col;
    const float u0 = bf2f(p[0]);
    const float up = (t > 0) ? bf2f(p[-ldc]) : 0.f;
    const float un = (t < SEQ - 1) ? bf2f(p[ldc]) : 0.f;
    return u0 + sp * (up - u0) + sn * (un - u0);
}

__device__ __forceinline__ void transpose_item(const float* W, int K, int N, bf16* WT, const float* gain, bool headperm, LAS float* scr, int item, int lane) {
    const int nblk = N / 32, kb = item / nblk, nb = item % nblk, k0 = 64 * kb, n0 = 32 * nb;
#pragma unroll 8
    for (int i = 0; i < 32; ++i) { const int kk = 2 * i + (lane >> 5); float w = W[(size_t)(k0 + kk) * N + n0 + (lane & 31)]; if (gain) w *= gain[k0 + kk]; scr[kk * 33 + (lane & 31)] = w; }
    LDS_WAIT(); asm volatile("" ::: "memory");
    const int c = lane & 7;
    const int p0 = headperm ? ((n0 & ~255) + 128 * ((n0 >> 5) & 1) + 32 * ((n0 >> 6) & 3)) : n0;
#pragma unroll
    for (int j = 0; j < 4; ++j) { const int n = (lane >> 3) + 8 * j; const LAS float* s = scr + (8 * c) * 33 + n;
        v4u o; o.x = pk2(s[0 * 33], s[1 * 33]); o.y = pk2(s[2 * 33], s[3 * 33]); o.z = pk2(s[4 * 33], s[5 * 33]); o.w = pk2(s[6 * 33], s[7 * 33]);
        *(GAS v4u*)(WT + (size_t)(p0 + n) * K + k0 + 8 * c) = o; }
    LDS_WAIT(); asm volatile("" ::: "memory");
}
__device__ __forceinline__ void wconv_phase(Frame& F, int layer) {
    unsigned char* const ws = kws();
    int lane_ = lane_id(); asm volatile("" : "+v"(lane_)); int wave_o = F.wv; asm volatile("" : "+s"(wave_o)); const int wave_ = wave_o, tid_ = wave_ * 64 + lane_;
    LAS float* scr = (LAS float*)(F.lds + RING_OFF + wave_ * 16384);
    const int gw = F.vcu * NWAVES + wave_, NGW = F.G * NWAVES;
    constexpr int I_1 = (D / 64) * (NPROJ / 32), I_2 = (D / 64) * (D / 32), I_3 = (D / 64) * (FF / 32), I_4 = (FF / 64) * (D / 32);
    const float* win = karg(I_WIN) + (size_t)layer * D * NPROJ; const float* wout = karg(I_WOUT) + (size_t)layer * D * D;
    const float* wup = karg(I_WUP) + (size_t)layer * D * FF; const float* wdn = karg(I_WDN) + (size_t)layer * FF * D;
    const float* g1 = karg(I_LN1) + layer * D; const float* g2 = karg(I_LN2) + layer * D;
    for (int it = gw; it < I_1 + I_2 + I_3 + I_4 + 96; it += NGW) {
        int r = it;
        if (r < I_1) { transpose_item(win, D, NPROJ, (bf16*)(ws + WS_WIN), g1, true, scr, r, lane_); continue; } r -= I_1;
        if (r < I_2) { transpose_item(wout, D, D, (bf16*)(ws + WS_WOUT), nullptr, false, scr, r, lane_); continue; } r -= I_2;
        if (r < I_3) { transpose_item(wup, D, FF, (bf16*)(ws + WS_WUP), g2, false, scr, r, lane_); continue; } r -= I_3;
        if (r < I_4) { transpose_item(wdn, FF, D, (bf16*)(ws + WS_WDN), nullptr, false, scr, r, lane_); continue; } r -= I_4;
        { const int mat = r >> 4, it16 = r & 15;
          const float* src = (mat < 2 ? karg(I_W2) : karg(I_A2)) + (size_t)(layer * 2 + (mat & 1)) * 64 * 512;
          if (mat < 4) transpose_item(src, 64, 512, (bf16*)(ws + WS_LORA) + (size_t)mat * 512 * 64, nullptr, false, scr, it16, lane_);
          else transpose_item(karg(I_G2) + (size_t)layer * 128 * 512, 128, 512, (bf16*)(ws + WS_G2T), nullptr, false, scr, r - 64, lane_); }
    }
}
__device__ __forceinline__ void x_prologue(Frame& F) {
    unsigned char* const ws = kws();
    int lane_ = lane_id(); asm volatile("" : "+v"(lane_)); int wave_o = F.wv; asm volatile("" : "+s"(wave_o)); const int wave_ = wave_o, tid_ = wave_ * 64 + lane_;
    const int gw = F.vcu * NWAVES + wave_, NGW = F.G * NWAVES;
    const float* x = karg(I_X); bf16* xb = (bf16*)(ws + R_XB); float* ss = (float*)(ws + WS_SS1);
    for (int m = gw; m < M; m += NGW) {
        const GAS f32x4* xr = (const GAS f32x4*)(x + (size_t)m * D) + lane_; GAS f32x4* orow = (GAS f32x4*)(kout() + (size_t)m * D) + lane_;
        GAS unsigned long long* o8 = (GAS unsigned long long*)(xb + (size_t)m * D) + lane_;
        float s = 0.f;
#pragma unroll
        for (int j = 0; j < 4; ++j) { const f32x4 v = xr[64 * j]; orow[64 * j] = v; s += (v.x * v.x + v.y * v.y) + (v.z * v.z + v.w * v.w);
            o8[64 * j] = (unsigned long long)pk2(v.x, v.y) | ((unsigned long long)pk2(v.z, v.w) << 32); }
        s = wave_sum(s, lane_);
        if (lane_ < 16) ss[(size_t)m * 16 + lane_] = (lane_ == 0) ? s : 0.f;
    }
}

__device__ __forceinline__ void attn_naive(Frame& F, int layer, int aw, int naw) {
    unsigned char* const ws = kws();
    int lane_ = lane_id(); asm volatile("" : "+v"(lane_)); int wave_o = F.wv; asm volatile("" : "+s"(wave_o)); const int wave_ = wave_o, tid_ = wave_ * 64 + lane_;
    bf16* MIX = (bf16*)(ws + R_MIX); const bf16* Q = MIX; const bf16* K = MIX + 512; const bf16* V = (const bf16*)(ws + R_V);
    LAS float* qs = (LAS float*)(F.lds + RING_OFF + wave_ * 4096); LAS float* pb = qs + 64;
    float bound;
    { const float* qg = karg(I_QG) + layer * HD; const float* kg = karg(I_KG) + layer * HD; float mq = 0.f, mk = 0.f;
      for (int i = 0; i < HD; ++i) { mq = fmaxf(mq, fabsf(qg[i])); mk = fmaxf(mk, fabsf(kg[i])); }
      bound = 8.0f * mq * mk + 0.25f; }
    const int lane = lane_;
    for (int unit = aw; unit < BATCH * H * SEQ; unit += naw) {
        const int t = unit % SEQ, bh = unit / SEQ, h = bh % H, b = bh / H; const size_t row = (size_t)b * SEQ + t;
        qs[lane] = bf2f(Q[row * 1024 + h * HD + lane]);
        LDS_WAIT(); asm volatile("" ::: "memory");
        float qv[HD];
#pragma unroll
        for (int i = 0; i < HD; ++i) qv[i] = qs[i];
        const float slope = exp2f(-(float)(h + 1));
        float lsum = 0.f;
        for (int bi = 0; bi < 3; ++bi) { const int d = 1 << (2 * bi);
            for (int pass = 0; pass < 3; ++pass) { const int jj = pass * 64 + lane; const bool act = jj <= 128; const int j = jj - 64; const int pos = t + j * d; const bool valid = act && pos >= 0 && pos < SEQ;
                float p = 0.f;
                if (valid) { const v4u* kr = (const v4u*)(K + ((size_t)b * SEQ + pos) * 1024 + h * HD); float dot = 0.f;
#pragma unroll
                    for (int c = 0; c < 8; ++c) { const v4u w = kr[c];
                        dot += qv[8 * c + 0] * __uint_as_float(w.x << 16) + qv[8 * c + 1] * __uint_as_float(w.x & 0xffff0000u) + qv[8 * c + 2] * __uint_as_float(w.y << 16) + qv[8 * c + 3] * __uint_as_float(w.y & 0xffff0000u)
                             + qv[8 * c + 4] * __uint_as_float(w.z << 16) + qv[8 * c + 5] * __uint_as_float(w.z & 0xffff0000u) + qv[8 * c + 6] * __uint_as_float(w.w << 16) + qv[8 * c + 7] * __uint_as_float(w.w & 0xffff0000u); }
                    const float s = dot - slope * fabsf((float)(j * d)); p = __expf(s - bound); }
                if (act) pb[bi * 129 + jj] = p;
                lsum += p; } }
        lsum = wave_sum(lsum, lane_);
        LDS_WAIT(); asm volatile("" ::: "memory");
        float o = 0.f;
        for (int bi = 0; bi < 3; ++bi) { const int d = 1 << (2 * bi);
            for (int jj = 0; jj < 129; ++jj) { const float p = pb[bi * 129 + jj];
                if (p != 0.f) { const int pos = t + (jj - 64) * d; o += p * bf2f(V[((size_t)b * SEQ + pos) * 512 + h * HD + lane]); } } }
        MIX[row * 1024 + h * HD + lane] = f2bf_s(o / lsum);
        LDS_WAIT(); asm volatile("" ::: "memory");
    }
}

typedef float f32x16 __attribute__((ext_vector_type(16)));
typedef short s16x4 __attribute__((ext_vector_type(4)));
typedef short v4i16_t __attribute__((ext_vector_type(4)));
typedef unsigned u32x2_t __attribute__((ext_vector_type(2)));
typedef float f32x2_t __attribute__((ext_vector_type(2))); typedef __bf16 bf16x2_t __attribute__((ext_vector_type(2)));
__device__ __forceinline__ unsigned cvtpk(float lo, float hi) { f32x2_t v = {lo, hi}; bf16x2_t b = __builtin_convertvector(v, bf16x2_t); return __builtin_bit_cast(unsigned, b); }
typedef _Float16 h16x2_t __attribute__((ext_vector_type(2))); typedef _Float16 h16x8 __attribute__((ext_vector_type(8)));
__device__ __forceinline__ unsigned cvtpk_h(float lo, float hi) { f32x2_t v = {lo, hi}; h16x2_t b = __builtin_convertvector(v, h16x2_t); return __builtin_bit_cast(unsigned, b); }
__device__ __forceinline__ f32x2_t unpk_h(unsigned w) { return __builtin_convertvector(__builtin_bit_cast(h16x2_t, w), f32x2_t); }
#define MFMA32H(nf, mf, acc) __builtin_amdgcn_mfma_f32_32x32x16_f16(__builtin_bit_cast(h16x8, (nf)), __builtin_bit_cast(h16x8, (mf)), (acc), 0, 0, 0)
constexpr int TSB = 144, TILE_B = 64 * TSB;
constexpr int PRE_TW = 14 * TILE_B, PRE_XA = 15 * TILE_B, PRE_INVN = 16 * TILE_B, PRE_GC = PRE_INVN + 256, PRE_BON = PRE_GC + 512, PRE_LDS_END = PRE_BON + 1024;
static_assert(PRE_LDS_END <= LDSCTL_OFF, "PRE LDS map");
__device__ __forceinline__ bf16x8 frag_row(const LAS unsigned char* tile, int row, int ks, int hi) {
    return *(const LAS bf16x8*)(tile + row * TSB + (16 * ks + 8 * hi) * 2);
}
__device__ __forceinline__ s16x4 tr4(const LAS unsigned char* p) { return __builtin_bit_cast(s16x4, __builtin_amdgcn_ds_read_tr16_b64_v4i16((LAS v4i16_t*)p)); }
__device__ __forceinline__ bf16x8 frag_tr(const LAS unsigned char* tile, int idx0, int ks, int lane) {
    const int hi = lane >> 5, g1 = (lane >> 4) & 1, i = lane & 15;
    const LAS unsigned char* p = tile + (16 * ks + 8 * hi + (i >> 2)) * TSB + (idx0 + 16 * g1 + 4 * (i & 3)) * 2;
    const s16x4 lo = tr4(p), h4 = tr4(p + 4 * TSB);
    return (bf16x8){lo[0], lo[1], lo[2], lo[3], h4[0], h4[1], h4[2], h4[3]};
}
__device__ __forceinline__ void store_quad(LAS unsigned char* tile, int row, int n0, int hi, const f32x16& a) {
#pragma unroll
    for (int q = 0; q < 4; ++q) { u32x2_t w; w.x = cvtpk(a[4 * q], a[4 * q + 1]); w.y = cvtpk(a[4 * q + 2], a[4 * q + 3]); *(LAS u32x2_t*)(tile + row * TSB + (n0 + 8 * q + 4 * hi) * 2) = w; }
}
__device__ __forceinline__ void store_quad_h(LAS unsigned char* tile, int row, int n0, int hi, const f32x16& a) {
#pragma unroll
    for (int q = 0; q < 4; ++q) { u32x2_t w; w.x = cvtpk_h(a[4 * q], a[4 * q + 1]); w.y = cvtpk_h(a[4 * q + 2], a[4 * q + 3]); *(LAS u32x2_t*)(tile + row * TSB + (n0 + 8 * q + 4 * hi) * 2) = w; }
}
__device__ __forceinline__ f32x16 load_quad(const LAS unsigned char* tile, int row, int n0, int hi) {
    f32x16 a;
#pragma unroll
    for (int q = 0; q < 4; ++q) { const u32x2_t w = *(const LAS u32x2_t*)(tile + row * TSB + (n0 + 8 * q + 4 * hi) * 2);
        a[4 * q] = __uint_as_float(w.x << 16); a[4 * q + 1] = __uint_as_float(w.x & 0xffff0000u); a[4 * q + 2] = __uint_as_float(w.y << 16); a[4 * q + 3] = __uint_as_float(w.y & 0xffff0000u); }
    return a;
}
#define MFMA32(nf, mf, acc) __builtin_amdgcn_mfma_f32_32x32x16_bf16((nf), (mf), (acc), 0, 0, 0)
#define WG_BAR() do { asm volatile("s_waitcnt vmcnt(0) lgkmcnt(0)" ::: "memory"); __builtin_amdgcn_s_barrier(); asm volatile("" ::: "memory"); } while (0)
__device__ __forceinline__ void shift8(const bf16* buf, int ldc, int col, int row, int t, const float* sp, const float* sn, float (&out)[8]) {
    const bf16* p = buf + (size_t)row * ldc + col;
    const v4u c = *(const v4u*)p; v4u pv = (v4u){0u, 0u, 0u, 0u}, nv = (v4u){0u, 0u, 0u, 0u};
    if (t > 0) pv = *(const v4u*)(p - ldc);
    if (t < SEQ - 1) nv = *(const v4u*)(p + ldc);
    const f32x4 sp0 = *(const f32x4*)sp, sp1 = *(const f32x4*)(sp + 4), sn0 = *(const f32x4*)sn, sn1 = *(const f32x4*)(sn + 4);
#pragma unroll
    for (int j = 0; j < 8; ++j) { const unsigned cw = c[j >> 1], pw = pv[j >> 1], nw = nv[j >> 1];
        const float u0 = (j & 1) ? __uint_as_float(cw & 0xffff0000u) : __uint_as_float(cw << 16), up = (j & 1) ? __uint_as_float(pw & 0xffff0000u) : __uint_as_float(pw << 16), un = (j & 1) ? __uint_as_float(nw & 0xffff0000u) : __uint_as_float(nw << 16);
        const float a = (j < 4) ? sp0[j & 3] : sp1[j & 3], bq = (j < 4) ? sn0[j & 3] : sn1[j & 3];
        out[j] = u0 + a * (up - u0) + bq * (un - u0); }
}
__device__ __forceinline__ f32x4 shift4(const bf16* buf, int ldc, int col, int row, int t, const float* sp, const float* sn) {
    const bf16* p = buf + (size_t)row * ldc + col;
    const u32x2_t c = *(const u32x2_t*)p; u32x2_t pv = (u32x2_t){0u, 0u}, nv = (u32x2_t){0u, 0u};
    if (t > 0) pv = *(const u32x2_t*)(p - ldc);
    if (t < SEQ - 1) nv = *(const u32x2_t*)(p + ldc);
    const f32x4 a = *(const f32x4*)sp, bq = *(const f32x4*)sn;
    const f32x4 u0 = (f32x4){__uint_as_float(c.x << 16), __uint_as_float(c.x & 0xffff0000u), __uint_as_float(c.y << 16), __uint_as_float(c.y & 0xffff0000u)};
    const f32x4 up = (f32x4){__uint_as_float(pv.x << 16), __uint_as_float(pv.x & 0xffff0000u), __uint_as_float(pv.y << 16), __uint_as_float(pv.y & 0xffff0000u)};
    const f32x4 un = (f32x4){__uint_as_float(nv.x << 16), __uint_as_float(nv.x & 0xffff0000u), __uint_as_float(nv.y << 16), __uint_as_float(nv.y & 0xffff0000u)};
    return u0 + a * (up - u0) + bq * (un - u0);
}

__device__ __forceinline__ void rwkv_pre_phase(Frame& F, int layer) {
    unsigned char* const ws = kws();
    int lane_ = lane_id(); asm volatile("" : "+v"(lane_)); int wave_o = F.wv; asm volatile("" : "+s"(wave_o)); const int wave_ = wave_o, tid_ = wave_ * 64 + lane_;
    const int d = wave_ >> 2, qm = (wave_ >> 1) & 1, qn = wave_ & 1, m0 = 32 * qm, n0 = 32 * qn;
#define LANE_VARS int lane = lane_; asm volatile("" : "+v"(lane)); const int hi = lane >> 5, l31 = lane & 31, mrow = m0 + l31; (void)hi; (void)l31; (void)mrow;
    LAS unsigned char* const L = F.lds;
    LAS unsigned char* const T0 = L + (d * 7 + 0) * TILE_B; LAS unsigned char* const T1 = L + (d * 7 + 1) * TILE_B; LAS unsigned char* const T2 = L + (d * 7 + 2) * TILE_B; LAS unsigned char* const T3 = L + (d * 7 + 3) * TILE_B;
    LAS unsigned char* const T4 = L + (d * 7 + 4) * TILE_B; LAS unsigned char* const T5 = L + (d * 7 + 5) * TILE_B; LAS unsigned char* const T6 = L + (d * 7 + 6) * TILE_B;
    LAS unsigned char* const TWt = L + PRE_TW; LAS unsigned char* const XAt = L + PRE_XA;
    LAS float* const invn = (LAS float*)(L + PRE_INVN); LAS float* const gcs = (LAS float*)(L + PRE_GC) + d * 64; LAS float* const bon = (LAS float*)(L + PRE_BON);
    const bf16* Rr = (const bf16*)(ws + R_RR); const bf16* Kr = (const bf16*)(ws + R_KR); const bf16* Vr = (const bf16*)(ws + R_VR); const bf16* XL = (const bf16*)(ws + R_XL);
    const bf16* W2T = (const bf16*)(ws + WS_LORA) + (size_t)d * 512 * 64; const bf16* A2T = (const bf16*)(ws + WS_LORA) + (size_t)(2 + d) * 512 * 64;
    float* BN = (float*)(ws + R_BN) + (size_t)d * M * 8;
    const float* sp = karg(I_TSP) + layer * RPROJ; const float* sn = karg(I_TSN) + layer * RPROJ;
    const float* w0 = karg(I_W0) + (layer * 2 + d) * 512; const float* a0 = karg(I_A0) + (layer * 2 + d) * 512;
    const float* kkp = karg(I_KK) + layer * 512; const float* kap = karg(I_KA) + layer * 512; const float* rkp = karg(I_RK) + layer * 512;
    for (int item = F.vcu; item < BATCH * H * (SEQ / 64); item += F.G) {
        const int cn = item & 63, h = (item >> 6) & 7, b = item >> 9, t0 = cn * 64, hc = h * HD;
#define SNAT (d ? 63 - mrow : mrow)
        { LANE_VARS; const int tidl = wave_ * 64 + lane; const int tok = tidl >> 3, oct = tidl & 7, t = t0 + tok, row = b * SEQ + t; float v8[8];
          shift8(XL, 256, 8 * oct, row, t, sp + 1536 + 8 * oct, sn + 1536 + 8 * oct, v8);
          { v4u w; w.x = cvtpk(tanh_fast(v8[0]), tanh_fast(v8[1])); w.y = cvtpk(tanh_fast(v8[2]), tanh_fast(v8[3])); w.z = cvtpk(tanh_fast(v8[4]), tanh_fast(v8[5])); w.w = cvtpk(tanh_fast(v8[6]), tanh_fast(v8[7])); *(LAS v4u*)(TWt + tok * TSB + 16 * oct) = w; }
          shift8(XL, 256, 64 + 8 * oct, row, t, sp + 1600 + 8 * oct, sn + 1600 + 8 * oct, v8);
          { v4u w; w.x = cvtpk(v8[0], v8[1]); w.y = cvtpk(v8[2], v8[3]); w.z = cvtpk(v8[4], v8[5]); w.w = cvtpk(v8[6], v8[7]); *(LAS v4u*)(XAt + tok * TSB + 16 * oct) = w; }
          shift8(Kr, 512, hc + 8 * oct, row, t, sp + 512 + hc + 8 * oct, sn + 512 + hc + 8 * oct, v8);
          const f32x4 k0 = *(const f32x4*)(kkp + hc + 8 * oct), k1 = *(const f32x4*)(kkp + hc + 8 * oct + 4); float ssq = 0.f;
#pragma unroll
          for (int j = 0; j < 8; ++j) { const float kx = v8[j] * ((j < 4) ? k0[j & 3] : k1[j & 3]); ssq += kx * kx; }
          ssq += pg8::shx(ssq, 1, lane); ssq += pg8::shx(ssq, 2, lane); ssq += pg8::shx(ssq, 4, lane);
          if (oct == 0) invn[tok] = 1.0f / sqrtf(ssq + 1e-12f); }
        WG_BAR();
        f32x16 zw, za, lw, av, cum;
        { LANE_VARS; const int snat = SNAT;
#pragma unroll
        for (int r = 0; r < 16; ++r) { zw[r] = 0.f; za[r] = 0.f; }
#pragma unroll
        for (int ks = 0; ks < 4; ++ks) { const size_t wo = (size_t)(hc + n0 + l31) * 64 + 16 * ks + 8 * hi;
            const bf16x8 wf = *(const bf16x8*)(W2T + wo), af = *(const bf16x8*)(A2T + wo);
            zw = MFMA32(wf, frag_row(TWt, snat, ks, hi), zw); za = MFMA32(af, frag_row(XAt, snat, ks, hi), za); }
#pragma unroll
        for (int q = 0; q < 4; ++q) { const f32x4 w0v = *(const f32x4*)(w0 + hc + n0 + 8 * q + 4 * hi), a0v = *(const f32x4*)(a0 + hc + n0 + 8 * q + 4 * hi);
#pragma unroll
            for (int i = 0; i < 4; ++i) { lw[4 * q + i] = -0.6065306597f * sigmoidf_(zw[4 * q + i] + w0v[i]); av[4 * q + i] = sigmoidf_(za[4 * q + i] + a0v[i]); } }
        { f32x16 lh, ll;
#pragma unroll
          for (int r = 0; r < 16; ++r) { lh[r] = __uint_as_float(cvtpk(lw[r], 0.f) << 16); ll[r] = lw[r] - lh[r]; }
          store_quad(T4, mrow, n0, hi, lh); store_quad(T5, mrow, n0, hi, ll); } }
        WG_BAR();
        { LANE_VARS;
#pragma unroll
        for (int r = 0; r < 16; ++r) cum[r] = 0.f;
#pragma unroll
        for (int ks = 0; ks < 4; ++ks) { bf16x8 tf;
#pragma unroll
            for (int j = 0; j < 8; ++j) tf[j] = (16 * ks + 8 * hi + j <= mrow) ? (short)0x3f80 : (short)0;
            cum = MFMA32(frag_tr(T4, n0, ks, lane), tf, cum); cum = MFMA32(frag_tr(T5, n0, ks, lane), tf, cum); } }
        f32x16 rh, kc, mrk;
        { LANE_VARS; const int snat = SNAT; const int tnat = t0 + snat, row = b * SEQ + tnat; const float inv = invn[snat];
          float bsum = 0.f;
#pragma unroll
          for (int q = 0; q < 4; ++q) { const int cg = hc + n0 + 8 * q + 4 * hi;
              const f32x4 r4 = shift4(Rr, 512, cg, row, tnat, sp + cg, sn + cg), k4 = shift4(Kr, 512, cg, row, tnat, sp + 512 + cg, sn + 512 + cg);
              const f32x4 kk4 = *(const f32x4*)(kkp + cg), ka4 = *(const f32x4*)(kap + cg), rk4 = *(const f32x4*)(rkp + cg);
              float kh4[4], bc4[4], rl4[4], kl4[4];
#pragma unroll
              for (int i = 0; i < 4; ++i) { const int e = 4 * q + i; const float a = av[e], cs = cum[e];
                  const float g = __expf(cs), gx = __expf(cs - lw[e]), gi = __expf(-cs);
                  const float kkn = k4[i] * kk4[i] * inv, kt = k4[i] * (1.0f + (a - 1.0f) * ka4[i]);
                  kh4[i] = gx * kkn; rh[e] = g * r4[i]; bc4[i] = a * kkn * gi; kc[e] = kt * gi; bsum += r4[i] * kt * rk4[i];
                  rl4[i] = rh[e] - __uint_as_float(cvtpk(rh[e], 0.f) << 16); kl4[i] = kc[e] - __uint_as_float(cvtpk(kc[e], 0.f) << 16);
                  if (mrow == 63) gcs[n0 + 8 * q + 4 * hi + i] = g; }
              const int off = mrow * TSB + (n0 + 8 * q + 4 * hi) * 2; u32x2_t w;
              w.x = cvtpk(kh4[0], kh4[1]); w.y = cvtpk(kh4[2], kh4[3]); *(LAS u32x2_t*)(T0 + off) = w;
              w.x = cvtpk(rh[4 * q], rh[4 * q + 1]); w.y = cvtpk(rh[4 * q + 2], rh[4 * q + 3]); *(LAS u32x2_t*)(T1 + off) = w;
              w.x = cvtpk(bc4[0], bc4[1]); w.y = cvtpk(bc4[2], bc4[3]); *(LAS u32x2_t*)(T2 + off) = w;
              w.x = cvtpk(kc[4 * q], kc[4 * q + 1]); w.y = cvtpk(kc[4 * q + 2], kc[4 * q + 3]); *(LAS u32x2_t*)(T3 + off) = w;
              w.x = cvtpk(rl4[0], rl4[1]); w.y = cvtpk(rl4[2], rl4[3]); *(LAS u32x2_t*)(T4 + off) = w;
              w.x = cvtpk(kl4[0], kl4[1]); w.y = cvtpk(kl4[2], kl4[3]); *(LAS u32x2_t*)(T5 + off) = w; }
          bsum += pg8::shx(bsum, 32, lane);
          if (hi == 0) bon[(d * 2 + qn) * 64 + snat] = bsum; }
        WG_BAR();
        { LANE_VARS; const int snat = SNAT; if (qn == 0 && hi == 0) BN[(size_t)(b * SEQ + t0 + snat) * 8 + h] = bon[(d * 2) * 64 + snat] + bon[(d * 2 + 1) * 64 + snat]; }
        { LANE_VARS;
#pragma unroll
          for (int r = 0; r < 16; ++r) mrk[r] = 0.f;
#pragma unroll
          for (int ks = 0; ks < 4; ++ks) { const bf16x8 rhi = frag_row(T1, mrow, ks, hi), khi = frag_row(T3, n0 + l31, ks, hi);
              mrk = MFMA32(khi, rhi, mrk); mrk = MFMA32(frag_row(T5, n0 + l31, ks, hi), rhi, mrk); mrk = MFMA32(khi, frag_row(T4, mrow, ks, hi), mrk); }
#pragma unroll
          for (int q = 0; q < 4; ++q)
#pragma unroll
              for (int i = 0; i < 4; ++i) { const int e = 4 * q + i, n = n0 + 8 * q + 4 * hi + i; mrk[e] = (n <= mrow) ? mrk[e] : 0.f; } }
        WG_BAR();
        { LANE_VARS; f32x16 x, mk, zz;
          float z0 = 0.f; asm volatile("" : "+v"(z0));
#pragma unroll
          for (int r = 0; r < 16; ++r) { x[r] = 0.f; mk[r] = 0.f; zz[r] = z0; }
#pragma unroll
          for (int ks = 0; ks < 4; ++ks) { const bf16x8 mf = frag_row(T0, mrow, ks, hi);
              x = MFMA32(frag_row(T2, n0 + l31, ks, hi), mf, x); mk = MFMA32(frag_row(T3, n0 + l31, ks, hi), mf, mk); }
#pragma unroll
          for (int q = 0; q < 4; ++q)
#pragma unroll
              for (int i = 0; i < 4; ++i) { const int e = 4 * q + i, n = n0 + 8 * q + 4 * hi + i; const bool lo = n < mrow; x[e] = lo ? -x[e] : 0.f; mk[e] = lo ? mk[e] : 0.f; }
          store_quad(T4, mrow, n0, hi, x); store_quad(T5, mrow, n0, hi, zz); store_quad(T6, mrow, n0, hi, mk); }
        WG_BAR();
        if ((wave_ & 3) == 0) { LANE_VARS; const int blk = lane >> 4, c = lane & 15; float t[16];
#pragma unroll
            for (int r = 0; r < 16; ++r) { const LAS unsigned char* xr = T4 + (16 * blk + r) * TSB + 32 * blk; const v4u w0_ = *(const LAS v4u*)xr, w1_ = *(const LAS v4u*)(xr + 16);
                float acc0 = (r == c) ? 1.0f : 0.f, acc1 = 0.f;
#pragma unroll
                for (int j = 0; j < r; ++j) { const unsigned w = (j < 8) ? w0_[j >> 1] : w1_[(j - 8) >> 1]; const float xv = (j & 1) ? __uint_as_float(w & 0xffff0000u) : __uint_as_float(w << 16);
                    if (j & 1) acc1 += xv * t[j]; else acc0 += xv * t[j]; }
                t[r] = acc0 + acc1; }
#pragma unroll
            for (int r = 0; r < 16; ++r) *(LAS unsigned short*)(T5 + (16 * blk + r) * TSB + (16 * blk + c) * 2) = (unsigned short)(cvtpk(t[r], 0.f) & 0xffffu); }
        WG_BAR();
        { LANE_VARS; LAS unsigned char* const scr = qm ? T5 : T4;
          if (qm == qn) {
              f32x16 w;
#pragma unroll
              for (int r = 0; r < 16; ++r) w[r] = 0.f;
              bf16x8 mf = frag_row(T4, m0 + l31, 2 * qm, hi);
              if (l31 < 16) mf = (bf16x8){0, 0, 0, 0, 0, 0, 0, 0};
              w = MFMA32(frag_tr(T5, m0, 2 * qm, lane), mf, w);
              store_quad(scr, l31, 32, hi, w); } }
        WG_BAR();
        { LANE_VARS; LAS unsigned char* const scr = qm ? T5 : T4;
          if (qm == qn) {
              f32x16 tq = load_quad(T5, mrow, m0, hi);
#pragma unroll
              for (int ks = 0; ks < 2; ++ks) tq = MFMA32(frag_tr(scr, 32, ks, lane), frag_row(T5, mrow, 2 * qm + ks, hi), tq);
              store_quad(T5, mrow, m0, hi, tq); } }
        WG_BAR();
        { LANE_VARS;
          if (qm == 1 && qn == 0) {
              f32x16 w;
#pragma unroll
              for (int r = 0; r < 16; ++r) w[r] = 0.f;
#pragma unroll
              for (int ks = 0; ks < 2; ++ks) w = MFMA32(frag_tr(T5, 0, ks, lane), frag_row(T4, 32 + l31, ks, hi), w);
              store_quad(T4, l31, 32, hi, w); }
          if (qm == 0 && qn == 1) { f32x16 zz; float z0 = 0.f; asm volatile("" : "+v"(z0));
#pragma unroll
              for (int r = 0; r < 16; ++r) zz[r] = z0;
              store_quad(T5, l31, 32, hi, zz); } }
        WG_BAR();
        { LANE_VARS;
          if (qm == 1 && qn == 0) {
              f32x16 t21;
#pragma unroll
              for (int r = 0; r < 16; ++r) t21[r] = 0.f;
#pragma unroll
              for (int ks = 0; ks < 2; ++ks) t21 = MFMA32(frag_tr(T4, 32, ks, lane), frag_row(T5, 32 + l31, 2 + ks, hi), t21);
              store_quad(T5, 32 + l31, 0, hi, t21); } }
        WG_BAR();
        { LANE_VARS; f32x16 kp, tk;
#pragma unroll
          for (int r = 0; r < 16; ++r) { kp[r] = 0.f; tk[r] = 0.f; }
#pragma unroll
          for (int ks = 0; ks < 4; ++ks) { const bf16x8 mf = frag_row(T5, mrow, ks, hi);
              kp = MFMA32(frag_tr(T0, n0, ks, lane), mf, kp); tk = MFMA32(frag_tr(T6, n0, ks, lane), mf, tk); }
          WG_BAR();
          store_quad(T0, mrow, n0, hi, kp); store_quad(T6, mrow, n0, hi, tk); }
        { LANE_VARS; f32x16 rb;
#pragma unroll
          for (int r = 0; r < 16; ++r) rb[r] = 0.f;
#pragma unroll
          for (int ks = 0; ks < 4; ++ks) rb = MFMA32(frag_row(T2, n0 + l31, ks, hi), frag_row(T1, mrow, ks, hi), rb);
#pragma unroll
          for (int q = 0; q < 4; ++q)
#pragma unroll
              for (int i = 0; i < 4; ++i) { const int e = 4 * q + i, n = n0 + 8 * q + 4 * hi + i; rb[e] = (n <= mrow) ? rb[e] : 0.f; }
          store_quad(T4, mrow, n0, hi, rb); }
        WG_BAR();
        const int cd = d ? 63 - cn : cn;
        bf16* const pre = (bf16*)(ws + R_PRE) + ((size_t)(((b * 8 + h) * 2 + d) * 64 + cd)) * 16384;
        { LANE_VARS; f32x16 rp, ml, pm, kq;
#pragma unroll
          for (int r = 0; r < 16; ++r) { rp[r] = 0.f; ml[r] = 0.f; pm[r] = 0.f; kq[r] = 0.f; }
#pragma unroll
          for (int ks = 0; ks < 4; ++ks) { const bf16x8 mrbf = frag_row(T4, mrow, ks, hi), khn = frag_tr(T0, n0, ks, lane), bcn = frag_tr(T2, n0, ks, lane);
              rp = MFMA32(khn, mrbf, rp); ml = MFMA32(frag_tr(T6, n0, ks, lane), mrbf, ml);
              pm = MFMA32(khn, frag_tr(T2, m0, ks, lane), pm); kq = MFMA32(bcn, frag_tr(T6, m0, ks, lane), kq); }
          const float gm = gcs[mrow];
#pragma unroll
          for (int q = 0; q < 4; ++q)
#pragma unroll
              for (int i = 0; i < 4; ++i) { const int e = 4 * q + i, n = n0 + 8 * q + 4 * hi + i;
                  rp[e] = rh[e] - rp[e]; ml[e] = mrk[e] - ml[e]; pm[e] = gm * (((n == mrow) ? 1.0f : 0.f) - pm[e]); kq[e] = (kc[e] - kq[e]) * gcs[n]; }
#pragma unroll
          for (int q = 0; q < 4; ++q) { const int pc = n0 + 16 * (q >> 1) + 8 * hi + 4 * (q & 1);
              u32x2_t w; w.x = cvtpk_h(pm[4 * q], pm[4 * q + 1]); w.y = cvtpk_h(pm[4 * q + 2], pm[4 * q + 3]); *(u32x2_t*)(pre + mrow * 64 + pc) = w;
              w.x = cvtpk_h(rp[4 * q], rp[4 * q + 1]); w.y = cvtpk_h(rp[4 * q + 2], rp[4 * q + 3]); *(u32x2_t*)(pre + 4096 + (d ? 63 - mrow : mrow) * 64 + pc) = w; }
          WG_BAR();
          store_quad_h(T4, mrow, n0, hi, ml); store_quad_h(T5, mrow, n0, hi, kq); }
        { LANE_VARS; const int tt = (wave_ * 64 + lane) & 255, s = tt >> 2, cg4 = (tt & 3) * 16, sn_ = d ? 63 - s : s, t = t0 + sn_, row = b * SEQ + t; float v8[8];
#pragma unroll
          for (int hlf = 0; hlf < 2; ++hlf) { const int c8 = cg4 + 8 * hlf;
              shift8(Vr, 512, hc + c8, row, t, sp + 1024 + hc + c8, sn + 1024 + hc + c8, v8);
              v4u w; w.x = cvtpk_h(v8[0], v8[1]); w.y = cvtpk_h(v8[2], v8[3]); w.z = cvtpk_h(v8[4], v8[5]); w.w = cvtpk_h(v8[6], v8[7]); *(LAS v4u*)(T1 + s * TSB + 2 * c8) = w; } }
        WG_BAR();
        { LANE_VARS; f32x16 qt, yt;
#pragma unroll
          for (int r = 0; r < 16; ++r) { qt[r] = 0.f; yt[r] = 0.f; }
#pragma unroll
          for (int ks = 0; ks < 4; ++ks) { const bf16x8 vf = frag_tr(T1, m0, ks, lane);
              qt = MFMA32H(frag_tr(T5, n0, ks, lane), vf, qt); yt = MFMA32H(frag_tr(T1, n0, ks, lane), frag_row(T4, mrow, ks, hi), yt); }
          v4u w0_, w1_;
          w0_.x = cvtpk_h(qt[0], qt[1]); w0_.y = cvtpk_h(qt[2], qt[3]); w0_.z = cvtpk_h(qt[4], qt[5]); w0_.w = cvtpk_h(qt[6], qt[7]); w1_.x = cvtpk_h(qt[8], qt[9]); w1_.y = cvtpk_h(qt[10], qt[11]); w1_.z = cvtpk_h(qt[12], qt[13]); w1_.w = cvtpk_h(qt[14], qt[15]);
          { bf16* dst = pre + 8192 + ((qn * 64 + mrow) * 2 + hi) * 16; *(v4u*)dst = w0_; *(v4u*)(dst + 8) = w1_; }
          w0_.x = cvtpk_h(yt[0], yt[1]); w0_.y = cvtpk_h(yt[2], yt[3]); w0_.z = cvtpk_h(yt[4], yt[5]); w0_.w = cvtpk_h(yt[6], yt[7]); w1_.x = cvtpk_h(yt[8], yt[9]); w1_.y = cvtpk_h(yt[10], yt[11]); w1_.z = cvtpk_h(yt[12], yt[13]); w1_.w = cvtpk_h(yt[14], yt[15]);
          { bf16* dst = pre + 12288 + ((qn * 64 + (d ? 63 - mrow : mrow)) * 2 + hi) * 16; *(v4u*)dst = w0_; *(v4u*)(dst + 8) = w1_; } }
        WG_BAR();
    }
#undef LANE_VARS
#undef SNAT
}

constexpr int SCAN_SLOT = 12 * 1024, SCAN_NS = 4;
__device__ __forceinline__ void scan_issue(const bf16* pre, LAS unsigned char* slot, int l31, int hi, int v) {
#pragma unroll
    for (int i = 0; i < 8; ++i) { const int mt = i >> 2, kt = (i >> 1) & 1, s = i & 1;
        __builtin_amdgcn_global_load_lds((const unsigned*)(pre + (32 * mt + l31) * 64 + 32 * kt + 16 * s + 8 * hi), (LAS unsigned*)(slot + i * 1024), 16, 0, 0); }
#pragma unroll
    for (int i = 0; i < 4; ++i) { const int mt = i >> 1, hf = i & 1;
        __builtin_amdgcn_global_load_lds((const unsigned*)(pre + 8192 + ((mt * 64 + v) * 2 + hi) * 16 + 8 * hf), (LAS unsigned*)(slot + (8 + i) * 1024), 16, 0, 0); }
}
__device__ __forceinline__ void rwkv_scan_chunk(Frame& F, int unit) {
    unsigned char* const ws = kws();
    int lane_ = lane_id(); asm volatile("" : "+v"(lane_));
    const int lane = lane_, hi = lane >> 5, l31 = lane & 31;
    const int chain = unit >> 1, vh = unit & 1, v = 32 * vh + l31;
    const bf16* pre = (const bf16*)(ws + R_PRE) + (size_t)chain * 64 * 16384;
    bf16* sd = (bf16*)(ws + R_SD) + (size_t)chain * 64 * 4096;
    LAS unsigned char* const ring = F.lds;
    f32x16 X0, X1;
#pragma unroll
    for (int r = 0; r < 16; ++r) { X0[r] = 0.f; X1[r] = 0.f; }
    scan_issue(pre, ring, l31, hi, v); scan_issue(pre + 16384, ring + SCAN_SLOT, l31, hi, v); scan_issue(pre + 2 * 16384, ring + 2 * SCAN_SLOT, l31, hi, v);
#pragma unroll 1
    for (int c = 0; c < 64; ++c) {
        bf16x8 xb[2][2], xl[2][2];
#pragma unroll
        for (int kt = 0; kt < 2; ++kt)
#pragma unroll
            for (int s = 0; s < 2; ++s) { v4u w, wl;
#pragma unroll
                for (int j = 0; j < 4; ++j) { const float a0 = kt ? X1[8 * s + 2 * j] : X0[8 * s + 2 * j], a1 = kt ? X1[8 * s + 2 * j + 1] : X0[8 * s + 2 * j + 1];
                    const unsigned hw = cvtpk_h(a0, a1); const f32x2_t hf = unpk_h(hw); w[j] = hw; wl[j] = cvtpk_h(a0 - hf.x, a1 - hf.y); }
                xb[kt][s] = __builtin_bit_cast(bf16x8, w); xl[kt][s] = __builtin_bit_cast(bf16x8, wl);
                *(v4u*)(sd + (size_t)c * 4096 + ((kt * 64 + v) * 2 + hi) * 16 + 8 * s) = w; }
        asm volatile("s_waitcnt lgkmcnt(0)" ::: "memory");
        if (c + 3 < 64) scan_issue(pre + (size_t)(c + 3) * 16384, ring + ((c + 3) & 3) * SCAN_SLOT, l31, hi, v);
        if (c + 3 < 64) asm volatile("s_waitcnt vmcnt(36)" ::: "memory"); else asm volatile("s_waitcnt vmcnt(0)" ::: "memory");
        const LAS unsigned char* sl = ring + (c & 3) * SCAN_SLOT + lane * 16;
        f32x16 acc[2];
#pragma unroll
        for (int mt = 0; mt < 2; ++mt) { const v4u w0_ = *(const LAS v4u*)(sl + (8 + 2 * mt) * 1024), w1_ = *(const LAS v4u*)(sl + (9 + 2 * mt) * 1024);
#pragma unroll
            for (int j = 0; j < 4; ++j) { const f32x2_t u0 = unpk_h(w0_[j]), u1 = unpk_h(w1_[j]); acc[mt][2 * j] = u0.x; acc[mt][2 * j + 1] = u0.y; acc[mt][8 + 2 * j] = u1.x; acc[mt][8 + 2 * j + 1] = u1.y; } }
#pragma unroll
        for (int mt = 0; mt < 2; ++mt)
#pragma unroll
            for (int kt = 0; kt < 2; ++kt)
#pragma unroll
                for (int s = 0; s < 2; ++s) { const bf16x8 af = *(const LAS bf16x8*)(sl + (4 * mt + 2 * kt + s) * 1024); acc[mt] = MFMA32H(af, xb[kt][s], acc[mt]); acc[mt] = MFMA32H(af, xl[kt][s], acc[mt]); }
        X0 = acc[0]; X1 = acc[1];
    }
}

constexpr int FIN_SGS = 272;
__device__ __forceinline__ void rwkv_finalize_mfma(Frame& F, int layer) {
    unsigned char* const ws = kws();
    int lane_ = lane_id(); asm volatile("" : "+v"(lane_)); int wave_o = F.wv; asm volatile("" : "+s"(wave_o)); const int wave_ = wave_o, lane = lane_, hi = lane >> 5, l31 = lane & 31, h = wave_, hc = h * HD;
    LAS unsigned char* const sgt = F.lds;
    const bf16* Vr = (const bf16*)(ws + R_VR); const bf16* XL = (const bf16*)(ws + R_XL); bf16* MIX = (bf16*)(ws + R_MIX); const bf16* G2T = (const bf16*)(ws + WS_G2T);
    const float* BN0 = (const float*)(ws + R_BN); const float* BN1 = BN0 + (size_t)M * 8;
    const float* sp = karg(I_TSP) + layer * RPROJ; const float* sn = karg(I_TSN) + layer * RPROJ;
    const float* gnw = karg(I_GNW) + layer * 512 + hc; const float* gnb = karg(I_GNB) + layer * 512 + hc;
    for (int unit = F.vcu; unit < BATCH * (SEQ / 64); unit += F.G) {
        const int cn = unit & 63, b = unit >> 6, t0 = cn * 64;
        { const int tid = wave_ * 64 + lane, tok = tid >> 3, oct = tid & 7, t = t0 + tok, row = b * SEQ + t; float v8[8];
#pragma unroll
          for (int hf = 0; hf < 2; ++hf) { const int k0 = 16 * oct + 8 * hf;
              shift8(XL, 256, 128 + k0, row, t, sp + 1664 + k0, sn + 1664 + k0, v8);
              v4u w; w.x = cvtpk(sigmoidf_(v8[0]), sigmoidf_(v8[1])); w.y = cvtpk(sigmoidf_(v8[2]), sigmoidf_(v8[3])); w.z = cvtpk(sigmoidf_(v8[4]), sigmoidf_(v8[5])); w.w = cvtpk(sigmoidf_(v8[6]), sigmoidf_(v8[7]));
              *(LAS v4u*)(sgt + tok * FIN_SGS + 2 * k0) = w; } }
        WG_BAR();
        f32x16 acc[2][2], gg[2][2];
#pragma unroll
        for (int tt = 0; tt < 2; ++tt)
#pragma unroll
            for (int vt = 0; vt < 2; ++vt)
#pragma unroll
                for (int r = 0; r < 16; ++r) { acc[tt][vt][r] = 0.f; gg[tt][vt][r] = 0.f; }
#pragma unroll
        for (int d = 0; d < 2; ++d) { const size_t item = (size_t)(((b * 8 + h) * 2 + d) * 64 + (d ? 63 - cn : cn));
            const bf16* pre = (const bf16*)(ws + R_PRE) + item * 16384; const bf16* sd = (const bf16*)(ws + R_SD) + item * 4096;
#pragma unroll
            for (int tt = 0; tt < 2; ++tt)
#pragma unroll
                for (int vt = 0; vt < 2; ++vt) { const bf16* src = pre + 12288 + ((vt * 64 + 32 * tt + l31) * 2 + hi) * 16; const v4u w0_ = *(const v4u*)src, w1_ = *(const v4u*)(src + 8);
#pragma unroll
                    for (int j = 0; j < 4; ++j) { const f32x2_t u0 = unpk_h(w0_[j]), u1 = unpk_h(w1_[j]); acc[tt][vt][2 * j] += u0.x; acc[tt][vt][2 * j + 1] += u0.y; acc[tt][vt][8 + 2 * j] += u1.x; acc[tt][vt][8 + 2 * j + 1] += u1.y; } }
#pragma unroll
            for (int kt = 0; kt < 2; ++kt)
#pragma unroll
                for (int s = 0; s < 2; ++s) { bf16x8 sf[2], rf[2];
#pragma unroll
                    for (int vt = 0; vt < 2; ++vt) sf[vt] = *(const bf16x8*)(sd + ((kt * 64 + 32 * vt + l31) * 2 + hi) * 16 + 8 * s);
#pragma unroll
                    for (int tt = 0; tt < 2; ++tt) rf[tt] = *(const bf16x8*)(pre + 4096 + (32 * tt + l31) * 64 + 32 * kt + 16 * s + 8 * hi);
#pragma unroll
                    for (int tt = 0; tt < 2; ++tt)
#pragma unroll
                        for (int vt = 0; vt < 2; ++vt) acc[tt][vt] = MFMA32H(sf[vt], rf[tt], acc[tt][vt]); } }
#pragma unroll
        for (int ks = 0; ks < 8; ++ks) { bf16x8 gf[2], tf[2];
#pragma unroll
            for (int vt = 0; vt < 2; ++vt) gf[vt] = *(const bf16x8*)(G2T + (size_t)(hc + 32 * vt + l31) * 128 + 16 * ks + 8 * hi);
#pragma unroll
            for (int tt = 0; tt < 2; ++tt) tf[tt] = *(const LAS bf16x8*)(sgt + (32 * tt + l31) * FIN_SGS + (16 * ks + 8 * hi) * 2);
#pragma unroll
            for (int tt = 0; tt < 2; ++tt)
#pragma unroll
                for (int vt = 0; vt < 2; ++vt) gg[tt][vt] = MFMA32(gf[vt], tf[tt], gg[tt][vt]); }
#pragma unroll
        for (int tt = 0; tt < 2; ++tt) { const int t = t0 + 32 * tt + l31, row = b * SEQ + t;
            float sm = 0.f;
#pragma unroll
            for (int vt = 0; vt < 2; ++vt)
#pragma unroll
                for (int r = 0; r < 16; ++r) sm += acc[tt][vt][r];
            sm += pg8::shx(sm, 32, lane); const float mu = sm * (1.0f / 64.0f); float sq = 0.f;
#pragma unroll
            for (int vt = 0; vt < 2; ++vt)
#pragma unroll
                for (int r = 0; r < 16; ++r) { const float dl = acc[tt][vt][r] - mu; sq += dl * dl; }
            sq += pg8::shx(sq, 32, lane); const float rstd = 1.0f / sqrtf(sq * (1.0f / 64.0f) + GN_EPS);
            const float bon = BN0[(size_t)row * 8 + h] + BN1[(size_t)row * 8 + h];
#pragma unroll
            for (int vt = 0; vt < 2; ++vt)
#pragma unroll
                for (int q = 0; q < 4; ++q) { const int v0 = 32 * vt + 8 * q + 4 * hi;
                    const f32x4 vs = shift4(Vr, 512, hc + v0, row, t, sp + 1024 + hc + v0, sn + 1024 + hc + v0), w4 = *(const f32x4*)(gnw + v0), b4 = *(const f32x4*)(gnb + v0);
                    float o4[4];
#pragma unroll
                    for (int i = 0; i < 4; ++i) o4[i] = ((acc[tt][vt][4 * q + i] - mu) * rstd * w4[i] + b4[i] + bon * vs[i]) * gg[tt][vt][4 * q + i];
                    u32x2_t w; w.x = cvtpk(o4[0], o4[1]); w.y = cvtpk(o4[2], o4[3]); *(u32x2_t*)(MIX + (size_t)row * 1024 + 512 + hc + v0) = w; } }
        WG_BAR();
    }
}

constexpr int ATT_O = 0, ATT_L = 65536, ATT_V = 67584, ATT_VT = 32 * TSB;
static_assert(ATT_V + NWAVES * ATT_VT <= LDSCTL_OFF, "attention LDS map");
__device__ __forceinline__ bf16x8 frag_tr_pv(const LAS unsigned char* tile, int d0, int s, int lane) {
    const int hi = lane >> 5, g1 = (lane >> 4) & 1, i = lane & 15;
    const LAS unsigned char* p = tile + (16 * s + 4 * hi + (i >> 2)) * TSB + (d0 + 16 * g1 + 4 * (i & 3)) * 2;
    const s16x4 lo = tr4(p), h4 = tr4(p + 8 * TSB);
    return (bf16x8){lo[0], lo[1], lo[2], lo[3], h4[0], h4[1], h4[2], h4[3]};
}
template <int NQH>
__device__ __forceinline__ void attn_block(const bf16* MIX, const bf16* V, LAS unsigned char* lds, LAS unsigned char* vt, int b, int h, int T0, int tq0, int d, float slope_d, float bound, bool first, int lane) {
    const int hi = lane >> 5, l31 = lane & 31;
    const int jlo = -(tq0 / d), jhi = (SEQ - 1 - tq0) / d;
    bf16x8 qf[NQH][4];
#pragma unroll
    for (int qh = 0; qh < NQH; ++qh) { const bf16* qp = MIX + ((size_t)b * SEQ + tq0 + d * (32 * qh + l31)) * 1024 + h * HD + 8 * hi;
#pragma unroll
        for (int ks = 0; ks < 4; ++ks) qf[qh][ks] = *(const bf16x8*)(qp + 16 * ks); }
    f32x16 o[NQH][2]; float lsum[NQH];
#pragma unroll
    for (int qh = 0; qh < NQH; ++qh) { lsum[qh] = 0.f;
#pragma unroll
        for (int r = 0; r < 16; ++r) { o[qh][0][r] = 0.f; o[qh][1][r] = 0.f; } }
    constexpr int NT = NQH == 2 ? 6 : 5;
#pragma unroll 1
    for (int jt = 0; jt < NT; ++jt) {
        { const int kr = lane >> 1, hf = lane & 1; int pos = tq0 + d * (32 * jt + kr - 64); pos = pos < 0 ? 0 : (pos > SEQ - 1 ? SEQ - 1 : pos);
          const v4u* src = (const v4u*)(V + ((size_t)b * SEQ + pos) * 512 + h * HD + 32 * hf); LAS v4u* dst = (LAS v4u*)(vt + kr * TSB + 64 * hf);
          const v4u a0 = src[0], a1 = src[1], a2 = src[2], a3 = src[3]; dst[0] = a0; dst[1] = a1; dst[2] = a2; dst[3] = a3; }
        bf16x8 kf[4];
        { int pos = tq0 + d * (32 * jt + l31 - 64); pos = pos < 0 ? 0 : (pos > SEQ - 1 ? SEQ - 1 : pos);
          const bf16* kp = MIX + ((size_t)b * SEQ + pos) * 1024 + 512 + h * HD + 8 * hi;
#pragma unroll
          for (int ks = 0; ks < 4; ++ks) kf[ks] = *(const bf16x8*)(kp + 16 * ks); }
        asm volatile("s_waitcnt lgkmcnt(0)" ::: "memory");
#pragma unroll
        for (int qh = 0; qh < NQH; ++qh) {
            if (NQH == 2 && ((qh == 0 && jt == 5) || (qh == 1 && jt == 0))) continue;
            f32x16 s;
#pragma unroll
            for (int r = 0; r < 16; ++r) s[r] = 0.f;
#pragma unroll
            for (int ks = 0; ks < 4; ++ks) s = MFMA32(kf[ks], qf[qh][ks], s);
            const int iq = 32 * qh + l31;
            v4u pk[2];
#pragma unroll
            for (int r = 0; r < 16; r += 2) { float p2[2];
#pragma unroll
                for (int e = 0; e < 2; ++e) { const int rr = r + e, jj = 32 * jt + (rr & 3) + 8 * (rr >> 2) + 4 * hi - 64; const int dl = iq - jj, ad = dl < 0 ? -dl : dl;
                    const bool valid = (ad <= 64) && (jj >= jlo) && (jj <= jhi);
                    p2[e] = valid ? __expf(s[rr] - slope_d * (float)ad - bound) : 0.f; lsum[qh] += p2[e]; }
                pk[r >> 3][(r >> 1) & 3] = cvtpk(p2[0], p2[1]); }
#pragma unroll
            for (int dt = 0; dt < 2; ++dt)
#pragma unroll
                for (int s2 = 0; s2 < 2; ++s2) o[qh][dt] = MFMA32(frag_tr_pv(vt, 32 * dt, s2, lane), __builtin_bit_cast(bf16x8, pk[s2]), o[qh][dt]);
        }
        asm volatile("s_waitcnt lgkmcnt(0)" ::: "memory");
    }
    int lane2 = lane; asm volatile("" : "+v"(lane2));
#pragma unroll
    for (int qh = 0; qh < NQH; ++qh) { const int hi = lane2 >> 5, l31 = lane2 & 31, lane = lane2;
        const int qi = (tq0 - T0) + d * (32 * qh + l31);
        const float lt = lsum[qh] + pg8::shx(lsum[qh], 32, lane);
        if (hi == 0) { LAS float* lp = (LAS float*)(lds + ATT_L) + qi; *lp = first ? lt : (*lp + lt); }
#pragma unroll
        for (int dt = 0; dt < 2; ++dt)
#pragma unroll
            for (int q = 0; q < 4; ++q) { const int d0 = 32 * dt + 8 * q + 4 * hi; LAS u32x2_t* op = (LAS u32x2_t*)(lds + ATT_O + qi * 128 + ((((d0 >> 3) ^ (qi & 7)) << 4) | ((d0 & 4) << 1)));
                float v0 = o[qh][dt][4 * q], v1 = o[qh][dt][4 * q + 1], v2 = o[qh][dt][4 * q + 2], v3 = o[qh][dt][4 * q + 3];
                if (!first) { const u32x2_t w = *op; v0 += __uint_as_float(w.x << 16); v1 += __uint_as_float(w.x & 0xffff0000u); v2 += __uint_as_float(w.y << 16); v3 += __uint_as_float(w.y & 0xffff0000u); }
                u32x2_t w; w.x = cvtpk(v0, v1); w.y = cvtpk(v2, v3); *op = w; }
    }
}
__device__ __forceinline__ void attn_phase_mfma(Frame& F, int layer, int unit0, int nunit, int ustride) {
    unsigned char* const ws = kws();
    int lane_ = lane_id(); asm volatile("" : "+v"(lane_)); int wave_o = F.wv; asm volatile("" : "+s"(wave_o)); const int wave_ = wave_o, lane = lane_;
    bf16* MIX = (bf16*)(ws + R_MIX); const bf16* V = (const bf16*)(ws + R_V);
    LAS unsigned char* const lds = F.lds; LAS unsigned char* const vt = lds + ATT_V + wave_ * ATT_VT;
    float bound;
    { const float* qg = karg(I_QG) + layer * HD; const float* kg = karg(I_KG) + layer * HD; float mq = 0.f, mk = 0.f;
      for (int i = 0; i < HD; ++i) { mq = fmaxf(mq, fabsf(qg[i])); mk = fmaxf(mk, fabsf(kg[i])); }
      bound = 8.0f * mq * mk + 0.25f; }
    for (int unit = unit0; unit < nunit; unit += ustride) {
        const int st = unit & 7, h = (unit >> 3) & 7, b = unit >> 6, T0 = st * 512;
        const float slope = exp2f(-(float)(h + 1));
        attn_block<2>(MIX, V, lds, vt, b, h, T0, T0 + 64 * wave_, 1, slope, bound, true, lane);
        WG_BAR();
        attn_block<2>(MIX, V, lds, vt, b, h, T0, T0 + (wave_ & 3) + 256 * (wave_ >> 2), 4, slope * 4.f, bound, false, lane);
        WG_BAR();
        attn_block<1>(MIX, V, lds, vt, b, h, T0, T0 + 2 * wave_, 16, slope * 16.f, bound, false, lane);
        attn_block<1>(MIX, V, lds, vt, b, h, T0, T0 + 2 * wave_ + 1, 16, slope * 16.f, bound, false, lane);
        WG_BAR();
        { const int tid = wave_ * 64 + lane;
#pragma unroll
          for (int k = 0; k < 8; ++k) { const int item = tid + 512 * k, qi = item >> 3, c16 = item & 7;
              const v4u w = *(const LAS v4u*)(lds + ATT_O + qi * 128 + ((c16 ^ (qi & 7)) << 4)); const float il = 1.0f / ((const LAS float*)(lds + ATT_L))[qi];
              v4u o;
#pragma unroll
              for (int j = 0; j < 4; ++j) o[j] = cvtpk(__uint_as_float(w[j] << 16) * il, __uint_as_float(w[j] & 0xffff0000u) * il);
              *(v4u*)(MIX + ((size_t)b * SEQ + T0 + qi) * 1024 + h * HD + 8 * c16) = o; } }
        WG_BAR();
    }
}

__global__ void __launch_bounds__(NTHR, 2) mk_fwd(Args args) {
    extern __shared__ __attribute__((aligned(16))) unsigned char lds[];
    Frame F;
    F.lds = (LAS unsigned char*)lds;
    F.MISC = (volatile LAS unsigned*)(F.lds + MISC_OFF);
    F.wv = __builtin_amdgcn_readfirstlane((int)threadIdx.x >> 6);
    F.G = gridDim.x; { const int bx = blockIdx.x; F.vcu = (F.G % 8 == 0) ? (bx % 8) * (F.G / 8) + bx / 8 : bx; }
    F.ctl = (gu32*)(kws() + WS_CTL);
    for (int u = F.wv * 64 + lane_id(); u < (LDS_BYTES - LDSCTL_OFF) / 4; u += NTHR) ((LAS unsigned*)(F.lds + LDSCTL_OFF))[u] = 0u;
    __syncthreads();
    XcdBarrier bar = xcd_barrier_post((unsigned*)(F.ctl + CW_BAR), F.MISC + 8, F.wv == 0 && lane_id() == 0);
#define GRID_BAR() xcd_barrier(bar, F.wv == 0 && lane_id() == 0)
#define XB ((bf16*)(ws + R_XB))
#define MIXB ((bf16*)(ws + R_MIX))
#define HID ((bf16*)(ws + R_HID))
#define SS1 ((float*)(ws + WS_SS1))
#define SS2 ((float*)(ws + WS_SS2))

    for (int step = 0; step < 8 * DEPTH; ++step) {
        const int layer = step >> 3, kind = step & 7;
        if (kind == 0) {
            if (layer == 0) x_prologue(F);
            wconv_phase(F, layer);
        } else if (kind == 1) {
            unsigned char* const ws = kws();
            pg8::Gemm g{XB, (const bf16*)(ws + WS_WIN), M, NPROJ, D}; pg8::StaticOrder S; S.init(M, NPROJ, F.G, (int)blockIdx.x);
            pg8::EpiProj E; E.base0 = (bf16*)(ws + WS_R0); E.ss = SS1; E.qg = karg(I_QG) + layer * HD; E.kg = karg(I_KG) + layer * HD;
            pg8::gemm_phase<pg8::EpiProj, pg8::StaticOrder, true, true>(F.lds + RING_OFF, g, S, E, F.wv, lane_id());
        } else if (kind == 2) {
            rwkv_pre_phase(F, layer);
        } else if (kind == 3) {
            const int bx = (int)blockIdx.x;
            if (bx < 128) { if (F.wv == 0) rwkv_scan_chunk(F, bx); }
            else attn_phase_mfma(F, layer, bx - 128, BATCH * H * 8, F.G - 128);
        } else if (kind == 4) {
            rwkv_finalize_mfma(F, layer);
        } else if (kind == 5 || kind == 7) {
            unsigned char* const ws = kws(); float* const xo = kout();
            pg8::Gemm g{kind == 5 ? MIXB : HID, (const bf16*)(ws + (kind == 5 ? WS_WOUT : WS_WDN)), M, D, kind == 5 ? D : FF}; pg8::StaticOrder S; S.init(M, D, F.G, (int)blockIdx.x);
            pg8::EpiRes E{xo, XB, kind == 5 ? SS2 : SS1};
            pg8::gemm_phase<pg8::EpiRes, pg8::StaticOrder, false, true>(F.lds + RING_OFF, g, S, E, F.wv, lane_id());
        } else {
            unsigned char* const ws = kws();
            pg8::Gemm g{XB, (const bf16*)(ws + WS_WUP), M, FF, D}; pg8::StaticOrder S; S.init(M, FF, F.G, (int)blockIdx.x);
            pg8::EpiUp E{HID, SS2};
            pg8::gemm_phase<pg8::EpiUp, pg8::StaticOrder, true, true>(F.lds + RING_OFF, g, S, E, F.wv, lane_id());
        }
        if (step + 1 < 8 * DEPTH) GRID_BAR();
    }
}

extern "C" void kernel_launch(void* const* d_in, const int* in_sizes, int n_in, void* d_out, int out_size, void* d_ws, size_t ws_size, hipStream_t stream) {
    static int grid = 0;
    if (grid == 0) {
        if (n_in != N_IN || in_sizes[0] != M * D || out_size != M * D || ws_size < WS_END) { fprintf(stderr, "kernel_launch: unexpected shapes (n_in %d, in0 %d, out %d, ws %zu)\n", n_in, n_in > 0 ? in_sizes[0] : -1, out_size, ws_size); grid = -1; return; }
        int dev = 0, cus = 0;
        if (hipGetDevice(&dev) != hipSuccess || hipDeviceGetAttribute(&cus, hipDeviceAttributeMultiprocessorCount, dev) != hipSuccess) { grid = -1; return; }
        if (hipFuncSetAttribute((const void*)mk_fwd, hipFuncAttributeMaxDynamicSharedMemorySize, LDS_BYTES) != hipSuccess) { fprintf(stderr, "kernel_launch: hipFuncSetAttribute failed\n"); grid = -1; return; }
        int per_cu = 0;
        (void)hipOccupancyMaxActiveBlocksPerMultiprocessor(&per_cu, (const void*)mk_fwd, NTHR, LDS_BYTES);
        (void)hipGetLastError();
        grid = cus;
    }
    if (grid < 0) return;
    (void)hipMemsetAsync((char*)d_ws + WS_CTL, 0, CTL_ZERO_BYTES, stream);
    Args a{};
    for (int i = 0; i < N_IN; ++i) a.in[i] = (const float*)d_in[i];
    a.out = (float*)d_out; a.ws = (unsigned char*)d_ws;
    hipLaunchKernelGGL(mk_fwd, dim3(grid), dim3(NTHR), LDS_BYTES, stream, a);
}
```

```cpp
#include <hip/hip_runtime.h>
#include <cstdio>
#include <cstdint>
namespace pg8 {
#define PG8_LAS __attribute__((address_space(3)))
typedef unsigned short bf16_t;
typedef short bf16x8 __attribute__((ext_vector_type(8)));
typedef float f32x4 __attribute__((ext_vector_type(4)));
typedef unsigned u32x4 __attribute__((ext_vector_type(4)));
constexpr int BM = 256, BK = 64, HALF = 128, HTB = HALF * BK * 2  , STAGE_BYTES = 8 * HTB, NXCD = 8, WGM = 8;

__host__ __device__ __forceinline__ int lds_byte(int r, int c) { const int st = (r >> 4) * 2 + (c >> 5), rr = r & 15, cc = c & 31, ob = rr * 64 + cc * 2; return st * 1024 + (ob ^ (((ob >> 9) & 1) << 5)); }
__host__ __device__ __forceinline__ void stage_rc(int b, int& R, int& C) { const int st = b / 1024, sb = b % 1024, swz = sb ^ (((sb >> 9) & 1) << 5); R = (st >> 1) * 16 + swz / 64; C = (st & 1) * 32 + (swz % 64) / 2; }
__host__ __device__ __forceinline__ int perm32(int rho) { const int n = rho >> 4, i = rho & 15; return 8 * (i >> 2) + 4 * n + (i & 3); }

struct Unit { int pm, pn; };
struct Gemm { const bf16_t* A; const bf16_t* Bt; int M, N, K; };

struct StaticOrder {
    int nM, nN, nwg, G, c;
    __host__ __device__ void init(int M, int N, int G_, int c_) { nM = M / BM; nN = N / BM; nwg = nM * nN; G = G_; c = c_; }
    __host__ __device__ bool next(int i, Unit& u) const {
        const long L = (long)i * G + c; if (L >= nwg) return false;
        int wgid = (int)L; { const int q = nwg / NXCD, r = nwg % NXCD, xcd = wgid % NXCD, off = wgid / NXCD; wgid = (xcd < r ? xcd * (q + 1) : r * (q + 1) + (xcd - r) * q) + off; }
        const int nig = WGM * nN, gid = wgid / nig, fm = gid * WGM, gsz = (nM - fm) < WGM ? (nM - fm) : WGM;
        u.pm = fm + ((wgid % nig) % gsz); u.pn = (wgid % nig) / gsz; return true;
    }
    __device__ __forceinline__ void a_ready(const Unit&) const {}
    __device__ __forceinline__ void done(const Unit&) const {}
};

__device__ __forceinline__ unsigned cvt_pk_bf16(float lo, float hi) { unsigned r; asm volatile("v_cvt_pk_bf16_f32 %0, %1, %2" : "=v"(r) : "v"(lo), "v"(hi)); return r; }
typedef unsigned u32x2 __attribute__((ext_vector_type(2)));

__device__ __forceinline__ float shx(float v, int m, int lane) { return __int_as_float(__builtin_amdgcn_ds_bpermute((lane ^ m) << 2, __float_as_int(v))); }
__device__ __forceinline__ float row_rs(const float* ss, int row, int fq, int lane) {
    const f32x4 p = *(const f32x4*)(ss + (size_t)row * 16 + 4 * fq);
    float s = (p[0] + p[1]) + (p[2] + p[3]);
    s += shx(s, 16, lane); s += shx(s, 32, lane);
    return 1.0f / sqrtf(s * (1.0f / 1024.0f) + 1e-6f);
}

struct EpiProj {
    static constexpr bool PERM = true, AFTER_DRAIN = false;
    bf16_t* base0; const float* ss; const float* qg; const float* kg;
    __device__ __forceinline__ void operator()(const f32x4 (&acc)[2][2][4][2], const Unit& u, int wr, int wc, int fr, int fq) const {
        const int tile = u.pn, di = tile >> 1;
        bf16_t* base = base0 + (di < 2 ? (size_t)di * 512 : (size_t)di * (8u << 20)); const int ldc = (di < 2) ? 1024 : ((di == 6) ? 256 : 512); const int cb = (di == 6) ? 0 : (tile & 1) * 256;
        const bool nrm = tile < 4; const float* gsrc = (tile < 2) ? qg : kg; const float post = (tile < 2) ? 0.125f : 1.0f;
        f32x4 g[2][2];
#pragma unroll
        for (int bj = 0; bj < 2; ++bj)
#pragma unroll
            for (int n = 0; n < 2; ++n) g[bj][n] = nrm ? *(const f32x4*)(gsrc + 32 * bj + 8 * fq + 4 * n) * post : (f32x4){1.f, 1.f, 1.f, 1.f};
#pragma unroll
        for (int ai = 0; ai < 2; ++ai)
#pragma unroll
            for (int m = 0; m < 4; ++m) {
                const int row = u.pm * BM + ai * HALF + wr * 64 + m * 16 + fr;
                const float rs = row_rs(ss, row, fq, 16 * fq + fr);
                f32x4 v[2][2]; float q = 0.f;
#pragma unroll
                for (int bj = 0; bj < 2; ++bj)
#pragma unroll
                    for (int n = 0; n < 2; ++n) { v[bj][n] = acc[ai][bj][m][n] * rs; const f32x4 t = v[bj][n]; q += (t[0] * t[0] + t[1] * t[1]) + (t[2] * t[2] + t[3] * t[3]); }
                q += shx(q, 16, 16 * fq + fr); q += shx(q, 32, 16 * fq + fr);
                const float inv = nrm ? 1.0f / sqrtf(q * (1.0f / 64.0f) + 1e-6f) : 1.0f;
                bf16_t* rowp = base + (size_t)row * ldc + cb + 64 * wc + 8 * fq;
#pragma unroll
                for (int bj = 0; bj < 2; ++bj) { const f32x4 v0 = v[bj][0] * inv * g[bj][0], v1 = v[bj][1] * inv * g[bj][1];
                    u32x4 w; w.x = cvt_pk_bf16(v0[0], v0[1]); w.y = cvt_pk_bf16(v0[2], v0[3]); w.z = cvt_pk_bf16(v1[0], v1[1]); w.w = cvt_pk_bf16(v1[2], v1[3]);
                    *(u32x4*)(rowp + 32 * bj) = w; }
                asm volatile("" ::: "memory");
            }
    }
};
struct EpiUp {
    static constexpr bool PERM = true, AFTER_DRAIN = false;
    bf16_t* O; const float* ss;
    __device__ __forceinline__ void operator()(const f32x4 (&acc)[2][2][4][2], const Unit& u, int wr, int wc, int fr, int fq) const {
#pragma unroll
        for (int ai = 0; ai < 2; ++ai)
#pragma unroll
            for (int m = 0; m < 4; ++m) {
                const int row = u.pm * BM + ai * HALF + wr * 64 + m * 16 + fr;
                const float rs = row_rs(ss, row, fq, 16 * fq + fr);
                bf16_t* rowp = O + (size_t)row * 4096 + u.pn * BM + wc * 32 + 8 * fq;
#pragma unroll
                for (int bj = 0; bj < 2; ++bj) { f32x4 v0 = acc[ai][bj][m][0] * rs, v1 = acc[ai][bj][m][1] * rs;
                    v0 = __builtin_elementwise_max(v0, (f32x4){0.f, 0.f, 0.f, 0.f}); v1 = __builtin_elementwise_max(v1, (f32x4){0.f, 0.f, 0.f, 0.f}); v0 = v0 * v0; v1 = v1 * v1;
                    u32x4 w; w.x = cvt_pk_bf16(v0[0], v0[1]); w.y = cvt_pk_bf16(v0[2], v0[3]); w.z = cvt_pk_bf16(v1[0], v1[1]); w.w = cvt_pk_bf16(v1[2], v1[3]);
                    *(u32x4*)(rowp + bj * HALF) = w; }
                asm volatile("" ::: "memory");
            }
    }
};
struct EpiRes {
    static constexpr bool PERM = false, AFTER_DRAIN = false;
    float* x; bf16_t* xb; float* ss;
    __device__ __forceinline__ void operator()(const f32x4 (&acc)[2][2][4][2], const Unit& u, int wr, int wc, int fr, int fq) const {
        const int col0 = u.pn * BM + wc * 32 + 4 * fq;
#pragma unroll
        for (int ai = 0; ai < 2; ++ai)
#pragma unroll
            for (int m = 0; m < 4; ++m) {
                const int row = u.pm * BM + ai * HALF + wr * 64 + m * 16 + fr; const size_t off = (size_t)row * 1024 + col0; float q = 0.f;
#pragma unroll
                for (int bj = 0; bj < 2; ++bj)
#pragma unroll
                    for (int n = 0; n < 2; ++n) { const size_t o = off + bj * HALF + n * 16; const f32x4 t = *(const f32x4*)(x + o) + acc[ai][bj][m][n];
                        *(f32x4*)(x + o) = t; u32x2 w; w.x = cvt_pk_bf16(t[0], t[1]); w.y = cvt_pk_bf16(t[2], t[3]); *(u32x2*)(xb + o) = w;
                        q += (t[0] * t[0] + t[1] * t[1]) + (t[2] * t[2] + t[3] * t[3]); }
                q += shx(q, 16, 16 * fq + fr); q += shx(q, 32, 16 * fq + fr);
                if (fq == 0) ss[(size_t)row * 16 + 4 * u.pn + wc] = q;
                asm volatile("" ::: "memory");
            }
    }
};

template <class Epi, class Sched, bool ALIGN_EPI = false, bool SP2 = false>
__device__ __forceinline__ void gemm_phase(PG8_LAS unsigned char* lds, const Gemm g, const Sched& S, const Epi& E, int wave_in, int lane_in) {
    int lane_o = lane_in, wave_o = wave_in; asm volatile("" : "+v"(lane_o)); asm volatile("" : "+s"(wave_o)); const int tid_ = wave_o * 64 + lane_o;
    const int tid = tid_, wid = wave_o, lane = lane_o, wr = wid >> 2, wc = wid & 3, fr = lane & 15, fq = lane >> 4;
    const int K = g.K, nt = K / BK;
    unsigned voffA[2], voffB[2];
#pragma unroll
    for (int i = 0; i < 2; ++i) { int R, C; stage_rc(tid * 16 + i * 8192, R, C); const int Rb = Epi::PERM ? ((R & ~31) + perm32(R & 31)) : R;
        voffA[i] = (unsigned)(R * K + C) * 2u; voffB[i] = (unsigned)(Rb * K + C) * 2u; }
    const size_t kstep = (size_t)(BK * 2);
    const size_t hstep = (size_t)HALF * K * 2;
    const size_t tstep = 2 * hstep;
    const unsigned ldsw = (unsigned)wid * 1024u;
    const int aoff = lds_byte(wr * 64 + fr, fq * 8), boff = lds_byte(wc * 32 + fr, fq * 8);
#define PG8_SA(b, h) (((b) * 2 + (h)) * HTB)
#define PG8_SB(b, h) ((4 + (b) * 2 + (h)) * HTB)
#define PG8_STAGE(bufoff, gbase, voff) do { _Pragma("unroll") for (int _i = 0; _i < 2; ++_i) \
        __builtin_amdgcn_global_load_lds((const unsigned*)((const char*)(gbase) + (voff)[_i]), (PG8_LAS unsigned*)(lds + (bufoff) + ldsw + _i * 8192), 16, 0, 0); } while (0)
#define PG8_LDA(dst, b, h) do { _Pragma("unroll") for (int m = 0; m < 4; ++m) _Pragma("unroll") for (int k = 0; k < 2; ++k) dst[m][k] = *(const PG8_LAS bf16x8*)(lds + PG8_SA(b, h) + aoff + m * 2048 + k * 1024); } while (0)
#define PG8_LDB(dst, b, h) do { _Pragma("unroll") for (int n = 0; n < 2; ++n) _Pragma("unroll") for (int k = 0; k < 2; ++k) dst[n][k] = *(const PG8_LAS bf16x8*)(lds + PG8_SB(b, h) + boff + n * 2048 + k * 1024); } while (0)
#define PG8_MMA(ai, bj, At, Bt) do { __builtin_amdgcn_s_setprio(1); _Pragma("unroll") for (int m = 0; m < 4; ++m) _Pragma("unroll") for (int n = 0; n < 2; ++n) _Pragma("unroll") for (int k = 0; k < 2; ++k) \
        acc[ai][bj][m][n] = __builtin_amdgcn_mfma_f32_16x16x32_bf16(Bt[n][k], At[m][k], acc[ai][bj][m][n], 0, 0, 0); __builtin_amdgcn_s_setprio(0); } while (0)
#define PG8_WAIT_V(n) asm volatile("s_waitcnt vmcnt(" #n ")" ::: "memory")
#define PG8_WAIT_L(n) asm volatile("s_waitcnt lgkmcnt(" #n ")" ::: "memory")
#define PG8_BAR __builtin_amdgcn_s_barrier()
#define PG8_SCHED __builtin_amdgcn_sched_barrier(0)
    Unit cur, nxt; int ui = 0;
    if (!S.next(0, cur)) return;
    f32x4 acc[2][2][4][2];
#pragma unroll
    for (int a = 0; a < 2; ++a)
#pragma unroll
        for (int b = 0; b < 2; ++b)
#pragma unroll
            for (int m = 0; m < 4; ++m)
#pragma unroll
                for (int n = 0; n < 2; ++n) acc[a][b][m][n] = (f32x4){0.f, 0.f, 0.f, 0.f};
    bf16x8 At[4][2], B0[2][2], B1[2][2];
    const char* cA = (const char*)g.A + (size_t)cur.pm * tstep; const char* cB = (const char*)g.Bt + (size_t)cur.pn * tstep;
    S.a_ready(cur);
    if constexpr (SP2) {
        PG8_STAGE(PG8_SB(0, 0), cB, voffB); PG8_STAGE(PG8_SB(0, 1), cB + hstep, voffB); PG8_STAGE(PG8_SA(0, 0), cA, voffA); PG8_STAGE(PG8_SA(0, 1), cA + hstep, voffA);
        if (wr == 1) PG8_BAR;
        PG8_WAIT_V(2); PG8_BAR;
        PG8_STAGE(PG8_SB(1, 0), cB + kstep, voffB); PG8_STAGE(PG8_SA(1, 0), cA + kstep, voffA); PG8_STAGE(PG8_SB(1, 1), cB + hstep + kstep, voffB);
        PG8_WAIT_V(6); PG8_BAR;
    } else {
        PG8_STAGE(PG8_SB(0, 0), cB, voffB); PG8_STAGE(PG8_SA(0, 0), cA, voffA); PG8_STAGE(PG8_SB(0, 1), cB + hstep, voffB); PG8_STAGE(PG8_SA(0, 1), cA + hstep, voffA);
        if (wr == 1) PG8_BAR;
        PG8_WAIT_V(4); PG8_BAR;
        PG8_STAGE(PG8_SB(1, 0), cB + kstep, voffB); PG8_STAGE(PG8_SA(1, 0), cA + kstep, voffA); PG8_STAGE(PG8_SB(1, 1), cB + hstep + kstep, voffB);
        PG8_WAIT_V(6); PG8_BAR;
    }
    for (;;) {
        const bool has_next = S.next(ui + 1, nxt);
        const char* nA = has_next ? (const char*)g.A + (size_t)nxt.pm * tstep : cA; const char* nB = has_next ? (const char*)g.Bt + (size_t)nxt.pn * tstep : cB;
        for (int t = 0; t < nt; t += 2) {
            const bool last = (t == nt - 2);
            const char* a1 = cA + (size_t)(t + 1) * kstep;
            const char* a2 = last ? nA : cA + (size_t)(t + 2) * kstep; const char* b2 = last ? nB : cB + (size_t)(t + 2) * kstep;
            const char* a3 = a2 + kstep; const char* b3 = b2 + kstep;
            if (last && has_next) S.a_ready(nxt);
            if constexpr (SP2) {
            PG8_LDB(B0, 0, 0); PG8_LDB(B1, 0, 1); PG8_SCHED; PG8_LDA(At, 0, 0); PG8_STAGE(PG8_SA(1, 1), a1 + hstep, voffA);
            PG8_WAIT_V(8); PG8_WAIT_L(0); PG8_BAR; PG8_MMA(0, 0, At, B0); PG8_MMA(0, 1, At, B1); PG8_BAR; PG8_SCHED;
            PG8_LDA(At, 0, 1); PG8_STAGE(PG8_SB(0, 0), b2, voffB); PG8_STAGE(PG8_SB(0, 1), b2 + hstep, voffB); PG8_STAGE(PG8_SA(0, 0), a2, voffA);
            PG8_WAIT_V(8); PG8_WAIT_L(0); PG8_BAR; PG8_MMA(1, 0, At, B0); PG8_MMA(1, 1, At, B1); PG8_BAR; PG8_SCHED;
            PG8_LDB(B0, 1, 0); PG8_LDB(B1, 1, 1); PG8_SCHED; PG8_LDA(At, 1, 0); PG8_STAGE(PG8_SA(0, 1), a2 + hstep, voffA);
            PG8_WAIT_V(8); PG8_WAIT_L(0); PG8_BAR; PG8_MMA(0, 0, At, B0); PG8_MMA(0, 1, At, B1); PG8_BAR; PG8_SCHED;
            PG8_LDA(At, 1, 1); PG8_STAGE(PG8_SB(1, 0), b3, voffB); PG8_STAGE(PG8_SB(1, 1), b3 + hstep, voffB); PG8_STAGE(PG8_SA(1, 0), a3, voffA);
            PG8_WAIT_V(8); PG8_WAIT_L(0); PG8_BAR; PG8_MMA(1, 0, At, B0); PG8_MMA(1, 1, At, B1); PG8_BAR; PG8_SCHED;
            } else {
            PG8_LDB(B0, 0, 0); PG8_SCHED; PG8_LDA(At, 0, 0); PG8_STAGE(PG8_SA(1, 1), a1 + hstep, voffA);
            PG8_WAIT_L(8); PG8_BAR; PG8_WAIT_L(0); PG8_MMA(0, 0, At, B0); PG8_BAR; PG8_SCHED;
            PG8_LDB(B1, 0, 1); PG8_STAGE(PG8_SB(0, 0), b2, voffB);
            PG8_BAR; PG8_WAIT_L(0); PG8_MMA(0, 1, At, B1); PG8_BAR;
            PG8_LDA(At, 0, 1); PG8_STAGE(PG8_SA(0, 0), a2, voffA);
            PG8_BAR; PG8_WAIT_L(0); PG8_MMA(1, 0, At, B0); PG8_BAR; PG8_SCHED;
            PG8_STAGE(PG8_SB(0, 1), b2 + hstep, voffB);
            PG8_WAIT_V(6); PG8_BAR; PG8_MMA(1, 1, At, B1); PG8_BAR;
            PG8_LDB(B0, 1, 0); PG8_SCHED; PG8_LDA(At, 1, 0); PG8_STAGE(PG8_SA(0, 1), a2 + hstep, voffA);
            PG8_WAIT_L(8); PG8_BAR; PG8_WAIT_L(0); PG8_MMA(0, 0, At, B0); PG8_BAR; PG8_SCHED;
            PG8_LDB(B1, 1, 1); PG8_STAGE(PG8_SB(1, 0), b3, voffB);
            PG8_BAR; PG8_WAIT_L(0); PG8_MMA(0, 1, At, B1); PG8_BAR;
            PG8_LDA(At, 1, 1); PG8_STAGE(PG8_SA(1, 0), a3, voffA);
            PG8_BAR; PG8_WAIT_L(0); PG8_MMA(1, 0, At, B0); PG8_BAR; PG8_SCHED;
            PG8_STAGE(PG8_SB(1, 1), b3 + hstep, voffB);
            PG8_WAIT_V(6); PG8_BAR; PG8_MMA(1, 1, At, B1); PG8_BAR;
            }
        }
        if constexpr (ALIGN_EPI) { if (wr == 0) PG8_BAR; }
        if constexpr (!Epi::AFTER_DRAIN) { E(acc, cur, wr, wc, fr, fq); S.done(cur); }
        if (!has_next) break;
#pragma unroll
        for (int a = 0; a < 2; ++a)
#pragma unroll
            for (int b = 0; b < 2; ++b)
#pragma unroll
                for (int m = 0; m < 4; ++m)
#pragma unroll
                    for (int n = 0; n < 2; ++n) acc[a][b][m][n] = (f32x4){0.f, 0.f, 0.f, 0.f};
        cur = nxt; cA = nA; cB = nB; ++ui;
        if constexpr (ALIGN_EPI) { if (wr == 1) PG8_BAR; }
    }
    PG8_WAIT_V(0);
    if constexpr (!ALIGN_EPI) { if (wr == 0) PG8_BAR; }
    PG8_BAR;
    if constexpr (Epi::AFTER_DRAIN) { E.fused(acc, cur, wr, wc, fr, fq, lds, wid, lane); S.done(cur); }
#undef PG8_SA
#undef PG8_SB
#undef PG8_STAGE
#undef PG8_LDA
#undef PG8_LDB
#undef PG8_MMA
#undef PG8_WAIT_V
#undef PG8_WAIT_L
#undef PG8_BAR
#undef PG8_SCHED
}
}
constexpr int NWAVES = 8, NTHR = 512;
constexpr int BATCH = 4, SEQ = 4096, D = 1024, DEPTH = 4, H = 8, HD = 64, FF = 4096, NPROJ = 3328, RPROJ = 1792;
constexpr int M = BATCH * SEQ;
constexpr float GN_EPS = 64e-5f;
enum { I_X = 0, I_LN1, I_WIN, I_QG, I_KG, I_TSP, I_TSN, I_W0, I_W2, I_A0, I_A2, I_G2, I_KK, I_KA, I_RK, I_GNW, I_GNB, I_WOUT, I_LN2, I_WUP, I_WDN, N_IN };
constexpr size_t MiB = 1u << 20;
constexpr size_t WS_CTL = 0, CTL_ZERO_BYTES = 64 * 1024;
constexpr size_t WS_SS1 = 1 * MiB, WS_SS2 = 2 * MiB;
constexpr size_t WS_WIN = 3 * MiB, WS_WOUT = WS_WIN + (size_t)NPROJ * D * 2, WS_WUP = WS_WOUT + (size_t)D * D * 2, WS_WDN = WS_WUP + (size_t)FF * D * 2;
constexpr size_t WS_R0 = 28 * MiB;
constexpr size_t R_MIX = WS_R0 + 0 * MiB;
constexpr size_t R_V = WS_R0 + 32 * MiB;
constexpr size_t R_RR = WS_R0 + 48 * MiB, R_KR = WS_R0 + 64 * MiB, R_VR = WS_R0 + 80 * MiB, R_XL = WS_R0 + 96 * MiB;
constexpr size_t R_SD = R_RR;
constexpr size_t R_PRE = WS_R0 + 104 * MiB;
constexpr size_t R_HID = WS_R0;
constexpr size_t R_XB = WS_R0 + 128 * MiB;
constexpr size_t R_BN = WS_R0 + 232 * MiB;
constexpr size_t WS_END = WS_R0 + 233 * MiB;
constexpr size_t WS_LORA = WS_WDN + (size_t)D * FF * 2;
constexpr size_t WS_G2T = WS_LORA + 4 * 512 * 64 * 2;
static_assert(WS_G2T + 512 * 128 * 2 <= WS_R0, "lora");
constexpr int CW_BAR = 1024;
constexpr int RING_OFF = 0, RING_BYTES = 131072;
constexpr int LDSCTL_OFF = 155648, MISC_OFF = LDSCTL_OFF + 320;
constexpr int LDS_BYTES = 163840;
#define GAS __attribute__((address_space(1)))
#define LAS __attribute__((address_space(3)))
typedef unsigned short bf16;
typedef unsigned v4u __attribute__((ext_vector_type(4)));
typedef float f32x4 __attribute__((ext_vector_type(4)));
typedef short bf16x8 __attribute__((ext_vector_type(8)));
typedef GAS unsigned gu32;
typedef GAS unsigned long long gu64;
#define RLX_AGENT __ATOMIC_RELAXED, __HIP_MEMORY_SCOPE_AGENT
#define LDS_WAIT() asm volatile("s_waitcnt lgkmcnt(0)" ::: "memory")
#define VM_WAIT() asm volatile("s_waitcnt vmcnt(0)" ::: "memory")
__device__ __forceinline__ unsigned long long rt() { return __builtin_amdgcn_s_memrealtime(); }
__device__ __forceinline__ unsigned f2bf(float f) { unsigned u = __builtin_bit_cast(unsigned, f); return (u + 0x7fffu + ((u >> 16) & 1u)) >> 16; }
__device__ __forceinline__ unsigned pk2(float lo, float hi) { return f2bf(lo) | (f2bf(hi) << 16); }

#define XB_TMO      128
#define XB_XCNT(j)  (256  + 64 * (j))
#define XB_XSUB(j)  (1280 + 64 * (j))
#define XB_XGEN(j)  (2304 + 64 * (j))
#define XB_TOP      3328
#define XB_TOPGEN   3392
#define XCD_BAR_WORDS 3456
#define XB_SPIN_CAP (1u << 18)

__device__ __forceinline__ unsigned xb_ld(unsigned* p)              { return __hip_atomic_load(p, __ATOMIC_RELAXED, __HIP_MEMORY_SCOPE_AGENT); }
__device__ __forceinline__ unsigned xb_add(unsigned* p, unsigned v) { return __hip_atomic_fetch_add(p, v, __ATOMIC_RELAXED, __HIP_MEMORY_SCOPE_AGENT); }
__device__ __forceinline__ unsigned xb_xcc_id() { return (unsigned)__builtin_amdgcn_s_getreg((3 << 11) | 20) & 0xFu; }
#define XB_SPIN(cond, bar) do { unsigned _sp = 0; while (cond) { __builtin_amdgcn_s_sleep(1); \
    if ((++_sp & 255u) == 0u) { if (xb_ld(&(bar)[XB_TMO])) break; if (_sp > XB_SPIN_CAP) { atomicAdd(&(bar)[XB_TMO], 1u); break; } } } } while (0)

struct XcdBarrier {
    unsigned* bar; unsigned x;
    volatile LAS unsigned* st;
};

__device__ __forceinline__ XcdBarrier xcd_barrier_post(unsigned* bar, volatile LAS unsigned* st, bool tid0) {
    XcdBarrier b; b.bar = bar; b.x = xb_xcc_id(); b.st = st;
    if (tid0) (void)xb_add(&bar[XB_XCNT(b.x)], 1u);
    return b;
}
__device__ __forceinline__ void xcd_barrier_complete(unsigned* bar, unsigned x, unsigned& nloc, unsigned& nx) {
    const unsigned G = gridDim.x * gridDim.y * gridDim.z;
    unsigned sum, cnt, mine, sp = 0u;
    for (;;) {
        sum = 0u; cnt = 0u; mine = 0u;
#pragma unroll
        for (unsigned j = 0; j < 16; ++j) { const unsigned c = xb_ld(&bar[XB_XCNT(j)]); sum += c; cnt += (c > 0u) ? 1u : 0u; mine = (j == x) ? c : mine; }
        if (sum == G) break;
        __builtin_amdgcn_s_sleep(1);
        if ((++sp & 255u) == 0u) { if (xb_ld(&bar[XB_TMO])) break; if (sp > XB_SPIN_CAP) { atomicAdd(&bar[XB_TMO], 1u); break; } }
    }
    nloc = mine > 0u ? mine : 1u; nx = cnt > 0u ? cnt : 1u;
}

__device__ __forceinline__ void xcd_barrier(const XcdBarrier& b, bool tid0) {
    asm volatile("s_waitcnt vmcnt(0)" ::: "memory");
    __syncthreads();
    if (tid0) {
        unsigned* bar = b.bar; asm volatile("" : "+v"(bar));
        __builtin_amdgcn_s_waitcnt(0);
        unsigned nloc = b.st[0], nx = b.st[1];
        if (nloc == 0u) { xcd_barrier_complete(bar, b.x, nloc, nx); b.st[0] = nloc; b.st[1] = nx; }
        const unsigned old = xb_add(&bar[XB_XSUB(b.x)], 1u);
        const unsigned gen = old / nloc;
        if (old + 1u == (gen + 1u) * nloc) {
            __builtin_amdgcn_fence(__ATOMIC_RELEASE, "agent");
            asm volatile("s_waitcnt vmcnt(0)" ::: "memory");
            const unsigned og = xb_add(&bar[XB_TOP], 1u);
            const unsigned tg = og / nx;
            if (og + 1u == (tg + 1u) * nx) xb_add(&bar[XB_TOPGEN], 1u);
            else XB_SPIN(xb_ld(&bar[XB_TOPGEN]) == tg, bar);
            __builtin_amdgcn_fence(__ATOMIC_ACQUIRE, "agent");
            xb_add(&bar[XB_XGEN(b.x)], 1u);
            asm volatile("s_waitcnt vmcnt(0)" ::: "memory");
        } else {
            XB_SPIN(xb_ld(&bar[XB_XGEN(b.x)]) == gen, bar);
            __builtin_amdgcn_fence(__ATOMIC_ACQUIRE, "agent");
            asm volatile("s_waitcnt vmcnt(0)" ::: "memory");
        }
    }
    __syncthreads();
}
__device__ __forceinline__ float bf2f(bf16 v) { return __uint_as_float(((unsigned)v) << 16); }
__device__ __forceinline__ bf16 f2bf_s(float f) { return (bf16)f2bf(f); }
__device__ __forceinline__ float wave_sum(float v, int lane) {
#pragma unroll
    for (int o = 1; o < 64; o <<= 1) v += pg8::shx(v, o, lane);
    return v;
}
__device__ __forceinline__ float sigmoidf_(float z) { return 1.0f / (1.0f + __expf(-z)); }
__device__ __forceinline__ float tanh_fast(float x) { return 1.0f - 2.0f / (__expf(2.0f * x) + 1.0f); }

struct Args { const float* in[N_IN]; float* out; unsigned char* ws; };
typedef const __attribute__((address_space(4))) Args CArgs;
__device__ __forceinline__ const CArgs* kargs() { const CArgs* p = (const CArgs*)__builtin_amdgcn_kernarg_segment_ptr(); asm volatile("" : "+s"(p)); return p; }
__device__ __forceinline__ unsigned char* kws() { return kargs()->ws; }
__device__ __forceinline__ float* kout() { return kargs()->out; }
__device__ __forceinline__ const float* karg(int i) { return kargs()->in[i]; }
__device__ __forceinline__ int lane_id() { int l; asm volatile("v_mbcnt_lo_u32_b32 %0, -1, 0\n\tv_mbcnt_hi_u32_b32 %0, -1, %0" : "=v"(l)); return l; }
struct Frame {
    LAS unsigned char* lds;
    volatile LAS unsigned* MISC;
    gu32* ctl;
    int vcu, G, wv;
};

__device__ __forceinline__ float ushift(const bf16* buf, int ldc, int col, int row, int t, float sp, float sn) {
    const bf16* p = buf + (size_t)row * ldc + col;
    const float u0 = bf2f(p[0]);
    const float up = (t > 0) ? bf2f(p[-ldc]) : 0.f;
    const float un = (t < SEQ - 1) ? bf2f(p[ldc]) : 0.f;
    return u0 + sp * (up - u0) + sn * (un - u0);
}

__device__ __forceinline__ void transpose_item(const float* W, int K, int N, bf16* WT, const float* gain, bool headperm, LAS float* scr, int item, int lane) {
    const int nblk = N / 32, kb = item / nblk, nb = item % nblk, k0 = 64 * kb, n0 = 32 * nb;
#pragma unroll 8
    for (int i = 0; i < 32; ++i) { const int kk = 2 * i + (lane >> 5); float w = W[(size_t)(k0 + kk) * N + n0 + (lane & 31)]; if (gain) w *= gain[k0 + kk]; scr[kk * 33 + (lane & 31)] = w; }
    LDS_WAIT(); asm volatile("" ::: "memory");
    const int c = lane & 7;
    const int p0 = headperm ? ((n0 & ~255) + 128 * ((n0 >> 5) & 1) + 32 * ((n0 >> 6) & 3)) : n0;
#pragma unroll
    for (int j = 0; j < 4; ++j) { const int n = (lane >> 3) + 8 * j; const LAS float* s = scr + (8 * c) * 33 + n;
        v4u o; o.x = pk2(s[0 * 33], s[1 * 33]); o.y = pk2(s[2 * 33], s[3 * 33]); o.z = pk2(s[4 * 33], s[5 * 33]); o.w = pk2(s[6 * 33], s[7 * 33]);
        *(GAS v4u*)(WT + (size_t)(p0 + n) * K + k0 + 8 * c) = o; }
    LDS_WAIT(); asm volatile("" ::: "memory");
}
__device__ __forceinline__ void wconv_items(int layerA, int layerB, int wi, int nw, LAS float* scr, int lane_) {
    unsigned char* const ws = kws();
    constexpr int I_1 = (D / 64) * (NPROJ / 32), I_2 = (D / 64) * (D / 32), I_3 = (D / 64) * (FF / 32), I_4 = (FF / 64) * (D / 32);
    constexpr int NA = I_1 + 64, NB = I_2 + I_3 + I_4 + 32;
    const int nA = (layerA >= 0 && layerA < DEPTH) ? NA : 0, nB = (layerB >= 0) ? NB : 0;
    for (int it = wi; it < nA + nB; it += nw) {
        int r = it;
        if (r < nA) { const int layer = layerA;
            if (r < I_1) { transpose_item(karg(I_WIN) + (size_t)layer * D * NPROJ, D, NPROJ, (bf16*)(ws + WS_WIN), karg(I_LN1) + layer * D, true, scr, r, lane_); continue; } r -= I_1;
            const int mat = r >> 4, it16 = r & 15;
            const float* src = (mat < 2 ? karg(I_W2) : karg(I_A2)) + (size_t)(layer * 2 + (mat & 1)) * 64 * 512;
            transpose_item(src, 64, 512, (bf16*)(ws + WS_LORA) + (size_t)mat * 512 * 64, nullptr, false, scr, it16, lane_); continue; }
        r -= nA; const int layer = layerB;
        if (r < I_2) { transpose_item(karg(I_WOUT) + (size_t)layer * D * D, D, D, (bf16*)(ws + WS_WOUT), nullptr, false, scr, r, lane_); continue; } r -= I_2;
        if (r < I_3) { transpose_item(karg(I_WUP) + (size_t)layer * D * FF, D, FF, (bf16*)(ws + WS_WUP), karg(I_LN2) + layer * D, false, scr, r, lane_); continue; } r -= I_3;
        if (r < I_4) { transpose_item(karg(I_WDN) + (size_t)layer * FF * D, FF, D, (bf16*)(ws + WS_WDN), nullptr, false, scr, r, lane_); continue; } r -= I_4;
        transpose_item(karg(I_G2) + (size_t)layer * 128 * 512, 128, 512, (bf16*)(ws + WS_G2T), nullptr, false, scr, r, lane_);
    }
}
__device__ __forceinline__ void x_prologue(Frame& F) {
    unsigned char* const ws = kws();
    int lane_ = lane_id(); asm volatile("" : "+v"(lane_)); int wave_o = F.wv; asm volatile("" : "+s"(wave_o)); const int wave_ = wave_o, tid_ = wave_ * 64 + lane_;
    const int gw = F.vcu * NWAVES + wave_, NGW = F.G * NWAVES;
    const float* x = karg(I_X); bf16* xb = (bf16*)(ws + R_XB); float* ss = (float*)(ws + WS_SS1);
    for (int m = gw; m < M; m += NGW) {
        const GAS f32x4* xr = (const GAS f32x4*)(x + (size_t)m * D) + lane_; GAS f32x4* orow = (GAS f32x4*)(kout() + (size_t)m * D) + lane_;
        GAS unsigned long long* o8 = (GAS unsigned long long*)(xb + (size_t)m * D) + lane_;
        float s = 0.f;
#pragma unroll
        for (int j = 0; j < 4; ++j) { const f32x4 v = xr[64 * j]; orow[64 * j] = v; s += (v.x * v.x + v.y * v.y) + (v.z * v.z + v.w * v.w);
            o8[64 * j] = (unsigned long long)pk2(v.x, v.y) | ((unsigned long long)pk2(v.z, v.w) << 32); }
        s = wave_sum(s, lane_);
        if (lane_ < 16) ss[(size_t)m * 16 + lane_] = (lane_ == 0) ? s : 0.f;
    }
}

__device__ __forceinline__ void attn_naive(Frame& F, int layer, int aw, int naw) {
    unsigned char* const ws = kws();
    int lane_ = lane_id(); asm volatile("" : "+v"(lane_)); int wave_o = F.wv; asm volatile("" : "+s"(wave_o)); const int wave_ = wave_o, tid_ = wave_ * 64 + lane_;
    bf16* MIX = (bf16*)(ws + R_MIX); const bf16* Q = MIX; const bf16* K = MIX + 512; const bf16* V = (const bf16*)(ws + R_V);
    LAS float* qs = (LAS float*)(F.lds + RING_OFF + wave_ * 4096); LAS float* pb = qs + 64;
    float bound;
    { const float* qg = karg(I_QG) + layer * HD; const float* kg = karg(I_KG) + layer * HD; float mq = 0.f, mk = 0.f;
      for (int i = 0; i < HD; ++i) { mq = fmaxf(mq, fabsf(qg[i])); mk = fmaxf(mk, fabsf(kg[i])); }
      bound = 8.0f * mq * mk + 0.25f; }
    const int lane = lane_;
    for (int unit = aw; unit < BATCH * H * SEQ; unit += naw) {
        const int t = unit % SEQ, bh = unit / SEQ, h = bh % H, b = bh / H; const size_t row = (size_t)b * SEQ + t;
        qs[lane] = bf2f(Q[row * 1024 + h * HD + lane]);
        LDS_WAIT(); asm volatile("" ::: "memory");
        float qv[HD];
#pragma unroll
        for (int i = 0; i < HD; ++i) qv[i] = qs[i];
        const float slope = exp2f(-(float)(h + 1));
        float lsum = 0.f;
        for (int bi = 0; bi < 3; ++bi) { const int d = 1 << (2 * bi);
            for (int pass = 0; pass < 3; ++pass) { const int jj = pass * 64 + lane; const bool act = jj <= 128; const int j = jj - 64; const int pos = t + j * d; const bool valid = act && pos >= 0 && pos < SEQ;
                float p = 0.f;
                if (valid) { const v4u* kr = (const v4u*)(K + ((size_t)b * SEQ + pos) * 1024 + h * HD); float dot = 0.f;
#pragma unroll
                    for (int c = 0; c < 8; ++c) { const v4u w = kr[c];
                        dot += qv[8 * c + 0] * __uint_as_float(w.x << 16) + qv[8 * c + 1] * __uint_as_float(w.x & 0xffff0000u) + qv[8 * c + 2] * __uint_as_float(w.y << 16) + qv[8 * c + 3] * __uint_as_float(w.y & 0xffff0000u)
                             + qv[8 * c + 4] * __uint_as_float(w.z << 16) + qv[8 * c + 5] * __uint_as_float(w.z & 0xffff0000u) + qv[8 * c + 6] * __uint_as_float(w.w << 16) + qv[8 * c + 7] * __uint_as_float(w.w & 0xffff0000u); }
                    const float s = dot - slope * fabsf((float)(j * d)); p = __expf(s - bound); }
                if (act) pb[bi * 129 + jj] = p;
                lsum += p; } }
        lsum = wave_sum(lsum, lane_);
        LDS_WAIT(); asm volatile("" ::: "memory");
        float o = 0.f;
        for (int bi = 0; bi < 3; ++bi) { const int d = 1 << (2 * bi);
            for (int jj = 0; jj < 129; ++jj) { const float p = pb[bi * 129 + jj];
                if (p != 0.f) { const int pos = t + (jj - 64) * d; o += p * bf2f(V[((size_t)b * SEQ + pos) * 512 + h * HD + lane]); } } }
        MIX[row * 1024 + h * HD + lane] = f2bf_s(o / lsum);
        LDS_WAIT(); asm volatile("" ::: "memory");
    }
}

typedef float f32x16 __attribute__((ext_vector_type(16)));
typedef short s16x4 __attribute__((ext_vector_type(4)));
typedef short v4i16_t __attribute__((ext_vector_type(4)));
typedef unsigned u32x2_t __attribute__((ext_vector_type(2)));
typedef float f32x2_t __attribute__((ext_vector_type(2))); typedef __bf16 bf16x2_t __attribute__((ext_vector_type(2)));
__device__ __forceinline__ unsigned cvtpk(float lo, float hi) { f32x2_t v = {lo, hi}; bf16x2_t b = __builtin_convertvector(v, bf16x2_t); return __builtin_bit_cast(unsigned, b); }
typedef _Float16 h16x2_t __attribute__((ext_vector_type(2))); typedef _Float16 h16x8 __attribute__((ext_vector_type(8)));
__device__ __forceinline__ unsigned cvtpk_h(float lo, float hi) { f32x2_t v = {lo, hi}; h16x2_t b = __builtin_convertvector(v, h16x2_t); return __builtin_bit_cast(unsigned, b); }
__device__ __forceinline__ f32x2_t unpk_h(unsigned w) { return __builtin_convertvector(__builtin_bit_cast(h16x2_t, w), f32x2_t); }
#define MFMA32H(nf, mf, acc) __builtin_amdgcn_mfma_f32_32x32x16_f16(__builtin_bit_cast(h16x8, (nf)), __builtin_bit_cast(h16x8, (mf)), (acc), 0, 0, 0)
constexpr int TSB = 144, TILE_B = 64 * TSB;
constexpr int PRE_TW = 14 * TILE_B, PRE_XA = 15 * TILE_B, PRE_INVN = 16 * TILE_B, PRE_GC = PRE_INVN + 256, PRE_BON = PRE_GC + 512, PRE_LDS_END = PRE_BON + 1024;
static_assert(PRE_LDS_END <= LDSCTL_OFF, "PRE LDS map");
__device__ __forceinline__ bf16x8 frag_row(const LAS unsigned char* tile, int row, int ks, int hi) {
    return *(const LAS bf16x8*)(tile + row * TSB + (16 * ks + 8 * hi) * 2);
}
__device__ __forceinline__ s16x4 tr4(const LAS unsigned char* p) { return __builtin_bit_cast(s16x4, __builtin_amdgcn_ds_read_tr16_b64_v4i16((LAS v4i16_t*)p)); }
__device__ __forceinline__ bf16x8 frag_tr(const LAS unsigned char* tile, int idx0, int ks, int lane) {
    const int hi = lane >> 5, g1 = (lane >> 4) & 1, i = lane & 15;
    const LAS unsigned char* p = tile + (16 * ks + 8 * hi + (i >> 2)) * TSB + (idx0 + 16 * g1 + 4 * (i & 3)) * 2;
    const s16x4 lo = tr4(p), h4 = tr4(p + 4 * TSB);
    return (bf16x8){lo[0], lo[1], lo[2], lo[3], h4[0], h4[1], h4[2], h4[3]};
}
__device__ __forceinline__ void store_quad(LAS unsigned char* tile, int row, int n0, int hi, const f32x16& a) {
#pragma unroll
    for (int q = 0; q < 4; ++q) { u32x2_t w; w.x = cvtpk(a[4 * q], a[4 * q + 1]); w.y = cvtpk(a[4 * q + 2], a[4 * q + 3]); *(LAS u32x2_t*)(tile + row * TSB + (n0 + 8 * q + 4 * hi) * 2) = w; }
}
__device__ __forceinline__ void store_quad_h(LAS unsigned char* tile, int row, int n0, int hi, const f32x16& a) {
#pragma unroll
    for (int q = 0; q < 4; ++q) { u32x2_t w; w.x = cvtpk_h(a[4 * q], a[4 * q + 1]); w.y = cvtpk_h(a[4 * q + 2], a[4 * q + 3]); *(LAS u32x2_t*)(tile + row * TSB + (n0 + 8 * q + 4 * hi) * 2) = w; }
}
__device__ __forceinline__ f32x16 load_quad(const LAS unsigned char* tile, int row, int n0, int hi) {
    f32x16 a;
#pragma unroll
    for (int q = 0; q < 4; ++q) { const u32x2_t w = *(const LAS u32x2_t*)(tile + row * TSB + (n0 + 8 * q + 4 * hi) * 2);
        a[4 * q] = __uint_as_float(w.x << 16); a[4 * q + 1] = __uint_as_float(w.x & 0xffff0000u); a[4 * q + 2] = __uint_as_float(w.y << 16); a[4 * q + 3] = __uint_as_float(w.y & 0xffff0000u); }
    return a;
}
#define MFMA32(nf, mf, acc) __builtin_amdgcn_mfma_f32_32x32x16_bf16((nf), (mf), (acc), 0, 0, 0)
#define WG_BAR() do { asm volatile("s_waitcnt vmcnt(0) lgkmcnt(0)" ::: "memory"); __builtin_amdgcn_s_barrier(); asm volatile("" ::: "memory"); } while (0)
__device__ __forceinline__ void shift8(const bf16* buf, int ldc, int col, int row, int t, const float* sp, const float* sn, float (&out)[8]) {
    const bf16* p = buf + (size_t)row * ldc + col;
    const v4u c = *(const v4u*)p; v4u pv = (v4u){0u, 0u, 0u, 0u}, nv = (v4u){0u, 0u, 0u, 0u};
    if (t > 0) pv = *(const v4u*)(p - ldc);
    if (t < SEQ - 1) nv = *(const v4u*)(p + ldc);
    const f32x4 sp0 = *(const f32x4*)sp, sp1 = *(const f32x4*)(sp + 4), sn0 = *(const f32x4*)sn, sn1 = *(const f32x4*)(sn + 4);
#pragma unroll
    for (int j = 0; j < 8; ++j) { const unsigned cw = c[j >> 1], pw = pv[j >> 1], nw = nv[j >> 1];
        const float u0 = (j & 1) ? __uint_as_float(cw & 0xffff0000u) : __uint_as_float(cw << 16), up = (j & 1) ? __uint_as_float(pw & 0xffff0000u) : __uint_as_float(pw << 16), un = (j & 1) ? __uint_as_float(nw & 0xffff0000u) : __uint_as_float(nw << 16);
        const float a = (j < 4) ? sp0[j & 3] : sp1[j & 3], bq = (j < 4) ? sn0[j & 3] : sn1[j & 3];
        out[j] = u0 + a * (up - u0) + bq * (un - u0); }
}
__device__ __forceinline__ f32x4 shift4(const bf16* buf, int ldc, int col, int row, int t, const float* sp, const float* sn) {
    const bf16* p = buf + (size_t)row * ldc + col;
    const u32x2_t c = *(const u32x2_t*)p; u32x2_t pv = (u32x2_t){0u, 0u}, nv = (u32x2_t){0u, 0u};
    if (t > 0) pv = *(const u32x2_t*)(p - ldc);
    if (t < SEQ - 1) nv = *(const u32x2_t*)(p + ldc);
    const f32x4 a = *(const f32x4*)sp, bq = *(const f32x4*)sn;
    const f32x4 u0 = (f32x4){__uint_as_float(c.x << 16), __uint_as_float(c.x & 0xffff0000u), __uint_as_float(c.y << 16), __uint_as_float(c.y & 0xffff0000u)};
    const f32x4 up = (f32x4){__uint_as_float(pv.x << 16), __uint_as_float(pv.x & 0xffff0000u), __uint_as_float(pv.y << 16), __uint_as_float(pv.y & 0xffff0000u)};
    const f32x4 un = (f32x4){__uint_as_float(nv.x << 16), __uint_as_float(nv.x & 0xffff0000u), __uint_as_float(nv.y << 16), __uint_as_float(nv.y & 0xffff0000u)};
    return u0 + a * (up - u0) + bq * (un - u0);
}

__device__ __forceinline__ void rwkv_pre_phase(Frame& F, int layer) {
    unsigned char* const ws = kws();
    int lane_ = lane_id(); asm volatile("" : "+v"(lane_)); int wave_o = F.wv; asm volatile("" : "+s"(wave_o)); const int wave_ = wave_o, tid_ = wave_ * 64 + lane_;
    const int d = wave_ >> 2, qm = (wave_ >> 1) & 1, qn = wave_ & 1, m0 = 32 * qm, n0 = 32 * qn;
#define LANE_VARS int lane = lane_; asm volatile("" : "+v"(lane)); const int hi = lane >> 5, l31 = lane & 31, mrow = m0 + l31; (void)hi; (void)l31; (void)mrow;
    LAS unsigned char* const L = F.lds;
    LAS unsigned char* const T0 = L + (d * 7 + 0) * TILE_B; LAS unsigned char* const T1 = L + (d * 7 + 1) * TILE_B; LAS unsigned char* const T2 = L + (d * 7 + 2) * TILE_B; LAS unsigned char* const T3 = L + (d * 7 + 3) * TILE_B;
    LAS unsigned char* const T4 = L + (d * 7 + 4) * TILE_B; LAS unsigned char* const T5 = L + (d * 7 + 5) * TILE_B; LAS unsigned char* const T6 = L + (d * 7 + 6) * TILE_B;
    LAS unsigned char* const TWt = L + PRE_TW; LAS unsigned char* const XAt = L + PRE_XA;
    LAS float* const invn = (LAS float*)(L + PRE_INVN); LAS float* const gcs = (LAS float*)(L + PRE_GC) + d * 64; LAS float* const bon = (LAS float*)(L + PRE_BON);
    const bf16* Rr = (const bf16*)(ws + R_RR); const bf16* Kr = (const bf16*)(ws + R_KR); const bf16* Vr = (const bf16*)(ws + R_VR); const bf16* XL = (const bf16*)(ws + R_XL);
    const bf16* W2T = (const bf16*)(ws + WS_LORA) + (size_t)d * 512 * 64; const bf16* A2T = (const bf16*)(ws + WS_LORA) + (size_t)(2 + d) * 512 * 64;
    float* BN = (float*)(ws + R_BN) + (size_t)d * M * 8;
    const float* sp = karg(I_TSP) + layer * RPROJ; const float* sn = karg(I_TSN) + layer * RPROJ;
    const float* w0 = karg(I_W0) + (layer * 2 + d) * 512; const float* a0 = karg(I_A0) + (layer * 2 + d) * 512;
    const float* kkp = karg(I_KK) + layer * 512; const float* kap = karg(I_KA) + layer * 512; const float* rkp = karg(I_RK) + layer * 512;
    for (int item = F.vcu; item < BATCH * H * (SEQ / 64); item += F.G) {
        const int cn = item & 63, h = (item >> 6) & 7, b = item >> 9, t0 = cn * 64, hc = h * HD;
#define SNAT (d ? 63 - mrow : mrow)
        { LANE_VARS; const int tidl = wave_ * 64 + lane; const int tok = tidl >> 3, oct = tidl & 7, t = t0 + tok, row = b * SEQ + t; float v8[8];
          shift8(XL, 256, 8 * oct, row, t, sp + 1536 + 8 * oct, sn + 1536 + 8 * oct, v8);
          { v4u w; w.x = cvtpk(tanh_fast(v8[0]), tanh_fast(v8[1])); w.y = cvtpk(tanh_fast(v8[2]), tanh_fast(v8[3])); w.z = cvtpk(tanh_fast(v8[4]), tanh_fast(v8[5])); w.w = cvtpk(tanh_fast(v8[6]), tanh_fast(v8[7])); *(LAS v4u*)(TWt + tok * TSB + 16 * oct) = w; }
          shift8(XL, 256, 64 + 8 * oct, row, t, sp + 1600 + 8 * oct, sn + 1600 + 8 * oct, v8);
          { v4u w; w.x = cvtpk(v8[0], v8[1]); w.y = cvtpk(v8[2], v8[3]); w.z = cvtpk(v8[4], v8[5]); w.w = cvtpk(v8[6], v8[7]); *(LAS v4u*)(XAt + tok * TSB + 16 * oct) = w; }
          shift8(Kr, 512, hc + 8 * oct, row, t, sp + 512 + hc + 8 * oct, sn + 512 + hc + 8 * oct, v8);
          const f32x4 k0 = *(const f32x4*)(kkp + hc + 8 * oct), k1 = *(const f32x4*)(kkp + hc + 8 * oct + 4); float ssq = 0.f;
#pragma unroll
          for (int j = 0; j < 8; ++j) { const float kx = v8[j] * ((j < 4) ? k0[j & 3] : k1[j & 3]); ssq += kx * kx; }
          ssq += pg8::shx(ssq, 1, lane); ssq += pg8::shx(ssq, 2, lane); ssq += pg8::shx(ssq, 4, lane);
          if (oct == 0) invn[tok] = 1.0f / sqrtf(ssq + 1e-12f); }
        WG_BAR();
        f32x16 zw, za, lw, av, cum;
        { LANE_VARS; const int snat = SNAT;
#pragma unroll
        for (int r = 0; r < 16; ++r) { zw[r] = 0.f; za[r] = 0.f; }
#pragma unroll
        for (int ks = 0; ks < 4; ++ks) { const size_t wo = (size_t)(hc + n0 + l31) * 64 + 16 * ks + 8 * hi;
            const bf16x8 wf = *(const bf16x8*)(W2T + wo), af = *(const bf16x8*)(A2T + wo);
            zw = MFMA32(wf, frag_row(TWt, snat, ks, hi), zw); za = MFMA32(af, frag_row(XAt, snat, ks, hi), za); }
#pragma unroll
        for (int q = 0; q < 4; ++q) { const f32x4 w0v = *(const f32x4*)(w0 + hc + n0 + 8 * q + 4 * hi), a0v = *(const f32x4*)(a0 + hc + n0 + 8 * q + 4 * hi);
#pragma unroll
            for (int i = 0; i < 4; ++i) { lw[4 * q + i] = -0.6065306597f * sigmoidf_(zw[4 * q + i] + w0v[i]); av[4 * q + i] = sigmoidf_(za[4 * q + i] + a0v[i]); } }
        { f32x16 lh, ll;
#pragma unroll
          for (int r = 0; r < 16; ++r) { lh[r] = __uint_as_float(cvtpk(lw[r], 0.f) << 16); ll[r] = lw[r] - lh[r]; }
          store_quad(T4, mrow, n0, hi, lh); store_quad(T5, mrow, n0, hi, ll); } }
        WG_BAR();
        { LANE_VARS;
#pragma unroll
        for (int r = 0; r < 16; ++r) cum[r] = 0.f;
#pragma unroll
        for (int ks = 0; ks < 4; ++ks) { bf16x8 tf;
#pragma unroll
            for (int j = 0; j < 8; ++j) tf[j] = (16 * ks + 8 * hi + j <= mrow) ? (short)0x3f80 : (short)0;
            cum = MFMA32(frag_tr(T4, n0, ks, lane), tf, cum); cum = MFMA32(frag_tr(T5, n0, ks, lane), tf, cum); } }
        f32x16 rh, kc, mrk;
        { LANE_VARS; const int snat = SNAT; const int tnat = t0 + snat, row = b * SEQ + tnat; const float inv = invn[snat];
          float bsum = 0.f;
#pragma unroll
          for (int q = 0; q < 4; ++q) { const int cg = hc + n0 + 8 * q + 4 * hi;
              const f32x4 r4 = shift4(Rr, 512, cg, row, tnat, sp + cg, sn + cg), k4 = shift4(Kr, 512, cg, row, tnat, sp + 512 + cg, sn + 512 + cg);
              const f32x4 kk4 = *(const f32x4*)(kkp + cg), ka4 = *(const f32x4*)(kap + cg), rk4 = *(const f32x4*)(rkp + cg);
              float kh4[4], bc4[4], rl4[4], kl4[4];
#pragma unroll
              for (int i = 0; i < 4; ++i) { const int e = 4 * q + i; const float a = av[e], cs = cum[e];
                  const float g = __expf(cs), gx = __expf(cs - lw[e]), gi = __expf(-cs);
                  const float kkn = k4[i] * kk4[i] * inv, kt = k4[i] * (1.0f + (a - 1.0f) * ka4[i]);
                  kh4[i] = gx * kkn; rh[e] = g * r4[i]; bc4[i] = a * kkn * gi; kc[e] = kt * gi; bsum += r4[i] * kt * rk4[i];
                  rl4[i] = rh[e] - __uint_as_float(cvtpk(rh[e], 0.f) << 16); kl4[i] = kc[e] - __uint_as_float(cvtpk(kc[e], 0.f) << 16);
                  if (mrow == 63) gcs[n0 + 8 * q + 4 * hi + i] = g; }
              const int off = mrow * TSB + (n0 + 8 * q + 4 * hi) * 2; u32x2_t w;
              w.x = cvtpk(kh4[0], kh4[1]); w.y = cvtpk(kh4[2], kh4[3]); *(LAS u32x2_t*)(T0 + off) = w;
              w.x = cvtpk(rh[4 * q], rh[4 * q + 1]); w.y = cvtpk(rh[4 * q + 2], rh[4 * q + 3]); *(LAS u32x2_t*)(T1 + off) = w;
              w.x = cvtpk(bc4[0], bc4[1]); w.y = cvtpk(bc4[2], bc4[3]); *(LAS u32x2_t*)(T2 + off) = w;
              w.x = cvtpk(kc[4 * q], kc[4 * q + 1]); w.y = cvtpk(kc[4 * q + 2], kc[4 * q + 3]); *(LAS u32x2_t*)(T3 + off) = w;
              w.x = cvtpk(rl4[0], rl4[1]); w.y = cvtpk(rl4[2], rl4[3]); *(LAS u32x2_t*)(T4 + off) = w;
              w.x = cvtpk(kl4[0], kl4[1]); w.y = cvtpk(kl4[2], kl4[3]); *(LAS u32x2_t*)(T5 + off) = w; }
          bsum += pg8::shx(bsum, 32, lane);
          if (hi == 0) bon[(d * 2 + qn) * 64 + snat] = bsum; }
        WG_BAR();
        { LANE_VARS; const int snat = SNAT; if (qn == 0 && hi == 0) BN[(size_t)(b * SEQ + t0 + snat) * 8 + h] = bon[(d * 2) * 64 + snat] + bon[(d * 2 + 1) * 64 + snat]; }
        { LANE_VARS;
#pragma unroll
          for (int r = 0; r < 16; ++r) mrk[r] = 0.f;
#pragma unroll
          for (int ks = 0; ks < 4; ++ks) { const bf16x8 rhi = frag_row(T1, mrow, ks, hi), khi = frag_row(T3, n0 + l31, ks, hi);
              mrk = MFMA32(khi, rhi, mrk); mrk = MFMA32(frag_row(T5, n0 + l31, ks, hi), rhi, mrk); mrk = MFMA32(khi, frag_row(T4, mrow, ks, hi), mrk); }
#pragma unroll
          for (int q = 0; q < 4; ++q)
#pragma unroll
              for (int i = 0; i < 4; ++i) { const int e = 4 * q + i, n = n0 + 8 * q + 4 * hi + i; mrk[e] = (n <= mrow) ? mrk[e] : 0.f; } }
        WG_BAR();
        { LANE_VARS; f32x16 x, mk, zz;
          float z0 = 0.f; asm volatile("" : "+v"(z0));
#pragma unroll
          for (int r = 0; r < 16; ++r) { x[r] = 0.f; mk[r] = 0.f; zz[r] = z0; }
#pragma unroll
          for (int ks = 0; ks < 4; ++ks) { const bf16x8 mf = frag_row(T0, mrow, ks, hi);
              x = MFMA32(frag_row(T2, n0 + l31, ks, hi), mf, x); mk = MFMA32(frag_row(T3, n0 + l31, ks, hi), mf, mk); }
#pragma unroll
          for (int q = 0; q < 4; ++q)
#pragma unroll
              for (int i = 0; i < 4; ++i) { const int e = 4 * q + i, n = n0 + 8 * q + 4 * hi + i; const bool lo = n < mrow; x[e] = lo ? -x[e] : 0.f; mk[e] = lo ? mk[e] : 0.f; }
          store_quad(T4, mrow, n0, hi, x); store_quad(T5, mrow, n0, hi, zz); store_quad(T6, mrow, n0, hi, mk); }
        WG_BAR();
        if ((wave_ & 3) == 0) { LANE_VARS; const int blk = lane >> 4, c = lane & 15; float t[16];
#pragma unroll
            for (int r = 0; r < 16; ++r) { const LAS unsigned char* xr = T4 + (16 * blk + r) * TSB + 32 * blk; const v4u w0_ = *(const LAS v4u*)xr, w1_ = *(const LAS v4u*)(xr + 16);
                float acc0 = (r == c) ? 1.0f : 0.f, acc1 = 0.f;
#pragma unroll
                for (int j = 0; j < r; ++j) { const unsigned w = (j < 8) ? w0_[j >> 1] : w1_[(j - 8) >> 1]; const float xv = (j & 1) ? __uint_as_float(w & 0xffff0000u) : __uint_as_float(w << 16);
                    if (j & 1) acc1 += xv * t[j]; else acc0 += xv * t[j]; }
                t[r] = acc0 + acc1; }
#pragma unroll
            for (int r = 0; r < 16; ++r) *(LAS unsigned short*)(T5 + (16 * blk + r) * TSB + (16 * blk + c) * 2) = (unsigned short)(cvtpk(t[r], 0.f) & 0xffffu); }
        WG_BAR();
        { LANE_VARS; LAS unsigned char* const scr = qm ? T5 : T4;
          if (qm == qn) {
              f32x16 w;
#pragma unroll
              for (int r = 0; r < 16; ++r) w[r] = 0.f;
              bf16x8 mf = frag_row(T4, m0 + l31, 2 * qm, hi);
              if (l31 < 16) mf = (bf16x8){0, 0, 0, 0, 0, 0, 0, 0};
              w = MFMA32(frag_tr(T5, m0, 2 * qm, lane), mf, w);
              store_quad(scr, l31, 32, hi, w); } }
        WG_BAR();
        { LANE_VARS; LAS unsigned char* const scr = qm ? T5 : T4;
          if (qm == qn) {
              f32x16 tq = load_quad(T5, mrow, m0, hi);
#pragma unroll
              for (int ks = 0; ks < 2; ++ks) tq = MFMA32(frag_tr(scr, 32, ks, lane), frag_row(T5, mrow, 2 * qm + ks, hi), tq);
              store_quad(T5, mrow, m0, hi, tq); } }
        WG_BAR();
        { LANE_VARS;
          if (qm == 1 && qn == 0) {
              f32x16 w;
#pragma unroll
              for (int r = 0; r < 16; ++r) w[r] = 0.f;
#pragma unroll
              for (int ks = 0; ks < 2; ++ks) w = MFMA32(frag_tr(T5, 0, ks, lane), frag_row(T4, 32 + l31, ks, hi), w);
              store_quad(T4, l31, 32, hi, w); }
          if (qm == 0 && qn == 1) { f32x16 zz; float z0 = 0.f; asm volatile("" : "+v"(z0));
#pragma unroll
              for (int r = 0; r < 16; ++r) zz[r] = z0;
              store_quad(T5, l31, 32, hi, zz); } }
        WG_BAR();
        { LANE_VARS;
          if (qm == 1 && qn == 0) {
              f32x16 t21;
#pragma unroll
              for (int r = 0; r < 16; ++r) t21[r] = 0.f;
#pragma unroll
              for (int ks = 0; ks < 2; ++ks) t21 = MFMA32(frag_tr(T4, 32, ks, lane), frag_row(T5, 32 + l31, 2 + ks, hi), t21);
              store_quad(T5, 32 + l31, 0, hi, t21); } }
        WG_BAR();
        { LANE_VARS; f32x16 kp, tk;
#pragma unroll
          for (int r = 0; r < 16; ++r) { kp[r] = 0.f; tk[r] = 0.f; }
#pragma unroll
          for (int ks = 0; ks < 4; ++ks) { const bf16x8 mf = frag_row(T5, mrow, ks, hi);
              kp = MFMA32(frag_tr(T0, n0, ks, lane), mf, kp); tk = MFMA32(frag_tr(T6, n0, ks, lane), mf, tk); }
          WG_BAR();
          store_quad(T0, mrow, n0, hi, kp); store_quad(T6, mrow, n0, hi, tk); }
        { LANE_VARS; f32x16 rb;
#pragma unroll
          for (int r = 0; r < 16; ++r) rb[r] = 0.f;
#pragma unroll
          for (int ks = 0; ks < 4; ++ks) rb = MFMA32(frag_row(T2, n0 + l31, ks, hi), frag_row(T1, mrow, ks, hi), rb);
#pragma unroll
          for (int q = 0; q < 4; ++q)
#pragma unroll
              for (int i = 0; i < 4; ++i) { const int e = 4 * q + i, n = n0 + 8 * q + 4 * hi + i; rb[e] = (n <= mrow) ? rb[e] : 0.f; }
          store_quad(T4, mrow, n0, hi, rb); }
        WG_BAR();
        const int cd = d ? 63 - cn : cn;
        bf16* const pre = (bf16*)(ws + R_PRE) + ((size_t)(((b * 8 + h) * 2 + d) * 64 + cd)) * 16384;
        { LANE_VARS; f32x16 rp, ml, pm, kq;
#pragma unroll
          for (int r = 0; r < 16; ++r) { rp[r] = 0.f; ml[r] = 0.f; pm[r] = 0.f; kq[r] = 0.f; }
#pragma unroll
          for (int ks = 0; ks < 4; ++ks) { const bf16x8 mrbf = frag_row(T4, mrow, ks, hi), khn = frag_tr(T0, n0, ks, lane), bcn = frag_tr(T2, n0, ks, lane);
              rp = MFMA32(khn, mrbf, rp); ml = MFMA32(frag_tr(T6, n0, ks, lane), mrbf, ml);
              pm = MFMA32(khn, frag_tr(T2, m0, ks, lane), pm); kq = MFMA32(bcn, frag_tr(T6, m0, ks, lane), kq); }
          const float gm = gcs[mrow];
#pragma unroll
          for (int q = 0; q < 4; ++q)
#pragma unroll
              for (int i = 0; i < 4; ++i) { const int e = 4 * q + i, n = n0 + 8 * q + 4 * hi + i;
                  rp[e] = rh[e] - rp[e]; ml[e] = mrk[e] - ml[e]; pm[e] = gm * (((n == mrow) ? 1.0f : 0.f) - pm[e]); kq[e] = (kc[e] - kq[e]) * gcs[n]; }
#pragma unroll
          for (int q = 0; q < 4; ++q) { const int pc = n0 + 16 * (q >> 1) + 8 * hi + 4 * (q & 1);
              u32x2_t w; w.x = cvtpk_h(pm[4 * q], pm[4 * q + 1]); w.y = cvtpk_h(pm[4 * q + 2], pm[4 * q + 3]); *(u32x2_t*)(pre + mrow * 64 + pc) = w;
              w.x = cvtpk_h(rp[4 * q], rp[4 * q + 1]); w.y = cvtpk_h(rp[4 * q + 2], rp[4 * q + 3]); *(u32x2_t*)(pre + 4096 + (d ? 63 - mrow : mrow) * 64 + pc) = w; }
          WG_BAR();
          store_quad_h(T4, mrow, n0, hi, ml); store_quad_h(T5, mrow, n0, hi, kq); }
        { LANE_VARS; const int tt = (wave_ * 64 + lane) & 255, s = tt >> 2, cg4 = (tt & 3) * 16, sn_ = d ? 63 - s : s, t = t0 + sn_, row = b * SEQ + t; float v8[8];
#pragma unroll
          for (int hlf = 0; hlf < 2; ++hlf) { const int c8 = cg4 + 8 * hlf;
              shift8(Vr, 512, hc + c8, row, t, sp + 1024 + hc + c8, sn + 1024 + hc + c8, v8);
              v4u w; w.x = cvtpk_h(v8[0], v8[1]); w.y = cvtpk_h(v8[2], v8[3]); w.z = cvtpk_h(v8[4], v8[5]); w.w = cvtpk_h(v8[6], v8[7]); *(LAS v4u*)(T1 + s * TSB + 2 * c8) = w; } }
        WG_BAR();
        { LANE_VARS; f32x16 qt, yt;
#pragma unroll
          for (int r = 0; r < 16; ++r) { qt[r] = 0.f; yt[r] = 0.f; }
#pragma unroll
          for (int ks = 0; ks < 4; ++ks) { const bf16x8 vf = frag_tr(T1, m0, ks, lane);
              qt = MFMA32H(frag_tr(T5, n0, ks, lane), vf, qt); yt = MFMA32H(frag_tr(T1, n0, ks, lane), frag_row(T4, mrow, ks, hi), yt); }
          v4u w0_, w1_;
          w0_.x = cvtpk_h(qt[0], qt[1]); w0_.y = cvtpk_h(qt[2], qt[3]); w0_.z = cvtpk_h(qt[4], qt[5]); w0_.w = cvtpk_h(qt[6], qt[7]); w1_.x = cvtpk_h(qt[8], qt[9]); w1_.y = cvtpk_h(qt[10], qt[11]); w1_.z = cvtpk_h(qt[12], qt[13]); w1_.w = cvtpk_h(qt[14], qt[15]);
          { bf16* dst = pre + 8192 + ((qn * 64 + mrow) * 2 + hi) * 16; *(v4u*)dst = w0_; *(v4u*)(dst + 8) = w1_; }
          w0_.x = cvtpk_h(yt[0], yt[1]); w0_.y = cvtpk_h(yt[2], yt[3]); w0_.z = cvtpk_h(yt[4], yt[5]); w0_.w = cvtpk_h(yt[6], yt[7]); w1_.x = cvtpk_h(yt[8], yt[9]); w1_.y = cvtpk_h(yt[10], yt[11]); w1_.z = cvtpk_h(yt[12], yt[13]); w1_.w = cvtpk_h(yt[14], yt[15]);
          { bf16* dst = pre + 12288 + ((qn * 64 + (d ? 63 - mrow : mrow)) * 2 + hi) * 16; *(v4u*)dst = w0_; *(v4u*)(dst + 8) = w1_; } }
        WG_BAR();
    }
#undef LANE_VARS
#undef SNAT
}

constexpr int SCAN_SLOT = 12 * 1024, SCAN_NS = 4;
__device__ __forceinline__ void scan_issue(const bf16* pre, LAS unsigned char* slot, int l31, int hi, int v) {
#pragma unroll
    for (int i = 0; i < 8; ++i) { const int mt = i >> 2, kt = (i >> 1) & 1, s = i & 1;
        __builtin_amdgcn_global_load_lds((const unsigned*)(pre + (32 * mt + l31) * 64 + 32 * kt + 16 * s + 8 * hi), (LAS unsigned*)(slot + i * 1024), 16, 0, 0); }
#pragma unroll
    for (int i = 0; i < 4; ++i) { const int mt = i >> 1, hf = i & 1;
        __builtin_amdgcn_global_load_lds((const unsigned*)(pre + 8192 + ((mt * 64 + v) * 2 + hi) * 16 + 8 * hf), (LAS unsigned*)(slot + (8 + i) * 1024), 16, 0, 0); }
}
__device__ __forceinline__ void rwkv_scan_chunk(Frame& F, int unit) {
    unsigned char* const ws = kws();
    int lane_ = lane_id(); asm volatile("" : "+v"(lane_));
    const int lane = lane_, hi = lane >> 5, l31 = lane & 31;
    const int chain = unit >> 1, vh = unit & 1, v = 32 * vh + l31;
    const bf16* pre = (const bf16*)(ws + R_PRE) + (size_t)chain * 64 * 16384;
    bf16* sd = (bf16*)(ws + R_SD) + (size_t)chain * 64 * 4096;
    LAS unsigned char* const ring = F.lds;
    f32x16 X0, X1;
#pragma unroll
    for (int r = 0; r < 16; ++r) { X0[r] = 0.f; X1[r] = 0.f; }
    scan_issue(pre, ring, l31, hi, v); scan_issue(pre + 16384, ring + SCAN_SLOT, l31, hi, v); scan_issue(pre + 2 * 16384, ring + 2 * SCAN_SLOT, l31, hi, v);
#pragma unroll 1
    for (int c = 0; c < 64; ++c) {
        bf16x8 xb[2][2], xl[2][2];
#pragma unroll
        for (int kt = 0; kt < 2; ++kt)
#pragma unroll
            for (int s = 0; s < 2; ++s) { v4u w, wl;
#pragma unroll
                for (int j = 0; j < 4; ++j) { const float a0 = kt ? X1[8 * s + 2 * j] : X0[8 * s + 2 * j], a1 = kt ? X1[8 * s + 2 * j + 1] : X0[8 * s + 2 * j + 1];
                    const unsigned hw = cvtpk_h(a0, a1); const f32x2_t hf = unpk_h(hw); w[j] = hw; wl[j] = cvtpk_h(a0 - hf.x, a1 - hf.y); }
                xb[kt][s] = __builtin_bit_cast(bf16x8, w); xl[kt][s] = __builtin_bit_cast(bf16x8, wl);
                *(v4u*)(sd + (size_t)c * 4096 + ((kt * 64 + v) * 2 + hi) * 16 + 8 * s) = w; }
        asm volatile("s_waitcnt lgkmcnt(0)" ::: "memory");
        if (c + 3 < 64) scan_issue(pre + (size_t)(c + 3) * 16384, ring + ((c + 3) & 3) * SCAN_SLOT, l31, hi, v);
        if (c + 3 < 64) asm volatile("s_waitcnt vmcnt(36)" ::: "memory"); else asm volatile("s_waitcnt vmcnt(0)" ::: "memory");
        const LAS unsigned char* sl = ring + (c & 3) * SCAN_SLOT + lane * 16;
        f32x16 acc[2];
#pragma unroll
        for (int mt = 0; mt < 2; ++mt) { const v4u w0_ = *(const LAS v4u*)(sl + (8 + 2 * mt) * 1024), w1_ = *(const LAS v4u*)(sl + (9 + 2 * mt) * 1024);
#pragma unroll
            for (int j = 0; j < 4; ++j) { const f32x2_t u0 = unpk_h(w0_[j]), u1 = unpk_h(w1_[j]); acc[mt][2 * j] = u0.x; acc[mt][2 * j + 1] = u0.y; acc[mt][8 + 2 * j] = u1.x; acc[mt][8 + 2 * j + 1] = u1.y; } }
#pragma unroll
        for (int mt = 0; mt < 2; ++mt)
#pragma unroll
            for (int kt = 0; kt < 2; ++kt)
#pragma unroll
                for (int s = 0; s < 2; ++s) { const bf16x8 af = *(const LAS bf16x8*)(sl + (4 * mt + 2 * kt + s) * 1024); acc[mt] = MFMA32H(af, xb[kt][s], acc[mt]); acc[mt] = MFMA32H(af, xl[kt][s], acc[mt]); }
        X0 = acc[0]; X1 = acc[1];
    }
}

constexpr int FIN_SGS = 272;
__device__ __forceinline__ void rwkv_finalize_mfma(Frame& F, int layer) {
    unsigned char* const ws = kws();
    int lane_ = lane_id(); asm volatile("" : "+v"(lane_)); int wave_o = F.wv; asm volatile("" : "+s"(wave_o)); const int wave_ = wave_o, lane = lane_, hi = lane >> 5, l31 = lane & 31, h = wave_, hc = h * HD;
    LAS unsigned char* const sgt = F.lds;
    const bf16* Vr = (const bf16*)(ws + R_VR); const bf16* XL = (const bf16*)(ws + R_XL); bf16* MIX = (bf16*)(ws + R_MIX); const bf16* G2T = (const bf16*)(ws + WS_G2T);
    const float* BN0 = (const float*)(ws + R_BN); const float* BN1 = BN0 + (size_t)M * 8;
    const float* sp = karg(I_TSP) + layer * RPROJ; const float* sn = karg(I_TSN) + layer * RPROJ;
    const float* gnw = karg(I_GNW) + layer * 512 + hc; const float* gnb = karg(I_GNB) + layer * 512 + hc;
    for (int unit = F.vcu; unit < BATCH * (SEQ / 64); unit += F.G) {
        const int cn = unit & 63, b = unit >> 6, t0 = cn * 64;
        { const int tid = wave_ * 64 + lane, tok = tid >> 3, oct = tid & 7, t = t0 + tok, row = b * SEQ + t; float v8[8];
#pragma unroll
          for (int hf = 0; hf < 2; ++hf) { const int k0 = 16 * oct + 8 * hf;
              shift8(XL, 256, 128 + k0, row, t, sp + 1664 + k0, sn + 1664 + k0, v8);
              v4u w; w.x = cvtpk(sigmoidf_(v8[0]), sigmoidf_(v8[1])); w.y = cvtpk(sigmoidf_(v8[2]), sigmoidf_(v8[3])); w.z = cvtpk(sigmoidf_(v8[4]), sigmoidf_(v8[5])); w.w = cvtpk(sigmoidf_(v8[6]), sigmoidf_(v8[7]));
              *(LAS v4u*)(sgt + tok * FIN_SGS + 2 * k0) = w; } }
        WG_BAR();
        f32x16 acc[2][2], gg[2][2];
#pragma unroll
        for (int tt = 0; tt < 2; ++tt)
#pragma unroll
            for (int vt = 0; vt < 2; ++vt)
#pragma unroll
                for (int r = 0; r < 16; ++r) { acc[tt][vt][r] = 0.f; gg[tt][vt][r] = 0.f; }
#pragma unroll
        for (int d = 0; d < 2; ++d) { const size_t item = (size_t)(((b * 8 + h) * 2 + d) * 64 + (d ? 63 - cn : cn));
            const bf16* pre = (const bf16*)(ws + R_PRE) + item * 16384; const bf16* sd = (const bf16*)(ws + R_SD) + item * 4096;
#pragma unroll
            for (int tt = 0; tt < 2; ++tt)
#pragma unroll
                for (int vt = 0; vt < 2; ++vt) { const bf16* src = pre + 12288 + ((vt * 64 + 32 * tt + l31) * 2 + hi) * 16; const v4u w0_ = *(const v4u*)src, w1_ = *(const v4u*)(src + 8);
#pragma unroll
                    for (int j = 0; j < 4; ++j) { const f32x2_t u0 = unpk_h(w0_[j]), u1 = unpk_h(w1_[j]); acc[tt][vt][2 * j] += u0.x; acc[tt][vt][2 * j + 1] += u0.y; acc[tt][vt][8 + 2 * j] += u1.x; acc[tt][vt][8 + 2 * j + 1] += u1.y; } }
#pragma unroll
            for (int kt = 0; kt < 2; ++kt)
#pragma unroll
                for (int s = 0; s < 2; ++s) { bf16x8 sf[2], rf[2];
#pragma unroll
                    for (int vt = 0; vt < 2; ++vt) sf[vt] = *(const bf16x8*)(sd + ((kt * 64 + 32 * vt + l31) * 2 + hi) * 16 + 8 * s);
#pragma unroll
                    for (int tt = 0; tt < 2; ++tt) rf[tt] = *(const bf16x8*)(pre + 4096 + (32 * tt + l31) * 64 + 32 * kt + 16 * s + 8 * hi);
#pragma unroll
                    for (int tt = 0; tt < 2; ++tt)
#pragma unroll
                        for (int vt = 0; vt < 2; ++vt) acc[tt][vt] = MFMA32H(sf[vt], rf[tt], acc[tt][vt]); } }
#pragma unroll
        for (int ks = 0; ks < 8; ++ks) { bf16x8 gf[2], tf[2];
#pragma unroll
            for (int vt = 0; vt < 2; ++vt) gf[vt] = *(const bf16x8*)(G2T + (size_t)(hc + 32 * vt + l31) * 128 + 16 * ks + 8 * hi);
#pragma unroll
            for (int tt = 0; tt < 2; ++tt) tf[tt] = *(const LAS bf16x8*)(sgt + (32 * tt + l31) * FIN_SGS + (16 * ks + 8 * hi) * 2);
#pragma unroll
            for (int tt = 0; tt < 2; ++tt)
#pragma unroll
                for (int vt = 0; vt < 2; ++vt) gg[tt][vt] = MFMA32(gf[vt], tf[tt], gg[tt][vt]); }
#pragma unroll
        for (int tt = 0; tt < 2; ++tt) { const int t = t0 + 32 * tt + l31, row = b * SEQ + t;
            float sm = 0.f;
#pragma unroll
            for (int vt = 0; vt < 2; ++vt)
#pragma unroll
                for (int r = 0; r < 16; ++r) sm += acc[tt][vt][r];
            sm += pg8::shx(sm, 32, lane); const float mu = sm * (1.0f / 64.0f); float sq = 0.f;
#pragma unroll
            for (int vt = 0; vt < 2; ++vt)
#pragma unroll
                for (int r = 0; r < 16; ++r) { const float dl = acc[tt][vt][r] - mu; sq += dl * dl; }
            sq += pg8::shx(sq, 32, lane); const float rstd = 1.0f / sqrtf(sq * (1.0f / 64.0f) + GN_EPS);
            const float bon = BN0[(size_t)row * 8 + h] + BN1[(size_t)row * 8 + h];
#pragma unroll
            for (int vt = 0; vt < 2; ++vt)
#pragma unroll
                for (int q = 0; q < 4; ++q) { const int v0 = 32 * vt + 8 * q + 4 * hi;
                    const f32x4 vs = shift4(Vr, 512, hc + v0, row, t, sp + 1024 + hc + v0, sn + 1024 + hc + v0), w4 = *(const f32x4*)(gnw + v0), b4 = *(const f32x4*)(gnb + v0);
                    float o4[4];
#pragma unroll
                    for (int i = 0; i < 4; ++i) o4[i] = ((acc[tt][vt][4 * q + i] - mu) * rstd * w4[i] + b4[i] + bon * vs[i]) * gg[tt][vt][4 * q + i];
                    u32x2_t w; w.x = cvtpk(o4[0], o4[1]); w.y = cvtpk(o4[2], o4[3]); *(u32x2_t*)(MIX + (size_t)row * 1024 + 512 + hc + v0) = w; } }
        WG_BAR();
    }
}

constexpr int ATT_O = 0, ATT_L = 65536, ATT_V = 67584, ATT_VT = 32 * TSB;
static_assert(ATT_V + NWAVES * ATT_VT <= LDSCTL_OFF, "attention LDS map");
__device__ __forceinline__ bf16x8 frag_tr_pv(const LAS unsigned char* tile, int d0, int s, int lane) {
    const int hi = lane >> 5, g1 = (lane >> 4) & 1, i = lane & 15;
    const LAS unsigned char* p = tile + (16 * s + 4 * hi + (i >> 2)) * TSB + (d0 + 16 * g1 + 4 * (i & 3)) * 2;
    const s16x4 lo = tr4(p), h4 = tr4(p + 8 * TSB);
    return (bf16x8){lo[0], lo[1], lo[2], lo[3], h4[0], h4[1], h4[2], h4[3]};
}
template <int NQH>
__device__ __forceinline__ void attn_block(const bf16* MIX, const bf16* V, LAS unsigned char* lds, LAS unsigned char* vt, int b, int h, int T0, int tq0, int d, float slope_d, float bound, bool first, int lane) {
    const int hi = lane >> 5, l31 = lane & 31;
    const int jlo = -(tq0 / d), jhi = (SEQ - 1 - tq0) / d;
    bf16x8 qf[NQH][4];
#pragma unroll
    for (int qh = 0; qh < NQH; ++qh) { const bf16* qp = MIX + ((size_t)b * SEQ + tq0 + d * (32 * qh + l31)) * 1024 + h * HD + 8 * hi;
#pragma unroll
        for (int ks = 0; ks < 4; ++ks) qf[qh][ks] = *(const bf16x8*)(qp + 16 * ks); }
    f32x16 o[NQH][2]; float lsum[NQH];
#pragma unroll
    for (int qh = 0; qh < NQH; ++qh) { lsum[qh] = 0.f;
#pragma unroll
        for (int r = 0; r < 16; ++r) { o[qh][0][r] = 0.f; o[qh][1][r] = 0.f; } }
    constexpr int NT = NQH == 2 ? 6 : 5;
#pragma unroll 1
    for (int jt = 0; jt < NT; ++jt) {
        { const int kr = lane >> 1, hf = lane & 1; int pos = tq0 + d * (32 * jt + kr - 64); pos = pos < 0 ? 0 : (pos > SEQ - 1 ? SEQ - 1 : pos);
          const v4u* src = (const v4u*)(V + ((size_t)b * SEQ + pos) * 512 + h * HD + 32 * hf); LAS v4u* dst = (LAS v4u*)(vt + kr * TSB + 64 * hf);
          const v4u a0 = src[0], a1 = src[1], a2 = src[2], a3 = src[3]; dst[0] = a0; dst[1] = a1; dst[2] = a2; dst[3] = a3; }
        bf16x8 kf[4];
        { int pos = tq0 + d * (32 * jt + l31 - 64); pos = pos < 0 ? 0 : (pos > SEQ - 1 ? SEQ - 1 : pos);
          const bf16* kp = MIX + ((size_t)b * SEQ + pos) * 1024 + 512 + h * HD + 8 * hi;
#pragma unroll
          for (int ks = 0; ks < 4; ++ks) kf[ks] = *(const bf16x8*)(kp + 16 * ks); }
        asm volatile("s_waitcnt lgkmcnt(0)" ::: "memory");
#pragma unroll
        for (int qh = 0; qh < NQH; ++qh) {
            if (NQH == 2 && ((qh == 0 && jt == 5) || (qh == 1 && jt == 0))) continue;
            f32x16 s;
#pragma unroll
            for (int r = 0; r < 16; ++r) s[r] = 0.f;
#pragma unroll
            for (int ks = 0; ks < 4; ++ks) s = MFMA32(kf[ks], qf[qh][ks], s);
            const int iq = 32 * qh + l31;
            v4u pk[2];
#pragma unroll
            for (int r = 0; r < 16; r += 2) { float p2[2];
#pragma unroll
                for (int e = 0; e < 2; ++e) { const int rr = r + e, jj = 32 * jt + (rr & 3) + 8 * (rr >> 2) + 4 * hi - 64; const int dl = iq - jj, ad = dl < 0 ? -dl : dl;
                    const bool valid = (ad <= 64) && (jj >= jlo) && (jj <= jhi);
                    p2[e] = valid ? __expf(s[rr] - slope_d * (float)ad - bound) : 0.f; lsum[qh] += p2[e]; }
                pk[r >> 3][(r >> 1) & 3] = cvtpk(p2[0], p2[1]); }
#pragma unroll
            for (int dt = 0; dt < 2; ++dt)
#pragma unroll
                for (int s2 = 0; s2 < 2; ++s2) o[qh][dt] = MFMA32(frag_tr_pv(vt, 32 * dt, s2, lane), __builtin_bit_cast(bf16x8, pk[s2]), o[qh][dt]);
        }
        asm volatile("s_waitcnt lgkmcnt(0)" ::: "memory");
    }
    int lane2 = lane; asm volatile("" : "+v"(lane2));
#pragma unroll
    for (int qh = 0; qh < NQH; ++qh) { const int hi = lane2 >> 5, l31 = lane2 & 31, lane = lane2;
        const int qi = (tq0 - T0) + d * (32 * qh + l31);
        const float lt = lsum[qh] + pg8::shx(lsum[qh], 32, lane);
        if (hi == 0) { LAS float* lp = (LAS float*)(lds + ATT_L) + qi; *lp = first ? lt : (*lp + lt); }
#pragma unroll
        for (int dt = 0; dt < 2; ++dt)
#pragma unroll
            for (int q = 0; q < 4; ++q) { const int d0 = 32 * dt + 8 * q + 4 * hi; LAS u32x2_t* op = (LAS u32x2_t*)(lds + ATT_O + qi * 128 + ((((d0 >> 3) ^ (qi & 7)) << 4) | ((d0 & 4) << 1)));
                float v0 = o[qh][dt][4 * q], v1 = o[qh][dt][4 * q + 1], v2 = o[qh][dt][4 * q + 2], v3 = o[qh][dt][4 * q + 3];
                if (!first) { const u32x2_t w = *op; v0 += __uint_as_float(w.x << 16); v1 += __uint_as_float(w.x & 0xffff0000u); v2 += __uint_as_float(w.y << 16); v3 += __uint_as_float(w.y & 0xffff0000u); }
                u32x2_t w; w.x = cvtpk(v0, v1); w.y = cvtpk(v2, v3); *op = w; }
    }
}
__device__ __forceinline__ void attn_phase_mfma(Frame& F, int layer, int unit0, int nunit, int ustride) {
    unsigned char* const ws = kws();
    int lane_ = lane_id(); asm volatile("" : "+v"(lane_)); int wave_o = F.wv; asm volatile("" : "+s"(wave_o)); const int wave_ = wave_o, lane = lane_;
    bf16* MIX = (bf16*)(ws + R_MIX); const bf16* V = (const bf16*)(ws + R_V);
    LAS unsigned char* const lds = F.lds; LAS unsigned char* const vt = lds + ATT_V + wave_ * ATT_VT;
    float bound;
    { const float* qg = karg(I_QG) + layer * HD; const float* kg = karg(I_KG) + layer * HD; float mq = 0.f, mk = 0.f;
      for (int i = 0; i < HD; ++i) { mq = fmaxf(mq, fabsf(qg[i])); mk = fmaxf(mk, fabsf(kg[i])); }
      bound = 8.0f * mq * mk + 0.25f; }
    for (int unit = unit0; unit < nunit; unit += ustride) {
        const int st = unit & 7, h = (unit >> 3) & 7, b = unit >> 6, T0 = st * 512;
        const float slope = exp2f(-(float)(h + 1));
        attn_block<2>(MIX, V, lds, vt, b, h, T0, T0 + 64 * wave_, 1, slope, bound, true, lane);
        WG_BAR();
        attn_block<2>(MIX, V, lds, vt, b, h, T0, T0 + (wave_ & 3) + 256 * (wave_ >> 2), 4, slope * 4.f, bound, false, lane);
        WG_BAR();
        attn_block<1>(MIX, V, lds, vt, b, h, T0, T0 + 2 * wave_, 16, slope * 16.f, bound, false, lane);
        attn_block<1>(MIX, V, lds, vt, b, h, T0, T0 + 2 * wave_ + 1, 16, slope * 16.f, bound, false, lane);
        WG_BAR();
        { const int tid = wave_ * 64 + lane;
#pragma unroll
          for (int k = 0; k < 8; ++k) { const int item = tid + 512 * k, qi = item >> 3, c16 = item & 7;
              const v4u w = *(const LAS v4u*)(lds + ATT_O + qi * 128 + ((c16 ^ (qi & 7)) << 4)); const float il = 1.0f / ((const LAS float*)(lds + ATT_L))[qi];
              v4u o;
#pragma unroll
              for (int j = 0; j < 4; ++j) o[j] = cvtpk(__uint_as_float(w[j] << 16) * il, __uint_as_float(w[j] & 0xffff0000u) * il);
              *(v4u*)(MIX + ((size_t)b * SEQ + T0 + qi) * 1024 + h * HD + 8 * c16) = o; } }
        WG_BAR();
    }
}

__global__ void __launch_bounds__(NTHR, 2) mk_fwd(Args args) {
    extern __shared__ __attribute__((aligned(16))) unsigned char lds[];
    Frame F;
    F.lds = (LAS unsigned char*)lds;
    F.MISC = (volatile LAS unsigned*)(F.lds + MISC_OFF);
    F.wv = __builtin_amdgcn_readfirstlane((int)threadIdx.x >> 6);
    F.G = gridDim.x; { const int bx = blockIdx.x; F.vcu = (F.G % 8 == 0) ? (bx % 8) * (F.G / 8) + bx / 8 : bx; }
    F.ctl = (gu32*)(kws() + WS_CTL);
    for (int u = F.wv * 64 + lane_id(); u < (LDS_BYTES - LDSCTL_OFF) / 4; u += NTHR) ((LAS unsigned*)(F.lds + LDSCTL_OFF))[u] = 0u;
    __syncthreads();
    XcdBarrier bar = xcd_barrier_post((unsigned*)(F.ctl + CW_BAR), F.MISC + 8, F.wv == 0 && lane_id() == 0);
#define GRID_BAR() xcd_barrier(bar, F.wv == 0 && lane_id() == 0)
#define XB ((bf16*)(ws + R_XB))
#define MIXB ((bf16*)(ws + R_MIX))
#define HID ((bf16*)(ws + R_HID))
#define SS1 ((float*)(ws + WS_SS1))
#define SS2 ((float*)(ws + WS_SS2))

    for (int step = 0; step < 8 * DEPTH; ++step) {
        const int layer = step >> 3, kind = step & 7;
        if (kind == 0) {
            if (layer > 0) continue;
            x_prologue(F);
            { int lane_ = lane_id(); asm volatile("" : "+v"(lane_)); wconv_items(0, -1, F.vcu * NWAVES + F.wv, F.G * NWAVES, (LAS float*)(F.lds + RING_OFF + F.wv * 16384), lane_); }
        } else if (kind == 1) {
            unsigned char* const ws = kws();
            pg8::Gemm g{XB, (const bf16*)(ws + WS_WIN), M, NPROJ, D}; pg8::StaticOrder S; S.init(M, NPROJ, F.G, (int)blockIdx.x);
            pg8::EpiProj E; E.base0 = (bf16*)(ws + WS_R0); E.ss = SS1; E.qg = karg(I_QG) + layer * HD; E.kg = karg(I_KG) + layer * HD;
            pg8::gemm_phase<pg8::EpiProj, pg8::StaticOrder, true, true>(F.lds + RING_OFF, g, S, E, F.wv, lane_id());
        } else if (kind == 2) {
            rwkv_pre_phase(F, layer);
        } else if (kind == 3) {
            const int bx = (int)blockIdx.x;
            if (bx < 128) { if (F.wv == 0) rwkv_scan_chunk(F, bx);
                            else { int lane_ = lane_id(); asm volatile("" : "+v"(lane_)); wconv_items(layer + 1, layer, bx * 7 + F.wv - 1, 128 * 7, (LAS float*)(F.lds + SCAN_NS * SCAN_SLOT + (F.wv - 1) * 9216), lane_); } }
            else attn_phase_mfma(F, layer, bx - 128, BATCH * H * 8, F.G - 128);
        } else if (kind == 4) {
            rwkv_finalize_mfma(F, layer);
        } else if (kind == 5 || kind == 7) {
            unsigned char* const ws = kws(); float* const xo = kout();
            pg8::Gemm g{kind == 5 ? MIXB : HID, (const bf16*)(ws + (kind == 5 ? WS_WOUT : WS_WDN)), M, D, kind == 5 ? D : FF}; pg8::StaticOrder S; S.init(M, D, F.G, (int)blockIdx.x);
            pg8::EpiRes E{xo, XB, kind == 5 ? SS2 : SS1};
            pg8::gemm_phase<pg8::EpiRes, pg8::StaticOrder, false, true>(F.lds + RING_OFF, g, S, E, F.wv, lane_id());
        } else {
            unsigned char* const ws = kws();
            pg8::Gemm g{XB, (const bf16*)(ws + WS_WUP), M, FF, D}; pg8::StaticOrder S; S.init(M, FF, F.G, (int)blockIdx.x);
            pg8::EpiUp E{HID, SS2};
            pg8::gemm_phase<pg8::EpiUp, pg8::StaticOrder, true, true>(F.lds + RING_OFF, g, S, E, F.wv, lane_id());
        }
        if (step + 1 < 8 * DEPTH) GRID_BAR();
    }
}

extern "C" void kernel_launch(void* const* d_in, const int* in_sizes, int n_in, void* d_out, int out_size, void* d_ws, size_t ws_size, hipStream_t stream) {
    static int grid = 0;
    if (grid == 0) {
        if (n_in != N_IN || in_sizes[0] != M * D || out_size != M * D || ws_size < WS_END) { fprintf(stderr, "kernel_launch: unexpected shapes (n_in %d, in0 %d, out %d, ws %zu)\n", n_in, n_in > 0 ? in_sizes[0] : -1, out_size, ws_size); grid = -1; return; }
        int dev = 0, cus = 0;
        if (hipGetDevice(&dev) != hipSuccess || hipDeviceGetAttribute(&cus, hipDeviceAttributeMultiprocessorCount, dev) != hipSuccess) { grid = -1; return; }
        if (hipFuncSetAttribute((const void*)mk_fwd, hipFuncAttributeMaxDynamicSharedMemorySize, LDS_BYTES) != hipSuccess) { fprintf(stderr, "kernel_launch: hipFuncSetAttribute failed\n"); grid = -1; return; }
        int per_cu = 0;
        (void)hipOccupancyMaxActiveBlocksPerMultiprocessor(&per_cu, (const void*)mk_fwd, NTHR, LDS_BYTES);
        (void)hipGetLastError();
        grid = cus;
    }
    if (grid < 0) return;
    (void)hipMemsetAsync((char*)d_ws + WS_CTL, 0, CTL_ZERO_BYTES, stream);
    Args a{};
    for (int i = 0; i < N_IN; ++i) a.in[i] = (const float*)d_in[i];
    a.out = (float*)d_out; a.ws = (unsigned char*)d_ws;
    hipLaunchKernelGGL(mk_fwd, dim3(grid), dim3(NTHR), LDS_BYTES, stream, a);
}
```

```cpp
#include <hip/hip_runtime.h>
#include <cstdio>
#include <cstdint>
namespace pg8 {
#define PG8_LAS __attribute__((address_space(3)))
typedef unsigned short bf16_t;
typedef short bf16x8 __attribute__((ext_vector_type(8)));
typedef float f32x4 __attribute__((ext_vector_type(4)));
typedef unsigned u32x4 __attribute__((ext_vector_type(4)));
constexpr int BM = 256, BK = 64, HALF = 128, HTB = HALF * BK * 2  , STAGE_BYTES = 8 * HTB, NXCD = 8, WGM = 8;

__host__ __device__ __forceinline__ int lds_byte(int r, int c) { const int st = (r >> 4) * 2 + (c >> 5), rr = r & 15, cc = c & 31, ob = rr * 64 + cc * 2; return st * 1024 + (ob ^ (((ob >> 9) & 1) << 5)); }
__host__ __device__ __forceinline__ void stage_rc(int b, int& R, int& C) { const int st = b / 1024, sb = b % 1024, swz = sb ^ (((sb >> 9) & 1) << 5); R = (st >> 1) * 16 + swz / 64; C = (st & 1) * 32 + (swz % 64) / 2; }
__host__ __device__ __forceinline__ int perm32(int rho) { const int n = rho >> 4, i = rho & 15; return 8 * (i >> 2) + 4 * n + (i & 3); }

struct Unit { int pm, pn; };
struct Gemm { const bf16_t* A; const bf16_t* Bt; int M, N, K; };

struct StaticOrder {
    int nM, nN, nwg, G, c;
    __host__ __device__ void init(int M, int N, int G_, int c_) { nM = M / BM; nN = N / BM; nwg = nM * nN; G = G_; c = c_; }
    __host__ __device__ bool next(int i, Unit& u) const {
        const long L = (long)i * G + c; if (L >= nwg) return false;
        int wgid = (int)L; { const int q = nwg / NXCD, r = nwg % NXCD, xcd = wgid % NXCD, off = wgid / NXCD; wgid = (xcd < r ? xcd * (q + 1) : r * (q + 1) + (xcd - r) * q) + off; }
        const int nig = WGM * nN, gid = wgid / nig, fm = gid * WGM, gsz = (nM - fm) < WGM ? (nM - fm) : WGM;
        u.pm = fm + ((wgid % nig) % gsz); u.pn = (wgid % nig) / gsz; return true;
    }
    __device__ __forceinline__ void a_ready(const Unit&) const {}
    __device__ __forceinline__ void done(const Unit&) const {}
};

__device__ __forceinline__ unsigned cvt_pk_bf16(float lo, float hi) { unsigned r; asm volatile("v_cvt_pk_bf16_f32 %0, %1, %2" : "=v"(r) : "v"(lo), "v"(hi)); return r; }
typedef unsigned u32x2 __attribute__((ext_vector_type(2)));

__device__ __forceinline__ float shx(float v, int m, int lane) { return __int_as_float(__builtin_amdgcn_ds_bpermute((lane ^ m) << 2, __float_as_int(v))); }
__device__ __forceinline__ float row_rs(const float* ss, int row, int fq, int lane) {
    const f32x4 p = *(const f32x4*)(ss + (size_t)row * 16 + 4 * fq);
    float s = (p[0] + p[1]) + (p[2] + p[3]);
    s += shx(s, 16, lane); s += shx(s, 32, lane);
    return 1.0f / sqrtf(s * (1.0f / 1024.0f) + 1e-6f);
}

struct EpiProj {
    static constexpr bool PERM = true, AFTER_DRAIN = false;
    bf16_t* base0; const float* ss; const float* qg; const float* kg;
    __device__ __forceinline__ void operator()(const f32x4 (&acc)[2][2][4][2], const Unit& u, int wr, int wc, int fr, int fq) const {
        const int tile = u.pn, di = tile >> 1;
        bf16_t* base = base0 + (di < 2 ? (size_t)di * 512 : (size_t)di * (8u << 20)); const int ldc = (di < 2) ? 1024 : ((di == 6) ? 256 : 512); const int cb = (di == 6) ? 0 : (tile & 1) * 256;
        const bool nrm = tile < 4; const float* gsrc = (tile < 2) ? qg : kg; const float post = (tile < 2) ? 0.125f : 1.0f;
        f32x4 g[2][2];
#pragma unroll
        for (int bj = 0; bj < 2; ++bj)
#pragma unroll
            for (int n = 0; n < 2; ++n) g[bj][n] = nrm ? *(const f32x4*)(gsrc + 32 * bj + 8 * fq + 4 * n) * post : (f32x4){1.f, 1.f, 1.f, 1.f};
#pragma unroll
        for (int ai = 0; ai < 2; ++ai)
#pragma unroll
            for (int m = 0; m < 4; ++m) {
                const int row = u.pm * BM + ai * HALF + wr * 64 + m * 16 + fr;
                const float rs = row_rs(ss, row, fq, 16 * fq + fr);
                f32x4 v[2][2]; float q = 0.f;
#pragma unroll
                for (int bj = 0; bj < 2; ++bj)
#pragma unroll
                    for (int n = 0; n < 2; ++n) { v[bj][n] = acc[ai][bj][m][n] * rs; const f32x4 t = v[bj][n]; q += (t[0] * t[0] + t[1] * t[1]) + (t[2] * t[2] + t[3] * t[3]); }
                q += shx(q, 16, 16 * fq + fr); q += shx(q, 32, 16 * fq + fr);
                const float inv = nrm ? 1.0f / sqrtf(q * (1.0f / 64.0f) + 1e-6f) : 1.0f;
                bf16_t* rowp = base + (size_t)row * ldc + cb + 64 * wc + 8 * fq;
#pragma unroll
                for (int bj = 0; bj < 2; ++bj) { const f32x4 v0 = v[bj][0] * inv * g[bj][0], v1 = v[bj][1] * inv * g[bj][1];
                    u32x4 w; w.x = cvt_pk_bf16(v0[0], v0[1]); w.y = cvt_pk_bf16(v0[2], v0[3]); w.z = cvt_pk_bf16(v1[0], v1[1]); w.w = cvt_pk_bf16(v1[2], v1[3]);
                    *(u32x4*)(rowp + 32 * bj) = w; }
                asm volatile("" ::: "memory");
            }
    }
};
struct EpiUp {
    static constexpr bool PERM = true, AFTER_DRAIN = false;
    bf16_t* O; const float* ss;
    __device__ __forceinline__ void operator()(const f32x4 (&acc)[2][2][4][2], const Unit& u, int wr, int wc, int fr, int fq) const {
#pragma unroll
        for (int ai = 0; ai < 2; ++ai)
#pragma unroll
            for (int m = 0; m < 4; ++m) {
                const int row = u.pm * BM + ai * HALF + wr * 64 + m * 16 + fr;
                const float rs = row_rs(ss, row, fq, 16 * fq + fr);
                bf16_t* rowp = O + (size_t)row * 4096 + u.pn * BM + wc * 32 + 8 * fq;
#pragma unroll
                for (int bj = 0; bj < 2; ++bj) { f32x4 v0 = acc[ai][bj][m][0] * rs, v1 = acc[ai][bj][m][1] * rs;
                    v0 = __builtin_elementwise_max(v0, (f32x4){0.f, 0.f, 0.f, 0.f}); v1 = __builtin_elementwise_max(v1, (f32x4){0.f, 0.f, 0.f, 0.f}); v0 = v0 * v0; v1 = v1 * v1;
                    u32x4 w; w.x = cvt_pk_bf16(v0[0], v0[1]); w.y = cvt_pk_bf16(v0[2], v0[3]); w.z = cvt_pk_bf16(v1[0], v1[1]); w.w = cvt_pk_bf16(v1[2], v1[3]);
                    *(u32x4*)(rowp + bj * HALF) = w; }
                asm volatile("" ::: "memory");
            }
    }
};
struct EpiRes {
    static constexpr bool PERM = false, AFTER_DRAIN = false;
    float* x; bf16_t* xb; float* ss;
    __device__ __forceinline__ void operator()(const f32x4 (&acc)[2][2][4][2], const Unit& u, int wr, int wc, int fr, int fq) const {
        const int col0 = u.pn * BM + wc * 32 + 4 * fq;
#pragma unroll
        for (int ai = 0; ai < 2; ++ai)
#pragma unroll
            for (int m = 0; m < 4; ++m) {
                const int row = u.pm * BM + ai * HALF + wr * 64 + m * 16 + fr; const size_t off = (size_t)row * 1024 + col0; float q = 0.f;
#pragma unroll
                for (int bj = 0; bj < 2; ++bj)
#pragma unroll
                    for (int n = 0; n < 2; ++n) { const size_t o = off + bj * HALF + n * 16; const f32x4 t = *(const f32x4*)(x + o) + acc[ai][bj][m][n];
                        *(f32x4*)(x + o) = t; u32x2 w; w.x = cvt_pk_bf16(t[0], t[1]); w.y = cvt_pk_bf16(t[2], t[3]); *(u32x2*)(xb + o) = w;
                        q += (t[0] * t[0] + t[1] * t[1]) + (t[2] * t[2] + t[3] * t[3]); }
                q += shx(q, 16, 16 * fq + fr); q += shx(q, 32, 16 * fq + fr);
                if (fq == 0) ss[(size_t)row * 16 + 4 * u.pn + wc] = q;
                asm volatile("" ::: "memory");
            }
    }
};

template <class Epi, class Sched, bool ALIGN_EPI = false, bool SP2 = false>
__device__ __forceinline__ void gemm_phase(PG8_LAS unsigned char* lds, const Gemm g, const Sched& S, const Epi& E, int wave_in, int lane_in) {
    int lane_o = lane_in, wave_o = wave_in; asm volatile("" : "+v"(lane_o)); asm volatile("" : "+s"(wave_o)); const int tid_ = wave_o * 64 + lane_o;
    const int tid = tid_, wid = wave_o, lane = lane_o, wr = wid >> 2, wc = wid & 3, fr = lane & 15, fq = lane >> 4;
    const int K = g.K, nt = K / BK;
    unsigned voffA[2], voffB[2];
#pragma unroll
    for (int i = 0; i < 2; ++i) { int R, C; stage_rc(tid * 16 + i * 8192, R, C); const int Rb = Epi::PERM ? ((R & ~31) + perm32(R & 31)) : R;
        voffA[i] = (unsigned)(R * K + C) * 2u; voffB[i] = (unsigned)(Rb * K + C) * 2u; }
    const size_t kstep = (size_t)(BK * 2);
    const size_t hstep = (size_t)HALF * K * 2;
    const size_t tstep = 2 * hstep;
    const unsigned ldsw = (unsigned)wid * 1024u;
    const int aoff = lds_byte(wr * 64 + fr, fq * 8), boff = lds_byte(wc * 32 + fr, fq * 8);
#define PG8_SA(b, h) (((b) * 2 + (h)) * HTB)
#define PG8_SB(b, h) ((4 + (b) * 2 + (h)) * HTB)
#define PG8_STAGE(bufoff, gbase, voff) do { _Pragma("unroll") for (int _i = 0; _i < 2; ++_i) \
        __builtin_amdgcn_global_load_lds((const unsigned*)((const char*)(gbase) + (voff)[_i]), (PG8_LAS unsigned*)(lds + (bufoff) + ldsw + _i * 8192), 16, 0, 0); } while (0)
#define PG8_LDA(dst, b, h) do { _Pragma("unroll") for (int m = 0; m < 4; ++m) _Pragma("unroll") for (int k = 0; k < 2; ++k) dst[m][k] = *(const PG8_LAS bf16x8*)(lds + PG8_SA(b, h) + aoff + m * 2048 + k * 1024); } while (0)
#define PG8_LDB(dst, b, h) do { _Pragma("unroll") for (int n = 0; n < 2; ++n) _Pragma("unroll") for (int k = 0; k < 2; ++k) dst[n][k] = *(const PG8_LAS bf16x8*)(lds + PG8_SB(b, h) + boff + n * 2048 + k * 1024); } while (0)
#define PG8_MMA(ai, bj, At, Bt) do { __builtin_amdgcn_s_setprio(1); _Pragma("unroll") for (int m = 0; m < 4; ++m) _Pragma("unroll") for (int n = 0; n < 2; ++n) _Pragma("unroll") for (int k = 0; k < 2; ++k) \
        acc[ai][bj][m][n] = __builtin_amdgcn_mfma_f32_16x16x32_bf16(Bt[n][k], At[m][k], acc[ai][bj][m][n], 0, 0, 0); __builtin_amdgcn_s_setprio(0); } while (0)
#define PG8_WAIT_V(n) asm volatile("s_waitcnt vmcnt(" #n ")" ::: "memory")
#define PG8_WAIT_L(n) asm volatile("s_waitcnt lgkmcnt(" #n ")" ::: "memory")
#define PG8_BAR __builtin_amdgcn_s_barrier()
#define PG8_SCHED __builtin_amdgcn_sched_barrier(0)
    Unit cur, nxt; int ui = 0;
    if (!S.next(0, cur)) return;
    f32x4 acc[2][2][4][2];
#pragma unroll
    for (int a = 0; a < 2; ++a)
#pragma unroll
        for (int b = 0; b < 2; ++b)
#pragma unroll
            for (int m = 0; m < 4; ++m)
#pragma unroll
                for (int n = 0; n < 2; ++n) acc[a][b][m][n] = (f32x4){0.f, 0.f, 0.f, 0.f};
    bf16x8 At[4][2], B0[2][2], B1[2][2];
    const char* cA = (const char*)g.A + (size_t)cur.pm * tstep; const char* cB = (const char*)g.Bt + (size_t)cur.pn * tstep;
    S.a_ready(cur);
    if constexpr (SP2) {
        PG8_STAGE(PG8_SB(0, 0), cB, voffB); PG8_STAGE(PG8_SB(0, 1), cB + hstep, voffB); PG8_STAGE(PG8_SA(0, 0), cA, voffA); PG8_STAGE(PG8_SA(0, 1), cA + hstep, voffA);
        if (wr == 1) PG8_BAR;
        PG8_WAIT_V(2); PG8_BAR;
        PG8_STAGE(PG8_SB(1, 0), cB + kstep, voffB); PG8_STAGE(PG8_SA(1, 0), cA + kstep, voffA); PG8_STAGE(PG8_SB(1, 1), cB + hstep + kstep, voffB);
        PG8_WAIT_V(6); PG8_BAR;
    } else {
        PG8_STAGE(PG8_SB(0, 0), cB, voffB); PG8_STAGE(PG8_SA(0, 0), cA, voffA); PG8_STAGE(PG8_SB(0, 1), cB + hstep, voffB); PG8_STAGE(PG8_SA(0, 1), cA + hstep, voffA);
        if (wr == 1) PG8_BAR;
        PG8_WAIT_V(4); PG8_BAR;
        PG8_STAGE(PG8_SB(1, 0), cB + kstep, voffB); PG8_STAGE(PG8_SA(1, 0), cA + kstep, voffA); PG8_STAGE(PG8_SB(1, 1), cB + hstep + kstep, voffB);
        PG8_WAIT_V(6); PG8_BAR;
    }
    for (;;) {
        const bool has_next = S.next(ui + 1, nxt);
        const char* nA = has_next ? (const char*)g.A + (size_t)nxt.pm * tstep : cA; const char* nB = has_next ? (const char*)g.Bt + (size_t)nxt.pn * tstep : cB;
        for (int t = 0; t < nt; t += 2) {
            const bool last = (t == nt - 2);
            const char* a1 = cA + (size_t)(t + 1) * kstep;
            const char* a2 = last ? nA : cA + (size_t)(t + 2) * kstep; const char* b2 = last ? nB : cB + (size_t)(t + 2) * kstep;
            const char* a3 = a2 + kstep; const char* b3 = b2 + kstep;
            if (last && has_next) S.a_ready(nxt);
            if constexpr (SP2) {
            PG8_LDB(B0, 0, 0); PG8_LDB(B1, 0, 1); PG8_SCHED; PG8_LDA(At, 0, 0); PG8_STAGE(PG8_SA(1, 1), a1 + hstep, voffA);
            PG8_WAIT_V(8); PG8_WAIT_L(0); PG8_BAR; PG8_MMA(0, 0, At, B0); PG8_MMA(0, 1, At, B1); PG8_BAR; PG8_SCHED;
            PG8_LDA(At, 0, 1); PG8_STAGE(PG8_SB(0, 0), b2, voffB); PG8_STAGE(PG8_SB(0, 1), b2 + hstep, voffB); PG8_STAGE(PG8_SA(0, 0), a2, voffA);
            PG8_WAIT_V(8); PG8_WAIT_L(0); PG8_BAR; PG8_MMA(1, 0, At, B0); PG8_MMA(1, 1, At, B1); PG8_BAR; PG8_SCHED;
            PG8_LDB(B0, 1, 0); PG8_LDB(B1, 1, 1); PG8_SCHED; PG8_LDA(At, 1, 0); PG8_STAGE(PG8_SA(0, 1), a2 + hstep, voffA);
            PG8_WAIT_V(8); PG8_WAIT_L(0); PG8_BAR; PG8_MMA(0, 0, At, B0); PG8_MMA(0, 1, At, B1); PG8_BAR; PG8_SCHED;
            PG8_LDA(At, 1, 1); PG8_STAGE(PG8_SB(1, 0), b3, voffB); PG8_STAGE(PG8_SB(1, 1), b3 + hstep, voffB); PG8_STAGE(PG8_SA(1, 0), a3, voffA);
            PG8_WAIT_V(8); PG8_WAIT_L(0); PG8_BAR; PG8_MMA(1, 0, At, B0); PG8_MMA(1, 1, At, B1); PG8_BAR; PG8_SCHED;
            } else {
            PG8_LDB(B0, 0, 0); PG8_SCHED; PG8_LDA(At, 0, 0); PG8_STAGE(PG8_SA(1, 1), a1 + hstep, voffA);
            PG8_WAIT_L(8); PG8_BAR; PG8_WAIT_L(0); PG8_MMA(0, 0, At, B0); PG8_BAR; PG8_SCHED;
            PG8_LDB(B1, 0, 1); PG8_STAGE(PG8_SB(0, 0), b2, voffB);
            PG8_BAR; PG8_WAIT_L(0); PG8_MMA(0, 1, At, B1); PG8_BAR;
            PG8_LDA(At, 0, 1); PG8_STAGE(PG8_SA(0, 0), a2, voffA);
            PG8_BAR; PG8_WAIT_L(0); PG8_MMA(1, 0, At, B0); PG8_BAR; PG8_SCHED;
            PG8_STAGE(PG8_SB(0, 1), b2 + hstep, voffB);
            PG8_WAIT_V(6); PG8_BAR; PG8_MMA(1, 1, At, B1); PG8_BAR;
            PG8_LDB(B0, 1, 0); PG8_SCHED; PG8_LDA(At, 1, 0); PG8_STAGE(PG8_SA(0, 1), a2 + hstep, voffA);
            PG8_WAIT_L(8); PG8_BAR; PG8_WAIT_L(0); PG8_MMA(0, 0, At, B0); PG8_BAR; PG8_SCHED;
            PG8_LDB(B1, 1, 1); PG8_STAGE(PG8_SB(1, 0), b3, voffB);
            PG8_BAR; PG8_WAIT_L(0); PG8_MMA(0, 1, At, B1); PG8_BAR;
            PG8_LDA(At, 1, 1); PG8_STAGE(PG8_SA(1, 0), a3, voffA);
            PG8_BAR; PG8_WAIT_L(0); PG8_MMA(1, 0, At, B0); PG8_BAR; PG8_SCHED;
            PG8_STAGE(PG8_SB(1, 1), b3 + hstep, voffB);
            PG8_WAIT_V(6); PG8_BAR; PG8_MMA(1, 1, At, B1); PG8_BAR;
            }
        }
        if constexpr (ALIGN_EPI) { if (wr == 0) PG8_BAR; }
        if constexpr (!Epi::AFTER_DRAIN) { E(acc, cur, wr, wc, fr, fq); S.done(cur); }
        if (!has_next) break;
#pragma unroll
        for (int a = 0; a < 2; ++a)
#pragma unroll
            for (int b = 0; b < 2; ++b)
#pragma unroll
                for (int m = 0; m < 4; ++m)
#pragma unroll
                    for (int n = 0; n < 2; ++n) acc[a][b][m][n] = (f32x4){0.f, 0.f, 0.f, 0.f};
        cur = nxt; cA = nA; cB = nB; ++ui;
        if constexpr (ALIGN_EPI) { if (wr == 1) PG8_BAR; }
    }
    PG8_WAIT_V(0);
    if constexpr (!ALIGN_EPI) { if (wr == 0) PG8_BAR; }
    PG8_BAR;
    if constexpr (Epi::AFTER_DRAIN) { E.fused(acc, cur, wr, wc, fr, fq, lds, wid, lane); S.done(cur); }
#undef PG8_SA
#undef PG8_SB
#undef PG8_STAGE
#undef PG8_LDA
#undef PG8_LDB
#undef PG8_MMA
#undef PG8_WAIT_V
#undef PG8_WAIT_L
#undef PG8_BAR
#undef PG8_SCHED
}
}
constexpr int NWAVES = 8, NTHR = 512;
constexpr int BATCH = 4, SEQ = 4096, D = 1024, DEPTH = 4, H = 8, HD = 64, FF = 4096, NPROJ = 3328, RPROJ = 1792;
constexpr int M = BATCH * SEQ;
constexpr float GN_EPS = 64e-5f;
enum { I_X = 0, I_LN1, I_WIN, I_QG, I_KG, I_TSP, I_TSN, I_W0, I_W2, I_A0, I_A2, I_G2, I_KK, I_KA, I_RK, I_GNW, I_GNB, I_WOUT, I_LN2, I_WUP, I_WDN, N_IN };
constexpr size_t MiB = 1u << 20;
constexpr size_t WS_CTL = 0, CTL_ZERO_BYTES = 64 * 1024;
constexpr size_t WS_SS1 = 1 * MiB, WS_SS2 = 2 * MiB;
constexpr size_t WS_WIN = 3 * MiB, WS_WOUT = WS_WIN + (size_t)NPROJ * D * 2, WS_WUP = WS_WOUT + (size_t)D * D * 2, WS_WDN = WS_WUP + (size_t)FF * D * 2;
constexpr size_t WS_R0 = 28 * MiB;
constexpr size_t R_MIX = WS_R0 + 0 * MiB;
constexpr size_t R_V = WS_R0 + 32 * MiB;
constexpr size_t R_RR = WS_R0 + 48 * MiB, R_KR = WS_R0 + 64 * MiB, R_VR = WS_R0 + 80 * MiB, R_XL = WS_R0 + 96 * MiB;
constexpr size_t R_SD = R_RR;
constexpr size_t R_PRE = WS_R0 + 104 * MiB;
constexpr size_t R_HID = WS_R0;
constexpr size_t R_XB = WS_R0 + 128 * MiB;
constexpr size_t R_BN = WS_R0 + 232 * MiB;
constexpr size_t WS_END = WS_R0 + 233 * MiB;
constexpr size_t WS_LORA = WS_WDN + (size_t)D * FF * 2;
constexpr size_t WS_G2T = WS_LORA + 4 * 512 * 64 * 2;
static_assert(WS_G2T + 512 * 128 * 2 <= WS_R0, "lora");
constexpr int CW_BAR = 1024;
constexpr int RING_OFF = 0, RING_BYTES = 131072;
constexpr int LDSCTL_OFF = 155648, MISC_OFF = LDSCTL_OFF + 320;
constexpr int LDS_BYTES = 163840;
#define GAS __attribute__((address_space(1)))
#define LAS __attribute__((address_space(3)))
typedef unsigned short bf16;
typedef unsigned v4u __attribute__((ext_vector_type(4)));
typedef float f32x4 __attribute__((ext_vector_type(4)));
typedef short bf16x8 __attribute__((ext_vector_type(8)));
typedef GAS unsigned gu32;
typedef GAS unsigned long long gu64;
#define RLX_AGENT __ATOMIC_RELAXED, __HIP_MEMORY_SCOPE_AGENT
#define LDS_WAIT() asm volatile("s_waitcnt lgkmcnt(0)" ::: "memory")
#define VM_WAIT() asm volatile("s_waitcnt vmcnt(0)" ::: "memory")
__device__ __forceinline__ unsigned long long rt() { return __builtin_amdgcn_s_memrealtime(); }
__device__ __forceinline__ unsigned f2bf(float f) { unsigned u = __builtin_bit_cast(unsigned, f); return (u + 0x7fffu + ((u >> 16) & 1u)) >> 16; }
__device__ __forceinline__ unsigned pk2(float lo, float hi) { return f2bf(lo) | (f2bf(hi) << 16); }

#define XB_TMO      128
#define XB_XCNT(j)  (256  + 64 * (j))
#define XB_XSUB(j)  (1280 + 64 * (j))
#define XB_XGEN(j)  (2304 + 64 * (j))
#define XB_TOP      3328
#define XB_TOPGEN   3392
#define XCD_BAR_WORDS 3456
#define XB_SPIN_CAP (1u << 18)

__device__ __forceinline__ unsigned xb_ld(unsigned* p)              { return __hip_atomic_load(p, __ATOMIC_RELAXED, __HIP_MEMORY_SCOPE_AGENT); }
__device__ __forceinline__ unsigned xb_add(unsigned* p, unsigned v) { return __hip_atomic_fetch_add(p, v, __ATOMIC_RELAXED, __HIP_MEMORY_SCOPE_AGENT); }
__device__ __forceinline__ unsigned xb_xcc_id() { return (unsigned)__builtin_amdgcn_s_getreg((3 << 11) | 20) & 0xFu; }
#define XB_SPIN(cond, bar) do { unsigned _sp = 0; while (cond) { __builtin_amdgcn_s_sleep(1); \
    if ((++_sp & 255u) == 0u) { if (xb_ld(&(bar)[XB_TMO])) break; if (_sp > XB_SPIN_CAP) { atomicAdd(&(bar)[XB_TMO], 1u); break; } } } } while (0)

struct XcdBarrier {
    unsigned* bar; unsigned x;
    volatile LAS unsigned* st;
};

__device__ __forceinline__ XcdBarrier xcd_barrier_post(unsigned* bar, volatile LAS unsigned* st, bool tid0) {
    XcdBarrier b; b.bar = bar; b.x = xb_xcc_id(); b.st = st;
    if (tid0) (void)xb_add(&bar[XB_XCNT(b.x)], 1u);
    return b;
}
__device__ __forceinline__ void xcd_barrier_complete(unsigned* bar, unsigned x, unsigned& nloc, unsigned& nx) {
    const unsigned G = gridDim.x * gridDim.y * gridDim.z;
    unsigned sum, cnt, mine, sp = 0u;
    for (;;) {
        sum = 0u; cnt = 0u; mine = 0u;
#pragma unroll
        for (unsigned j = 0; j < 16; ++j) { const unsigned c = xb_ld(&bar[XB_XCNT(j)]); sum += c; cnt += (c > 0u) ? 1u : 0u; mine = (j == x) ? c : mine; }
        if (sum == G) break;
        __builtin_amdgcn_s_sleep(1);
        if ((++sp & 255u) == 0u) { if (xb_ld(&bar[XB_TMO])) break; if (sp > XB_SPIN_CAP) { atomicAdd(&bar[XB_TMO], 1u); break; } }
    }
    nloc = mine > 0u ? mine : 1u; nx = cnt > 0u ? cnt : 1u;
}

__device__ __forceinline__ void xcd_barrier(const XcdBarrier& b, bool tid0) {
    asm volatile("s_waitcnt vmcnt(0)" ::: "memory");
    __syncthreads();
    if (tid0) {
        unsigned* bar = b.bar; asm volatile("" : "+v"(bar));
        __builtin_amdgcn_s_waitcnt(0);
        unsigned nloc = b.st[0], nx = b.st[1];
        if (nloc == 0u) { xcd_barrier_complete(bar, b.x, nloc, nx); b.st[0] = nloc; b.st[1] = nx; }
        const unsigned old = xb_add(&bar[XB_XSUB(b.x)], 1u);
        const unsigned gen = old / nloc;
        if (old + 1u == (gen + 1u) * nloc) {
            __builtin_amdgcn_fence(__ATOMIC_RELEASE, "agent");
            asm volatile("s_waitcnt vmcnt(0)" ::: "memory");
            const unsigned og = xb_add(&bar[XB_TOP], 1u);
            const unsigned tg = og / nx;
            if (og + 1u == (tg + 1u) * nx) xb_add(&bar[XB_TOPGEN], 1u);
            else XB_SPIN(xb_ld(&bar[XB_TOPGEN]) == tg, bar);
            __builtin_amdgcn_fence(__ATOMIC_ACQUIRE, "agent");
            xb_add(&bar[XB_XGEN(b.x)], 1u);
            asm volatile("s_waitcnt vmcnt(0)" ::: "memory");
        } else {
            XB_SPIN(xb_ld(&bar[XB_XGEN(b.x)]) == gen, bar);
            __builtin_amdgcn_fence(__ATOMIC_ACQUIRE, "agent");
            asm volatile("s_waitcnt vmcnt(0)" ::: "memory");
        }
    }
    __syncthreads();
}
__device__ __forceinline__ float bf2f(bf16 v) { return __uint_as_float(((unsigned)v) << 16); }
__device__ __forceinline__ bf16 f2bf_s(float f) { return (bf16)f2bf(f); }
__device__ __forceinline__ float wave_sum(float v, int lane) {
#pragma unroll
    for (int o = 1; o < 64; o <<= 1) v += pg8::shx(v, o, lane);
    return v;
}
__device__ __forceinline__ float sigmoidf_(float z) { return 1.0f / (1.0f + __expf(-z)); }
__device__ __forceinline__ float tanh_fast(float x) { return 1.0f - 2.0f / (__expf(2.0f * x) + 1.0f); }

struct Args { const float* in[N_IN]; float* out; unsigned char* ws; };
typedef const __attribute__((address_space(4))) Args CArgs;
__device__ __forceinline__ const CArgs* kargs() { const CArgs* p = (const CArgs*)__builtin_amdgcn_kernarg_segment_ptr(); asm volatile("" : "+s"(p)); return p; }
__device__ __forceinline__ unsigned char* kws() { return kargs()->ws; }
__device__ __forceinline__ float* kout() { return kargs()->out; }
__device__ __forceinline__ const float* karg(int i) { return kargs()->in[i]; }
__device__ __forceinline__ int lane_id() { int l; asm volatile("v_mbcnt_lo_u32_b32 %0, -1, 0\n\tv_mbcnt_hi_u32_b32 %0, -1, %0" : "=v"(l)); return l; }
struct Frame {
    LAS unsigned char* lds;
    volatile LAS unsigned* MISC;
    gu32* ctl;
    int vcu, G, wv;
};

__device__ __forceinline__ float ushift(const bf16* buf, int ldc, int col, int row, int t, float sp, float sn) {
    const bf16* p = buf + (size_t)row * ldc + col;
    const float u0 = bf2f(p[0]);
    const float up = (t > 0) ? bf2f(p[-ldc]) : 0.f;
    const float un = (t < SEQ - 1) ? bf2f(p[ldc]) : 0.f;
    return u0 + sp * (up - u0) + sn * (un - u0);
}

__device__ __forceinline__ void transpose_item(const float* W, int K, int N, bf16* WT, const float* gain, bool headperm, LAS float* scr, int item, int lane) {
    const int nblk = N / 32, kb = item / nblk, nb = item % nblk, k0 = 64 * kb, n0 = 32 * nb;
#pragma unroll 8
    for (int i = 0; i < 32; ++i) { const int kk = 2 * i + (lane >> 5); float w = W[(size_t)(k0 + kk) * N + n0 + (lane & 31)]; if (gain) w *= gain[k0 + kk]; scr[kk * 33 + (lane & 31)] = w; }
    LDS_WAIT(); asm volatile("" ::: "memory");
    const int c = lane & 7;
    const int p0 = headperm ? ((n0 & ~255) + 128 * ((n0 >> 5) & 1) + 32 * ((n0 >> 6) & 3)) : n0;
#pragma unroll
    for (int j = 0; j < 4; ++j) { const int n = (lane >> 3) + 8 * j; const LAS float* s = scr + (8 * c) * 33 + n;
        v4u o; o.x = pk2(s[0 * 33], s[1 * 33]); o.y = pk2(s[2 * 33], s[3 * 33]); o.z = pk2(s[4 * 33], s[5 * 33]); o.w = pk2(s[6 * 33], s[7 * 33]);
        *(GAS v4u*)(WT + (size_t)(p0 + n) * K + k0 + 8 * c) = o; }
    LDS_WAIT(); asm volatile("" ::: "memory");
}
__device__ __forceinline__ void wconv_items(int layerA, int layerB, int wi, int nw, LAS float* scr, int lane_) {
    unsigned char* const ws = kws();
    constexpr int I_1 = (D / 64) * (NPROJ / 32), I_2 = (D / 64) * (D / 32), I_3 = (D / 64) * (FF / 32), I_4 = (FF / 64) * (D / 32);
    constexpr int NA = I_1 + 64, NB = I_2 + I_3 + I_4 + 32;
    const int nA = (layerA >= 0 && layerA < DEPTH) ? NA : 0, nB = (layerB >= 0) ? NB : 0;
    for (int it = wi; it < nA + nB; it += nw) {
        int r = it;
        if (r < nA) { const int layer = layerA;
            if (r < I_1) { transpose_item(karg(I_WIN) + (size_t)layer * D * NPROJ, D, NPROJ, (bf16*)(ws + WS_WIN), karg(I_LN1) + layer * D, true, scr, r, lane_); continue; } r -= I_1;
            const int mat = r >> 4, it16 = r & 15;
            const float* src = (mat < 2 ? karg(I_W2) : karg(I_A2)) + (size_t)(layer * 2 + (mat & 1)) * 64 * 512;
            transpose_item(src, 64, 512, (bf16*)(ws + WS_LORA) + (size_t)mat * 512 * 64, nullptr, false, scr, it16, lane_); continue; }
        r -= nA; const int layer = layerB;
        if (r < I_2) { transpose_item(karg(I_WOUT) + (size_t)layer * D * D, D, D, (bf16*)(ws + WS_WOUT), nullptr, false, scr, r, lane_); continue; } r -= I_2;
        if (r < I_3) { transpose_item(karg(I_WUP) + (size_t)layer * D * FF, D, FF, (bf16*)(ws + WS_WUP), karg(I_LN2) + layer * D, false, scr, r, lane_); continue; } r -= I_3;
        if (r < I_4) { transpose_item(karg(I_WDN) + (size_t)layer * FF * D, FF, D, (bf16*)(ws + WS_WDN), nullptr, false, scr, r, lane_); continue; } r -= I_4;
        transpose_item(karg(I_G2) + (size_t)layer * 128 * 512, 128, 512, (bf16*)(ws + WS_G2T), nullptr, false, scr, r, lane_);
    }
}
__device__ __forceinline__ void x_prologue(Frame& F) {
    unsigned char* const ws = kws();
    int lane_ = lane_id(); asm volatile("" : "+v"(lane_)); int wave_o = F.wv; asm volatile("" : "+s"(wave_o)); const int wave_ = wave_o, tid_ = wave_ * 64 + lane_;
    const int gw = F.vcu * NWAVES + wave_, NGW = F.G * NWAVES;
    const float* x = karg(I_X); bf16* xb = (bf16*)(ws + R_XB); float* ss = (float*)(ws + WS_SS1);
    for (int m = gw; m < M; m += NGW) {
        const GAS f32x4* xr = (const GAS f32x4*)(x + (size_t)m * D) + lane_; GAS f32x4* orow = (GAS f32x4*)(kout() + (size_t)m * D) + lane_;
        GAS unsigned long long* o8 = (GAS unsigned long long*)(xb + (size_t)m * D) + lane_;
        float s = 0.f;
#pragma unroll
        for (int j = 0; j < 4; ++j) { const f32x4 v = xr[64 * j]; orow[64 * j] = v; s += (v.x * v.x + v.y * v.y) + (v.z * v.z + v.w * v.w);
            o8[64 * j] = (unsigned long long)pk2(v.x, v.y) | ((unsigned long long)pk2(v.z, v.w) << 32); }
        s = wave_sum(s, lane_);
        if (lane_ < 16) ss[(size_t)m * 16 + lane_] = (lane_ == 0) ? s : 0.f;
    }
}

__device__ __forceinline__ void attn_naive(Frame& F, int layer, int aw, int naw) {
    unsigned char* const ws = kws();
    int lane_ = lane_id(); asm volatile("" : "+v"(lane_)); int wave_o = F.wv; asm volatile("" : "+s"(wave_o)); const int wave_ = wave_o, tid_ = wave_ * 64 + lane_;
    bf16* MIX = (bf16*)(ws + R_MIX); const bf16* Q = MIX; const bf16* K = MIX + 512; const bf16* V = (const bf16*)(ws + R_V);
    LAS float* qs = (LAS float*)(F.lds + RING_OFF + wave_ * 4096); LAS float* pb = qs + 64;
    float bound;
    { const float* qg = karg(I_QG) + layer * HD; const float* kg = karg(I_KG) + layer * HD; float mq = 0.f, mk = 0.f;
      for (int i = 0; i < HD; ++i) { mq = fmaxf(mq, fabsf(qg[i])); mk = fmaxf(mk, fabsf(kg[i])); }
      bound = 8.0f * mq * mk + 0.25f; }
    const int lane = lane_;
    for (int unit = aw; unit < BATCH * H * SEQ; unit += naw) {
        const int t = unit % SEQ, bh = unit / SEQ, h = bh % H, b = bh / H; const size_t row = (size_t)b * SEQ + t;
        qs[lane] = bf2f(Q[row * 1024 + h * HD + lane]);
        LDS_WAIT(); asm volatile("" ::: "memory");
        float qv[HD];
#pragma unroll
        for (int i = 0; i < HD; ++i) qv[i] = qs[i];
        const float slope = exp2f(-(float)(h + 1));
        float lsum = 0.f;
        for (int bi = 0; bi < 3; ++bi) { const int d = 1 << (2 * bi);
            for (int pass = 0; pass < 3; ++pass) { const int jj = pass * 64 + lane; const bool act = jj <= 128; const int j = jj - 64; const int pos = t + j * d; const bool valid = act && pos >= 0 && pos < SEQ;
                float p = 0.f;
                if (valid) { const v4u* kr = (const v4u*)(K + ((size_t)b * SEQ + pos) * 1024 + h * HD); float dot = 0.f;
#pragma unroll
                    for (int c = 0; c < 8; ++c) { const v4u w = kr[c];
                        dot += qv[8 * c + 0] * __uint_as_float(w.x << 16) + qv[8 * c + 1] * __uint_as_float(w.x & 0xffff0000u) + qv[8 * c + 2] * __uint_as_float(w.y << 16) + qv[8 * c + 3] * __uint_as_float(w.y & 0xffff0000u)
                             + qv[8 * c + 4] * __uint_as_float(w.z << 16) + qv[8 * c + 5] * __uint_as_float(w.z & 0xffff0000u) + qv[8 * c + 6] * __uint_as_float(w.w << 16) + qv[8 * c + 7] * __uint_as_float(w.w & 0xffff0000u); }
                    const float s = dot - slope * fabsf((float)(j * d)); p = __expf(s - bound); }
                if (act) pb[bi * 129 + jj] = p;
                lsum += p; } }
        lsum = wave_sum(lsum, lane_);
        LDS_WAIT(); asm volatile("" ::: "memory");
        float o = 0.f;
        for (int bi = 0; bi < 3; ++bi) { const int d = 1 << (2 * bi);
            for (int jj = 0; jj < 129; ++jj) { const float p = pb[bi * 129 + jj];
                if (p != 0.f) { const int pos = t + (jj - 64) * d; o += p * bf2f(V[((size_t)b * SEQ + pos) * 512 + h * HD + lane]); } } }
        MIX[row * 1024 + h * HD + lane] = f2bf_s(o / lsum);
        LDS_WAIT(); asm volatile("" ::: "memory");
    }
}

typedef float f32x16 __attribute__((ext_vector_type(16)));
typedef short s16x4 __attribute__((ext_vector_type(4)));
typedef short v4i16_t __attribute__((ext_vector_type(4)));
typedef unsigned u32x2_t __attribute__((ext_vector_type(2)));
typedef float f32x2_t __attribute__((ext_vector_type(2))); typedef __bf16 bf16x2_t __attribute__((ext_vector_type(2)));
__device__ __forceinline__ unsigned cvtpk(float lo, float hi) { f32x2_t v = {lo, hi}; bf16x2_t b = __builtin_convertvector(v, bf16x2_t); return __builtin_bit_cast(unsigned, b); }
typedef _Float16 h16x2_t __attribute__((ext_vector_type(2))); typedef _Float16 h16x8 __attribute__((ext_vector_type(8)));
__device__ __forceinline__ unsigned cvtpk_h(float lo, float hi) { f32x2_t v = {lo, hi}; h16x2_t b = __builtin_convertvector(v, h16x2_t); return __builtin_bit_cast(unsigned, b); }
__device__ __forceinline__ f32x2_t unpk_h(unsigned w) { return __builtin_convertvector(__builtin_bit_cast(h16x2_t, w), f32x2_t); }
#define MFMA32H(nf, mf, acc) __builtin_amdgcn_mfma_f32_32x32x16_f16(__builtin_bit_cast(h16x8, (nf)), __builtin_bit_cast(h16x8, (mf)), (acc), 0, 0, 0)
constexpr int TSB = 144, TILE_B = 64 * TSB;
constexpr int PRE_TW = 14 * TILE_B, PRE_XA = 15 * TILE_B, PRE_INVN = 16 * TILE_B, PRE_GC = PRE_INVN + 256, PRE_BON = PRE_GC + 512, PRE_LDS_END = PRE_BON + 1024;
static_assert(PRE_LDS_END <= LDSCTL_OFF, "PRE LDS map");
__device__ __forceinline__ bf16x8 frag_row(const LAS unsigned char* tile, int row, int ks, int hi) {
    return *(const LAS bf16x8*)(tile + row * TSB + (16 * ks + 8 * hi) * 2);
}
__device__ __forceinline__ s16x4 tr4(const LAS unsigned char* p) { return __builtin_bit_cast(s16x4, __builtin_amdgcn_ds_read_tr16_b64_v4i16((LAS v4i16_t*)p)); }
__device__ __forceinline__ bf16x8 frag_tr(const LAS unsigned char* tile, int idx0, int ks, int lane) {
    const int hi = lane >> 5, g1 = (lane >> 4) & 1, i = lane & 15;
    const LAS unsigned char* p = tile + (16 * ks + 8 * hi + (i >> 2)) * TSB + (idx0 + 16 * g1 + 4 * (i & 3)) * 2;
    const s16x4 lo = tr4(p), h4 = tr4(p + 4 * TSB);
    return (bf16x8){lo[0], lo[1], lo[2], lo[3], h4[0], h4[1], h4[2], h4[3]};
}
__device__ __forceinline__ void store_quad(LAS unsigned char* tile, int row, int n0, int hi, const f32x16& a) {
#pragma unroll
    for (int q = 0; q < 4; ++q) { u32x2_t w; w.x = cvtpk(a[4 * q], a[4 * q + 1]); w.y = cvtpk(a[4 * q + 2], a[4 * q + 3]); *(LAS u32x2_t*)(tile + row * TSB + (n0 + 8 * q + 4 * hi) * 2) = w; }
}
__device__ __forceinline__ void store_quad_h(LAS unsigned char* tile, int row, int n0, int hi, const f32x16& a) {
#pragma unroll
    for (int q = 0; q < 4; ++q) { u32x2_t w; w.x = cvtpk_h(a[4 * q], a[4 * q + 1]); w.y = cvtpk_h(a[4 * q + 2], a[4 * q + 3]); *(LAS u32x2_t*)(tile + row * TSB + (n0 + 8 * q + 4 * hi) * 2) = w; }
}
__device__ __forceinline__ f32x16 load_quad(const LAS unsigned char* tile, int row, int n0, int hi) {
    f32x16 a;
#pragma unroll
    for (int q = 0; q < 4; ++q) { const u32x2_t w = *(const LAS u32x2_t*)(tile + row * TSB + (n0 + 8 * q + 4 * hi) * 2);
        a[4 * q] = __uint_as_float(w.x << 16); a[4 * q + 1] = __uint_as_float(w.x & 0xffff0000u); a[4 * q + 2] = __uint_as_float(w.y << 16); a[4 * q + 3] = __uint_as_float(w.y & 0xffff0000u); }
    return a;
}
#define MFMA32(nf, mf, acc) __builtin_amdgcn_mfma_f32_32x32x16_bf16((nf), (mf), (acc), 0, 0, 0)
#define LD4_ROW(dst, tile, row) _Pragma("unroll") for (int ks_ = 0; ks_ < 4; ++ks_) dst[ks_] = frag_row(tile, row, ks_, hi)
#define LD4_TR(dst, tile, idx0) _Pragma("unroll") for (int ks_ = 0; ks_ < 4; ++ks_) dst[ks_] = frag_tr(tile, idx0, ks_, lane)
#define SBAR0() __builtin_amdgcn_sched_barrier(0)
#define WG_BARL() do { asm volatile("s_waitcnt lgkmcnt(0)" ::: "memory"); __builtin_amdgcn_s_barrier(); asm volatile("" ::: "memory"); } while (0)
#define WG_BAR() do { asm volatile("s_waitcnt vmcnt(0) lgkmcnt(0)" ::: "memory"); __builtin_amdgcn_s_barrier(); asm volatile("" ::: "memory"); } while (0)
__device__ __forceinline__ void shift8(const bf16* buf, int ldc, int col, int row, int t, const float* sp, const float* sn, float (&out)[8]) {
    const bf16* p = buf + (size_t)row * ldc + col;
    const v4u c = *(const v4u*)p; v4u pv = (v4u){0u, 0u, 0u, 0u}, nv = (v4u){0u, 0u, 0u, 0u};
    if (t > 0) pv = *(const v4u*)(p - ldc);
    if (t < SEQ - 1) nv = *(const v4u*)(p + ldc);
    const f32x4 sp0 = *(const f32x4*)sp, sp1 = *(const f32x4*)(sp + 4), sn0 = *(const f32x4*)sn, sn1 = *(const f32x4*)(sn + 4);
#pragma unroll
    for (int j = 0; j < 8; ++j) { const unsigned cw = c[j >> 1], pw = pv[j >> 1], nw = nv[j >> 1];
        const float u0 = (j & 1) ? __uint_as_float(cw & 0xffff0000u) : __uint_as_float(cw << 16), up = (j & 1) ? __uint_as_float(pw & 0xffff0000u) : __uint_as_float(pw << 16), un = (j & 1) ? __uint_as_float(nw & 0xffff0000u) : __uint_as_float(nw << 16);
        const float a = (j < 4) ? sp0[j & 3] : sp1[j & 3], bq = (j < 4) ? sn0[j & 3] : sn1[j & 3];
        out[j] = u0 + a * (up - u0) + bq * (un - u0); }
}
__device__ __forceinline__ f32x4 shift4(const bf16* buf, int ldc, int col, int row, int t, const float* sp, const float* sn) {
    const bf16* p = buf + (size_t)row * ldc + col;
    const u32x2_t c = *(const u32x2_t*)p; u32x2_t pv = (u32x2_t){0u, 0u}, nv = (u32x2_t){0u, 0u};
    if (t > 0) pv = *(const u32x2_t*)(p - ldc);
    if (t < SEQ - 1) nv = *(const u32x2_t*)(p + ldc);
    const f32x4 a = *(const f32x4*)sp, bq = *(const f32x4*)sn;
    const f32x4 u0 = (f32x4){__uint_as_float(c.x << 16), __uint_as_float(c.x & 0xffff0000u), __uint_as_float(c.y << 16), __uint_as_float(c.y & 0xffff0000u)};
    const f32x4 up = (f32x4){__uint_as_float(pv.x << 16), __uint_as_float(pv.x & 0xffff0000u), __uint_as_float(pv.y << 16), __uint_as_float(pv.y & 0xffff0000u)};
    const f32x4 un = (f32x4){__uint_as_float(nv.x << 16), __uint_as_float(nv.x & 0xffff0000u), __uint_as_float(nv.y << 16), __uint_as_float(nv.y & 0xffff0000u)};
    return u0 + a * (up - u0) + bq * (un - u0);
}

struct R16 { v4u c, p, n; };
struct R8 { u32x2_t c, p, n; };
__device__ __forceinline__ R16 ld3x16(const bf16* buf, int ldc, int col, int row, int t) {
    const bf16* q = buf + (size_t)row * ldc + col; R16 r; r.c = *(const v4u*)q; r.p = (v4u){0u, 0u, 0u, 0u}; r.n = (v4u){0u, 0u, 0u, 0u};
    if (t > 0) r.p = *(const v4u*)(q - ldc);
    if (t < SEQ - 1) r.n = *(const v4u*)(q + ldc);
    return r;
}
__device__ __forceinline__ R8 ld3x8(const bf16* buf, int ldc, int col, int row, int t) {
    const bf16* q = buf + (size_t)row * ldc + col; R8 r; r.c = *(const u32x2_t*)q; r.p = (u32x2_t){0u, 0u}; r.n = (u32x2_t){0u, 0u};
    if (t > 0) r.p = *(const u32x2_t*)(q - ldc);
    if (t < SEQ - 1) r.n = *(const u32x2_t*)(q + ldc);
    return r;
}
__device__ __forceinline__ void sh8(const R16& r, const LAS float* sp, const LAS float* sn, float (&out)[8]) {
    const f32x4 sp0 = *(const LAS f32x4*)sp, sp1 = *(const LAS f32x4*)(sp + 4), sn0 = *(const LAS f32x4*)sn, sn1 = *(const LAS f32x4*)(sn + 4);
#pragma unroll
    for (int j = 0; j < 8; ++j) { const unsigned cw = r.c[j >> 1], pw = r.p[j >> 1], nw = r.n[j >> 1];
        const float u0 = (j & 1) ? __uint_as_float(cw & 0xffff0000u) : __uint_as_float(cw << 16), up = (j & 1) ? __uint_as_float(pw & 0xffff0000u) : __uint_as_float(pw << 16), un = (j & 1) ? __uint_as_float(nw & 0xffff0000u) : __uint_as_float(nw << 16);
        const float a = (j < 4) ? sp0[j & 3] : sp1[j & 3], bq = (j < 4) ? sn0[j & 3] : sn1[j & 3];
        out[j] = u0 + a * (up - u0) + bq * (un - u0); }
}
__device__ __forceinline__ f32x4 sh4(const R8& r, const f32x4 a, const f32x4 bq) {
    const f32x4 u0 = (f32x4){__uint_as_float(r.c.x << 16), __uint_as_float(r.c.x & 0xffff0000u), __uint_as_float(r.c.y << 16), __uint_as_float(r.c.y & 0xffff0000u)};
    const f32x4 up = (f32x4){__uint_as_float(r.p.x << 16), __uint_as_float(r.p.x & 0xffff0000u), __uint_as_float(r.p.y << 16), __uint_as_float(r.p.y & 0xffff0000u)};
    const f32x4 un = (f32x4){__uint_as_float(r.n.x << 16), __uint_as_float(r.n.x & 0xffff0000u), __uint_as_float(r.n.y << 16), __uint_as_float(r.n.y & 0xffff0000u)};
    return u0 + a * (up - u0) + bq * (un - u0);
}
constexpr int PRE_CT = PRE_LDS_END;
enum { CT_KK = 0, CT_KA = 64, CT_RK = 128, CT_W0 = 192  , CT_A0 = 320  , CT_SPR = 448, CT_SNR = 512, CT_SPK = 576, CT_SNK = 640, CT_SPV = 704, CT_SNV = 768, CT_SPX = 832  , CT_SNX = 960  , CT_N = 1088 };
static_assert(PRE_CT + CT_N * 4 <= LDSCTL_OFF, "PRE constant table");
__device__ __forceinline__ void rwkv_pre_phase(Frame& F, int layer) {
    unsigned char* const ws = kws();
    int lane_ = lane_id(); asm volatile("" : "+v"(lane_)); int wave_o = F.wv; asm volatile("" : "+s"(wave_o)); const int wave_ = wave_o;
    const int d = wave_ >> 2, qm = (wave_ >> 1) & 1, qn = wave_ & 1, m0 = 32 * qm, n0 = 32 * qn;
#define LANE_VARS int lane = lane_; asm volatile("" : "+v"(lane)); const int hi = lane >> 5, l31 = lane & 31, mrow = m0 + l31; (void)hi; (void)l31; (void)mrow;
    LAS unsigned char* const L = F.lds;
    LAS unsigned char* const T0 = L + (d * 7 + 0) * TILE_B; LAS unsigned char* const T1 = L + (d * 7 + 1) * TILE_B; LAS unsigned char* const T2 = L + (d * 7 + 2) * TILE_B; LAS unsigned char* const T3 = L + (d * 7 + 3) * TILE_B;
    LAS unsigned char* const T4 = L + (d * 7 + 4) * TILE_B; LAS unsigned char* const T5 = L + (d * 7 + 5) * TILE_B; LAS unsigned char* const T6 = L + (d * 7 + 6) * TILE_B;
    LAS unsigned char* const TWt = L + PRE_TW; LAS unsigned char* const XAt = L + PRE_XA;
    LAS float* const invn = (LAS float*)(L + PRE_INVN); LAS float* const gcs = (LAS float*)(L + PRE_GC) + d * 64; LAS float* const bon = (LAS float*)(L + PRE_BON); LAS float* const ct = (LAS float*)(L + PRE_CT);
    const bf16* Rr = (const bf16*)(ws + R_RR); const bf16* Kr = (const bf16*)(ws + R_KR); const bf16* Vr = (const bf16*)(ws + R_VR); const bf16* XL = (const bf16*)(ws + R_XL);
    const bf16* W2T = (const bf16*)(ws + WS_LORA) + (size_t)d * 512 * 64; const bf16* A2T = (const bf16*)(ws + WS_LORA) + (size_t)(2 + d) * 512 * 64;
    float* BN = (float*)(ws + R_BN) + (size_t)d * M * 8;
    const int h = F.vcu & 7, hc = h * HD, bc0 = F.vcu >> 3, bcs = F.G >> 3;
    { LANE_VARS; const float* sp = karg(I_TSP) + layer * RPROJ; const float* sn = karg(I_TSN) + layer * RPROJ;
      for (int idx = wave_ * 64 + lane; idx < CT_N; idx += NTHR) { const int seg = idx >> 6, c = idx & 63; float v;
          if (seg == 0) v = karg(I_KK)[layer * 512 + hc + c]; else if (seg == 1) v = karg(I_KA)[layer * 512 + hc + c]; else if (seg == 2) v = karg(I_RK)[layer * 512 + hc + c];
          else if (seg < 5) v = karg(I_W0)[(layer * 2 + seg - 3) * 512 + hc + c]; else if (seg < 7) v = karg(I_A0)[(layer * 2 + seg - 5) * 512 + hc + c];
          else if (seg < 13) { const int j = seg - 7; v = ((j & 1) ? sn : sp)[(j >> 1) * 512 + hc + c]; }
          else if (seg < 15) v = sp[1536 + (idx - CT_SPX)]; else v = sn[1536 + (idx - CT_SNX)];
          ct[idx] = v; } }
    WG_BARL();
    R16 xw3, xa3, kk3;
    { LANE_VARS; const int tidl = wave_ * 64 + lane, tok = tidl >> 3, oct = tidl & 7; const int b = bc0 >> 6, t = (bc0 & 63) * 64 + tok, row = b * SEQ + t;
      xw3 = ld3x16(XL, 256, 8 * oct, row, t); xa3 = ld3x16(XL, 256, 64 + 8 * oct, row, t); kk3 = ld3x16(Kr, 512, hc + 8 * oct, row, t); }
    for (int bc = bc0; bc < BATCH * (SEQ / 64); bc += bcs) {
        const int cn = bc & 63, b = bc >> 6, t0 = cn * 64;
#define SNAT (d ? 63 - mrow : mrow)
        bf16x8 wfr[4], afr[4]; R8 rq[4], kq_[4];
        { LANE_VARS; const int snat = SNAT, tnat = t0 + snat, row = b * SEQ + tnat;
#pragma unroll
          for (int ks = 0; ks < 4; ++ks) { const size_t wo = (size_t)(hc + n0 + l31) * 64 + 16 * ks + 8 * hi; wfr[ks] = *(const bf16x8*)(W2T + wo); afr[ks] = *(const bf16x8*)(A2T + wo); }
#pragma unroll
          for (int q = 0; q < 4; ++q) { const int cg = hc + n0 + 8 * q + 4 * hi; rq[q] = ld3x8(Rr, 512, cg, row, tnat); kq_[q] = ld3x8(Kr, 512, cg, row, tnat); } }
        { LANE_VARS; const int tidl = wave_ * 64 + lane; const int tok = tidl >> 3, oct = tidl & 7; float v8[8];
          sh8(xw3, ct + CT_SPX + 8 * oct, ct + CT_SNX + 8 * oct, v8);
          { v4u w; w.x = cvtpk(tanh_fast(v8[0]), tanh_fast(v8[1])); w.y = cvtpk(tanh_fast(v8[2]), tanh_fast(v8[3])); w.z = cvtpk(tanh_fast(v8[4]), tanh_fast(v8[5])); w.w = cvtpk(tanh_fast(v8[6]), tanh_fast(v8[7])); *(LAS v4u*)(TWt + tok * TSB + 16 * oct) = w; }
          sh8(xa3, ct + CT_SPX + 64 + 8 * oct, ct + CT_SNX + 64 + 8 * oct, v8);
          { v4u w; w.x = cvtpk(v8[0], v8[1]); w.y = cvtpk(v8[2], v8[3]); w.z = cvtpk(v8[4], v8[5]); w.w = cvtpk(v8[6], v8[7]); *(LAS v4u*)(XAt + tok * TSB + 16 * oct) = w; }
          sh8(kk3, ct + CT_SPK + 8 * oct, ct + CT_SNK + 8 * oct, v8);
          const f32x4 k0 = *(const LAS f32x4*)(ct + CT_KK + 8 * oct), k1 = *(const LAS f32x4*)(ct + CT_KK + 8 * oct + 4); float ssq = 0.f;
#pragma unroll
          for (int j = 0; j < 8; ++j) { const float kx = v8[j] * ((j < 4) ? k0[j & 3] : k1[j & 3]); ssq += kx * kx; }
          ssq += pg8::shx(ssq, 1, lane); ssq += pg8::shx(ssq, 2, lane); ssq += pg8::shx(ssq, 4, lane);
          if (oct == 0) invn[tok] = 1.0f / sqrtf(ssq + 1e-12f); }
        WG_BARL();
        f32x16 zw, za, lw, av, cum;
        { LANE_VARS; const int snat = SNAT;
#pragma unroll
        for (int r = 0; r < 16; ++r) { zw[r] = 0.f; za[r] = 0.f; }
        { bf16x8 f0[4], f1[4]; LD4_ROW(f0, TWt, snat); LD4_ROW(f1, XAt, snat); SBAR0();
#pragma unroll
          for (int ks = 0; ks < 4; ++ks) { zw = MFMA32(wfr[ks], f0[ks], zw); za = MFMA32(afr[ks], f1[ks], za); } }
#pragma unroll
        for (int q = 0; q < 4; ++q) { const f32x4 w0v = *(const LAS f32x4*)(ct + CT_W0 + 64 * d + n0 + 8 * q + 4 * hi), a0v = *(const LAS f32x4*)(ct + CT_A0 + 64 * d + n0 + 8 * q + 4 * hi);
#pragma unroll
            for (int i = 0; i < 4; ++i) { lw[4 * q + i] = -0.6065306597f * sigmoidf_(zw[4 * q + i] + w0v[i]); av[4 * q + i] = sigmoidf_(za[4 * q + i] + a0v[i]); } }
        { f32x16 lh, ll;
#pragma unroll
          for (int r = 0; r < 16; ++r) { lh[r] = __uint_as_float(cvtpk(lw[r], 0.f) << 16); ll[r] = lw[r] - lh[r]; }
          store_quad(T4, mrow, n0, hi, lh); store_quad(T5, mrow, n0, hi, ll); } }
        WG_BARL();
        { LANE_VARS;
#pragma unroll
        for (int r = 0; r < 16; ++r) cum[r] = 0.f;
        { bf16x8 f0[4], f1[4]; LD4_TR(f0, T4, n0); LD4_TR(f1, T5, n0); SBAR0();
#pragma unroll
        for (int ks = 0; ks < 4; ++ks) { bf16x8 tf;
#pragma unroll
            for (int j = 0; j < 8; ++j) tf[j] = (16 * ks + 8 * hi + j <= mrow) ? (short)0x3f80 : (short)0;
            cum = MFMA32(f0[ks], tf, cum); cum = MFMA32(f1[ks], tf, cum); } } }
        f32x16 rh, kc, mrk;
        { LANE_VARS; const int snat = SNAT; const float inv = invn[snat];
          float bsum = 0.f;
#pragma unroll
          for (int q = 0; q < 4; ++q) { const int cl = n0 + 8 * q + 4 * hi;
              const f32x4 r4 = sh4(rq[q], *(const LAS f32x4*)(ct + CT_SPR + cl), *(const LAS f32x4*)(ct + CT_SNR + cl)), k4 = sh4(kq_[q], *(const LAS f32x4*)(ct + CT_SPK + cl), *(const LAS f32x4*)(ct + CT_SNK + cl));
              const f32x4 kk4 = *(const LAS f32x4*)(ct + CT_KK + cl), ka4 = *(const LAS f32x4*)(ct + CT_KA + cl), rk4 = *(const LAS f32x4*)(ct + CT_RK + cl);
              float kh4[4], bc4[4], rl4[4], kl4[4];
#pragma unroll
              for (int i = 0; i < 4; ++i) { const int e = 4 * q + i; const float a = av[e], cs = cum[e];
                  const float g = __expf(cs), gx = __expf(cs - lw[e]), gi = __expf(-cs);
                  const float kkn = k4[i] * kk4[i] * inv, kt = k4[i] * (1.0f + (a - 1.0f) * ka4[i]);
                  kh4[i] = gx * kkn; rh[e] = g * r4[i]; bc4[i] = a * kkn * gi; kc[e] = kt * gi; bsum += r4[i] * kt * rk4[i];
                  rl4[i] = rh[e] - __uint_as_float(cvtpk(rh[e], 0.f) << 16); kl4[i] = kc[e] - __uint_as_float(cvtpk(kc[e], 0.f) << 16);
                  if (mrow == 63) gcs[n0 + 8 * q + 4 * hi + i] = g; }
              const int off = mrow * TSB + (n0 + 8 * q + 4 * hi) * 2; u32x2_t w;
              w.x = cvtpk(kh4[0], kh4[1]); w.y = cvtpk(kh4[2], kh4[3]); *(LAS u32x2_t*)(T0 + off) = w;
              w.x = cvtpk(rh[4 * q], rh[4 * q + 1]); w.y = cvtpk(rh[4 * q + 2], rh[4 * q + 3]); *(LAS u32x2_t*)(T1 + off) = w;
              w.x = cvtpk(bc4[0], bc4[1]); w.y = cvtpk(bc4[2], bc4[3]); *(LAS u32x2_t*)(T2 + off) = w;
              w.x = cvtpk(kc[4 * q], kc[4 * q + 1]); w.y = cvtpk(kc[4 * q + 2], kc[4 * q + 3]); *(LAS u32x2_t*)(T3 + off) = w;
              w.x = cvtpk(rl4[0], rl4[1]); w.y = cvtpk(rl4[2], rl4[3]); *(LAS u32x2_t*)(T4 + off) = w;
              w.x = cvtpk(kl4[0], kl4[1]); w.y = cvtpk(kl4[2], kl4[3]); *(LAS u32x2_t*)(T5 + off) = w; }
          bsum += pg8::shx(bsum, 32, lane);
          if (hi == 0) bon[(d * 2 + qn) * 64 + snat] = bsum; }
        if (bc + bcs < BATCH * (SEQ / 64)) { LANE_VARS; const int tidl = wave_ * 64 + lane, tok = tidl >> 3, oct = tidl & 7; const int bn = bc + bcs, b2 = bn >> 6, t = (bn & 63) * 64 + tok, row = b2 * SEQ + t;
            xw3 = ld3x16(XL, 256, 8 * oct, row, t); xa3 = ld3x16(XL, 256, 64 + 8 * oct, row, t); kk3 = ld3x16(Kr, 512, hc + 8 * oct, row, t); }
        WG_BARL();
        { LANE_VARS; const int snat = SNAT; if (qn == 0 && hi == 0) BN[(size_t)(b * SEQ + t0 + snat) * 8 + h] = bon[(d * 2) * 64 + snat] + bon[(d * 2 + 1) * 64 + snat]; }
        { LANE_VARS;
#pragma unroll
          for (int r = 0; r < 16; ++r) mrk[r] = 0.f;
          bf16x8 f0[4], f1[4], f2[4], f3[4]; LD4_ROW(f0, T1, mrow); LD4_ROW(f1, T3, n0 + l31); LD4_ROW(f2, T5, n0 + l31); LD4_ROW(f3, T4, mrow); SBAR0();
#pragma unroll
          for (int ks = 0; ks < 4; ++ks) { mrk = MFMA32(f1[ks], f0[ks], mrk); mrk = MFMA32(f2[ks], f0[ks], mrk); mrk = MFMA32(f1[ks], f3[ks], mrk); }
#pragma unroll
          for (int q = 0; q < 4; ++q)
#pragma unroll
              for (int i = 0; i < 4; ++i) { const int e = 4 * q + i, n = n0 + 8 * q + 4 * hi + i; mrk[e] = (n <= mrow) ? mrk[e] : 0.f; } }
        WG_BARL();
        { LANE_VARS; f32x16 x, mk, zz;
          float z0 = 0.f; asm volatile("" : "+v"(z0));
#pragma unroll
          for (int r = 0; r < 16; ++r) { x[r] = 0.f; mk[r] = 0.f; zz[r] = z0; }
          { bf16x8 f0[4], f1[4], f2[4]; LD4_ROW(f0, T0, mrow); LD4_ROW(f1, T2, n0 + l31); LD4_ROW(f2, T3, n0 + l31); SBAR0();
#pragma unroll
            for (int ks = 0; ks < 4; ++ks) { x = MFMA32(f1[ks], f0[ks], x); mk = MFMA32(f2[ks], f0[ks], mk); } }
#pragma unroll
          for (int q = 0; q < 4; ++q)
#pragma unroll
              for (int i = 0; i < 4; ++i) { const int e = 4 * q + i, n = n0 + 8 * q + 4 * hi + i; const bool lo = n < mrow; x[e] = lo ? -x[e] : 0.f; mk[e] = lo ? mk[e] : 0.f; }
          store_quad(T4, mrow, n0, hi, x); store_quad(T5, mrow, n0, hi, zz); store_quad(T6, mrow, n0, hi, mk); }
        WG_BARL();
        if ((wave_ & 3) == 0) { LANE_VARS; const int blk = lane >> 4, c = lane & 15; float t[16];
#pragma unroll
            for (int r = 0; r < 16; ++r) { const LAS unsigned char* xr = T4 + (16 * blk + r) * TSB + 32 * blk; const v4u w0_ = *(const LAS v4u*)xr, w1_ = *(const LAS v4u*)(xr + 16);
                float acc0 = (r == c) ? 1.0f : 0.f, acc1 = 0.f;
#pragma unroll
                for (int j = 0; j < r; ++j) { const unsigned w = (j < 8) ? w0_[j >> 1] : w1_[(j - 8) >> 1]; const float xv = (j & 1) ? __uint_as_float(w & 0xffff0000u) : __uint_as_float(w << 16);
                    if (j & 1) acc1 += xv * t[j]; else acc0 += xv * t[j]; }
                t[r] = acc0 + acc1; }
#pragma unroll
            for (int r = 0; r < 16; ++r) *(LAS unsigned short*)(T5 + (16 * blk + r) * TSB + (16 * blk + c) * 2) = (unsigned short)(cvtpk(t[r], 0.f) & 0xffffu); }
        WG_BARL();
        { LANE_VARS; LAS unsigned char* const scr = qm ? T5 : T4;
          if (qm == qn) {
              f32x16 w;
#pragma unroll
              for (int r = 0; r < 16; ++r) w[r] = 0.f;
              bf16x8 mf = frag_row(T4, m0 + l31, 2 * qm, hi);
              if (l31 < 16) mf = (bf16x8){0, 0, 0, 0, 0, 0, 0, 0};
              w = MFMA32(frag_tr(T5, m0, 2 * qm, lane), mf, w);
              store_quad(scr, l31, 32, hi, w); } }
        WG_BARL();
        { LANE_VARS; LAS unsigned char* const scr = qm ? T5 : T4;
          if (qm == qn) {
              f32x16 tq = load_quad(T5, mrow, m0, hi);
#pragma unroll
              for (int ks = 0; ks < 2; ++ks) tq = MFMA32(frag_tr(scr, 32, ks, lane), frag_row(T5, mrow, 2 * qm + ks, hi), tq);
              store_quad(T5, mrow, m0, hi, tq); } }
        WG_BARL();
        { LANE_VARS;
          if (qm == 1 && qn == 0) {
              f32x16 w;
#pragma unroll
              for (int r = 0; r < 16; ++r) w[r] = 0.f;
#pragma unroll
              for (int ks = 0; ks < 2; ++ks) w = MFMA32(frag_tr(T5, 0, ks, lane), frag_row(T4, 32 + l31, ks, hi), w);
              store_quad(T4, l31, 32, hi, w); }
          if (qm == 0 && qn == 1) { f32x16 zz; float z0 = 0.f; asm volatile("" : "+v"(z0));
#pragma unroll
              for (int r = 0; r < 16; ++r) zz[r] = z0;
              store_quad(T5, l31, 32, hi, zz); } }
        WG_BARL();
        { LANE_VARS;
          if (qm == 1 && qn == 0) {
              f32x16 t21;
#pragma unroll
              for (int r = 0; r < 16; ++r) t21[r] = 0.f;
#pragma unroll
              for (int ks = 0; ks < 2; ++ks) t21 = MFMA32(frag_tr(T4, 32, ks, lane), frag_row(T5, 32 + l31, 2 + ks, hi), t21);
              store_quad(T5, 32 + l31, 0, hi, t21); } }
        WG_BARL();
        R16 vr3[2];
        { LANE_VARS; const int tt = (wave_ * 64 + lane) & 255, s = tt >> 2, cg4 = (tt & 3) * 16, sn_ = d ? 63 - s : s, t = t0 + sn_, row = b * SEQ + t;
          vr3[0] = ld3x16(Vr, 512, hc + cg4, row, t); vr3[1] = ld3x16(Vr, 512, hc + cg4 + 8, row, t); }
        { LANE_VARS; f32x16 kp, tk;
#pragma unroll
          for (int r = 0; r < 16; ++r) { kp[r] = 0.f; tk[r] = 0.f; }
          { bf16x8 f0[4], f1[4], f2[4]; LD4_ROW(f0, T5, mrow); LD4_TR(f1, T0, n0); LD4_TR(f2, T6, n0); SBAR0();
#pragma unroll
            for (int ks = 0; ks < 4; ++ks) { kp = MFMA32(f1[ks], f0[ks], kp); tk = MFMA32(f2[ks], f0[ks], tk); } }
          WG_BARL();
          store_quad(T0, mrow, n0, hi, kp); store_quad(T6, mrow, n0, hi, tk); }
        { LANE_VARS; f32x16 rb;
#pragma unroll
          for (int r = 0; r < 16; ++r) rb[r] = 0.f;
          { bf16x8 f0[4], f1[4]; LD4_ROW(f0, T2, n0 + l31); LD4_ROW(f1, T1, mrow); SBAR0();
#pragma unroll
            for (int ks = 0; ks < 4; ++ks) rb = MFMA32(f0[ks], f1[ks], rb); }
#pragma unroll
          for (int q = 0; q < 4; ++q)
#pragma unroll
              for (int i = 0; i < 4; ++i) { const int e = 4 * q + i, n = n0 + 8 * q + 4 * hi + i; rb[e] = (n <= mrow) ? rb[e] : 0.f; }
          store_quad(T4, mrow, n0, hi, rb); }
        WG_BARL();
        const int cd = d ? 63 - cn : cn;
        bf16* const pre = (bf16*)(ws + R_PRE) + ((size_t)(((b * 8 + h) * 2 + d) * 64 + cd)) * 16384;
        { LANE_VARS; f32x16 rp, ml, pm, kq;
#pragma unroll
          for (int r = 0; r < 16; ++r) { rp[r] = 0.f; ml[r] = 0.f; pm[r] = 0.f; kq[r] = 0.f; }
#pragma unroll
          for (int kh = 0; kh < 2; ++kh) { bf16x8 mrbf[2], khn[2], bcn[2], tkn[2], bcm[2], tkm[2];
#pragma unroll
              for (int k2 = 0; k2 < 2; ++k2) { const int ks = 2 * kh + k2; mrbf[k2] = frag_row(T4, mrow, ks, hi); khn[k2] = frag_tr(T0, n0, ks, lane); bcn[k2] = frag_tr(T2, n0, ks, lane); tkn[k2] = frag_tr(T6, n0, ks, lane); bcm[k2] = frag_tr(T2, m0, ks, lane); tkm[k2] = frag_tr(T6, m0, ks, lane); }
              SBAR0();
#pragma unroll
              for (int k2 = 0; k2 < 2; ++k2) { rp = MFMA32(khn[k2], mrbf[k2], rp); ml = MFMA32(tkn[k2], mrbf[k2], ml); pm = MFMA32(khn[k2], bcm[k2], pm); kq = MFMA32(bcn[k2], tkm[k2], kq); }
              SBAR0(); }
          const float gm = gcs[mrow];
#pragma unroll
          for (int q = 0; q < 4; ++q)
#pragma unroll
              for (int i = 0; i < 4; ++i) { const int e = 4 * q + i, n = n0 + 8 * q + 4 * hi + i;
                  rp[e] = rh[e] - rp[e]; ml[e] = mrk[e] - ml[e]; pm[e] = gm * (((n == mrow) ? 1.0f : 0.f) - pm[e]); kq[e] = (kc[e] - kq[e]) * gcs[n]; }
#pragma unroll
          for (int q = 0; q < 4; ++q) { const int pc = n0 + 16 * (q >> 1) + 8 * hi + 4 * (q & 1);
              u32x2_t w; w.x = cvtpk_h(pm[4 * q], pm[4 * q + 1]); w.y = cvtpk_h(pm[4 * q + 2], pm[4 * q + 3]); *(u32x2_t*)(pre + mrow * 64 + pc) = w;
              w.x = cvtpk_h(rp[4 * q], rp[4 * q + 1]); w.y = cvtpk_h(rp[4 * q + 2], rp[4 * q + 3]); *(u32x2_t*)(pre + 4096 + (d ? 63 - mrow : mrow) * 64 + pc) = w; }
          WG_BARL();
          store_quad_h(T4, mrow, n0, hi, ml); store_quad_h(T5, mrow, n0, hi, kq); }
        { LANE_VARS; const int tt = (wave_ * 64 + lane) & 255, s = tt >> 2, cg4 = (tt & 3) * 16; float v8[8];
#pragma unroll
          for (int hlf = 0; hlf < 2; ++hlf) { const int c8 = cg4 + 8 * hlf;
              sh8(vr3[hlf], ct + CT_SPV + c8, ct + CT_SNV + c8, v8);
              v4u w; w.x = cvtpk_h(v8[0], v8[1]); w.y = cvtpk_h(v8[2], v8[3]); w.z = cvtpk_h(v8[4], v8[5]); w.w = cvtpk_h(v8[6], v8[7]); *(LAS v4u*)(T1 + s * TSB + 2 * c8) = w; } }
        WG_BARL();
        { LANE_VARS; f32x16 qt, yt;
#pragma unroll
          for (int r = 0; r < 16; ++r) { qt[r] = 0.f; yt[r] = 0.f; }
          { bf16x8 f0[4], f1[4], f2[4], f3[4]; LD4_TR(f0, T1, m0); LD4_TR(f1, T5, n0); LD4_TR(f2, T1, n0); LD4_ROW(f3, T4, mrow); SBAR0();
#pragma unroll
            for (int ks = 0; ks < 4; ++ks) { qt = MFMA32H(f1[ks], f0[ks], qt); yt = MFMA32H(f2[ks], f3[ks], yt); } }
          v4u w0_, w1_;
          w0_.x = cvtpk_h(qt[0], qt[1]); w0_.y = cvtpk_h(qt[2], qt[3]); w0_.z = cvtpk_h(qt[4], qt[5]); w0_.w = cvtpk_h(qt[6], qt[7]); w1_.x = cvtpk_h(qt[8], qt[9]); w1_.y = cvtpk_h(qt[10], qt[11]); w1_.z = cvtpk_h(qt[12], qt[13]); w1_.w = cvtpk_h(qt[14], qt[15]);
          { bf16* dst = pre + 8192 + ((qn * 64 + mrow) * 2 + hi) * 16; *(v4u*)dst = w0_; *(v4u*)(dst + 8) = w1_; }
          w0_.x = cvtpk_h(yt[0], yt[1]); w0_.y = cvtpk_h(yt[2], yt[3]); w0_.z = cvtpk_h(yt[4], yt[5]); w0_.w = cvtpk_h(yt[6], yt[7]); w1_.x = cvtpk_h(yt[8], yt[9]); w1_.y = cvtpk_h(yt[10], yt[11]); w1_.z = cvtpk_h(yt[12], yt[13]); w1_.w = cvtpk_h(yt[14], yt[15]);
          { bf16* dst = pre + 12288 + ((qn * 64 + (d ? 63 - mrow : mrow)) * 2 + hi) * 16; *(v4u*)dst = w0_; *(v4u*)(dst + 8) = w1_; } }
        WG_BARL();
    }
#undef LANE_VARS
#undef SNAT
}

constexpr int SCAN_SLOT = 12 * 1024, SCAN_NS = 4;
__device__ __forceinline__ void scan_issue(const bf16* pre, LAS unsigned char* slot, int l31, int hi, int v) {
#pragma unroll
    for (int i = 0; i < 8; ++i) { const int mt = i >> 2, kt = (i >> 1) & 1, s = i & 1;
        __builtin_amdgcn_global_load_lds((const unsigned*)(pre + (32 * mt + l31) * 64 + 32 * kt + 16 * s + 8 * hi), (LAS unsigned*)(slot + i * 1024), 16, 0, 0); }
#pragma unroll
    for (int i = 0; i < 4; ++i) { const int mt = i >> 1, hf = i & 1;
        __builtin_amdgcn_global_load_lds((const unsigned*)(pre + 8192 + ((mt * 64 + v) * 2 + hi) * 16 + 8 * hf), (LAS unsigned*)(slot + (8 + i) * 1024), 16, 0, 0); }
}
__device__ __forceinline__ void rwkv_scan_chunk(Frame& F, int unit) {
    unsigned char* const ws = kws();
    int lane_ = lane_id(); asm volatile("" : "+v"(lane_));
    const int lane = lane_, hi = lane >> 5, l31 = lane & 31;
    const int chain = unit >> 1, vh = unit & 1, v = 32 * vh + l31;
    const bf16* pre = (const bf16*)(ws + R_PRE) + (size_t)chain * 64 * 16384;
    bf16* sd = (bf16*)(ws + R_SD) + (size_t)chain * 64 * 4096;
    LAS unsigned char* const ring = F.lds;
    f32x16 X0, X1;
#pragma unroll
    for (int r = 0; r < 16; ++r) { X0[r] = 0.f; X1[r] = 0.f; }
    scan_issue(pre, ring, l31, hi, v); scan_issue(pre + 16384, ring + SCAN_SLOT, l31, hi, v); scan_issue(pre + 2 * 16384, ring + 2 * SCAN_SLOT, l31, hi, v);
#pragma unroll 1
    for (int c = 0; c < 64; ++c) {
        bf16x8 xb[2][2], xl[2][2];
#pragma unroll
        for (int kt = 0; kt < 2; ++kt)
#pragma unroll
            for (int s = 0; s < 2; ++s) { v4u w, wl;
#pragma unroll
                for (int j = 0; j < 4; ++j) { const float a0 = kt ? X1[8 * s + 2 * j] : X0[8 * s + 2 * j], a1 = kt ? X1[8 * s + 2 * j + 1] : X0[8 * s + 2 * j + 1];
                    const unsigned hw = cvtpk_h(a0, a1); const f32x2_t hf = unpk_h(hw); w[j] = hw; wl[j] = cvtpk_h(a0 - hf.x, a1 - hf.y); }
                xb[kt][s] = __builtin_bit_cast(bf16x8, w); xl[kt][s] = __builtin_bit_cast(bf16x8, wl);
                *(v4u*)(sd + (size_t)c * 4096 + ((kt * 64 + v) * 2 + hi) * 16 + 8 * s) = w; }
        asm volatile("s_waitcnt lgkmcnt(0)" ::: "memory");
        if (c + 3 < 64) scan_issue(pre + (size_t)(c + 3) * 16384, ring + ((c + 3) & 3) * SCAN_SLOT, l31, hi, v);
        if (c + 3 < 64) asm volatile("s_waitcnt vmcnt(36)" ::: "memory"); else asm volatile("s_waitcnt vmcnt(0)" ::: "memory");
        const LAS unsigned char* sl = ring + (c & 3) * SCAN_SLOT + lane * 16;
        f32x16 acc[2];
#pragma unroll
        for (int mt = 0; mt < 2; ++mt) { const v4u w0_ = *(const LAS v4u*)(sl + (8 + 2 * mt) * 1024), w1_ = *(const LAS v4u*)(sl + (9 + 2 * mt) * 1024);
#pragma unroll
            for (int j = 0; j < 4; ++j) { const f32x2_t u0 = unpk_h(w0_[j]), u1 = unpk_h(w1_[j]); acc[mt][2 * j] = u0.x; acc[mt][2 * j + 1] = u0.y; acc[mt][8 + 2 * j] = u1.x; acc[mt][8 + 2 * j + 1] = u1.y; } }
        bf16x8 pf[8];
#pragma unroll
        for (int i = 0; i < 8; ++i) pf[i] = *(const LAS bf16x8*)(sl + i * 1024);
        SBAR0();
#pragma unroll
        for (int mt = 0; mt < 2; ++mt)
#pragma unroll
            for (int kt = 0; kt < 2; ++kt)
#pragma unroll
                for (int s = 0; s < 2; ++s) { const bf16x8 af = pf[4 * mt + 2 * kt + s]; acc[mt] = MFMA32H(af, xb[kt][s], acc[mt]); acc[mt] = MFMA32H(af, xl[kt][s], acc[mt]); }
        X0 = acc[0]; X1 = acc[1];
    }
}

constexpr int FIN_SGS = 272;
__device__ __forceinline__ void rwkv_finalize_mfma(Frame& F, int layer) {
    unsigned char* const ws = kws();
    int lane_ = lane_id(); asm volatile("" : "+v"(lane_)); int wave_o = F.wv; asm volatile("" : "+s"(wave_o)); const int wave_ = wave_o, lane = lane_, hi = lane >> 5, l31 = lane & 31, h = wave_, hc = h * HD;
    LAS unsigned char* const sgt = F.lds;
    const bf16* Vr = (const bf16*)(ws + R_VR); const bf16* XL = (const bf16*)(ws + R_XL); bf16* MIX = (bf16*)(ws + R_MIX); const bf16* G2T = (const bf16*)(ws + WS_G2T);
    const float* BN0 = (const float*)(ws + R_BN); const float* BN1 = BN0 + (size_t)M * 8;
    const float* sp = karg(I_TSP) + layer * RPROJ; const float* sn = karg(I_TSN) + layer * RPROJ;
    const float* gnw = karg(I_GNW) + layer * 512 + hc; const float* gnb = karg(I_GNB) + layer * 512 + hc;
    for (int unit = F.vcu; unit < BATCH * (SEQ / 64); unit += F.G) {
        const int cn = unit & 63, b = unit >> 6, t0 = cn * 64;
        { const int tid = wave_ * 64 + lane, tok = tid >> 3, oct = tid & 7, t = t0 + tok, row = b * SEQ + t; float v8[8];
#pragma unroll
          for (int hf = 0; hf < 2; ++hf) { const int k0 = 16 * oct + 8 * hf;
              shift8(XL, 256, 128 + k0, row, t, sp + 1664 + k0, sn + 1664 + k0, v8);
              v4u w; w.x = cvtpk(sigmoidf_(v8[0]), sigmoidf_(v8[1])); w.y = cvtpk(sigmoidf_(v8[2]), sigmoidf_(v8[3])); w.z = cvtpk(sigmoidf_(v8[4]), sigmoidf_(v8[5])); w.w = cvtpk(sigmoidf_(v8[6]), sigmoidf_(v8[7]));
              *(LAS v4u*)(sgt + tok * FIN_SGS + 2 * k0) = w; } }
        WG_BAR();
        f32x16 acc[2][2], gg[2][2];
#pragma unroll
        for (int tt = 0; tt < 2; ++tt)
#pragma unroll
            for (int vt = 0; vt < 2; ++vt)
#pragma unroll
                for (int r = 0; r < 16; ++r) { acc[tt][vt][r] = 0.f; gg[tt][vt][r] = 0.f; }
#pragma unroll
        for (int d = 0; d < 2; ++d) { const size_t item = (size_t)(((b * 8 + h) * 2 + d) * 64 + (d ? 63 - cn : cn));
            const bf16* pre = (const bf16*)(ws + R_PRE) + item * 16384; const bf16* sd = (const bf16*)(ws + R_SD) + item * 4096;
#pragma unroll
            for (int tt = 0; tt < 2; ++tt)
#pragma unroll
                for (int vt = 0; vt < 2; ++vt) { const bf16* src = pre + 12288 + ((vt * 64 + 32 * tt + l31) * 2 + hi) * 16; const v4u w0_ = *(const v4u*)src, w1_ = *(const v4u*)(src + 8);
#pragma unroll
                    for (int j = 0; j < 4; ++j) { const f32x2_t u0 = unpk_h(w0_[j]), u1 = unpk_h(w1_[j]); acc[tt][vt][2 * j] += u0.x; acc[tt][vt][2 * j + 1] += u0.y; acc[tt][vt][8 + 2 * j] += u1.x; acc[tt][vt][8 + 2 * j + 1] += u1.y; } }
            bf16x8 sf[4][2], rf[4][2];
#pragma unroll
            for (int ks = 0; ks < 4; ++ks) { const int kt = ks >> 1, s = ks & 1;
#pragma unroll
                for (int vt = 0; vt < 2; ++vt) sf[ks][vt] = *(const bf16x8*)(sd + ((kt * 64 + 32 * vt + l31) * 2 + hi) * 16 + 8 * s);
#pragma unroll
                for (int tt = 0; tt < 2; ++tt) rf[ks][tt] = *(const bf16x8*)(pre + 4096 + (32 * tt + l31) * 64 + 32 * kt + 16 * s + 8 * hi); }
            SBAR0();
#pragma unroll
            for (int ks = 0; ks < 4; ++ks)
#pragma unroll
                for (int tt = 0; tt < 2; ++tt)
#pragma unroll
                    for (int vt = 0; vt < 2; ++vt) acc[tt][vt] = MFMA32H(sf[ks][vt], rf[ks][tt], acc[tt][vt]); }
#pragma unroll
        for (int kh = 0; kh < 2; ++kh) { bf16x8 gf[4][2], tf[4][2];
#pragma unroll
            for (int k4 = 0; k4 < 4; ++k4) { const int ks = 4 * kh + k4;
#pragma unroll
                for (int vt = 0; vt < 2; ++vt) gf[k4][vt] = *(const bf16x8*)(G2T + (size_t)(hc + 32 * vt + l31) * 128 + 16 * ks + 8 * hi);
#pragma unroll
                for (int tt = 0; tt < 2; ++tt) tf[k4][tt] = *(const LAS bf16x8*)(sgt + (32 * tt + l31) * FIN_SGS + (16 * ks + 8 * hi) * 2); }
            SBAR0();
#pragma unroll
            for (int k4 = 0; k4 < 4; ++k4)
#pragma unroll
                for (int tt = 0; tt < 2; ++tt)
#pragma unroll
                    for (int vt = 0; vt < 2; ++vt) gg[tt][vt] = MFMA32(gf[k4][vt], tf[k4][tt], gg[tt][vt]);
            SBAR0(); }
#pragma unroll
        for (int tt = 0; tt < 2; ++tt) { const int t = t0 + 32 * tt + l31, row = b * SEQ + t;
            float sm = 0.f;
#pragma unroll
            for (int vt = 0; vt < 2; ++vt)
#pragma unroll
                for (int r = 0; r < 16; ++r) sm += acc[tt][vt][r];
            sm += pg8::shx(sm, 32, lane); const float mu = sm * (1.0f / 64.0f); float sq = 0.f;
#pragma unroll
            for (int vt = 0; vt < 2; ++vt)
#pragma unroll
                for (int r = 0; r < 16; ++r) { const float dl = acc[tt][vt][r] - mu; sq += dl * dl; }
            sq += pg8::shx(sq, 32, lane); const float rstd = 1.0f / sqrtf(sq * (1.0f / 64.0f) + GN_EPS);
            const float bon = BN0[(size_t)row * 8 + h] + BN1[(size_t)row * 8 + h];
#pragma unroll
            for (int vt = 0; vt < 2; ++vt)
#pragma unroll
                for (int q = 0; q < 4; ++q) { const int v0 = 32 * vt + 8 * q + 4 * hi;
                    const f32x4 vs = shift4(Vr, 512, hc + v0, row, t, sp + 1024 + hc + v0, sn + 1024 + hc + v0), w4 = *(const f32x4*)(gnw + v0), b4 = *(const f32x4*)(gnb + v0);
                    float o4[4];
#pragma unroll
                    for (int i = 0; i < 4; ++i) o4[i] = ((acc[tt][vt][4 * q + i] - mu) * rstd * w4[i] + b4[i] + bon * vs[i]) * gg[tt][vt][4 * q + i];
                    u32x2_t w; w.x = cvtpk(o4[0], o4[1]); w.y = cvtpk(o4[2], o4[3]); *(u32x2_t*)(MIX + (size_t)row * 1024 + 512 + hc + v0) = w; } }
        WG_BAR();
    }
}

constexpr int ATT_O = 0, ATT_L = 65536, ATT_V = 67584, ATT_VT = 32 * TSB;
static_assert(ATT_V + NWAVES * ATT_VT <= LDSCTL_OFF, "attention LDS map");
__device__ __forceinline__ bf16x8 frag_tr_pv(const LAS unsigned char* tile, int d0, int s, int lane) {
    const int hi = lane >> 5, g1 = (lane >> 4) & 1, i = lane & 15;
    const LAS unsigned char* p = tile + (16 * s + 4 * hi + (i >> 2)) * TSB + (d0 + 16 * g1 + 4 * (i & 3)) * 2;
    const s16x4 lo = tr4(p), h4 = tr4(p + 8 * TSB);
    return (bf16x8){lo[0], lo[1], lo[2], lo[3], h4[0], h4[1], h4[2], h4[3]};
}
template <int NQH>
__device__ __forceinline__ void attn_block(const bf16* MIX, const bf16* V, LAS unsigned char* lds, LAS unsigned char* vt, int b, int h, int T0, int tq0, int d, float slope_d, float bound, bool first, int lane) {
    const int hi = lane >> 5, l31 = lane & 31;
    const int jlo = -(tq0 / d), jhi = (SEQ - 1 - tq0) / d;
    bf16x8 qf[NQH][4];
#pragma unroll
    for (int qh = 0; qh < NQH; ++qh) { const bf16* qp = MIX + ((size_t)b * SEQ + tq0 + d * (32 * qh + l31)) * 1024 + h * HD + 8 * hi;
#pragma unroll
        for (int ks = 0; ks < 4; ++ks) qf[qh][ks] = *(const bf16x8*)(qp + 16 * ks); }
    f32x16 o[NQH][2]; float lsum[NQH];
#pragma unroll
    for (int qh = 0; qh < NQH; ++qh) { lsum[qh] = 0.f;
#pragma unroll
        for (int r = 0; r < 16; ++r) { o[qh][0][r] = 0.f; o[qh][1][r] = 0.f; } }
    constexpr int NT = NQH == 2 ? 6 : 5;
#pragma unroll 1
    for (int jt = 0; jt < NT; ++jt) {
        { const int kr = lane >> 1, hf = lane & 1; int pos = tq0 + d * (32 * jt + kr - 64); pos = pos < 0 ? 0 : (pos > SEQ - 1 ? SEQ - 1 : pos);
          const v4u* src = (const v4u*)(V + ((size_t)b * SEQ + pos) * 512 + h * HD + 32 * hf); LAS v4u* dst = (LAS v4u*)(vt + kr * TSB + 64 * hf);
          const v4u a0 = src[0], a1 = src[1], a2 = src[2], a3 = src[3]; dst[0] = a0; dst[1] = a1; dst[2] = a2; dst[3] = a3; }
        bf16x8 kf[4];
        { int pos = tq0 + d * (32 * jt + l31 - 64); pos = pos < 0 ? 0 : (pos > SEQ - 1 ? SEQ - 1 : pos);
          const bf16* kp = MIX + ((size_t)b * SEQ + pos) * 1024 + 512 + h * HD + 8 * hi;
#pragma unroll
          for (int ks = 0; ks < 4; ++ks) kf[ks] = *(const bf16x8*)(kp + 16 * ks); }
        asm volatile("s_waitcnt lgkmcnt(0)" ::: "memory");
#pragma unroll
        for (int qh = 0; qh < NQH; ++qh) {
            if (NQH == 2 && ((qh == 0 && jt == 5) || (qh == 1 && jt == 0))) continue;
            f32x16 s;
#pragma unroll
            for (int r = 0; r < 16; ++r) s[r] = 0.f;
#pragma unroll
            for (int ks = 0; ks < 4; ++ks) s = MFMA32(kf[ks], qf[qh][ks], s);
            const int iq = 32 * qh + l31;
            v4u pk[2];
#pragma unroll
            for (int r = 0; r < 16; r += 2) { float p2[2];
#pragma unroll
                for (int e = 0; e < 2; ++e) { const int rr = r + e, jj = 32 * jt + (rr & 3) + 8 * (rr >> 2) + 4 * hi - 64; const int dl = iq - jj, ad = dl < 0 ? -dl : dl;
                    const bool valid = (ad <= 64) && (jj >= jlo) && (jj <= jhi);
                    p2[e] = valid ? __expf(s[rr] - slope_d * (float)ad - bound) : 0.f; lsum[qh] += p2[e]; }
                pk[r >> 3][(r >> 1) & 3] = cvtpk(p2[0], p2[1]); }
#pragma unroll
            for (int dt = 0; dt < 2; ++dt)
#pragma unroll
                for (int s2 = 0; s2 < 2; ++s2) o[qh][dt] = MFMA32(frag_tr_pv(vt, 32 * dt, s2, lane), __builtin_bit_cast(bf16x8, pk[s2]), o[qh][dt]);
        }
        asm volatile("s_waitcnt lgkmcnt(0)" ::: "memory");
    }
    int lane2 = lane; asm volatile("" : "+v"(lane2));
#pragma unroll
    for (int qh = 0; qh < NQH; ++qh) { const int hi = lane2 >> 5, l31 = lane2 & 31, lane = lane2;
        const int qi = (tq0 - T0) + d * (32 * qh + l31);
        const float lt = lsum[qh] + pg8::shx(lsum[qh], 32, lane);
        if (hi == 0) { LAS float* lp = (LAS float*)(lds + ATT_L) + qi; *lp = first ? lt : (*lp + lt); }
#pragma unroll
        for (int dt = 0; dt < 2; ++dt)
#pragma unroll
            for (int q = 0; q < 4; ++q) { const int d0 = 32 * dt + 8 * q + 4 * hi; LAS u32x2_t* op = (LAS u32x2_t*)(lds + ATT_O + qi * 128 + ((((d0 >> 3) ^ (qi & 7)) << 4) | ((d0 & 4) << 1)));
                float v0 = o[qh][dt][4 * q], v1 = o[qh][dt][4 * q + 1], v2 = o[qh][dt][4 * q + 2], v3 = o[qh][dt][4 * q + 3];
                if (!first) { const u32x2_t w = *op; v0 += __uint_as_float(w.x << 16); v1 += __uint_as_float(w.x & 0xffff0000u); v2 += __uint_as_float(w.y << 16); v3 += __uint_as_float(w.y & 0xffff0000u); }
                u32x2_t w; w.x = cvtpk(v0, v1); w.y = cvtpk(v2, v3); *op = w; }
    }
}
__device__ __forceinline__ void attn_phase_mfma(Frame& F, int layer, int unit0, int nunit, int ustride) {
    unsigned char* const ws = kws();
    int lane_ = lane_id(); asm volatile("" : "+v"(lane_)); int wave_o = F.wv; asm volatile("" : "+s"(wave_o)); const int wave_ = wave_o, lane = lane_;
    bf16* MIX = (bf16*)(ws + R_MIX); const bf16* V = (const bf16*)(ws + R_V);
    LAS unsigned char* const lds = F.lds; LAS unsigned char* const vt = lds + ATT_V + wave_ * ATT_VT;
    float bound;
    { const float* qg = karg(I_QG) + layer * HD; const float* kg = karg(I_KG) + layer * HD; float mq = 0.f, mk = 0.f;
      for (int i = 0; i < HD; ++i) { mq = fmaxf(mq, fabsf(qg[i])); mk = fmaxf(mk, fabsf(kg[i])); }
      bound = 8.0f * mq * mk + 0.25f; }
    for (int unit = unit0; unit < nunit; unit += ustride) {
        const int st = unit & 7, h = (unit >> 3) & 7, b = unit >> 6, T0 = st * 512;
        const float slope = exp2f(-(float)(h + 1));
        attn_block<2>(MIX, V, lds, vt, b, h, T0, T0 + 64 * wave_, 1, slope, bound, true, lane);
        WG_BAR();
        attn_block<2>(MIX, V, lds, vt, b, h, T0, T0 + (wave_ & 3) + 256 * (wave_ >> 2), 4, slope * 4.f, bound, false, lane);
        WG_BAR();
        attn_block<1>(MIX, V, lds, vt, b, h, T0, T0 + 2 * wave_, 16, slope * 16.f, bound, false, lane);
        attn_block<1>(MIX, V, lds, vt, b, h, T0, T0 + 2 * wave_ + 1, 16, slope * 16.f, bound, false, lane);
        WG_BAR();
        { const int tid = wave_ * 64 + lane;
#pragma unroll
          for (int k = 0; k < 8; ++k) { const int item = tid + 512 * k, qi = item >> 3, c16 = item & 7;
              const v4u w = *(const LAS v4u*)(lds + ATT_O + qi * 128 + ((c16 ^ (qi & 7)) << 4)); const float il = 1.0f / ((const LAS float*)(lds + ATT_L))[qi];
              v4u o;
#pragma unroll
              for (int j = 0; j < 4; ++j) o[j] = cvtpk(__uint_as_float(w[j] << 16) * il, __uint_as_float(w[j] & 0xffff0000u) * il);
              *(v4u*)(MIX + ((size_t)b * SEQ + T0 + qi) * 1024 + h * HD + 8 * c16) = o; } }
        WG_BAR();
    }
}

__global__ void __launch_bounds__(NTHR, 2) mk_fwd(Args args) {
    extern __shared__ __attribute__((aligned(16))) unsigned char lds[];
    Frame F;
    F.lds = (LAS unsigned char*)lds;
    F.MISC = (volatile LAS unsigned*)(F.lds + MISC_OFF);
    F.wv = __builtin_amdgcn_readfirstlane((int)threadIdx.x >> 6);
    F.G = gridDim.x; { const int bx = blockIdx.x; F.vcu = (F.G % 8 == 0) ? (bx % 8) * (F.G / 8) + bx / 8 : bx; }
    F.ctl = (gu32*)(kws() + WS_CTL);
    for (int u = F.wv * 64 + lane_id(); u < (LDS_BYTES - LDSCTL_OFF) / 4; u += NTHR) ((LAS unsigned*)(F.lds + LDSCTL_OFF))[u] = 0u;
    __syncthreads();
    XcdBarrier bar = xcd_barrier_post((unsigned*)(F.ctl + CW_BAR), F.MISC + 8, F.wv == 0 && lane_id() == 0);
#define GRID_BAR() xcd_barrier(bar, F.wv == 0 && lane_id() == 0)
#define XB ((bf16*)(ws + R_XB))
#define MIXB ((bf16*)(ws + R_MIX))
#define HID ((bf16*)(ws + R_HID))
#define SS1 ((float*)(ws + WS_SS1))
#define SS2 ((float*)(ws + WS_SS2))

    for (int step = 0; step < 8 * DEPTH; ++step) {
        const int layer = step >> 3, kind = step & 7;
        if (kind == 0) {
            if (layer > 0) continue;
            x_prologue(F);
            { int lane_ = lane_id(); asm volatile("" : "+v"(lane_)); wconv_items(0, -1, F.vcu * NWAVES + F.wv, F.G * NWAVES, (LAS float*)(F.lds + RING_OFF + F.wv * 16384), lane_); }
        } else if (kind == 1) {
            unsigned char* const ws = kws();
            pg8::Gemm g{XB, (const bf16*)(ws + WS_WIN), M, NPROJ, D}; pg8::StaticOrder S; S.init(M, NPROJ, F.G, (int)blockIdx.x);
            pg8::EpiProj E; E.base0 = (bf16*)(ws + WS_R0); E.ss = SS1; E.qg = karg(I_QG) + layer * HD; E.kg = karg(I_KG) + layer * HD;
            pg8::gemm_phase<pg8::EpiProj, pg8::StaticOrder, true, true>(F.lds + RING_OFF, g, S, E, F.wv, lane_id());
        } else if (kind == 2) {
            rwkv_pre_phase(F, layer);
        } else if (kind == 3) {
            const int bx = (int)blockIdx.x;
            if (bx < 128) { if (F.wv == 0) rwkv_scan_chunk(F, bx);
                            else { int lane_ = lane_id(); asm volatile("" : "+v"(lane_)); wconv_items(layer + 1, layer, bx * 7 + F.wv - 1, 128 * 7, (LAS float*)(F.lds + SCAN_NS * SCAN_SLOT + (F.wv - 1) * 9216), lane_); } }
            else attn_phase_mfma(F, layer, bx - 128, BATCH * H * 8, F.G - 128);
        } else if (kind == 4) {
            rwkv_finalize_mfma(F, layer);
        } else if (kind == 5 || kind == 7) {
            unsigned char* const ws = kws(); float* const xo = kout();
            pg8::Gemm g{kind == 5 ? MIXB : HID, (const bf16*)(ws + (kind == 5 ? WS_WOUT : WS_WDN)), M, D, kind == 5 ? D : FF}; pg8::StaticOrder S; S.init(M, D, F.G, (int)blockIdx.x);
            pg8::EpiRes E{xo, XB, kind == 5 ? SS2 : SS1};
            pg8::gemm_phase<pg8::EpiRes, pg8::StaticOrder, false, true>(F.lds + RING_OFF, g, S, E, F.wv, lane_id());
        } else {
            unsigned char* const ws = kws();
            pg8::Gemm g{XB, (const bf16*)(ws + WS_WUP), M, FF, D}; pg8::StaticOrder S; S.init(M, FF, F.G, (int)blockIdx.x);
            pg8::EpiUp E{HID, SS2};
            pg8::gemm_phase<pg8::EpiUp, pg8::StaticOrder, true, true>(F.lds + RING_OFF, g, S, E, F.wv, lane_id());
        }
        if (step + 1 < 8 * DEPTH) GRID_BAR();
    }
}

extern "C" void kernel_launch(void* const* d_in, const int* in_sizes, int n_in, void* d_out, int out_size, void* d_ws, size_t ws_size, hipStream_t stream) {
    static int grid = 0;
    if (grid == 0) {
        if (n_in != N_IN || in_sizes[0] != M * D || out_size != M * D || ws_size < WS_END) { fprintf(stderr, "kernel_launch: unexpected shapes (n_in %d, in0 %d, out %d, ws %zu)\n", n_in, n_in > 0 ? in_sizes[0] : -1, out_size, ws_size); grid = -1; return; }
        int dev = 0, cus = 0;
        if (hipGetDevice(&dev) != hipSuccess || hipDeviceGetAttribute(&cus, hipDeviceAttributeMultiprocessorCount, dev) != hipSuccess) { grid = -1; return; }
        if (hipFuncSetAttribute((const void*)mk_fwd, hipFuncAttributeMaxDynamicSharedMemorySize, LDS_BYTES) != hipSuccess) { fprintf(stderr, "kernel_launch: hipFuncSetAttribute failed\n"); grid = -1; return; }
        int per_cu = 0;
        (void)hipOccupancyMaxActiveBlocksPerMultiprocessor(&per_cu, (const void*)mk_fwd, NTHR, LDS_BYTES);
        (void)hipGetLastError();
        grid = cus;
    }
    if (grid < 0) return;
    (void)hipMemsetAsync((char*)d_ws + WS_CTL, 0, CTL_ZERO_BYTES, stream);
    Args a{};
    for (int i = 0; i < N_IN; ++i) a.in[i] = (const float*)d_in[i];
    a.out = (float*)d_out; a.ws = (unsigned char*)d_ws;
    hipLaunchKernelGGL(mk_fwd, dim3(grid), dim3(NTHR), LDS_BYTES, stream, a);
}
```

```cpp
#include <hip/hip_runtime.h>
#include <cstdio>
#include <cstdint>
namespace pg8 {
#define PG8_LAS __attribute__((address_space(3)))
typedef unsigned short bf16_t;
typedef short bf16x8 __attribute__((ext_vector_type(8)));
typedef float f32x4 __attribute__((ext_vector_type(4)));
typedef unsigned u32x4 __attribute__((ext_vector_type(4)));
constexpr int BM = 256, BK = 64, HALF = 128, HTB = HALF * BK * 2  , STAGE_BYTES = 8 * HTB, NXCD = 8, WGM = 8;

__host__ __device__ __forceinline__ int lds_byte(int r, int c) { const int st = (r >> 4) * 2 + (c >> 5), rr = r & 15, cc = c & 31, ob = rr * 64 + cc * 2; return st * 1024 + (ob ^ (((ob >> 9) & 1) << 5)); }
__host__ __device__ __forceinline__ void stage_rc(int b, int& R, int& C) { const int st = b / 1024, sb = b % 1024, swz = sb ^ (((sb >> 9) & 1) << 5); R = (st >> 1) * 16 + swz / 64; C = (st & 1) * 32 + (swz % 64) / 2; }
__host__ __device__ __forceinline__ int perm32(int rho) { const int n = rho >> 4, i = rho & 15; return 8 * (i >> 2) + 4 * n + (i & 3); }

struct Unit { int pm, pn; };
struct Gemm { const bf16_t* A; const bf16_t* Bt; int M, N, K; };

struct StaticOrder {
    int nM, nN, nwg, G, c;
    __host__ __device__ void init(int M, int N, int G_, int c_) { nM = M / BM; nN = N / BM; nwg = nM * nN; G = G_; c = c_; }
    __host__ __device__ bool next(int i, Unit& u) const {
        const long L = (long)i * G + c; if (L >= nwg) return false;
        int wgid = (int)L; { const int q = nwg / NXCD, r = nwg % NXCD, xcd = wgid % NXCD, off = wgid / NXCD; wgid = (xcd < r ? xcd * (q + 1) : r * (q + 1) + (xcd - r) * q) + off; }
        const int nig = WGM * nN, gid = wgid / nig, fm = gid * WGM, gsz = (nM - fm) < WGM ? (nM - fm) : WGM;
        u.pm = fm + ((wgid % nig) % gsz); u.pn = (wgid % nig) / gsz; return true;
    }
    __device__ __forceinline__ void a_ready(const Unit&) const {}
    __device__ __forceinline__ void done(const Unit&) const {}
};

__device__ __forceinline__ unsigned cvt_pk_bf16(float lo, float hi) { unsigned r; asm volatile("v_cvt_pk_bf16_f32 %0, %1, %2" : "=v"(r) : "v"(lo), "v"(hi)); return r; }
typedef unsigned u32x2 __attribute__((ext_vector_type(2)));

__device__ __forceinline__ float shx(float v, int m, int lane) { return __int_as_float(__builtin_amdgcn_ds_bpermute((lane ^ m) << 2, __float_as_int(v))); }
__device__ __forceinline__ float row_rs(const float* ss, int row, int fq, int lane) {
    const f32x4 p = *(const f32x4*)(ss + (size_t)row * 16 + 4 * fq);
    float s = (p[0] + p[1]) + (p[2] + p[3]);
    s += shx(s, 16, lane); s += shx(s, 32, lane);
    return 1.0f / sqrtf(s * (1.0f / 1024.0f) + 1e-6f);
}

struct EpiProj {
    static constexpr bool PERM = true, AFTER_DRAIN = false;
    bf16_t* base0; const float* ss; const float* qg; const float* kg;
    __device__ __forceinline__ void operator()(const f32x4 (&acc)[2][2][4][2], const Unit& u, int wr, int wc, int fr, int fq) const {
        const int tile = u.pn, di = tile >> 1;
        bf16_t* base = base0 + (di < 2 ? (size_t)di * 512 : (size_t)di * (8u << 20)); const int ldc = (di < 2) ? 1024 : ((di == 6) ? 256 : 512); const int cb = (di == 6) ? 0 : (tile & 1) * 256;
        const bool nrm = tile < 4; const float* gsrc = (tile < 2) ? qg : kg; const float post = (tile < 2) ? 0.125f : 1.0f;
        f32x4 g[2][2];
#pragma unroll
        for (int bj = 0; bj < 2; ++bj)
#pragma unroll
            for (int n = 0; n < 2; ++n) g[bj][n] = nrm ? *(const f32x4*)(gsrc + 32 * bj + 8 * fq + 4 * n) * post : (f32x4){1.f, 1.f, 1.f, 1.f};
#pragma unroll
        for (int ai = 0; ai < 2; ++ai)
#pragma unroll
            for (int m = 0; m < 4; ++m) {
                const int row = u.pm * BM + ai * HALF + wr * 64 + m * 16 + fr;
                const float rs = row_rs(ss, row, fq, 16 * fq + fr);
                f32x4 v[2][2]; float q = 0.f;
#pragma unroll
                for (int bj = 0; bj < 2; ++bj)
#pragma unroll
                    for (int n = 0; n < 2; ++n) { v[bj][n] = acc[ai][bj][m][n] * rs; const f32x4 t = v[bj][n]; q += (t[0] * t[0] + t[1] * t[1]) + (t[2] * t[2] + t[3] * t[3]); }
                q += shx(q, 16, 16 * fq + fr); q += shx(q, 32, 16 * fq + fr);
                const float inv = nrm ? 1.0f / sqrtf(q * (1.0f / 64.0f) + 1e-6f) : 1.0f;
                bf16_t* rowp = base + (size_t)row * ldc + cb + 64 * wc + 8 * fq;
#pragma unroll
                for (int bj = 0; bj < 2; ++bj) { const f32x4 v0 = v[bj][0] * inv * g[bj][0], v1 = v[bj][1] * inv * g[bj][1];
                    u32x4 w; w.x = cvt_pk_bf16(v0[0], v0[1]); w.y = cvt_pk_bf16(v0[2], v0[3]); w.z = cvt_pk_bf16(v1[0], v1[1]); w.w = cvt_pk_bf16(v1[2], v1[3]);
                    *(u32x4*)(rowp + 32 * bj) = w; }
                asm volatile("" ::: "memory");
            }
    }
};
struct EpiUp {
    static constexpr bool PERM = true, AFTER_DRAIN = false;
    bf16_t* O; const float* ss;
    __device__ __forceinline__ void operator()(const f32x4 (&acc)[2][2][4][2], const Unit& u, int wr, int wc, int fr, int fq) const {
#pragma unroll
        for (int ai = 0; ai < 2; ++ai)
#pragma unroll
            for (int m = 0; m < 4; ++m) {
                const int row = u.pm * BM + ai * HALF + wr * 64 + m * 16 + fr;
                const float rs = row_rs(ss, row, fq, 16 * fq + fr);
                bf16_t* rowp = O + (size_t)row * 4096 + u.pn * BM + wc * 32 + 8 * fq;
#pragma unroll
                for (int bj = 0; bj < 2; ++bj) { f32x4 v0 = acc[ai][bj][m][0] * rs, v1 = acc[ai][bj][m][1] * rs;
                    v0 = __builtin_elementwise_max(v0, (f32x4){0.f, 0.f, 0.f, 0.f}); v1 = __builtin_elementwise_max(v1, (f32x4){0.f, 0.f, 0.f, 0.f}); v0 = v0 * v0; v1 = v1 * v1;
                    u32x4 w; w.x = cvt_pk_bf16(v0[0], v0[1]); w.y = cvt_pk_bf16(v0[2], v0[3]); w.z = cvt_pk_bf16(v1[0], v1[1]); w.w = cvt_pk_bf16(v1[2], v1[3]);
                    *(u32x4*)(rowp + bj * HALF) = w; }
                asm volatile("" ::: "memory");
            }
    }
};
struct EpiRes {
    static constexpr bool PERM = false, AFTER_DRAIN = false;
    float* x; bf16_t* xb; float* ss;
    __device__ __forceinline__ void operator()(const f32x4 (&acc)[2][2][4][2], const Unit& u, int wr, int wc, int fr, int fq) const {
        const int col0 = u.pn * BM + wc * 32 + 4 * fq;
#pragma unroll
        for (int ai = 0; ai < 2; ++ai)
#pragma unroll
            for (int m = 0; m < 4; ++m) {
                const int row = u.pm * BM + ai * HALF + wr * 64 + m * 16 + fr; const size_t off = (size_t)row * 1024 + col0; float q = 0.f;
#pragma unroll
                for (int bj = 0; bj < 2; ++bj)
#pragma unroll
                    for (int n = 0; n < 2; ++n) { const size_t o = off + bj * HALF + n * 16; const f32x4 t = *(const f32x4*)(x + o) + acc[ai][bj][m][n];
                        *(f32x4*)(x + o) = t; u32x2 w; w.x = cvt_pk_bf16(t[0], t[1]); w.y = cvt_pk_bf16(t[2], t[3]); *(u32x2*)(xb + o) = w;
                        q += (t[0] * t[0] + t[1] * t[1]) + (t[2] * t[2] + t[3] * t[3]); }
                q += shx(q, 16, 16 * fq + fr); q += shx(q, 32, 16 * fq + fr);
                if (fq == 0) ss[(size_t)row * 16 + 4 * u.pn + wc] = q;
                asm volatile("" ::: "memory");
            }
    }
};

template <class Epi, class Sched, bool ALIGN_EPI = false, bool SP2 = false>
__device__ __forceinline__ void gemm_phase(PG8_LAS unsigned char* lds, const Gemm g, const Sched& S, const Epi& E, int wave_in, int lane_in) {
    int lane_o = lane_in, wave_o = wave_in; asm volatile("" : "+v"(lane_o)); asm volatile("" : "+s"(wave_o)); const int tid_ = wave_o * 64 + lane_o;
    const int tid = tid_, wid = wave_o, lane = lane_o, wr = wid >> 2, wc = wid & 3, fr = lane & 15, fq = lane >> 4;
    const int K = g.K, nt = K / BK;
    unsigned voffA[2], voffB[2];
#pragma unroll
    for (int i = 0; i < 2; ++i) { int R, C; stage_rc(tid * 16 + i * 8192, R, C); const int Rb = Epi::PERM ? ((R & ~31) + perm32(R & 31)) : R;
        voffA[i] = (unsigned)(R * K + C) * 2u; voffB[i] = (unsigned)(Rb * K + C) * 2u; }
    const size_t kstep = (size_t)(BK * 2);
    const size_t hstep = (size_t)HALF * K * 2;
    const size_t tstep = 2 * hstep;
    const unsigned ldsw = (unsigned)wid * 1024u;
    const int aoff = lds_byte(wr * 64 + fr, fq * 8), boff = lds_byte(wc * 32 + fr, fq * 8);
#define PG8_SA(b, h) (((b) * 2 + (h)) * HTB)
#define PG8_SB(b, h) ((4 + (b) * 2 + (h)) * HTB)
#define PG8_STAGE(bufoff, gbase, voff) do { _Pragma("unroll") for (int _i = 0; _i < 2; ++_i) \
        __builtin_amdgcn_global_load_lds((const unsigned*)((const char*)(gbase) + (voff)[_i]), (PG8_LAS unsigned*)(lds + (bufoff) + ldsw + _i * 8192), 16, 0, 0); } while (0)
#define PG8_LDA(dst, b, h) do { _Pragma("unroll") for (int m = 0; m < 4; ++m) _Pragma("unroll") for (int k = 0; k < 2; ++k) dst[m][k] = *(const PG8_LAS bf16x8*)(lds + PG8_SA(b, h) + aoff + m * 2048 + k * 1024); } while (0)
#define PG8_LDB(dst, b, h) do { _Pragma("unroll") for (int n = 0; n < 2; ++n) _Pragma("unroll") for (int k = 0; k < 2; ++k) dst[n][k] = *(const PG8_LAS bf16x8*)(lds + PG8_SB(b, h) + boff + n * 2048 + k * 1024); } while (0)
#define PG8_MMA(ai, bj, At, Bt) do { __builtin_amdgcn_s_setprio(1); _Pragma("unroll") for (int m = 0; m < 4; ++m) _Pragma("unroll") for (int n = 0; n < 2; ++n) _Pragma("unroll") for (int k = 0; k < 2; ++k) \
        acc[ai][bj][m][n] = __builtin_amdgcn_mfma_f32_16x16x32_bf16(Bt[n][k], At[m][k], acc[ai][bj][m][n], 0, 0, 0); __builtin_amdgcn_s_setprio(0); } while (0)
#define PG8_WAIT_V(n) asm volatile("s_waitcnt vmcnt(" #n ")" ::: "memory")
#define PG8_WAIT_L(n) asm volatile("s_waitcnt lgkmcnt(" #n ")" ::: "memory")
#define PG8_BAR __builtin_amdgcn_s_barrier()
#define PG8_SCHED __builtin_amdgcn_sched_barrier(0)
    Unit cur, nxt; int ui = 0;
    if (!S.next(0, cur)) return;
    f32x4 acc[2][2][4][2];
#pragma unroll
    for (int a = 0; a < 2; ++a)
#pragma unroll
        for (int b = 0; b < 2; ++b)
#pragma unroll
            for (int m = 0; m < 4; ++m)
#pragma unroll
                for (int n = 0; n < 2; ++n) acc[a][b][m][n] = (f32x4){0.f, 0.f, 0.f, 0.f};
    bf16x8 At[4][2], B0[2][2], B1[2][2];
    const char* cA = (const char*)g.A + (size_t)cur.pm * tstep; const char* cB = (const char*)g.Bt + (size_t)cur.pn * tstep;
    S.a_ready(cur);
    if constexpr (SP2) {
        PG8_STAGE(PG8_SB(0, 0), cB, voffB); PG8_STAGE(PG8_SB(0, 1), cB + hstep, voffB); PG8_STAGE(PG8_SA(0, 0), cA, voffA); PG8_STAGE(PG8_SA(0, 1), cA + hstep, voffA);
        if (wr == 1) PG8_BAR;
        PG8_WAIT_V(2); PG8_BAR;
        PG8_STAGE(PG8_SB(1, 0), cB + kstep, voffB); PG8_STAGE(PG8_SA(1, 0), cA + kstep, voffA); PG8_STAGE(PG8_SB(1, 1), cB + hstep + kstep, voffB);
        PG8_WAIT_V(6); PG8_BAR;
    } else {
        PG8_STAGE(PG8_SB(0, 0), cB, voffB); PG8_STAGE(PG8_SA(0, 0), cA, voffA); PG8_STAGE(PG8_SB(0, 1), cB + hstep, voffB); PG8_STAGE(PG8_SA(0, 1), cA + hstep, voffA);
        if (wr == 1) PG8_BAR;
        PG8_WAIT_V(4); PG8_BAR;
        PG8_STAGE(PG8_SB(1, 0), cB + kstep, voffB); PG8_STAGE(PG8_SA(1, 0), cA + kstep, voffA); PG8_STAGE(PG8_SB(1, 1), cB + hstep + kstep, voffB);
        PG8_WAIT_V(6); PG8_BAR;
    }
    for (;;) {
        const bool has_next = S.next(ui + 1, nxt);
        const char* nA = has_next ? (const char*)g.A + (size_t)nxt.pm * tstep : cA; const char* nB = has_next ? (const char*)g.Bt + (size_t)nxt.pn * tstep : cB;
        for (int t = 0; t < nt; t += 2) {
            const bool last = (t == nt - 2);
            const char* a1 = cA + (size_t)(t + 1) * kstep;
            const char* a2 = last ? nA : cA + (size_t)(t + 2) * kstep; const char* b2 = last ? nB : cB + (size_t)(t + 2) * kstep;
            const char* a3 = a2 + kstep; const char* b3 = b2 + kstep;
            if (last && has_next) S.a_ready(nxt);
            if constexpr (SP2) {
            PG8_LDB(B0, 0, 0); PG8_LDB(B1, 0, 1); PG8_SCHED; PG8_LDA(At, 0, 0); PG8_STAGE(PG8_SA(1, 1), a1 + hstep, voffA);
            PG8_WAIT_V(8); PG8_WAIT_L(0); PG8_BAR; PG8_MMA(0, 0, At, B0); PG8_MMA(0, 1, At, B1); PG8_BAR; PG8_SCHED;
            PG8_LDA(At, 0, 1); PG8_STAGE(PG8_SB(0, 0), b2, voffB); PG8_STAGE(PG8_SB(0, 1), b2 + hstep, voffB); PG8_STAGE(PG8_SA(0, 0), a2, voffA);
            PG8_WAIT_V(8); PG8_WAIT_L(0); PG8_BAR; PG8_MMA(1, 0, At, B0); PG8_MMA(1, 1, At, B1); PG8_BAR; PG8_SCHED;
            PG8_LDB(B0, 1, 0); PG8_LDB(B1, 1, 1); PG8_SCHED; PG8_LDA(At, 1, 0); PG8_STAGE(PG8_SA(0, 1), a2 + hstep, voffA);
            PG8_WAIT_V(8); PG8_WAIT_L(0); PG8_BAR; PG8_MMA(0, 0, At, B0); PG8_MMA(0, 1, At, B1); PG8_BAR; PG8_SCHED;
            PG8_LDA(At, 1, 1); PG8_STAGE(PG8_SB(1, 0), b3, voffB); PG8_STAGE(PG8_SB(1, 1), b3 + hstep, voffB); PG8_STAGE(PG8_SA(1, 0), a3, voffA);
            PG8_WAIT_V(8); PG8_WAIT_L(0); PG8_BAR; PG8_MMA(1, 0, At, B0); PG8_MMA(1, 1, At, B1); PG8_BAR; PG8_SCHED;
            } else {
            PG8_LDB(B0, 0, 0); PG8_SCHED; PG8_LDA(At, 0, 0); PG8_STAGE(PG8_SA(1, 1), a1 + hstep, voffA);
            PG8_WAIT_L(8); PG8_BAR; PG8_WAIT_L(0); PG8_MMA(0, 0, At, B0); PG8_BAR; PG8_SCHED;
            PG8_LDB(B1, 0, 1); PG8_STAGE(PG8_SB(0, 0), b2, voffB);
            PG8_BAR; PG8_WAIT_L(0); PG8_MMA(0, 1, At, B1); PG8_BAR;
            PG8_LDA(At, 0, 1); PG8_STAGE(PG8_SA(0, 0), a2, voffA);
            PG8_BAR; PG8_WAIT_L(0); PG8_MMA(1, 0, At, B0); PG8_BAR; PG8_SCHED;
            PG8_STAGE(PG8_SB(0, 1), b2 + hstep, voffB);
            PG8_WAIT_V(6); PG8_BAR; PG8_MMA(1, 1, At, B1); PG8_BAR;
            PG8_LDB(B0, 1, 0); PG8_SCHED; PG8_LDA(At, 1, 0); PG8_STAGE(PG8_SA(0, 1), a2 + hstep, voffA);
            PG8_WAIT_L(8); PG8_BAR; PG8_WAIT_L(0); PG8_MMA(0, 0, At, B0); PG8_BAR; PG8_SCHED;
            PG8_LDB(B1, 1, 1); PG8_STAGE(PG8_SB(1, 0), b3, voffB);
            PG8_BAR; PG8_WAIT_L(0); PG8_MMA(0, 1, At, B1); PG8_BAR;
            PG8_LDA(At, 1, 1); PG8_STAGE(PG8_SA(1, 0), a3, voffA);
            PG8_BAR; PG8_WAIT_L(0); PG8_MMA(1, 0, At, B0); PG8_BAR; PG8_SCHED;
            PG8_STAGE(PG8_SB(1, 1), b3 + hstep, voffB);
            PG8_WAIT_V(6); PG8_BAR; PG8_MMA(1, 1, At, B1); PG8_BAR;
            }
        }
        if constexpr (ALIGN_EPI) { if (wr == 0) PG8_BAR; }
        if constexpr (!Epi::AFTER_DRAIN) { E(acc, cur, wr, wc, fr, fq); S.done(cur); }
        if (!has_next) break;
#pragma unroll
        for (int a = 0; a < 2; ++a)
#pragma unroll
            for (int b = 0; b < 2; ++b)
#pragma unroll
                for (int m = 0; m < 4; ++m)
#pragma unroll
                    for (int n = 0; n < 2; ++n) acc[a][b][m][n] = (f32x4){0.f, 0.f, 0.f, 0.f};
        cur = nxt; cA = nA; cB = nB; ++ui;
        if constexpr (ALIGN_EPI) { if (wr == 1) PG8_BAR; }
    }
    PG8_WAIT_V(0);
    if constexpr (!ALIGN_EPI) { if (wr == 0) PG8_BAR; }
    PG8_BAR;
    if constexpr (Epi::AFTER_DRAIN) { E.fused(acc, cur, wr, wc, fr, fq, lds, wid, lane); S.done(cur); }
#undef PG8_SA
#undef PG8_SB
#undef PG8_STAGE
#undef PG8_LDA
#undef PG8_LDB
#undef PG8_MMA
#undef PG8_WAIT_V
#undef PG8_WAIT_L
#undef PG8_BAR
#undef PG8_SCHED
}
}
constexpr int NWAVES = 8, NTHR = 512;
constexpr int BATCH = 4, SEQ = 4096, D = 1024, DEPTH = 4, H = 8, HD = 64, FF = 4096, NPROJ = 3328, RPROJ = 1792;
constexpr int M = BATCH * SEQ;
constexpr float GN_EPS = 64e-5f;
enum { I_X = 0, I_LN1, I_WIN, I_QG, I_KG, I_TSP, I_TSN, I_W0, I_W2, I_A0, I_A2, I_G2, I_KK, I_KA, I_RK, I_GNW, I_GNB, I_WOUT, I_LN2, I_WUP, I_WDN, N_IN };
constexpr size_t MiB = 1u << 20;
constexpr size_t WS_CTL = 0, CTL_ZERO_BYTES = 64 * 1024;
constexpr size_t WS_SS1 = 1 * MiB, WS_SS2 = 2 * MiB;
constexpr size_t WS_WIN = 3 * MiB, WS_WOUT = WS_WIN + (size_t)NPROJ * D * 2, WS_WUP = WS_WOUT + (size_t)D * D * 2, WS_WDN = WS_WUP + (size_t)FF * D * 2;
constexpr size_t WS_R0 = 28 * MiB;
constexpr size_t R_MIX = WS_R0 + 0 * MiB;
constexpr size_t R_V = WS_R0 + 32 * MiB;
constexpr size_t R_RR = WS_R0 + 48 * MiB, R_KR = WS_R0 + 64 * MiB, R_VR = WS_R0 + 80 * MiB, R_XL = WS_R0 + 96 * MiB;
constexpr size_t R_SD = R_RR;
constexpr size_t R_PRE = WS_R0 + 104 * MiB;
constexpr size_t R_HID = WS_R0;
constexpr size_t R_XB = WS_R0 + 128 * MiB;
constexpr size_t R_BN = WS_R0 + 232 * MiB;
constexpr size_t WS_END = WS_R0 + 233 * MiB;
constexpr size_t WS_LORA = WS_WDN + (size_t)D * FF * 2;
constexpr size_t WS_G2T = WS_LORA + 4 * 512 * 64 * 2;
static_assert(WS_G2T + 512 * 128 * 2 <= WS_R0, "lora");
constexpr int CW_BAR = 1024;
constexpr int RING_OFF = 0, RING_BYTES = 131072;
constexpr int LDSCTL_OFF = 155648, MISC_OFF = LDSCTL_OFF + 320;
constexpr int LDS_BYTES = 163840;
#define GAS __attribute__((address_space(1)))
#define LAS __attribute__((address_space(3)))
typedef unsigned short bf16;
typedef unsigned v4u __attribute__((ext_vector_type(4)));
typedef float f32x4 __attribute__((ext_vector_type(4)));
typedef short bf16x8 __attribute__((ext_vector_type(8)));
typedef GAS unsigned gu32;
typedef GAS unsigned long long gu64;
#define RLX_AGENT __ATOMIC_RELAXED, __HIP_MEMORY_SCOPE_AGENT
#define LDS_WAIT() asm volatile("s_waitcnt lgkmcnt(0)" ::: "memory")
#define VM_WAIT() asm volatile("s_waitcnt vmcnt(0)" ::: "memory")
__device__ __forceinline__ unsigned long long rt() { return __builtin_amdgcn_s_memrealtime(); }
__device__ __forceinline__ unsigned f2bf(float f) { unsigned u = __builtin_bit_cast(unsigned, f); return (u + 0x7fffu + ((u >> 16) & 1u)) >> 16; }
__device__ __forceinline__ unsigned pk2(float lo, float hi) { return f2bf(lo) | (f2bf(hi) << 16); }

#define XB_TMO      128
#define XB_XCNT(j)  (256  + 64 * (j))
#define XB_XSUB(j)  (1280 + 64 * (j))
#define XB_XGEN(j)  (2304 + 64 * (j))
#define XB_TOP      3328
#define XB_TOPGEN   3392
#define XCD_BAR_WORDS 3456
#define XB_SPIN_CAP (1u << 18)

__device__ __forceinline__ unsigned xb_ld(unsigned* p)              { return __hip_atomic_load(p, __ATOMIC_RELAXED, __HIP_MEMORY_SCOPE_AGENT); }
__device__ __forceinline__ unsigned xb_add(unsigned* p, unsigned v) { return __hip_atomic_fetch_add(p, v, __ATOMIC_RELAXED, __HIP_MEMORY_SCOPE_AGENT); }
__device__ __forceinline__ unsigned xb_xcc_id() { return (unsigned)__builtin_amdgcn_s_getreg((3 << 11) | 20) & 0xFu; }
#define XB_SPIN(cond, bar) do { unsigned _sp = 0; while (cond) { __builtin_amdgcn_s_sleep(1); \
    if ((++_sp & 255u) == 0u) { if (xb_ld(&(bar)[XB_TMO])) break; if (_sp > XB_SPIN_CAP) { atomicAdd(&(bar)[XB_TMO], 1u); break; } } } } while (0)

struct XcdBarrier {
    unsigned* bar; unsigned x;
    volatile LAS unsigned* st;
};

__device__ __forceinline__ XcdBarrier xcd_barrier_post(unsigned* bar, volatile LAS unsigned* st, bool tid0) {
    XcdBarrier b; b.bar = bar; b.x = xb_xcc_id(); b.st = st;
    if (tid0) (void)xb_add(&bar[XB_XCNT(b.x)], 1u);
    return b;
}
__device__ __forceinline__ void xcd_barrier_complete(unsigned* bar, unsigned x, unsigned& nloc, unsigned& nx) {
    const unsigned G = gridDim.x * gridDim.y * gridDim.z;
    unsigned sum, cnt, mine, sp = 0u;
    for (;;) {
        sum = 0u; cnt = 0u; mine = 0u;
#pragma unroll
        for (unsigned j = 0; j < 16; ++j) { const unsigned c = xb_ld(&bar[XB_XCNT(j)]); sum += c; cnt += (c > 0u) ? 1u : 0u; mine = (j == x) ? c : mine; }
        if (sum == G) break;
        __builtin_amdgcn_s_sleep(1);
        if ((++sp & 255u) == 0u) { if (xb_ld(&bar[XB_TMO])) break; if (sp > XB_SPIN_CAP) { atomicAdd(&bar[XB_TMO], 1u); break; } }
    }
    nloc = mine > 0u ? mine : 1u; nx = cnt > 0u ? cnt : 1u;
}

__device__ __forceinline__ void xcd_barrier(const XcdBarrier& b, bool tid0) {
    asm volatile("s_waitcnt vmcnt(0)" ::: "memory");
    __syncthreads();
    if (tid0) {
        unsigned* bar = b.bar; asm volatile("" : "+v"(bar));
        __builtin_amdgcn_s_waitcnt(0);
        unsigned nloc = b.st[0], nx = b.st[1];
        if (nloc == 0u) { xcd_barrier_complete(bar, b.x, nloc, nx); b.st[0] = nloc; b.st[1] = nx; }
        const unsigned old = xb_add(&bar[XB_XSUB(b.x)], 1u);
        const unsigned gen = old / nloc;
        if (old + 1u == (gen + 1u) * nloc) {
            __builtin_amdgcn_fence(__ATOMIC_RELEASE, "agent");
            asm volatile("s_waitcnt vmcnt(0)" ::: "memory");
            const unsigned og = xb_add(&bar[XB_TOP], 1u);
            const unsigned tg = og / nx;
            if (og + 1u == (tg + 1u) * nx) xb_add(&bar[XB_TOPGEN], 1u);
            else XB_SPIN(xb_ld(&bar[XB_TOPGEN]) == tg, bar);
            __builtin_amdgcn_fence(__ATOMIC_ACQUIRE, "agent");
            xb_add(&bar[XB_XGEN(b.x)], 1u);
            asm volatile("s_waitcnt vmcnt(0)" ::: "memory");
        } else {
            XB_SPIN(xb_ld(&bar[XB_XGEN(b.x)]) == gen, bar);
            __builtin_amdgcn_fence(__ATOMIC_ACQUIRE, "agent");
            asm volatile("s_waitcnt vmcnt(0)" ::: "memory");
        }
    }
    __syncthreads();
}
__device__ __forceinline__ float bf2f(bf16 v) { return __uint_as_float(((unsigned)v) << 16); }
__device__ __forceinline__ bf16 f2bf_s(float f) { return (bf16)f2bf(f); }
__device__ __forceinline__ float wave_sum(float v, int lane) {
#pragma unroll
    for (int o = 1; o < 64; o <<= 1) v += pg8::shx(v, o, lane);
    return v;
}
__device__ __forceinline__ float sigmoidf_(float z) { return 1.0f / (1.0f + __expf(-z)); }
__device__ __forceinline__ float tanh_fast(float x) { return 1.0f - 2.0f / (__expf(2.0f * x) + 1.0f); }

struct Args { const float* in[N_IN]; float* out; unsigned char* ws; };
typedef const __attribute__((address_space(4))) Args CArgs;
__device__ __forceinline__ const CArgs* kargs() { const CArgs* p = (const CArgs*)__builtin_amdgcn_kernarg_segment_ptr(); asm volatile("" : "+s"(p)); return p; }
__device__ __forceinline__ unsigned char* kws() { return kargs()->ws; }
__device__ __forceinline__ float* kout() { return kargs()->out; }
__device__ __forceinline__ const float* karg(int i) { return kargs()->in[i]; }
__device__ __forceinline__ int lane_id() { int l; asm volatile("v_mbcnt_lo_u32_b32 %0, -1, 0\n\tv_mbcnt_hi_u32_b32 %0, -1, %0" : "=v"(l)); return l; }
struct Frame {
    LAS unsigned char* lds;
    volatile LAS unsigned* MISC;
    gu32* ctl;
    int vcu, G, wv;
};

__device__ __forceinline__ float ushift(const bf16* buf, int ldc, int col, int row, int t, float sp, float sn) {
    const bf16* p = buf + (size_t)row * ldc + col;
    const float u0 = bf2f(p[0]);
    const float up = (t > 0) ? bf2f(p[-ldc]) : 0.f;
    const float un = (t < SEQ - 1) ? bf2f(p[ldc]) : 0.f;
    return u0 + sp * (up - u0) + sn * (un - u0);
}

__device__ __forceinline__ void transpose_item(const float* W, int K, int N, bf16* WT, const float* gain, bool headperm, LAS float* scr, int item, int lane) {
    const int nblk = N / 32, kb = item / nblk, nb = item % nblk, k0 = 64 * kb, n0 = 32 * nb;
#pragma unroll 8
    for (int i = 0; i < 32; ++i) { const int kk = 2 * i + (lane >> 5); float w = W[(size_t)(k0 + kk) * N + n0 + (lane & 31)]; if (gain) w *= gain[k0 + kk]; scr[kk * 33 + (lane & 31)] = w; }
    LDS_WAIT(); asm volatile("" ::: "memory");
    const int c = lane & 7;
    const int p0 = headperm ? ((n0 & ~255) + 128 * ((n0 >> 5) & 1) + 32 * ((n0 >> 6) & 3)) : n0;
#pragma unroll
    for (int j = 0; j < 4; ++j) { const int n = (lane >> 3) + 8 * j; const LAS float* s = scr + (8 * c) * 33 + n;
        v4u o; o.x = pk2(s[0 * 33], s[1 * 33]); o.y = pk2(s[2 * 33], s[3 * 33]); o.z = pk2(s[4 * 33], s[5 * 33]); o.w = pk2(s[6 * 33], s[7 * 33]);
        *(GAS v4u*)(WT + (size_t)(p0 + n) * K + k0 + 8 * c) = o; }
    LDS_WAIT(); asm volatile("" ::: "memory");
}
__device__ __forceinline__ void wconv_items(int layerA, int layerB, int wi, int nw, LAS float* scr, int lane_) {
    unsigned char* const ws = kws();
    constexpr int I_1 = (D / 64) * (NPROJ / 32), I_2 = (D / 64) * (D / 32), I_3 = (D / 64) * (FF / 32), I_4 = (FF / 64) * (D / 32);
    constexpr int NA = I_1 + 64, NB = I_2 + I_3 + I_4 + 32;
    const int nA = (layerA >= 0 && layerA < DEPTH) ? NA : 0, nB = (layerB >= 0) ? NB : 0;
    for (int it = wi; it < nA + nB; it += nw) {
        int r = it;
        if (r < nA) { const int layer = layerA;
            if (r < I_1) { transpose_item(karg(I_WIN) + (size_t)layer * D * NPROJ, D, NPROJ, (bf16*)(ws + WS_WIN), karg(I_LN1) + layer * D, true, scr, r, lane_); continue; } r -= I_1;
            const int mat = r >> 4, it16 = r & 15;
            const float* src = (mat < 2 ? karg(I_W2) : karg(I_A2)) + (size_t)(layer * 2 + (mat & 1)) * 64 * 512;
            transpose_item(src, 64, 512, (bf16*)(ws + WS_LORA) + (size_t)mat * 512 * 64, nullptr, false, scr, it16, lane_); continue; }
        r -= nA; const int layer = layerB;
        if (r < I_2) { transpose_item(karg(I_WOUT) + (size_t)layer * D * D, D, D, (bf16*)(ws + WS_WOUT), nullptr, false, scr, r, lane_); continue; } r -= I_2;
        if (r < I_3) { transpose_item(karg(I_WUP) + (size_t)layer * D * FF, D, FF, (bf16*)(ws + WS_WUP), karg(I_LN2) + layer * D, false, scr, r, lane_); continue; } r -= I_3;
        if (r < I_4) { transpose_item(karg(I_WDN) + (size_t)layer * FF * D, FF, D, (bf16*)(ws + WS_WDN), nullptr, false, scr, r, lane_); continue; } r -= I_4;
        transpose_item(karg(I_G2) + (size_t)layer * 128 * 512, 128, 512, (bf16*)(ws + WS_G2T), nullptr, false, scr, r, lane_);
    }
}
__device__ __forceinline__ void x_prologue(Frame& F) {
    unsigned char* const ws = kws();
    int lane_ = lane_id(); asm volatile("" : "+v"(lane_)); int wave_o = F.wv; asm volatile("" : "+s"(wave_o)); const int wave_ = wave_o, tid_ = wave_ * 64 + lane_;
    const int gw = F.vcu * NWAVES + wave_, NGW = F.G * NWAVES;
    const float* x = karg(I_X); bf16* xb = (bf16*)(ws + R_XB); float* ss = (float*)(ws + WS_SS1);
    for (int m = gw; m < M; m += NGW) {
        const GAS f32x4* xr = (const GAS f32x4*)(x + (size_t)m * D) + lane_; GAS f32x4* orow = (GAS f32x4*)(kout() + (size_t)m * D) + lane_;
        GAS unsigned long long* o8 = (GAS unsigned long long*)(xb + (size_t)m * D) + lane_;
        float s = 0.f;
#pragma unroll
        for (int j = 0; j < 4; ++j) { const f32x4 v = xr[64 * j]; orow[64 * j] = v; s += (v.x * v.x + v.y * v.y) + (v.z * v.z + v.w * v.w);
            o8[64 * j] = (unsigned long long)pk2(v.x, v.y) | ((unsigned long long)pk2(v.z, v.w) << 32); }
        s = wave_sum(s, lane_);
        if (lane_ < 16) ss[(size_t)m * 16 + lane_] = (lane_ == 0) ? s : 0.f;
    }
}

__device__ __forceinline__ void attn_naive(Frame& F, int layer, int aw, int naw) {
    unsigned char* const ws = kws();
    int lane_ = lane_id(); asm volatile("" : "+v"(lane_)); int wave_o = F.wv; asm volatile("" : "+s"(wave_o)); const int wave_ = wave_o, tid_ = wave_ * 64 + lane_;
    bf16* MIX = (bf16*)(ws + R_MIX); const bf16* Q = MIX; const bf16* K = MIX + 512; const bf16* V = (const bf16*)(ws + R_V);
    LAS float* qs = (LAS float*)(F.lds + RING_OFF + wave_ * 4096); LAS float* pb = qs + 64;
    float bound;
    { const float* qg = karg(I_QG) + layer * HD; const float* kg = karg(I_KG) + layer * HD; float mq = 0.f, mk = 0.f;
      for (int i = 0; i < HD; ++i) { mq = fmaxf(mq, fabsf(qg[i])); mk = fmaxf(mk, fabsf(kg[i])); }
      bound = 8.0f * mq * mk + 0.25f; }
    const int lane = lane_;
    for (int unit = aw; unit < BATCH * H * SEQ; unit += naw) {
        const int t = unit % SEQ, bh = unit / SEQ, h = bh % H, b = bh / H; const size_t row = (size_t)b * SEQ + t;
        qs[lane] = bf2f(Q[row * 1024 + h * HD + lane]);
        LDS_WAIT(); asm volatile("" ::: "memory");
        float qv[HD];
#pragma unroll
        for (int i = 0; i < HD; ++i) qv[i] = qs[i];
        const float slope = exp2f(-(float)(h + 1));
        float lsum = 0.f;
        for (int bi = 0; bi < 3; ++bi) { const int d = 1 << (2 * bi);
            for (int pass = 0; pass < 3; ++pass) { const int jj = pass * 64 + lane; const bool act = jj <= 128; const int j = jj - 64; const int pos = t + j * d; const bool valid = act && pos >= 0 && pos < SEQ;
                float p = 0.f;
                if (valid) { const v4u* kr = (const v4u*)(K + ((size_t)b * SEQ + pos) * 1024 + h * HD); float dot = 0.f;
#pragma unroll
                    for (int c = 0; c < 8; ++c) { const v4u w = kr[c];
                        dot += qv[8 * c + 0] * __uint_as_float(w.x << 16) + qv[8 * c + 1] * __uint_as_float(w.x & 0xffff0000u) + qv[8 * c + 2] * __uint_as_float(w.y << 16) + qv[8 * c + 3] * __uint_as_float(w.y & 0xffff0000u)
                             + qv[8 * c + 4] * __uint_as_float(w.z << 16) + qv[8 * c + 5] * __uint_as_float(w.z & 0xffff0000u) + qv[8 * c + 6] * __uint_as_float(w.w << 16) + qv[8 * c + 7] * __uint_as_float(w.w & 0xffff0000u); }
                    const float s = dot - slope * fabsf((float)(j * d)); p = __expf(s - bound); }
                if (act) pb[bi * 129 + jj] = p;
                lsum += p; } }
        lsum = wave_sum(lsum, lane_);
        LDS_WAIT(); asm volatile("" ::: "memory");
        float o = 0.f;
        for (int bi = 0; bi < 3; ++bi) { const int d = 1 << (2 * bi);
            for (int jj = 0; jj < 129; ++jj) { const float p = pb[bi * 129 + jj];
                if (p != 0.f) { const int pos = t + (jj - 64) * d; o += p * bf2f(V[((size_t)b * SEQ + pos) * 512 + h * HD + lane]); } } }
        MIX[row * 1024 + h * HD + lane] = f2bf_s(o / lsum);
        LDS_WAIT(); asm volatile("" ::: "memory");
    }
}

typedef float f32x16 __attribute__((ext_vector_type(16)));
typedef short s16x4 __attribute__((ext_vector_type(4)));
typedef short v4i16_t __attribute__((ext_vector_type(4)));
typedef unsigned u32x2_t __attribute__((ext_vector_type(2)));
typedef float f32x2_t __attribute__((ext_vector_type(2))); typedef __bf16 bf16x2_t __attribute__((ext_vector_type(2)));
__device__ __forceinline__ unsigned cvtpk(float lo, float hi) { f32x2_t v = {lo, hi}; bf16x2_t b = __builtin_convertvector(v, bf16x2_t); return __builtin_bit_cast(unsigned, b); }
typedef _Float16 h16x2_t __attribute__((ext_vector_type(2))); typedef _Float16 h16x8 __attribute__((ext_vector_type(8)));
__device__ __forceinline__ unsigned cvtpk_h(float lo, float hi) { f32x2_t v = {lo, hi}; h16x2_t b = __builtin_convertvector(v, h16x2_t); return __builtin_bit_cast(unsigned, b); }
__device__ __forceinline__ f32x2_t unpk_h(unsigned w) { return __builtin_convertvector(__builtin_bit_cast(h16x2_t, w), f32x2_t); }
#define MFMA32H(nf, mf, acc) __builtin_amdgcn_mfma_f32_32x32x16_f16(__builtin_bit_cast(h16x8, (nf)), __builtin_bit_cast(h16x8, (mf)), (acc), 0, 0, 0)
constexpr int TSB = 144, TILE_B = 64 * TSB;
constexpr int PRE_TW = 14 * TILE_B, PRE_XA = 15 * TILE_B, PRE_INVN = 16 * TILE_B, PRE_GC = PRE_INVN + 256, PRE_BON = PRE_GC + 512, PRE_LDS_END = PRE_BON + 1024;
static_assert(PRE_LDS_END <= LDSCTL_OFF, "PRE LDS map");
__device__ __forceinline__ bf16x8 frag_row(const LAS unsigned char* tile, int row, int ks, int hi) {
    return *(const LAS bf16x8*)(tile + row * TSB + (16 * ks + 8 * hi) * 2);
}
__device__ __forceinline__ s16x4 tr4(const LAS unsigned char* p) { return __builtin_bit_cast(s16x4, __builtin_amdgcn_ds_read_tr16_b64_v4i16((LAS v4i16_t*)p)); }
__device__ __forceinline__ bf16x8 frag_tr(const LAS unsigned char* tile, int idx0, int ks, int lane) {
    const int hi = lane >> 5, g1 = (lane >> 4) & 1, i = lane & 15;
    const LAS unsigned char* p = tile + (16 * ks + 8 * hi + (i >> 2)) * TSB + (idx0 + 16 * g1 + 4 * (i & 3)) * 2;
    const s16x4 lo = tr4(p), h4 = tr4(p + 4 * TSB);
    return (bf16x8){lo[0], lo[1], lo[2], lo[3], h4[0], h4[1], h4[2], h4[3]};
}
__device__ __forceinline__ void store_quad(LAS unsigned char* tile, int row, int n0, int hi, const f32x16& a) {
#pragma unroll
    for (int q = 0; q < 4; ++q) { u32x2_t w; w.x = cvtpk(a[4 * q], a[4 * q + 1]); w.y = cvtpk(a[4 * q + 2], a[4 * q + 3]); *(LAS u32x2_t*)(tile + row * TSB + (n0 + 8 * q + 4 * hi) * 2) = w; }
}
__device__ __forceinline__ void store_quad_h(LAS unsigned char* tile, int row, int n0, int hi, const f32x16& a) {
#pragma unroll
    for (int q = 0; q < 4; ++q) { u32x2_t w; w.x = cvtpk_h(a[4 * q], a[4 * q + 1]); w.y = cvtpk_h(a[4 * q + 2], a[4 * q + 3]); *(LAS u32x2_t*)(tile + row * TSB + (n0 + 8 * q + 4 * hi) * 2) = w; }
}
__device__ __forceinline__ f32x16 load_quad(const LAS unsigned char* tile, int row, int n0, int hi) {
    f32x16 a;
#pragma unroll
    for (int q = 0; q < 4; ++q) { const u32x2_t w = *(const LAS u32x2_t*)(tile + row * TSB + (n0 + 8 * q + 4 * hi) * 2);
        a[4 * q] = __uint_as_float(w.x << 16); a[4 * q + 1] = __uint_as_float(w.x & 0xffff0000u); a[4 * q + 2] = __uint_as_float(w.y << 16); a[4 * q + 3] = __uint_as_float(w.y & 0xffff0000u); }
    return a;
}
#define MFMA32(nf, mf, acc) __builtin_amdgcn_mfma_f32_32x32x16_bf16((nf), (mf), (acc), 0, 0, 0)
#define LD4_ROW(dst, tile, row) _Pragma("unroll") for (int ks_ = 0; ks_ < 4; ++ks_) dst[ks_] = frag_row(tile, row, ks_, hi)
#define LD4_TR(dst, tile, idx0) _Pragma("unroll") for (int ks_ = 0; ks_ < 4; ++ks_) dst[ks_] = frag_tr(tile, idx0, ks_, lane)
#define SBAR0() __builtin_amdgcn_sched_barrier(0)
#define WG_BARL() do { asm volatile("s_waitcnt lgkmcnt(0)" ::: "memory"); __builtin_amdgcn_s_barrier(); asm volatile("" ::: "memory"); } while (0)
#define WG_BAR() do { asm volatile("s_waitcnt vmcnt(0) lgkmcnt(0)" ::: "memory"); __builtin_amdgcn_s_barrier(); asm volatile("" ::: "memory"); } while (0)
__device__ __forceinline__ void shift8(const bf16* buf, int ldc, int col, int row, int t, const float* sp, const float* sn, float (&out)[8]) {
    const bf16* p = buf + (size_t)row * ldc + col;
    const v4u c = *(const v4u*)p; v4u pv = (v4u){0u, 0u, 0u, 0u}, nv = (v4u){0u, 0u, 0u, 0u};
    if (t > 0) pv = *(const v4u*)(p - ldc);
    if (t < SEQ - 1) nv = *(const v4u*)(p + ldc);
    const f32x4 sp0 = *(const f32x4*)sp, sp1 = *(const f32x4*)(sp + 4), sn0 = *(const f32x4*)sn, sn1 = *(const f32x4*)(sn + 4);
#pragma unroll
    for (int j = 0; j < 8; ++j) { const unsigned cw = c[j >> 1], pw = pv[j >> 1], nw = nv[j >> 1];
        const float u0 = (j & 1) ? __uint_as_float(cw & 0xffff0000u) : __uint_as_float(cw << 16), up = (j & 1) ? __uint_as_float(pw & 0xffff0000u) : __uint_as_float(pw << 16), un = (j & 1) ? __uint_as_float(nw & 0xffff0000u) : __uint_as_float(nw << 16);
        const float a = (j < 4) ? sp0[j & 3] : sp1[j & 3], bq = (j < 4) ? sn0[j & 3] : sn1[j & 3];
        out[j] = u0 + a * (up - u0) + bq * (un - u0); }
}
__device__ __forceinline__ f32x4 shift4(const bf16* buf, int ldc, int col, int row, int t, const float* sp, const float* sn) {
    const bf16* p = buf + (size_t)row * ldc + col;
    const u32x2_t c = *(const u32x2_t*)p; u32x2_t pv = (u32x2_t){0u, 0u}, nv = (u32x2_t){0u, 0u};
    if (t > 0) pv = *(const u32x2_t*)(p - ldc);
    if (t < SEQ - 1) nv = *(const u32x2_t*)(p + ldc);
    const f32x4 a = *(const f32x4*)sp, bq = *(const f32x4*)sn;
    const f32x4 u0 = (f32x4){__uint_as_float(c.x << 16), __uint_as_float(c.x & 0xffff0000u), __uint_as_float(c.y << 16), __uint_as_float(c.y & 0xffff0000u)};
    const f32x4 up = (f32x4){__uint_as_float(pv.x << 16), __uint_as_float(pv.x & 0xffff0000u), __uint_as_float(pv.y << 16), __uint_as_float(pv.y & 0xffff0000u)};
    const f32x4 un = (f32x4){__uint_as_float(nv.x << 16), __uint_as_float(nv.x & 0xffff0000u), __uint_as_float(nv.y << 16), __uint_as_float(nv.y & 0xffff0000u)};
    return u0 + a * (up - u0) + bq * (un - u0);
}

struct R16 { v4u c, p, n; };
struct R8 { u32x2_t c, p, n; };
__device__ __forceinline__ R16 ld3x16(const bf16* buf, int ldc, int col, int row, int t) {
    const bf16* q = buf + (size_t)row * ldc + col; R16 r; r.c = *(const v4u*)q; r.p = (v4u){0u, 0u, 0u, 0u}; r.n = (v4u){0u, 0u, 0u, 0u};
    if (t > 0) r.p = *(const v4u*)(q - ldc);
    if (t < SEQ - 1) r.n = *(const v4u*)(q + ldc);
    return r;
}
__device__ __forceinline__ R8 ld3x8(const bf16* buf, int ldc, int col, int row, int t) {
    const bf16* q = buf + (size_t)row * ldc + col; R8 r; r.c = *(const u32x2_t*)q; r.p = (u32x2_t){0u, 0u}; r.n = (u32x2_t){0u, 0u};
    if (t > 0) r.p = *(const u32x2_t*)(q - ldc);
    if (t < SEQ - 1) r.n = *(const u32x2_t*)(q + ldc);
    return r;
}
__device__ __forceinline__ void sh8(const R16& r, const LAS float* sp, const LAS float* sn, float (&out)[8]) {
    const f32x4 sp0 = *(const LAS f32x4*)sp, sp1 = *(const LAS f32x4*)(sp + 4), sn0 = *(const LAS f32x4*)sn, sn1 = *(const LAS f32x4*)(sn + 4);
#pragma unroll
    for (int j = 0; j < 8; ++j) { const unsigned cw = r.c[j >> 1], pw = r.p[j >> 1], nw = r.n[j >> 1];
        const float u0 = (j & 1) ? __uint_as_float(cw & 0xffff0000u) : __uint_as_float(cw << 16), up = (j & 1) ? __uint_as_float(pw & 0xffff0000u) : __uint_as_float(pw << 16), un = (j & 1) ? __uint_as_float(nw & 0xffff0000u) : __uint_as_float(nw << 16);
        const float a = (j < 4) ? sp0[j & 3] : sp1[j & 3], bq = (j < 4) ? sn0[j & 3] : sn1[j & 3];
        out[j] = u0 + a * (up - u0) + bq * (un - u0); }
}
__device__ __forceinline__ f32x4 sh4(const R8& r, const f32x4 a, const f32x4 bq) {
    const f32x4 u0 = (f32x4){__uint_as_float(r.c.x << 16), __uint_as_float(r.c.x & 0xffff0000u), __uint_as_float(r.c.y << 16), __uint_as_float(r.c.y & 0xffff0000u)};
    const f32x4 up = (f32x4){__uint_as_float(r.p.x << 16), __uint_as_float(r.p.x & 0xffff0000u), __uint_as_float(r.p.y << 16), __uint_as_float(r.p.y & 0xffff0000u)};
    const f32x4 un = (f32x4){__uint_as_float(r.n.x << 16), __uint_as_float(r.n.x & 0xffff0000u), __uint_as_float(r.n.y << 16), __uint_as_float(r.n.y & 0xffff0000u)};
    return u0 + a * (up - u0) + bq * (un - u0);
}
constexpr int PRE_CT = PRE_LDS_END;
enum { CT_KK = 0, CT_KA = 64, CT_RK = 128, CT_W0 = 192  , CT_A0 = 320  , CT_SPR = 448, CT_SNR = 512, CT_SPK = 576, CT_SNK = 640, CT_SPV = 704, CT_SNV = 768, CT_SPX = 832  , CT_SNX = 960  , CT_N = 1088 };
static_assert(PRE_CT + CT_N * 4 <= LDSCTL_OFF, "PRE constant table");
__device__ __forceinline__ void rwkv_pre_phase(Frame& F, int layer) {
    unsigned char* const ws = kws();
    int lane_ = lane_id(); asm volatile("" : "+v"(lane_)); int wave_o = F.wv; asm volatile("" : "+s"(wave_o)); const int wave_ = wave_o;
    const int d = wave_ >> 2, qm = (wave_ >> 1) & 1, qn = wave_ & 1, m0 = 32 * qm, n0 = 32 * qn;
#define LANE_VARS int lane = lane_; asm volatile("" : "+v"(lane)); const int hi = lane >> 5, l31 = lane & 31, mrow = m0 + l31; (void)hi; (void)l31; (void)mrow;
    LAS unsigned char* const L = F.lds;
    LAS unsigned char* const T0 = L + (d * 7 + 0) * TILE_B; LAS unsigned char* const T1 = L + (d * 7 + 1) * TILE_B; LAS unsigned char* const T2 = L + (d * 7 + 2) * TILE_B; LAS unsigned char* const T3 = L + (d * 7 + 3) * TILE_B;
    LAS unsigned char* const T4 = L + (d * 7 + 4) * TILE_B; LAS unsigned char* const T5 = L + (d * 7 + 5) * TILE_B; LAS unsigned char* const T6 = L + (d * 7 + 6) * TILE_B;
    LAS unsigned char* const TWt = L + PRE_TW; LAS unsigned char* const XAt = L + PRE_XA;
    LAS float* const invn = (LAS float*)(L + PRE_INVN); LAS float* const gcs = (LAS float*)(L + PRE_GC) + d * 64; LAS float* const bon = (LAS float*)(L + PRE_BON); LAS float* const ct = (LAS float*)(L + PRE_CT);
    const bf16* Rr = (const bf16*)(ws + R_RR); const bf16* Kr = (const bf16*)(ws + R_KR); const bf16* Vr = (const bf16*)(ws + R_VR); const bf16* XL = (const bf16*)(ws + R_XL);
    const bf16* W2T = (const bf16*)(ws + WS_LORA) + (size_t)d * 512 * 64; const bf16* A2T = (const bf16*)(ws + WS_LORA) + (size_t)(2 + d) * 512 * 64;
    float* BN = (float*)(ws + R_BN) + (size_t)d * M * 8;
    const int h = F.vcu & 7, hc = h * HD, bc0 = F.vcu >> 3, bcs = F.G >> 3;
    { LANE_VARS; const float* sp = karg(I_TSP) + layer * RPROJ; const float* sn = karg(I_TSN) + layer * RPROJ;
      for (int idx = wave_ * 64 + lane; idx < CT_N; idx += NTHR) { const int seg = idx >> 6, c = idx & 63; float v;
          if (seg == 0) v = karg(I_KK)[layer * 512 + hc + c]; else if (seg == 1) v = karg(I_KA)[layer * 512 + hc + c]; else if (seg == 2) v = karg(I_RK)[layer * 512 + hc + c];
          else if (seg < 5) v = karg(I_W0)[(layer * 2 + seg - 3) * 512 + hc + c]; else if (seg < 7) v = karg(I_A0)[(layer * 2 + seg - 5) * 512 + hc + c];
          else if (seg < 13) { const int j = seg - 7; v = ((j & 1) ? sn : sp)[(j >> 1) * 512 + hc + c]; }
          else if (seg < 15) v = sp[1536 + (idx - CT_SPX)]; else v = sn[1536 + (idx - CT_SNX)];
          ct[idx] = v; } }
    WG_BARL();
    R16 xw3, xa3, kk3, rr3;
    { LANE_VARS; const int tidl = wave_ * 64 + lane, tok = tidl >> 3, oct = tidl & 7; const int b = bc0 >> 6, t = (bc0 & 63) * 64 + tok, row = b * SEQ + t;
      xw3 = ld3x16(XL, 256, 8 * oct, row, t); xa3 = ld3x16(XL, 256, 64 + 8 * oct, row, t); kk3 = ld3x16(Kr, 512, hc + 8 * oct, row, t); rr3 = ld3x16(Rr, 512, hc + 8 * oct, row, t); }
    LAS unsigned char* const RF0 = L + 6 * TILE_B; LAS unsigned char* const RF1 = L + 13 * TILE_B;
    for (int bc = bc0; bc < BATCH * (SEQ / 64); bc += bcs) {
        const int cn = bc & 63, b = bc >> 6, t0 = cn * 64;
#define SNAT (d ? 63 - mrow : mrow)
        bf16x8 wfr[4], afr[4];
        { LANE_VARS;
#pragma unroll
          for (int ks = 0; ks < 4; ++ks) { const size_t wo = (size_t)(hc + n0 + l31) * 64 + 16 * ks + 8 * hi; wfr[ks] = *(const bf16x8*)(W2T + wo); afr[ks] = *(const bf16x8*)(A2T + wo); }
        }
        float ksh[8];
        { LANE_VARS; const int tidl = wave_ * 64 + lane; const int tok = tidl >> 3, oct = tidl & 7; float v8[8];
          sh8(xw3, ct + CT_SPX + 8 * oct, ct + CT_SNX + 8 * oct, v8);
          { v4u w; w.x = cvtpk(tanh_fast(v8[0]), tanh_fast(v8[1])); w.y = cvtpk(tanh_fast(v8[2]), tanh_fast(v8[3])); w.z = cvtpk(tanh_fast(v8[4]), tanh_fast(v8[5])); w.w = cvtpk(tanh_fast(v8[6]), tanh_fast(v8[7])); *(LAS v4u*)(TWt + tok * TSB + 16 * oct) = w; }
          sh8(xa3, ct + CT_SPX + 64 + 8 * oct, ct + CT_SNX + 64 + 8 * oct, v8);
          { v4u w; w.x = cvtpk(v8[0], v8[1]); w.y = cvtpk(v8[2], v8[3]); w.z = cvtpk(v8[4], v8[5]); w.w = cvtpk(v8[6], v8[7]); *(LAS v4u*)(XAt + tok * TSB + 16 * oct) = w; }
          sh8(rr3, ct + CT_SPR + 8 * oct, ct + CT_SNR + 8 * oct, v8);
          { LAS f32x4* rp_ = (LAS f32x4*)((tok < 32 ? RF0 : RF1) + (tok & 31) * 256 + 32 * oct); rp_[0] = (f32x4){v8[0], v8[1], v8[2], v8[3]}; rp_[1] = (f32x4){v8[4], v8[5], v8[6], v8[7]}; }
          sh8(kk3, ct + CT_SPK + 8 * oct, ct + CT_SNK + 8 * oct, ksh);
          const f32x4 k0 = *(const LAS f32x4*)(ct + CT_KK + 8 * oct), k1 = *(const LAS f32x4*)(ct + CT_KK + 8 * oct + 4); float ssq = 0.f;
#pragma unroll
          for (int j = 0; j < 8; ++j) { const float kx = ksh[j] * ((j < 4) ? k0[j & 3] : k1[j & 3]); ssq += kx * kx; }
          ssq += pg8::shx(ssq, 1, lane); ssq += pg8::shx(ssq, 2, lane); ssq += pg8::shx(ssq, 4, lane);
          if (oct == 0) invn[tok] = 1.0f / sqrtf(ssq + 1e-12f); }
        WG_BARL();
        f32x16 zw, za, lw, av, cum;
        { LANE_VARS; const int snat = SNAT;
#pragma unroll
        for (int r = 0; r < 16; ++r) { zw[r] = 0.f; za[r] = 0.f; }
        { bf16x8 f0[4], f1[4]; LD4_ROW(f0, TWt, snat); LD4_ROW(f1, XAt, snat); SBAR0();
#pragma unroll
          for (int ks = 0; ks < 4; ++ks) { zw = MFMA32(wfr[ks], f0[ks], zw); za = MFMA32(afr[ks], f1[ks], za); } }
#pragma unroll
        for (int q = 0; q < 4; ++q) { const f32x4 w0v = *(const LAS f32x4*)(ct + CT_W0 + 64 * d + n0 + 8 * q + 4 * hi), a0v = *(const LAS f32x4*)(ct + CT_A0 + 64 * d + n0 + 8 * q + 4 * hi);
#pragma unroll
            for (int i = 0; i < 4; ++i) { lw[4 * q + i] = -0.6065306597f * sigmoidf_(zw[4 * q + i] + w0v[i]); av[4 * q + i] = sigmoidf_(za[4 * q + i] + a0v[i]); } }
        { f32x16 lh, ll;
#pragma unroll
          for (int r = 0; r < 16; ++r) { lh[r] = __uint_as_float(cvtpk(lw[r], 0.f) << 16); ll[r] = lw[r] - lh[r]; }
          store_quad(T4, mrow, n0, hi, lh); store_quad(T5, mrow, n0, hi, ll); } }
        WG_BARL();
        { LANE_VARS; const int tidl = wave_ * 64 + lane, tok = tidl >> 3, oct = tidl & 7;
          LAS f32x4* kp_ = (LAS f32x4*)((tok < 32 ? TWt : XAt) + (tok & 31) * 256 + 32 * oct); kp_[0] = (f32x4){ksh[0], ksh[1], ksh[2], ksh[3]}; kp_[1] = (f32x4){ksh[4], ksh[5], ksh[6], ksh[7]}; }
        { LANE_VARS;
#pragma unroll
        for (int r = 0; r < 16; ++r) cum[r] = 0.f;
        { bf16x8 f0[4], f1[4]; LD4_TR(f0, T4, n0); LD4_TR(f1, T5, n0); SBAR0();
#pragma unroll
        for (int ks = 0; ks < 4; ++ks) { bf16x8 tf;
#pragma unroll
            for (int j = 0; j < 8; ++j) tf[j] = (16 * ks + 8 * hi + j <= mrow) ? (short)0x3f80 : (short)0;
            cum = MFMA32(f0[ks], tf, cum); cum = MFMA32(f1[ks], tf, cum); } } }
        WG_BARL();
        f32x16 rh, kc, mrk;
        { LANE_VARS; const int snat = SNAT; const float inv = invn[snat];
          float bsum = 0.f;
#pragma unroll
          for (int q = 0; q < 4; ++q) { const int cl = n0 + 8 * q + 4 * hi;
              const f32x4 r4 = *(const LAS f32x4*)((snat < 32 ? RF0 : RF1) + (snat & 31) * 256 + 4 * cl), k4 = *(const LAS f32x4*)((snat < 32 ? TWt : XAt) + (snat & 31) * 256 + 4 * cl);
              const f32x4 kk4 = *(const LAS f32x4*)(ct + CT_KK + cl), ka4 = *(const LAS f32x4*)(ct + CT_KA + cl), rk4 = *(const LAS f32x4*)(ct + CT_RK + cl);
              float kh4[4], bc4[4], rl4[4], kl4[4];
#pragma unroll
              for (int i = 0; i < 4; ++i) { const int e = 4 * q + i; const float a = av[e], cs = cum[e];
                  const float g = __expf(cs), gx = __expf(cs - lw[e]), gi = __expf(-cs);
                  const float kkn = k4[i] * kk4[i] * inv, kt = k4[i] * (1.0f + (a - 1.0f) * ka4[i]);
                  kh4[i] = gx * kkn; rh[e] = g * r4[i]; bc4[i] = a * kkn * gi; kc[e] = kt * gi; bsum += r4[i] * kt * rk4[i];
                  rl4[i] = rh[e] - __uint_as_float(cvtpk(rh[e], 0.f) << 16); kl4[i] = kc[e] - __uint_as_float(cvtpk(kc[e], 0.f) << 16);
                  if (mrow == 63) gcs[n0 + 8 * q + 4 * hi + i] = g; }
              const int off = mrow * TSB + (n0 + 8 * q + 4 * hi) * 2; u32x2_t w;
              w.x = cvtpk(kh4[0], kh4[1]); w.y = cvtpk(kh4[2], kh4[3]); *(LAS u32x2_t*)(T0 + off) = w;
              w.x = cvtpk(rh[4 * q], rh[4 * q + 1]); w.y = cvtpk(rh[4 * q + 2], rh[4 * q + 3]); *(LAS u32x2_t*)(T1 + off) = w;
              w.x = cvtpk(bc4[0], bc4[1]); w.y = cvtpk(bc4[2], bc4[3]); *(LAS u32x2_t*)(T2 + off) = w;
              w.x = cvtpk(kc[4 * q], kc[4 * q + 1]); w.y = cvtpk(kc[4 * q + 2], kc[4 * q + 3]); *(LAS u32x2_t*)(T3 + off) = w;
              w.x = cvtpk(rl4[0], rl4[1]); w.y = cvtpk(rl4[2], rl4[3]); *(LAS u32x2_t*)(T4 + off) = w;
              w.x = cvtpk(kl4[0], kl4[1]); w.y = cvtpk(kl4[2], kl4[3]); *(LAS u32x2_t*)(T5 + off) = w; }
          bsum += pg8::shx(bsum, 32, lane);
          if (hi == 0) bon[(d * 2 + qn) * 64 + snat] = bsum; }
        if (bc + bcs < BATCH * (SEQ / 64)) { LANE_VARS; const int tidl = wave_ * 64 + lane, tok = tidl >> 3, oct = tidl & 7; const int bn = bc + bcs, b2 = bn >> 6, t = (bn & 63) * 64 + tok, row = b2 * SEQ + t;
            xw3 = ld3x16(XL, 256, 8 * oct, row, t); xa3 = ld3x16(XL, 256, 64 + 8 * oct, row, t); kk3 = ld3x16(Kr, 512, hc + 8 * oct, row, t); rr3 = ld3x16(Rr, 512, hc + 8 * oct, row, t); }
        WG_BARL();
        { LANE_VARS; const int snat = SNAT; if (qn == 0 && hi == 0) BN[(size_t)(b * SEQ + t0 + snat) * 8 + h] = bon[(d * 2) * 64 + snat] + bon[(d * 2 + 1) * 64 + snat]; }
        { LANE_VARS;
#pragma unroll
          for (int r = 0; r < 16; ++r) mrk[r] = 0.f;
          bf16x8 f0[4], f1[4], f2[4], f3[4]; LD4_ROW(f0, T1, mrow); LD4_ROW(f1, T3, n0 + l31); LD4_ROW(f2, T5, n0 + l31); LD4_ROW(f3, T4, mrow); SBAR0();
#pragma unroll
          for (int ks = 0; ks < 4; ++ks) { mrk = MFMA32(f1[ks], f0[ks], mrk); mrk = MFMA32(f2[ks], f0[ks], mrk); mrk = MFMA32(f1[ks], f3[ks], mrk); }
#pragma unroll
          for (int q = 0; q < 4; ++q)
#pragma unroll
              for (int i = 0; i < 4; ++i) { const int e = 4 * q + i, n = n0 + 8 * q + 4 * hi + i; mrk[e] = (n <= mrow) ? mrk[e] : 0.f; } }
        WG_BARL();
        { LANE_VARS; f32x16 x, mk, zz;
          float z0 = 0.f; asm volatile("" : "+v"(z0));
#pragma unroll
          for (int r = 0; r < 16; ++r) { x[r] = 0.f; mk[r] = 0.f; zz[r] = z0; }
          { bf16x8 f0[4], f1[4], f2[4]; LD4_ROW(f0, T0, mrow); LD4_ROW(f1, T2, n0 + l31); LD4_ROW(f2, T3, n0 + l31); SBAR0();
#pragma unroll
            for (int ks = 0; ks < 4; ++ks) { x = MFMA32(f1[ks], f0[ks], x); mk = MFMA32(f2[ks], f0[ks], mk); } }
#pragma unroll
          for (int q = 0; q < 4; ++q)
#pragma unroll
              for (int i = 0; i < 4; ++i) { const int e = 4 * q + i, n = n0 + 8 * q + 4 * hi + i; const bool lo = n < mrow; x[e] = lo ? -x[e] : 0.f; mk[e] = lo ? mk[e] : 0.f; }
          store_quad(T4, mrow, n0, hi, x); store_quad(T5, mrow, n0, hi, zz); store_quad(T6, mrow, n0, hi, mk); }
        WG_BARL();
        if ((wave_ & 3) == 0) { LANE_VARS; const int blk = lane >> 4, c = lane & 15; float t[16];
#pragma unroll
            for (int r = 0; r < 16; ++r) { const LAS unsigned char* xr = T4 + (16 * blk + r) * TSB + 32 * blk; const v4u w0_ = *(const LAS v4u*)xr, w1_ = *(const LAS v4u*)(xr + 16);
                float acc0 = (r == c) ? 1.0f : 0.f, acc1 = 0.f;
#pragma unroll
                for (int j = 0; j < r; ++j) { const unsigned w = (j < 8) ? w0_[j >> 1] : w1_[(j - 8) >> 1]; const float xv = (j & 1) ? __uint_as_float(w & 0xffff0000u) : __uint_as_float(w << 16);
                    if (j & 1) acc1 += xv * t[j]; else acc0 += xv * t[j]; }
                t[r] = acc0 + acc1; }
#pragma unroll
            for (int r = 0; r < 16; ++r) *(LAS unsigned short*)(T5 + (16 * blk + r) * TSB + (16 * blk + c) * 2) = (unsigned short)(cvtpk(t[r], 0.f) & 0xffffu); }
        WG_BARL();
        { LANE_VARS; LAS unsigned char* const scr = qm ? T5 : T4;
          if (qm == qn) {
              f32x16 w;
#pragma unroll
              for (int r = 0; r < 16; ++r) w[r] = 0.f;
              bf16x8 mf = frag_row(T4, m0 + l31, 2 * qm, hi);
              if (l31 < 16) mf = (bf16x8){0, 0, 0, 0, 0, 0, 0, 0};
              w = MFMA32(frag_tr(T5, m0, 2 * qm, lane), mf, w);
              store_quad(scr, l31, 32, hi, w); } }
        WG_BARL();
        { LANE_VARS; LAS unsigned char* const scr = qm ? T5 : T4;
          if (qm == qn) {
              f32x16 tq = load_quad(T5, mrow, m0, hi);
#pragma unroll
              for (int ks = 0; ks < 2; ++ks) tq = MFMA32(frag_tr(scr, 32, ks, lane), frag_row(T5, mrow, 2 * qm + ks, hi), tq);
              store_quad(T5, mrow, m0, hi, tq); } }
        WG_BARL();
        { LANE_VARS;
          if (qm == 1 && qn == 0) {
              f32x16 w;
#pragma unroll
              for (int r = 0; r < 16; ++r) w[r] = 0.f;
#pragma unroll
              for (int ks = 0; ks < 2; ++ks) w = MFMA32(frag_tr(T5, 0, ks, lane), frag_row(T4, 32 + l31, ks, hi), w);
              store_quad(T4, l31, 32, hi, w); }
          if (qm == 0 && qn == 1) { f32x16 zz; float z0 = 0.f; asm volatile("" : "+v"(z0));
#pragma unroll
              for (int r = 0; r < 16; ++r) zz[r] = z0;
              store_quad(T5, l31, 32, hi, zz); } }
        WG_BARL();
        { LANE_VARS;
          if (qm == 1 && qn == 0) {
              f32x16 t21;
#pragma unroll
              for (int r = 0; r < 16; ++r) t21[r] = 0.f;
#pragma unroll
              for (int ks = 0; ks < 2; ++ks) t21 = MFMA32(frag_tr(T4, 32, ks, lane), frag_row(T5, 32 + l31, 2 + ks, hi), t21);
              store_quad(T5, 32 + l31, 0, hi, t21); } }
        WG_BARL();
        R16 vr3[2];
        { LANE_VARS; const int tt = (wave_ * 64 + lane) & 255, s = tt >> 2, cg4 = (tt & 3) * 16, sn_ = d ? 63 - s : s, t = t0 + sn_, row = b * SEQ + t;
          vr3[0] = ld3x16(Vr, 512, hc + cg4, row, t); vr3[1] = ld3x16(Vr, 512, hc + cg4 + 8, row, t); }
        { LANE_VARS; f32x16 kp, tk;
#pragma unroll
          for (int r = 0; r < 16; ++r) { kp[r] = 0.f; tk[r] = 0.f; }
          { bf16x8 f0[4], f1[4], f2[4]; LD4_ROW(f0, T5, mrow); LD4_TR(f1, T0, n0); LD4_TR(f2, T6, n0); SBAR0();
#pragma unroll
            for (int ks = 0; ks < 4; ++ks) { kp = MFMA32(f1[ks], f0[ks], kp); tk = MFMA32(f2[ks], f0[ks], tk); } }
          WG_BARL();
          store_quad(T0, mrow, n0, hi, kp); store_quad(T6, mrow, n0, hi, tk); }
        { LANE_VARS; f32x16 rb;
#pragma unroll
          for (int r = 0; r < 16; ++r) rb[r] = 0.f;
          { bf16x8 f0[4], f1[4]; LD4_ROW(f0, T2, n0 + l31); LD4_ROW(f1, T1, mrow); SBAR0();
#pragma unroll
            for (int ks = 0; ks < 4; ++ks) rb = MFMA32(f0[ks], f1[ks], rb); }
#pragma unroll
          for (int q = 0; q < 4; ++q)
#pragma unroll
              for (int i = 0; i < 4; ++i) { const int e = 4 * q + i, n = n0 + 8 * q + 4 * hi + i; rb[e] = (n <= mrow) ? rb[e] : 0.f; }
          store_quad(T4, mrow, n0, hi, rb); }
        WG_BARL();
        const int cd = d ? 63 - cn : cn;
        bf16* const pre = (bf16*)(ws + R_PRE) + ((size_t)(((b * 8 + h) * 2 + d) * 64 + cd)) * 16384;
        { LANE_VARS; f32x16 rp, ml, pm, kq;
#pragma unroll
          for (int r = 0; r < 16; ++r) { rp[r] = 0.f; ml[r] = 0.f; pm[r] = 0.f; kq[r] = 0.f; }
#pragma unroll
          for (int kh = 0; kh < 2; ++kh) { bf16x8 mrbf[2], khn[2], bcn[2], tkn[2], bcm[2], tkm[2];
#pragma unroll
              for (int k2 = 0; k2 < 2; ++k2) { const int ks = 2 * kh + k2; mrbf[k2] = frag_row(T4, mrow, ks, hi); khn[k2] = frag_tr(T0, n0, ks, lane); bcn[k2] = frag_tr(T2, n0, ks, lane); tkn[k2] = frag_tr(T6, n0, ks, lane); bcm[k2] = frag_tr(T2, m0, ks, lane); tkm[k2] = frag_tr(T6, m0, ks, lane); }
              SBAR0();
#pragma unroll
              for (int k2 = 0; k2 < 2; ++k2) { rp = MFMA32(khn[k2], mrbf[k2], rp); ml = MFMA32(tkn[k2], mrbf[k2], ml); pm = MFMA32(khn[k2], bcm[k2], pm); kq = MFMA32(bcn[k2], tkm[k2], kq); }
              SBAR0(); }
          const float gm = gcs[mrow];
#pragma unroll
          for (int q = 0; q < 4; ++q)
#pragma unroll
              for (int i = 0; i < 4; ++i) { const int e = 4 * q + i, n = n0 + 8 * q + 4 * hi + i;
                  rp[e] = rh[e] - rp[e]; ml[e] = mrk[e] - ml[e]; pm[e] = gm * (((n == mrow) ? 1.0f : 0.f) - pm[e]); kq[e] = (kc[e] - kq[e]) * gcs[n]; }
#pragma unroll
          for (int q = 0; q < 4; ++q) { const int pc = n0 + 16 * (q >> 1) + 8 * hi + 4 * (q & 1);
              u32x2_t w; w.x = cvtpk_h(pm[4 * q], pm[4 * q + 1]); w.y = cvtpk_h(pm[4 * q + 2], pm[4 * q + 3]); *(u32x2_t*)(pre + mrow * 64 + pc) = w;
              w.x = cvtpk_h(rp[4 * q], rp[4 * q + 1]); w.y = cvtpk_h(rp[4 * q + 2], rp[4 * q + 3]); *(u32x2_t*)(pre + 4096 + (d ? 63 - mrow : mrow) * 64 + pc) = w; }
          WG_BARL();
          store_quad_h(T4, mrow, n0, hi, ml); store_quad_h(T5, mrow, n0, hi, kq); }
        { LANE_VARS; const int tt = (wave_ * 64 + lane) & 255, s = tt >> 2, cg4 = (tt & 3) * 16; float v8[8];
#pragma unroll
          for (int hlf = 0; hlf < 2; ++hlf) { const int c8 = cg4 + 8 * hlf;
              sh8(vr3[hlf], ct + CT_SPV + c8, ct + CT_SNV + c8, v8);
              v4u w; w.x = cvtpk_h(v8[0], v8[1]); w.y = cvtpk_h(v8[2], v8[3]); w.z = cvtpk_h(v8[4], v8[5]); w.w = cvtpk_h(v8[6], v8[7]); *(LAS v4u*)(T1 + s * TSB + 2 * c8) = w; } }
        WG_BARL();
        { LANE_VARS; f32x16 qt, yt;
#pragma unroll
          for (int r = 0; r < 16; ++r) { qt[r] = 0.f; yt[r] = 0.f; }
          { bf16x8 f0[4], f1[4], f2[4], f3[4]; LD4_TR(f0, T1, m0); LD4_TR(f1, T5, n0); LD4_TR(f2, T1, n0); LD4_ROW(f3, T4, mrow); SBAR0();
#pragma unroll
            for (int ks = 0; ks < 4; ++ks) { qt = MFMA32H(f1[ks], f0[ks], qt); yt = MFMA32H(f2[ks], f3[ks], yt); } }
          v4u w0_, w1_;
          w0_.x = cvtpk_h(qt[0], qt[1]); w0_.y = cvtpk_h(qt[2], qt[3]); w0_.z = cvtpk_h(qt[4], qt[5]); w0_.w = cvtpk_h(qt[6], qt[7]); w1_.x = cvtpk_h(qt[8], qt[9]); w1_.y = cvtpk_h(qt[10], qt[11]); w1_.z = cvtpk_h(qt[12], qt[13]); w1_.w = cvtpk_h(qt[14], qt[15]);
          { bf16* dst = pre + 8192 + ((qn * 64 + mrow) * 2 + hi) * 16; *(v4u*)dst = w0_; *(v4u*)(dst + 8) = w1_; }
          w0_.x = cvtpk_h(yt[0], yt[1]); w0_.y = cvtpk_h(yt[2], yt[3]); w0_.z = cvtpk_h(yt[4], yt[5]); w0_.w = cvtpk_h(yt[6], yt[7]); w1_.x = cvtpk_h(yt[8], yt[9]); w1_.y = cvtpk_h(yt[10], yt[11]); w1_.z = cvtpk_h(yt[12], yt[13]); w1_.w = cvtpk_h(yt[14], yt[15]);
          { bf16* dst = pre + 12288 + ((qn * 64 + (d ? 63 - mrow : mrow)) * 2 + hi) * 16; *(v4u*)dst = w0_; *(v4u*)(dst + 8) = w1_; } }
        WG_BARL();
    }
#undef LANE_VARS
#undef SNAT
}

constexpr int SCAN_SLOT = 12 * 1024, SCAN_NS = 4;
__device__ __forceinline__ void scan_issue(const bf16* pre, LAS unsigned char* slot, int l31, int hi, int v) {
#pragma unroll
    for (int i = 0; i < 8; ++i) { const int mt = i >> 2, kt = (i >> 1) & 1, s = i & 1;
        __builtin_amdgcn_global_load_lds((const unsigned*)(pre + (32 * mt + l31) * 64 + 32 * kt + 16 * s + 8 * hi), (LAS unsigned*)(slot + i * 1024), 16, 0, 0); }
#pragma unroll
    for (int i = 0; i < 4; ++i) { const int mt = i >> 1, hf = i & 1;
        __builtin_amdgcn_global_load_lds((const unsigned*)(pre + 8192 + ((mt * 64 + v) * 2 + hi) * 16 + 8 * hf), (LAS unsigned*)(slot + (8 + i) * 1024), 16, 0, 0); }
}
__device__ __forceinline__ void rwkv_scan_chunk(Frame& F, int unit) {
    unsigned char* const ws = kws();
    int lane_ = lane_id(); asm volatile("" : "+v"(lane_));
    const int lane = lane_, hi = lane >> 5, l31 = lane & 31;
    const int chain = unit >> 1, vh = unit & 1, v = 32 * vh + l31;
    const bf16* pre = (const bf16*)(ws + R_PRE) + (size_t)chain * 64 * 16384;
    bf16* sd = (bf16*)(ws + R_SD) + (size_t)chain * 64 * 4096;
    LAS unsigned char* const ring = F.lds;
    f32x16 X0, X1;
#pragma unroll
    for (int r = 0; r < 16; ++r) { X0[r] = 0.f; X1[r] = 0.f; }
    scan_issue(pre, ring, l31, hi, v); scan_issue(pre + 16384, ring + SCAN_SLOT, l31, hi, v); scan_issue(pre + 2 * 16384, ring + 2 * SCAN_SLOT, l31, hi, v);
#pragma unroll 1
    for (int c = 0; c < 64; ++c) {
        bf16x8 xb[2][2], xl[2][2];
#pragma unroll
        for (int kt = 0; kt < 2; ++kt)
#pragma unroll
            for (int s = 0; s < 2; ++s) { v4u w, wl;
#pragma unroll
                for (int j = 0; j < 4; ++j) { const float a0 = kt ? X1[8 * s + 2 * j] : X0[8 * s + 2 * j], a1 = kt ? X1[8 * s + 2 * j + 1] : X0[8 * s + 2 * j + 1];
                    const unsigned hw = cvtpk_h(a0, a1); const f32x2_t hf = unpk_h(hw); w[j] = hw; wl[j] = cvtpk_h(a0 - hf.x, a1 - hf.y); }
                xb[kt][s] = __builtin_bit_cast(bf16x8, w); xl[kt][s] = __builtin_bit_cast(bf16x8, wl);
                *(v4u*)(sd + (size_t)c * 4096 + ((kt * 64 + v) * 2 + hi) * 16 + 8 * s) = w; }
        asm volatile("s_waitcnt lgkmcnt(0)" ::: "memory");
        if (c + 3 < 64) scan_issue(pre + (size_t)(c + 3) * 16384, ring + ((c + 3) & 3) * SCAN_SLOT, l31, hi, v);
        if (c + 3 < 64) asm volatile("s_waitcnt vmcnt(36)" ::: "memory"); else asm volatile("s_waitcnt vmcnt(0)" ::: "memory");
        const LAS unsigned char* sl = ring + (c & 3) * SCAN_SLOT + lane * 16;
        f32x16 acc[2];
#pragma unroll
        for (int mt = 0; mt < 2; ++mt) { const v4u w0_ = *(const LAS v4u*)(sl + (8 + 2 * mt) * 1024), w1_ = *(const LAS v4u*)(sl + (9 + 2 * mt) * 1024);
#pragma unroll
            for (int j = 0; j < 4; ++j) { const f32x2_t u0 = unpk_h(w0_[j]), u1 = unpk_h(w1_[j]); acc[mt][2 * j] = u0.x; acc[mt][2 * j + 1] = u0.y; acc[mt][8 + 2 * j] = u1.x; acc[mt][8 + 2 * j + 1] = u1.y; } }
        bf16x8 pf[8];
#pragma unroll
        for (int i = 0; i < 8; ++i) pf[i] = *(const LAS bf16x8*)(sl + i * 1024);
        SBAR0();
#pragma unroll
        for (int mt = 0; mt < 2; ++mt)
#pragma unroll
            for (int kt = 0; kt < 2; ++kt)
#pragma unroll
                for (int s = 0; s < 2; ++s) { const bf16x8 af = pf[4 * mt + 2 * kt + s]; acc[mt] = MFMA32H(af, xb[kt][s], acc[mt]); acc[mt] = MFMA32H(af, xl[kt][s], acc[mt]); }
        X0 = acc[0]; X1 = acc[1];
    }
}

constexpr int FIN_SGS = 272;
__device__ __forceinline__ void rwkv_finalize_mfma(Frame& F, int layer) {
    unsigned char* const ws = kws();
    int lane_ = lane_id(); asm volatile("" : "+v"(lane_)); int wave_o = F.wv; asm volatile("" : "+s"(wave_o)); const int wave_ = wave_o, lane = lane_, hi = lane >> 5, l31 = lane & 31, h = wave_, hc = h * HD;
    LAS unsigned char* const sgt = F.lds;
    const bf16* Vr = (const bf16*)(ws + R_VR); const bf16* XL = (const bf16*)(ws + R_XL); bf16* MIX = (bf16*)(ws + R_MIX); const bf16* G2T = (const bf16*)(ws + WS_G2T);
    const float* BN0 = (const float*)(ws + R_BN); const float* BN1 = BN0 + (size_t)M * 8;
    const float* sp = karg(I_TSP) + layer * RPROJ; const float* sn = karg(I_TSN) + layer * RPROJ;
    const float* gnw = karg(I_GNW) + layer * 512 + hc; const float* gnb = karg(I_GNB) + layer * 512 + hc;
    for (int unit = F.vcu; unit < BATCH * (SEQ / 64); unit += F.G) {
        const int cn = unit & 63, b = unit >> 6, t0 = cn * 64;
        { const int tid = wave_ * 64 + lane, tok = tid >> 3, oct = tid & 7, t = t0 + tok, row = b * SEQ + t; float v8[8];
#pragma unroll
          for (int hf = 0; hf < 2; ++hf) { const int k0 = 16 * oct + 8 * hf;
              shift8(XL, 256, 128 + k0, row, t, sp + 1664 + k0, sn + 1664 + k0, v8);
              v4u w; w.x = cvtpk(sigmoidf_(v8[0]), sigmoidf_(v8[1])); w.y = cvtpk(sigmoidf_(v8[2]), sigmoidf_(v8[3])); w.z = cvtpk(sigmoidf_(v8[4]), sigmoidf_(v8[5])); w.w = cvtpk(sigmoidf_(v8[6]), sigmoidf_(v8[7]));
              *(LAS v4u*)(sgt + tok * FIN_SGS + 2 * k0) = w; } }
        WG_BAR();
        f32x16 acc[2][2], gg[2][2];
#pragma unroll
        for (int tt = 0; tt < 2; ++tt)
#pragma unroll
            for (int vt = 0; vt < 2; ++vt)
#pragma unroll
                for (int r = 0; r < 16; ++r) { acc[tt][vt][r] = 0.f; gg[tt][vt][r] = 0.f; }
#pragma unroll
        for (int d = 0; d < 2; ++d) { const size_t item = (size_t)(((b * 8 + h) * 2 + d) * 64 + (d ? 63 - cn : cn));
            const bf16* pre = (const bf16*)(ws + R_PRE) + item * 16384; const bf16* sd = (const bf16*)(ws + R_SD) + item * 4096;
#pragma unroll
            for (int tt = 0; tt < 2; ++tt)
#pragma unroll
                for (int vt = 0; vt < 2; ++vt) { const bf16* src = pre + 12288 + ((vt * 64 + 32 * tt + l31) * 2 + hi) * 16; const v4u w0_ = *(const v4u*)src, w1_ = *(const v4u*)(src + 8);
#pragma unroll
                    for (int j = 0; j < 4; ++j) { const f32x2_t u0 = unpk_h(w0_[j]), u1 = unpk_h(w1_[j]); acc[tt][vt][2 * j] += u0.x; acc[tt][vt][2 * j + 1] += u0.y; acc[tt][vt][8 + 2 * j] += u1.x; acc[tt][vt][8 + 2 * j + 1] += u1.y; } }
            bf16x8 sf[4][2], rf[4][2];
#pragma unroll
            for (int ks = 0; ks < 4; ++ks) { const int kt = ks >> 1, s = ks & 1;
#pragma unroll
                for (int vt = 0; vt < 2; ++vt) sf[ks][vt] = *(const bf16x8*)(sd + ((kt * 64 + 32 * vt + l31) * 2 + hi) * 16 + 8 * s);
#pragma unroll
                for (int tt = 0; tt < 2; ++tt) rf[ks][tt] = *(const bf16x8*)(pre + 4096 + (32 * tt + l31) * 64 + 32 * kt + 16 * s + 8 * hi); }
            SBAR0();
#pragma unroll
            for (int ks = 0; ks < 4; ++ks)
#pragma unroll
                for (int tt = 0; tt < 2; ++tt)
#pragma unroll
                    for (int vt = 0; vt < 2; ++vt) acc[tt][vt] = MFMA32H(sf[ks][vt], rf[ks][tt], acc[tt][vt]); }
#pragma unroll
        for (int kh = 0; kh < 2; ++kh) { bf16x8 gf[4][2], tf[4][2];
#pragma unroll
            for (int k4 = 0; k4 < 4; ++k4) { const int ks = 4 * kh + k4;
#pragma unroll
                for (int vt = 0; vt < 2; ++vt) gf[k4][vt] = *(const bf16x8*)(G2T + (size_t)(hc + 32 * vt + l31) * 128 + 16 * ks + 8 * hi);
#pragma unroll
                for (int tt = 0; tt < 2; ++tt) tf[k4][tt] = *(const LAS bf16x8*)(sgt + (32 * tt + l31) * FIN_SGS + (16 * ks + 8 * hi) * 2); }
            SBAR0();
#pragma unroll
            for (int k4 = 0; k4 < 4; ++k4)
#pragma unroll
                for (int tt = 0; tt < 2; ++tt)
#pragma unroll
                    for (int vt = 0; vt < 2; ++vt) gg[tt][vt] = MFMA32(gf[k4][vt], tf[k4][tt], gg[tt][vt]);
            SBAR0(); }
#pragma unroll
        for (int tt = 0; tt < 2; ++tt) { const int t = t0 + 32 * tt + l31, row = b * SEQ + t;
            float sm = 0.f;
#pragma unroll
            for (int vt = 0; vt < 2; ++vt)
#pragma unroll
                for (int r = 0; r < 16; ++r) sm += acc[tt][vt][r];
            sm += pg8::shx(sm, 32, lane); const float mu = sm * (1.0f / 64.0f); float sq = 0.f;
#pragma unroll
            for (int vt = 0; vt < 2; ++vt)
#pragma unroll
                for (int r = 0; r < 16; ++r) { const float dl = acc[tt][vt][r] - mu; sq += dl * dl; }
            sq += pg8::shx(sq, 32, lane); const float rstd = 1.0f / sqrtf(sq * (1.0f / 64.0f) + GN_EPS);
            const float bon = BN0[(size_t)row * 8 + h] + BN1[(size_t)row * 8 + h];
#pragma unroll
            for (int vt = 0; vt < 2; ++vt)
#pragma unroll
                for (int q = 0; q < 4; ++q) { const int v0 = 32 * vt + 8 * q + 4 * hi;
                    const f32x4 vs = shift4(Vr, 512, hc + v0, row, t, sp + 1024 + hc + v0, sn + 1024 + hc + v0), w4 = *(const f32x4*)(gnw + v0), b4 = *(const f32x4*)(gnb + v0);
                    float o4[4];
#pragma unroll
                    for (int i = 0; i < 4; ++i) o4[i] = ((acc[tt][vt][4 * q + i] - mu) * rstd * w4[i] + b4[i] + bon * vs[i]) * gg[tt][vt][4 * q + i];
                    u32x2_t w; w.x = cvtpk(o4[0], o4[1]); w.y = cvtpk(o4[2], o4[3]); *(u32x2_t*)(MIX + (size_t)row * 1024 + 512 + hc + v0) = w; } }
        WG_BAR();
    }
}

constexpr int ATT_O = 0, ATT_L = 65536, ATT_V = 67584, ATT_VT = 32 * TSB;
static_assert(ATT_V + NWAVES * ATT_VT <= LDSCTL_OFF, "attention LDS map");
__device__ __forceinline__ bf16x8 frag_tr_pv(const LAS unsigned char* tile, int d0, int s, int lane) {
    const int hi = lane >> 5, g1 = (lane >> 4) & 1, i = lane & 15;
    const LAS unsigned char* p = tile + (16 * s + 4 * hi + (i >> 2)) * TSB + (d0 + 16 * g1 + 4 * (i & 3)) * 2;
    const s16x4 lo = tr4(p), h4 = tr4(p + 8 * TSB);
    return (bf16x8){lo[0], lo[1], lo[2], lo[3], h4[0], h4[1], h4[2], h4[3]};
}
template <int NQH>
__device__ __forceinline__ void attn_block(const bf16* MIX, const bf16* V, LAS unsigned char* lds, LAS unsigned char* vt, int b, int h, int T0, int tq0, int d, float slope_d, float bound, bool first, int lane) {
    const int hi = lane >> 5, l31 = lane & 31;
    const int jlo = -(tq0 / d), jhi = (SEQ - 1 - tq0) / d;
    bf16x8 qf[NQH][4];
#pragma unroll
    for (int qh = 0; qh < NQH; ++qh) { const bf16* qp = MIX + ((size_t)b * SEQ + tq0 + d * (32 * qh + l31)) * 1024 + h * HD + 8 * hi;
#pragma unroll
        for (int ks = 0; ks < 4; ++ks) qf[qh][ks] = *(const bf16x8*)(qp + 16 * ks); }
    f32x16 o[NQH][2]; float lsum[NQH];
#pragma unroll
    for (int qh = 0; qh < NQH; ++qh) { lsum[qh] = 0.f;
#pragma unroll
        for (int r = 0; r < 16; ++r) { o[qh][0][r] = 0.f; o[qh][1][r] = 0.f; } }
    constexpr int NT = NQH == 2 ? 6 : 5;
#pragma unroll 1
    for (int jt = 0; jt < NT; ++jt) {
        { const int kr = lane >> 1, hf = lane & 1; int pos = tq0 + d * (32 * jt + kr - 64); pos = pos < 0 ? 0 : (pos > SEQ - 1 ? SEQ - 1 : pos);
          const v4u* src = (const v4u*)(V + ((size_t)b * SEQ + pos) * 512 + h * HD + 32 * hf); LAS v4u* dst = (LAS v4u*)(vt + kr * TSB + 64 * hf);
          const v4u a0 = src[0], a1 = src[1], a2 = src[2], a3 = src[3]; dst[0] = a0; dst[1] = a1; dst[2] = a2; dst[3] = a3; }
        bf16x8 kf[4];
        { int pos = tq0 + d * (32 * jt + l31 - 64); pos = pos < 0 ? 0 : (pos > SEQ - 1 ? SEQ - 1 : pos);
          const bf16* kp = MIX + ((size_t)b * SEQ + pos) * 1024 + 512 + h * HD + 8 * hi;
#pragma unroll
          for (int ks = 0; ks < 4; ++ks) kf[ks] = *(const bf16x8*)(kp + 16 * ks); }
        asm volatile("s_waitcnt lgkmcnt(0)" ::: "memory");
#pragma unroll
        for (int qh = 0; qh < NQH; ++qh) {
            if (NQH == 2 && ((qh == 0 && jt == 5) || (qh == 1 && jt == 0))) continue;
            f32x16 s;
#pragma unroll
            for (int r = 0; r < 16; ++r) s[r] = 0.f;
#pragma unroll
            for (int ks = 0; ks < 4; ++ks) s = MFMA32(kf[ks], qf[qh][ks], s);
            const int iq = 32 * qh + l31;
            v4u pk[2];
#pragma unroll
            for (int r = 0; r < 16; r += 2) { float p2[2];
#pragma unroll
                for (int e = 0; e < 2; ++e) { const int rr = r + e, jj = 32 * jt + (rr & 3) + 8 * (rr >> 2) + 4 * hi - 64; const int dl = iq - jj, ad = dl < 0 ? -dl : dl;
                    const bool valid = (ad <= 64) && (jj >= jlo) && (jj <= jhi);
                    p2[e] = valid ? __expf(s[rr] - slope_d * (float)ad - bound) : 0.f; lsum[qh] += p2[e]; }
                pk[r >> 3][(r >> 1) & 3] = cvtpk(p2[0], p2[1]); }
#pragma unroll
            for (int dt = 0; dt < 2; ++dt)
#pragma unroll
                for (int s2 = 0; s2 < 2; ++s2) o[qh][dt] = MFMA32(frag_tr_pv(vt, 32 * dt, s2, lane), __builtin_bit_cast(bf16x8, pk[s2]), o[qh][dt]);
        }
        asm volatile("s_waitcnt lgkmcnt(0)" ::: "memory");
    }
    int lane2 = lane; asm volatile("" : "+v"(lane2));
#pragma unroll
    for (int qh = 0; qh < NQH; ++qh) { const int hi = lane2 >> 5, l31 = lane2 & 31, lane = lane2;
        const int qi = (tq0 - T0) + d * (32 * qh + l31);
        const float lt = lsum[qh] + pg8::shx(lsum[qh], 32, lane);
        if (hi == 0) { LAS float* lp = (LAS float*)(lds + ATT_L) + qi; *lp = first ? lt : (*lp + lt); }
#pragma unroll
        for (int dt = 0; dt < 2; ++dt)
#pragma unroll
            for (int q = 0; q < 4; ++q) { const int d0 = 32 * dt + 8 * q + 4 * hi; LAS u32x2_t* op = (LAS u32x2_t*)(lds + ATT_O + qi * 128 + ((((d0 >> 3) ^ (qi & 7)) << 4) | ((d0 & 4) << 1)));
                float v0 = o[qh][dt][4 * q], v1 = o[qh][dt][4 * q + 1], v2 = o[qh][dt][4 * q + 2], v3 = o[qh][dt][4 * q + 3];
                if (!first) { const u32x2_t w = *op; v0 += __uint_as_float(w.x << 16); v1 += __uint_as_float(w.x & 0xffff0000u); v2 += __uint_as_float(w.y << 16); v3 += __uint_as_float(w.y & 0xffff0000u); }
                u32x2_t w; w.x = cvtpk(v0, v1); w.y = cvtpk(v2, v3); *op = w; }
    }
}
__device__ __forceinline__ void attn_phase_mfma(Frame& F, int layer, int unit0, int nunit, int ustride) {
    unsigned char* const ws = kws();
    int lane_ = lane_id(); asm volatile("" : "+v"(lane_)); int wave_o = F.wv; asm volatile("" : "+s"(wave_o)); const int wave_ = wave_o, lane = lane_;
    bf16* MIX = (bf16*)(ws + R_MIX); const bf16* V = (const bf16*)(ws + R_V);
    LAS unsigned char* const lds = F.lds; LAS unsigned char* const vt = lds + ATT_V + wave_ * ATT_VT;
    float bound;
    { const float* qg = karg(I_QG) + layer * HD; const float* kg = karg(I_KG) + layer * HD; float mq = 0.f, mk = 0.f;
      for (int i = 0; i < HD; ++i) { mq = fmaxf(mq, fabsf(qg[i])); mk = fmaxf(mk, fabsf(kg[i])); }
      bound = 8.0f * mq * mk + 0.25f; }
    for (int unit = unit0; unit < nunit; unit += ustride) {
        const int st = unit & 7, h = (unit >> 3) & 7, b = unit >> 6, T0 = st * 512;
        const float slope = exp2f(-(float)(h + 1));
        attn_block<2>(MIX, V, lds, vt, b, h, T0, T0 + 64 * wave_, 1, slope, bound, true, lane);
        WG_BAR();
        attn_block<2>(MIX, V, lds, vt, b, h, T0, T0 + (wave_ & 3) + 256 * (wave_ >> 2), 4, slope * 4.f, bound, false, lane);
        WG_BAR();
        attn_block<1>(MIX, V, lds, vt, b, h, T0, T0 + 2 * wave_, 16, slope * 16.f, bound, false, lane);
        attn_block<1>(MIX, V, lds, vt, b, h, T0, T0 + 2 * wave_ + 1, 16, slope * 16.f, bound, false, lane);
        WG_BAR();
        { const int tid = wave_ * 64 + lane;
#pragma unroll
          for (int k = 0; k < 8; ++k) { const int item = tid + 512 * k, qi = item >> 3, c16 = item & 7;
              const v4u w = *(const LAS v4u*)(lds + ATT_O + qi * 128 + ((c16 ^ (qi & 7)) << 4)); const float il = 1.0f / ((const LAS float*)(lds + ATT_L))[qi];
              v4u o;
#pragma unroll
              for (int j = 0; j < 4; ++j) o[j] = cvtpk(__uint_as_float(w[j] << 16) * il, __uint_as_float(w[j] & 0xffff0000u) * il);
              *(v4u*)(MIX + ((size_t)b * SEQ + T0 + qi) * 1024 + h * HD + 8 * c16) = o; } }
        WG_BAR();
    }
}

__global__ void __launch_bounds__(NTHR, 2) mk_fwd(Args args) {
    extern __shared__ __attribute__((aligned(16))) unsigned char lds[];
    Frame F;
    F.lds = (LAS unsigned char*)lds;
    F.MISC = (volatile LAS unsigned*)(F.lds + MISC_OFF);
    F.wv = __builtin_amdgcn_readfirstlane((int)threadIdx.x >> 6);
    F.G = gridDim.x; { const int bx = blockIdx.x; F.vcu = (F.G % 8 == 0) ? (bx % 8) * (F.G / 8) + bx / 8 : bx; }
    F.ctl = (gu32*)(kws() + WS_CTL);
    for (int u = F.wv * 64 + lane_id(); u < (LDS_BYTES - LDSCTL_OFF) / 4; u += NTHR) ((LAS unsigned*)(F.lds + LDSCTL_OFF))[u] = 0u;
    __syncthreads();
    XcdBarrier bar = xcd_barrier_post((unsigned*)(F.ctl + CW_BAR), F.MISC + 8, F.wv == 0 && lane_id() == 0);
#define GRID_BAR() xcd_barrier(bar, F.wv == 0 && lane_id() == 0)
#define XB ((bf16*)(ws + R_XB))
#define MIXB ((bf16*)(ws + R_MIX))
#define HID ((bf16*)(ws + R_HID))
#define SS1 ((float*)(ws + WS_SS1))
#define SS2 ((float*)(ws + WS_SS2))

    for (int step = 0; step < 8 * DEPTH; ++step) {
        const int layer = step >> 3, kind = step & 7;
        if (kind == 0) {
            if (layer > 0) continue;
            x_prologue(F);
            { int lane_ = lane_id(); asm volatile("" : "+v"(lane_)); wconv_items(0, -1, F.vcu * NWAVES + F.wv, F.G * NWAVES, (LAS float*)(F.lds + RING_OFF + F.wv * 16384), lane_); }
        } else if (kind == 1) {
            unsigned char* const ws = kws();
            pg8::Gemm g{XB, (const bf16*)(ws + WS_WIN), M, NPROJ, D}; pg8::StaticOrder S; S.init(M, NPROJ, F.G, (int)blockIdx.x);
            pg8::EpiProj E; E.base0 = (bf16*)(ws + WS_R0); E.ss = SS1; E.qg = karg(I_QG) + layer * HD; E.kg = karg(I_KG) + layer * HD;
            pg8::gemm_phase<pg8::EpiProj, pg8::StaticOrder, true, true>(F.lds + RING_OFF, g, S, E, F.wv, lane_id());
        } else if (kind == 2) {
            rwkv_pre_phase(F, layer);
        } else if (kind == 3) {
            const int bx = (int)blockIdx.x;
            if (bx < 128) { if (F.wv == 0) rwkv_scan_chunk(F, bx);
                            else { int lane_ = lane_id(); asm volatile("" : "+v"(lane_)); wconv_items(layer + 1, layer, bx * 7 + F.wv - 1, 128 * 7, (LAS float*)(F.lds + SCAN_NS * SCAN_SLOT + (F.wv - 1) * 9216), lane_); } }
            else attn_phase_mfma(F, layer, bx - 128, BATCH * H * 8, F.G - 128);
        } else if (kind == 4) {
            rwkv_finalize_mfma(F, layer);
        } else if (kind == 5 || kind == 7) {
            unsigned char* const ws = kws(); float* const xo = kout();
            pg8::Gemm g{kind == 5 ? MIXB : HID, (const bf16*)(ws + (kind == 5 ? WS_WOUT : WS_WDN)), M, D, kind == 5 ? D : FF}; pg8::StaticOrder S; S.init(M, D, F.G, (int)blockIdx.x);
            pg8::EpiRes E{xo, XB, kind == 5 ? SS2 : SS1};
            pg8::gemm_phase<pg8::EpiRes, pg8::StaticOrder, false, true>(F.lds + RING_OFF, g, S, E, F.wv, lane_id());
        } else {
            unsigned char* const ws = kws();
            pg8::Gemm g{XB, (const bf16*)(ws + WS_WUP), M, FF, D}; pg8::StaticOrder S; S.init(M, FF, F.G, (int)blockIdx.x);
            pg8::EpiUp E{HID, SS2};
            pg8::gemm_phase<pg8::EpiUp, pg8::StaticOrder, true, true>(F.lds + RING_OFF, g, S, E, F.wv, lane_id());
        }
        if (step + 1 < 8 * DEPTH) GRID_BAR();
    }
}

extern "C" void kernel_launch(void* const* d_in, const int* in_sizes, int n_in, void* d_out, int out_size, void* d_ws, size_t ws_size, hipStream_t stream) {
    static int grid = 0;
    if (grid == 0) {
        if (n_in != N_IN || in_sizes[0] != M * D || out_size != M * D || ws_size < WS_END) { fprintf(stderr, "kernel_launch: unexpected shapes (n_in %d, in0 %d, out %d, ws %zu)\n", n_in, n_in > 0 ? in_sizes[0] : -1, out_size, ws_size); grid = -1; return; }
        int dev = 0, cus = 0;
        if (hipGetDevice(&dev) != hipSuccess || hipDeviceGetAttribute(&cus, hipDeviceAttributeMultiprocessorCount, dev) != hipSuccess) { grid = -1; return; }
        if (hipFuncSetAttribute((const void*)mk_fwd, hipFuncAttributeMaxDynamicSharedMemorySize, LDS_BYTES) != hipSuccess) { fprintf(stderr, "kernel_launch: hipFuncSetAttribute failed\n"); grid = -1; return; }
        int per_cu = 0;
        (void)hipOccupancyMaxActiveBlocksPerMultiprocessor(&per_cu, (const void*)mk_fwd, NTHR, LDS_BYTES);
        (void)hipGetLastError();
        grid = cus;
    }
    if (grid < 0) return;
    (void)hipMemsetAsync((char*)d_ws + WS_CTL, 0, CTL_ZERO_BYTES, stream);
    Args a{};
    for (int i = 0; i < N_IN; ++i) a.in[i] = (const float*)d_in[i];
    a.out = (float*)d_out; a.ws = (unsigned char*)d_ws;
    hipLaunchKernelGGL(mk_fwd, dim3(grid), dim3(NTHR), LDS_BYTES, stream, a);
}
```

```cpp
#include <hip/hip_runtime.h>
#include <cstdio>
#include <cstdint>
namespace pg8 {
#define PG8_LAS __attribute__((address_space(3)))
typedef unsigned short bf16_t;
typedef short bf16x8 __attribute__((ext_vector_type(8)));
typedef float f32x4 __attribute__((ext_vector_type(4)));
typedef unsigned u32x4 __attribute__((ext_vector_type(4)));
constexpr int BM = 256, BK = 64, HALF = 128, HTB = HALF * BK * 2  , STAGE_BYTES = 8 * HTB, NXCD = 8, WGM = 8;

__host__ __device__ __forceinline__ int lds_byte(int r, int c) { const int st = (r >> 4) * 2 + (c >> 5), rr = r & 15, cc = c & 31, ob = rr * 64 + cc * 2; return st * 1024 + (ob ^ (((ob >> 9) & 1) << 5)); }
__host__ __device__ __forceinline__ void stage_rc(int b, int& R, int& C) { const int st = b / 1024, sb = b % 1024, swz = sb ^ (((sb >> 9) & 1) << 5); R = (st >> 1) * 16 + swz / 64; C = (st & 1) * 32 + (swz % 64) / 2; }
__host__ __device__ __forceinline__ int perm32(int rho) { const int n = rho >> 4, i = rho & 15; return 8 * (i >> 2) + 4 * n + (i & 3); }

struct Unit { int pm, pn; };
struct Gemm { const bf16_t* A; const bf16_t* Bt; int M, N, K; };

struct StaticOrder {
    int nM, nN, nwg, G, c;
    __host__ __device__ void init(int M, int N, int G_, int c_) { nM = M / BM; nN = N / BM; nwg = nM * nN; G = G_; c = c_; }
    __host__ __device__ bool next(int i, Unit& u) const {
        const long L = (long)i * G + c; if (L >= nwg) return false;
        int wgid = (int)L; { const int q = nwg / NXCD, r = nwg % NXCD, xcd = wgid % NXCD, off = wgid / NXCD; wgid = (xcd < r ? xcd * (q + 1) : r * (q + 1) + (xcd - r) * q) + off; }
        const int nig = WGM * nN, gid = wgid / nig, fm = gid * WGM, gsz = (nM - fm) < WGM ? (nM - fm) : WGM;
        u.pm = fm + ((wgid % nig) % gsz); u.pn = (wgid % nig) / gsz; return true;
    }
    __device__ __forceinline__ void a_ready(const Unit&) const {}
    __device__ __forceinline__ void done(const Unit&) const {}
};

__device__ __forceinline__ unsigned cvt_pk_bf16(float lo, float hi) { unsigned r; asm volatile("v_cvt_pk_bf16_f32 %0, %1, %2" : "=v"(r) : "v"(lo), "v"(hi)); return r; }
typedef unsigned u32x2 __attribute__((ext_vector_type(2)));

__device__ __forceinline__ float shx(float v, int m, int lane) { return __int_as_float(__builtin_amdgcn_ds_bpermute((lane ^ m) << 2, __float_as_int(v))); }
__device__ __forceinline__ float row_rs(const float* ss, int row, int fq, int lane) {
    const f32x4 p = *(const f32x4*)(ss + (size_t)row * 16 + 4 * fq);
    float s = (p[0] + p[1]) + (p[2] + p[3]);
    s += shx(s, 16, lane); s += shx(s, 32, lane);
    return 1.0f / sqrtf(s * (1.0f / 1024.0f) + 1e-6f);
}

struct EpiProj {
    static constexpr bool PERM = true, AFTER_DRAIN = false;
    bf16_t* base0; const float* ss; const float* qg; const float* kg;
    __device__ __forceinline__ void operator()(const f32x4 (&acc)[2][2][4][2], const Unit& u, int wr, int wc, int fr, int fq) const {
        const int tile = u.pn, di = tile >> 1;
        bf16_t* base = base0 + (di < 2 ? (size_t)di * 512 : (size_t)di * (8u << 20)); const int ldc = (di < 2) ? 1024 : ((di == 6) ? 256 : 512); const int cb = (di == 6) ? 0 : (tile & 1) * 256;
        const bool nrm = tile < 4; const float* gsrc = (tile < 2) ? qg : kg; const float post = (tile < 2) ? 0.125f : 1.0f;
        f32x4 g[2][2];
#pragma unroll
        for (int bj = 0; bj < 2; ++bj)
#pragma unroll
            for (int n = 0; n < 2; ++n) g[bj][n] = nrm ? *(const f32x4*)(gsrc + 32 * bj + 8 * fq + 4 * n) * post : (f32x4){1.f, 1.f, 1.f, 1.f};
#pragma unroll
        for (int ai = 0; ai < 2; ++ai)
#pragma unroll
            for (int m = 0; m < 4; ++m) {
                const int row = u.pm * BM + ai * HALF + wr * 64 + m * 16 + fr;
                const float rs = row_rs(ss, row, fq, 16 * fq + fr);
                f32x4 v[2][2]; float q = 0.f;
#pragma unroll
                for (int bj = 0; bj < 2; ++bj)
#pragma unroll
                    for (int n = 0; n < 2; ++n) { v[bj][n] = acc[ai][bj][m][n] * rs; const f32x4 t = v[bj][n]; q += (t[0] * t[0] + t[1] * t[1]) + (t[2] * t[2] + t[3] * t[3]); }
                q += shx(q, 16, 16 * fq + fr); q += shx(q, 32, 16 * fq + fr);
                const float inv = nrm ? 1.0f / sqrtf(q * (1.0f / 64.0f) + 1e-6f) : 1.0f;
                bf16_t* rowp = base + (size_t)row * ldc + cb + 64 * wc + 8 * fq;
#pragma unroll
                for (int bj = 0; bj < 2; ++bj) { const f32x4 v0 = v[bj][0] * inv * g[bj][0], v1 = v[bj][1] * inv * g[bj][1];
                    u32x4 w; w.x = cvt_pk_bf16(v0[0], v0[1]); w.y = cvt_pk_bf16(v0[2], v0[3]); w.z = cvt_pk_bf16(v1[0], v1[1]); w.w = cvt_pk_bf16(v1[2], v1[3]);
                    *(u32x4*)(rowp + 32 * bj) = w; }
                asm volatile("" ::: "memory");
            }
    }
};
struct EpiUp {
    static constexpr bool PERM = true, AFTER_DRAIN = false;
    bf16_t* O; const float* ss;
    __device__ __forceinline__ void operator()(const f32x4 (&acc)[2][2][4][2], const Unit& u, int wr, int wc, int fr, int fq) const {
#pragma unroll
        for (int ai = 0; ai < 2; ++ai)
#pragma unroll
            for (int m = 0; m < 4; ++m) {
                const int row = u.pm * BM + ai * HALF + wr * 64 + m * 16 + fr;
                const float rs = row_rs(ss, row, fq, 16 * fq + fr);
                bf16_t* rowp = O + (size_t)row * 4096 + u.pn * BM + wc * 32 + 8 * fq;
#pragma unroll
                for (int bj = 0; bj < 2; ++bj) { f32x4 v0 = acc[ai][bj][m][0] * rs, v1 = acc[ai][bj][m][1] * rs;
                    v0 = __builtin_elementwise_max(v0, (f32x4){0.f, 0.f, 0.f, 0.f}); v1 = __builtin_elementwise_max(v1, (f32x4){0.f, 0.f, 0.f, 0.f}); v0 = v0 * v0; v1 = v1 * v1;
                    u32x4 w; w.x = cvt_pk_bf16(v0[0], v0[1]); w.y = cvt_pk_bf16(v0[2], v0[3]); w.z = cvt_pk_bf16(v1[0], v1[1]); w.w = cvt_pk_bf16(v1[2], v1[3]);
                    *(u32x4*)(rowp + bj * HALF) = w; }
                asm volatile("" ::: "memory");
            }
    }
};
struct EpiRes {
    static constexpr bool PERM = false, AFTER_DRAIN = false;
    float* x; bf16_t* xb; float* ss;
    __device__ __forceinline__ void operator()(const f32x4 (&acc)[2][2][4][2], const Unit& u, int wr, int wc, int fr, int fq) const {
        const int col0 = u.pn * BM + wc * 32 + 4 * fq;
#pragma unroll
        for (int ai = 0; ai < 2; ++ai)
#pragma unroll
            for (int m = 0; m < 4; ++m) {
                const int row = u.pm * BM + ai * HALF + wr * 64 + m * 16 + fr; const size_t off = (size_t)row * 1024 + col0; float q = 0.f;
#pragma unroll
                for (int bj = 0; bj < 2; ++bj)
#pragma unroll
                    for (int n = 0; n < 2; ++n) { const size_t o = off + bj * HALF + n * 16; const f32x4 t = *(const f32x4*)(x + o) + acc[ai][bj][m][n];
                        *(f32x4*)(x + o) = t; u32x2 w; w.x = cvt_pk_bf16(t[0], t[1]); w.y = cvt_pk_bf16(t[2], t[3]); *(u32x2*)(xb + o) = w;
                        q += (t[0] * t[0] + t[1] * t[1]) + (t[2] * t[2] + t[3] * t[3]); }
                q += shx(q, 16, 16 * fq + fr); q += shx(q, 32, 16 * fq + fr);
                if (fq == 0) ss[(size_t)row * 16 + 4 * u.pn + wc] = q;
                asm volatile("" ::: "memory");
            }
    }
};

template <class Epi, class Sched, bool ALIGN_EPI = false, bool SP2 = false>
__device__ __forceinline__ void gemm_phase(PG8_LAS unsigned char* lds, const Gemm g, const Sched& S, const Epi& E, int wave_in, int lane_in) {
    int lane_o = lane_in, wave_o = wave_in; asm volatile("" : "+v"(lane_o)); asm volatile("" : "+s"(wave_o)); const int tid_ = wave_o * 64 + lane_o;
    const int tid = tid_, wid = wave_o, lane = lane_o, wr = wid >> 2, wc = wid & 3, fr = lane & 15, fq = lane >> 4;
    const int K = g.K, nt = K / BK;
    unsigned voffA[2], voffB[2];
#pragma unroll
    for (int i = 0; i < 2; ++i) { int R, C; stage_rc(tid * 16 + i * 8192, R, C); const int Rb = Epi::PERM ? ((R & ~31) + perm32(R & 31)) : R;
        voffA[i] = (unsigned)(R * K + C) * 2u; voffB[i] = (unsigned)(Rb * K + C) * 2u; }
    const size_t kstep = (size_t)(BK * 2);
    const size_t hstep = (size_t)HALF * K * 2;
    const size_t tstep = 2 * hstep;
    const unsigned ldsw = (unsigned)wid * 1024u;
    const int aoff = lds_byte(wr * 64 + fr, fq * 8), boff = lds_byte(wc * 32 + fr, fq * 8);
#define PG8_SA(b, h) (((b) * 2 + (h)) * HTB)
#define PG8_SB(b, h) ((4 + (b) * 2 + (h)) * HTB)
#define PG8_STAGE(bufoff, gbase, voff) do { _Pragma("unroll") for (int _i = 0; _i < 2; ++_i) \
        __builtin_amdgcn_global_load_lds((const unsigned*)((const char*)(gbase) + (voff)[_i]), (PG8_LAS unsigned*)(lds + (bufoff) + ldsw + _i * 8192), 16, 0, 0); } while (0)
#define PG8_LDA(dst, b, h) do { _Pragma("unroll") for (int m = 0; m < 4; ++m) _Pragma("unroll") for (int k = 0; k < 2; ++k) dst[m][k] = *(const PG8_LAS bf16x8*)(lds + PG8_SA(b, h) + aoff + m * 2048 + k * 1024); } while (0)
#define PG8_LDB(dst, b, h) do { _Pragma("unroll") for (int n = 0; n < 2; ++n) _Pragma("unroll") for (int k = 0; k < 2; ++k) dst[n][k] = *(const PG8_LAS bf16x8*)(lds + PG8_SB(b, h) + boff + n * 2048 + k * 1024); } while (0)
#define PG8_MMA(ai, bj, At, Bt) do { __builtin_amdgcn_s_setprio(1); _Pragma("unroll") for (int m = 0; m < 4; ++m) _Pragma("unroll") for (int n = 0; n < 2; ++n) _Pragma("unroll") for (int k = 0; k < 2; ++k) \
        acc[ai][bj][m][n] = __builtin_amdgcn_mfma_f32_16x16x32_bf16(Bt[n][k], At[m][k], acc[ai][bj][m][n], 0, 0, 0); __builtin_amdgcn_s_setprio(0); } while (0)
#define PG8_WAIT_V(n) asm volatile("s_waitcnt vmcnt(" #n ")" ::: "memory")
#define PG8_WAIT_L(n) asm volatile("s_waitcnt lgkmcnt(" #n ")" ::: "memory")
#define PG8_BAR __builtin_amdgcn_s_barrier()
#define PG8_SCHED __builtin_amdgcn_sched_barrier(0)
    Unit cur, nxt; int ui = 0;
    if (!S.next(0, cur)) return;
    f32x4 acc[2][2][4][2];
#pragma unroll
    for (int a = 0; a < 2; ++a)
#pragma unroll
        for (int b = 0; b < 2; ++b)
#pragma unroll
            for (int m = 0; m < 4; ++m)
#pragma unroll
                for (int n = 0; n < 2; ++n) acc[a][b][m][n] = (f32x4){0.f, 0.f, 0.f, 0.f};
    bf16x8 At[4][2], B0[2][2], B1[2][2];
    const char* cA = (const char*)g.A + (size_t)cur.pm * tstep; const char* cB = (const char*)g.Bt + (size_t)cur.pn * tstep;
    S.a_ready(cur);
    if constexpr (SP2) {
        PG8_STAGE(PG8_SB(0, 0), cB, voffB); PG8_STAGE(PG8_SB(0, 1), cB + hstep, voffB); PG8_STAGE(PG8_SA(0, 0), cA, voffA); PG8_STAGE(PG8_SA(0, 1), cA + hstep, voffA);
        if (wr == 1) PG8_BAR;
        PG8_WAIT_V(2); PG8_BAR;
        PG8_STAGE(PG8_SB(1, 0), cB + kstep, voffB); PG8_STAGE(PG8_SA(1, 0), cA + kstep, voffA); PG8_STAGE(PG8_SB(1, 1), cB + hstep + kstep, voffB);
        PG8_WAIT_V(6); PG8_BAR;
    } else {
        PG8_STAGE(PG8_SB(0, 0), cB, voffB); PG8_STAGE(PG8_SA(0, 0), cA, voffA); PG8_STAGE(PG8_SB(0, 1), cB + hstep, voffB); PG8_STAGE(PG8_SA(0, 1), cA + hstep, voffA);
        if (wr == 1) PG8_BAR;
        PG8_WAIT_V(4); PG8_BAR;
        PG8_STAGE(PG8_SB(1, 0), cB + kstep, voffB); PG8_STAGE(PG8_SA(1, 0), cA + kstep, voffA); PG8_STAGE(PG8_SB(1, 1), cB + hstep + kstep, voffB);
        PG8_WAIT_V(6); PG8_BAR;
    }
    for (;;) {
        const bool has_next = S.next(ui + 1, nxt);
        const char* nA = has_next ? (const char*)g.A + (size_t)nxt.pm * tstep : cA; const char* nB = has_next ? (const char*)g.Bt + (size_t)nxt.pn * tstep : cB;
        for (int t = 0; t < nt; t += 2) {
            const bool last = (t == nt - 2);
            const char* a1 = cA + (size_t)(t + 1) * kstep;
            const char* a2 = last ? nA : cA + (size_t)(t + 2) * kstep; const char* b2 = last ? nB : cB + (size_t)(t + 2) * kstep;
            const char* a3 = a2 + kstep; const char* b3 = b2 + kstep;
            if (last && has_next) S.a_ready(nxt);
            if constexpr (SP2) {
            PG8_LDB(B0, 0, 0); PG8_LDB(B1, 0, 1); PG8_SCHED; PG8_LDA(At, 0, 0); PG8_STAGE(PG8_SA(1, 1), a1 + hstep, voffA);
            PG8_WAIT_V(8); PG8_WAIT_L(0); PG8_BAR; PG8_MMA(0, 0, At, B0); PG8_MMA(0, 1, At, B1); PG8_BAR; PG8_SCHED;
            PG8_LDA(At, 0, 1); PG8_STAGE(PG8_SB(0, 0), b2, voffB); PG8_STAGE(PG8_SB(0, 1), b2 + hstep, voffB); PG8_STAGE(PG8_SA(0, 0), a2, voffA);
            PG8_WAIT_V(8); PG8_WAIT_L(0); PG8_BAR; PG8_MMA(1, 0, At, B0); PG8_MMA(1, 1, At, B1); PG8_BAR; PG8_SCHED;
            PG8_LDB(B0, 1, 0); PG8_LDB(B1, 1, 1); PG8_SCHED; PG8_LDA(At, 1, 0); PG8_STAGE(PG8_SA(0, 1), a2 + hstep, voffA);
            PG8_WAIT_V(8); PG8_WAIT_L(0); PG8_BAR; PG8_MMA(0, 0, At, B0); PG8_MMA(0, 1, At, B1); PG8_BAR; PG8_SCHED;
            PG8_LDA(At, 1, 1); PG8_STAGE(PG8_SB(1, 0), b3, voffB); PG8_STAGE(PG8_SB(1, 1), b3 + hstep, voffB); PG8_STAGE(PG8_SA(1, 0), a3, voffA);
            PG8_WAIT_V(8); PG8_WAIT_L(0); PG8_BAR; PG8_MMA(1, 0, At, B0); PG8_MMA(1, 1, At, B1); PG8_BAR; PG8_SCHED;
            } else {
            PG8_LDB(B0, 0, 0); PG8_SCHED; PG8_LDA(At, 0, 0); PG8_STAGE(PG8_SA(1, 1), a1 + hstep, voffA);
            PG8_WAIT_L(8); PG8_BAR; PG8_WAIT_L(0); PG8_MMA(0, 0, At, B0); PG8_BAR; PG8_SCHED;
            PG8_LDB(B1, 0, 1); PG8_STAGE(PG8_SB(0, 0), b2, voffB);
            PG8_BAR; PG8_WAIT_L(0); PG8_MMA(0, 1, At, B1); PG8_BAR;
            PG8_LDA(At, 0, 1); PG8_STAGE(PG8_SA(0, 0), a2, voffA);
            PG8_BAR; PG8_WAIT_L(0); PG8_MMA(1, 0, At, B0); PG8_BAR; PG8_SCHED;
            PG8_STAGE(PG8_SB(0, 1), b2 + hstep, voffB);
            PG8_WAIT_V(6); PG8_BAR; PG8_MMA(1, 1, At, B1); PG8_BAR;
            PG8_LDB(B0, 1, 0); PG8_SCHED; PG8_LDA(At, 1, 0); PG8_STAGE(PG8_SA(0, 1), a2 + hstep, voffA);
            PG8_WAIT_L(8); PG8_BAR; PG8_WAIT_L(0); PG8_MMA(0, 0, At, B0); PG8_BAR; PG8_SCHED;
            PG8_LDB(B1, 1, 1); PG8_STAGE(PG8_SB(1, 0), b3, voffB);
            PG8_BAR; PG8_WAIT_L(0); PG8_MMA(0, 1, At, B1); PG8_BAR;
            PG8_LDA(At, 1, 1); PG8_STAGE(PG8_SA(1, 0), a3, voffA);
            PG8_BAR; PG8_WAIT_L(0); PG8_MMA(1, 0, At, B0); PG8_BAR; PG8_SCHED;
            PG8_STAGE(PG8_SB(1, 1), b3 + hstep, voffB);
            PG8_WAIT_V(6); PG8_BAR; PG8_MMA(1, 1, At, B1); PG8_BAR;
            }
        }
        if constexpr (ALIGN_EPI) { if (wr == 0) PG8_BAR; }
        if constexpr (!Epi::AFTER_DRAIN) { E(acc, cur, wr, wc, fr, fq); S.done(cur); }
        if (!has_next) break;
#pragma unroll
        for (int a = 0; a < 2; ++a)
#pragma unroll
            for (int b = 0; b < 2; ++b)
#pragma unroll
                for (int m = 0; m < 4; ++m)
#pragma unroll
                    for (int n = 0; n < 2; ++n) acc[a][b][m][n] = (f32x4){0.f, 0.f, 0.f, 0.f};
        cur = nxt; cA = nA; cB = nB; ++ui;
        if constexpr (ALIGN_EPI) { if (wr == 1) PG8_BAR; }
    }
    PG8_WAIT_V(0);
    if constexpr (!ALIGN_EPI) { if (wr == 0) PG8_BAR; }
    PG8_BAR;
    if constexpr (Epi::AFTER_DRAIN) { E.fused(acc, cur, wr, wc, fr, fq, lds, wid, lane); S.done(cur); }
#undef PG8_SA
#undef PG8_SB
#undef PG8_STAGE
#undef PG8_LDA
#undef PG8_LDB
#undef PG8_MMA
#undef PG8_WAIT_V
#undef PG8_WAIT_L
#undef PG8_BAR
#undef PG8_SCHED
}
}
constexpr int NWAVES = 8, NTHR = 512;
constexpr int BATCH = 4, SEQ = 4096, D = 1024, DEPTH = 4, H = 8, HD = 64, FF = 4096, NPROJ = 3328, RPROJ = 1792;
constexpr int M = BATCH * SEQ;
constexpr float GN_EPS = 64e-5f;
enum { I_X = 0, I_LN1, I_WIN, I_QG, I_KG, I_TSP, I_TSN, I_W0, I_W2, I_A0, I_A2, I_G2, I_KK, I_KA, I_RK, I_GNW, I_GNB, I_WOUT, I_LN2, I_WUP, I_WDN, N_IN };
constexpr size_t MiB = 1u << 20;
constexpr size_t WS_CTL = 0, CTL_ZERO_BYTES = 64 * 1024;
constexpr size_t WS_SS1 = 1 * MiB, WS_SS2 = 2 * MiB;
constexpr size_t WS_WIN = 3 * MiB, WS_WOUT = WS_WIN + (size_t)NPROJ * D * 2, WS_WUP = WS_WOUT + (size_t)D * D * 2, WS_WDN = WS_WUP + (size_t)FF * D * 2;
constexpr size_t WS_R0 = 28 * MiB;
constexpr size_t R_MIX = WS_R0 + 0 * MiB;
constexpr size_t R_V = WS_R0 + 32 * MiB;
constexpr size_t R_RR = WS_R0 + 48 * MiB, R_KR = WS_R0 + 64 * MiB, R_VR = WS_R0 + 80 * MiB, R_XL = WS_R0 + 96 * MiB;
constexpr size_t R_SD = R_RR;
constexpr size_t R_PRE = WS_R0 + 104 * MiB;
constexpr size_t R_HID = WS_R0;
constexpr size_t R_XB = WS_R0 + 128 * MiB;
constexpr size_t R_BN = WS_R0 + 232 * MiB;
constexpr size_t WS_END = WS_R0 + 233 * MiB;
constexpr size_t WS_LORA = WS_WDN + (size_t)D * FF * 2;
constexpr size_t WS_G2T = WS_LORA + 4 * 512 * 64 * 2;
static_assert(WS_G2T + 512 * 128 * 2 <= WS_R0, "lora");
constexpr int CW_BAR = 1024;
constexpr int RING_OFF = 0, RING_BYTES = 131072;
constexpr int LDSCTL_OFF = 155648, MISC_OFF = LDSCTL_OFF + 320;
constexpr int LDS_BYTES = 163840;
#define GAS __attribute__((address_space(1)))
#define LAS __attribute__((address_space(3)))
typedef unsigned short bf16;
typedef unsigned v4u __attribute__((ext_vector_type(4)));
typedef float f32x4 __attribute__((ext_vector_type(4)));
typedef short bf16x8 __attribute__((ext_vector_type(8)));
typedef GAS unsigned gu32;
typedef GAS unsigned long long gu64;
#define RLX_AGENT __ATOMIC_RELAXED, __HIP_MEMORY_SCOPE_AGENT
#define LDS_WAIT() asm volatile("s_waitcnt lgkmcnt(0)" ::: "memory")
#define VM_WAIT() asm volatile("s_waitcnt vmcnt(0)" ::: "memory")
__device__ __forceinline__ unsigned long long rt() { return __builtin_amdgcn_s_memrealtime(); }
__device__ __forceinline__ unsigned f2bf(float f) { unsigned u = __builtin_bit_cast(unsigned, f); return (u + 0x7fffu + ((u >> 16) & 1u)) >> 16; }
__device__ __forceinline__ unsigned pk2(float lo, float hi) { return f2bf(lo) | (f2bf(hi) << 16); }

#define XB_TMO      128
#define XB_XCNT(j)  (256  + 64 * (j))
#define XB_XSUB(j)  (1280 + 64 * (j))
#define XB_XGEN(j)  (2304 + 64 * (j))
#define XB_TOP      3328
#define XB_TOPGEN   3392
#define XCD_BAR_WORDS 3456
#define XB_SPIN_CAP (1u << 18)

__device__ __forceinline__ unsigned xb_ld(unsigned* p)              { return __hip_atomic_load(p, __ATOMIC_RELAXED, __HIP_MEMORY_SCOPE_AGENT); }
__device__ __forceinline__ unsigned xb_add(unsigned* p, unsigned v) { return __hip_atomic_fetch_add(p, v, __ATOMIC_RELAXED, __HIP_MEMORY_SCOPE_AGENT); }
__device__ __forceinline__ unsigned xb_xcc_id() { return (unsigned)__builtin_amdgcn_s_getreg((3 << 11) | 20) & 0xFu; }
#define XB_SPIN(cond, bar) do { unsigned _sp = 0; while (cond) { __builtin_amdgcn_s_sleep(1); \
    if ((++_sp & 255u) == 0u) { if (xb_ld(&(bar)[XB_TMO])) break; if (_sp > XB_SPIN_CAP) { atomicAdd(&(bar)[XB_TMO], 1u); break; } } } } while (0)

struct XcdBarrier {
    unsigned* bar; unsigned x;
    volatile LAS unsigned* st;
};

__device__ __forceinline__ XcdBarrier xcd_barrier_post(unsigned* bar, volatile LAS unsigned* st, bool tid0) {
    XcdBarrier b; b.bar = bar; b.x = xb_xcc_id(); b.st = st;
    if (tid0) (void)xb_add(&bar[XB_XCNT(b.x)], 1u);
    return b;
}
__device__ __forceinline__ void xcd_barrier_complete(unsigned* bar, unsigned x, unsigned& nloc, unsigned& nx) {
    const unsigned G = gridDim.x * gridDim.y * gridDim.z;
    unsigned sum, cnt, mine, sp = 0u;
    for (;;) {
        sum = 0u; cnt = 0u; mine = 0u;
#pragma unroll
        for (unsigned j = 0; j < 16; ++j) { const unsigned c = xb_ld(&bar[XB_XCNT(j)]); sum += c; cnt += (c > 0u) ? 1u : 0u; mine = (j == x) ? c : mine; }
        if (sum == G) break;
        __builtin_amdgcn_s_sleep(1);
        if ((++sp & 255u) == 0u) { if (xb_ld(&bar[XB_TMO])) break; if (sp > XB_SPIN_CAP) { atomicAdd(&bar[XB_TMO], 1u); break; } }
    }
    nloc = mine > 0u ? mine : 1u; nx = cnt > 0u ? cnt : 1u;
}

__device__ __forceinline__ void xcd_barrier(const XcdBarrier& b, bool tid0) {
    asm volatile("s_waitcnt vmcnt(0)" ::: "memory");
    __syncthreads();
    if (tid0) {
        unsigned* bar = b.bar; asm volatile("" : "+v"(bar));
        __builtin_amdgcn_s_waitcnt(0);
        unsigned nloc = b.st[0], nx = b.st[1];
        if (nloc == 0u) { xcd_barrier_complete(bar, b.x, nloc, nx); b.st[0] = nloc; b.st[1] = nx; }
        const unsigned old = xb_add(&bar[XB_XSUB(b.x)], 1u);
        const unsigned gen = old / nloc;
        if (old + 1u == (gen + 1u) * nloc) {
            __builtin_amdgcn_fence(__ATOMIC_RELEASE, "agent");
            asm volatile("s_waitcnt vmcnt(0)" ::: "memory");
            const unsigned og = xb_add(&bar[XB_TOP], 1u);
            const unsigned tg = og / nx;
            if (og + 1u == (tg + 1u) * nx) xb_add(&bar[XB_TOPGEN], 1u);
            else XB_SPIN(xb_ld(&bar[XB_TOPGEN]) == tg, bar);
            __builtin_amdgcn_fence(__ATOMIC_ACQUIRE, "agent");
            xb_add(&bar[XB_XGEN(b.x)], 1u);
            asm volatile("s_waitcnt vmcnt(0)" ::: "memory");
        } else {
            XB_SPIN(xb_ld(&bar[XB_XGEN(b.x)]) == gen, bar);
            __builtin_amdgcn_fence(__ATOMIC_ACQUIRE, "agent");
            asm volatile("s_waitcnt vmcnt(0)" ::: "memory");
        }
    }
    __syncthreads();
}
__device__ __forceinline__ float bf2f(bf16 v) { return __uint_as_float(((unsigned)v) << 16); }
__device__ __forceinline__ bf16 f2bf_s(float f) { return (bf16)f2bf(f); }
__device__ __forceinline__ float wave_sum(float v, int lane) {
#pragma unroll
    for (int o = 1; o < 64; o <<= 1) v += pg8::shx(v, o, lane);
    return v;
}
__device__ __forceinline__ float sigmoidf_(float z) { return 1.0f / (1.0f + __expf(-z)); }
__device__ __forceinline__ float tanh_fast(float x) { return 1.0f - 2.0f / (__expf(2.0f * x) + 1.0f); }

struct Args { const float* in[N_IN]; float* out; unsigned char* ws; };
typedef const __attribute__((address_space(4))) Args CArgs;
__device__ __forceinline__ const CArgs* kargs() { const CArgs* p = (const CArgs*)__builtin_amdgcn_kernarg_segment_ptr(); asm volatile("" : "+s"(p)); return p; }
__device__ __forceinline__ unsigned char* kws() { return kargs()->ws; }
__device__ __forceinline__ float* kout() { return kargs()->out; }
__device__ __forceinline__ const float* karg(int i) { return kargs()->in[i]; }
__device__ __forceinline__ int lane_id() { int l; asm volatile("v_mbcnt_lo_u32_b32 %0, -1, 0\n\tv_mbcnt_hi_u32_b32 %0, -1, %0" : "=v"(l)); return l; }
struct Frame {
    LAS unsigned char* lds;
    volatile LAS unsigned* MISC;
    gu32* ctl;
    int vcu, G, wv;
};

__device__ __forceinline__ float ushift(const bf16* buf, int ldc, int col, int row, int t, float sp, float sn) {
    const bf16* p = buf + (size_t)row * ldc + col;
    const float u0 = bf2f(p[0]);
    const float up = (t > 0) ? bf2f(p[-ldc]) : 0.f;
    const float un = (t < SEQ - 1) ? bf2f(p[ldc]) : 0.f;
    return u0 + sp * (up - u0) + sn * (un - u0);
}

__device__ __forceinline__ void transpose_item(const float* W, int K, int N, bf16* WT, const float* gain, bool headperm, LAS float* scr, int item, int lane) {
    const int nblk = N / 32, kb = item / nblk, nb = item % nblk, k0 = 64 * kb, n0 = 32 * nb;
#pragma unroll 8
    for (int i = 0; i < 32; ++i) { const int kk = 2 * i + (lane >> 5); float w = W[(size_t)(k0 + kk) * N + n0 + (lane & 31)]; if (gain) w *= gain[k0 + kk]; scr[kk * 33 + (lane & 31)] = w; }
    LDS_WAIT(); asm volatile("" ::: "memory");
    const int c = lane & 7;
    const int p0 = headperm ? ((n0 & ~255) + 128 * ((n0 >> 5) & 1) + 32 * ((n0 >> 6) & 3)) : n0;
#pragma unroll
    for (int j = 0; j < 4; ++j) { const int n = (lane >> 3) + 8 * j; const LAS float* s = scr + (8 * c) * 33 + n;
        v4u o; o.x = pk2(s[0 * 33], s[1 * 33]); o.y = pk2(s[2 * 33], s[3 * 33]); o.z = pk2(s[4 * 33], s[5 * 33]); o.w = pk2(s[6 * 33], s[7 * 33]);
        *(GAS v4u*)(WT + (size_t)(p0 + n) * K + k0 + 8 * c) = o; }
    LDS_WAIT(); asm volatile("" ::: "memory");
}
__device__ __forceinline__ void wconv_items(int layerA, int layerB, int wi, int nw, LAS float* scr, int lane_) {
    unsigned char* const ws = kws();
    constexpr int I_1 = (D / 64) * (NPROJ / 32), I_2 = (D / 64) * (D / 32), I_3 = (D / 64) * (FF / 32), I_4 = (FF / 64) * (D / 32);
    constexpr int NA = I_1 + 64, NB = I_2 + I_3 + I_4 + 32;
    const int nA = (layerA >= 0 && layerA < DEPTH) ? NA : 0, nB = (layerB >= 0) ? NB : 0;
    for (int it = wi; it < nA + nB; it += nw) {
        int r = it;
        if (r < nA) { const int layer = layerA;
            if (r < I_1) { transpose_item(karg(I_WIN) + (size_t)layer * D * NPROJ, D, NPROJ, (bf16*)(ws + WS_WIN), karg(I_LN1) + layer * D, true, scr, r, lane_); continue; } r -= I_1;
            const int mat = r >> 4, it16 = r & 15;
            const float* src = (mat < 2 ? karg(I_W2) : karg(I_A2)) + (size_t)(layer * 2 + (mat & 1)) * 64 * 512;
            transpose_item(src, 64, 512, (bf16*)(ws + WS_LORA) + (size_t)mat * 512 * 64, nullptr, false, scr, it16, lane_); continue; }
        r -= nA; const int layer = layerB;
        if (r < I_2) { transpose_item(karg(I_WOUT) + (size_t)layer * D * D, D, D, (bf16*)(ws + WS_WOUT), nullptr, false, scr, r, lane_); continue; } r -= I_2;
        if (r < I_3) { transpose_item(karg(I_WUP) + (size_t)layer * D * FF, D, FF, (bf16*)(ws + WS_WUP), karg(I_LN2) + layer * D, false, scr, r, lane_); continue; } r -= I_3;
        if (r < I_4) { transpose_item(karg(I_WDN) + (size_t)layer * FF * D, FF, D, (bf16*)(ws + WS_WDN), nullptr, false, scr, r, lane_); continue; } r -= I_4;
        transpose_item(karg(I_G2) + (size_t)layer * 128 * 512, 128, 512, (bf16*)(ws + WS_G2T), nullptr, false, scr, r, lane_);
    }
}
__device__ __forceinline__ void x_prologue(Frame& F) {
    unsigned char* const ws = kws();
    int lane_ = lane_id(); asm volatile("" : "+v"(lane_)); int wave_o = F.wv; asm volatile("" : "+s"(wave_o)); const int wave_ = wave_o, tid_ = wave_ * 64 + lane_;
    const int gw = F.vcu * NWAVES + wave_, NGW = F.G * NWAVES;
    const float* x = karg(I_X); bf16* xb = (bf16*)(ws + R_XB); float* ss = (float*)(ws + WS_SS1);
    for (int m = gw; m < M; m += NGW) {
        const GAS f32x4* xr = (const GAS f32x4*)(x + (size_t)m * D) + lane_; GAS f32x4* orow = (GAS f32x4*)(kout() + (size_t)m * D) + lane_;
        GAS unsigned long long* o8 = (GAS unsigned long long*)(xb + (size_t)m * D) + lane_;
        float s = 0.f;
#pragma unroll
        for (int j = 0; j < 4; ++j) { const f32x4 v = xr[64 * j]; orow[64 * j] = v; s += (v.x * v.x + v.y * v.y) + (v.z * v.z + v.w * v.w);
            o8[64 * j] = (unsigned long long)pk2(v.x, v.y) | ((unsigned long long)pk2(v.z, v.w) << 32); }
        s = wave_sum(s, lane_);
        if (lane_ < 16) ss[(size_t)m * 16 + lane_] = (lane_ == 0) ? s : 0.f;
    }
}

__device__ __forceinline__ void attn_naive(Frame& F, int layer, int aw, int naw) {
    unsigned char* const ws = kws();
    int lane_ = lane_id(); asm volatile("" : "+v"(lane_)); int wave_o = F.wv; asm volatile("" : "+s"(wave_o)); const int wave_ = wave_o, tid_ = wave_ * 64 + lane_;
    bf16* MIX = (bf16*)(ws + R_MIX); const bf16* Q = MIX; const bf16* K = MIX + 512; const bf16* V = (const bf16*)(ws + R_V);
    LAS float* qs = (LAS float*)(F.lds + RING_OFF + wave_ * 4096); LAS float* pb = qs + 64;
    float bound;
    { const float* qg = karg(I_QG) + layer * HD; const float* kg = karg(I_KG) + layer * HD; float mq = 0.f, mk = 0.f;
      for (int i = 0; i < HD; ++i) { mq = fmaxf(mq, fabsf(qg[i])); mk = fmaxf(mk, fabsf(kg[i])); }
      bound = 8.0f * mq * mk + 0.25f; }
    const int lane = lane_;
    for (int unit = aw; unit < BATCH * H * SEQ; unit += naw) {
        const int t = unit % SEQ, bh = unit / SEQ, h = bh % H, b = bh / H; const size_t row = (size_t)b * SEQ + t;
        qs[lane] = bf2f(Q[row * 1024 + h * HD + lane]);
        LDS_WAIT(); asm volatile("" ::: "memory");
        float qv[HD];
#pragma unroll
        for (int i = 0; i < HD; ++i) qv[i] = qs[i];
        const float slope = exp2f(-(float)(h + 1));
        float lsum = 0.f;
        for (int bi = 0; bi < 3; ++bi) { const int d = 1 << (2 * bi);
            for (int pass = 0; pass < 3; ++pass) { const int jj = pass * 64 + lane; const bool act = jj <= 128; const int j = jj - 64; const int pos = t + j * d; const bool valid = act && pos >= 0 && pos < SEQ;
                float p = 0.f;
                if (valid) { const v4u* kr = (const v4u*)(K + ((size_t)b * SEQ + pos) * 1024 + h * HD); float dot = 0.f;
#pragma unroll
                    for (int c = 0; c < 8; ++c) { const v4u w = kr[c];
                        dot += qv[8 * c + 0] * __uint_as_float(w.x << 16) + qv[8 * c + 1] * __uint_as_float(w.x & 0xffff0000u) + qv[8 * c + 2] * __uint_as_float(w.y << 16) + qv[8 * c + 3] * __uint_as_float(w.y & 0xffff0000u)
                             + qv[8 * c + 4] * __uint_as_float(w.z << 16) + qv[8 * c + 5] * __uint_as_float(w.z & 0xffff0000u) + qv[8 * c + 6] * __uint_as_float(w.w << 16) + qv[8 * c + 7] * __uint_as_float(w.w & 0xffff0000u); }
                    const float s = dot - slope * fabsf((float)(j * d)); p = __expf(s - bound); }
                if (act) pb[bi * 129 + jj] = p;
                lsum += p; } }
        lsum = wave_sum(lsum, lane_);
        LDS_WAIT(); asm volatile("" ::: "memory");
        float o = 0.f;
        for (int bi = 0; bi < 3; ++bi) { const int d = 1 << (2 * bi);
            for (int jj = 0; jj < 129; ++jj) { const float p = pb[bi * 129 + jj];
                if (p != 0.f) { const int pos = t + (jj - 64) * d; o += p * bf2f(V[((size_t)b * SEQ + pos) * 512 + h * HD + lane]); } } }
        MIX[row * 1024 + h * HD + lane] = f2bf_s(o / lsum);
        LDS_WAIT(); asm volatile("" ::: "memory");
    }
}

typedef float f32x16 __attribute__((ext_vector_type(16)));
typedef short s16x4 __attribute__((ext_vector_type(4)));
typedef short v4i16_t __attribute__((ext_vector_type(4)));
typedef unsigned u32x2_t __attribute__((ext_vector_type(2)));
typedef float f32x2_t __attribute__((ext_vector_type(2))); typedef __bf16 bf16x2_t __attribute__((ext_vector_type(2)));
__device__ __forceinline__ unsigned cvtpk(float lo, float hi) { f32x2_t v = {lo, hi}; bf16x2_t b = __builtin_convertvector(v, bf16x2_t); return __builtin_bit_cast(unsigned, b); }
typedef _Float16 h16x2_t __attribute__((ext_vector_type(2))); typedef _Float16 h16x8 __attribute__((ext_vector_type(8)));
__device__ __forceinline__ unsigned cvtpk_h(float lo, float hi) { f32x2_t v = {lo, hi}; h16x2_t b = __builtin_convertvector(v, h16x2_t); return __builtin_bit_cast(unsigned, b); }
__device__ __forceinline__ f32x2_t unpk_h(unsigned w) { return __builtin_convertvector(__builtin_bit_cast(h16x2_t, w), f32x2_t); }
#define MFMA32H(nf, mf, acc) __builtin_amdgcn_mfma_f32_32x32x16_f16(__builtin_bit_cast(h16x8, (nf)), __builtin_bit_cast(h16x8, (mf)), (acc), 0, 0, 0)
constexpr int TSB = 144, TILE_B = 64 * TSB;
constexpr int PRE_TW = 14 * TILE_B, PRE_XA = 15 * TILE_B, PRE_INVN = 16 * TILE_B, PRE_GC = PRE_INVN + 256, PRE_BON = PRE_GC + 512, PRE_LDS_END = PRE_BON + 1024;
static_assert(PRE_LDS_END <= LDSCTL_OFF, "PRE LDS map");
__device__ __forceinline__ bf16x8 frag_row(const LAS unsigned char* tile, int row, int ks, int hi) {
    return *(const LAS bf16x8*)(tile + row * TSB + (16 * ks + 8 * hi) * 2);
}
__device__ __forceinline__ s16x4 tr4(const LAS unsigned char* p) { return __builtin_bit_cast(s16x4, __builtin_amdgcn_ds_read_tr16_b64_v4i16((LAS v4i16_t*)p)); }
__device__ __forceinline__ bf16x8 frag_tr(const LAS unsigned char* tile, int idx0, int ks, int lane) {
    const int hi = lane >> 5, g1 = (lane >> 4) & 1, i = lane & 15;
    const LAS unsigned char* p = tile + (16 * ks + 8 * hi + (i >> 2)) * TSB + (idx0 + 16 * g1 + 4 * (i & 3)) * 2;
    const s16x4 lo = tr4(p), h4 = tr4(p + 4 * TSB);
    return (bf16x8){lo[0], lo[1], lo[2], lo[3], h4[0], h4[1], h4[2], h4[3]};
}
__device__ __forceinline__ void store_quad(LAS unsigned char* tile, int row, int n0, int hi, const f32x16& a) {
#pragma unroll
    for (int q = 0; q < 4; ++q) { u32x2_t w; w.x = cvtpk(a[4 * q], a[4 * q + 1]); w.y = cvtpk(a[4 * q + 2], a[4 * q + 3]); *(LAS u32x2_t*)(tile + row * TSB + (n0 + 8 * q + 4 * hi) * 2) = w; }
}
__device__ __forceinline__ void store_quad_h(LAS unsigned char* tile, int row, int n0, int hi, const f32x16& a) {
#pragma unroll
    for (int q = 0; q < 4; ++q) { u32x2_t w; w.x = cvtpk_h(a[4 * q], a[4 * q + 1]); w.y = cvtpk_h(a[4 * q + 2], a[4 * q + 3]); *(LAS u32x2_t*)(tile + row * TSB + (n0 + 8 * q + 4 * hi) * 2) = w; }
}
__device__ __forceinline__ f32x16 load_quad(const LAS unsigned char* tile, int row, int n0, int hi) {
    f32x16 a;
#pragma unroll
    for (int q = 0; q < 4; ++q) { const u32x2_t w = *(const LAS u32x2_t*)(tile + row * TSB + (n0 + 8 * q + 4 * hi) * 2);
        a[4 * q] = __uint_as_float(w.x << 16); a[4 * q + 1] = __uint_as_float(w.x & 0xffff0000u); a[4 * q + 2] = __uint_as_float(w.y << 16); a[4 * q + 3] = __uint_as_float(w.y & 0xffff0000u); }
    return a;
}
#define MFMA32(nf, mf, acc) __builtin_amdgcn_mfma_f32_32x32x16_bf16((nf), (mf), (acc), 0, 0, 0)
#define LD4_ROW(dst, tile, row) _Pragma("unroll") for (int ks_ = 0; ks_ < 4; ++ks_) dst[ks_] = frag_row(tile, row, ks_, hi)
#define LD4_TR(dst, tile, idx0) _Pragma("unroll") for (int ks_ = 0; ks_ < 4; ++ks_) dst[ks_] = frag_tr(tile, idx0, ks_, lane)
#define SBAR0() __builtin_amdgcn_sched_barrier(0)
#define WG_BARL() do { asm volatile("s_waitcnt lgkmcnt(0)" ::: "memory"); __builtin_amdgcn_s_barrier(); asm volatile("" ::: "memory"); } while (0)
#define WG_BAR() do { asm volatile("s_waitcnt vmcnt(0) lgkmcnt(0)" ::: "memory"); __builtin_amdgcn_s_barrier(); asm volatile("" ::: "memory"); } while (0)
__device__ __forceinline__ void shift8(const bf16* buf, int ldc, int col, int row, int t, const float* sp, const float* sn, float (&out)[8]) {
    const bf16* p = buf + (size_t)row * ldc + col;
    const v4u c = *(const v4u*)p; v4u pv = (v4u){0u, 0u, 0u, 0u}, nv = (v4u){0u, 0u, 0u, 0u};
    if (t > 0) pv = *(const v4u*)(p - ldc);
    if (t < SEQ - 1) nv = *(const v4u*)(p + ldc);
    const f32x4 sp0 = *(const f32x4*)sp, sp1 = *(const f32x4*)(sp + 4), sn0 = *(const f32x4*)sn, sn1 = *(const f32x4*)(sn + 4);
#pragma unroll
    for (int j = 0; j < 8; ++j) { const unsigned cw = c[j >> 1], pw = pv[j >> 1], nw = nv[j >> 1];
        const float u0 = (j & 1) ? __uint_as_float(cw & 0xffff0000u) : __uint_as_float(cw << 16), up = (j & 1) ? __uint_as_float(pw & 0xffff0000u) : __uint_as_float(pw << 16), un = (j & 1) ? __uint_as_float(nw & 0xffff0000u) : __uint_as_float(nw << 16);
        const float a = (j < 4) ? sp0[j & 3] : sp1[j & 3], bq = (j < 4) ? sn0[j & 3] : sn1[j & 3];
        out[j] = u0 + a * (up - u0) + bq * (un - u0); }
}
__device__ __forceinline__ f32x4 shift4(const bf16* buf, int ldc, int col, int row, int t, const float* sp, const float* sn) {
    const bf16* p = buf + (size_t)row * ldc + col;
    const u32x2_t c = *(const u32x2_t*)p; u32x2_t pv = (u32x2_t){0u, 0u}, nv = (u32x2_t){0u, 0u};
    if (t > 0) pv = *(const u32x2_t*)(p - ldc);
    if (t < SEQ - 1) nv = *(const u32x2_t*)(p + ldc);
    const f32x4 a = *(const f32x4*)sp, bq = *(const f32x4*)sn;
    const f32x4 u0 = (f32x4){__uint_as_float(c.x << 16), __uint_as_float(c.x & 0xffff0000u), __uint_as_float(c.y << 16), __uint_as_float(c.y & 0xffff0000u)};
    const f32x4 up = (f32x4){__uint_as_float(pv.x << 16), __uint_as_float(pv.x & 0xffff0000u), __uint_as_float(pv.y << 16), __uint_as_float(pv.y & 0xffff0000u)};
    const f32x4 un = (f32x4){__uint_as_float(nv.x << 16), __uint_as_float(nv.x & 0xffff0000u), __uint_as_float(nv.y << 16), __uint_as_float(nv.y & 0xffff0000u)};
    return u0 + a * (up - u0) + bq * (un - u0);
}

struct R16 { v4u c, p, n; };
struct R8 { u32x2_t c, p, n; };
__device__ __forceinline__ R16 ld3x16(const bf16* buf, int ldc, int col, int row, int t) {
    const bf16* q = buf + (size_t)row * ldc + col; R16 r; r.c = *(const v4u*)q; r.p = (v4u){0u, 0u, 0u, 0u}; r.n = (v4u){0u, 0u, 0u, 0u};
    if (t > 0) r.p = *(const v4u*)(q - ldc);
    if (t < SEQ - 1) r.n = *(const v4u*)(q + ldc);
    return r;
}
__device__ __forceinline__ R8 ld3x8(const bf16* buf, int ldc, int col, int row, int t) {
    const bf16* q = buf + (size_t)row * ldc + col; R8 r; r.c = *(const u32x2_t*)q; r.p = (u32x2_t){0u, 0u}; r.n = (u32x2_t){0u, 0u};
    if (t > 0) r.p = *(const u32x2_t*)(q - ldc);
    if (t < SEQ - 1) r.n = *(const u32x2_t*)(q + ldc);
    return r;
}
__device__ __forceinline__ void sh8(const R16& r, const LAS float* sp, const LAS float* sn, float (&out)[8]) {
    const f32x4 sp0 = *(const LAS f32x4*)sp, sp1 = *(const LAS f32x4*)(sp + 4), sn0 = *(const LAS f32x4*)sn, sn1 = *(const LAS f32x4*)(sn + 4);
#pragma unroll
    for (int j = 0; j < 8; ++j) { const unsigned cw = r.c[j >> 1], pw = r.p[j >> 1], nw = r.n[j >> 1];
        const float u0 = (j & 1) ? __uint_as_float(cw & 0xffff0000u) : __uint_as_float(cw << 16), up = (j & 1) ? __uint_as_float(pw & 0xffff0000u) : __uint_as_float(pw << 16), un = (j & 1) ? __uint_as_float(nw & 0xffff0000u) : __uint_as_float(nw << 16);
        const float a = (j < 4) ? sp0[j & 3] : sp1[j & 3], bq = (j < 4) ? sn0[j & 3] : sn1[j & 3];
        out[j] = u0 + a * (up - u0) + bq * (un - u0); }
}
__device__ __forceinline__ f32x4 sh4(const R8& r, const f32x4 a, const f32x4 bq) {
    const f32x4 u0 = (f32x4){__uint_as_float(r.c.x << 16), __uint_as_float(r.c.x & 0xffff0000u), __uint_as_float(r.c.y << 16), __uint_as_float(r.c.y & 0xffff0000u)};
    const f32x4 up = (f32x4){__uint_as_float(r.p.x << 16), __uint_as_float(r.p.x & 0xffff0000u), __uint_as_float(r.p.y << 16), __uint_as_float(r.p.y & 0xffff0000u)};
    const f32x4 un = (f32x4){__uint_as_float(r.n.x << 16), __uint_as_float(r.n.x & 0xffff0000u), __uint_as_float(r.n.y << 16), __uint_as_float(r.n.y & 0xffff0000u)};
    return u0 + a * (up - u0) + bq * (un - u0);
}
constexpr int PRE_CT = PRE_LDS_END;
enum { CT_KK = 0, CT_KA = 64, CT_RK = 128, CT_W0 = 192  , CT_A0 = 320  , CT_SPR = 448, CT_SNR = 512, CT_SPK = 576, CT_SNK = 640, CT_SPV = 704, CT_SNV = 768, CT_SPX = 832  , CT_SNX = 960  , CT_N = 1088 };
static_assert(PRE_CT + CT_N * 4 <= LDSCTL_OFF, "PRE constant table");
__device__ __forceinline__ void rwkv_pre_phase(Frame& F, int layer) {
    unsigned char* const ws = kws();
    int lane_ = lane_id(); asm volatile("" : "+v"(lane_)); int wave_o = F.wv; asm volatile("" : "+s"(wave_o)); const int wave_ = wave_o;
    const int d = wave_ >> 2, qm = (wave_ >> 1) & 1, qn = wave_ & 1, m0 = 32 * qm, n0 = 32 * qn;
#define LANE_VARS int lane = lane_; asm volatile("" : "+v"(lane)); const int hi = lane >> 5, l31 = lane & 31, mrow = m0 + l31; (void)hi; (void)l31; (void)mrow;
    LAS unsigned char* const L = F.lds;
    LAS unsigned char* const T0 = L + (d * 7 + 0) * TILE_B; LAS unsigned char* const T1 = L + (d * 7 + 1) * TILE_B; LAS unsigned char* const T2 = L + (d * 7 + 2) * TILE_B; LAS unsigned char* const T3 = L + (d * 7 + 3) * TILE_B;
    LAS unsigned char* const T4 = L + (d * 7 + 4) * TILE_B; LAS unsigned char* const T5 = L + (d * 7 + 5) * TILE_B; LAS unsigned char* const T6 = L + (d * 7 + 6) * TILE_B;
    LAS unsigned char* const TWt = L + PRE_TW; LAS unsigned char* const XAt = L + PRE_XA;
    LAS float* const invn = (LAS float*)(L + PRE_INVN); LAS float* const gcs = (LAS float*)(L + PRE_GC) + d * 64; LAS float* const bon = (LAS float*)(L + PRE_BON); LAS float* const ct = (LAS float*)(L + PRE_CT);
    const bf16* Rr = (const bf16*)(ws + R_RR); const bf16* Kr = (const bf16*)(ws + R_KR); const bf16* Vr = (const bf16*)(ws + R_VR); const bf16* XL = (const bf16*)(ws + R_XL);
    const bf16* W2T = (const bf16*)(ws + WS_LORA) + (size_t)d * 512 * 64; const bf16* A2T = (const bf16*)(ws + WS_LORA) + (size_t)(2 + d) * 512 * 64;
    float* BN = (float*)(ws + R_BN) + (size_t)d * M * 8;
    const int h = F.vcu & 7, hc = h * HD, bc0 = F.vcu >> 3, bcs = F.G >> 3;
    { LANE_VARS; const float* sp = karg(I_TSP) + layer * RPROJ; const float* sn = karg(I_TSN) + layer * RPROJ;
      for (int idx = wave_ * 64 + lane; idx < CT_N; idx += NTHR) { const int seg = idx >> 6, c = idx & 63; float v;
          if (seg == 0) v = karg(I_KK)[layer * 512 + hc + c]; else if (seg == 1) v = karg(I_KA)[layer * 512 + hc + c]; else if (seg == 2) v = karg(I_RK)[layer * 512 + hc + c];
          else if (seg < 5) v = karg(I_W0)[(layer * 2 + seg - 3) * 512 + hc + c]; else if (seg < 7) v = karg(I_A0)[(layer * 2 + seg - 5) * 512 + hc + c];
          else if (seg < 13) { const int j = seg - 7; v = ((j & 1) ? sn : sp)[(j >> 1) * 512 + hc + c]; }
          else if (seg < 15) v = sp[1536 + (idx - CT_SPX)]; else v = sn[1536 + (idx - CT_SNX)];
          ct[idx] = v; } }
    WG_BARL();
    R16 xw3, xa3, kk3, rr3;
    { LANE_VARS; const int tidl = wave_ * 64 + lane, tok = tidl >> 3, oct = tidl & 7; const int b = bc0 >> 6, t = (bc0 & 63) * 64 + tok, row = b * SEQ + t;
      xw3 = ld3x16(XL, 256, 8 * oct, row, t); xa3 = ld3x16(XL, 256, 64 + 8 * oct, row, t); kk3 = ld3x16(Kr, 512, hc + 8 * oct, row, t); rr3 = ld3x16(Rr, 512, hc + 8 * oct, row, t); }
    LAS unsigned char* const RF0 = L + 6 * TILE_B; LAS unsigned char* const RF1 = L + 13 * TILE_B;
    for (int bc = bc0; bc < BATCH * (SEQ / 64); bc += bcs) {
        const int cn = bc & 63, b = bc >> 6, t0 = cn * 64;
#define SNAT (d ? 63 - mrow : mrow)
        bf16x8 wfr[4], afr[4];
        { LANE_VARS;
#pragma unroll
          for (int ks = 0; ks < 4; ++ks) { const size_t wo = (size_t)(hc + n0 + l31) * 64 + 16 * ks + 8 * hi; wfr[ks] = *(const bf16x8*)(W2T + wo); afr[ks] = *(const bf16x8*)(A2T + wo); }
        }
        float ksh[8];
        { LANE_VARS; const int tidl = wave_ * 64 + lane; const int tok = tidl >> 3, oct = tidl & 7; float v8[8];
          sh8(xw3, ct + CT_SPX + 8 * oct, ct + CT_SNX + 8 * oct, v8);
          { v4u w; w.x = cvtpk(tanh_fast(v8[0]), tanh_fast(v8[1])); w.y = cvtpk(tanh_fast(v8[2]), tanh_fast(v8[3])); w.z = cvtpk(tanh_fast(v8[4]), tanh_fast(v8[5])); w.w = cvtpk(tanh_fast(v8[6]), tanh_fast(v8[7])); *(LAS v4u*)(TWt + tok * TSB + 16 * oct) = w; }
          sh8(xa3, ct + CT_SPX + 64 + 8 * oct, ct + CT_SNX + 64 + 8 * oct, v8);
          { v4u w; w.x = cvtpk(v8[0], v8[1]); w.y = cvtpk(v8[2], v8[3]); w.z = cvtpk(v8[4], v8[5]); w.w = cvtpk(v8[6], v8[7]); *(LAS v4u*)(XAt + tok * TSB + 16 * oct) = w; }
          sh8(rr3, ct + CT_SPR + 8 * oct, ct + CT_SNR + 8 * oct, v8);
          { LAS f32x4* rp_ = (LAS f32x4*)((tok < 32 ? RF0 : RF1) + (tok & 31) * 256 + 32 * oct); rp_[0] = (f32x4){v8[0], v8[1], v8[2], v8[3]}; rp_[1] = (f32x4){v8[4], v8[5], v8[6], v8[7]}; }
          sh8(kk3, ct + CT_SPK + 8 * oct, ct + CT_SNK + 8 * oct, ksh);
          const f32x4 k0 = *(const LAS f32x4*)(ct + CT_KK + 8 * oct), k1 = *(const LAS f32x4*)(ct + CT_KK + 8 * oct + 4); float ssq = 0.f;
#pragma unroll
          for (int j = 0; j < 8; ++j) { const float kx = ksh[j] * ((j < 4) ? k0[j & 3] : k1[j & 3]); ssq += kx * kx; }
          ssq += pg8::shx(ssq, 1, lane); ssq += pg8::shx(ssq, 2, lane); ssq += pg8::shx(ssq, 4, lane);
          if (oct == 0) invn[tok] = 1.0f / sqrtf(ssq + 1e-12f); }
        WG_BARL();
        f32x16 zw, za, lw, av, cum;
        { LANE_VARS; const int snat = SNAT;
#pragma unroll
        for (int r = 0; r < 16; ++r) { zw[r] = 0.f; za[r] = 0.f; }
        { bf16x8 f0[4], f1[4]; LD4_ROW(f0, TWt, snat); LD4_ROW(f1, XAt, snat); SBAR0();
#pragma unroll
          for (int ks = 0; ks < 4; ++ks) { zw = MFMA32(wfr[ks], f0[ks], zw); za = MFMA32(afr[ks], f1[ks], za); } }
#pragma unroll
        for (int q = 0; q < 4; ++q) { const f32x4 w0v = *(const LAS f32x4*)(ct + CT_W0 + 64 * d + n0 + 8 * q + 4 * hi), a0v = *(const LAS f32x4*)(ct + CT_A0 + 64 * d + n0 + 8 * q + 4 * hi);
#pragma unroll
            for (int i = 0; i < 4; ++i) { lw[4 * q + i] = -0.6065306597f * sigmoidf_(zw[4 * q + i] + w0v[i]); av[4 * q + i] = sigmoidf_(za[4 * q + i] + a0v[i]); } }
        { f32x16 lh, ll;
#pragma unroll
          for (int r = 0; r < 16; ++r) { lh[r] = __uint_as_float(cvtpk(lw[r], 0.f) << 16); ll[r] = lw[r] - lh[r]; }
          store_quad(T4, mrow, n0, hi, lh); store_quad(T5, mrow, n0, hi, ll); } }
        WG_BARL();
        { LANE_VARS; const int tidl = wave_ * 64 + lane, tok = tidl >> 3, oct = tidl & 7;
          LAS f32x4* kp_ = (LAS f32x4*)((tok < 32 ? TWt : XAt) + (tok & 31) * 256 + 32 * oct); kp_[0] = (f32x4){ksh[0], ksh[1], ksh[2], ksh[3]}; kp_[1] = (f32x4){ksh[4], ksh[5], ksh[6], ksh[7]}; }
        { LANE_VARS;
#pragma unroll
        for (int r = 0; r < 16; ++r) cum[r] = 0.f;
        { bf16x8 f0[4], f1[4]; LD4_TR(f0, T4, n0); LD4_TR(f1, T5, n0); SBAR0();
#pragma unroll
        for (int ks = 0; ks < 4; ++ks) { bf16x8 tf;
#pragma unroll
            for (int j = 0; j < 8; ++j) tf[j] = (16 * ks + 8 * hi + j <= mrow) ? (short)0x3f80 : (short)0;
            cum = MFMA32(f0[ks], tf, cum); cum = MFMA32(f1[ks], tf, cum); } } }
        WG_BARL();
        f32x16 rh, kc, mrk;
        { LANE_VARS; const int snat = SNAT; const float inv = invn[snat];
          float bsum = 0.f;
#pragma unroll
          for (int q = 0; q < 4; ++q) { const int cl = n0 + 8 * q + 4 * hi;
              const f32x4 r4 = *(const LAS f32x4*)((snat < 32 ? RF0 : RF1) + (snat & 31) * 256 + 4 * cl), k4 = *(const LAS f32x4*)((snat < 32 ? TWt : XAt) + (snat & 31) * 256 + 4 * cl);
              const f32x4 kk4 = *(const LAS f32x4*)(ct + CT_KK + cl), ka4 = *(const LAS f32x4*)(ct + CT_KA + cl), rk4 = *(const LAS f32x4*)(ct + CT_RK + cl);
              float kh4[4], bc4[4], rl4[4], kl4[4];
#pragma unroll
              for (int i = 0; i < 4; ++i) { const int e = 4 * q + i; const float a = av[e], cs = cum[e];
                  const float g = __expf(cs), gx = __expf(cs - lw[e]), gi = __expf(-cs);
                  const float kkn = k4[i] * kk4[i] * inv, kt = k4[i] * (1.0f + (a - 1.0f) * ka4[i]);
                  kh4[i] = gx * kkn; rh[e] = g * r4[i]; bc4[i] = a * kkn * gi; kc[e] = kt * gi; bsum += r4[i] * kt * rk4[i];
                  rl4[i] = rh[e] - __uint_as_float(cvtpk(rh[e], 0.f) << 16); kl4[i] = kc[e] - __uint_as_float(cvtpk(kc[e], 0.f) << 16);
                  if (mrow == 63) gcs[n0 + 8 * q + 4 * hi + i] = g; }
              const int off = mrow * TSB + (n0 + 8 * q + 4 * hi) * 2; u32x2_t w;
              w.x = cvtpk(kh4[0], kh4[1]); w.y = cvtpk(kh4[2], kh4[3]); *(LAS u32x2_t*)(T0 + off) = w;
              w.x = cvtpk(rh[4 * q], rh[4 * q + 1]); w.y = cvtpk(rh[4 * q + 2], rh[4 * q + 3]); *(LAS u32x2_t*)(T1 + off) = w;
              w.x = cvtpk(bc4[0], bc4[1]); w.y = cvtpk(bc4[2], bc4[3]); *(LAS u32x2_t*)(T2 + off) = w;
              w.x = cvtpk(kc[4 * q], kc[4 * q + 1]); w.y = cvtpk(kc[4 * q + 2], kc[4 * q + 3]); *(LAS u32x2_t*)(T3 + off) = w;
              w.x = cvtpk(rl4[0], rl4[1]); w.y = cvtpk(rl4[2], rl4[3]); *(LAS u32x2_t*)(T4 + off) = w;
              w.x = cvtpk(kl4[0], kl4[1]); w.y = cvtpk(kl4[2], kl4[3]); *(LAS u32x2_t*)(T5 + off) = w; }
          bsum += pg8::shx(bsum, 32, lane);
          if (hi == 0) bon[(d * 2 + qn) * 64 + snat] = bsum; }
        if (bc + bcs < BATCH * (SEQ / 64)) { LANE_VARS; const int tidl = wave_ * 64 + lane, tok = tidl >> 3, oct = tidl & 7; const int bn = bc + bcs, b2 = bn >> 6, t = (bn & 63) * 64 + tok, row = b2 * SEQ + t;
            xw3 = ld3x16(XL, 256, 8 * oct, row, t); xa3 = ld3x16(XL, 256, 64 + 8 * oct, row, t); kk3 = ld3x16(Kr, 512, hc + 8 * oct, row, t); rr3 = ld3x16(Rr, 512, hc + 8 * oct, row, t); }
        WG_BARL();
        { LANE_VARS; const int snat = SNAT; if (qn == 0 && hi == 0) BN[(size_t)(b * SEQ + t0 + snat) * 8 + h] = bon[(d * 2) * 64 + snat] + bon[(d * 2 + 1) * 64 + snat]; }
        { LANE_VARS;
#pragma unroll
          for (int r = 0; r < 16; ++r) mrk[r] = 0.f;
          bf16x8 f0[4], f1[4], f2[4], f3[4]; LD4_ROW(f0, T1, mrow); LD4_ROW(f1, T3, n0 + l31); LD4_ROW(f2, T5, n0 + l31); LD4_ROW(f3, T4, mrow); SBAR0();
#pragma unroll
          for (int ks = 0; ks < 4; ++ks) { mrk = MFMA32(f1[ks], f0[ks], mrk); mrk = MFMA32(f2[ks], f0[ks], mrk); mrk = MFMA32(f1[ks], f3[ks], mrk); }
#pragma unroll
          for (int q = 0; q < 4; ++q)
#pragma unroll
              for (int i = 0; i < 4; ++i) { const int e = 4 * q + i, n = n0 + 8 * q + 4 * hi + i; mrk[e] = (n <= mrow) ? mrk[e] : 0.f; } }
        WG_BARL();
        { LANE_VARS; f32x16 x, mk, zz;
          float z0 = 0.f; asm volatile("" : "+v"(z0));
#pragma unroll
          for (int r = 0; r < 16; ++r) { x[r] = 0.f; mk[r] = 0.f; zz[r] = z0; }
          { bf16x8 f0[4], f1[4], f2[4]; LD4_ROW(f0, T0, mrow); LD4_ROW(f1, T2, n0 + l31); LD4_ROW(f2, T3, n0 + l31); SBAR0();
#pragma unroll
            for (int ks = 0; ks < 4; ++ks) { x = MFMA32(f1[ks], f0[ks], x); mk = MFMA32(f2[ks], f0[ks], mk); } }
#pragma unroll
          for (int q = 0; q < 4; ++q)
#pragma unroll
              for (int i = 0; i < 4; ++i) { const int e = 4 * q + i, n = n0 + 8 * q + 4 * hi + i; const bool lo = n < mrow; x[e] = lo ? -x[e] : 0.f; mk[e] = lo ? mk[e] : 0.f; }
          store_quad(T4, mrow, n0, hi, x); store_quad(T5, mrow, n0, hi, zz); store_quad(T6, mrow, n0, hi, mk); }
        WG_BARL();
        if ((wave_ & 3) == 0) { LANE_VARS; const int blk = lane >> 4, c = lane & 15; float t[16];
#pragma unroll
            for (int r = 0; r < 16; ++r) { const LAS unsigned char* xr = T4 + (16 * blk + r) * TSB + 32 * blk; const v4u w0_ = *(const LAS v4u*)xr, w1_ = *(const LAS v4u*)(xr + 16);
                float acc0 = (r == c) ? 1.0f : 0.f, acc1 = 0.f;
#pragma unroll
                for (int j = 0; j < r; ++j) { const unsigned w = (j < 8) ? w0_[j >> 1] : w1_[(j - 8) >> 1]; const float xv = (j & 1) ? __uint_as_float(w & 0xffff0000u) : __uint_as_float(w << 16);
                    if (j & 1) acc1 += xv * t[j]; else acc0 += xv * t[j]; }
                t[r] = acc0 + acc1; }
#pragma unroll
            for (int r = 0; r < 16; ++r) *(LAS unsigned short*)(T5 + (16 * blk + r) * TSB + (16 * blk + c) * 2) = (unsigned short)(cvtpk(t[r], 0.f) & 0xffffu); }
        WG_BARL();
        { LANE_VARS; LAS unsigned char* const scr = qm ? T5 : T4;
          if (qm == qn) {
              f32x16 w;
#pragma unroll
              for (int r = 0; r < 16; ++r) w[r] = 0.f;
              bf16x8 mf = frag_row(T4, m0 + l31, 2 * qm, hi);
              if (l31 < 16) mf = (bf16x8){0, 0, 0, 0, 0, 0, 0, 0};
              w = MFMA32(frag_tr(T5, m0, 2 * qm, lane), mf, w);
              store_quad(scr, l31, 32, hi, w); } }
        WG_BARL();
        { LANE_VARS; LAS unsigned char* const scr = qm ? T5 : T4;
          if (qm == qn) {
              f32x16 tq = load_quad(T5, mrow, m0, hi);
#pragma unroll
              for (int ks = 0; ks < 2; ++ks) tq = MFMA32(frag_tr(scr, 32, ks, lane), frag_row(T5, mrow, 2 * qm + ks, hi), tq);
              store_quad(T5, mrow, m0, hi, tq); } }
        WG_BARL();
        { LANE_VARS;
          if (qm == 1 && qn == 0) {
              f32x16 w;
#pragma unroll
              for (int r = 0; r < 16; ++r) w[r] = 0.f;
#pragma unroll
              for (int ks = 0; ks < 2; ++ks) w = MFMA32(frag_tr(T5, 0, ks, lane), frag_row(T4, 32 + l31, ks, hi), w);
              store_quad(T4, l31, 32, hi, w); }
          if (qm == 0 && qn == 1) { f32x16 zz; float z0 = 0.f; asm volatile("" : "+v"(z0));
#pragma unroll
              for (int r = 0; r < 16; ++r) zz[r] = z0;
              store_quad(T5, l31, 32, hi, zz); } }
        WG_BARL();
        { LANE_VARS;
          if (qm == 1 && qn == 0) {
              f32x16 t21;
#pragma unroll
              for (int r = 0; r < 16; ++r) t21[r] = 0.f;
#pragma unroll
              for (int ks = 0; ks < 2; ++ks) t21 = MFMA32(frag_tr(T4, 32, ks, lane), frag_row(T5, 32 + l31, 2 + ks, hi), t21);
              store_quad(T5, 32 + l31, 0, hi, t21); } }
        WG_BARL();
        R16 vr3[2];
        { LANE_VARS; const int tt = (wave_ * 64 + lane) & 255, s = tt >> 2, cg4 = (tt & 3) * 16, sn_ = d ? 63 - s : s, t = t0 + sn_, row = b * SEQ + t;
          vr3[0] = ld3x16(Vr, 512, hc + cg4, row, t); vr3[1] = ld3x16(Vr, 512, hc + cg4 + 8, row, t); }
        { LANE_VARS; f32x16 kp, tk;
#pragma unroll
          for (int r = 0; r < 16; ++r) { kp[r] = 0.f; tk[r] = 0.f; }
          { bf16x8 f0[4], f1[4], f2[4]; LD4_ROW(f0, T5, mrow); LD4_TR(f1, T0, n0); LD4_TR(f2, T6, n0); SBAR0();
#pragma unroll
            for (int ks = 0; ks < 4; ++ks) { kp = MFMA32(f1[ks], f0[ks], kp); tk = MFMA32(f2[ks], f0[ks], tk); } }
          WG_BARL();
          store_quad(T0, mrow, n0, hi, kp); store_quad(T6, mrow, n0, hi, tk); }
        { LANE_VARS; f32x16 rb;
#pragma unroll
          for (int r = 0; r < 16; ++r) rb[r] = 0.f;
          { bf16x8 f0[4], f1[4]; LD4_ROW(f0, T2, n0 + l31); LD4_ROW(f1, T1, mrow); SBAR0();
#pragma unroll
            for (int ks = 0; ks < 4; ++ks) rb = MFMA32(f0[ks], f1[ks], rb); }
#pragma unroll
          for (int q = 0; q < 4; ++q)
#pragma unroll
              for (int i = 0; i < 4; ++i) { const int e = 4 * q + i, n = n0 + 8 * q + 4 * hi + i; rb[e] = (n <= mrow) ? rb[e] : 0.f; }
          store_quad(T4, mrow, n0, hi, rb); }
        WG_BARL();
        const int cd = d ? 63 - cn : cn;
        bf16* const pre = (bf16*)(ws + R_PRE) + ((size_t)(((b * 8 + h) * 2 + d) * 64 + cd)) * 16384;
        { LANE_VARS; f32x16 rp, ml, pm, kq;
#pragma unroll
          for (int r = 0; r < 16; ++r) { rp[r] = 0.f; ml[r] = 0.f; pm[r] = 0.f; kq[r] = 0.f; }
#pragma unroll
          for (int kh = 0; kh < 2; ++kh) { bf16x8 mrbf[2], khn[2], bcn[2], tkn[2], bcm[2], tkm[2];
#pragma unroll
              for (int k2 = 0; k2 < 2; ++k2) { const int ks = 2 * kh + k2; mrbf[k2] = frag_row(T4, mrow, ks, hi); khn[k2] = frag_tr(T0, n0, ks, lane); bcn[k2] = frag_tr(T2, n0, ks, lane); tkn[k2] = frag_tr(T6, n0, ks, lane); bcm[k2] = frag_tr(T2, m0, ks, lane); tkm[k2] = frag_tr(T6, m0, ks, lane); }
              SBAR0();
#pragma unroll
              for (int k2 = 0; k2 < 2; ++k2) { rp = MFMA32(khn[k2], mrbf[k2], rp); ml = MFMA32(tkn[k2], mrbf[k2], ml); pm = MFMA32(khn[k2], bcm[k2], pm); kq = MFMA32(bcn[k2], tkm[k2], kq); }
              SBAR0(); }
          const float gm = gcs[mrow];
#pragma unroll
          for (int q = 0; q < 4; ++q)
#pragma unroll
              for (int i = 0; i < 4; ++i) { const int e = 4 * q + i, n = n0 + 8 * q + 4 * hi + i;
                  rp[e] = rh[e] - rp[e]; ml[e] = mrk[e] - ml[e]; pm[e] = gm * (((n == mrow) ? 1.0f : 0.f) - pm[e]); kq[e] = (kc[e] - kq[e]) * gcs[n]; }
#pragma unroll
          for (int q = 0; q < 4; ++q) { const int pc = n0 + 16 * (q >> 1) + 8 * hi + 4 * (q & 1);
              u32x2_t w; w.x = cvtpk_h(pm[4 * q], pm[4 * q + 1]); w.y = cvtpk_h(pm[4 * q + 2], pm[4 * q + 3]); *(u32x2_t*)(pre + mrow * 64 + pc) = w;
              w.x = cvtpk_h(rp[4 * q], rp[4 * q + 1]); w.y = cvtpk_h(rp[4 * q + 2], rp[4 * q + 3]); *(u32x2_t*)(pre + 4096 + (d ? 63 - mrow : mrow) * 64 + pc) = w; }
          WG_BARL();
          store_quad_h(T4, mrow, n0, hi, ml); store_quad_h(T5, mrow, n0, hi, kq); }
        { LANE_VARS; const int tt = (wave_ * 64 + lane) & 255, s = tt >> 2, cg4 = (tt & 3) * 16; float v8[8];
#pragma unroll
          for (int hlf = 0; hlf < 2; ++hlf) { const int c8 = cg4 + 8 * hlf;
              sh8(vr3[hlf], ct + CT_SPV + c8, ct + CT_SNV + c8, v8);
              v4u w; w.x = cvtpk_h(v8[0], v8[1]); w.y = cvtpk_h(v8[2], v8[3]); w.z = cvtpk_h(v8[4], v8[5]); w.w = cvtpk_h(v8[6], v8[7]); *(LAS v4u*)(T1 + s * TSB + 2 * c8) = w; } }
        WG_BARL();
        { LANE_VARS; f32x16 qt, yt;
#pragma unroll
          for (int r = 0; r < 16; ++r) { qt[r] = 0.f; yt[r] = 0.f; }
          { bf16x8 f0[4], f1[4], f2[4], f3[4]; LD4_TR(f0, T1, m0); LD4_TR(f1, T5, n0); LD4_TR(f2, T1, n0); LD4_ROW(f3, T4, mrow); SBAR0();
#pragma unroll
            for (int ks = 0; ks < 4; ++ks) { qt = MFMA32H(f1[ks], f0[ks], qt); yt = MFMA32H(f2[ks], f3[ks], yt); } }
          v4u w0_, w1_;
          w0_.x = cvtpk_h(qt[0], qt[1]); w0_.y = cvtpk_h(qt[2], qt[3]); w0_.z = cvtpk_h(qt[4], qt[5]); w0_.w = cvtpk_h(qt[6], qt[7]); w1_.x = cvtpk_h(qt[8], qt[9]); w1_.y = cvtpk_h(qt[10], qt[11]); w1_.z = cvtpk_h(qt[12], qt[13]); w1_.w = cvtpk_h(qt[14], qt[15]);
          { bf16* dst = pre + 8192 + ((qn * 64 + mrow) * 2 + hi) * 16; *(v4u*)dst = w0_; *(v4u*)(dst + 8) = w1_; }
          w0_.x = cvtpk_h(yt[0], yt[1]); w0_.y = cvtpk_h(yt[2], yt[3]); w0_.z = cvtpk_h(yt[4], yt[5]); w0_.w = cvtpk_h(yt[6], yt[7]); w1_.x = cvtpk_h(yt[8], yt[9]); w1_.y = cvtpk_h(yt[10], yt[11]); w1_.z = cvtpk_h(yt[12], yt[13]); w1_.w = cvtpk_h(yt[14], yt[15]);
          { bf16* dst = pre + 12288 + ((qn * 64 + (d ? 63 - mrow : mrow)) * 2 + hi) * 16; *(v4u*)dst = w0_; *(v4u*)(dst + 8) = w1_; } }
        WG_BARL();
    }
#undef LANE_VARS
#undef SNAT
}

constexpr int SCAN_SLOT = 12 * 1024, SCAN_NS = 4;
__device__ __forceinline__ void scan_issue(const bf16* pre, LAS unsigned char* slot, int l31, int hi, int v) {
#pragma unroll
    for (int i = 0; i < 8; ++i) { const int mt = i >> 2, kt = (i >> 1) & 1, s = i & 1;
        __builtin_amdgcn_global_load_lds((const unsigned*)(pre + (32 * mt + l31) * 64 + 32 * kt + 16 * s + 8 * hi), (LAS unsigned*)(slot + i * 1024), 16, 0, 0); }
#pragma unroll
    for (int i = 0; i < 4; ++i) { const int mt = i >> 1, hf = i & 1;
        __builtin_amdgcn_global_load_lds((const unsigned*)(pre + 8192 + ((mt * 64 + v) * 2 + hi) * 16 + 8 * hf), (LAS unsigned*)(slot + (8 + i) * 1024), 16, 0, 0); }
}
__device__ __forceinline__ void rwkv_scan_chunk(Frame& F, int unit) {
    unsigned char* const ws = kws();
    int lane_ = lane_id(); asm volatile("" : "+v"(lane_));
    const int lane = lane_, hi = lane >> 5, l31 = lane & 31;
    const int chain = unit >> 1, vh = unit & 1, v = 32 * vh + l31;
    const bf16* pre = (const bf16*)(ws + R_PRE) + (size_t)chain * 64 * 16384;
    bf16* sd = (bf16*)(ws + R_SD) + (size_t)chain * 64 * 4096;
    LAS unsigned char* const ring = F.lds;
    f32x16 X0, X1;
#pragma unroll
    for (int r = 0; r < 16; ++r) { X0[r] = 0.f; X1[r] = 0.f; }
    scan_issue(pre, ring, l31, hi, v); scan_issue(pre + 16384, ring + SCAN_SLOT, l31, hi, v); scan_issue(pre + 2 * 16384, ring + 2 * SCAN_SLOT, l31, hi, v);
#pragma unroll 1
    for (int c = 0; c < 64; ++c) {
        bf16x8 xb[2][2], xl[2][2];
#pragma unroll
        for (int kt = 0; kt < 2; ++kt)
#pragma unroll
            for (int s = 0; s < 2; ++s) { v4u w, wl;
#pragma unroll
                for (int j = 0; j < 4; ++j) { const float a0 = kt ? X1[8 * s + 2 * j] : X0[8 * s + 2 * j], a1 = kt ? X1[8 * s + 2 * j + 1] : X0[8 * s + 2 * j + 1];
                    const unsigned hw = cvtpk_h(a0, a1); const f32x2_t hf = unpk_h(hw); w[j] = hw; wl[j] = cvtpk_h(a0 - hf.x, a1 - hf.y); }
                xb[kt][s] = __builtin_bit_cast(bf16x8, w); xl[kt][s] = __builtin_bit_cast(bf16x8, wl);
                *(v4u*)(sd + (size_t)c * 4096 + ((kt * 64 + v) * 2 + hi) * 16 + 8 * s) = w; }
        asm volatile("s_waitcnt lgkmcnt(0)" ::: "memory");
        if (c + 3 < 64) scan_issue(pre + (size_t)(c + 3) * 16384, ring + ((c + 3) & 3) * SCAN_SLOT, l31, hi, v);
        if (c + 3 < 64) asm volatile("s_waitcnt vmcnt(36)" ::: "memory"); else asm volatile("s_waitcnt vmcnt(0)" ::: "memory");
        const LAS unsigned char* sl = ring + (c & 3) * SCAN_SLOT + lane * 16;
        f32x16 acc[2];
#pragma unroll
        for (int mt = 0; mt < 2; ++mt) { const v4u w0_ = *(const LAS v4u*)(sl + (8 + 2 * mt) * 1024), w1_ = *(const LAS v4u*)(sl + (9 + 2 * mt) * 1024);
#pragma unroll
            for (int j = 0; j < 4; ++j) { const f32x2_t u0 = unpk_h(w0_[j]), u1 = unpk_h(w1_[j]); acc[mt][2 * j] = u0.x; acc[mt][2 * j + 1] = u0.y; acc[mt][8 + 2 * j] = u1.x; acc[mt][8 + 2 * j + 1] = u1.y; } }
        bf16x8 pf[8];
#pragma unroll
        for (int i = 0; i < 8; ++i) pf[i] = *(const LAS bf16x8*)(sl + i * 1024);
        SBAR0();
#pragma unroll
        for (int mt = 0; mt < 2; ++mt)
#pragma unroll
            for (int kt = 0; kt < 2; ++kt)
#pragma unroll
                for (int s = 0; s < 2; ++s) { const bf16x8 af = pf[4 * mt + 2 * kt + s]; acc[mt] = MFMA32H(af, xb[kt][s], acc[mt]); acc[mt] = MFMA32H(af, xl[kt][s], acc[mt]); }
        X0 = acc[0]; X1 = acc[1];
    }
}

constexpr int FIN_SGS = 272;
__device__ __forceinline__ void rwkv_finalize_mfma(Frame& F, int layer) {
    unsigned char* const ws = kws();
    int lane_ = lane_id(); asm volatile("" : "+v"(lane_)); int wave_o = F.wv; asm volatile("" : "+s"(wave_o)); const int wave_ = wave_o, lane = lane_, hi = lane >> 5, l31 = lane & 31, h = wave_, hc = h * HD;
    LAS unsigned char* const sgt = F.lds;
    const bf16* Vr = (const bf16*)(ws + R_VR); const bf16* XL = (const bf16*)(ws + R_XL); bf16* MIX = (bf16*)(ws + R_MIX); const bf16* G2T = (const bf16*)(ws + WS_G2T);
    const float* BN0 = (const float*)(ws + R_BN); const float* BN1 = BN0 + (size_t)M * 8;
    const float* sp = karg(I_TSP) + layer * RPROJ; const float* sn = karg(I_TSN) + layer * RPROJ;
    const float* gnw = karg(I_GNW) + layer * 512 + hc; const float* gnb = karg(I_GNB) + layer * 512 + hc;
    for (int unit = F.vcu; unit < BATCH * (SEQ / 64); unit += F.G) {
        const int cn = unit & 63, b = unit >> 6, t0 = cn * 64;
        { const int tid = wave_ * 64 + lane, tok = tid >> 3, oct = tid & 7, t = t0 + tok, row = b * SEQ + t; float v8[8];
#pragma unroll
          for (int hf = 0; hf < 2; ++hf) { const int k0 = 16 * oct + 8 * hf;
              shift8(XL, 256, 128 + k0, row, t, sp + 1664 + k0, sn + 1664 + k0, v8);
              v4u w; w.x = cvtpk(sigmoidf_(v8[0]), sigmoidf_(v8[1])); w.y = cvtpk(sigmoidf_(v8[2]), sigmoidf_(v8[3])); w.z = cvtpk(sigmoidf_(v8[4]), sigmoidf_(v8[5])); w.w = cvtpk(sigmoidf_(v8[6]), sigmoidf_(v8[7]));
              *(LAS v4u*)(sgt + tok * FIN_SGS + 2 * k0) = w; } }
        WG_BAR();
        f32x16 acc[2][2], gg[2][2];
#pragma unroll
        for (int tt = 0; tt < 2; ++tt)
#pragma unroll
            for (int vt = 0; vt < 2; ++vt)
#pragma unroll
                for (int r = 0; r < 16; ++r) { acc[tt][vt][r] = 0.f; gg[tt][vt][r] = 0.f; }
#pragma unroll
        for (int d = 0; d < 2; ++d) { const size_t item = (size_t)(((b * 8 + h) * 2 + d) * 64 + (d ? 63 - cn : cn));
            const bf16* pre = (const bf16*)(ws + R_PRE) + item * 16384; const bf16* sd = (const bf16*)(ws + R_SD) + item * 4096;
#pragma unroll
            for (int tt = 0; tt < 2; ++tt)
#pragma unroll
                for (int vt = 0; vt < 2; ++vt) { const bf16* src = pre + 12288 + ((vt * 64 + 32 * tt + l31) * 2 + hi) * 16; const v4u w0_ = *(const v4u*)src, w1_ = *(const v4u*)(src + 8);
#pragma unroll
                    for (int j = 0; j < 4; ++j) { const f32x2_t u0 = unpk_h(w0_[j]), u1 = unpk_h(w1_[j]); acc[tt][vt][2 * j] += u0.x; acc[tt][vt][2 * j + 1] += u0.y; acc[tt][vt][8 + 2 * j] += u1.x; acc[tt][vt][8 + 2 * j + 1] += u1.y; } }
            bf16x8 sf[4][2], rf[4][2];
#pragma unroll
            for (int ks = 0; ks < 4; ++ks) { const int kt = ks >> 1, s = ks & 1;
#pragma unroll
                for (int vt = 0; vt < 2; ++vt) sf[ks][vt] = *(const bf16x8*)(sd + ((kt * 64 + 32 * vt + l31) * 2 + hi) * 16 + 8 * s);
#pragma unroll
                for (int tt = 0; tt < 2; ++tt) rf[ks][tt] = *(const bf16x8*)(pre + 4096 + (32 * tt + l31) * 64 + 32 * kt + 16 * s + 8 * hi); }
            SBAR0();
#pragma unroll
            for (int ks = 0; ks < 4; ++ks)
#pragma unroll
                for (int tt = 0; tt < 2; ++tt)
#pragma unroll
                    for (int vt = 0; vt < 2; ++vt) acc[tt][vt] = MFMA32H(sf[ks][vt], rf[ks][tt], acc[tt][vt]); }
#pragma unroll
        for (int kh = 0; kh < 2; ++kh) { bf16x8 gf[4][2], tf[4][2];
#pragma unroll
            for (int k4 = 0; k4 < 4; ++k4) { const int ks = 4 * kh + k4;
#pragma unroll
                for (int vt = 0; vt < 2; ++vt) gf[k4][vt] = *(const bf16x8*)(G2T + (size_t)(hc + 32 * vt + l31) * 128 + 16 * ks + 8 * hi);
#pragma unroll
                for (int tt = 0; tt < 2; ++tt) tf[k4][tt] = *(const LAS bf16x8*)(sgt + (32 * tt + l31) * FIN_SGS + (16 * ks + 8 * hi) * 2); }
            SBAR0();
#pragma unroll
            for (int k4 = 0; k4 < 4; ++k4)
#pragma unroll
                for (int tt = 0; tt < 2; ++tt)
#pragma unroll
                    for (int vt = 0; vt < 2; ++vt) gg[tt][vt] = MFMA32(gf[k4][vt], tf[k4][tt], gg[tt][vt]);
            SBAR0(); }
#pragma unroll
        for (int tt = 0; tt < 2; ++tt) { const int t = t0 + 32 * tt + l31, row = b * SEQ + t;
            float sm = 0.f;
#pragma unroll
            for (int vt = 0; vt < 2; ++vt)
#pragma unroll
                for (int r = 0; r < 16; ++r) sm += acc[tt][vt][r];
            sm += pg8::shx(sm, 32, lane); const float mu = sm * (1.0f / 64.0f); float sq = 0.f;
#pragma unroll
            for (int vt = 0; vt < 2; ++vt)
#pragma unroll
                for (int r = 0; r < 16; ++r) { const float dl = acc[tt][vt][r] - mu; sq += dl * dl; }
            sq += pg8::shx(sq, 32, lane); const float rstd = 1.0f / sqrtf(sq * (1.0f / 64.0f) + GN_EPS);
            const float bon = BN0[(size_t)row * 8 + h] + BN1[(size_t)row * 8 + h];
#pragma unroll
            for (int vt = 0; vt < 2; ++vt)
#pragma unroll
                for (int q = 0; q < 4; ++q) { const int v0 = 32 * vt + 8 * q + 4 * hi;
                    const f32x4 vs = shift4(Vr, 512, hc + v0, row, t, sp + 1024 + hc + v0, sn + 1024 + hc + v0), w4 = *(const f32x4*)(gnw + v0), b4 = *(const f32x4*)(gnb + v0);
                    float o4[4];
#pragma unroll
                    for (int i = 0; i < 4; ++i) o4[i] = ((acc[tt][vt][4 * q + i] - mu) * rstd * w4[i] + b4[i] + bon * vs[i]) * gg[tt][vt][4 * q + i];
                    u32x2_t w; w.x = cvtpk(o4[0], o4[1]); w.y = cvtpk(o4[2], o4[3]); *(u32x2_t*)(MIX + (size_t)row * 1024 + 512 + hc + v0) = w; } }
        WG_BAR();
    }
}

constexpr int ATT_O = 0, ATT_L = 65536, ATT_V = 67584, ATT_VT = 32 * TSB;
static_assert(ATT_V + NWAVES * ATT_VT <= LDSCTL_OFF, "attention LDS map");
__device__ __forceinline__ bf16x8 frag_tr_pv(const LAS unsigned char* tile, int d0, int s, int lane) {
    const int hi = lane >> 5, g1 = (lane >> 4) & 1, i = lane & 15;
    const LAS unsigned char* p = tile + (16 * s + 4 * hi + (i >> 2)) * TSB + (d0 + 16 * g1 + 4 * (i & 3)) * 2;
    const s16x4 lo = tr4(p), h4 = tr4(p + 8 * TSB);
    return (bf16x8){lo[0], lo[1], lo[2], lo[3], h4[0], h4[1], h4[2], h4[3]};
}
template <int NQH>
__device__ __forceinline__ void attn_block(const bf16* MIX, const bf16* V, LAS unsigned char* lds, LAS unsigned char* vt, int b, int h, int T0, int tq0, int d, float slope_d, float bound, bool first, int lane_in) {
    int lane = lane_in; asm volatile("" : "+v"(lane));
    const int hi = lane >> 5, l31 = lane & 31;
    const int jlo = -(tq0 / d), jhi = (SEQ - 1 - tq0) / d;
    bf16x8 qf[NQH][4];
#pragma unroll
    for (int qh = 0; qh < NQH; ++qh) { const bf16* qp = MIX + ((size_t)b * SEQ + tq0 + d * (32 * qh + l31)) * 1024 + h * HD + 8 * hi;
#pragma unroll
        for (int ks = 0; ks < 4; ++ks) qf[qh][ks] = *(const bf16x8*)(qp + 16 * ks); }
    f32x16 o[NQH][2]; float lsum[NQH];
#pragma unroll
    for (int qh = 0; qh < NQH; ++qh) { lsum[qh] = 0.f;
#pragma unroll
        for (int r = 0; r < 16; ++r) { o[qh][0][r] = 0.f; o[qh][1][r] = 0.f; } }
    constexpr int NT = NQH == 2 ? 6 : 5;
    v4u vraw[4]; bf16x8 kn[4];
#define ATT_LOAD(JT) do { { const int kr_ = lane >> 1, hf_ = lane & 1; int pos_ = tq0 + d * (32 * (JT) + kr_ - 64); pos_ = pos_ < 0 ? 0 : (pos_ > SEQ - 1 ? SEQ - 1 : pos_); \
          const v4u* src_ = (const v4u*)(V + ((size_t)b * SEQ + pos_) * 512 + h * HD + 32 * hf_); vraw[0] = src_[0]; vraw[1] = src_[1]; vraw[2] = src_[2]; vraw[3] = src_[3]; } \
        { int pos_ = tq0 + d * (32 * (JT) + l31 - 64); pos_ = pos_ < 0 ? 0 : (pos_ > SEQ - 1 ? SEQ - 1 : pos_); const bf16* kp_ = MIX + ((size_t)b * SEQ + pos_) * 1024 + 512 + h * HD + 8 * hi; \
          _Pragma("unroll") for (int ks = 0; ks < 4; ++ks) kn[ks] = *(const bf16x8*)(kp_ + 16 * ks); } } while (0)
    ATT_LOAD(0);
#pragma unroll 1
    for (int jt = 0; jt < NT; ++jt) {
        bf16x8 kf[4];
        { LAS v4u* dst = (LAS v4u*)(vt + (lane >> 1) * TSB + 64 * (lane & 1)); dst[0] = vraw[0]; dst[1] = vraw[1]; dst[2] = vraw[2]; dst[3] = vraw[3]; }
#pragma unroll
        for (int ks = 0; ks < 4; ++ks) kf[ks] = kn[ks];
        if (jt + 1 < NT) ATT_LOAD(jt + 1);
        asm volatile("s_waitcnt lgkmcnt(0)" ::: "memory");
        bf16x8 vfr[2][2];
#pragma unroll
        for (int dt = 0; dt < 2; ++dt)
#pragma unroll
            for (int s2 = 0; s2 < 2; ++s2) vfr[dt][s2] = frag_tr_pv(vt, 32 * dt, s2, lane);
        const bool inseq = (32 * jt - 64 >= jlo) && (32 * jt - 33 <= jhi);
#pragma unroll
        for (int qh = 0; qh < NQH; ++qh) {
            if (NQH == 2 && ((qh == 0 && jt == 5) || (qh == 1 && jt == 0))) continue;
            f32x16 s;
#pragma unroll
            for (int r = 0; r < 16; ++r) s[r] = 0.f;
#pragma unroll
            for (int ks = 0; ks < 4; ++ks) s = MFMA32(kf[ks], qf[qh][ks], s);
            const int base = 32 * qh + l31 - (32 * jt + 4 * hi - 64);
            const bool full = inseq && (jt >= 1 + qh) && (jt <= 3 + qh);
            v4u pk[2];
            if (full) {
#pragma unroll
                for (int r = 0; r < 16; r += 2) { float p2[2];
#pragma unroll
                    for (int e = 0; e < 2; ++e) { const int rr = r + e, dl = base - ((rr & 3) + 8 * (rr >> 2)), ad = dl < 0 ? -dl : dl;
                        p2[e] = __expf(s[rr] - slope_d * (float)ad - bound); lsum[qh] += p2[e]; }
                    pk[r >> 3][(r >> 1) & 3] = cvtpk(p2[0], p2[1]); }
            } else {
#pragma unroll
                for (int r = 0; r < 16; r += 2) { float p2[2];
#pragma unroll
                    for (int e = 0; e < 2; ++e) { const int rr = r + e, cr = (rr & 3) + 8 * (rr >> 2), jj = 32 * jt + cr + 4 * hi - 64, dl = base - cr, ad = dl < 0 ? -dl : dl;
                        const bool valid = (ad <= 64) && (jj >= jlo) && (jj <= jhi);
                        p2[e] = valid ? __expf(s[rr] - slope_d * (float)ad - bound) : 0.f; lsum[qh] += p2[e]; }
                    pk[r >> 3][(r >> 1) & 3] = cvtpk(p2[0], p2[1]); }
            }
#pragma unroll
            for (int dt = 0; dt < 2; ++dt)
#pragma unroll
                for (int s2 = 0; s2 < 2; ++s2) o[qh][dt] = MFMA32(vfr[dt][s2], __builtin_bit_cast(bf16x8, pk[s2]), o[qh][dt]);
        }
    }
#undef ATT_LOAD
    int lane2 = lane; asm volatile("" : "+v"(lane2));
#pragma unroll
    for (int qh = 0; qh < NQH; ++qh) { const int hi = lane2 >> 5, l31 = lane2 & 31, lane = lane2;
        const int qi = (tq0 - T0) + d * (32 * qh + l31);
        const float lt = lsum[qh] + pg8::shx(lsum[qh], 32, lane);
        if (hi == 0) { LAS float* lp = (LAS float*)(lds + ATT_L) + qi; *lp = first ? lt : (*lp + lt); }
#pragma unroll
        for (int dt = 0; dt < 2; ++dt)
#pragma unroll
            for (int q = 0; q < 4; ++q) { const int d0 = 32 * dt + 8 * q + 4 * hi; LAS u32x2_t* op = (LAS u32x2_t*)(lds + ATT_O + qi * 128 + ((((d0 >> 3) ^ (qi & 7)) << 4) | ((d0 & 4) << 1)));
                float v0 = o[qh][dt][4 * q], v1 = o[qh][dt][4 * q + 1], v2 = o[qh][dt][4 * q + 2], v3 = o[qh][dt][4 * q + 3];
                if (!first) { const u32x2_t w = *op; v0 += __uint_as_float(w.x << 16); v1 += __uint_as_float(w.x & 0xffff0000u); v2 += __uint_as_float(w.y << 16); v3 += __uint_as_float(w.y & 0xffff0000u); }
                u32x2_t w; w.x = cvtpk(v0, v1); w.y = cvtpk(v2, v3); *op = w; }
    }
}
__device__ __forceinline__ void attn_phase_mfma(Frame& F, int layer, int unit0, int nunit, int ustride) {
    unsigned char* const ws = kws();
    int lane_ = lane_id(); asm volatile("" : "+v"(lane_)); int wave_o = F.wv; asm volatile("" : "+s"(wave_o)); const int wave_ = wave_o, lane = lane_;
    bf16* MIX = (bf16*)(ws + R_MIX); const bf16* V = (const bf16*)(ws + R_V);
    LAS unsigned char* const lds = F.lds; LAS unsigned char* const vt = lds + ATT_V + wave_ * ATT_VT;
    float bound;
    { const float* qg = karg(I_QG) + layer * HD; const float* kg = karg(I_KG) + layer * HD; float mq = 0.f, mk = 0.f;
      for (int i = 0; i < HD; ++i) { mq = fmaxf(mq, fabsf(qg[i])); mk = fmaxf(mk, fabsf(kg[i])); }
      bound = 8.0f * mq * mk + 0.25f; }
    for (int unit = unit0; unit < nunit; unit += ustride) {
        const int st = unit & 7, h = (unit >> 3) & 7, b = unit >> 6, T0 = st * 512;
        const float slope = exp2f(-(float)(h + 1));
        attn_block<2>(MIX, V, lds, vt, b, h, T0, T0 + 64 * wave_, 1, slope, bound, true, lane);
        WG_BAR();
        attn_block<2>(MIX, V, lds, vt, b, h, T0, T0 + (wave_ & 3) + 256 * (wave_ >> 2), 4, slope * 4.f, bound, false, lane);
        WG_BAR();
        attn_block<1>(MIX, V, lds, vt, b, h, T0, T0 + 2 * wave_, 16, slope * 16.f, bound, false, lane);
        attn_block<1>(MIX, V, lds, vt, b, h, T0, T0 + 2 * wave_ + 1, 16, slope * 16.f, bound, false, lane);
        WG_BAR();
        { int lane3 = lane; asm volatile("" : "+v"(lane3)); const int tid = wave_ * 64 + lane3;
#pragma unroll
          for (int k = 0; k < 8; ++k) { const int item = tid + 512 * k, qi = item >> 3, c16 = item & 7;
              const v4u w = *(const LAS v4u*)(lds + ATT_O + qi * 128 + ((c16 ^ (qi & 7)) << 4)); const float il = 1.0f / ((const LAS float*)(lds + ATT_L))[qi];
              v4u o;
#pragma unroll
              for (int j = 0; j < 4; ++j) o[j] = cvtpk(__uint_as_float(w[j] << 16) * il, __uint_as_float(w[j] & 0xffff0000u) * il);
              *(v4u*)(MIX + ((size_t)b * SEQ + T0 + qi) * 1024 + h * HD + 8 * c16) = o; } }
        WG_BAR();
    }
}

__global__ void __launch_bounds__(NTHR, 2) mk_fwd(Args args) {
    extern __shared__ __attribute__((aligned(16))) unsigned char lds[];
    Frame F;
    F.lds = (LAS unsigned char*)lds;
    F.MISC = (volatile LAS unsigned*)(F.lds + MISC_OFF);
    F.wv = __builtin_amdgcn_readfirstlane((int)threadIdx.x >> 6);
    F.G = gridDim.x; { const int bx = blockIdx.x; F.vcu = (F.G % 8 == 0) ? (bx % 8) * (F.G / 8) + bx / 8 : bx; }
    F.ctl = (gu32*)(kws() + WS_CTL);
    for (int u = F.wv * 64 + lane_id(); u < (LDS_BYTES - LDSCTL_OFF) / 4; u += NTHR) ((LAS unsigned*)(F.lds + LDSCTL_OFF))[u] = 0u;
    __syncthreads();
    XcdBarrier bar = xcd_barrier_post((unsigned*)(F.ctl + CW_BAR), F.MISC + 8, F.wv == 0 && lane_id() == 0);
#define GRID_BAR() xcd_barrier(bar, F.wv == 0 && lane_id() == 0)
#define XB ((bf16*)(ws + R_XB))
#define MIXB ((bf16*)(ws + R_MIX))
#define HID ((bf16*)(ws + R_HID))
#define SS1 ((float*)(ws + WS_SS1))
#define SS2 ((float*)(ws + WS_SS2))

    for (int step = 0; step < 8 * DEPTH; ++step) {
        const int layer = step >> 3, kind = step & 7;
        if (kind == 0) {
            if (layer > 0) continue;
            x_prologue(F);
            { int lane_ = lane_id(); asm volatile("" : "+v"(lane_)); wconv_items(0, -1, F.vcu * NWAVES + F.wv, F.G * NWAVES, (LAS float*)(F.lds + RING_OFF + F.wv * 16384), lane_); }
        } else if (kind == 1) {
            unsigned char* const ws = kws();
            pg8::Gemm g{XB, (const bf16*)(ws + WS_WIN), M, NPROJ, D}; pg8::StaticOrder S; S.init(M, NPROJ, F.G, (int)blockIdx.x);
            pg8::EpiProj E; E.base0 = (bf16*)(ws + WS_R0); E.ss = SS1; E.qg = karg(I_QG) + layer * HD; E.kg = karg(I_KG) + layer * HD;
            pg8::gemm_phase<pg8::EpiProj, pg8::StaticOrder, true, true>(F.lds + RING_OFF, g, S, E, F.wv, lane_id());
        } else if (kind == 2) {
            rwkv_pre_phase(F, layer);
        } else if (kind == 3) {
            const int bx = (int)blockIdx.x;
            if (bx < 128) { if (F.wv == 0) rwkv_scan_chunk(F, bx);
                            else { int lane_ = lane_id(); asm volatile("" : "+v"(lane_)); wconv_items(layer + 1, layer, bx * 7 + F.wv - 1, 128 * 7, (LAS float*)(F.lds + SCAN_NS * SCAN_SLOT + (F.wv - 1) * 9216), lane_); } }
            else attn_phase_mfma(F, layer, bx - 128, BATCH * H * 8, F.G - 128);
        } else if (kind == 4) {
            rwkv_finalize_mfma(F, layer);
        } else if (kind == 5 || kind == 7) {
            unsigned char* const ws = kws(); float* const xo = kout();
            pg8::Gemm g{kind == 5 ? MIXB : HID, (const bf16*)(ws + (kind == 5 ? WS_WOUT : WS_WDN)), M, D, kind == 5 ? D : FF}; pg8::StaticOrder S; S.init(M, D, F.G, (int)blockIdx.x);
            pg8::EpiRes E{xo, XB, kind == 5 ? SS2 : SS1};
            pg8::gemm_phase<pg8::EpiRes, pg8::StaticOrder, false, true>(F.lds + RING_OFF, g, S, E, F.wv, lane_id());
        } else {
            unsigned char* const ws = kws();
            pg8::Gemm g{XB, (const bf16*)(ws + WS_WUP), M, FF, D}; pg8::StaticOrder S; S.init(M, FF, F.G, (int)blockIdx.x);
            pg8::EpiUp E{HID, SS2};
            pg8::gemm_phase<pg8::EpiUp, pg8::StaticOrder, true, true>(F.lds + RING_OFF, g, S, E, F.wv, lane_id());
        }
        if (step + 1 < 8 * DEPTH) GRID_BAR();
    }
}

extern "C" void kernel_launch(void* const* d_in, const int* in_sizes, int n_in, void* d_out, int out_size, void* d_ws, size_t ws_size, hipStream_t stream) {
    static int grid = 0;
    if (grid == 0) {
        if (n_in != N_IN || in_sizes[0] != M * D || out_size != M * D || ws_size < WS_END) { fprintf(stderr, "kernel_launch: unexpected shapes (n_in %d, in0 %d, out %d, ws %zu)\n", n_in, n_in > 0 ? in_sizes[0] : -1, out_size, ws_size); grid = -1; return; }
        int dev = 0, cus = 0;
        if (hipGetDevice(&dev) != hipSuccess || hipDeviceGetAttribute(&cus, hipDeviceAttributeMultiprocessorCount, dev) != hipSuccess) { grid = -1; return; }
        if (hipFuncSetAttribute((const void*)mk_fwd, hipFuncAttributeMaxDynamicSharedMemorySize, LDS_BYTES) != hipSuccess) { fprintf(stderr, "kernel_launch: hipFuncSetAttribute failed\n"); grid = -1; return; }
        int per_cu = 0;
        (void)hipOccupancyMaxActiveBlocksPerMultiprocessor(&per_cu, (const void*)mk_fwd, NTHR, LDS_BYTES);
        (void)hipGetLastError();
        grid = cus;
    }
    if (grid < 0) return;
    (void)hipMemsetAsync((char*)d_ws + WS_CTL, 0, CTL_ZERO_BYTES, stream);
    Args a{};
    for (int i = 0; i < N_IN; ++i) a.in[i] = (const float*)d_in[i];
    a.out = (float*)d_out; a.ws = (unsigned char*)d_ws;
    hipLaunchKernelGGL(mk_fwd, dim3(grid), dim3(NTHR), LDS_BYTES, stream, a);
}
```

```cpp
#include <hip/hip_runtime.h>
#include <cstdio>
#include <cstdint>
namespace pg8 {
#define PG8_LAS __attribute__((address_space(3)))
typedef unsigned short bf16_t;
typedef short bf16x8 __attribute__((ext_vector_type(8)));
typedef float f32x4 __attribute__((ext_vector_type(4)));
typedef unsigned u32x4 __attribute__((ext_vector_type(4)));
constexpr int BM = 256, BK = 64, HALF = 128, HTB = HALF * BK * 2  , STAGE_BYTES = 8 * HTB, NXCD = 8, WGM = 8;

__host__ __device__ __forceinline__ int lds_byte(int r, int c) { const int st = (r >> 4) * 2 + (c >> 5), rr = r & 15, cc = c & 31, ob = rr * 64 + cc * 2; return st * 1024 + (ob ^ (((ob >> 9) & 1) << 5)); }
__host__ __device__ __forceinline__ void stage_rc(int b, int& R, int& C) { const int st = b / 1024, sb = b % 1024, swz = sb ^ (((sb >> 9) & 1) << 5); R = (st >> 1) * 16 + swz / 64; C = (st & 1) * 32 + (swz % 64) / 2; }
__host__ __device__ __forceinline__ int perm32(int rho) { const int n = rho >> 4, i = rho & 15; return 8 * (i >> 2) + 4 * n + (i & 3); }

struct Unit { int pm, pn; };
struct Gemm { const bf16_t* A; const bf16_t* Bt; int M, N, K; };

struct StaticOrder {
    int nM, nN, nwg, G, c;
    __host__ __device__ void init(int M, int N, int G_, int c_) { nM = M / BM; nN = N / BM; nwg = nM * nN; G = G_; c = c_; }
    __host__ __device__ bool next(int i, Unit& u) const {
        const long L = (long)i * G + c; if (L >= nwg) return false;
        int wgid = (int)L; { const int q = nwg / NXCD, r = nwg % NXCD, xcd = wgid % NXCD, off = wgid / NXCD; wgid = (xcd < r ? xcd * (q + 1) : r * (q + 1) + (xcd - r) * q) + off; }
        const int nig = WGM * nN, gid = wgid / nig, fm = gid * WGM, gsz = (nM - fm) < WGM ? (nM - fm) : WGM;
        u.pm = fm + ((wgid % nig) % gsz); u.pn = (wgid % nig) / gsz; return true;
    }
    __device__ __forceinline__ void a_ready(const Unit&) const {}
    __device__ __forceinline__ void done(const Unit&) const {}
};

__device__ __forceinline__ unsigned cvt_pk_bf16(float lo, float hi) { unsigned r; asm volatile("v_cvt_pk_bf16_f32 %0, %1, %2" : "=v"(r) : "v"(lo), "v"(hi)); return r; }
typedef unsigned u32x2 __attribute__((ext_vector_type(2)));

__device__ __forceinline__ float shx(float v, int m, int lane) { return __int_as_float(__builtin_amdgcn_ds_bpermute((lane ^ m) << 2, __float_as_int(v))); }
__device__ __forceinline__ float row_rs(const float* ss, int row, int fq, int lane) {
    const f32x4 p = *(const f32x4*)(ss + (size_t)row * 16 + 4 * fq);
    float s = (p[0] + p[1]) + (p[2] + p[3]);
    s += shx(s, 16, lane); s += shx(s, 32, lane);
    return 1.0f / sqrtf(s * (1.0f / 1024.0f) + 1e-6f);
}

struct EpiProj {
    static constexpr bool PERM = true, AFTER_DRAIN = false;
    bf16_t* base0; const float* ss; const float* qg; const float* kg;
    __device__ __forceinline__ void operator()(const f32x4 (&acc)[2][2][4][2], const Unit& u, int wr, int wc, int fr, int fq) const {
        const int tile = u.pn, di = tile >> 1;
        bf16_t* base = base0 + (di < 2 ? (size_t)di * 512 : (size_t)di * (8u << 20)); const int ldc = (di < 2) ? 1024 : ((di == 6) ? 256 : 512); const int cb = (di == 6) ? 0 : (tile & 1) * 256;
        const bool nrm = tile < 4; const float* gsrc = (tile < 2) ? qg : kg; const float post = (tile < 2) ? 0.125f * 1.4426950408889634f : 1.0f;
        f32x4 g[2][2];
#pragma unroll
        for (int bj = 0; bj < 2; ++bj)
#pragma unroll
            for (int n = 0; n < 2; ++n) g[bj][n] = nrm ? *(const f32x4*)(gsrc + 32 * bj + 8 * fq + 4 * n) * post : (f32x4){1.f, 1.f, 1.f, 1.f};
#pragma unroll
        for (int ai = 0; ai < 2; ++ai)
#pragma unroll
            for (int m = 0; m < 4; ++m) {
                const int row = u.pm * BM + ai * HALF + wr * 64 + m * 16 + fr;
                const float rs = row_rs(ss, row, fq, 16 * fq + fr);
                f32x4 v[2][2]; float q = 0.f;
#pragma unroll
                for (int bj = 0; bj < 2; ++bj)
#pragma unroll
                    for (int n = 0; n < 2; ++n) { v[bj][n] = acc[ai][bj][m][n] * rs; const f32x4 t = v[bj][n]; q += (t[0] * t[0] + t[1] * t[1]) + (t[2] * t[2] + t[3] * t[3]); }
                q += shx(q, 16, 16 * fq + fr); q += shx(q, 32, 16 * fq + fr);
                const float inv = nrm ? 1.0f / sqrtf(q * (1.0f / 64.0f) + 1e-6f) : 1.0f;
                bf16_t* rowp = base + (size_t)row * ldc + cb + 64 * wc + 8 * fq;
#pragma unroll
                for (int bj = 0; bj < 2; ++bj) { const f32x4 v0 = v[bj][0] * inv * g[bj][0], v1 = v[bj][1] * inv * g[bj][1];
                    u32x4 w; w.x = cvt_pk_bf16(v0[0], v0[1]); w.y = cvt_pk_bf16(v0[2], v0[3]); w.z = cvt_pk_bf16(v1[0], v1[1]); w.w = cvt_pk_bf16(v1[2], v1[3]);
                    *(u32x4*)(rowp + 32 * bj) = w; }
                asm volatile("" ::: "memory");
            }
    }
};
struct EpiUp {
    static constexpr bool PERM = true, AFTER_DRAIN = false;
    bf16_t* O; const float* ss;
    __device__ __forceinline__ void operator()(const f32x4 (&acc)[2][2][4][2], const Unit& u, int wr, int wc, int fr, int fq) const {
#pragma unroll
        for (int ai = 0; ai < 2; ++ai)
#pragma unroll
            for (int m = 0; m < 4; ++m) {
                const int row = u.pm * BM + ai * HALF + wr * 64 + m * 16 + fr;
                const float rs = row_rs(ss, row, fq, 16 * fq + fr);
                bf16_t* rowp = O + (size_t)row * 4096 + u.pn * BM + wc * 32 + 8 * fq;
#pragma unroll
                for (int bj = 0; bj < 2; ++bj) { f32x4 v0 = acc[ai][bj][m][0] * rs, v1 = acc[ai][bj][m][1] * rs;
                    v0 = __builtin_elementwise_max(v0, (f32x4){0.f, 0.f, 0.f, 0.f}); v1 = __builtin_elementwise_max(v1, (f32x4){0.f, 0.f, 0.f, 0.f}); v0 = v0 * v0; v1 = v1 * v1;
                    u32x4 w; w.x = cvt_pk_bf16(v0[0], v0[1]); w.y = cvt_pk_bf16(v0[2], v0[3]); w.z = cvt_pk_bf16(v1[0], v1[1]); w.w = cvt_pk_bf16(v1[2], v1[3]);
                    *(u32x4*)(rowp + bj * HALF) = w; }
                asm volatile("" ::: "memory");
            }
    }
};
struct EpiRes {
    static constexpr bool PERM = false, AFTER_DRAIN = false;
    float* x; bf16_t* xb; float* ss;
    __device__ __forceinline__ void operator()(const f32x4 (&acc)[2][2][4][2], const Unit& u, int wr, int wc, int fr, int fq) const {
        const int col0 = u.pn * BM + wc * 32 + 4 * fq;
#pragma unroll
        for (int ai = 0; ai < 2; ++ai)
#pragma unroll
            for (int m = 0; m < 4; ++m) {
                const int row = u.pm * BM + ai * HALF + wr * 64 + m * 16 + fr; const size_t off = (size_t)row * 1024 + col0; float q = 0.f;
#pragma unroll
                for (int bj = 0; bj < 2; ++bj)
#pragma unroll
                    for (int n = 0; n < 2; ++n) { const size_t o = off + bj * HALF + n * 16; const f32x4 t = *(const f32x4*)(x + o) + acc[ai][bj][m][n];
                        *(f32x4*)(x + o) = t; u32x2 w; w.x = cvt_pk_bf16(t[0], t[1]); w.y = cvt_pk_bf16(t[2], t[3]); *(u32x2*)(xb + o) = w;
                        q += (t[0] * t[0] + t[1] * t[1]) + (t[2] * t[2] + t[3] * t[3]); }
                q += shx(q, 16, 16 * fq + fr); q += shx(q, 32, 16 * fq + fr);
                if (fq == 0) ss[(size_t)row * 16 + 4 * u.pn + wc] = q;
                asm volatile("" ::: "memory");
            }
    }
};

template <class Epi, class Sched, bool ALIGN_EPI = false, bool SP2 = false>
__device__ __forceinline__ void gemm_phase(PG8_LAS unsigned char* lds, const Gemm g, const Sched& S, const Epi& E, int wave_in, int lane_in) {
    int lane_o = lane_in, wave_o = wave_in; asm volatile("" : "+v"(lane_o)); asm volatile("" : "+s"(wave_o)); const int tid_ = wave_o * 64 + lane_o;
    const int tid = tid_, wid = wave_o, lane = lane_o, wr = wid >> 2, wc = wid & 3, fr = lane & 15, fq = lane >> 4;
    const int K = g.K, nt = K / BK;
    unsigned voffA[2], voffB[2];
#pragma unroll
    for (int i = 0; i < 2; ++i) { int R, C; stage_rc(tid * 16 + i * 8192, R, C); const int Rb = Epi::PERM ? ((R & ~31) + perm32(R & 31)) : R;
        voffA[i] = (unsigned)(R * K + C) * 2u; voffB[i] = (unsigned)(Rb * K + C) * 2u; }
    const size_t kstep = (size_t)(BK * 2);
    const size_t hstep = (size_t)HALF * K * 2;
    const size_t tstep = 2 * hstep;
    const unsigned ldsw = (unsigned)wid * 1024u;
    const int aoff = lds_byte(wr * 64 + fr, fq * 8), boff = lds_byte(wc * 32 + fr, fq * 8);
#define PG8_SA(b, h) (((b) * 2 + (h)) * HTB)
#define PG8_SB(b, h) ((4 + (b) * 2 + (h)) * HTB)
#define PG8_STAGE(bufoff, gbase, voff) do { _Pragma("unroll") for (int _i = 0; _i < 2; ++_i) \
        __builtin_amdgcn_global_load_lds((const unsigned*)((const char*)(gbase) + (voff)[_i]), (PG8_LAS unsigned*)(lds + (bufoff) + ldsw + _i * 8192), 16, 0, 0); } while (0)
#define PG8_LDA(dst, b, h) do { _Pragma("unroll") for (int m = 0; m < 4; ++m) _Pragma("unroll") for (int k = 0; k < 2; ++k) dst[m][k] = *(const PG8_LAS bf16x8*)(lds + PG8_SA(b, h) + aoff + m * 2048 + k * 1024); } while (0)
#define PG8_LDB(dst, b, h) do { _Pragma("unroll") for (int n = 0; n < 2; ++n) _Pragma("unroll") for (int k = 0; k < 2; ++k) dst[n][k] = *(const PG8_LAS bf16x8*)(lds + PG8_SB(b, h) + boff + n * 2048 + k * 1024); } while (0)
#define PG8_MMA(ai, bj, At, Bt) do { __builtin_amdgcn_s_setprio(1); _Pragma("unroll") for (int m = 0; m < 4; ++m) _Pragma("unroll") for (int n = 0; n < 2; ++n) _Pragma("unroll") for (int k = 0; k < 2; ++k) \
        acc[ai][bj][m][n] = __builtin_amdgcn_mfma_f32_16x16x32_bf16(Bt[n][k], At[m][k], acc[ai][bj][m][n], 0, 0, 0); __builtin_amdgcn_s_setprio(0); } while (0)
#define PG8_WAIT_V(n) asm volatile("s_waitcnt vmcnt(" #n ")" ::: "memory")
#define PG8_WAIT_L(n) asm volatile("s_waitcnt lgkmcnt(" #n ")" ::: "memory")
#define PG8_BAR __builtin_amdgcn_s_barrier()
#define PG8_SCHED __builtin_amdgcn_sched_barrier(0)
    Unit cur, nxt; int ui = 0;
    if (!S.next(0, cur)) return;
    f32x4 acc[2][2][4][2];
#pragma unroll
    for (int a = 0; a < 2; ++a)
#pragma unroll
        for (int b = 0; b < 2; ++b)
#pragma unroll
            for (int m = 0; m < 4; ++m)
#pragma unroll
                for (int n = 0; n < 2; ++n) acc[a][b][m][n] = (f32x4){0.f, 0.f, 0.f, 0.f};
    bf16x8 At[4][2], B0[2][2], B1[2][2];
    const char* cA = (const char*)g.A + (size_t)cur.pm * tstep; const char* cB = (const char*)g.Bt + (size_t)cur.pn * tstep;
    S.a_ready(cur);
    if constexpr (SP2) {
        PG8_STAGE(PG8_SB(0, 0), cB, voffB); PG8_STAGE(PG8_SB(0, 1), cB + hstep, voffB); PG8_STAGE(PG8_SA(0, 0), cA, voffA); PG8_STAGE(PG8_SA(0, 1), cA + hstep, voffA);
        if (wr == 1) PG8_BAR;
        PG8_WAIT_V(2); PG8_BAR;
        PG8_STAGE(PG8_SB(1, 0), cB + kstep, voffB); PG8_STAGE(PG8_SA(1, 0), cA + kstep, voffA); PG8_STAGE(PG8_SB(1, 1), cB + hstep + kstep, voffB);
        PG8_WAIT_V(6); PG8_BAR;
    } else {
        PG8_STAGE(PG8_SB(0, 0), cB, voffB); PG8_STAGE(PG8_SA(0, 0), cA, voffA); PG8_STAGE(PG8_SB(0, 1), cB + hstep, voffB); PG8_STAGE(PG8_SA(0, 1), cA + hstep, voffA);
        if (wr == 1) PG8_BAR;
        PG8_WAIT_V(4); PG8_BAR;
        PG8_STAGE(PG8_SB(1, 0), cB + kstep, voffB); PG8_STAGE(PG8_SA(1, 0), cA + kstep, voffA); PG8_STAGE(PG8_SB(1, 1), cB + hstep + kstep, voffB);
        PG8_WAIT_V(6); PG8_BAR;
    }
    for (;;) {
        const bool has_next = S.next(ui + 1, nxt);
        const char* nA = has_next ? (const char*)g.A + (size_t)nxt.pm * tstep : cA; const char* nB = has_next ? (const char*)g.Bt + (size_t)nxt.pn * tstep : cB;
        for (int t = 0; t < nt; t += 2) {
            const bool last = (t == nt - 2);
            const char* a1 = cA + (size_t)(t + 1) * kstep;
            const char* a2 = last ? nA : cA + (size_t)(t + 2) * kstep; const char* b2 = last ? nB : cB + (size_t)(t + 2) * kstep;
            const char* a3 = a2 + kstep; const char* b3 = b2 + kstep;
            if (last && has_next) S.a_ready(nxt);
            if constexpr (SP2) {
            PG8_LDB(B0, 0, 0); PG8_LDB(B1, 0, 1); PG8_SCHED; PG8_LDA(At, 0, 0); PG8_STAGE(PG8_SA(1, 1), a1 + hstep, voffA);
            PG8_WAIT_V(8); PG8_WAIT_L(0); PG8_BAR; PG8_MMA(0, 0, At, B0); PG8_MMA(0, 1, At, B1); PG8_BAR; PG8_SCHED;
            PG8_LDA(At, 0, 1); PG8_STAGE(PG8_SB(0, 0), b2, voffB); PG8_STAGE(PG8_SB(0, 1), b2 + hstep, voffB); PG8_STAGE(PG8_SA(0, 0), a2, voffA);
            PG8_WAIT_V(8); PG8_WAIT_L(0); PG8_BAR; PG8_MMA(1, 0, At, B0); PG8_MMA(1, 1, At, B1); PG8_BAR; PG8_SCHED;
            PG8_LDB(B0, 1, 0); PG8_LDB(B1, 1, 1); PG8_SCHED; PG8_LDA(At, 1, 0); PG8_STAGE(PG8_SA(0, 1), a2 + hstep, voffA);
            PG8_WAIT_V(8); PG8_WAIT_L(0); PG8_BAR; PG8_MMA(0, 0, At, B0); PG8_MMA(0, 1, At, B1); PG8_BAR; PG8_SCHED;
            PG8_LDA(At, 1, 1); PG8_STAGE(PG8_SB(1, 0), b3, voffB); PG8_STAGE(PG8_SB(1, 1), b3 + hstep, voffB); PG8_STAGE(PG8_SA(1, 0), a3, voffA);
            PG8_WAIT_V(8); PG8_WAIT_L(0); PG8_BAR; PG8_MMA(1, 0, At, B0); PG8_MMA(1, 1, At, B1); PG8_BAR; PG8_SCHED;
            } else {
            PG8_LDB(B0, 0, 0); PG8_SCHED; PG8_LDA(At, 0, 0); PG8_STAGE(PG8_SA(1, 1), a1 + hstep, voffA);
            PG8_WAIT_L(8); PG8_BAR; PG8_WAIT_L(0); PG8_MMA(0, 0, At, B0); PG8_BAR; PG8_SCHED;
            PG8_LDB(B1, 0, 1); PG8_STAGE(PG8_SB(0, 0), b2, voffB);
            PG8_BAR; PG8_WAIT_L(0); PG8_MMA(0, 1, At, B1); PG8_BAR;
            PG8_LDA(At, 0, 1); PG8_STAGE(PG8_SA(0, 0), a2, voffA);
            PG8_BAR; PG8_WAIT_L(0); PG8_MMA(1, 0, At, B0); PG8_BAR; PG8_SCHED;
            PG8_STAGE(PG8_SB(0, 1), b2 + hstep, voffB);
            PG8_WAIT_V(6); PG8_BAR; PG8_MMA(1, 1, At, B1); PG8_BAR;
            PG8_LDB(B0, 1, 0); PG8_SCHED; PG8_LDA(At, 1, 0); PG8_STAGE(PG8_SA(0, 1), a2 + hstep, voffA);
            PG8_WAIT_L(8); PG8_BAR; PG8_WAIT_L(0); PG8_MMA(0, 0, At, B0); PG8_BAR; PG8_SCHED;
            PG8_LDB(B1, 1, 1); PG8_STAGE(PG8_SB(1, 0), b3, voffB);
            PG8_BAR; PG8_WAIT_L(0); PG8_MMA(0, 1, At, B1); PG8_BAR;
            PG8_LDA(At, 1, 1); PG8_STAGE(PG8_SA(1, 0), a3, voffA);
            PG8_BAR; PG8_WAIT_L(0); PG8_MMA(1, 0, At, B0); PG8_BAR; PG8_SCHED;
            PG8_STAGE(PG8_SB(1, 1), b3 + hstep, voffB);
            PG8_WAIT_V(6); PG8_BAR; PG8_MMA(1, 1, At, B1); PG8_BAR;
            }
        }
        if constexpr (ALIGN_EPI) { if (wr == 0) PG8_BAR; }
        if constexpr (!Epi::AFTER_DRAIN) { E(acc, cur, wr, wc, fr, fq); S.done(cur); }
        if (!has_next) break;
#pragma unroll
        for (int a = 0; a < 2; ++a)
#pragma unroll
            for (int b = 0; b < 2; ++b)
#pragma unroll
                for (int m = 0; m < 4; ++m)
#pragma unroll
                    for (int n = 0; n < 2; ++n) acc[a][b][m][n] = (f32x4){0.f, 0.f, 0.f, 0.f};
        cur = nxt; cA = nA; cB = nB; ++ui;
        if constexpr (ALIGN_EPI) { if (wr == 1) PG8_BAR; }
    }
    PG8_WAIT_V(0);
    if constexpr (!ALIGN_EPI) { if (wr == 0) PG8_BAR; }
    PG8_BAR;
    if constexpr (Epi::AFTER_DRAIN) { E.fused(acc, cur, wr, wc, fr, fq, lds, wid, lane); S.done(cur); }
#undef PG8_SA
#undef PG8_SB
#undef PG8_STAGE
#undef PG8_LDA
#undef PG8_LDB
#undef PG8_MMA
#undef PG8_WAIT_V
#undef PG8_WAIT_L
#undef PG8_BAR
#undef PG8_SCHED
}
}
constexpr int NWAVES = 8, NTHR = 512;
constexpr int BATCH = 4, SEQ = 4096, D = 1024, DEPTH = 4, H = 8, HD = 64, FF = 4096, NPROJ = 3328, RPROJ = 1792;
constexpr int M = BATCH * SEQ;
constexpr float GN_EPS = 64e-5f;
enum { I_X = 0, I_LN1, I_WIN, I_QG, I_KG, I_TSP, I_TSN, I_W0, I_W2, I_A0, I_A2, I_G2, I_KK, I_KA, I_RK, I_GNW, I_GNB, I_WOUT, I_LN2, I_WUP, I_WDN, N_IN };
constexpr size_t MiB = 1u << 20;
constexpr size_t WS_CTL = 0, CTL_ZERO_BYTES = 64 * 1024;
constexpr size_t WS_SS1 = 1 * MiB, WS_SS2 = 2 * MiB;
constexpr size_t WS_WIN = 3 * MiB, WS_WOUT = WS_WIN + (size_t)NPROJ * D * 2, WS_WUP = WS_WOUT + (size_t)D * D * 2, WS_WDN = WS_WUP + (size_t)FF * D * 2;
constexpr size_t WS_R0 = 28 * MiB;
constexpr size_t R_MIX = WS_R0 + 0 * MiB;
constexpr size_t R_V = WS_R0 + 32 * MiB;
constexpr size_t R_RR = WS_R0 + 48 * MiB, R_KR = WS_R0 + 64 * MiB, R_VR = WS_R0 + 80 * MiB, R_XL = WS_R0 + 96 * MiB;
constexpr size_t R_SD = R_RR;
constexpr size_t R_PRE = WS_R0 + 104 * MiB;
constexpr size_t R_HID = WS_R0;
constexpr size_t R_XB = WS_R0 + 128 * MiB;
constexpr size_t R_BN = WS_R0 + 232 * MiB;
constexpr size_t WS_END = WS_R0 + 233 * MiB;
constexpr size_t WS_LORA = WS_WDN + (size_t)D * FF * 2;
constexpr size_t WS_G2T = WS_LORA + 4 * 512 * 64 * 2;
static_assert(WS_G2T + 512 * 128 * 2 <= WS_R0, "lora");
constexpr int CW_BAR = 1024;
constexpr int RING_OFF = 0, RING_BYTES = 131072;
constexpr int LDSCTL_OFF = 155648, MISC_OFF = LDSCTL_OFF + 320;
constexpr int LDS_BYTES = 163840;
#define GAS __attribute__((address_space(1)))
#define LAS __attribute__((address_space(3)))
typedef unsigned short bf16;
typedef unsigned v4u __attribute__((ext_vector_type(4)));
typedef float f32x4 __attribute__((ext_vector_type(4)));
typedef short bf16x8 __attribute__((ext_vector_type(8)));
typedef GAS unsigned gu32;
typedef GAS unsigned long long gu64;
#define RLX_AGENT __ATOMIC_RELAXED, __HIP_MEMORY_SCOPE_AGENT
#define LDS_WAIT() asm volatile("s_waitcnt lgkmcnt(0)" ::: "memory")
#define VM_WAIT() asm volatile("s_waitcnt vmcnt(0)" ::: "memory")
__device__ __forceinline__ unsigned long long rt() { return __builtin_amdgcn_s_memrealtime(); }
__device__ __forceinline__ unsigned f2bf(float f) { unsigned u = __builtin_bit_cast(unsigned, f); return (u + 0x7fffu + ((u >> 16) & 1u)) >> 16; }
__device__ __forceinline__ unsigned pk2(float lo, float hi) { return f2bf(lo) | (f2bf(hi) << 16); }

#define XB_TMO      128
#define XB_XCNT(j)  (256  + 64 * (j))
#define XB_XSUB(j)  (1280 + 64 * (j))
#define XB_XGEN(j)  (2304 + 64 * (j))
#define XB_TOP      3328
#define XB_TOPGEN   3392
#define XCD_BAR_WORDS 3456
#define XB_SPIN_CAP (1u << 18)

__device__ __forceinline__ unsigned xb_ld(unsigned* p)              { return __hip_atomic_load(p, __ATOMIC_RELAXED, __HIP_MEMORY_SCOPE_AGENT); }
__device__ __forceinline__ unsigned xb_add(unsigned* p, unsigned v) { return __hip_atomic_fetch_add(p, v, __ATOMIC_RELAXED, __HIP_MEMORY_SCOPE_AGENT); }
__device__ __forceinline__ unsigned xb_xcc_id() { return (unsigned)__builtin_amdgcn_s_getreg((3 << 11) | 20) & 0xFu; }
#define XB_SPIN(cond, bar) do { unsigned _sp = 0; while (cond) { __builtin_amdgcn_s_sleep(1); \
    if ((++_sp & 255u) == 0u) { if (xb_ld(&(bar)[XB_TMO])) break; if (_sp > XB_SPIN_CAP) { atomicAdd(&(bar)[XB_TMO], 1u); break; } } } } while (0)

struct XcdBarrier {
    unsigned* bar; unsigned x;
    volatile LAS unsigned* st;
};

__device__ __forceinline__ XcdBarrier xcd_barrier_post(unsigned* bar, volatile LAS unsigned* st, bool tid0) {
    XcdBarrier b; b.bar = bar; b.x = xb_xcc_id(); b.st = st;
    if (tid0) (void)xb_add(&bar[XB_XCNT(b.x)], 1u);
    return b;
}
__device__ __forceinline__ void xcd_barrier_complete(unsigned* bar, unsigned x, unsigned& nloc, unsigned& nx) {
    const unsigned G = gridDim.x * gridDim.y * gridDim.z;
    unsigned sum, cnt, mine, sp = 0u;
    for (;;) {
        sum = 0u; cnt = 0u; mine = 0u;
#pragma unroll
        for (unsigned j = 0; j < 16; ++j) { const unsigned c = xb_ld(&bar[XB_XCNT(j)]); sum += c; cnt += (c > 0u) ? 1u : 0u; mine = (j == x) ? c : mine; }
        if (sum == G) break;
        __builtin_amdgcn_s_sleep(1);
        if ((++sp & 255u) == 0u) { if (xb_ld(&bar[XB_TMO])) break; if (sp > XB_SPIN_CAP) { atomicAdd(&bar[XB_TMO], 1u); break; } }
    }
    nloc = mine > 0u ? mine : 1u; nx = cnt > 0u ? cnt : 1u;
}

__device__ __forceinline__ void xcd_barrier(const XcdBarrier& b, bool tid0) {
    asm volatile("s_waitcnt vmcnt(0)" ::: "memory");
    __syncthreads();
    if (tid0) {
        unsigned* bar = b.bar; asm volatile("" : "+v"(bar));
        __builtin_amdgcn_s_waitcnt(0);
        unsigned nloc = b.st[0], nx = b.st[1];
        if (nloc == 0u) { xcd_barrier_complete(bar, b.x, nloc, nx); b.st[0] = nloc; b.st[1] = nx; }
        const unsigned old = xb_add(&bar[XB_XSUB(b.x)], 1u);
        const unsigned gen = old / nloc;
        if (old + 1u == (gen + 1u) * nloc) {
            __builtin_amdgcn_fence(__ATOMIC_RELEASE, "agent");
            asm volatile("s_waitcnt vmcnt(0)" ::: "memory");
            const unsigned og = xb_add(&bar[XB_TOP], 1u);
            const unsigned tg = og / nx;
            if (og + 1u == (tg + 1u) * nx) xb_add(&bar[XB_TOPGEN], 1u);
            else XB_SPIN(xb_ld(&bar[XB_TOPGEN]) == tg, bar);
            __builtin_amdgcn_fence(__ATOMIC_ACQUIRE, "agent");
            xb_add(&bar[XB_XGEN(b.x)], 1u);
            asm volatile("s_waitcnt vmcnt(0)" ::: "memory");
        } else {
            XB_SPIN(xb_ld(&bar[XB_XGEN(b.x)]) == gen, bar);
            __builtin_amdgcn_fence(__ATOMIC_ACQUIRE, "agent");
            asm volatile("s_waitcnt vmcnt(0)" ::: "memory");
        }
    }
    __syncthreads();
}
__device__ __forceinline__ float bf2f(bf16 v) { return __uint_as_float(((unsigned)v) << 16); }
__device__ __forceinline__ bf16 f2bf_s(float f) { return (bf16)f2bf(f); }
__device__ __forceinline__ float wave_sum(float v, int lane) {
#pragma unroll
    for (int o = 1; o < 64; o <<= 1) v += pg8::shx(v, o, lane);
    return v;
}
__device__ __forceinline__ float sigmoidf_(float z) { return __builtin_amdgcn_rcpf(1.0f + __expf(-z)); }
__device__ __forceinline__ float tanh_fast(float x) { return 1.0f - 2.0f * __builtin_amdgcn_rcpf(__expf(2.0f * x) + 1.0f); }

struct Args { const float* in[N_IN]; float* out; unsigned char* ws; };
typedef const __attribute__((address_space(4))) Args CArgs;
__device__ __forceinline__ const CArgs* kargs() { const CArgs* p = (const CArgs*)__builtin_amdgcn_kernarg_segment_ptr(); asm volatile("" : "+s"(p)); return p; }
__device__ __forceinline__ unsigned char* kws() { return kargs()->ws; }
__device__ __forceinline__ float* kout() { return kargs()->out; }
__device__ __forceinline__ const float* karg(int i) { return kargs()->in[i]; }
__device__ __forceinline__ int lane_id() { int l; asm volatile("v_mbcnt_lo_u32_b32 %0, -1, 0\n\tv_mbcnt_hi_u32_b32 %0, -1, %0" : "=v"(l)); return l; }
struct Frame {
    LAS unsigned char* lds;
    volatile LAS unsigned* MISC;
    gu32* ctl;
    int vcu, G, wv;
};

__device__ __forceinline__ float ushift(const bf16* buf, int ldc, int col, int row, int t, float sp, float sn) {
    const bf16* p = buf + (size_t)row * ldc + col;
    const float u0 = bf2f(p[0]);
    const float up = (t > 0) ? bf2f(p[-ldc]) : 0.f;
    const float un = (t < SEQ - 1) ? bf2f(p[ldc]) : 0.f;
    return u0 + sp * (up - u0) + sn * (un - u0);
}

__device__ __forceinline__ void transpose_item(const float* W, int K, int N, bf16* WT, const float* gain, bool headperm, LAS float* scr, int item, int lane) {
    const int nblk = N / 32, kb = item / nblk, nb = item % nblk, k0 = 64 * kb, n0 = 32 * nb;
    { const int r = lane >> 3, c4 = lane & 7;
      f32x4 v[8];
#pragma unroll
      for (int i = 0; i < 8; ++i) v[i] = *(const f32x4*)(W + (size_t)(k0 + 8 * i + r) * N + n0 + 4 * c4);
#pragma unroll
      for (int i = 0; i < 8; ++i) { f32x4 w = v[i]; if (gain) w = w * gain[k0 + 8 * i + r]; *(LAS f32x4*)(scr + (8 * i + r) * 36 + 4 * c4) = w; } }
    LDS_WAIT(); asm volatile("" ::: "memory");
    const int c = lane & 7;
    const int p0 = headperm ? ((n0 & ~255) + 128 * ((n0 >> 5) & 1) + 32 * ((n0 >> 6) & 3)) : n0;
#pragma unroll
    for (int j = 0; j < 4; ++j) { const int n = (lane >> 3) + 8 * j; const LAS float* s = scr + (8 * c) * 36 + n;
        v4u o; o.x = pk2(s[0 * 36], s[1 * 36]); o.y = pk2(s[2 * 36], s[3 * 36]); o.z = pk2(s[4 * 36], s[5 * 36]); o.w = pk2(s[6 * 36], s[7 * 36]);
        *(GAS v4u*)(WT + (size_t)(p0 + n) * K + k0 + 8 * c) = o; }
    LDS_WAIT(); asm volatile("" ::: "memory");
}
__device__ __forceinline__ void wconv_items(int layerA, int layerB, int wi, int nw, LAS float* scr, int lane_) {
    unsigned char* const ws = kws();
    constexpr int I_1 = (D / 64) * (NPROJ / 32), I_2 = (D / 64) * (D / 32), I_3 = (D / 64) * (FF / 32), I_4 = (FF / 64) * (D / 32);
    constexpr int NA = I_1 + 64, NB = I_2 + I_3 + I_4 + 32;
    const int nA = (layerA >= 0 && layerA < DEPTH) ? NA : 0, nB = (layerB >= 0) ? NB : 0;
    for (int it = wi; it < nA + nB; it += nw) {
        int r = it;
        if (r < nA) { const int layer = layerA;
            if (r < I_1) { transpose_item(karg(I_WIN) + (size_t)layer * D * NPROJ, D, NPROJ, (bf16*)(ws + WS_WIN), karg(I_LN1) + layer * D, true, scr, r, lane_); continue; } r -= I_1;
            const int mat = r >> 4, it16 = r & 15;
            const float* src = (mat < 2 ? karg(I_W2) : karg(I_A2)) + (size_t)(layer * 2 + (mat & 1)) * 64 * 512;
            transpose_item(src, 64, 512, (bf16*)(ws + WS_LORA) + (size_t)mat * 512 * 64, nullptr, false, scr, it16, lane_); continue; }
        r -= nA; const int layer = layerB;
        if (r < I_2) { transpose_item(karg(I_WOUT) + (size_t)layer * D * D, D, D, (bf16*)(ws + WS_WOUT), nullptr, false, scr, r, lane_); continue; } r -= I_2;
        if (r < I_3) { transpose_item(karg(I_WUP) + (size_t)layer * D * FF, D, FF, (bf16*)(ws + WS_WUP), karg(I_LN2) + layer * D, false, scr, r, lane_); continue; } r -= I_3;
        if (r < I_4) { transpose_item(karg(I_WDN) + (size_t)layer * FF * D, FF, D, (bf16*)(ws + WS_WDN), nullptr, false, scr, r, lane_); continue; } r -= I_4;
        transpose_item(karg(I_G2) + (size_t)layer * 128 * 512, 128, 512, (bf16*)(ws + WS_G2T), nullptr, false, scr, r, lane_);
    }
}
__device__ __forceinline__ void x_prologue(Frame& F) {
    unsigned char* const ws = kws();
    int lane_ = lane_id(); asm volatile("" : "+v"(lane_)); int wave_o = F.wv; asm volatile("" : "+s"(wave_o)); const int wave_ = wave_o, tid_ = wave_ * 64 + lane_;
    const int gw = F.vcu * NWAVES + wave_, NGW = F.G * NWAVES;
    const float* x = karg(I_X); bf16* xb = (bf16*)(ws + R_XB); float* ss = (float*)(ws + WS_SS1);
    for (int m = gw; m < M; m += NGW) {
        const GAS f32x4* xr = (const GAS f32x4*)(x + (size_t)m * D) + lane_; GAS f32x4* orow = (GAS f32x4*)(kout() + (size_t)m * D) + lane_;
        GAS unsigned long long* o8 = (GAS unsigned long long*)(xb + (size_t)m * D) + lane_;
        float s = 0.f;
#pragma unroll
        for (int j = 0; j < 4; ++j) { const f32x4 v = xr[64 * j]; orow[64 * j] = v; s += (v.x * v.x + v.y * v.y) + (v.z * v.z + v.w * v.w);
            o8[64 * j] = (unsigned long long)pk2(v.x, v.y) | ((unsigned long long)pk2(v.z, v.w) << 32); }
        s = wave_sum(s, lane_);
        if (lane_ < 16) ss[(size_t)m * 16 + lane_] = (lane_ == 0) ? s : 0.f;
    }
}

typedef float f32x16 __attribute__((ext_vector_type(16)));
typedef short s16x4 __attribute__((ext_vector_type(4)));
typedef short v4i16_t __attribute__((ext_vector_type(4)));
typedef unsigned u32x2_t __attribute__((ext_vector_type(2)));
typedef float f32x2_t __attribute__((ext_vector_type(2))); typedef __bf16 bf16x2_t __attribute__((ext_vector_type(2)));
__device__ __forceinline__ unsigned cvtpk(float lo, float hi) { f32x2_t v = {lo, hi}; bf16x2_t b = __builtin_convertvector(v, bf16x2_t); return __builtin_bit_cast(unsigned, b); }
typedef _Float16 h16x2_t __attribute__((ext_vector_type(2))); typedef _Float16 h16x8 __attribute__((ext_vector_type(8)));
__device__ __forceinline__ unsigned cvtpk_h(float lo, float hi) { f32x2_t v = {lo, hi}; h16x2_t b = __builtin_convertvector(v, h16x2_t); return __builtin_bit_cast(unsigned, b); }
__device__ __forceinline__ f32x2_t unpk_h(unsigned w) { return __builtin_convertvector(__builtin_bit_cast(h16x2_t, w), f32x2_t); }
#define MFMA32H(nf, mf, acc) __builtin_amdgcn_mfma_f32_32x32x16_f16(__builtin_bit_cast(h16x8, (nf)), __builtin_bit_cast(h16x8, (mf)), (acc), 0, 0, 0)
constexpr int TSB = 144, TILE_B = 64 * TSB;
constexpr int PRE_TW = 14 * TILE_B, PRE_XA = 15 * TILE_B, PRE_INVN = 16 * TILE_B, PRE_GC = PRE_INVN + 256, PRE_BON = PRE_GC + 512, PRE_LDS_END = PRE_BON + 1024;
static_assert(PRE_LDS_END <= LDSCTL_OFF, "PRE LDS map");
__device__ __forceinline__ bf16x8 frag_row(const LAS unsigned char* tile, int row, int ks, int hi) {
    return *(const LAS bf16x8*)(tile + row * TSB + (16 * ks + 8 * hi) * 2);
}
__device__ __forceinline__ s16x4 tr4(const LAS unsigned char* p) { return __builtin_bit_cast(s16x4, __builtin_amdgcn_ds_read_tr16_b64_v4i16((LAS v4i16_t*)p)); }
__device__ __forceinline__ bf16x8 frag_tr(const LAS unsigned char* tile, int idx0, int ks, int lane) {
    const int hi = lane >> 5, g1 = (lane >> 4) & 1, i = lane & 15;
    const LAS unsigned char* p = tile + (16 * ks + 8 * hi + (i >> 2)) * TSB + (idx0 + 16 * g1 + 4 * (i & 3)) * 2;
    const s16x4 lo = tr4(p), h4 = tr4(p + 4 * TSB);
    return (bf16x8){lo[0], lo[1], lo[2], lo[3], h4[0], h4[1], h4[2], h4[3]};
}
__device__ __forceinline__ void store_quad(LAS unsigned char* tile, int row, int n0, int hi, const f32x16& a) {
#pragma unroll
    for (int q = 0; q < 4; ++q) { u32x2_t w; w.x = cvtpk(a[4 * q], a[4 * q + 1]); w.y = cvtpk(a[4 * q + 2], a[4 * q + 3]); *(LAS u32x2_t*)(tile + row * TSB + (n0 + 8 * q + 4 * hi) * 2) = w; }
}
__device__ __forceinline__ void store_quad_h(LAS unsigned char* tile, int row, int n0, int hi, const f32x16& a) {
#pragma unroll
    for (int q = 0; q < 4; ++q) { u32x2_t w; w.x = cvtpk_h(a[4 * q], a[4 * q + 1]); w.y = cvtpk_h(a[4 * q + 2], a[4 * q + 3]); *(LAS u32x2_t*)(tile + row * TSB + (n0 + 8 * q + 4 * hi) * 2) = w; }
}
__device__ __forceinline__ f32x16 load_quad(const LAS unsigned char* tile, int row, int n0, int hi) {
    f32x16 a;
#pragma unroll
    for (int q = 0; q < 4; ++q) { const u32x2_t w = *(const LAS u32x2_t*)(tile + row * TSB + (n0 + 8 * q + 4 * hi) * 2);
        a[4 * q] = __uint_as_float(w.x << 16); a[4 * q + 1] = __uint_as_float(w.x & 0xffff0000u); a[4 * q + 2] = __uint_as_float(w.y << 16); a[4 * q + 3] = __uint_as_float(w.y & 0xffff0000u); }
    return a;
}
#define MFMA32(nf, mf, acc) __builtin_amdgcn_mfma_f32_32x32x16_bf16((nf), (mf), (acc), 0, 0, 0)
#define LD4_ROW(dst, tile, row) _Pragma("unroll") for (int ks_ = 0; ks_ < 4; ++ks_) dst[ks_] = frag_row(tile, row, ks_, hi)
#define LD4_TR(dst, tile, idx0) _Pragma("unroll") for (int ks_ = 0; ks_ < 4; ++ks_) dst[ks_] = frag_tr(tile, idx0, ks_, lane)
#define SBAR0() __builtin_amdgcn_sched_barrier(0)
#define WG_BARL() do { asm volatile("s_waitcnt lgkmcnt(0)" ::: "memory"); __builtin_amdgcn_s_barrier(); asm volatile("" ::: "memory"); } while (0)
#define WG_BAR() do { asm volatile("s_waitcnt vmcnt(0) lgkmcnt(0)" ::: "memory"); __builtin_amdgcn_s_barrier(); asm volatile("" ::: "memory"); } while (0)
__device__ __forceinline__ void shift8(const bf16* buf, int ldc, int col, int row, int t, const float* sp, const float* sn, float (&out)[8]) {
    const bf16* p = buf + (size_t)row * ldc + col;
    const v4u c = *(const v4u*)p; v4u pv = (v4u){0u, 0u, 0u, 0u}, nv = (v4u){0u, 0u, 0u, 0u};
    if (t > 0) pv = *(const v4u*)(p - ldc);
    if (t < SEQ - 1) nv = *(const v4u*)(p + ldc);
    const f32x4 sp0 = *(const f32x4*)sp, sp1 = *(const f32x4*)(sp + 4), sn0 = *(const f32x4*)sn, sn1 = *(const f32x4*)(sn + 4);
#pragma unroll
    for (int j = 0; j < 8; ++j) { const unsigned cw = c[j >> 1], pw = pv[j >> 1], nw = nv[j >> 1];
        const float u0 = (j & 1) ? __uint_as_float(cw & 0xffff0000u) : __uint_as_float(cw << 16), up = (j & 1) ? __uint_as_float(pw & 0xffff0000u) : __uint_as_float(pw << 16), un = (j & 1) ? __uint_as_float(nw & 0xffff0000u) : __uint_as_float(nw << 16);
        const float a = (j < 4) ? sp0[j & 3] : sp1[j & 3], bq = (j < 4) ? sn0[j & 3] : sn1[j & 3];
        out[j] = u0 + a * (up - u0) + bq * (un - u0); }
}
__device__ __forceinline__ f32x4 shift4(const bf16* buf, int ldc, int col, int row, int t, const float* sp, const float* sn) {
    const bf16* p = buf + (size_t)row * ldc + col;
    const u32x2_t c = *(const u32x2_t*)p; u32x2_t pv = (u32x2_t){0u, 0u}, nv = (u32x2_t){0u, 0u};
    if (t > 0) pv = *(const u32x2_t*)(p - ldc);
    if (t < SEQ - 1) nv = *(const u32x2_t*)(p + ldc);
    const f32x4 a = *(const f32x4*)sp, bq = *(const f32x4*)sn;
    const f32x4 u0 = (f32x4){__uint_as_float(c.x << 16), __uint_as_float(c.x & 0xffff0000u), __uint_as_float(c.y << 16), __uint_as_float(c.y & 0xffff0000u)};
    const f32x4 up = (f32x4){__uint_as_float(pv.x << 16), __uint_as_float(pv.x & 0xffff0000u), __uint_as_float(pv.y << 16), __uint_as_float(pv.y & 0xffff0000u)};
    const f32x4 un = (f32x4){__uint_as_float(nv.x << 16), __uint_as_float(nv.x & 0xffff0000u), __uint_as_float(nv.y << 16), __uint_as_float(nv.y & 0xffff0000u)};
    return u0 + a * (up - u0) + bq * (un - u0);
}

struct R16 { v4u c, p, n; };
struct R8 { u32x2_t c, p, n; };
__device__ __forceinline__ R16 ld3x16(const bf16* buf, int ldc, int col, int row, int t) {
    const bf16* q = buf + (size_t)row * ldc + col; R16 r; r.c = *(const v4u*)q; r.p = (v4u){0u, 0u, 0u, 0u}; r.n = (v4u){0u, 0u, 0u, 0u};
    if (t > 0) r.p = *(const v4u*)(q - ldc);
    if (t < SEQ - 1) r.n = *(const v4u*)(q + ldc);
    return r;
}
__device__ __forceinline__ R8 ld3x8(const bf16* buf, int ldc, int col, int row, int t) {
    const bf16* q = buf + (size_t)row * ldc + col; R8 r; r.c = *(const u32x2_t*)q; r.p = (u32x2_t){0u, 0u}; r.n = (u32x2_t){0u, 0u};
    if (t > 0) r.p = *(const u32x2_t*)(q - ldc);
    if (t < SEQ - 1) r.n = *(const u32x2_t*)(q + ldc);
    return r;
}
__device__ __forceinline__ void sh8(const R16& r, const LAS float* sp, const LAS float* sn, float (&out)[8]) {
    const f32x4 sp0 = *(const LAS f32x4*)sp, sp1 = *(const LAS f32x4*)(sp + 4), sn0 = *(const LAS f32x4*)sn, sn1 = *(const LAS f32x4*)(sn + 4);
#pragma unroll
    for (int j = 0; j < 8; ++j) { const unsigned cw = r.c[j >> 1], pw = r.p[j >> 1], nw = r.n[j >> 1];
        const float u0 = (j & 1) ? __uint_as_float(cw & 0xffff0000u) : __uint_as_float(cw << 16), up = (j & 1) ? __uint_as_float(pw & 0xffff0000u) : __uint_as_float(pw << 16), un = (j & 1) ? __uint_as_float(nw & 0xffff0000u) : __uint_as_float(nw << 16);
        const float a = (j < 4) ? sp0[j & 3] : sp1[j & 3], bq = (j < 4) ? sn0[j & 3] : sn1[j & 3];
        out[j] = u0 + a * (up - u0) + bq * (un - u0); }
}
__device__ __forceinline__ f32x4 sh4(const R8& r, const f32x4 a, const f32x4 bq) {
    const f32x4 u0 = (f32x4){__uint_as_float(r.c.x << 16), __uint_as_float(r.c.x & 0xffff0000u), __uint_as_float(r.c.y << 16), __uint_as_float(r.c.y & 0xffff0000u)};
    const f32x4 up = (f32x4){__uint_as_float(r.p.x << 16), __uint_as_float(r.p.x & 0xffff0000u), __uint_as_float(r.p.y << 16), __uint_as_float(r.p.y & 0xffff0000u)};
    const f32x4 un = (f32x4){__uint_as_float(r.n.x << 16), __uint_as_float(r.n.x & 0xffff0000u), __uint_as_float(r.n.y << 16), __uint_as_float(r.n.y & 0xffff0000u)};
    return u0 + a * (up - u0) + bq * (un - u0);
}
constexpr int PRE_CT = PRE_LDS_END;
enum { CT_KK = 0, CT_KA = 64, CT_RK = 128, CT_W0 = 192  , CT_A0 = 320  , CT_SPR = 448, CT_SNR = 512, CT_SPK = 576, CT_SNK = 640, CT_SPV = 704, CT_SNV = 768, CT_SPX = 832  , CT_SNX = 960  , CT_N = 1088 };
static_assert(PRE_CT + CT_N * 4 <= LDSCTL_OFF, "PRE constant table");
__device__ __forceinline__ void rwkv_pre_phase(Frame& F, int layer) {
    unsigned char* const ws = kws();
    int lane_ = lane_id(); asm volatile("" : "+v"(lane_)); int wave_o = F.wv; asm volatile("" : "+s"(wave_o)); const int wave_ = wave_o;
    const int d = wave_ >> 2, qm = (wave_ >> 1) & 1, qn = wave_ & 1, m0 = 32 * qm, n0 = 32 * qn;
#define LANE_VARS int lane = lane_; asm volatile("" : "+v"(lane)); const int hi = lane >> 5, l31 = lane & 31, mrow = m0 + l31; (void)hi; (void)l31; (void)mrow;
    LAS unsigned char* const L = F.lds;
    LAS unsigned char* const T0 = L + (d * 7 + 0) * TILE_B; LAS unsigned char* const T1 = L + (d * 7 + 1) * TILE_B; LAS unsigned char* const T2 = L + (d * 7 + 2) * TILE_B; LAS unsigned char* const T3 = L + (d * 7 + 3) * TILE_B;
    LAS unsigned char* const T4 = L + (d * 7 + 4) * TILE_B; LAS unsigned char* const T5 = L + (d * 7 + 5) * TILE_B; LAS unsigned char* const T6 = L + (d * 7 + 6) * TILE_B;
    LAS unsigned char* const TWt = L + PRE_TW; LAS unsigned char* const XAt = L + PRE_XA;
    LAS float* const invn = (LAS float*)(L + PRE_INVN); LAS float* const gcs = (LAS float*)(L + PRE_GC) + d * 64; LAS float* const bon = (LAS float*)(L + PRE_BON); LAS float* const ct = (LAS float*)(L + PRE_CT);
    const bf16* Rr = (const bf16*)(ws + R_RR); const bf16* Kr = (const bf16*)(ws + R_KR); const bf16* Vr = (const bf16*)(ws + R_VR); const bf16* XL = (const bf16*)(ws + R_XL);
    const bf16* W2T = (const bf16*)(ws + WS_LORA) + (size_t)d * 512 * 64; const bf16* A2T = (const bf16*)(ws + WS_LORA) + (size_t)(2 + d) * 512 * 64;
    float* BN = (float*)(ws + R_BN) + (size_t)d * M * 8;
    const int h = F.vcu & 7, hc = h * HD, bc0 = F.vcu >> 3, bcs = F.G >> 3;
    { LANE_VARS; const float* sp = karg(I_TSP) + layer * RPROJ; const float* sn = karg(I_TSN) + layer * RPROJ;
      for (int idx = wave_ * 64 + lane; idx < CT_N; idx += NTHR) { const int seg = idx >> 6, c = idx & 63; float v;
          if (seg == 0) v = karg(I_KK)[layer * 512 + hc + c]; else if (seg == 1) v = karg(I_KA)[layer * 512 + hc + c]; else if (seg == 2) v = karg(I_RK)[layer * 512 + hc + c];
          else if (seg < 5) v = karg(I_W0)[(layer * 2 + seg - 3) * 512 + hc + c]; else if (seg < 7) v = karg(I_A0)[(layer * 2 + seg - 5) * 512 + hc + c];
          else if (seg < 13) { const int j = seg - 7; v = ((j & 1) ? sn : sp)[(j >> 1) * 512 + hc + c]; }
          else if (seg < 15) v = sp[1536 + (idx - CT_SPX)]; else v = sn[1536 + (idx - CT_SNX)];
          ct[idx] = v; } }
    WG_BARL();
    R16 xw3, xa3, kk3, rr3;
    { LANE_VARS; const int tidl = wave_ * 64 + lane, tok = tidl >> 3, oct = tidl & 7; const int b = bc0 >> 6, t = (bc0 & 63) * 64 + tok, row = b * SEQ + t;
      xw3 = ld3x16(XL, 256, 8 * oct, row, t); xa3 = ld3x16(XL, 256, 64 + 8 * oct, row, t); kk3 = ld3x16(Kr, 512, hc + 8 * oct, row, t); rr3 = ld3x16(Rr, 512, hc + 8 * oct, row, t); }
    LAS unsigned char* const RF0 = L + 6 * TILE_B; LAS unsigned char* const RF1 = L + 13 * TILE_B;
    for (int bc = bc0; bc < BATCH * (SEQ / 64); bc += bcs) {
        const int cn = bc & 63, b = bc >> 6, t0 = cn * 64;
#define SNAT (d ? 63 - mrow : mrow)
        bf16x8 wfr[4], afr[4];
        { LANE_VARS;
#pragma unroll
          for (int ks = 0; ks < 4; ++ks) { const size_t wo = (size_t)(hc + n0 + l31) * 64 + 16 * ks + 8 * hi; wfr[ks] = *(const bf16x8*)(W2T + wo); afr[ks] = *(const bf16x8*)(A2T + wo); }
        }
        float ksh[8];
        { LANE_VARS; const int tidl = wave_ * 64 + lane; const int tok = tidl >> 3, oct = tidl & 7; float v8[8];
          sh8(xw3, ct + CT_SPX + 8 * oct, ct + CT_SNX + 8 * oct, v8);
          { v4u w; w.x = cvtpk(tanh_fast(v8[0]), tanh_fast(v8[1])); w.y = cvtpk(tanh_fast(v8[2]), tanh_fast(v8[3])); w.z = cvtpk(tanh_fast(v8[4]), tanh_fast(v8[5])); w.w = cvtpk(tanh_fast(v8[6]), tanh_fast(v8[7])); *(LAS v4u*)(TWt + tok * TSB + 16 * oct) = w; }
          sh8(xa3, ct + CT_SPX + 64 + 8 * oct, ct + CT_SNX + 64 + 8 * oct, v8);
          { v4u w; w.x = cvtpk(v8[0], v8[1]); w.y = cvtpk(v8[2], v8[3]); w.z = cvtpk(v8[4], v8[5]); w.w = cvtpk(v8[6], v8[7]); *(LAS v4u*)(XAt + tok * TSB + 16 * oct) = w; }
          sh8(rr3, ct + CT_SPR + 8 * oct, ct + CT_SNR + 8 * oct, v8);
          { LAS f32x4* rp_ = (LAS f32x4*)((tok < 32 ? RF0 : RF1) + (tok & 31) * 256 + 32 * oct); rp_[0] = (f32x4){v8[0], v8[1], v8[2], v8[3]}; rp_[1] = (f32x4){v8[4], v8[5], v8[6], v8[7]}; }
          sh8(kk3, ct + CT_SPK + 8 * oct, ct + CT_SNK + 8 * oct, ksh);
          const f32x4 k0 = *(const LAS f32x4*)(ct + CT_KK + 8 * oct), k1 = *(const LAS f32x4*)(ct + CT_KK + 8 * oct + 4); float ssq = 0.f;
#pragma unroll
          for (int j = 0; j < 8; ++j) { const float kx = ksh[j] * ((j < 4) ? k0[j & 3] : k1[j & 3]); ssq += kx * kx; }
          ssq += pg8::shx(ssq, 1, lane); ssq += pg8::shx(ssq, 2, lane); ssq += pg8::shx(ssq, 4, lane);
          if (oct == 0) invn[tok] = 1.0f / sqrtf(ssq + 1e-12f); }
        WG_BARL();
        f32x16 zw, za, lw, av, cum;
        { LANE_VARS; const int snat = SNAT;
#pragma unroll
        for (int r = 0; r < 16; ++r) { zw[r] = 0.f; za[r] = 0.f; }
        { bf16x8 f0[4], f1[4]; LD4_ROW(f0, TWt, snat); LD4_ROW(f1, XAt, snat); SBAR0();
#pragma unroll
          for (int ks = 0; ks < 4; ++ks) { zw = MFMA32(wfr[ks], f0[ks], zw); za = MFMA32(afr[ks], f1[ks], za); } }
#pragma unroll
        for (int q = 0; q < 4; ++q) { const f32x4 w0v = *(const LAS f32x4*)(ct + CT_W0 + 64 * d + n0 + 8 * q + 4 * hi), a0v = *(const LAS f32x4*)(ct + CT_A0 + 64 * d + n0 + 8 * q + 4 * hi);
#pragma unroll
            for (int i = 0; i < 4; ++i) { lw[4 * q + i] = -0.6065306597f * sigmoidf_(zw[4 * q + i] + w0v[i]); av[4 * q + i] = sigmoidf_(za[4 * q + i] + a0v[i]); } }
        { f32x16 lh, ll;
#pragma unroll
          for (int r = 0; r < 16; ++r) { lh[r] = __uint_as_float(cvtpk(lw[r], 0.f) << 16); ll[r] = lw[r] - lh[r]; }
          store_quad(T4, mrow, n0, hi, lh); store_quad(T5, mrow, n0, hi, ll); } }
        WG_BARL();
        { LANE_VARS; const int tidl = wave_ * 64 + lane, tok = tidl >> 3, oct = tidl & 7;
          LAS f32x4* kp_ = (LAS f32x4*)((tok < 32 ? TWt : XAt) + (tok & 31) * 256 + 32 * oct); kp_[0] = (f32x4){ksh[0], ksh[1], ksh[2], ksh[3]}; kp_[1] = (f32x4){ksh[4], ksh[5], ksh[6], ksh[7]}; }
        { LANE_VARS;
#pragma unroll
        for (int r = 0; r < 16; ++r) cum[r] = 0.f;
        { bf16x8 f0[4], f1[4]; LD4_TR(f0, T4, n0); LD4_TR(f1, T5, n0); SBAR0();
#pragma unroll
        for (int ks = 0; ks < 4; ++ks) { bf16x8 tf;
#pragma unroll
            for (int j = 0; j < 8; ++j) tf[j] = (16 * ks + 8 * hi + j <= mrow) ? (short)0x3f80 : (short)0;
            cum = MFMA32(f0[ks], tf, cum); cum = MFMA32(f1[ks], tf, cum); } } }
        WG_BARL();
        f32x16 rh, kc, mrk;
        { LANE_VARS; const int snat = SNAT; const float inv = invn[snat];
          float bsum = 0.f;
#pragma unroll
          for (int q = 0; q < 4; ++q) { const int cl = n0 + 8 * q + 4 * hi;
              const f32x4 r4 = *(const LAS f32x4*)((snat < 32 ? RF0 : RF1) + (snat & 31) * 256 + 4 * cl), k4 = *(const LAS f32x4*)((snat < 32 ? TWt : XAt) + (snat & 31) * 256 + 4 * cl);
              const f32x4 kk4 = *(const LAS f32x4*)(ct + CT_KK + cl), ka4 = *(const LAS f32x4*)(ct + CT_KA + cl), rk4 = *(const LAS f32x4*)(ct + CT_RK + cl);
              float kh4[4], bc4[4], rl4[4], kl4[4];
#pragma unroll
              for (int i = 0; i < 4; ++i) { const int e = 4 * q + i; const float a = av[e], cs = cum[e];
                  const float g = __expf(cs), gx = __expf(cs - lw[e]), gi = __expf(-cs);
                  const float kkn = k4[i] * kk4[i] * inv, kt = k4[i] * (1.0f + (a - 1.0f) * ka4[i]);
                  kh4[i] = gx * kkn; rh[e] = g * r4[i]; bc4[i] = a * kkn * gi; kc[e] = kt * gi; bsum += r4[i] * kt * rk4[i];
                  rl4[i] = rh[e] - __uint_as_float(cvtpk(rh[e], 0.f) << 16); kl4[i] = kc[e] - __uint_as_float(cvtpk(kc[e], 0.f) << 16);
                  if (mrow == 63) gcs[n0 + 8 * q + 4 * hi + i] = g; }
              const int off = mrow * TSB + (n0 + 8 * q + 4 * hi) * 2; u32x2_t w;
              w.x = cvtpk(kh4[0], kh4[1]); w.y = cvtpk(kh4[2], kh4[3]); *(LAS u32x2_t*)(T0 + off) = w;
              w.x = cvtpk(rh[4 * q], rh[4 * q + 1]); w.y = cvtpk(rh[4 * q + 2], rh[4 * q + 3]); *(LAS u32x2_t*)(T1 + off) = w;
              w.x = cvtpk(bc4[0], bc4[1]); w.y = cvtpk(bc4[2], bc4[3]); *(LAS u32x2_t*)(T2 + off) = w;
              w.x = cvtpk(kc[4 * q], kc[4 * q + 1]); w.y = cvtpk(kc[4 * q + 2], kc[4 * q + 3]); *(LAS u32x2_t*)(T3 + off) = w;
              w.x = cvtpk(rl4[0], rl4[1]); w.y = cvtpk(rl4[2], rl4[3]); *(LAS u32x2_t*)(T4 + off) = w;
              w.x = cvtpk(kl4[0], kl4[1]); w.y = cvtpk(kl4[2], kl4[3]); *(LAS u32x2_t*)(T5 + off) = w; }
          bsum += pg8::shx(bsum, 32, lane);
          if (hi == 0) bon[(d * 2 + qn) * 64 + snat] = bsum; }
        if (bc + bcs < BATCH * (SEQ / 64)) { LANE_VARS; const int tidl = wave_ * 64 + lane, tok = tidl >> 3, oct = tidl & 7; const int bn = bc + bcs, b2 = bn >> 6, t = (bn & 63) * 64 + tok, row = b2 * SEQ + t;
            xw3 = ld3x16(XL, 256, 8 * oct, row, t); xa3 = ld3x16(XL, 256, 64 + 8 * oct, row, t); kk3 = ld3x16(Kr, 512, hc + 8 * oct, row, t); rr3 = ld3x16(Rr, 512, hc + 8 * oct, row, t); }
        WG_BARL();
        { LANE_VARS; const int snat = SNAT; if (qn == 0 && hi == 0) BN[(size_t)(b * SEQ + t0 + snat) * 8 + h] = bon[(d * 2) * 64 + snat] + bon[(d * 2 + 1) * 64 + snat]; }
        { LANE_VARS;
#pragma unroll
          for (int r = 0; r < 16; ++r) mrk[r] = 0.f;
          bf16x8 f0[4], f1[4], f2[4], f3[4]; LD4_ROW(f0, T1, mrow); LD4_ROW(f1, T3, n0 + l31); LD4_ROW(f2, T5, n0 + l31); LD4_ROW(f3, T4, mrow); SBAR0();
#pragma unroll
          for (int ks = 0; ks < 4; ++ks) { mrk = MFMA32(f1[ks], f0[ks], mrk); mrk = MFMA32(f2[ks], f0[ks], mrk); mrk = MFMA32(f1[ks], f3[ks], mrk); }
#pragma unroll
          for (int q = 0; q < 4; ++q)
#pragma unroll
              for (int i = 0; i < 4; ++i) { const int e = 4 * q + i, n = n0 + 8 * q + 4 * hi + i; mrk[e] = (n <= mrow) ? mrk[e] : 0.f; } }
        WG_BARL();
        { LANE_VARS; f32x16 x, mk, zz;
          float z0 = 0.f; asm volatile("" : "+v"(z0));
#pragma unroll
          for (int r = 0; r < 16; ++r) { x[r] = 0.f; mk[r] = 0.f; zz[r] = z0; }
          { bf16x8 f0[4], f1[4], f2[4]; LD4_ROW(f0, T0, mrow); LD4_ROW(f1, T2, n0 + l31); LD4_ROW(f2, T3, n0 + l31); SBAR0();
#pragma unroll
            for (int ks = 0; ks < 4; ++ks) { x = MFMA32(f1[ks], f0[ks], x); mk = MFMA32(f2[ks], f0[ks], mk); } }
#pragma unroll
          for (int q = 0; q < 4; ++q)
#pragma unroll
              for (int i = 0; i < 4; ++i) { const int e = 4 * q + i, n = n0 + 8 * q + 4 * hi + i; const bool lo = n < mrow; x[e] = lo ? -x[e] : 0.f; mk[e] = lo ? mk[e] : 0.f; }
          store_quad(T4, mrow, n0, hi, x); store_quad(T5, mrow, n0, hi, zz); store_quad(T6, mrow, n0, hi, mk); }
        WG_BARL();
        if ((wave_ & 3) == 0) { LANE_VARS; const int blk = lane >> 4, c = lane & 15; float t[16];
#pragma unroll
            for (int r = 0; r < 16; ++r) { const LAS unsigned char* xr = T4 + (16 * blk + r) * TSB + 32 * blk; const v4u w0_ = *(const LAS v4u*)xr, w1_ = *(const LAS v4u*)(xr + 16);
                float acc0 = (r == c) ? 1.0f : 0.f, acc1 = 0.f;
#pragma unroll
                for (int j = 0; j < r; ++j) { const unsigned w = (j < 8) ? w0_[j >> 1] : w1_[(j - 8) >> 1]; const float xv = (j & 1) ? __uint_as_float(w & 0xffff0000u) : __uint_as_float(w << 16);
                    if (j & 1) acc1 += xv * t[j]; else acc0 += xv * t[j]; }
                t[r] = acc0 + acc1; }
#pragma unroll
            for (int r = 0; r < 16; ++r) *(LAS unsigned short*)(T5 + (16 * blk + r) * TSB + (16 * blk + c) * 2) = (unsigned short)(cvtpk(t[r], 0.f) & 0xffffu); }
        WG_BARL();
        { LANE_VARS; LAS unsigned char* const scr = qm ? T5 : T4;
          if (qm == qn) {
              f32x16 w;
#pragma unroll
              for (int r = 0; r < 16; ++r) w[r] = 0.f;
              bf16x8 mf = frag_row(T4, m0 + l31, 2 * qm, hi);
              if (l31 < 16) mf = (bf16x8){0, 0, 0, 0, 0, 0, 0, 0};
              w = MFMA32(frag_tr(T5, m0, 2 * qm, lane), mf, w);
              store_quad(scr, l31, 32, hi, w); } }
        WG_BARL();
        { LANE_VARS; LAS unsigned char* const scr = qm ? T5 : T4;
          if (qm == qn) {
              f32x16 tq = load_quad(T5, mrow, m0, hi);
#pragma unroll
              for (int ks = 0; ks < 2; ++ks) tq = MFMA32(frag_tr(scr, 32, ks, lane), frag_row(T5, mrow, 2 * qm + ks, hi), tq);
              store_quad(T5, mrow, m0, hi, tq); } }
        WG_BARL();
        { LANE_VARS;
          if (qm == 1 && qn == 0) {
              f32x16 w;
#pragma unroll
              for (int r = 0; r < 16; ++r) w[r] = 0.f;
#pragma unroll
              for (int ks = 0; ks < 2; ++ks) w = MFMA32(frag_tr(T5, 0, ks, lane), frag_row(T4, 32 + l31, ks, hi), w);
              store_quad(T4, l31, 32, hi, w); }
          if (qm == 0 && qn == 1) { f32x16 zz; float z0 = 0.f; asm volatile("" : "+v"(z0));
#pragma unroll
              for (int r = 0; r < 16; ++r) zz[r] = z0;
              store_quad(T5, l31, 32, hi, zz); } }
        WG_BARL();
        { LANE_VARS;
          if (qm == 1 && qn == 0) {
              f32x16 t21;
#pragma unroll
              for (int r = 0; r < 16; ++r) t21[r] = 0.f;
#pragma unroll
              for (int ks = 0; ks < 2; ++ks) t21 = MFMA32(frag_tr(T4, 32, ks, lane), frag_row(T5, 32 + l31, 2 + ks, hi), t21);
              store_quad(T5, 32 + l31, 0, hi, t21); } }
        WG_BARL();
        R16 vr3[2];
        { LANE_VARS; const int tt = (wave_ * 64 + lane) & 255, s = tt >> 2, cg4 = (tt & 3) * 16, sn_ = d ? 63 - s : s, t = t0 + sn_, row = b * SEQ + t;
          vr3[0] = ld3x16(Vr, 512, hc + cg4, row, t); vr3[1] = ld3x16(Vr, 512, hc + cg4 + 8, row, t); }
        { LANE_VARS; f32x16 kp, tk;
#pragma unroll
          for (int r = 0; r < 16; ++r) { kp[r] = 0.f; tk[r] = 0.f; }
          { bf16x8 f0[4], f1[4], f2[4]; LD4_ROW(f0, T5, mrow); LD4_TR(f1, T0, n0); LD4_TR(f2, T6, n0); SBAR0();
#pragma unroll
            for (int ks = 0; ks < 4; ++ks) { kp = MFMA32(f1[ks], f0[ks], kp); tk = MFMA32(f2[ks], f0[ks], tk); } }
          WG_BARL();
          store_quad(T0, mrow, n0, hi, kp); store_quad(T6, mrow, n0, hi, tk); }
        { LANE_VARS; f32x16 rb;
#pragma unroll
          for (int r = 0; r < 16; ++r) rb[r] = 0.f;
          { bf16x8 f0[4], f1[4]; LD4_ROW(f0, T2, n0 + l31); LD4_ROW(f1, T1, mrow); SBAR0();
#pragma unroll
            for (int ks = 0; ks < 4; ++ks) rb = MFMA32(f0[ks], f1[ks], rb); }
#pragma unroll
          for (int q = 0; q < 4; ++q)
#pragma unroll
              for (int i = 0; i < 4; ++i) { const int e = 4 * q + i, n = n0 + 8 * q + 4 * hi + i; rb[e] = (n <= mrow) ? rb[e] : 0.f; }
          store_quad(T4, mrow, n0, hi, rb); }
        WG_BARL();
        const int cd = d ? 63 - cn : cn;
        bf16* const pre = (bf16*)(ws + R_PRE) + ((size_t)(((b * 8 + h) * 2 + d) * 64 + cd)) * 16384;
        { LANE_VARS; f32x16 rp, ml, pm, kq;
#pragma unroll
          for (int r = 0; r < 16; ++r) { rp[r] = 0.f; ml[r] = 0.f; pm[r] = 0.f; kq[r] = 0.f; }
#pragma unroll
          for (int kh = 0; kh < 2; ++kh) { bf16x8 mrbf[2], khn[2], bcn[2], tkn[2], bcm[2], tkm[2];
#pragma unroll
              for (int k2 = 0; k2 < 2; ++k2) { const int ks = 2 * kh + k2; mrbf[k2] = frag_row(T4, mrow, ks, hi); khn[k2] = frag_tr(T0, n0, ks, lane); bcn[k2] = frag_tr(T2, n0, ks, lane); tkn[k2] = frag_tr(T6, n0, ks, lane); bcm[k2] = frag_tr(T2, m0, ks, lane); tkm[k2] = frag_tr(T6, m0, ks, lane); }
              SBAR0();
#pragma unroll
              for (int k2 = 0; k2 < 2; ++k2) { rp = MFMA32(khn[k2], mrbf[k2], rp); ml = MFMA32(tkn[k2], mrbf[k2], ml); pm = MFMA32(khn[k2], bcm[k2], pm); kq = MFMA32(bcn[k2], tkm[k2], kq); }
              SBAR0(); }
          const float gm = gcs[mrow];
#pragma unroll
          for (int q = 0; q < 4; ++q)
#pragma unroll
              for (int i = 0; i < 4; ++i) { const int e = 4 * q + i, n = n0 + 8 * q + 4 * hi + i;
                  rp[e] = rh[e] - rp[e]; ml[e] = mrk[e] - ml[e]; pm[e] = gm * (((n == mrow) ? 1.0f : 0.f) - pm[e]); kq[e] = (kc[e] - kq[e]) * gcs[n]; }
#pragma unroll
          for (int q = 0; q < 4; ++q) { const int pc = n0 + 16 * (q >> 1) + 8 * hi + 4 * (q & 1);
              u32x2_t w; w.x = cvtpk_h(pm[4 * q], pm[4 * q + 1]); w.y = cvtpk_h(pm[4 * q + 2], pm[4 * q + 3]); *(u32x2_t*)(pre + mrow * 64 + pc) = w;
              w.x = cvtpk_h(rp[4 * q], rp[4 * q + 1]); w.y = cvtpk_h(rp[4 * q + 2], rp[4 * q + 3]); *(u32x2_t*)(pre + 4096 + (d ? 63 - mrow : mrow) * 64 + pc) = w; }
          WG_BARL();
          store_quad_h(T4, mrow, n0, hi, ml); store_quad_h(T5, mrow, n0, hi, kq); }
        { LANE_VARS; const int tt = (wave_ * 64 + lane) & 255, s = tt >> 2, cg4 = (tt & 3) * 16; float v8[8];
#pragma unroll
          for (int hlf = 0; hlf < 2; ++hlf) { const int c8 = cg4 + 8 * hlf;
              sh8(vr3[hlf], ct + CT_SPV + c8, ct + CT_SNV + c8, v8);
              v4u w; w.x = cvtpk_h(v8[0], v8[1]); w.y = cvtpk_h(v8[2], v8[3]); w.z = cvtpk_h(v8[4], v8[5]); w.w = cvtpk_h(v8[6], v8[7]); *(LAS v4u*)(T1 + s * TSB + 2 * c8) = w; } }
        WG_BARL();
        { LANE_VARS; f32x16 qt, yt;
#pragma unroll
          for (int r = 0; r < 16; ++r) { qt[r] = 0.f; yt[r] = 0.f; }
          { bf16x8 f0[4], f1[4], f2[4], f3[4]; LD4_TR(f0, T1, m0); LD4_TR(f1, T5, n0); LD4_TR(f2, T1, n0); LD4_ROW(f3, T4, mrow); SBAR0();
#pragma unroll
            for (int ks = 0; ks < 4; ++ks) { qt = MFMA32H(f1[ks], f0[ks], qt); yt = MFMA32H(f2[ks], f3[ks], yt); } }
          v4u w0_, w1_;
          w0_.x = cvtpk_h(qt[0], qt[1]); w0_.y = cvtpk_h(qt[2], qt[3]); w0_.z = cvtpk_h(qt[4], qt[5]); w0_.w = cvtpk_h(qt[6], qt[7]); w1_.x = cvtpk_h(qt[8], qt[9]); w1_.y = cvtpk_h(qt[10], qt[11]); w1_.z = cvtpk_h(qt[12], qt[13]); w1_.w = cvtpk_h(qt[14], qt[15]);
          { bf16* dst = pre + 8192 + ((qn * 64 + mrow) * 2 + hi) * 16; *(v4u*)dst = w0_; *(v4u*)(dst + 8) = w1_; }
          w0_.x = cvtpk_h(yt[0], yt[1]); w0_.y = cvtpk_h(yt[2], yt[3]); w0_.z = cvtpk_h(yt[4], yt[5]); w0_.w = cvtpk_h(yt[6], yt[7]); w1_.x = cvtpk_h(yt[8], yt[9]); w1_.y = cvtpk_h(yt[10], yt[11]); w1_.z = cvtpk_h(yt[12], yt[13]); w1_.w = cvtpk_h(yt[14], yt[15]);
          { bf16* dst = pre + 12288 + ((qn * 64 + (d ? 63 - mrow : mrow)) * 2 + hi) * 16; *(v4u*)dst = w0_; *(v4u*)(dst + 8) = w1_; } }
        WG_BARL();
    }
#undef LANE_VARS
#undef SNAT
}

constexpr int SCAN_SLOT = 12 * 1024, SCAN_NS = 4;
__device__ __forceinline__ void scan_issue(const bf16* pre, LAS unsigned char* slot, int l31, int hi, int v) {
#pragma unroll
    for (int i = 0; i < 8; ++i) { const int mt = i >> 2, kt = (i >> 1) & 1, s = i & 1;
        __builtin_amdgcn_global_load_lds((const unsigned*)(pre + (32 * mt + l31) * 64 + 32 * kt + 16 * s + 8 * hi), (LAS unsigned*)(slot + i * 1024), 16, 0, 0); }
#pragma unroll
    for (int i = 0; i < 4; ++i) { const int mt = i >> 1, hf = i & 1;
        __builtin_amdgcn_global_load_lds((const unsigned*)(pre + 8192 + ((mt * 64 + v) * 2 + hi) * 16 + 8 * hf), (LAS unsigned*)(slot + (8 + i) * 1024), 16, 0, 0); }
}
__device__ __forceinline__ void rwkv_scan_chunk(Frame& F, int unit) {
    unsigned char* const ws = kws();
    int lane_ = lane_id(); asm volatile("" : "+v"(lane_));
    const int lane = lane_, hi = lane >> 5, l31 = lane & 31;
    const int chain = unit >> 1, vh = unit & 1, v = 32 * vh + l31;
    const bf16* pre = (const bf16*)(ws + R_PRE) + (size_t)chain * 64 * 16384;
    bf16* sd = (bf16*)(ws + R_SD) + (size_t)chain * 64 * 4096;
    LAS unsigned char* const ring = F.lds;
    f32x16 X0, X1;
#pragma unroll
    for (int r = 0; r < 16; ++r) { X0[r] = 0.f; X1[r] = 0.f; }
    scan_issue(pre, ring, l31, hi, v); scan_issue(pre + 16384, ring + SCAN_SLOT, l31, hi, v); scan_issue(pre + 2 * 16384, ring + 2 * SCAN_SLOT, l31, hi, v);
#pragma unroll 1
    for (int c = 0; c < 64; ++c) {
        bf16x8 xb[2][2], xl[2][2];
#pragma unroll
        for (int kt = 0; kt < 2; ++kt)
#pragma unroll
            for (int s = 0; s < 2; ++s) { v4u w, wl;
#pragma unroll
                for (int j = 0; j < 4; ++j) { const float a0 = kt ? X1[8 * s + 2 * j] : X0[8 * s + 2 * j], a1 = kt ? X1[8 * s + 2 * j + 1] : X0[8 * s + 2 * j + 1];
                    const unsigned hw = cvtpk_h(a0, a1); const f32x2_t hf = unpk_h(hw); w[j] = hw; wl[j] = cvtpk_h(a0 - hf.x, a1 - hf.y); }
                xb[kt][s] = __builtin_bit_cast(bf16x8, w); xl[kt][s] = __builtin_bit_cast(bf16x8, wl);
                *(v4u*)(sd + (size_t)c * 4096 + ((kt * 64 + v) * 2 + hi) * 16 + 8 * s) = w; }
        asm volatile("s_waitcnt lgkmcnt(0)" ::: "memory");
        if (c + 3 < 64) scan_issue(pre + (size_t)(c + 3) * 16384, ring + ((c + 3) & 3) * SCAN_SLOT, l31, hi, v);
        if (c + 3 < 64) asm volatile("s_waitcnt vmcnt(36)" ::: "memory"); else asm volatile("s_waitcnt vmcnt(0)" ::: "memory");
        const LAS unsigned char* sl = ring + (c & 3) * SCAN_SLOT + lane * 16;
        f32x16 acc[2];
#pragma unroll
        for (int mt = 0; mt < 2; ++mt) { const v4u w0_ = *(const LAS v4u*)(sl + (8 + 2 * mt) * 1024), w1_ = *(const LAS v4u*)(sl + (9 + 2 * mt) * 1024);
#pragma unroll
            for (int j = 0; j < 4; ++j) { const f32x2_t u0 = unpk_h(w0_[j]), u1 = unpk_h(w1_[j]); acc[mt][2 * j] = u0.x; acc[mt][2 * j + 1] = u0.y; acc[mt][8 + 2 * j] = u1.x; acc[mt][8 + 2 * j + 1] = u1.y; } }
        bf16x8 pf[8];
#pragma unroll
        for (int i = 0; i < 8; ++i) pf[i] = *(const LAS bf16x8*)(sl + i * 1024);
        SBAR0();
#pragma unroll
        for (int mt = 0; mt < 2; ++mt)
#pragma unroll
            for (int kt = 0; kt < 2; ++kt)
#pragma unroll
                for (int s = 0; s < 2; ++s) { const bf16x8 af = pf[4 * mt + 2 * kt + s]; acc[mt] = MFMA32H(af, xb[kt][s], acc[mt]); acc[mt] = MFMA32H(af, xl[kt][s], acc[mt]); }
        X0 = acc[0]; X1 = acc[1];
    }
}

constexpr int FIN_SGS = 272;
__device__ __forceinline__ void rwkv_finalize_mfma(Frame& F, int layer) {
    unsigned char* const ws = kws();
    int lane_ = lane_id(); asm volatile("" : "+v"(lane_)); int wave_o = F.wv; asm volatile("" : "+s"(wave_o)); const int wave_ = wave_o, lane = lane_, hi = lane >> 5, l31 = lane & 31, h = wave_, hc = h * HD;
    LAS unsigned char* const sgt = F.lds;
    const bf16* Vr = (const bf16*)(ws + R_VR); const bf16* XL = (const bf16*)(ws + R_XL); bf16* MIX = (bf16*)(ws + R_MIX); const bf16* G2T = (const bf16*)(ws + WS_G2T);
    const float* BN0 = (const float*)(ws + R_BN); const float* BN1 = BN0 + (size_t)M * 8;
    const float* sp = karg(I_TSP) + layer * RPROJ; const float* sn = karg(I_TSN) + layer * RPROJ;
    const float* gnw = karg(I_GNW) + layer * 512 + hc; const float* gnb = karg(I_GNB) + layer * 512 + hc;
    for (int unit = F.vcu; unit < BATCH * (SEQ / 64); unit += F.G) {
        const int cn = unit & 63, b = unit >> 6, t0 = cn * 64;
        { const int tid = wave_ * 64 + lane, tok = tid >> 3, oct = tid & 7, t = t0 + tok, row = b * SEQ + t; float v8[8];
#pragma unroll
          for (int hf = 0; hf < 2; ++hf) { const int k0 = 16 * oct + 8 * hf;
              shift8(XL, 256, 128 + k0, row, t, sp + 1664 + k0, sn + 1664 + k0, v8);
              v4u w; w.x = cvtpk(sigmoidf_(v8[0]), sigmoidf_(v8[1])); w.y = cvtpk(sigmoidf_(v8[2]), sigmoidf_(v8[3])); w.z = cvtpk(sigmoidf_(v8[4]), sigmoidf_(v8[5])); w.w = cvtpk(sigmoidf_(v8[6]), sigmoidf_(v8[7]));
              *(LAS v4u*)(sgt + tok * FIN_SGS + 2 * k0) = w; } }
        WG_BAR();
        f32x16 acc[2][2], gg[2][2];
#pragma unroll
        for (int tt = 0; tt < 2; ++tt)
#pragma unroll
            for (int vt = 0; vt < 2; ++vt)
#pragma unroll
                for (int r = 0; r < 16; ++r) { acc[tt][vt][r] = 0.f; gg[tt][vt][r] = 0.f; }
#pragma unroll
        for (int d = 0; d < 2; ++d) { const size_t item = (size_t)(((b * 8 + h) * 2 + d) * 64 + (d ? 63 - cn : cn));
            const bf16* pre = (const bf16*)(ws + R_PRE) + item * 16384; const bf16* sd = (const bf16*)(ws + R_SD) + item * 4096;
#pragma unroll
            for (int tt = 0; tt < 2; ++tt)
#pragma unroll
                for (int vt = 0; vt < 2; ++vt) { const bf16* src = pre + 12288 + ((vt * 64 + 32 * tt + l31) * 2 + hi) * 16; const v4u w0_ = *(const v4u*)src, w1_ = *(const v4u*)(src + 8);
#pragma unroll
                    for (int j = 0; j < 4; ++j) { const f32x2_t u0 = unpk_h(w0_[j]), u1 = unpk_h(w1_[j]); acc[tt][vt][2 * j] += u0.x; acc[tt][vt][2 * j + 1] += u0.y; acc[tt][vt][8 + 2 * j] += u1.x; acc[tt][vt][8 + 2 * j + 1] += u1.y; } }
            bf16x8 sf[4][2], rf[4][2];
#pragma unroll
            for (int ks = 0; ks < 4; ++ks) { const int kt = ks >> 1, s = ks & 1;
#pragma unroll
                for (int vt = 0; vt < 2; ++vt) sf[ks][vt] = *(const bf16x8*)(sd + ((kt * 64 + 32 * vt + l31) * 2 + hi) * 16 + 8 * s);
#pragma unroll
                for (int tt = 0; tt < 2; ++tt) rf[ks][tt] = *(const bf16x8*)(pre + 4096 + (32 * tt + l31) * 64 + 32 * kt + 16 * s + 8 * hi); }
            SBAR0();
#pragma unroll
            for (int ks = 0; ks < 4; ++ks)
#pragma unroll
                for (int tt = 0; tt < 2; ++tt)
#pragma unroll
                    for (int vt = 0; vt < 2; ++vt) acc[tt][vt] = MFMA32H(sf[ks][vt], rf[ks][tt], acc[tt][vt]); }
#pragma unroll
        for (int kh = 0; kh < 2; ++kh) { bf16x8 gf[4][2], tf[4][2];
#pragma unroll
            for (int k4 = 0; k4 < 4; ++k4) { const int ks = 4 * kh + k4;
#pragma unroll
                for (int vt = 0; vt < 2; ++vt) gf[k4][vt] = *(const bf16x8*)(G2T + (size_t)(hc + 32 * vt + l31) * 128 + 16 * ks + 8 * hi);
#pragma unroll
                for (int tt = 0; tt < 2; ++tt) tf[k4][tt] = *(const LAS bf16x8*)(sgt + (32 * tt + l31) * FIN_SGS + (16 * ks + 8 * hi) * 2); }
            SBAR0();
#pragma unroll
            for (int k4 = 0; k4 < 4; ++k4)
#pragma unroll
                for (int tt = 0; tt < 2; ++tt)
#pragma unroll
                    for (int vt = 0; vt < 2; ++vt) gg[tt][vt] = MFMA32(gf[k4][vt], tf[k4][tt], gg[tt][vt]);
            SBAR0(); }
#pragma unroll
        for (int tt = 0; tt < 2; ++tt) { const int t = t0 + 32 * tt + l31, row = b * SEQ + t;
            float sm = 0.f;
#pragma unroll
            for (int vt = 0; vt < 2; ++vt)
#pragma unroll
                for (int r = 0; r < 16; ++r) sm += acc[tt][vt][r];
            sm += pg8::shx(sm, 32, lane); const float mu = sm * (1.0f / 64.0f); float sq = 0.f;
#pragma unroll
            for (int vt = 0; vt < 2; ++vt)
#pragma unroll
                for (int r = 0; r < 16; ++r) { const float dl = acc[tt][vt][r] - mu; sq += dl * dl; }
            sq += pg8::shx(sq, 32, lane); const float rstd = 1.0f / sqrtf(sq * (1.0f / 64.0f) + GN_EPS);
            const float bon = BN0[(size_t)row * 8 + h] + BN1[(size_t)row * 8 + h];
#pragma unroll
            for (int vt = 0; vt < 2; ++vt)
#pragma unroll
                for (int q = 0; q < 4; ++q) { const int v0 = 32 * vt + 8 * q + 4 * hi;
                    const f32x4 vs = shift4(Vr, 512, hc + v0, row, t, sp + 1024 + hc + v0, sn + 1024 + hc + v0), w4 = *(const f32x4*)(gnw + v0), b4 = *(const f32x4*)(gnb + v0);
                    float o4[4];
#pragma unroll
                    for (int i = 0; i < 4; ++i) o4[i] = ((acc[tt][vt][4 * q + i] - mu) * rstd * w4[i] + b4[i] + bon * vs[i]) * gg[tt][vt][4 * q + i];
                    u32x2_t w; w.x = cvtpk(o4[0], o4[1]); w.y = cvtpk(o4[2], o4[3]); *(u32x2_t*)(MIX + (size_t)row * 1024 + 512 + hc + v0) = w; } }
        WG_BAR();
    }
}

constexpr int ATT_O = 0, ATT_L = 65536, ATT_V = 67584, ATT_VT = 32 * TSB;
static_assert(ATT_V + NWAVES * ATT_VT <= LDSCTL_OFF, "attention LDS map");
__device__ __forceinline__ bf16x8 frag_tr_pv(const LAS unsigned char* tile, int d0, int s, int lane) {
    const int hi = lane >> 5, g1 = (lane >> 4) & 1, i = lane & 15;
    const LAS unsigned char* p = tile + (16 * s + 4 * hi + (i >> 2)) * TSB + (d0 + 16 * g1 + 4 * (i & 3)) * 2;
    const s16x4 lo = tr4(p), h4 = tr4(p + 8 * TSB);
    return (bf16x8){lo[0], lo[1], lo[2], lo[3], h4[0], h4[1], h4[2], h4[3]};
}
template <int NQH>
__device__ __forceinline__ void attn_block(const bf16* MIX, const bf16* V, LAS unsigned char* lds, LAS unsigned char* vt, int b, int h, int T0, int tq0, int d, float slope_d, float bound, bool first, int lane_in) {
    int lane = lane_in; asm volatile("" : "+v"(lane));
    const int hi = lane >> 5, l31 = lane & 31;
    const int jlo = -(tq0 / d), jhi = (SEQ - 1 - tq0) / d;
    bf16x8 qf[NQH][4];
#pragma unroll
    for (int qh = 0; qh < NQH; ++qh) { const bf16* qp = MIX + ((size_t)b * SEQ + tq0 + d * (32 * qh + l31)) * 1024 + h * HD + 8 * hi;
#pragma unroll
        for (int ks = 0; ks < 4; ++ks) qf[qh][ks] = *(const bf16x8*)(qp + 16 * ks); }
    f32x16 o[NQH][2]; float lsum[NQH];
#pragma unroll
    for (int qh = 0; qh < NQH; ++qh) { lsum[qh] = 0.f;
#pragma unroll
        for (int r = 0; r < 16; ++r) { o[qh][0][r] = 0.f; o[qh][1][r] = 0.f; } }
    constexpr int NT = NQH == 2 ? 6 : 5;
    v4u vraw[4]; bf16x8 kn[4];
#define ATT_LOAD(JT) do { { const int kr_ = lane >> 1, hf_ = lane & 1; int pos_ = tq0 + d * (32 * (JT) + kr_ - 64); pos_ = pos_ < 0 ? 0 : (pos_ > SEQ - 1 ? SEQ - 1 : pos_); \
          const v4u* src_ = (const v4u*)(V + ((size_t)b * SEQ + pos_) * 512 + h * HD + 32 * hf_); vraw[0] = src_[0]; vraw[1] = src_[1]; vraw[2] = src_[2]; vraw[3] = src_[3]; } \
        { int pos_ = tq0 + d * (32 * (JT) + l31 - 64); pos_ = pos_ < 0 ? 0 : (pos_ > SEQ - 1 ? SEQ - 1 : pos_); const bf16* kp_ = MIX + ((size_t)b * SEQ + pos_) * 1024 + 512 + h * HD + 8 * hi; \
          _Pragma("unroll") for (int ks = 0; ks < 4; ++ks) kn[ks] = *(const bf16x8*)(kp_ + 16 * ks); } } while (0)
    ATT_LOAD(0);
#pragma unroll 1
    for (int jt = 0; jt < NT; ++jt) {
        bf16x8 kf[4];
        { LAS v4u* dst = (LAS v4u*)(vt + (lane >> 1) * TSB + 64 * (lane & 1)); dst[0] = vraw[0]; dst[1] = vraw[1]; dst[2] = vraw[2]; dst[3] = vraw[3]; }
#pragma unroll
        for (int ks = 0; ks < 4; ++ks) kf[ks] = kn[ks];
        if (jt + 1 < NT) ATT_LOAD(jt + 1);
        asm volatile("s_waitcnt lgkmcnt(0)" ::: "memory");
        bf16x8 vfr[2][2];
#pragma unroll
        for (int dt = 0; dt < 2; ++dt)
#pragma unroll
            for (int s2 = 0; s2 < 2; ++s2) vfr[dt][s2] = frag_tr_pv(vt, 32 * dt, s2, lane);
        const bool inseq = (32 * jt - 64 >= jlo) && (32 * jt - 33 <= jhi);
#pragma unroll
        for (int qh = 0; qh < NQH; ++qh) {
            if (NQH == 2 && ((qh == 0 && jt == 5) || (qh == 1 && jt == 0))) continue;
            const float fb = (float)(32 * qh + l31 - (32 * jt + 4 * hi - 64)); const int rel = jt - qh;
            f32x16 s;
            if (inseq && rel == 1) { const float A = fmaf(-slope_d, fb, -bound);
#pragma unroll
                for (int r = 0; r < 16; ++r) s[r] = fmaf(slope_d, (float)((r & 3) + 8 * (r >> 2)), A);
            } else if (inseq && rel == 3) { const float A = fmaf(slope_d, fb, -bound);
#pragma unroll
                for (int r = 0; r < 16; ++r) s[r] = fmaf(-slope_d, (float)((r & 3) + 8 * (r >> 2)), A);
            } else if (inseq && rel == 2) {
#pragma unroll
                for (int r = 0; r < 16; ++r) s[r] = fmaf(-slope_d, fabsf(fb - (float)((r & 3) + 8 * (r >> 2))), -bound);
            } else if (inseq) {
#pragma unroll
                for (int r = 0; r < 16; ++r) { const float t = fabsf(fb - (float)((r & 3) + 8 * (r >> 2))); s[r] = (t <= 64.0f) ? fmaf(-slope_d, t, -bound) : -1e30f; }
            } else {
#pragma unroll
                for (int r = 0; r < 16; ++r) { const int cr = (r & 3) + 8 * (r >> 2), jj = 32 * jt + cr + 4 * hi - 64; const float t = fabsf(fb - (float)cr);
                    s[r] = ((t <= 64.0f) && (jj >= jlo) && (jj <= jhi)) ? fmaf(-slope_d, t, -bound) : -1e30f; }
            }
#pragma unroll
            for (int ks = 0; ks < 4; ++ks) s = MFMA32(kf[ks], qf[qh][ks], s);
            v4u pk[2];
#pragma unroll
            for (int r = 0; r < 16; r += 2) { const float p0 = __builtin_amdgcn_exp2f(s[r]), p1 = __builtin_amdgcn_exp2f(s[r + 1]); lsum[qh] += p0 + p1; pk[r >> 3][(r >> 1) & 3] = cvtpk(p0, p1); }
#pragma unroll
            for (int dt = 0; dt < 2; ++dt)
#pragma unroll
                for (int s2 = 0; s2 < 2; ++s2) o[qh][dt] = MFMA32(vfr[dt][s2], __builtin_bit_cast(bf16x8, pk[s2]), o[qh][dt]);
        }
    }
#undef ATT_LOAD
    int lane2 = lane; asm volatile("" : "+v"(lane2));
#pragma unroll
    for (int qh = 0; qh < NQH; ++qh) { const int hi = lane2 >> 5, l31 = lane2 & 31, lane = lane2;
        const int qi = (tq0 - T0) + d * (32 * qh + l31);
        const float lt = lsum[qh] + pg8::shx(lsum[qh], 32, lane);
        if (hi == 0) { LAS float* lp = (LAS float*)(lds + ATT_L) + qi; *lp = first ? lt : (*lp + lt); }
#pragma unroll
        for (int dt = 0; dt < 2; ++dt)
#pragma unroll
            for (int q = 0; q < 4; ++q) { const int d0 = 32 * dt + 8 * q + 4 * hi; LAS u32x2_t* op = (LAS u32x2_t*)(lds + ATT_O + qi * 128 + ((((d0 >> 3) ^ (qi & 7)) << 4) | ((d0 & 4) << 1)));
                float v0 = o[qh][dt][4 * q], v1 = o[qh][dt][4 * q + 1], v2 = o[qh][dt][4 * q + 2], v3 = o[qh][dt][4 * q + 3];
                if (!first) { const u32x2_t w = *op; v0 += __uint_as_float(w.x << 16); v1 += __uint_as_float(w.x & 0xffff0000u); v2 += __uint_as_float(w.y << 16); v3 += __uint_as_float(w.y & 0xffff0000u); }
                u32x2_t w; w.x = cvtpk(v0, v1); w.y = cvtpk(v2, v3); *op = w; }
    }
}
__device__ __forceinline__ void attn_phase_mfma(Frame& F, int layer, int unit0, int nunit, int ustride) {
    unsigned char* const ws = kws();
    int lane_ = lane_id(); asm volatile("" : "+v"(lane_)); int wave_o = F.wv; asm volatile("" : "+s"(wave_o)); const int wave_ = wave_o, lane = lane_;
    bf16* MIX = (bf16*)(ws + R_MIX); const bf16* V = (const bf16*)(ws + R_V);
    LAS unsigned char* const lds = F.lds; LAS unsigned char* const vt = lds + ATT_V + wave_ * ATT_VT;
    float bound;
    { const float* qg = karg(I_QG) + layer * HD; const float* kg = karg(I_KG) + layer * HD; float mq = 0.f, mk = 0.f;
      for (int i = 0; i < HD; ++i) { mq = fmaxf(mq, fabsf(qg[i])); mk = fmaxf(mk, fabsf(kg[i])); }
      bound = (8.0f * mq * mk + 0.25f) * 1.4426950408889634f; }
    for (int unit = unit0; unit < nunit; unit += ustride) {
        const int st = unit & 7, h = (unit >> 3) & 7, b = unit >> 6, T0 = st * 512;
        const float slope = exp2f(-(float)(h + 1)) * 1.4426950408889634f;
        attn_block<2>(MIX, V, lds, vt, b, h, T0, T0 + 64 * wave_, 1, slope, bound, true, lane);
        WG_BAR();
        attn_block<2>(MIX, V, lds, vt, b, h, T0, T0 + (wave_ & 3) + 256 * (wave_ >> 2), 4, slope * 4.f, bound, false, lane);
        WG_BAR();
        attn_block<1>(MIX, V, lds, vt, b, h, T0, T0 + 2 * wave_, 16, slope * 16.f, bound, false, lane);
        attn_block<1>(MIX, V, lds, vt, b, h, T0, T0 + 2 * wave_ + 1, 16, slope * 16.f, bound, false, lane);
        WG_BAR();
        { int lane3 = lane; asm volatile("" : "+v"(lane3)); const int tid = wave_ * 64 + lane3;
#pragma unroll
          for (int k = 0; k < 8; ++k) { const int item = tid + 512 * k, qi = item >> 3, c16 = item & 7;
              const v4u w = *(const LAS v4u*)(lds + ATT_O + qi * 128 + ((c16 ^ (qi & 7)) << 4)); const float il = 1.0f / ((const LAS float*)(lds + ATT_L))[qi];
              v4u o;
#pragma unroll
              for (int j = 0; j < 4; ++j) o[j] = cvtpk(__uint_as_float(w[j] << 16) * il, __uint_as_float(w[j] & 0xffff0000u) * il);
              *(v4u*)(MIX + ((size_t)b * SEQ + T0 + qi) * 1024 + h * HD + 8 * c16) = o; } }
        WG_BAR();
    }
}

__global__ void __launch_bounds__(NTHR, 2) mk_fwd(Args args) {
    extern __shared__ __attribute__((aligned(16))) unsigned char lds[];
    Frame F;
    F.lds = (LAS unsigned char*)lds;
    F.MISC = (volatile LAS unsigned*)(F.lds + MISC_OFF);
    F.wv = __builtin_amdgcn_readfirstlane((int)threadIdx.x >> 6);
    F.G = gridDim.x; { const int bx = blockIdx.x; F.vcu = (F.G % 8 == 0) ? (bx % 8) * (F.G / 8) + bx / 8 : bx; }
    F.ctl = (gu32*)(kws() + WS_CTL);
    for (int u = F.wv * 64 + lane_id(); u < (LDS_BYTES - LDSCTL_OFF) / 4; u += NTHR) ((LAS unsigned*)(F.lds + LDSCTL_OFF))[u] = 0u;
    __syncthreads();
    XcdBarrier bar = xcd_barrier_post((unsigned*)(F.ctl + CW_BAR), F.MISC + 8, F.wv == 0 && lane_id() == 0);
#define GRID_BAR() xcd_barrier(bar, F.wv == 0 && lane_id() == 0)
#define XB ((bf16*)(ws + R_XB))
#define MIXB ((bf16*)(ws + R_MIX))
#define HID ((bf16*)(ws + R_HID))
#define SS1 ((float*)(ws + WS_SS1))
#define SS2 ((float*)(ws + WS_SS2))

    for (int step = 0; step < 8 * DEPTH; ++step) {
        const int layer = step >> 3, kind = step & 7;
        if (kind == 0) {
            if (layer > 0) continue;
            x_prologue(F);
            { int lane_ = lane_id(); asm volatile("" : "+v"(lane_)); wconv_items(0, -1, F.vcu * NWAVES + F.wv, F.G * NWAVES, (LAS float*)(F.lds + RING_OFF + F.wv * 16384), lane_); }
        } else if (kind == 1) {
            unsigned char* const ws = kws();
            pg8::Gemm g{XB, (const bf16*)(ws + WS_WIN), M, NPROJ, D}; pg8::StaticOrder S; S.init(M, NPROJ, F.G, (int)blockIdx.x);
            pg8::EpiProj E; E.base0 = (bf16*)(ws + WS_R0); E.ss = SS1; E.qg = karg(I_QG) + layer * HD; E.kg = karg(I_KG) + layer * HD;
            pg8::gemm_phase<pg8::EpiProj, pg8::StaticOrder, true, true>(F.lds + RING_OFF, g, S, E, F.wv, lane_id());
        } else if (kind == 2) {
            rwkv_pre_phase(F, layer);
        } else if (kind == 3) {
            const int bx = (int)blockIdx.x;
            if (bx < 128) { if (F.wv == 0) rwkv_scan_chunk(F, bx);
                            else { int lane_ = lane_id(); asm volatile("" : "+v"(lane_)); wconv_items(layer + 1, layer, bx * 7 + F.wv - 1, 128 * 7, (LAS float*)(F.lds + SCAN_NS * SCAN_SLOT + (F.wv - 1) * 9216), lane_); } }
            else attn_phase_mfma(F, layer, bx - 128, BATCH * H * 8, F.G - 128);
        } else if (kind == 4) {
            rwkv_finalize_mfma(F, layer);
        } else if (kind == 5 || kind == 7) {
            unsigned char* const ws = kws(); float* const xo = kout();
            pg8::Gemm g{kind == 5 ? MIXB : HID, (const bf16*)(ws + (kind == 5 ? WS_WOUT : WS_WDN)), M, D, kind == 5 ? D : FF}; pg8::StaticOrder S; S.init(M, D, F.G, (int)blockIdx.x);
            pg8::EpiRes E{xo, XB, kind == 5 ? SS2 : SS1};
            pg8::gemm_phase<pg8::EpiRes, pg8::StaticOrder, false, true>(F.lds + RING_OFF, g, S, E, F.wv, lane_id());
        } else {
            unsigned char* const ws = kws();
            pg8::Gemm g{XB, (const bf16*)(ws + WS_WUP), M, FF, D}; pg8::StaticOrder S; S.init(M, FF, F.G, (int)blockIdx.x);
            pg8::EpiUp E{HID, SS2};
            pg8::gemm_phase<pg8::EpiUp, pg8::StaticOrder, true, true>(F.lds + RING_OFF, g, S, E, F.wv, lane_id());
        }
        if (step + 1 < 8 * DEPTH) GRID_BAR();
    }
}

extern "C" void kernel_launch(void* const* d_in, const int* in_sizes, int n_in, void* d_out, int out_size, void* d_ws, size_t ws_size, hipStream_t stream) {
    static int grid = 0;
    if (grid == 0) {
        if (n_in != N_IN || in_sizes[0] != M * D || out_size != M * D || ws_size < WS_END) { fprintf(stderr, "kernel_launch: unexpected shapes (n_in %d, in0 %d, out %d, ws %zu)\n", n_in, n_in > 0 ? in_sizes[0] : -1, out_size, ws_size); grid = -1; return; }
        int dev = 0, cus = 0;
        if (hipGetDevice(&dev) != hipSuccess || hipDeviceGetAttribute(&cus, hipDeviceAttributeMultiprocessorCount, dev) != hipSuccess) { grid = -1; return; }
        if (hipFuncSetAttribute((const void*)mk_fwd, hipFuncAttributeMaxDynamicSharedMemorySize, LDS_BYTES) != hipSuccess) { fprintf(stderr, "kernel_launch: hipFuncSetAttribute failed\n"); grid = -1; return; }
        int per_cu = 0;
        (void)hipOccupancyMaxActiveBlocksPerMultiprocessor(&per_cu, (const void*)mk_fwd, NTHR, LDS_BYTES);
        (void)hipGetLastError();
        grid = cus;
    }
    if (grid < 0) return;
    (void)hipMemsetAsync((char*)d_ws + WS_CTL, 0, CTL_ZERO_BYTES, stream);
    Args a{};
    for (int i = 0; i < N_IN; ++i) a.in[i] = (const float*)d_in[i];
    a.out = (float*)d_out; a.ws = (unsigned char*)d_ws;
    hipLaunchKernelGGL(mk_fwd, dim3(grid), dim3(NTHR), LDS_BYTES, stream, a);
}
```

```cpp
#include <hip/hip_runtime.h>
#include <cstdio>
#include <cstdint>
namespace pg8 {
#define PG8_LAS __attribute__((address_space(3)))
typedef unsigned short bf16_t;
typedef short bf16x8 __attribute__((ext_vector_type(8)));
typedef float f32x4 __attribute__((ext_vector_type(4)));
typedef unsigned u32x4 __attribute__((ext_vector_type(4)));
constexpr int BM = 256, BK = 64, HALF = 128, HTB = HALF * BK * 2  , STAGE_BYTES = 8 * HTB, NXCD = 8, WGM = 8;

__host__ __device__ __forceinline__ int lds_byte(int r, int c) { const int st = (r >> 4) * 2 + (c >> 5), rr = r & 15, cc = c & 31, ob = rr * 64 + cc * 2; return st * 1024 + (ob ^ (((ob >> 9) & 1) << 5)); }
__host__ __device__ __forceinline__ void stage_rc(int b, int& R, int& C) { const int st = b / 1024, sb = b % 1024, swz = sb ^ (((sb >> 9) & 1) << 5); R = (st >> 1) * 16 + swz / 64; C = (st & 1) * 32 + (swz % 64) / 2; }
__host__ __device__ __forceinline__ int perm32(int rho) { const int n = rho >> 4, i = rho & 15; return 8 * (i >> 2) + 4 * n + (i & 3); }

struct Unit { int pm, pn; };
struct Gemm { const bf16_t* A; const bf16_t* Bt; int M, N, K; };

struct StaticOrder {
    int nM, nN, nwg, G, c;
    __host__ __device__ void init(int M, int N, int G_, int c_) { nM = M / BM; nN = N / BM; nwg = nM * nN; G = G_; c = c_; }
    __host__ __device__ bool next(int i, Unit& u) const {
        const long L = (long)i * G + c; if (L >= nwg) return false;
        int wgid = (int)L; { const int q = nwg / NXCD, r = nwg % NXCD, xcd = wgid % NXCD, off = wgid / NXCD; wgid = (xcd < r ? xcd * (q + 1) : r * (q + 1) + (xcd - r) * q) + off; }
        const int nig = WGM * nN, gid = wgid / nig, fm = gid * WGM, gsz = (nM - fm) < WGM ? (nM - fm) : WGM;
        u.pm = fm + ((wgid % nig) % gsz); u.pn = (wgid % nig) / gsz; return true;
    }
    __device__ __forceinline__ void a_ready(const Unit&) const {}
    __device__ __forceinline__ void done(const Unit&) const {}
};

__device__ __forceinline__ unsigned cvt_pk_bf16(float lo, float hi) { unsigned r; asm volatile("v_cvt_pk_bf16_f32 %0, %1, %2" : "=v"(r) : "v"(lo), "v"(hi)); return r; }
typedef unsigned u32x2 __attribute__((ext_vector_type(2)));

__device__ __forceinline__ float shx(float v, int m, int lane) { return __int_as_float(__builtin_amdgcn_ds_bpermute((lane ^ m) << 2, __float_as_int(v))); }
__device__ __forceinline__ float row_rs(const float* ss, int row, int fq, int lane) {
    const f32x4 p = *(const f32x4*)(ss + (size_t)row * 16 + 4 * fq);
    float s = (p[0] + p[1]) + (p[2] + p[3]);
    s += shx(s, 16, lane); s += shx(s, 32, lane);
    return 1.0f / sqrtf(s * (1.0f / 1024.0f) + 1e-6f);
}

struct EpiProj {
    static constexpr bool PERM = true, AFTER_DRAIN = false;
    bf16_t* base0; const float* ss; const float* qg; const float* kg;
    __device__ __forceinline__ void operator()(const f32x4 (&acc)[2][2][4][2], const Unit& u, int wr, int wc, int fr, int fq) const {
        const int tile = u.pn, di = tile >> 1;
        bf16_t* base = base0 + (di < 2 ? (size_t)di * 512 : (size_t)di * (8u << 20)); const int ldc = (di < 2) ? 1024 : ((di == 6) ? 256 : 512); const int cb = (di == 6) ? 0 : (tile & 1) * 256;
        const bool nrm = tile < 4; const float* gsrc = (tile < 2) ? qg : kg; const float post = (tile < 2) ? 0.125f * 1.4426950408889634f : 1.0f;
        f32x4 g[2][2];
#pragma unroll
        for (int bj = 0; bj < 2; ++bj)
#pragma unroll
            for (int n = 0; n < 2; ++n) g[bj][n] = nrm ? *(const f32x4*)(gsrc + 32 * bj + 8 * fq + 4 * n) * post : (f32x4){1.f, 1.f, 1.f, 1.f};
#pragma unroll
        for (int ai = 0; ai < 2; ++ai)
#pragma unroll
            for (int m = 0; m < 4; ++m) {
                const int row = u.pm * BM + ai * HALF + wr * 64 + m * 16 + fr;
                const float rs = row_rs(ss, row, fq, 16 * fq + fr);
                f32x4 v[2][2]; float q = 0.f;
#pragma unroll
                for (int bj = 0; bj < 2; ++bj)
#pragma unroll
                    for (int n = 0; n < 2; ++n) { v[bj][n] = acc[ai][bj][m][n] * rs; const f32x4 t = v[bj][n]; q += (t[0] * t[0] + t[1] * t[1]) + (t[2] * t[2] + t[3] * t[3]); }
                q += shx(q, 16, 16 * fq + fr); q += shx(q, 32, 16 * fq + fr);
                const float inv = nrm ? 1.0f / sqrtf(q * (1.0f / 64.0f) + 1e-6f) : 1.0f;
                bf16_t* rowp = base + (size_t)row * ldc + cb + 64 * wc + 8 * fq;
#pragma unroll
                for (int bj = 0; bj < 2; ++bj) { const f32x4 v0 = v[bj][0] * inv * g[bj][0], v1 = v[bj][1] * inv * g[bj][1];
                    u32x4 w; w.x = cvt_pk_bf16(v0[0], v0[1]); w.y = cvt_pk_bf16(v0[2], v0[3]); w.z = cvt_pk_bf16(v1[0], v1[1]); w.w = cvt_pk_bf16(v1[2], v1[3]);
                    *(u32x4*)(rowp + 32 * bj) = w; }
                asm volatile("" ::: "memory");
            }
    }
};
struct EpiUp {
    static constexpr bool PERM = true, AFTER_DRAIN = false;
    bf16_t* O; const float* ss;
    __device__ __forceinline__ void operator()(const f32x4 (&acc)[2][2][4][2], const Unit& u, int wr, int wc, int fr, int fq) const {
#pragma unroll
        for (int ai = 0; ai < 2; ++ai)
#pragma unroll
            for (int m = 0; m < 4; ++m) {
                const int row = u.pm * BM + ai * HALF + wr * 64 + m * 16 + fr;
                const float rs = row_rs(ss, row, fq, 16 * fq + fr);
                bf16_t* rowp = O + (size_t)row * 4096 + u.pn * BM + wc * 32 + 8 * fq;
#pragma unroll
                for (int bj = 0; bj < 2; ++bj) { f32x4 v0 = acc[ai][bj][m][0] * rs, v1 = acc[ai][bj][m][1] * rs;
                    v0 = __builtin_elementwise_max(v0, (f32x4){0.f, 0.f, 0.f, 0.f}); v1 = __builtin_elementwise_max(v1, (f32x4){0.f, 0.f, 0.f, 0.f}); v0 = v0 * v0; v1 = v1 * v1;
                    u32x4 w; w.x = cvt_pk_bf16(v0[0], v0[1]); w.y = cvt_pk_bf16(v0[2], v0[3]); w.z = cvt_pk_bf16(v1[0], v1[1]); w.w = cvt_pk_bf16(v1[2], v1[3]);
                    *(u32x4*)(rowp + bj * HALF) = w; }
                asm volatile("" ::: "memory");
            }
    }
};
struct EpiRes {
    static constexpr bool PERM = false, AFTER_DRAIN = false;
    float* x; bf16_t* xb; float* ss;
    __device__ __forceinline__ void operator()(const f32x4 (&acc)[2][2][4][2], const Unit& u, int wr, int wc, int fr, int fq) const {
        const int col0 = u.pn * BM + wc * 32 + 4 * fq;
#pragma unroll
        for (int ai = 0; ai < 2; ++ai)
#pragma unroll
            for (int m = 0; m < 4; ++m) {
                const int row = u.pm * BM + ai * HALF + wr * 64 + m * 16 + fr; const size_t off = (size_t)row * 1024 + col0; float q = 0.f;
#pragma unroll
                for (int bj = 0; bj < 2; ++bj)
#pragma unroll
                    for (int n = 0; n < 2; ++n) { const size_t o = off + bj * HALF + n * 16; const f32x4 t = *(const f32x4*)(x + o) + acc[ai][bj][m][n];
                        *(f32x4*)(x + o) = t; u32x2 w; w.x = cvt_pk_bf16(t[0], t[1]); w.y = cvt_pk_bf16(t[2], t[3]); *(u32x2*)(xb + o) = w;
                        q += (t[0] * t[0] + t[1] * t[1]) + (t[2] * t[2] + t[3] * t[3]); }
                q += shx(q, 16, 16 * fq + fr); q += shx(q, 32, 16 * fq + fr);
                if (fq == 0) ss[(size_t)row * 16 + 4 * u.pn + wc] = q;
                asm volatile("" ::: "memory");
            }
    }
};

template <class Epi, class Sched, bool ALIGN_EPI = false, bool SP2 = false>
__device__ __forceinline__ void gemm_phase(PG8_LAS unsigned char* lds, const Gemm g, const Sched& S, const Epi& E, int wave_in, int lane_in) {
    int lane_o = lane_in, wave_o = wave_in; asm volatile("" : "+v"(lane_o)); asm volatile("" : "+s"(wave_o)); const int tid_ = wave_o * 64 + lane_o;
    const int tid = tid_, wid = wave_o, lane = lane_o, wr = wid >> 2, wc = wid & 3, fr = lane & 15, fq = lane >> 4;
    const int K = g.K, nt = K / BK;
    unsigned voffA[2], voffB[2];
#pragma unroll
    for (int i = 0; i < 2; ++i) { int R, C; stage_rc(tid * 16 + i * 8192, R, C); const int Rb = Epi::PERM ? ((R & ~31) + perm32(R & 31)) : R;
        voffA[i] = (unsigned)(R * K + C) * 2u; voffB[i] = (unsigned)(Rb * K + C) * 2u; }
    const size_t kstep = (size_t)(BK * 2);
    const size_t hstep = (size_t)HALF * K * 2;
    const size_t tstep = 2 * hstep;
    const unsigned ldsw = (unsigned)wid * 1024u;
    const int aoff = lds_byte(wr * 64 + fr, fq * 8), boff = lds_byte(wc * 32 + fr, fq * 8);
#define PG8_SA(b, h) (((b) * 2 + (h)) * HTB)
#define PG8_SB(b, h) ((4 + (b) * 2 + (h)) * HTB)
#define PG8_STAGE(bufoff, gbase, voff) do { _Pragma("unroll") for (int _i = 0; _i < 2; ++_i) \
        __builtin_amdgcn_global_load_lds((const unsigned*)((const char*)(gbase) + (voff)[_i]), (PG8_LAS unsigned*)(lds + (bufoff) + ldsw + _i * 8192), 16, 0, 0); } while (0)
#define PG8_LDA(dst, b, h) do { _Pragma("unroll") for (int m = 0; m < 4; ++m) _Pragma("unroll") for (int k = 0; k < 2; ++k) dst[m][k] = *(const PG8_LAS bf16x8*)(lds + PG8_SA(b, h) + aoff + m * 2048 + k * 1024); } while (0)
#define PG8_LDB(dst, b, h) do { _Pragma("unroll") for (int n = 0; n < 2; ++n) _Pragma("unroll") for (int k = 0; k < 2; ++k) dst[n][k] = *(const PG8_LAS bf16x8*)(lds + PG8_SB(b, h) + boff + n * 2048 + k * 1024); } while (0)
#define PG8_MMA(ai, bj, At, Bt) do { __builtin_amdgcn_s_setprio(1); _Pragma("unroll") for (int m = 0; m < 4; ++m) _Pragma("unroll") for (int n = 0; n < 2; ++n) _Pragma("unroll") for (int k = 0; k < 2; ++k) \
        acc[ai][bj][m][n] = __builtin_amdgcn_mfma_f32_16x16x32_bf16(Bt[n][k], At[m][k], acc[ai][bj][m][n], 0, 0, 0); __builtin_amdgcn_s_setprio(0); } while (0)
#define PG8_WAIT_V(n) asm volatile("s_waitcnt vmcnt(" #n ")" ::: "memory")
#define PG8_WAIT_L(n) asm volatile("s_waitcnt lgkmcnt(" #n ")" ::: "memory")
#define PG8_BAR __builtin_amdgcn_s_barrier()
#define PG8_SCHED __builtin_amdgcn_sched_barrier(0)
    Unit cur, nxt; int ui = 0;
    if (!S.next(0, cur)) return;
    f32x4 acc[2][2][4][2];
#pragma unroll
    for (int a = 0; a < 2; ++a)
#pragma unroll
        for (int b = 0; b < 2; ++b)
#pragma unroll
            for (int m = 0; m < 4; ++m)
#pragma unroll
                for (int n = 0; n < 2; ++n) acc[a][b][m][n] = (f32x4){0.f, 0.f, 0.f, 0.f};
    bf16x8 At[4][2], B0[2][2], B1[2][2];
    const char* cA = (const char*)g.A + (size_t)cur.pm * tstep; const char* cB = (const char*)g.Bt + (size_t)cur.pn * tstep;
    S.a_ready(cur);
    if constexpr (SP2) {
        PG8_STAGE(PG8_SB(0, 0), cB, voffB); PG8_STAGE(PG8_SB(0, 1), cB + hstep, voffB); PG8_STAGE(PG8_SA(0, 0), cA, voffA); PG8_STAGE(PG8_SA(0, 1), cA + hstep, voffA);
        if (wr == 1) PG8_BAR;
        PG8_WAIT_V(2); PG8_BAR;
        PG8_STAGE(PG8_SB(1, 0), cB + kstep, voffB); PG8_STAGE(PG8_SA(1, 0), cA + kstep, voffA); PG8_STAGE(PG8_SB(1, 1), cB + hstep + kstep, voffB);
        PG8_WAIT_V(6); PG8_BAR;
    } else {
        PG8_STAGE(PG8_SB(0, 0), cB, voffB); PG8_STAGE(PG8_SA(0, 0), cA, voffA); PG8_STAGE(PG8_SB(0, 1), cB + hstep, voffB); PG8_STAGE(PG8_SA(0, 1), cA + hstep, voffA);
        if (wr == 1) PG8_BAR;
        PG8_WAIT_V(4); PG8_BAR;
        PG8_STAGE(PG8_SB(1, 0), cB + kstep, voffB); PG8_STAGE(PG8_SA(1, 0), cA + kstep, voffA); PG8_STAGE(PG8_SB(1, 1), cB + hstep + kstep, voffB);
        PG8_WAIT_V(6); PG8_BAR;
    }
    for (;;) {
        const bool has_next = S.next(ui + 1, nxt);
        const char* nA = has_next ? (const char*)g.A + (size_t)nxt.pm * tstep : cA; const char* nB = has_next ? (const char*)g.Bt + (size_t)nxt.pn * tstep : cB;
        for (int t = 0; t < nt; t += 2) {
            const bool last = (t == nt - 2);
            const char* a1 = cA + (size_t)(t + 1) * kstep;
            const char* a2 = last ? nA : cA + (size_t)(t + 2) * kstep; const char* b2 = last ? nB : cB + (size_t)(t + 2) * kstep;
            const char* a3 = a2 + kstep; const char* b3 = b2 + kstep;
            if (last && has_next) S.a_ready(nxt);
            if constexpr (SP2) {
            PG8_LDB(B0, 0, 0); PG8_LDB(B1, 0, 1); PG8_SCHED; PG8_LDA(At, 0, 0); PG8_STAGE(PG8_SA(1, 1), a1 + hstep, voffA);
            PG8_WAIT_V(8); PG8_WAIT_L(0); PG8_BAR; PG8_MMA(0, 0, At, B0); PG8_MMA(0, 1, At, B1); PG8_BAR; PG8_SCHED;
            PG8_LDA(At, 0, 1); PG8_STAGE(PG8_SB(0, 0), b2, voffB); PG8_STAGE(PG8_SB(0, 1), b2 + hstep, voffB); PG8_STAGE(PG8_SA(0, 0), a2, voffA);
            PG8_WAIT_V(8); PG8_WAIT_L(0); PG8_BAR; PG8_MMA(1, 0, At, B0); PG8_MMA(1, 1, At, B1); PG8_BAR; PG8_SCHED;
            PG8_LDB(B0, 1, 0); PG8_LDB(B1, 1, 1); PG8_SCHED; PG8_LDA(At, 1, 0); PG8_STAGE(PG8_SA(0, 1), a2 + hstep, voffA);
            PG8_WAIT_V(8); PG8_WAIT_L(0); PG8_BAR; PG8_MMA(0, 0, At, B0); PG8_MMA(0, 1, At, B1); PG8_BAR; PG8_SCHED;
            PG8_LDA(At, 1, 1); PG8_STAGE(PG8_SB(1, 0), b3, voffB); PG8_STAGE(PG8_SB(1, 1), b3 + hstep, voffB); PG8_STAGE(PG8_SA(1, 0), a3, voffA);
            PG8_WAIT_V(8); PG8_WAIT_L(0); PG8_BAR; PG8_MMA(1, 0, At, B0); PG8_MMA(1, 1, At, B1); PG8_BAR; PG8_SCHED;
            } else {
            PG8_LDB(B0, 0, 0); PG8_SCHED; PG8_LDA(At, 0, 0); PG8_STAGE(PG8_SA(1, 1), a1 + hstep, voffA);
            PG8_WAIT_L(8); PG8_BAR; PG8_WAIT_L(0); PG8_MMA(0, 0, At, B0); PG8_BAR; PG8_SCHED;
            PG8_LDB(B1, 0, 1); PG8_STAGE(PG8_SB(0, 0), b2, voffB);
            PG8_BAR; PG8_WAIT_L(0); PG8_MMA(0, 1, At, B1); PG8_BAR;
            PG8_LDA(At, 0, 1); PG8_STAGE(PG8_SA(0, 0), a2, voffA);
            PG8_BAR; PG8_WAIT_L(0); PG8_MMA(1, 0, At, B0); PG8_BAR; PG8_SCHED;
            PG8_STAGE(PG8_SB(0, 1), b2 + hstep, voffB);
            PG8_WAIT_V(6); PG8_BAR; PG8_MMA(1, 1, At, B1); PG8_BAR;
            PG8_LDB(B0, 1, 0); PG8_SCHED; PG8_LDA(At, 1, 0); PG8_STAGE(PG8_SA(0, 1), a2 + hstep, voffA);
            PG8_WAIT_L(8); PG8_BAR; PG8_WAIT_L(0); PG8_MMA(0, 0, At, B0); PG8_BAR; PG8_SCHED;
            PG8_LDB(B1, 1, 1); PG8_STAGE(PG8_SB(1, 0), b3, voffB);
            PG8_BAR; PG8_WAIT_L(0); PG8_MMA(0, 1, At, B1); PG8_BAR;
            PG8_LDA(At, 1, 1); PG8_STAGE(PG8_SA(1, 0), a3, voffA);
            PG8_BAR; PG8_WAIT_L(0); PG8_MMA(1, 0, At, B0); PG8_BAR; PG8_SCHED;
            PG8_STAGE(PG8_SB(1, 1), b3 + hstep, voffB);
            PG8_WAIT_V(6); PG8_BAR; PG8_MMA(1, 1, At, B1); PG8_BAR;
            }
        }
        if constexpr (ALIGN_EPI) { if (wr == 0) PG8_BAR; }
        if constexpr (!Epi::AFTER_DRAIN) { E(acc, cur, wr, wc, fr, fq); S.done(cur); }
        if (!has_next) break;
#pragma unroll
        for (int a = 0; a < 2; ++a)
#pragma unroll
            for (int b = 0; b < 2; ++b)
#pragma unroll
                for (int m = 0; m < 4; ++m)
#pragma unroll
                    for (int n = 0; n < 2; ++n) acc[a][b][m][n] = (f32x4){0.f, 0.f, 0.f, 0.f};
        cur = nxt; cA = nA; cB = nB; ++ui;
        if constexpr (ALIGN_EPI) { if (wr == 1) PG8_BAR; }
    }
    PG8_WAIT_V(0);
    if constexpr (!ALIGN_EPI) { if (wr == 0) PG8_BAR; }
    PG8_BAR;
    if constexpr (Epi::AFTER_DRAIN) { E.fused(acc, cur, wr, wc, fr, fq, lds, wid, lane); S.done(cur); }
#undef PG8_SA
#undef PG8_SB
#undef PG8_STAGE
#undef PG8_LDA
#undef PG8_LDB
#undef PG8_MMA
#undef PG8_WAIT_V
#undef PG8_WAIT_L
#undef PG8_BAR
#undef PG8_SCHED
}
}
constexpr int NWAVES = 8, NTHR = 512;
constexpr int BATCH = 4, SEQ = 4096, D = 1024, DEPTH = 4, H = 8, HD = 64, FF = 4096, NPROJ = 3328, RPROJ = 1792;
constexpr int M = BATCH * SEQ;
constexpr float GN_EPS = 64e-5f;
enum { I_X = 0, I_LN1, I_WIN, I_QG, I_KG, I_TSP, I_TSN, I_W0, I_W2, I_A0, I_A2, I_G2, I_KK, I_KA, I_RK, I_GNW, I_GNB, I_WOUT, I_LN2, I_WUP, I_WDN, N_IN };
constexpr size_t MiB = 1u << 20;
constexpr size_t WS_CTL = 0, CTL_ZERO_BYTES = 64 * 1024;
constexpr size_t WS_SS1 = 1 * MiB, WS_SS2 = 2 * MiB;
constexpr size_t WS_WIN = 3 * MiB, WS_WOUT = WS_WIN + (size_t)NPROJ * D * 2, WS_WUP = WS_WOUT + (size_t)D * D * 2, WS_WDN = WS_WUP + (size_t)FF * D * 2;
constexpr size_t WS_R0 = 28 * MiB;
constexpr size_t R_MIX = WS_R0 + 0 * MiB;
constexpr size_t R_V = WS_R0 + 32 * MiB;
constexpr size_t R_RR = WS_R0 + 48 * MiB, R_KR = WS_R0 + 64 * MiB, R_VR = WS_R0 + 80 * MiB, R_XL = WS_R0 + 96 * MiB;
constexpr size_t R_SD = R_RR;
constexpr size_t R_PRE = WS_R0 + 104 * MiB;
constexpr size_t R_HID = WS_R0;
constexpr size_t R_XB = WS_R0 + 128 * MiB;
constexpr size_t R_BN = WS_R0 + 232 * MiB;
constexpr size_t WS_END = WS_R0 + 233 * MiB;
constexpr size_t WS_LORA = WS_WDN + (size_t)D * FF * 2;
constexpr size_t WS_G2T = WS_LORA + 4 * 512 * 64 * 2;
static_assert(WS_G2T + 512 * 128 * 2 <= WS_R0, "lora");
constexpr int CW_BAR = 1024;
constexpr int RING_OFF = 0, RING_BYTES = 131072;
constexpr int LDSCTL_OFF = 155648, MISC_OFF = LDSCTL_OFF + 320;
constexpr int LDS_BYTES = 163840;
#define GAS __attribute__((address_space(1)))
#define LAS __attribute__((address_space(3)))
typedef unsigned short bf16;
typedef unsigned v4u __attribute__((ext_vector_type(4)));
typedef float f32x4 __attribute__((ext_vector_type(4)));
typedef short bf16x8 __attribute__((ext_vector_type(8)));
typedef GAS unsigned gu32;
typedef GAS unsigned long long gu64;
#define RLX_AGENT __ATOMIC_RELAXED, __HIP_MEMORY_SCOPE_AGENT
#define LDS_WAIT() asm volatile("s_waitcnt lgkmcnt(0)" ::: "memory")
#define VM_WAIT() asm volatile("s_waitcnt vmcnt(0)" ::: "memory")
__device__ __forceinline__ unsigned long long rt() { return __builtin_amdgcn_s_memrealtime(); }
__device__ __forceinline__ unsigned f2bf(float f) { unsigned u = __builtin_bit_cast(unsigned, f); return (u + 0x7fffu + ((u >> 16) & 1u)) >> 16; }
__device__ __forceinline__ unsigned pk2(float lo, float hi) { return f2bf(lo) | (f2bf(hi) << 16); }

#define XB_TMO      128
#define XB_XCNT(j)  (256  + 64 * (j))
#define XB_XSUB(j)  (1280 + 64 * (j))
#define XB_XGEN(j)  (2304 + 64 * (j))
#define XB_TOP      3328
#define XB_TOPGEN   3392
#define XCD_BAR_WORDS 3456
#define XB_SPIN_CAP (1u << 18)

__device__ __forceinline__ unsigned xb_ld(unsigned* p)              { return __hip_atomic_load(p, __ATOMIC_RELAXED, __HIP_MEMORY_SCOPE_AGENT); }
__device__ __forceinline__ unsigned xb_add(unsigned* p, unsigned v) { return __hip_atomic_fetch_add(p, v, __ATOMIC_RELAXED, __HIP_MEMORY_SCOPE_AGENT); }
__device__ __forceinline__ unsigned xb_xcc_id() { return (unsigned)__builtin_amdgcn_s_getreg((3 << 11) | 20) & 0xFu; }
#define XB_SPIN(cond, bar) do { unsigned _sp = 0; while (cond) { __builtin_amdgcn_s_sleep(1); \
    if ((++_sp & 255u) == 0u) { if (xb_ld(&(bar)[XB_TMO])) break; if (_sp > XB_SPIN_CAP) { atomicAdd(&(bar)[XB_TMO], 1u); break; } } } } while (0)

struct XcdBarrier {
    unsigned* bar; unsigned x;
    volatile LAS unsigned* st;
};

__device__ __forceinline__ XcdBarrier xcd_barrier_post(unsigned* bar, volatile LAS unsigned* st, bool tid0) {
    XcdBarrier b; b.bar = bar; b.x = xb_xcc_id(); b.st = st;
    if (tid0) (void)xb_add(&bar[XB_XCNT(b.x)], 1u);
    return b;
}
__device__ __forceinline__ void xcd_barrier_complete(unsigned* bar, unsigned x, unsigned& nloc, unsigned& nx) {
    const unsigned G = gridDim.x * gridDim.y * gridDim.z;
    unsigned sum, cnt, mine, sp = 0u;
    for (;;) {
        sum = 0u; cnt = 0u; mine = 0u;
#pragma unroll
        for (unsigned j = 0; j < 16; ++j) { const unsigned c = xb_ld(&bar[XB_XCNT(j)]); sum += c; cnt += (c > 0u) ? 1u : 0u; mine = (j == x) ? c : mine; }
        if (sum == G) break;
        __builtin_amdgcn_s_sleep(1);
        if ((++sp & 255u) == 0u) { if (xb_ld(&bar[XB_TMO])) break; if (sp > XB_SPIN_CAP) { atomicAdd(&bar[XB_TMO], 1u); break; } }
    }
    nloc = mine > 0u ? mine : 1u; nx = cnt > 0u ? cnt : 1u;
}

__device__ __forceinline__ void xcd_barrier(const XcdBarrier& b, bool tid0) {
    asm volatile("s_waitcnt vmcnt(0)" ::: "memory");
    __syncthreads();
    if (tid0) {
        unsigned* bar = b.bar; asm volatile("" : "+v"(bar));
        __builtin_amdgcn_s_waitcnt(0);
        unsigned nloc = b.st[0], nx = b.st[1];
        if (nloc == 0u) { xcd_barrier_complete(bar, b.x, nloc, nx); b.st[0] = nloc; b.st[1] = nx; }
        const unsigned old = xb_add(&bar[XB_XSUB(b.x)], 1u);
        const unsigned gen = old / nloc;
        if (old + 1u == (gen + 1u) * nloc) {
            __builtin_amdgcn_fence(__ATOMIC_RELEASE, "agent");
            asm volatile("s_waitcnt vmcnt(0)" ::: "memory");
            const unsigned og = xb_add(&bar[XB_TOP], 1u);
            const unsigned tg = og / nx;
            if (og + 1u == (tg + 1u) * nx) xb_add(&bar[XB_TOPGEN], 1u);
            else XB_SPIN(xb_ld(&bar[XB_TOPGEN]) == tg, bar);
            __builtin_amdgcn_fence(__ATOMIC_ACQUIRE, "agent");
            xb_add(&bar[XB_XGEN(b.x)], 1u);
            asm volatile("s_waitcnt vmcnt(0)" ::: "memory");
        } else {
            XB_SPIN(xb_ld(&bar[XB_XGEN(b.x)]) == gen, bar);
            __builtin_amdgcn_fence(__ATOMIC_ACQUIRE, "agent");
            asm volatile("s_waitcnt vmcnt(0)" ::: "memory");
        }
    }
    __syncthreads();
}
__device__ __forceinline__ float bf2f(bf16 v) { return __uint_as_float(((unsigned)v) << 16); }
__device__ __forceinline__ bf16 f2bf_s(float f) { return (bf16)f2bf(f); }
__device__ __forceinline__ float wave_sum(float v, int lane) {
#pragma unroll
    for (int o = 1; o < 64; o <<= 1) v += pg8::shx(v, o, lane);
    return v;
}
__device__ __forceinline__ float sigmoidf_(float z) { return __builtin_amdgcn_rcpf(1.0f + __expf(-z)); }
__device__ __forceinline__ float tanh_fast(float x) { return 1.0f - 2.0f * __builtin_amdgcn_rcpf(__expf(2.0f * x) + 1.0f); }

struct Args { const float* in[N_IN]; float* out; unsigned char* ws; };
typedef const __attribute__((address_space(4))) Args CArgs;
__device__ __forceinline__ const CArgs* kargs() { const CArgs* p = (const CArgs*)__builtin_amdgcn_kernarg_segment_ptr(); asm volatile("" : "+s"(p)); return p; }
__device__ __forceinline__ unsigned char* kws() { return kargs()->ws; }
__device__ __forceinline__ float* kout() { return kargs()->out; }
__device__ __forceinline__ const float* karg(int i) { return kargs()->in[i]; }
__device__ __forceinline__ int lane_id() { int l; asm volatile("v_mbcnt_lo_u32_b32 %0, -1, 0\n\tv_mbcnt_hi_u32_b32 %0, -1, %0" : "=v"(l)); return l; }
struct Frame {
    LAS unsigned char* lds;
    volatile LAS unsigned* MISC;
    gu32* ctl;
    int vcu, G, wv;
};

__device__ __forceinline__ float ushift(const bf16* buf, int ldc, int col, int row, int t, float sp, float sn) {
    const bf16* p = buf + (size_t)row * ldc + col;
    const float u0 = bf2f(p[0]);
    const float up = (t > 0) ? bf2f(p[-ldc]) : 0.f;
    const float un = (t < SEQ - 1) ? bf2f(p[ldc]) : 0.f;
    return u0 + sp * (up - u0) + sn * (un - u0);
}

__device__ __forceinline__ void transpose_item(const float* W, int K, int N, bf16* WT, const float* gain, bool headperm, LAS float* scr, int item, int lane) {
    const int nblk = N / 32, kb = item / nblk, nb = item % nblk, k0 = 64 * kb, n0 = 32 * nb;
    { const int r = lane >> 3, c4 = lane & 7;
      f32x4 v[8];
#pragma unroll
      for (int i = 0; i < 8; ++i) v[i] = *(const f32x4*)(W + (size_t)(k0 + 8 * i + r) * N + n0 + 4 * c4);
#pragma unroll
      for (int i = 0; i < 8; ++i) { f32x4 w = v[i]; if (gain) w = w * gain[k0 + 8 * i + r]; *(LAS f32x4*)(scr + (8 * i + r) * 36 + 4 * c4) = w; } }
    LDS_WAIT(); asm volatile("" ::: "memory");
    const int c = lane & 7;
    const int p0 = headperm ? ((n0 & ~255) + 128 * ((n0 >> 5) & 1) + 32 * ((n0 >> 6) & 3)) : n0;
#pragma unroll
    for (int j = 0; j < 4; ++j) { const int n = (lane >> 3) + 8 * j; const LAS float* s = scr + (8 * c) * 36 + n;
        v4u o; o.x = pk2(s[0 * 36], s[1 * 36]); o.y = pk2(s[2 * 36], s[3 * 36]); o.z = pk2(s[4 * 36], s[5 * 36]); o.w = pk2(s[6 * 36], s[7 * 36]);
        *(GAS v4u*)(WT + (size_t)(p0 + n) * K + k0 + 8 * c) = o; }
    LDS_WAIT(); asm volatile("" ::: "memory");
}
__device__ __forceinline__ void wconv_items(int layerA, int layerB, int wi, int nw, LAS float* scr, int lane_) {
    unsigned char* const ws = kws();
    constexpr int I_1 = (D / 64) * (NPROJ / 32), I_2 = (D / 64) * (D / 32), I_3 = (D / 64) * (FF / 32), I_4 = (FF / 64) * (D / 32);
    constexpr int NA = I_1 + 64, NB = I_2 + I_3 + I_4 + 32;
    const int nA = (layerA >= 0 && layerA < DEPTH) ? NA : 0, nB = (layerB >= 0) ? NB : 0;
    for (int it = wi; it < nA + nB; it += nw) {
        int r = it;
        if (r < nA) { const int layer = layerA;
            if (r < I_1) { transpose_item(karg(I_WIN) + (size_t)layer * D * NPROJ, D, NPROJ, (bf16*)(ws + WS_WIN), karg(I_LN1) + layer * D, true, scr, r, lane_); continue; } r -= I_1;
            const int mat = r >> 4, it16 = r & 15;
            const float* src = (mat < 2 ? karg(I_W2) : karg(I_A2)) + (size_t)(layer * 2 + (mat & 1)) * 64 * 512;
            transpose_item(src, 64, 512, (bf16*)(ws + WS_LORA) + (size_t)mat * 512 * 64, nullptr, false, scr, it16, lane_); continue; }
        r -= nA; const int layer = layerB;
        if (r < I_2) { transpose_item(karg(I_WOUT) + (size_t)layer * D * D, D, D, (bf16*)(ws + WS_WOUT), nullptr, false, scr, r, lane_); continue; } r -= I_2;
        if (r < I_3) { transpose_item(karg(I_WUP) + (size_t)layer * D * FF, D, FF, (bf16*)(ws + WS_WUP), karg(I_LN2) + layer * D, false, scr, r, lane_); continue; } r -= I_3;
        if (r < I_4) { transpose_item(karg(I_WDN) + (size_t)layer * FF * D, FF, D, (bf16*)(ws + WS_WDN), nullptr, false, scr, r, lane_); continue; } r -= I_4;
        transpose_item(karg(I_G2) + (size_t)layer * 128 * 512, 128, 512, (bf16*)(ws + WS_G2T), nullptr, false, scr, r, lane_);
    }
}
__device__ __forceinline__ void x_prologue(Frame& F) {
    unsigned char* const ws = kws();
    int lane_ = lane_id(); asm volatile("" : "+v"(lane_)); int wave_o = F.wv; asm volatile("" : "+s"(wave_o)); const int wave_ = wave_o, tid_ = wave_ * 64 + lane_;
    const int gw = F.vcu * NWAVES + wave_, NGW = F.G * NWAVES;
    const float* x = karg(I_X); bf16* xb = (bf16*)(ws + R_XB); float* ss = (float*)(ws + WS_SS1);
    for (int m = gw; m < M; m += NGW) {
        const GAS f32x4* xr = (const GAS f32x4*)(x + (size_t)m * D) + lane_; GAS f32x4* orow = (GAS f32x4*)(kout() + (size_t)m * D) + lane_;
        GAS unsigned long long* o8 = (GAS unsigned long long*)(xb + (size_t)m * D) + lane_;
        float s = 0.f;
#pragma unroll
        for (int j = 0; j < 4; ++j) { const f32x4 v = xr[64 * j]; orow[64 * j] = v; s += (v.x * v.x + v.y * v.y) + (v.z * v.z + v.w * v.w);
            o8[64 * j] = (unsigned long long)pk2(v.x, v.y) | ((unsigned long long)pk2(v.z, v.w) << 32); }
        s = wave_sum(s, lane_);
        if (lane_ < 16) ss[(size_t)m * 16 + lane_] = (lane_ == 0) ? s : 0.f;
    }
}

typedef float f32x16 __attribute__((ext_vector_type(16)));
typedef short s16x4 __attribute__((ext_vector_type(4)));
typedef short v4i16_t __attribute__((ext_vector_type(4)));
typedef unsigned u32x2_t __attribute__((ext_vector_type(2)));
typedef float f32x2_t __attribute__((ext_vector_type(2))); typedef __bf16 bf16x2_t __attribute__((ext_vector_type(2)));
__device__ __forceinline__ unsigned cvtpk(float lo, float hi) { f32x2_t v = {lo, hi}; bf16x2_t b = __builtin_convertvector(v, bf16x2_t); return __builtin_bit_cast(unsigned, b); }
typedef _Float16 h16x2_t __attribute__((ext_vector_type(2))); typedef _Float16 h16x8 __attribute__((ext_vector_type(8)));
__device__ __forceinline__ unsigned cvtpk_h(float lo, float hi) { f32x2_t v = {lo, hi}; h16x2_t b = __builtin_convertvector(v, h16x2_t); return __builtin_bit_cast(unsigned, b); }
__device__ __forceinline__ f32x2_t unpk_h(unsigned w) { return __builtin_convertvector(__builtin_bit_cast(h16x2_t, w), f32x2_t); }
#define MFMA32H(nf, mf, acc) __builtin_amdgcn_mfma_f32_32x32x16_f16(__builtin_bit_cast(h16x8, (nf)), __builtin_bit_cast(h16x8, (mf)), (acc), 0, 0, 0)
constexpr int TSB = 144, TILE_B = 64 * TSB;
constexpr int PRE_TW = 14 * TILE_B, PRE_XA = 15 * TILE_B, PRE_INVN = 16 * TILE_B, PRE_GC = PRE_INVN + 256, PRE_BON = PRE_GC + 512, PRE_LDS_END = PRE_BON + 1024;
static_assert(PRE_LDS_END <= LDSCTL_OFF, "PRE LDS map");
__device__ __forceinline__ bf16x8 frag_row(const LAS unsigned char* tile, int row, int ks, int hi) {
    return *(const LAS bf16x8*)(tile + row * TSB + (16 * ks + 8 * hi) * 2);
}
__device__ __forceinline__ s16x4 tr4(const LAS unsigned char* p) { return __builtin_bit_cast(s16x4, __builtin_amdgcn_ds_read_tr16_b64_v4i16((LAS v4i16_t*)p)); }
__device__ __forceinline__ bf16x8 frag_tr(const LAS unsigned char* tile, int idx0, int ks, int lane) {
    const int hi = lane >> 5, g1 = (lane >> 4) & 1, i = lane & 15;
    const LAS unsigned char* p = tile + (16 * ks + 8 * hi + (i >> 2)) * TSB + (idx0 + 16 * g1 + 4 * (i & 3)) * 2;
    const s16x4 lo = tr4(p), h4 = tr4(p + 4 * TSB);
    return (bf16x8){lo[0], lo[1], lo[2], lo[3], h4[0], h4[1], h4[2], h4[3]};
}
__device__ __forceinline__ void store_quad(LAS unsigned char* tile, int row, int n0, int hi, const f32x16& a) {
#pragma unroll
    for (int q = 0; q < 4; ++q) { u32x2_t w; w.x = cvtpk(a[4 * q], a[4 * q + 1]); w.y = cvtpk(a[4 * q + 2], a[4 * q + 3]); *(LAS u32x2_t*)(tile + row * TSB + (n0 + 8 * q + 4 * hi) * 2) = w; }
}
__device__ __forceinline__ void store_quad_h(LAS unsigned char* tile, int row, int n0, int hi, const f32x16& a) {
#pragma unroll
    for (int q = 0; q < 4; ++q) { u32x2_t w; w.x = cvtpk_h(a[4 * q], a[4 * q + 1]); w.y = cvtpk_h(a[4 * q + 2], a[4 * q + 3]); *(LAS u32x2_t*)(tile + row * TSB + (n0 + 8 * q + 4 * hi) * 2) = w; }
}
__device__ __forceinline__ f32x16 load_quad(const LAS unsigned char* tile, int row, int n0, int hi) {
    f32x16 a;
#pragma unroll
    for (int q = 0; q < 4; ++q) { const u32x2_t w = *(const LAS u32x2_t*)(tile + row * TSB + (n0 + 8 * q + 4 * hi) * 2);
        a[4 * q] = __uint_as_float(w.x << 16); a[4 * q + 1] = __uint_as_float(w.x & 0xffff0000u); a[4 * q + 2] = __uint_as_float(w.y << 16); a[4 * q + 3] = __uint_as_float(w.y & 0xffff0000u); }
    return a;
}
#define MFMA32(nf, mf, acc) __builtin_amdgcn_mfma_f32_32x32x16_bf16((nf), (mf), (acc), 0, 0, 0)
#define LD4_ROW(dst, tile, row) _Pragma("unroll") for (int ks_ = 0; ks_ < 4; ++ks_) dst[ks_] = frag_row(tile, row, ks_, hi)
#define LD4_TR(dst, tile, idx0) _Pragma("unroll") for (int ks_ = 0; ks_ < 4; ++ks_) dst[ks_] = frag_tr(tile, idx0, ks_, lane)
#define SBAR0() __builtin_amdgcn_sched_barrier(0)
#define WG_BARL() do { asm volatile("s_waitcnt lgkmcnt(0)" ::: "memory"); __builtin_amdgcn_s_barrier(); asm volatile("" ::: "memory"); } while (0)
#define WG_BAR() do { asm volatile("s_waitcnt vmcnt(0) lgkmcnt(0)" ::: "memory"); __builtin_amdgcn_s_barrier(); asm volatile("" ::: "memory"); } while (0)
__device__ __forceinline__ void shift8(const bf16* buf, int ldc, int col, int row, int t, const float* sp, const float* sn, float (&out)[8]) {
    const bf16* p = buf + (size_t)row * ldc + col;
    const v4u c = *(const v4u*)p; v4u pv = (v4u){0u, 0u, 0u, 0u}, nv = (v4u){0u, 0u, 0u, 0u};
    if (t > 0) pv = *(const v4u*)(p - ldc);
    if (t < SEQ - 1) nv = *(const v4u*)(p + ldc);
    const f32x4 sp0 = *(const f32x4*)sp, sp1 = *(const f32x4*)(sp + 4), sn0 = *(const f32x4*)sn, sn1 = *(const f32x4*)(sn + 4);
#pragma unroll
    for (int j = 0; j < 8; ++j) { const unsigned cw = c[j >> 1], pw = pv[j >> 1], nw = nv[j >> 1];
        const float u0 = (j & 1) ? __uint_as_float(cw & 0xffff0000u) : __uint_as_float(cw << 16), up = (j & 1) ? __uint_as_float(pw & 0xffff0000u) : __uint_as_float(pw << 16), un = (j & 1) ? __uint_as_float(nw & 0xffff0000u) : __uint_as_float(nw << 16);
        const float a = (j < 4) ? sp0[j & 3] : sp1[j & 3], bq = (j < 4) ? sn0[j & 3] : sn1[j & 3];
        out[j] = u0 + a * (up - u0) + bq * (un - u0); }
}
__device__ __forceinline__ f32x4 shift4(const bf16* buf, int ldc, int col, int row, int t, const float* sp, const float* sn) {
    const bf16* p = buf + (size_t)row * ldc + col;
    const u32x2_t c = *(const u32x2_t*)p; u32x2_t pv = (u32x2_t){0u, 0u}, nv = (u32x2_t){0u, 0u};
    if (t > 0) pv = *(const u32x2_t*)(p - ldc);
    if (t < SEQ - 1) nv = *(const u32x2_t*)(p + ldc);
    const f32x4 a = *(const f32x4*)sp, bq = *(const f32x4*)sn;
    const f32x4 u0 = (f32x4){__uint_as_float(c.x << 16), __uint_as_float(c.x & 0xffff0000u), __uint_as_float(c.y << 16), __uint_as_float(c.y & 0xffff0000u)};
    const f32x4 up = (f32x4){__uint_as_float(pv.x << 16), __uint_as_float(pv.x & 0xffff0000u), __uint_as_float(pv.y << 16), __uint_as_float(pv.y & 0xffff0000u)};
    const f32x4 un = (f32x4){__uint_as_float(nv.x << 16), __uint_as_float(nv.x & 0xffff0000u), __uint_as_float(nv.y << 16), __uint_as_float(nv.y & 0xffff0000u)};
    return u0 + a * (up - u0) + bq * (un - u0);
}

struct R16 { v4u c, p, n; };
struct R8 { u32x2_t c, p, n; };
__device__ __forceinline__ R16 ld3x16(const bf16* buf, int ldc, int col, int row, int t) {
    const bf16* q = buf + (size_t)row * ldc + col; R16 r; r.c = *(const v4u*)q; r.p = (v4u){0u, 0u, 0u, 0u}; r.n = (v4u){0u, 0u, 0u, 0u};
    if (t > 0) r.p = *(const v4u*)(q - ldc);
    if (t < SEQ - 1) r.n = *(const v4u*)(q + ldc);
    return r;
}
__device__ __forceinline__ R8 ld3x8(const bf16* buf, int ldc, int col, int row, int t) {
    const bf16* q = buf + (size_t)row * ldc + col; R8 r; r.c = *(const u32x2_t*)q; r.p = (u32x2_t){0u, 0u}; r.n = (u32x2_t){0u, 0u};
    if (t > 0) r.p = *(const u32x2_t*)(q - ldc);
    if (t < SEQ - 1) r.n = *(const u32x2_t*)(q + ldc);
    return r;
}
__device__ __forceinline__ void sh8(const R16& r, const LAS float* sp, const LAS float* sn, float (&out)[8]) {
    const f32x4 sp0 = *(const LAS f32x4*)sp, sp1 = *(const LAS f32x4*)(sp + 4), sn0 = *(const LAS f32x4*)sn, sn1 = *(const LAS f32x4*)(sn + 4);
#pragma unroll
    for (int j = 0; j < 8; ++j) { const unsigned cw = r.c[j >> 1], pw = r.p[j >> 1], nw = r.n[j >> 1];
        const float u0 = (j & 1) ? __uint_as_float(cw & 0xffff0000u) : __uint_as_float(cw << 16), up = (j & 1) ? __uint_as_float(pw & 0xffff0000u) : __uint_as_float(pw << 16), un = (j & 1) ? __uint_as_float(nw & 0xffff0000u) : __uint_as_float(nw << 16);
        const float a = (j < 4) ? sp0[j & 3] : sp1[j & 3], bq = (j < 4) ? sn0[j & 3] : sn1[j & 3];
        out[j] = u0 + a * (up - u0) + bq * (un - u0); }
}
__device__ __forceinline__ f32x4 sh4(const R8& r, const f32x4 a, const f32x4 bq) {
    const f32x4 u0 = (f32x4){__uint_as_float(r.c.x << 16), __uint_as_float(r.c.x & 0xffff0000u), __uint_as_float(r.c.y << 16), __uint_as_float(r.c.y & 0xffff0000u)};
    const f32x4 up = (f32x4){__uint_as_float(r.p.x << 16), __uint_as_float(r.p.x & 0xffff0000u), __uint_as_float(r.p.y << 16), __uint_as_float(r.p.y & 0xffff0000u)};
    const f32x4 un = (f32x4){__uint_as_float(r.n.x << 16), __uint_as_float(r.n.x & 0xffff0000u), __uint_as_float(r.n.y << 16), __uint_as_float(r.n.y & 0xffff0000u)};
    return u0 + a * (up - u0) + bq * (un - u0);
}
constexpr int PRE_CT = PRE_LDS_END;
enum { CT_KK = 0, CT_KA = 64, CT_RK = 128, CT_W0 = 192  , CT_A0 = 320  , CT_SPR = 448, CT_SNR = 512, CT_SPK = 576, CT_SNK = 640, CT_SPV = 704, CT_SNV = 768, CT_SPX = 832  , CT_SNX = 960  , CT_N = 1088 };
static_assert(PRE_CT + CT_N * 4 <= LDSCTL_OFF, "PRE constant table");
__device__ __forceinline__ void rwkv_pre_phase(Frame& F, int layer) {
    unsigned char* const ws = kws();
    int lane_ = lane_id(); asm volatile("" : "+v"(lane_)); int wave_o = F.wv; asm volatile("" : "+s"(wave_o)); const int wave_ = wave_o;
    const int d = wave_ >> 2, qm = (wave_ >> 1) & 1, qn = wave_ & 1, m0 = 32 * qm, n0 = 32 * qn;
#define LANE_VARS int lane = lane_; asm volatile("" : "+v"(lane)); const int hi = lane >> 5, l31 = lane & 31, mrow = m0 + l31; (void)hi; (void)l31; (void)mrow;
    LAS unsigned char* const L = F.lds;
    LAS unsigned char* const T0 = L + (d * 7 + 0) * TILE_B; LAS unsigned char* const T1 = L + (d * 7 + 1) * TILE_B; LAS unsigned char* const T2 = L + (d * 7 + 2) * TILE_B; LAS unsigned char* const T3 = L + (d * 7 + 3) * TILE_B;
    LAS unsigned char* const T4 = L + (d * 7 + 4) * TILE_B; LAS unsigned char* const T5 = L + (d * 7 + 5) * TILE_B; LAS unsigned char* const T6 = L + (d * 7 + 6) * TILE_B;
    LAS unsigned char* const TWt = L + PRE_TW; LAS unsigned char* const XAt = L + PRE_XA;
    LAS float* const invn = (LAS float*)(L + PRE_INVN); LAS float* const gcs = (LAS float*)(L + PRE_GC) + d * 64; LAS float* const bon = (LAS float*)(L + PRE_BON); LAS float* const ct = (LAS float*)(L + PRE_CT);
    const bf16* Rr = (const bf16*)(ws + R_RR); const bf16* Kr = (const bf16*)(ws + R_KR); const bf16* Vr = (const bf16*)(ws + R_VR); const bf16* XL = (const bf16*)(ws + R_XL);
    const bf16* W2T = (const bf16*)(ws + WS_LORA) + (size_t)d * 512 * 64; const bf16* A2T = (const bf16*)(ws + WS_LORA) + (size_t)(2 + d) * 512 * 64;
    float* BN = (float*)(ws + R_BN) + (size_t)d * M * 8;
    const int h = F.vcu & 7, hc = h * HD, bc0 = F.vcu >> 3, bcs = F.G >> 3;
    { LANE_VARS; const float* sp = karg(I_TSP) + layer * RPROJ; const float* sn = karg(I_TSN) + layer * RPROJ;
      for (int idx = wave_ * 64 + lane; idx < CT_N; idx += NTHR) { const int seg = idx >> 6, c = idx & 63; float v;
          if (seg == 0) v = karg(I_KK)[layer * 512 + hc + c]; else if (seg == 1) v = karg(I_KA)[layer * 512 + hc + c]; else if (seg == 2) v = karg(I_RK)[layer * 512 + hc + c];
          else if (seg < 5) v = karg(I_W0)[(layer * 2 + seg - 3) * 512 + hc + c]; else if (seg < 7) v = karg(I_A0)[(layer * 2 + seg - 5) * 512 + hc + c];
          else if (seg < 13) { const int j = seg - 7; v = ((j & 1) ? sn : sp)[(j >> 1) * 512 + hc + c]; }
          else if (seg < 15) v = sp[1536 + (idx - CT_SPX)]; else v = sn[1536 + (idx - CT_SNX)];
          ct[idx] = v; } }
    WG_BARL();
    R16 xw3, xa3, kk3, rr3;
    { LANE_VARS; const int tidl = wave_ * 64 + lane, tok = tidl >> 3, oct = tidl & 7; const int b = bc0 >> 6, t = (bc0 & 63) * 64 + tok, row = b * SEQ + t;
      xw3 = ld3x16(XL, 256, 8 * oct, row, t); xa3 = ld3x16(XL, 256, 64 + 8 * oct, row, t); kk3 = ld3x16(Kr, 512, hc + 8 * oct, row, t); rr3 = ld3x16(Rr, 512, hc + 8 * oct, row, t); }
    LAS unsigned char* const RF0 = L + 6 * TILE_B; LAS unsigned char* const RF1 = L + 13 * TILE_B;
    for (int bc = bc0; bc < BATCH * (SEQ / 64); bc += bcs) {
        const int cn = bc & 63, b = bc >> 6, t0 = cn * 64;
#define SNAT (d ? 63 - mrow : mrow)
        bf16x8 wfr[4], afr[4];
        { LANE_VARS;
#pragma unroll
          for (int ks = 0; ks < 4; ++ks) { const size_t wo = (size_t)(hc + n0 + l31) * 64 + 16 * ks + 8 * hi; wfr[ks] = *(const bf16x8*)(W2T + wo); afr[ks] = *(const bf16x8*)(A2T + wo); }
        }
        float ksh[8];
        { LANE_VARS; const int tidl = wave_ * 64 + lane; const int tok = tidl >> 3, oct = tidl & 7; float v8[8];
          sh8(xw3, ct + CT_SPX + 8 * oct, ct + CT_SNX + 8 * oct, v8);
          { v4u w; w.x = cvtpk(tanh_fast(v8[0]), tanh_fast(v8[1])); w.y = cvtpk(tanh_fast(v8[2]), tanh_fast(v8[3])); w.z = cvtpk(tanh_fast(v8[4]), tanh_fast(v8[5])); w.w = cvtpk(tanh_fast(v8[6]), tanh_fast(v8[7])); *(LAS v4u*)(TWt + tok * TSB + 16 * oct) = w; }
          sh8(xa3, ct + CT_SPX + 64 + 8 * oct, ct + CT_SNX + 64 + 8 * oct, v8);
          { v4u w; w.x = cvtpk(v8[0], v8[1]); w.y = cvtpk(v8[2], v8[3]); w.z = cvtpk(v8[4], v8[5]); w.w = cvtpk(v8[6], v8[7]); *(LAS v4u*)(XAt + tok * TSB + 16 * oct) = w; }
          sh8(rr3, ct + CT_SPR + 8 * oct, ct + CT_SNR + 8 * oct, v8);
          { LAS f32x4* rp_ = (LAS f32x4*)((tok < 32 ? RF0 : RF1) + (tok & 31) * 256 + 32 * oct); rp_[0] = (f32x4){v8[0], v8[1], v8[2], v8[3]}; rp_[1] = (f32x4){v8[4], v8[5], v8[6], v8[7]}; }
          sh8(kk3, ct + CT_SPK + 8 * oct, ct + CT_SNK + 8 * oct, ksh);
          const f32x4 k0 = *(const LAS f32x4*)(ct + CT_KK + 8 * oct), k1 = *(const LAS f32x4*)(ct + CT_KK + 8 * oct + 4); float ssq = 0.f;
#pragma unroll
          for (int j = 0; j < 8; ++j) { const float kx = ksh[j] * ((j < 4) ? k0[j & 3] : k1[j & 3]); ssq += kx * kx; }
          ssq += pg8::shx(ssq, 1, lane); ssq += pg8::shx(ssq, 2, lane); ssq += pg8::shx(ssq, 4, lane);
          if (oct == 0) invn[tok] = 1.0f / sqrtf(ssq + 1e-12f); }
        WG_BARL();
        f32x16 zw, za, lw, av, cum;
        { LANE_VARS; const int snat = SNAT;
#pragma unroll
        for (int r = 0; r < 16; ++r) { zw[r] = 0.f; za[r] = 0.f; }
        { bf16x8 f0[4], f1[4]; LD4_ROW(f0, TWt, snat); LD4_ROW(f1, XAt, snat); SBAR0();
#pragma unroll
          for (int ks = 0; ks < 4; ++ks) { zw = MFMA32(wfr[ks], f0[ks], zw); za = MFMA32(afr[ks], f1[ks], za); } }
#pragma unroll
        for (int q = 0; q < 4; ++q) { const f32x4 w0v = *(const LAS f32x4*)(ct + CT_W0 + 64 * d + n0 + 8 * q + 4 * hi), a0v = *(const LAS f32x4*)(ct + CT_A0 + 64 * d + n0 + 8 * q + 4 * hi);
#pragma unroll
            for (int i = 0; i < 4; ++i) { lw[4 * q + i] = -0.6065306597f * sigmoidf_(zw[4 * q + i] + w0v[i]); av[4 * q + i] = sigmoidf_(za[4 * q + i] + a0v[i]); } }
        { f32x16 lh, ll;
#pragma unroll
          for (int r = 0; r < 16; ++r) { lh[r] = __uint_as_float(cvtpk(lw[r], 0.f) << 16); ll[r] = lw[r] - lh[r]; }
          store_quad(T4, mrow, n0, hi, lh); store_quad(T5, mrow, n0, hi, ll); } }
        WG_BARL();
        { LANE_VARS; const int tidl = wave_ * 64 + lane, tok = tidl >> 3, oct = tidl & 7;
          LAS f32x4* kp_ = (LAS f32x4*)((tok < 32 ? TWt : XAt) + (tok & 31) * 256 + 32 * oct); kp_[0] = (f32x4){ksh[0], ksh[1], ksh[2], ksh[3]}; kp_[1] = (f32x4){ksh[4], ksh[5], ksh[6], ksh[7]}; }
        { LANE_VARS;
#pragma unroll
        for (int r = 0; r < 16; ++r) cum[r] = 0.f;
        { bf16x8 f0[4], f1[4]; LD4_TR(f0, T4, n0); LD4_TR(f1, T5, n0); SBAR0();
#pragma unroll
        for (int ks = 0; ks < 4; ++ks) { bf16x8 tf;
#pragma unroll
            for (int j = 0; j < 8; ++j) tf[j] = (16 * ks + 8 * hi + j <= mrow) ? (short)0x3f80 : (short)0;
            cum = MFMA32(f0[ks], tf, cum); cum = MFMA32(f1[ks], tf, cum); } } }
        WG_BARL();
        f32x16 rh, kc, mrk;
        { LANE_VARS; const int snat = SNAT; const float inv = invn[snat];
          float bsum = 0.f;
#pragma unroll
          for (int q = 0; q < 4; ++q) { const int cl = n0 + 8 * q + 4 * hi;
              const f32x4 r4 = *(const LAS f32x4*)((snat < 32 ? RF0 : RF1) + (snat & 31) * 256 + 4 * cl), k4 = *(const LAS f32x4*)((snat < 32 ? TWt : XAt) + (snat & 31) * 256 + 4 * cl);
              const f32x4 kk4 = *(const LAS f32x4*)(ct + CT_KK + cl), ka4 = *(const LAS f32x4*)(ct + CT_KA + cl), rk4 = *(const LAS f32x4*)(ct + CT_RK + cl);
              float kh4[4], bc4[4], rl4[4], kl4[4];
#pragma unroll
              for (int i = 0; i < 4; ++i) { const int e = 4 * q + i; const float a = av[e], cs = cum[e];
                  const float g = __expf(cs), gx = __expf(cs - lw[e]), gi = __expf(-cs);
                  const float kkn = k4[i] * kk4[i] * inv, kt = k4[i] * (1.0f + (a - 1.0f) * ka4[i]);
                  kh4[i] = gx * kkn; rh[e] = g * r4[i]; bc4[i] = a * kkn * gi; kc[e] = kt * gi; bsum += r4[i] * kt * rk4[i];
                  rl4[i] = rh[e] - __uint_as_float(cvtpk(rh[e], 0.f) << 16); kl4[i] = kc[e] - __uint_as_float(cvtpk(kc[e], 0.f) << 16);
                  if (mrow == 63) gcs[n0 + 8 * q + 4 * hi + i] = g; }
              const int off = mrow * TSB + (n0 + 8 * q + 4 * hi) * 2; u32x2_t w;
              w.x = cvtpk(kh4[0], kh4[1]); w.y = cvtpk(kh4[2], kh4[3]); *(LAS u32x2_t*)(T0 + off) = w;
              w.x = cvtpk(rh[4 * q], rh[4 * q + 1]); w.y = cvtpk(rh[4 * q + 2], rh[4 * q + 3]); *(LAS u32x2_t*)(T1 + off) = w;
              w.x = cvtpk(bc4[0], bc4[1]); w.y = cvtpk(bc4[2], bc4[3]); *(LAS u32x2_t*)(T2 + off) = w;
              w.x = cvtpk(kc[4 * q], kc[4 * q + 1]); w.y = cvtpk(kc[4 * q + 2], kc[4 * q + 3]); *(LAS u32x2_t*)(T3 + off) = w;
              w.x = cvtpk(rl4[0], rl4[1]); w.y = cvtpk(rl4[2], rl4[3]); *(LAS u32x2_t*)(T4 + off) = w;
              w.x = cvtpk(kl4[0], kl4[1]); w.y = cvtpk(kl4[2], kl4[3]); *(LAS u32x2_t*)(T5 + off) = w; }
          bsum += pg8::shx(bsum, 32, lane);
          if (hi == 0) bon[(d * 2 + qn) * 64 + snat] = bsum; }
        if (bc + bcs < BATCH * (SEQ / 64)) { LANE_VARS; const int tidl = wave_ * 64 + lane, tok = tidl >> 3, oct = tidl & 7; const int bn = bc + bcs, b2 = bn >> 6, t = (bn & 63) * 64 + tok, row = b2 * SEQ + t;
            xw3 = ld3x16(XL, 256, 8 * oct, row, t); xa3 = ld3x16(XL, 256, 64 + 8 * oct, row, t); kk3 = ld3x16(Kr, 512, hc + 8 * oct, row, t); rr3 = ld3x16(Rr, 512, hc + 8 * oct, row, t); }
        WG_BARL();
        { LANE_VARS; const int snat = SNAT; if (qn == 0 && hi == 0) BN[(size_t)(b * SEQ + t0 + snat) * 8 + h] = bon[(d * 2) * 64 + snat] + bon[(d * 2 + 1) * 64 + snat]; }
        { LANE_VARS;
#pragma unroll
          for (int r = 0; r < 16; ++r) mrk[r] = 0.f;
          bf16x8 f0[4], f1[4], f2[4], f3[4]; LD4_ROW(f0, T1, mrow); LD4_ROW(f1, T3, n0 + l31); LD4_ROW(f2, T5, n0 + l31); LD4_ROW(f3, T4, mrow); SBAR0();
#pragma unroll
          for (int ks = 0; ks < 4; ++ks) { mrk = MFMA32(f1[ks], f0[ks], mrk); mrk = MFMA32(f2[ks], f0[ks], mrk); mrk = MFMA32(f1[ks], f3[ks], mrk); }
#pragma unroll
          for (int q = 0; q < 4; ++q)
#pragma unroll
              for (int i = 0; i < 4; ++i) { const int e = 4 * q + i, n = n0 + 8 * q + 4 * hi + i; mrk[e] = (n <= mrow) ? mrk[e] : 0.f; } }
        WG_BARL();
        { LANE_VARS; f32x16 x, mk, zz;
          float z0 = 0.f; asm volatile("" : "+v"(z0));
#pragma unroll
          for (int r = 0; r < 16; ++r) { x[r] = 0.f; mk[r] = 0.f; zz[r] = z0; }
          { bf16x8 f0[4], f1[4], f2[4]; LD4_ROW(f0, T0, mrow); LD4_ROW(f1, T2, n0 + l31); LD4_ROW(f2, T3, n0 + l31); SBAR0();
#pragma unroll
            for (int ks = 0; ks < 4; ++ks) { x = MFMA32(f1[ks], f0[ks], x); mk = MFMA32(f2[ks], f0[ks], mk); } }
#pragma unroll
          for (int q = 0; q < 4; ++q)
#pragma unroll
              for (int i = 0; i < 4; ++i) { const int e = 4 * q + i, n = n0 + 8 * q + 4 * hi + i; const bool lo = n < mrow; x[e] = lo ? -x[e] : 0.f; mk[e] = lo ? mk[e] : 0.f; }
          store_quad(T4, mrow, n0, hi, x); store_quad(T5, mrow, n0, hi, zz); store_quad(T6, mrow, n0, hi, mk); }
        WG_BARL();
        if ((wave_ & 3) == 0) { LANE_VARS; const int blk = lane >> 4, c = lane & 15; float t[16];
#pragma unroll
            for (int r = 0; r < 16; ++r) { const LAS unsigned char* xr = T4 + (16 * blk + r) * TSB + 32 * blk; const v4u w0_ = *(const LAS v4u*)xr, w1_ = *(const LAS v4u*)(xr + 16);
                float acc0 = (r == c) ? 1.0f : 0.f, acc1 = 0.f;
#pragma unroll
                for (int j = 0; j < r; ++j) { const unsigned w = (j < 8) ? w0_[j >> 1] : w1_[(j - 8) >> 1]; const float xv = (j & 1) ? __uint_as_float(w & 0xffff0000u) : __uint_as_float(w << 16);
                    if (j & 1) acc1 += xv * t[j]; else acc0 += xv * t[j]; }
                t[r] = acc0 + acc1; }
#pragma unroll
            for (int r = 0; r < 16; ++r) *(LAS unsigned short*)(T5 + (16 * blk + r) * TSB + (16 * blk + c) * 2) = (unsigned short)(cvtpk(t[r], 0.f) & 0xffffu); }
        WG_BARL();
        { LANE_VARS; LAS unsigned char* const scr = qm ? T5 : T4;
          if (qm == qn) {
              f32x16 w;
#pragma unroll
              for (int r = 0; r < 16; ++r) w[r] = 0.f;
              bf16x8 mf = frag_row(T4, m0 + l31, 2 * qm, hi);
              if (l31 < 16) mf = (bf16x8){0, 0, 0, 0, 0, 0, 0, 0};
              w = MFMA32(frag_tr(T5, m0, 2 * qm, lane), mf, w);
              store_quad(scr, l31, 32, hi, w); } }
        WG_BARL();
        { LANE_VARS; LAS unsigned char* const scr = qm ? T5 : T4;
          if (qm == qn) {
              f32x16 tq = load_quad(T5, mrow, m0, hi);
#pragma unroll
              for (int ks = 0; ks < 2; ++ks) tq = MFMA32(frag_tr(scr, 32, ks, lane), frag_row(T5, mrow, 2 * qm + ks, hi), tq);
              store_quad(T5, mrow, m0, hi, tq); } }
        WG_BARL();
        { LANE_VARS;
          if (qm == 1 && qn == 0) {
              f32x16 w;
#pragma unroll
              for (int r = 0; r < 16; ++r) w[r] = 0.f;
#pragma unroll
              for (int ks = 0; ks < 2; ++ks) w = MFMA32(frag_tr(T5, 0, ks, lane), frag_row(T4, 32 + l31, ks, hi), w);
              store_quad(T4, l31, 32, hi, w); }
          if (qm == 0 && qn == 1) { f32x16 zz; float z0 = 0.f; asm volatile("" : "+v"(z0));
#pragma unroll
              for (int r = 0; r < 16; ++r) zz[r] = z0;
              store_quad(T5, l31, 32, hi, zz); } }
        WG_BARL();
        { LANE_VARS;
          if (qm == 1 && qn == 0) {
              f32x16 t21;
#pragma unroll
              for (int r = 0; r < 16; ++r) t21[r] = 0.f;
#pragma unroll
              for (int ks = 0; ks < 2; ++ks) t21 = MFMA32(frag_tr(T4, 32, ks, lane), frag_row(T5, 32 + l31, 2 + ks, hi), t21);
              store_quad(T5, 32 + l31, 0, hi, t21); } }
        WG_BARL();
        R16 vr3[2];
        { LANE_VARS; const int tt = (wave_ * 64 + lane) & 255, s = tt >> 2, cg4 = (tt & 3) * 16, sn_ = d ? 63 - s : s, t = t0 + sn_, row = b * SEQ + t;
          vr3[0] = ld3x16(Vr, 512, hc + cg4, row, t); vr3[1] = ld3x16(Vr, 512, hc + cg4 + 8, row, t); }
        { LANE_VARS; f32x16 kp, tk;
#pragma unroll
          for (int r = 0; r < 16; ++r) { kp[r] = 0.f; tk[r] = 0.f; }
          { bf16x8 f0[4], f1[4], f2[4]; LD4_ROW(f0, T5, mrow); LD4_TR(f1, T0, n0); LD4_TR(f2, T6, n0); SBAR0();
#pragma unroll
            for (int ks = 0; ks < 4; ++ks) { kp = MFMA32(f1[ks], f0[ks], kp); tk = MFMA32(f2[ks], f0[ks], tk); } }
          WG_BARL();
          store_quad(T0, mrow, n0, hi, kp); store_quad(T6, mrow, n0, hi, tk); }
        { LANE_VARS; f32x16 rb;
#pragma unroll
          for (int r = 0; r < 16; ++r) rb[r] = 0.f;
          { bf16x8 f0[4], f1[4]; LD4_ROW(f0, T2, n0 + l31); LD4_ROW(f1, T1, mrow); SBAR0();
#pragma unroll
            for (int ks = 0; ks < 4; ++ks) rb = MFMA32(f0[ks], f1[ks], rb); }
#pragma unroll
          for (int q = 0; q < 4; ++q)
#pragma unroll
              for (int i = 0; i < 4; ++i) { const int e = 4 * q + i, n = n0 + 8 * q + 4 * hi + i; rb[e] = (n <= mrow) ? rb[e] : 0.f; }
          store_quad(T4, mrow, n0, hi, rb); }
        WG_BARL();
        const int cd = d ? 63 - cn : cn;
        bf16* const pre = (bf16*)(ws + R_PRE) + ((size_t)(((b * 8 + h) * 2 + d) * 64 + cd)) * 16384;
        { LANE_VARS; f32x16 rp, ml, pm, kq;
#pragma unroll
          for (int r = 0; r < 16; ++r) { rp[r] = 0.f; ml[r] = 0.f; pm[r] = 0.f; kq[r] = 0.f; }
#pragma unroll
          for (int kh = 0; kh < 2; ++kh) { bf16x8 mrbf[2], khn[2], bcn[2], tkn[2], bcm[2], tkm[2];
#pragma unroll
              for (int k2 = 0; k2 < 2; ++k2) { const int ks = 2 * kh + k2; mrbf[k2] = frag_row(T4, mrow, ks, hi); khn[k2] = frag_tr(T0, n0, ks, lane); bcn[k2] = frag_tr(T2, n0, ks, lane); tkn[k2] = frag_tr(T6, n0, ks, lane); bcm[k2] = frag_tr(T2, m0, ks, lane); tkm[k2] = frag_tr(T6, m0, ks, lane); }
              SBAR0();
#pragma unroll
              for (int k2 = 0; k2 < 2; ++k2) { rp = MFMA32(khn[k2], mrbf[k2], rp); ml = MFMA32(tkn[k2], mrbf[k2], ml); pm = MFMA32(khn[k2], bcm[k2], pm); kq = MFMA32(bcn[k2], tkm[k2], kq); }
              SBAR0(); }
          const float gm = gcs[mrow];
#pragma unroll
          for (int q = 0; q < 4; ++q)
#pragma unroll
              for (int i = 0; i < 4; ++i) { const int e = 4 * q + i, n = n0 + 8 * q + 4 * hi + i;
                  rp[e] = rh[e] - rp[e]; ml[e] = mrk[e] - ml[e]; pm[e] = gm * (((n == mrow) ? 1.0f : 0.f) - pm[e]); kq[e] = (kc[e] - kq[e]) * gcs[n]; }
#pragma unroll
          for (int q = 0; q < 4; ++q) { const int pc = n0 + 16 * (q >> 1) + 8 * hi + 4 * (q & 1);
              u32x2_t w; w.x = cvtpk_h(pm[4 * q], pm[4 * q + 1]); w.y = cvtpk_h(pm[4 * q + 2], pm[4 * q + 3]); *(u32x2_t*)(pre + mrow * 64 + pc) = w;
              w.x = cvtpk_h(rp[4 * q], rp[4 * q + 1]); w.y = cvtpk_h(rp[4 * q + 2], rp[4 * q + 3]); *(u32x2_t*)(pre + 4096 + (d ? 63 - mrow : mrow) * 64 + pc) = w; }
          WG_BARL();
          store_quad_h(T4, mrow, n0, hi, ml); store_quad_h(T5, mrow, n0, hi, kq); }
        { LANE_VARS; const int tt = (wave_ * 64 + lane) & 255, s = tt >> 2, cg4 = (tt & 3) * 16; float v8[8];
#pragma unroll
          for (int hlf = 0; hlf < 2; ++hlf) { const int c8 = cg4 + 8 * hlf;
              sh8(vr3[hlf], ct + CT_SPV + c8, ct + CT_SNV + c8, v8);
              v4u w; w.x = cvtpk_h(v8[0], v8[1]); w.y = cvtpk_h(v8[2], v8[3]); w.z = cvtpk_h(v8[4], v8[5]); w.w = cvtpk_h(v8[6], v8[7]); *(LAS v4u*)(T1 + s * TSB + 2 * c8) = w; } }
        WG_BARL();
        { LANE_VARS; f32x16 qt, yt;
#pragma unroll
          for (int r = 0; r < 16; ++r) { qt[r] = 0.f; yt[r] = 0.f; }
          { bf16x8 f0[4], f1[4], f2[4], f3[4]; LD4_TR(f0, T1, m0); LD4_TR(f1, T5, n0); LD4_TR(f2, T1, n0); LD4_ROW(f3, T4, mrow); SBAR0();
#pragma unroll
            for (int ks = 0; ks < 4; ++ks) { qt = MFMA32H(f1[ks], f0[ks], qt); yt = MFMA32H(f2[ks], f3[ks], yt); } }
          v4u w0_, w1_;
          w0_.x = cvtpk_h(qt[0], qt[1]); w0_.y = cvtpk_h(qt[2], qt[3]); w0_.z = cvtpk_h(qt[4], qt[5]); w0_.w = cvtpk_h(qt[6], qt[7]); w1_.x = cvtpk_h(qt[8], qt[9]); w1_.y = cvtpk_h(qt[10], qt[11]); w1_.z = cvtpk_h(qt[12], qt[13]); w1_.w = cvtpk_h(qt[14], qt[15]);
          { bf16* dst = pre + 8192 + ((qn * 64 + mrow) * 2 + hi) * 16; *(v4u*)dst = w0_; *(v4u*)(dst + 8) = w1_; }
          w0_.x = cvtpk_h(yt[0], yt[1]); w0_.y = cvtpk_h(yt[2], yt[3]); w0_.z = cvtpk_h(yt[4], yt[5]); w0_.w = cvtpk_h(yt[6], yt[7]); w1_.x = cvtpk_h(yt[8], yt[9]); w1_.y = cvtpk_h(yt[10], yt[11]); w1_.z = cvtpk_h(yt[12], yt[13]); w1_.w = cvtpk_h(yt[14], yt[15]);
          { bf16* dst = pre + 12288 + ((qn * 64 + (d ? 63 - mrow : mrow)) * 2 + hi) * 16; *(v4u*)dst = w0_; *(v4u*)(dst + 8) = w1_; } }
        WG_BARL();
    }
#undef LANE_VARS
#undef SNAT
}

constexpr int SCAN_SLOT = 12 * 1024, SCAN_NS = 4;
__device__ __forceinline__ void scan_issue(const bf16* pre, LAS unsigned char* slot, int l31, int hi, int v) {
#pragma unroll
    for (int i = 0; i < 8; ++i) { const int mt = i >> 2, kt = (i >> 1) & 1, s = i & 1;
        __builtin_amdgcn_global_load_lds((const unsigned*)(pre + (32 * mt + l31) * 64 + 32 * kt + 16 * s + 8 * hi), (LAS unsigned*)(slot + i * 1024), 16, 0, 0); }
#pragma unroll
    for (int i = 0; i < 4; ++i) { const int mt = i >> 1, hf = i & 1;
        __builtin_amdgcn_global_load_lds((const unsigned*)(pre + 8192 + ((mt * 64 + v) * 2 + hi) * 16 + 8 * hf), (LAS unsigned*)(slot + (8 + i) * 1024), 16, 0, 0); }
}
__device__ __forceinline__ void rwkv_scan_chunk(Frame& F, int unit) {
    unsigned char* const ws = kws();
    int lane_ = lane_id(); asm volatile("" : "+v"(lane_));
    const int lane = lane_, hi = lane >> 5, l31 = lane & 31;
    const int chain = unit >> 1, vh = unit & 1, v = 32 * vh + l31;
    const bf16* pre = (const bf16*)(ws + R_PRE) + (size_t)chain * 64 * 16384;
    bf16* sd = (bf16*)(ws + R_SD) + (size_t)chain * 64 * 4096;
    LAS unsigned char* const ring = F.lds;
    f32x16 X0, X1;
#pragma unroll
    for (int r = 0; r < 16; ++r) { X0[r] = 0.f; X1[r] = 0.f; }
    scan_issue(pre, ring, l31, hi, v); scan_issue(pre + 16384, ring + SCAN_SLOT, l31, hi, v); scan_issue(pre + 2 * 16384, ring + 2 * SCAN_SLOT, l31, hi, v);
#pragma unroll 1
    for (int c = 0; c < 64; ++c) {
        bf16x8 xb[2][2], xl[2][2];
#pragma unroll
        for (int kt = 0; kt < 2; ++kt)
#pragma unroll
            for (int s = 0; s < 2; ++s) { v4u w, wl;
#pragma unroll
                for (int j = 0; j < 4; ++j) { const float a0 = kt ? X1[8 * s + 2 * j] : X0[8 * s + 2 * j], a1 = kt ? X1[8 * s + 2 * j + 1] : X0[8 * s + 2 * j + 1];
                    const unsigned hw = cvtpk_h(a0, a1); const f32x2_t hf = unpk_h(hw); w[j] = hw; wl[j] = cvtpk_h(a0 - hf.x, a1 - hf.y); }
                xb[kt][s] = __builtin_bit_cast(bf16x8, w); xl[kt][s] = __builtin_bit_cast(bf16x8, wl);
                *(v4u*)(sd + (size_t)c * 4096 + ((kt * 64 + v) * 2 + hi) * 16 + 8 * s) = w; }
        asm volatile("s_waitcnt lgkmcnt(0)" ::: "memory");
        if (c + 3 < 64) scan_issue(pre + (size_t)(c + 3) * 16384, ring + ((c + 3) & 3) * SCAN_SLOT, l31, hi, v);
        if (c + 3 < 64) asm volatile("s_waitcnt vmcnt(36)" ::: "memory"); else asm volatile("s_waitcnt vmcnt(0)" ::: "memory");
        const LAS unsigned char* sl = ring + (c & 3) * SCAN_SLOT + lane * 16;
        f32x16 acc[2];
#pragma unroll
        for (int mt = 0; mt < 2; ++mt) { const v4u w0_ = *(const LAS v4u*)(sl + (8 + 2 * mt) * 1024), w1_ = *(const LAS v4u*)(sl + (9 + 2 * mt) * 1024);
#pragma unroll
            for (int j = 0; j < 4; ++j) { const f32x2_t u0 = unpk_h(w0_[j]), u1 = unpk_h(w1_[j]); acc[mt][2 * j] = u0.x; acc[mt][2 * j + 1] = u0.y; acc[mt][8 + 2 * j] = u1.x; acc[mt][8 + 2 * j + 1] = u1.y; } }
        bf16x8 pf[8];
#pragma unroll
        for (int i = 0; i < 8; ++i) pf[i] = *(const LAS bf16x8*)(sl + i * 1024);
        SBAR0();
#pragma unroll
        for (int mt = 0; mt < 2; ++mt)
#pragma unroll
            for (int kt = 0; kt < 2; ++kt)
#pragma unroll
                for (int s = 0; s < 2; ++s) { const bf16x8 af = pf[4 * mt + 2 * kt + s]; acc[mt] = MFMA32H(af, xb[kt][s], acc[mt]); acc[mt] = MFMA32H(af, xl[kt][s], acc[mt]); }
        X0 = acc[0]; X1 = acc[1];
    }
}

constexpr int FIN_SGS = 272, FIN_VSS = 1040;
__device__ __forceinline__ void rwkv_finalize_mfma(Frame& F, int layer) {
    unsigned char* const ws = kws();
    int lane_ = lane_id(); asm volatile("" : "+v"(lane_)); int wave_o = F.wv; asm volatile("" : "+s"(wave_o)); const int wave_ = wave_o, h = wave_, hc = h * HD;
#define FIN_LANE int lane = lane_; asm volatile("" : "+v"(lane)); const int hi = lane >> 5, l31 = lane & 31; (void)hi; (void)l31;
    LAS unsigned char* const sgt = F.lds; LAS unsigned char* const vst = F.lds + 64 * FIN_SGS;
    const bf16* Vr = (const bf16*)(ws + R_VR); const bf16* XL = (const bf16*)(ws + R_XL); bf16* MIX = (bf16*)(ws + R_MIX); const bf16* G2T = (const bf16*)(ws + WS_G2T);
    const float* BN0 = (const float*)(ws + R_BN); const float* BN1 = BN0 + (size_t)M * 8;
    const float* sp = karg(I_TSP) + layer * RPROJ; const float* sn = karg(I_TSN) + layer * RPROJ;
    const float* gnw = karg(I_GNW) + layer * 512 + hc; const float* gnb = karg(I_GNB) + layer * 512 + hc;
    for (int unit = F.vcu; unit < BATCH * (SEQ / 64); unit += F.G) {
        const int cn = unit & 63, b = unit >> 6, t0 = cn * 64;
        { FIN_LANE; const int tid = wave_ * 64 + lane, tok = tid >> 3, oct = tid & 7, t = t0 + tok, row = b * SEQ + t; float v8[8];
#pragma unroll
          for (int hf = 0; hf < 2; ++hf) { const int k0 = 16 * oct + 8 * hf;
              shift8(XL, 256, 128 + k0, row, t, sp + 1664 + k0, sn + 1664 + k0, v8);
              v4u w; w.x = cvtpk(sigmoidf_(v8[0]), sigmoidf_(v8[1])); w.y = cvtpk(sigmoidf_(v8[2]), sigmoidf_(v8[3])); w.z = cvtpk(sigmoidf_(v8[4]), sigmoidf_(v8[5])); w.w = cvtpk(sigmoidf_(v8[6]), sigmoidf_(v8[7]));
              *(LAS v4u*)(sgt + tok * FIN_SGS + 2 * k0) = w; }
#pragma unroll 2
          for (int j = 0; j < 8; ++j) { const int c0 = 64 * j + 8 * oct; float v8[8];
              shift8(Vr, 512, c0, row, t, sp + 1024 + c0, sn + 1024 + c0, v8);
              v4u w; w.x = cvtpk(v8[0], v8[1]); w.y = cvtpk(v8[2], v8[3]); w.z = cvtpk(v8[4], v8[5]); w.w = cvtpk(v8[6], v8[7]);
              *(LAS v4u*)(vst + tok * FIN_VSS + 2 * c0) = w; } }
        WG_BARL();
        { FIN_LANE;
        f32x16 acc[2][2], gg[2][2];
#pragma unroll
        for (int tt = 0; tt < 2; ++tt)
#pragma unroll
            for (int vt = 0; vt < 2; ++vt)
#pragma unroll
                for (int r = 0; r < 16; ++r) { acc[tt][vt][r] = 0.f; gg[tt][vt][r] = 0.f; }
#pragma unroll
        for (int d = 0; d < 2; ++d) { const size_t item = (size_t)(((b * 8 + h) * 2 + d) * 64 + (d ? 63 - cn : cn));
            const bf16* pre = (const bf16*)(ws + R_PRE) + item * 16384; const bf16* sd = (const bf16*)(ws + R_SD) + item * 4096;
#pragma unroll
            for (int tt = 0; tt < 2; ++tt)
#pragma unroll
                for (int vt = 0; vt < 2; ++vt) { const bf16* src = pre + 12288 + ((vt * 64 + 32 * tt + l31) * 2 + hi) * 16; const v4u w0_ = *(const v4u*)src, w1_ = *(const v4u*)(src + 8);
#pragma unroll
                    for (int j = 0; j < 4; ++j) { const f32x2_t u0 = unpk_h(w0_[j]), u1 = unpk_h(w1_[j]); acc[tt][vt][2 * j] += u0.x; acc[tt][vt][2 * j + 1] += u0.y; acc[tt][vt][8 + 2 * j] += u1.x; acc[tt][vt][8 + 2 * j + 1] += u1.y; } }
            bf16x8 sf[4][2], rf[4][2];
#pragma unroll
            for (int ks = 0; ks < 4; ++ks) { const int kt = ks >> 1, s = ks & 1;
#pragma unroll
                for (int vt = 0; vt < 2; ++vt) sf[ks][vt] = *(const bf16x8*)(sd + ((kt * 64 + 32 * vt + l31) * 2 + hi) * 16 + 8 * s);
#pragma unroll
                for (int tt = 0; tt < 2; ++tt) rf[ks][tt] = *(const bf16x8*)(pre + 4096 + (32 * tt + l31) * 64 + 32 * kt + 16 * s + 8 * hi); }
            SBAR0();
#pragma unroll
            for (int ks = 0; ks < 4; ++ks)
#pragma unroll
                for (int tt = 0; tt < 2; ++tt)
#pragma unroll
                    for (int vt = 0; vt < 2; ++vt) acc[tt][vt] = MFMA32H(sf[ks][vt], rf[ks][tt], acc[tt][vt]); }
#pragma unroll
        for (int kh = 0; kh < 2; ++kh) { bf16x8 gf[4][2], tf[4][2];
#pragma unroll
            for (int k4 = 0; k4 < 4; ++k4) { const int ks = 4 * kh + k4;
#pragma unroll
                for (int vt = 0; vt < 2; ++vt) gf[k4][vt] = *(const bf16x8*)(G2T + (size_t)(hc + 32 * vt + l31) * 128 + 16 * ks + 8 * hi);
#pragma unroll
                for (int tt = 0; tt < 2; ++tt) tf[k4][tt] = *(const LAS bf16x8*)(sgt + (32 * tt + l31) * FIN_SGS + (16 * ks + 8 * hi) * 2); }
            SBAR0();
#pragma unroll
            for (int k4 = 0; k4 < 4; ++k4)
#pragma unroll
                for (int tt = 0; tt < 2; ++tt)
#pragma unroll
                    for (int vt = 0; vt < 2; ++vt) gg[tt][vt] = MFMA32(gf[k4][vt], tf[k4][tt], gg[tt][vt]);
            SBAR0(); }
#pragma unroll
        for (int tt = 0; tt < 2; ++tt) { const int t = t0 + 32 * tt + l31, row = b * SEQ + t;
            float sm = 0.f;
#pragma unroll
            for (int vt = 0; vt < 2; ++vt)
#pragma unroll
                for (int r = 0; r < 16; ++r) sm += acc[tt][vt][r];
            sm += pg8::shx(sm, 32, lane); const float mu = sm * (1.0f / 64.0f); float sq = 0.f;
#pragma unroll
            for (int vt = 0; vt < 2; ++vt)
#pragma unroll
                for (int r = 0; r < 16; ++r) { const float dl = acc[tt][vt][r] - mu; sq += dl * dl; }
            sq += pg8::shx(sq, 32, lane); const float rstd = 1.0f / sqrtf(sq * (1.0f / 64.0f) + GN_EPS);
            const float bon = BN0[(size_t)row * 8 + h] + BN1[(size_t)row * 8 + h];
#pragma unroll
            for (int vt = 0; vt < 2; ++vt)
#pragma unroll
                for (int q = 0; q < 4; ++q) { const int v0 = 32 * vt + 8 * q + 4 * hi;
                    LAS u32x2_t* const vp = (LAS u32x2_t*)(vst + (32 * tt + l31) * FIN_VSS + 2 * (hc + v0)); const u32x2_t vw = *vp;
                    const f32x4 vs = (f32x4){__uint_as_float(vw.x << 16), __uint_as_float(vw.x & 0xffff0000u), __uint_as_float(vw.y << 16), __uint_as_float(vw.y & 0xffff0000u)}, w4 = *(const f32x4*)(gnw + v0), b4 = *(const f32x4*)(gnb + v0);
                    float o4[4];
#pragma unroll
                    for (int i = 0; i < 4; ++i) o4[i] = ((acc[tt][vt][4 * q + i] - mu) * rstd * w4[i] + b4[i] + bon * vs[i]) * gg[tt][vt][4 * q + i];
                    u32x2_t w; w.x = cvtpk(o4[0], o4[1]); w.y = cvtpk(o4[2], o4[3]); *vp = w; } } }
        WG_BARL();
        { FIN_LANE; const int tid = wave_ * 64 + lane, tok = tid >> 3, oct = tid & 7; bf16* orow = MIX + (size_t)(b * SEQ + t0 + tok) * 1024 + 512;
#pragma unroll
          for (int j = 0; j < 8; ++j) { const int c0 = 64 * j + 8 * oct; *(v4u*)(orow + c0) = *(const LAS v4u*)(vst + tok * FIN_VSS + 2 * c0); } }
        WG_BARL();
    }
}
#undef FIN_LANE

constexpr int ATT_O = 0, ATT_L = 65536, ATT_V = 67584, ATT_VT = 32 * TSB;
static_assert(ATT_V + NWAVES * ATT_VT <= LDSCTL_OFF, "attention LDS map");
__device__ __forceinline__ bf16x8 frag_tr_pv(const LAS unsigned char* tile, int d0, int s, int lane) {
    const int hi = lane >> 5, g1 = (lane >> 4) & 1, i = lane & 15;
    const LAS unsigned char* p = tile + (16 * s + 4 * hi + (i >> 2)) * TSB + (d0 + 16 * g1 + 4 * (i & 3)) * 2;
    const s16x4 lo = tr4(p), h4 = tr4(p + 8 * TSB);
    return (bf16x8){lo[0], lo[1], lo[2], lo[3], h4[0], h4[1], h4[2], h4[3]};
}
template <int NQH>
__device__ __forceinline__ void attn_block(const bf16* MIX, const bf16* V, LAS unsigned char* lds, LAS unsigned char* vt, int b, int h, int T0, int tq0, int d, float slope_d, float bound, bool first, int lane_in) {
    int lane = lane_in; asm volatile("" : "+v"(lane));
    const int hi = lane >> 5, l31 = lane & 31;
    const int jlo = -(tq0 / d), jhi = (SEQ - 1 - tq0) / d;
    bf16x8 qf[NQH][4];
#pragma unroll
    for (int qh = 0; qh < NQH; ++qh) { const bf16* qp = MIX + ((size_t)b * SEQ + tq0 + d * (32 * qh + l31)) * 1024 + h * HD + 8 * hi;
#pragma unroll
        for (int ks = 0; ks < 4; ++ks) qf[qh][ks] = *(const bf16x8*)(qp + 16 * ks); }
    f32x16 o[NQH][2]; float lsum[NQH];
#pragma unroll
    for (int qh = 0; qh < NQH; ++qh) { lsum[qh] = 0.f;
#pragma unroll
        for (int r = 0; r < 16; ++r) { o[qh][0][r] = 0.f; o[qh][1][r] = 0.f; } }
    constexpr int NT = NQH == 2 ? 6 : 5;
    v4u vraw[4]; bf16x8 kn[4];
#define ATT_LOAD(JT) do { { const int kr_ = lane >> 1, hf_ = lane & 1; int pos_ = tq0 + d * (32 * (JT) + kr_ - 64); pos_ = pos_ < 0 ? 0 : (pos_ > SEQ - 1 ? SEQ - 1 : pos_); \
          const v4u* src_ = (const v4u*)(V + ((size_t)b * SEQ + pos_) * 512 + h * HD + 32 * hf_); vraw[0] = src_[0]; vraw[1] = src_[1]; vraw[2] = src_[2]; vraw[3] = src_[3]; } \
        { int pos_ = tq0 + d * (32 * (JT) + l31 - 64); pos_ = pos_ < 0 ? 0 : (pos_ > SEQ - 1 ? SEQ - 1 : pos_); const bf16* kp_ = MIX + ((size_t)b * SEQ + pos_) * 1024 + 512 + h * HD + 8 * hi; \
          _Pragma("unroll") for (int ks = 0; ks < 4; ++ks) kn[ks] = *(const bf16x8*)(kp_ + 16 * ks); } } while (0)
    ATT_LOAD(0);
#pragma unroll 1
    for (int jt = 0; jt < NT; ++jt) {
        bf16x8 kf[4];
        { LAS v4u* dst = (LAS v4u*)(vt + (lane >> 1) * TSB + 64 * (lane & 1)); dst[0] = vraw[0]; dst[1] = vraw[1]; dst[2] = vraw[2]; dst[3] = vraw[3]; }
#pragma unroll
        for (int ks = 0; ks < 4; ++ks) kf[ks] = kn[ks];
        if (jt + 1 < NT) ATT_LOAD(jt + 1);
        asm volatile("s_waitcnt lgkmcnt(0)" ::: "memory");
        bf16x8 vfr[2][2];
#pragma unroll
        for (int dt = 0; dt < 2; ++dt)
#pragma unroll
            for (int s2 = 0; s2 < 2; ++s2) vfr[dt][s2] = frag_tr_pv(vt, 32 * dt, s2, lane);
        const bool inseq = (32 * jt - 64 >= jlo) && (32 * jt - 33 <= jhi);
#pragma unroll
        for (int qh = 0; qh < NQH; ++qh) {
            if (NQH == 2 && ((qh == 0 && jt == 5) || (qh == 1 && jt == 0))) continue;
            const float fb = (float)(32 * qh + l31 - (32 * jt + 4 * hi - 64)); const int rel = jt - qh;
            f32x16 s;
            if (inseq && rel == 1) { const float A = fmaf(-slope_d, fb, -bound);
#pragma unroll
                for (int r = 0; r < 16; ++r) s[r] = fmaf(slope_d, (float)((r & 3) + 8 * (r >> 2)), A);
            } else if (inseq && rel == 3) { const float A = fmaf(slope_d, fb, -bound);
#pragma unroll
                for (int r = 0; r < 16; ++r) s[r] = fmaf(-slope_d, (float)((r & 3) + 8 * (r >> 2)), A);
            } else if (inseq && rel == 2) {
#pragma unroll
                for (int r = 0; r < 16; ++r) s[r] = fmaf(-slope_d, fabsf(fb - (float)((r & 3) + 8 * (r >> 2))), -bound);
            } else if (inseq) {
#pragma unroll
                for (int r = 0; r < 16; ++r) { const float t = fabsf(fb - (float)((r & 3) + 8 * (r >> 2))); s[r] = (t <= 64.0f) ? fmaf(-slope_d, t, -bound) : -1e30f; }
            } else {
#pragma unroll
                for (int r = 0; r < 16; ++r) { const int cr = (r & 3) + 8 * (r >> 2), jj = 32 * jt + cr + 4 * hi - 64; const float t = fabsf(fb - (float)cr);
                    s[r] = ((t <= 64.0f) && (jj >= jlo) && (jj <= jhi)) ? fmaf(-slope_d, t, -bound) : -1e30f; }
            }
#pragma unroll
            for (int ks = 0; ks < 4; ++ks) s = MFMA32(kf[ks], qf[qh][ks], s);
            v4u pk[2];
#pragma unroll
            for (int r = 0; r < 16; r += 2) { const float p0 = __builtin_amdgcn_exp2f(s[r]), p1 = __builtin_amdgcn_exp2f(s[r + 1]); lsum[qh] += p0 + p1; pk[r >> 3][(r >> 1) & 3] = cvtpk(p0, p1); }
#pragma unroll
            for (int dt = 0; dt < 2; ++dt)
#pragma unroll
                for (int s2 = 0; s2 < 2; ++s2) o[qh][dt] = MFMA32(vfr[dt][s2], __builtin_bit_cast(bf16x8, pk[s2]), o[qh][dt]);
        }
    }
#undef ATT_LOAD
    int lane2 = lane; asm volatile("" : "+v"(lane2));
#pragma unroll
    for (int qh = 0; qh < NQH; ++qh) { const int hi = lane2 >> 5, l31 = lane2 & 31, lane = lane2;
        const int qi = (tq0 - T0) + d * (32 * qh + l31);
        const float lt = lsum[qh] + pg8::shx(lsum[qh], 32, lane);
        if (hi == 0) { LAS float* lp = (LAS float*)(lds + ATT_L) + qi; *lp = first ? lt : (*lp + lt); }
#pragma unroll
        for (int dt = 0; dt < 2; ++dt)
#pragma unroll
            for (int q = 0; q < 4; ++q) { const int d0 = 32 * dt + 8 * q + 4 * hi; LAS u32x2_t* op = (LAS u32x2_t*)(lds + ATT_O + qi * 128 + ((((d0 >> 3) ^ (qi & 7)) << 4) | ((d0 & 4) << 1)));
                float v0 = o[qh][dt][4 * q], v1 = o[qh][dt][4 * q + 1], v2 = o[qh][dt][4 * q + 2], v3 = o[qh][dt][4 * q + 3];
                if (!first) { const u32x2_t w = *op; v0 += __uint_as_float(w.x << 16); v1 += __uint_as_float(w.x & 0xffff0000u); v2 += __uint_as_float(w.y << 16); v3 += __uint_as_float(w.y & 0xffff0000u); }
                u32x2_t w; w.x = cvtpk(v0, v1); w.y = cvtpk(v2, v3); *op = w; }
    }
}
__device__ __forceinline__ void attn_phase_mfma(Frame& F, int layer, int unit0, int nunit, int ustride) {
    unsigned char* const ws = kws();
    int lane_ = lane_id(); asm volatile("" : "+v"(lane_)); int wave_o = F.wv; asm volatile("" : "+s"(wave_o)); const int wave_ = wave_o, lane = lane_;
    bf16* MIX = (bf16*)(ws + R_MIX); const bf16* V = (const bf16*)(ws + R_V);
    LAS unsigned char* const lds = F.lds; LAS unsigned char* const vt = lds + ATT_V + wave_ * ATT_VT;
    float bound;
    { const float* qg = karg(I_QG) + layer * HD; const float* kg = karg(I_KG) + layer * HD; float mq = 0.f, mk = 0.f;
      for (int i = 0; i < HD; ++i) { mq = fmaxf(mq, fabsf(qg[i])); mk = fmaxf(mk, fabsf(kg[i])); }
      bound = (8.0f * mq * mk + 0.25f) * 1.4426950408889634f; }
    for (int unit = unit0; unit < nunit; unit += ustride) {
        const int st = unit & 7, h = (unit >> 3) & 7, b = unit >> 6, T0 = st * 512;
        const float slope = exp2f(-(float)(h + 1)) * 1.4426950408889634f;
        attn_block<2>(MIX, V, lds, vt, b, h, T0, T0 + 64 * wave_, 1, slope, bound, true, lane);
        WG_BAR();
        attn_block<2>(MIX, V, lds, vt, b, h, T0, T0 + (wave_ & 3) + 256 * (wave_ >> 2), 4, slope * 4.f, bound, false, lane);
        WG_BAR();
        attn_block<1>(MIX, V, lds, vt, b, h, T0, T0 + 2 * wave_, 16, slope * 16.f, bound, false, lane);
        attn_block<1>(MIX, V, lds, vt, b, h, T0, T0 + 2 * wave_ + 1, 16, slope * 16.f, bound, false, lane);
        WG_BAR();
        { int lane3 = lane; asm volatile("" : "+v"(lane3)); const int tid = wave_ * 64 + lane3;
#pragma unroll
          for (int k = 0; k < 8; ++k) { const int item = tid + 512 * k, qi = item >> 3, c16 = item & 7;
              const v4u w = *(const LAS v4u*)(lds + ATT_O + qi * 128 + ((c16 ^ (qi & 7)) << 4)); const float il = 1.0f / ((const LAS float*)(lds + ATT_L))[qi];
              v4u o;
#pragma unroll
              for (int j = 0; j < 4; ++j) o[j] = cvtpk(__uint_as_float(w[j] << 16) * il, __uint_as_float(w[j] & 0xffff0000u) * il);
              *(v4u*)(MIX + ((size_t)b * SEQ + T0 + qi) * 1024 + h * HD + 8 * c16) = o; } }
        WG_BAR();
    }
}

__global__ void __launch_bounds__(NTHR, 2) mk_fwd(Args args) {
    extern __shared__ __attribute__((aligned(16))) unsigned char lds[];
    Frame F;
    F.lds = (LAS unsigned char*)lds;
    F.MISC = (volatile LAS unsigned*)(F.lds + MISC_OFF);
    F.wv = __builtin_amdgcn_readfirstlane((int)threadIdx.x >> 6);
    F.G = gridDim.x; { const int bx = blockIdx.x; F.vcu = (F.G % 8 == 0) ? (bx % 8) * (F.G / 8) + bx / 8 : bx; }
    F.ctl = (gu32*)(kws() + WS_CTL);
    for (int u = F.wv * 64 + lane_id(); u < (LDS_BYTES - LDSCTL_OFF) / 4; u += NTHR) ((LAS unsigned*)(F.lds + LDSCTL_OFF))[u] = 0u;
    __syncthreads();
    XcdBarrier bar = xcd_barrier_post((unsigned*)(F.ctl + CW_BAR), F.MISC + 8, F.wv == 0 && lane_id() == 0);
#define GRID_BAR() xcd_barrier(bar, F.wv == 0 && lane_id() == 0)
#define XB ((bf16*)(ws + R_XB))
#define MIXB ((bf16*)(ws + R_MIX))
#define HID ((bf16*)(ws + R_HID))
#define SS1 ((float*)(ws + WS_SS1))
#define SS2 ((float*)(ws + WS_SS2))

    for (int step = 0; step < 8 * DEPTH; ++step) {
        const int layer = step >> 3, kind = step & 7;
        if (kind == 0) {
            if (layer > 0) continue;
            x_prologue(F);
            { int lane_ = lane_id(); asm volatile("" : "+v"(lane_)); wconv_items(0, -1, F.vcu * NWAVES + F.wv, F.G * NWAVES, (LAS float*)(F.lds + RING_OFF + F.wv * 16384), lane_); }
        } else if (kind == 1) {
            unsigned char* const ws = kws();
            pg8::Gemm g{XB, (const bf16*)(ws + WS_WIN), M, NPROJ, D}; pg8::StaticOrder S; S.init(M, NPROJ, F.G, (int)blockIdx.x);
            pg8::EpiProj E; E.base0 = (bf16*)(ws + WS_R0); E.ss = SS1; E.qg = karg(I_QG) + layer * HD; E.kg = karg(I_KG) + layer * HD;
            pg8::gemm_phase<pg8::EpiProj, pg8::StaticOrder, true, true>(F.lds + RING_OFF, g, S, E, F.wv, lane_id());
        } else if (kind == 2) {
            rwkv_pre_phase(F, layer);
        } else if (kind == 3) {
            const int bx = (int)blockIdx.x;
            if (bx < 128) { if (F.wv == 0) rwkv_scan_chunk(F, bx);
                            else { int lane_ = lane_id(); asm volatile("" : "+v"(lane_)); wconv_items(layer + 1, layer, bx * 7 + F.wv - 1, 128 * 7, (LAS float*)(F.lds + SCAN_NS * SCAN_SLOT + (F.wv - 1) * 9216), lane_); } }
            else attn_phase_mfma(F, layer, bx - 128, BATCH * H * 8, F.G - 128);
        } else if (kind == 4) {
            rwkv_finalize_mfma(F, layer);
        } else if (kind == 5 || kind == 7) {
            unsigned char* const ws = kws(); float* const xo = kout();
            pg8::Gemm g{kind == 5 ? MIXB : HID, (const bf16*)(ws + (kind == 5 ? WS_WOUT : WS_WDN)), M, D, kind == 5 ? D : FF}; pg8::StaticOrder S; S.init(M, D, F.G, (int)blockIdx.x);
            pg8::EpiRes E{xo, XB, kind == 5 ? SS2 : SS1};
            pg8::gemm_phase<pg8::EpiRes, pg8::StaticOrder, false, true>(F.lds + RING_OFF, g, S, E, F.wv, lane_id());
        } else {
            unsigned char* const ws = kws();
            pg8::Gemm g{XB, (const bf16*)(ws + WS_WUP), M, FF, D}; pg8::StaticOrder S; S.init(M, FF, F.G, (int)blockIdx.x);
            pg8::EpiUp E{HID, SS2};
            pg8::gemm_phase<pg8::EpiUp, pg8::StaticOrder, true, true>(F.lds + RING_OFF, g, S, E, F.wv, lane_id());
        }
        if (step + 1 < 8 * DEPTH) GRID_BAR();
    }
}

extern "C" void kernel_launch(void* const* d_in, const int* in_sizes, int n_in, void* d_out, int out_size, void* d_ws, size_t ws_size, hipStream_t stream) {
    static int grid = 0;
    if (grid == 0) {
        if (n_in != N_IN || in_sizes[0] != M * D || out_size != M * D || ws_size < WS_END) { fprintf(stderr, "kernel_launch: unexpected shapes (n_in %d, in0 %d, out %d, ws %zu)\n", n_in, n_in > 0 ? in_sizes[0] : -1, out_size, ws_size); grid = -1; return; }
        int dev = 0, cus = 0;
        if (hipGetDevice(&dev) != hipSuccess || hipDeviceGetAttribute(&cus, hipDeviceAttributeMultiprocessorCount, dev) != hipSuccess) { grid = -1; return; }
        if (hipFuncSetAttribute((const void*)mk_fwd, hipFuncAttributeMaxDynamicSharedMemorySize, LDS_BYTES) != hipSuccess) { fprintf(stderr, "kernel_launch: hipFuncSetAttribute failed\n"); grid = -1; return; }
        int per_cu = 0;
        (void)hipOccupancyMaxActiveBlocksPerMultiprocessor(&per_cu, (const void*)mk_fwd, NTHR, LDS_BYTES);
        (void)hipGetLastError();
        grid = cus;
    }
    if (grid < 0) return;
    (void)hipMemsetAsync((char*)d_ws + WS_CTL, 0, CTL_ZERO_BYTES, stream);
    Args a{};
    for (int i = 0; i < N_IN; ++i) a.in[i] = (const float*)d_in[i];
    a.out = (float*)d_out; a.ws = (unsigned char*)d_ws;
    hipLaunchKernelGGL(mk_fwd, dim3(grid), dim3(NTHR), LDS_BYTES, stream, a);
}
```

```cpp
#include <hip/hip_runtime.h>
#include <cstdio>
#include <cstdint>
namespace pg8 {
#define PG8_LAS __attribute__((address_space(3)))
typedef unsigned short bf16_t;
typedef short bf16x8 __attribute__((ext_vector_type(8)));
typedef float f32x4 __attribute__((ext_vector_type(4)));
typedef unsigned u32x4 __attribute__((ext_vector_type(4)));
constexpr int BM = 256, BK = 64, HALF = 128, HTB = HALF * BK * 2  , STAGE_BYTES = 8 * HTB, NXCD = 8, WGM = 8;

__host__ __device__ __forceinline__ int lds_byte(int r, int c) { const int st = (r >> 4) * 2 + (c >> 5), rr = r & 15, cc = c & 31, ob = rr * 64 + cc * 2; return st * 1024 + (ob ^ (((ob >> 9) & 1) << 5)); }
__host__ __device__ __forceinline__ void stage_rc(int b, int& R, int& C) { const int st = b / 1024, sb = b % 1024, swz = sb ^ (((sb >> 9) & 1) << 5); R = (st >> 1) * 16 + swz / 64; C = (st & 1) * 32 + (swz % 64) / 2; }
__host__ __device__ __forceinline__ int perm32(int rho) { const int n = rho >> 4, i = rho & 15; return 8 * (i >> 2) + 4 * n + (i & 3); }

struct Unit { int pm, pn; };
struct Gemm { const bf16_t* A; const bf16_t* Bt; int M, N, K; };

struct StaticOrder {
    int nM, nN, nwg, G, c;
    __host__ __device__ void init(int M, int N, int G_, int c_) { nM = M / BM; nN = N / BM; nwg = nM * nN; G = G_; c = c_; }
    __host__ __device__ bool next(int i, Unit& u) const {
        const long L = (long)i * G + c; if (L >= nwg) return false;
        int wgid = (int)L; { const int q = nwg / NXCD, r = nwg % NXCD, xcd = wgid % NXCD, off = wgid / NXCD; wgid = (xcd < r ? xcd * (q + 1) : r * (q + 1) + (xcd - r) * q) + off; }
        const int nig = WGM * nN, gid = wgid / nig, fm = gid * WGM, gsz = (nM - fm) < WGM ? (nM - fm) : WGM;
        u.pm = fm + ((wgid % nig) % gsz); u.pn = (wgid % nig) / gsz; return true;
    }
    __device__ __forceinline__ void a_ready(const Unit&) const {}
    __device__ __forceinline__ void done(const Unit&) const {}
};

__device__ __forceinline__ unsigned cvt_pk_bf16(float lo, float hi) { unsigned r; asm volatile("v_cvt_pk_bf16_f32 %0, %1, %2" : "=v"(r) : "v"(lo), "v"(hi)); return r; }
typedef unsigned u32x2 __attribute__((ext_vector_type(2)));
typedef float f32x2 __attribute__((ext_vector_type(2))); typedef _Float16 h16x2 __attribute__((ext_vector_type(2))); typedef _Float16 f16x8 __attribute__((ext_vector_type(8)));
__device__ __forceinline__ unsigned pkh(float lo, float hi) { f32x2 v = {lo, hi}; return __builtin_bit_cast(unsigned, __builtin_convertvector(v, h16x2)); }
__device__ __forceinline__ f32x2 unpkh(unsigned w) { return __builtin_convertvector(__builtin_bit_cast(h16x2, w), f32x2); }

__device__ __forceinline__ float shx(float v, int m, int lane) { return __int_as_float(__builtin_amdgcn_ds_bpermute((lane ^ m) << 2, __float_as_int(v))); }
__device__ __forceinline__ float row_rs(const float* ss, int row, int fq, int lane) {
    const f32x4 p = *(const f32x4*)(ss + (size_t)row * 16 + 4 * fq);
    float s = (p[0] + p[1]) + (p[2] + p[3]);
    s += shx(s, 16, lane); s += shx(s, 32, lane);
    return __builtin_amdgcn_rsqf(s * (1.0f / 1024.0f) + 1e-6f);
}

struct EpiProj {
    static constexpr bool PERM = true, AFTER_DRAIN = false, RS_LDS = true;
    bf16_t* base0; const float* ss; const float* qg; const float* kg;
    __device__ __forceinline__ void operator()(const f32x4 (&acc)[2][2][4][2], const Unit& u, int wr, int wc, int fr, int fq, const PG8_LAS float* rsl) const {
        const int tile = u.pn, di = tile >> 1;
        bf16_t* base = base0 + (di < 2 ? (size_t)di * 512 : (size_t)di * (8u << 20)); const int ldc = (di < 2) ? 1024 : ((di == 6) ? 256 : 512); const int cb = (di == 6) ? 0 : (tile & 1) * 256;
        const bool nrm = tile < 4; const float* gsrc = (tile < 2) ? qg : kg; const float post = (tile < 2) ? 0.125f * 1.4426950408889634f : 1.0f;
        f32x4 g[2][2];
#pragma unroll
        for (int bj = 0; bj < 2; ++bj)
#pragma unroll
            for (int n = 0; n < 2; ++n) g[bj][n] = nrm ? *(const f32x4*)(gsrc + 32 * bj + 8 * fq + 4 * n) * post : (f32x4){1.f, 1.f, 1.f, 1.f};
#pragma unroll
        for (int ai = 0; ai < 2; ++ai)
#pragma unroll
            for (int m = 0; m < 4; ++m) {
                const int row = u.pm * BM + ai * HALF + wr * 64 + m * 16 + fr;
                const float rs = rsl[ai * HALF + wr * 64 + m * 16 + fr];
                f32x4 v[2][2]; float q = 0.f;
#pragma unroll
                for (int bj = 0; bj < 2; ++bj)
#pragma unroll
                    for (int n = 0; n < 2; ++n) { v[bj][n] = acc[ai][bj][m][n] * rs; const f32x4 t = v[bj][n]; q += (t[0] * t[0] + t[1] * t[1]) + (t[2] * t[2] + t[3] * t[3]); }
                q += shx(q, 16, 16 * fq + fr); q += shx(q, 32, 16 * fq + fr);
                const float inv = nrm ? __builtin_amdgcn_rsqf(q * (1.0f / 64.0f) + 1e-6f) : 1.0f;
                bf16_t* rowp = base + (size_t)row * ldc + cb + 64 * wc + 8 * fq;
#pragma unroll
                for (int bj = 0; bj < 2; ++bj) { const f32x4 v0 = v[bj][0] * inv * g[bj][0], v1 = v[bj][1] * inv * g[bj][1];
                    u32x4 w; w.x = cvt_pk_bf16(v0[0], v0[1]); w.y = cvt_pk_bf16(v0[2], v0[3]); w.z = cvt_pk_bf16(v1[0], v1[1]); w.w = cvt_pk_bf16(v1[2], v1[3]);
                    __builtin_nontemporal_store(w, (u32x4*)(rowp + 32 * bj)); }
                asm volatile("" ::: "memory");
            }
    }
};
struct EpiUp {
    static constexpr bool PERM = true, AFTER_DRAIN = false, RS_LDS = true;
    bf16_t* O; const float* ss;
    __device__ __forceinline__ void operator()(const f32x4 (&acc)[2][2][4][2], const Unit& u, int wr, int wc, int fr, int fq, const PG8_LAS float* rsl) const {
#pragma unroll
        for (int ai = 0; ai < 2; ++ai)
#pragma unroll
            for (int m = 0; m < 4; ++m) {
                const int row = u.pm * BM + ai * HALF + wr * 64 + m * 16 + fr;
                const float rs = rsl[ai * HALF + wr * 64 + m * 16 + fr];
                bf16_t* rowp = O + (size_t)row * 4096 + u.pn * BM + wc * 32 + 8 * fq;
#pragma unroll
                for (int bj = 0; bj < 2; ++bj) { f32x4 v0 = acc[ai][bj][m][0] * rs, v1 = acc[ai][bj][m][1] * rs;
                    v0 = __builtin_elementwise_max(v0, (f32x4){0.f, 0.f, 0.f, 0.f}); v1 = __builtin_elementwise_max(v1, (f32x4){0.f, 0.f, 0.f, 0.f}); v0 = v0 * v0; v1 = v1 * v1;
                    u32x4 w; w.x = cvt_pk_bf16(v0[0], v0[1]); w.y = cvt_pk_bf16(v0[2], v0[3]); w.z = cvt_pk_bf16(v1[0], v1[1]); w.w = cvt_pk_bf16(v1[2], v1[3]);
                    *(u32x4*)(rowp + bj * HALF) = w; }
                asm volatile("" ::: "memory");
            }
    }
};
struct EpiRes {
    static constexpr bool PERM = true, AFTER_DRAIN = false, RS_LDS = false;
    bf16_t* xh; float* out; float* ss;
    __device__ __forceinline__ void operator()(const f32x4 (&acc)[2][2][4][2], const Unit& u, int wr, int wc, int fr, int fq) const {
        const int col0 = u.pn * BM + wc * 32 + 8 * fq;
#pragma unroll
        for (int ai = 0; ai < 2; ++ai) {
            u32x4 rawv[4][2];
#pragma unroll
            for (int m = 0; m < 4; ++m)
#pragma unroll
                for (int bj = 0; bj < 2; ++bj) rawv[m][bj] = *(const u32x4*)(xh + (size_t)(u.pm * BM + ai * HALF + wr * 64 + m * 16 + fr) * 1024 + col0 + bj * HALF);
#pragma unroll
            for (int m = 0; m < 4; ++m) {
                const int row = u.pm * BM + ai * HALF + wr * 64 + m * 16 + fr; const size_t off = (size_t)row * 1024 + col0; float q = 0.f;
#pragma unroll
                for (int bj = 0; bj < 2; ++bj) { const size_t o = off + bj * HALF; const u32x4 raw = rawv[m][bj];
                    const f32x2 a0 = unpkh(raw.x), a1 = unpkh(raw.y), a2 = unpkh(raw.z), a3 = unpkh(raw.w);
                    const f32x4 t0 = (f32x4){a0[0], a0[1], a1[0], a1[1]} + acc[ai][bj][m][0], t1 = (f32x4){a2[0], a2[1], a3[0], a3[1]} + acc[ai][bj][m][1];
                    if (out) { *(f32x4*)(out + o) = t0; *(f32x4*)(out + o + 4) = t1; }
                    else { u32x4 w; w.x = pkh(t0[0], t0[1]); w.y = pkh(t0[2], t0[3]); w.z = pkh(t1[0], t1[1]); w.w = pkh(t1[2], t1[3]); *(u32x4*)(xh + o) = w; }
                    q += ((t0[0] * t0[0] + t0[1] * t0[1]) + (t0[2] * t0[2] + t0[3] * t0[3])) + ((t1[0] * t1[0] + t1[1] * t1[1]) + (t1[2] * t1[2] + t1[3] * t1[3])); }
                q += shx(q, 16, 16 * fq + fr); q += shx(q, 32, 16 * fq + fr);
                if (fq == 0) ss[(size_t)row * 16 + 4 * u.pn + wc] = q;
            }
            asm volatile("" ::: "memory");
        }
    }
};

template <class Epi, class Sched, bool ALIGN_EPI = false, bool SP2 = false, bool F16 = false>
__device__ __forceinline__ void gemm_phase(PG8_LAS unsigned char* lds, const Gemm g, const Sched& S, const Epi& E, int wave_in, int lane_in) {
    int lane_o = lane_in, wave_o = wave_in; asm volatile("" : "+v"(lane_o)); asm volatile("" : "+s"(wave_o)); const int tid_ = wave_o * 64 + lane_o;
    const int tid = tid_, wid = wave_o, lane = lane_o, wr = wid >> 2, wc = wid & 3, fr = lane & 15, fq = lane >> 4;
    const int K = g.K, nt = K / BK;
    unsigned voffA[2], voffB[2];
#pragma unroll
    for (int i = 0; i < 2; ++i) { int R, C; stage_rc(tid * 16 + i * 8192, R, C); const int Rb = Epi::PERM ? ((R & ~31) + perm32(R & 31)) : R;
        voffA[i] = (unsigned)(R * K + C) * 2u; voffB[i] = (unsigned)(Rb * K + C) * 2u; }
    const size_t kstep = (size_t)(BK * 2);
    const size_t hstep = (size_t)HALF * K * 2;
    const size_t tstep = 2 * hstep;
    const unsigned ldsw = (unsigned)wid * 1024u;
    const int aoff = lds_byte(wr * 64 + fr, fq * 8), boff = lds_byte(wc * 32 + fr, fq * 8);
#define PG8_SA(b, h) (((b) * 2 + (h)) * HTB)
#define PG8_SB(b, h) ((4 + (b) * 2 + (h)) * HTB)
#define PG8_STAGE(bufoff, gbase, voff) do { _Pragma("unroll") for (int _i = 0; _i < 2; ++_i) \
        __builtin_amdgcn_global_load_lds((const unsigned*)((const char*)(gbase) + (voff)[_i]), (PG8_LAS unsigned*)(lds + (bufoff) + ldsw + _i * 8192), 16, 0, 0); } while (0)
#define PG8_LDA(dst, b, h) do { _Pragma("unroll") for (int m = 0; m < 4; ++m) _Pragma("unroll") for (int k = 0; k < 2; ++k) dst[m][k] = *(const PG8_LAS bf16x8*)(lds + PG8_SA(b, h) + aoff + m * 2048 + k * 1024); } while (0)
#define PG8_LDB(dst, b, h) do { _Pragma("unroll") for (int n = 0; n < 2; ++n) _Pragma("unroll") for (int k = 0; k < 2; ++k) dst[n][k] = *(const PG8_LAS bf16x8*)(lds + PG8_SB(b, h) + boff + n * 2048 + k * 1024); } while (0)
#define PG8_MMA(ai, bj, At, Bt) do { __builtin_amdgcn_s_setprio(1); _Pragma("unroll") for (int m = 0; m < 4; ++m) _Pragma("unroll") for (int n = 0; n < 2; ++n) _Pragma("unroll") for (int k = 0; k < 2; ++k) \
        { if constexpr (F16) acc[ai][bj][m][n] = __builtin_amdgcn_mfma_f32_16x16x32_f16(__builtin_bit_cast(f16x8, Bt[n][k]), __builtin_bit_cast(f16x8, At[m][k]), acc[ai][bj][m][n], 0, 0, 0); \
          else acc[ai][bj][m][n] = __builtin_amdgcn_mfma_f32_16x16x32_bf16(Bt[n][k], At[m][k], acc[ai][bj][m][n], 0, 0, 0); } __builtin_amdgcn_s_setprio(0); } while (0)
#define PG8_WAIT_V(n) asm volatile("s_waitcnt vmcnt(" #n ")" ::: "memory")
#define PG8_WAIT_L(n) asm volatile("s_waitcnt lgkmcnt(" #n ")" ::: "memory")
#define PG8_BAR __builtin_amdgcn_s_barrier()
#define PG8_SCHED __builtin_amdgcn_sched_barrier(0)
    Unit cur, nxt; int ui = 0;
    if (!S.next(0, cur)) return;
    f32x4 acc[2][2][4][2];
#pragma unroll
    for (int a = 0; a < 2; ++a)
#pragma unroll
        for (int b = 0; b < 2; ++b)
#pragma unroll
            for (int m = 0; m < 4; ++m)
#pragma unroll
                for (int n = 0; n < 2; ++n) acc[a][b][m][n] = (f32x4){0.f, 0.f, 0.f, 0.f};
    bf16x8 At[4][2], B0[2][2], B1[2][2];
    PG8_LAS float* const rsb = (PG8_LAS float*)(lds + STAGE_BYTES);
    f32x4 rq0, rq1;
#define PG8_RS_LOAD(pm_) do { const float* sp_ = E.ss + ((size_t)(pm_) * BM + (tid >> 1)) * 16 + 8 * (tid & 1); rq0 = *(const f32x4*)sp_; rq1 = *(const f32x4*)(sp_ + 4); } while (0)
#define PG8_RS_PUT(buf_) do { float sm_ = ((rq0[0] + rq0[1]) + (rq0[2] + rq0[3])) + ((rq1[0] + rq1[1]) + (rq1[2] + rq1[3])); sm_ += shx(sm_, 1, lane); \
        if ((tid & 1) == 0) rsb[(buf_) * BM + (tid >> 1)] = __builtin_amdgcn_rsqf(sm_ * (1.0f / 1024.0f) + 1e-6f); } while (0)
    if constexpr (Epi::RS_LDS) PG8_RS_LOAD(cur.pm);
    const char* cA = (const char*)g.A + (size_t)cur.pm * tstep; const char* cB = (const char*)g.Bt + (size_t)cur.pn * tstep;
    S.a_ready(cur);
    if constexpr (SP2) {
        PG8_STAGE(PG8_SB(0, 0), cB, voffB); PG8_STAGE(PG8_SB(0, 1), cB + hstep, voffB); PG8_STAGE(PG8_SA(0, 0), cA, voffA); PG8_STAGE(PG8_SA(0, 1), cA + hstep, voffA);
        if (wr == 1) PG8_BAR;
        PG8_WAIT_V(2); PG8_BAR;
        PG8_STAGE(PG8_SB(1, 0), cB + kstep, voffB); PG8_STAGE(PG8_SA(1, 0), cA + kstep, voffA); PG8_STAGE(PG8_SB(1, 1), cB + hstep + kstep, voffB);
        PG8_WAIT_V(6); PG8_BAR;
    } else {
        PG8_STAGE(PG8_SB(0, 0), cB, voffB); PG8_STAGE(PG8_SA(0, 0), cA, voffA); PG8_STAGE(PG8_SB(0, 1), cB + hstep, voffB); PG8_STAGE(PG8_SA(0, 1), cA + hstep, voffA);
        if (wr == 1) PG8_BAR;
        PG8_WAIT_V(4); PG8_BAR;
        PG8_STAGE(PG8_SB(1, 0), cB + kstep, voffB); PG8_STAGE(PG8_SA(1, 0), cA + kstep, voffA); PG8_STAGE(PG8_SB(1, 1), cB + hstep + kstep, voffB);
        PG8_WAIT_V(6); PG8_BAR;
    }
    if constexpr (Epi::RS_LDS) PG8_RS_PUT(0);
    for (;;) {
        const bool has_next = S.next(ui + 1, nxt);
        const char* nA = has_next ? (const char*)g.A + (size_t)nxt.pm * tstep : cA; const char* nB = has_next ? (const char*)g.Bt + (size_t)nxt.pn * tstep : cB;
        for (int t = 0; t < nt; t += 2) {
            const bool last = (t == nt - 2);
            const char* a1 = cA + (size_t)(t + 1) * kstep;
            const char* a2 = last ? nA : cA + (size_t)(t + 2) * kstep; const char* b2 = last ? nB : cB + (size_t)(t + 2) * kstep;
            const char* a3 = a2 + kstep; const char* b3 = b2 + kstep;
            if (last && has_next) S.a_ready(nxt);
            if constexpr (SP2) {
            PG8_LDB(B0, 0, 0); PG8_LDB(B1, 0, 1); PG8_SCHED; PG8_LDA(At, 0, 0); PG8_STAGE(PG8_SA(1, 1), a1 + hstep, voffA);
            PG8_WAIT_V(8); PG8_WAIT_L(0); PG8_BAR; PG8_MMA(0, 0, At, B0); PG8_MMA(0, 1, At, B1); PG8_BAR; PG8_SCHED;
            PG8_LDA(At, 0, 1); PG8_STAGE(PG8_SB(0, 0), b2, voffB); PG8_STAGE(PG8_SB(0, 1), b2 + hstep, voffB); PG8_STAGE(PG8_SA(0, 0), a2, voffA);
            PG8_WAIT_V(8); PG8_WAIT_L(0); PG8_BAR; PG8_MMA(1, 0, At, B0); PG8_MMA(1, 1, At, B1); PG8_BAR; PG8_SCHED;
            PG8_LDB(B0, 1, 0); PG8_LDB(B1, 1, 1); PG8_SCHED; PG8_LDA(At, 1, 0); PG8_STAGE(PG8_SA(0, 1), a2 + hstep, voffA);
            PG8_WAIT_V(8); PG8_WAIT_L(0); PG8_BAR; PG8_MMA(0, 0, At, B0); PG8_MMA(0, 1, At, B1); PG8_BAR; PG8_SCHED;
            PG8_LDA(At, 1, 1); PG8_STAGE(PG8_SB(1, 0), b3, voffB); PG8_STAGE(PG8_SB(1, 1), b3 + hstep, voffB); PG8_STAGE(PG8_SA(1, 0), a3, voffA);
            PG8_WAIT_V(8); PG8_WAIT_L(0); PG8_BAR; PG8_MMA(1, 0, At, B0); PG8_MMA(1, 1, At, B1); PG8_BAR; PG8_SCHED;
            } else {
            PG8_LDB(B0, 0, 0); PG8_SCHED; PG8_LDA(At, 0, 0); PG8_STAGE(PG8_SA(1, 1), a1 + hstep, voffA);
            PG8_WAIT_L(8); PG8_BAR; PG8_WAIT_L(0); PG8_MMA(0, 0, At, B0); PG8_BAR; PG8_SCHED;
            PG8_LDB(B1, 0, 1); PG8_STAGE(PG8_SB(0, 0), b2, voffB);
            PG8_BAR; PG8_WAIT_L(0); PG8_MMA(0, 1, At, B1); PG8_BAR;
            PG8_LDA(At, 0, 1); PG8_STAGE(PG8_SA(0, 0), a2, voffA);
            PG8_BAR; PG8_WAIT_L(0); PG8_MMA(1, 0, At, B0); PG8_BAR; PG8_SCHED;
            PG8_STAGE(PG8_SB(0, 1), b2 + hstep, voffB);
            PG8_WAIT_V(6); PG8_BAR; PG8_MMA(1, 1, At, B1); PG8_BAR;
            PG8_LDB(B0, 1, 0); PG8_SCHED; PG8_LDA(At, 1, 0); PG8_STAGE(PG8_SA(0, 1), a2 + hstep, voffA);
            PG8_WAIT_L(8); PG8_BAR; PG8_WAIT_L(0); PG8_MMA(0, 0, At, B0); PG8_BAR; PG8_SCHED;
            PG8_LDB(B1, 1, 1); PG8_STAGE(PG8_SB(1, 0), b3, voffB);
            PG8_BAR; PG8_WAIT_L(0); PG8_MMA(0, 1, At, B1); PG8_BAR;
            PG8_LDA(At, 1, 1); PG8_STAGE(PG8_SA(1, 0), a3, voffA);
            PG8_BAR; PG8_WAIT_L(0); PG8_MMA(1, 0, At, B0); PG8_BAR; PG8_SCHED;
            PG8_STAGE(PG8_SB(1, 1), b3 + hstep, voffB);
            PG8_WAIT_V(6); PG8_BAR; PG8_MMA(1, 1, At, B1); PG8_BAR;
            }
        }
        if constexpr (ALIGN_EPI) { if (wr == 0) PG8_BAR; }
        if constexpr (Epi::RS_LDS) { if (has_next) PG8_RS_LOAD(nxt.pm); E(acc, cur, wr, wc, fr, fq, rsb + (ui & 1) * BM); if (has_next) PG8_RS_PUT((ui + 1) & 1); S.done(cur); }
        else if constexpr (!Epi::AFTER_DRAIN) { E(acc, cur, wr, wc, fr, fq); S.done(cur); }
        if (!has_next) break;
#pragma unroll
        for (int a = 0; a < 2; ++a)
#pragma unroll
            for (int b = 0; b < 2; ++b)
#pragma unroll
                for (int m = 0; m < 4; ++m)
#pragma unroll
                    for (int n = 0; n < 2; ++n) acc[a][b][m][n] = (f32x4){0.f, 0.f, 0.f, 0.f};
        cur = nxt; cA = nA; cB = nB; ++ui;
        if constexpr (ALIGN_EPI) { if (wr == 1) PG8_BAR; }
    }
    PG8_WAIT_V(0);
    if constexpr (!ALIGN_EPI) { if (wr == 0) PG8_BAR; }
    PG8_BAR;
    if constexpr (Epi::AFTER_DRAIN) { E.fused(acc, cur, wr, wc, fr, fq, lds, wid, lane); S.done(cur); }
#undef PG8_RS_LOAD
#undef PG8_RS_PUT
#undef PG8_SA
#undef PG8_SB
#undef PG8_STAGE
#undef PG8_LDA
#undef PG8_LDB
#undef PG8_MMA
#undef PG8_WAIT_V
#undef PG8_WAIT_L
#undef PG8_BAR
#undef PG8_SCHED
}
}
constexpr int NWAVES = 8, NTHR = 512;
constexpr int BATCH = 4, SEQ = 4096, D = 1024, DEPTH = 4, H = 8, HD = 64, FF = 4096, NPROJ = 3328, RPROJ = 1792;
constexpr int M = BATCH * SEQ;
constexpr float GN_EPS = 64e-5f;
enum { I_X = 0, I_LN1, I_WIN, I_QG, I_KG, I_TSP, I_TSN, I_W0, I_W2, I_A0, I_A2, I_G2, I_KK, I_KA, I_RK, I_GNW, I_GNB, I_WOUT, I_LN2, I_WUP, I_WDN, N_IN };
constexpr size_t MiB = 1u << 20;
constexpr size_t WS_CTL = 0, CTL_ZERO_BYTES = 64 * 1024;
constexpr size_t WS_SS1 = 1 * MiB, WS_SS2 = 2 * MiB;
constexpr size_t WS_WIN = 3 * MiB, WS_WOUT = WS_WIN + (size_t)NPROJ * D * 2, WS_WUP = WS_WOUT + (size_t)D * D * 2, WS_WDN = WS_WUP + (size_t)FF * D * 2;
constexpr size_t WS_R0 = 28 * MiB;
constexpr size_t R_MIX = WS_R0 + 0 * MiB;
constexpr size_t R_V = WS_R0 + 32 * MiB;
constexpr size_t R_RR = WS_R0 + 48 * MiB, R_KR = WS_R0 + 64 * MiB, R_VR = WS_R0 + 80 * MiB, R_XL = WS_R0 + 96 * MiB;
constexpr size_t R_SD = R_RR;
constexpr size_t R_PRE = WS_R0 + 160 * MiB;
constexpr size_t R_HID = WS_R0;
constexpr size_t R_XB = WS_R0 + 128 * MiB;
constexpr size_t R_BN = WS_R0 + 232 * MiB;
constexpr size_t WS_END = WS_R0 + 233 * MiB;
constexpr size_t WS_LORA = WS_WDN + (size_t)D * FF * 2;
constexpr size_t WS_G2T = WS_LORA + 4 * 512 * 64 * 2;
static_assert(WS_G2T + 512 * 128 * 2 <= WS_R0, "lora");
constexpr int CW_BAR = 1024;
constexpr int RING_OFF = 0, RING_BYTES = 131072;
constexpr int LDSCTL_OFF = 155648, MISC_OFF = LDSCTL_OFF + 320;
constexpr int LDS_BYTES = 163840;
#define GAS __attribute__((address_space(1)))
#define LAS __attribute__((address_space(3)))
typedef unsigned short bf16;
typedef unsigned v4u __attribute__((ext_vector_type(4)));
typedef float f32x4 __attribute__((ext_vector_type(4)));
typedef short bf16x8 __attribute__((ext_vector_type(8)));
typedef GAS unsigned gu32;
typedef GAS unsigned long long gu64;
#define RLX_AGENT __ATOMIC_RELAXED, __HIP_MEMORY_SCOPE_AGENT
#define LDS_WAIT() asm volatile("s_waitcnt lgkmcnt(0)" ::: "memory")
#define VM_WAIT() asm volatile("s_waitcnt vmcnt(0)" ::: "memory")
__device__ __forceinline__ unsigned long long rt() { return __builtin_amdgcn_s_memrealtime(); }
__device__ __forceinline__ unsigned f2bf(float f) { unsigned u = __builtin_bit_cast(unsigned, f); return (u + 0x7fffu + ((u >> 16) & 1u)) >> 16; }
__device__ __forceinline__ unsigned pk2(float lo, float hi) { return f2bf(lo) | (f2bf(hi) << 16); }

#define XB_TMO      128
#define XB_XCNT(j)  (256  + 64 * (j))
#define XB_XSUB(j)  (1280 + 64 * (j))
#define XB_XGEN(j)  (2304 + 64 * (j))
#define XB_TOP      3328
#define XB_TOPGEN   3392
#define XCD_BAR_WORDS 3456
#define XB_PSUB(j)  (3520 + 64 * (j))
#define XB_PTOP     4608
#define XB_SPIN_CAP (1u << 18)

__device__ __forceinline__ unsigned xb_ld(unsigned* p)              { return __hip_atomic_load(p, __ATOMIC_RELAXED, __HIP_MEMORY_SCOPE_AGENT); }
__device__ __forceinline__ unsigned xb_add(unsigned* p, unsigned v) { return __hip_atomic_fetch_add(p, v, __ATOMIC_RELAXED, __HIP_MEMORY_SCOPE_AGENT); }
__device__ __forceinline__ unsigned xb_xcc_id() { return (unsigned)__builtin_amdgcn_s_getreg((3 << 11) | 20) & 0xFu; }
#define XB_SPIN(cond, bar) do { unsigned _sp = 0; while (cond) { __builtin_amdgcn_s_sleep(1); \
    if ((++_sp & 255u) == 0u) { if (xb_ld(&(bar)[XB_TMO])) break; if (_sp > XB_SPIN_CAP) { atomicAdd(&(bar)[XB_TMO], 1u); break; } } } } while (0)

struct XcdBarrier {
    unsigned* bar; unsigned x;
    volatile LAS unsigned* st;
};

__device__ __forceinline__ XcdBarrier xcd_barrier_post(unsigned* bar, volatile LAS unsigned* st, bool tid0) {
    XcdBarrier b; b.bar = bar; b.x = xb_xcc_id(); b.st = st;
    if (tid0) (void)xb_add(&bar[XB_XCNT(b.x)], 1u);
    return b;
}
__device__ __forceinline__ void xcd_barrier_complete(unsigned* bar, unsigned x, unsigned& nloc, unsigned& nx) {
    const unsigned G = gridDim.x * gridDim.y * gridDim.z;
    unsigned sum, cnt, mine, sp = 0u;
    for (;;) {
        sum = 0u; cnt = 0u; mine = 0u;
#pragma unroll
        for (unsigned j = 0; j < 16; ++j) { const unsigned c = xb_ld(&bar[XB_XCNT(j)]); sum += c; cnt += (c > 0u) ? 1u : 0u; mine = (j == x) ? c : mine; }
        if (sum == G) break;
        __builtin_amdgcn_s_sleep(1);
        if ((++sp & 255u) == 0u) { if (xb_ld(&bar[XB_TMO])) break; if (sp > XB_SPIN_CAP) { atomicAdd(&bar[XB_TMO], 1u); break; } }
    }
    nloc = mine > 0u ? mine : 1u; nx = cnt > 0u ? cnt : 1u;
}

__device__ __forceinline__ void xcd_barrier(const XcdBarrier& b, bool tid0) {
    asm volatile("s_waitcnt vmcnt(0)" ::: "memory");
    __syncthreads();
    if (tid0) {
        unsigned* bar = b.bar; asm volatile("" : "+v"(bar));
        __builtin_amdgcn_s_waitcnt(0);
        unsigned nloc = b.st[0], nx = b.st[1];
        if (nloc == 0u) { xcd_barrier_complete(bar, b.x, nloc, nx); b.st[0] = nloc; b.st[1] = nx; }
        const unsigned old = xb_add(&bar[XB_XSUB(b.x)], 1u);
        const unsigned gen = old / nloc;
        if (old + 1u == (gen + 1u) * nloc) {
            __builtin_amdgcn_fence(__ATOMIC_RELEASE, "agent");
            asm volatile("s_waitcnt vmcnt(0)" ::: "memory");
            const unsigned og = xb_add(&bar[XB_TOP], 1u);
            const unsigned tg = og / nx;
            if (og + 1u == (tg + 1u) * nx) xb_add(&bar[XB_TOPGEN], 1u);
            else XB_SPIN(xb_ld(&bar[XB_TOPGEN]) == tg, bar);
            __builtin_amdgcn_fence(__ATOMIC_ACQUIRE, "agent");
            xb_add(&bar[XB_XGEN(b.x)], 1u);
            asm volatile("s_waitcnt vmcnt(0)" ::: "memory");
        } else {
            XB_SPIN(xb_ld(&bar[XB_XGEN(b.x)]) == gen, bar);
            __builtin_amdgcn_fence(__ATOMIC_ACQUIRE, "agent");
            asm volatile("s_waitcnt vmcnt(0)" ::: "memory");
        }
    }
    __syncthreads();
}
__device__ __forceinline__ void pre_done_signal(const XcdBarrier& b, bool tid0) {
    asm volatile("s_waitcnt vmcnt(0)" ::: "memory");
    __syncthreads();
    if (tid0) {
        unsigned* bar = b.bar; asm volatile("" : "+v"(bar));
        __builtin_amdgcn_s_waitcnt(0);
        const unsigned nloc = b.st[0];
        const unsigned old = xb_add(&bar[XB_PSUB(b.x)], 1u);
        if ((old + 1u) % nloc == 0u) {
            __builtin_amdgcn_fence(__ATOMIC_RELEASE, "agent");
            asm volatile("s_waitcnt vmcnt(0)" ::: "memory");
            xb_add(&bar[XB_PTOP], 1u);
        }
    }
}
__device__ __forceinline__ void pre_done_wait(const XcdBarrier& b, bool tid0, unsigned layer1) {
    if (tid0) {
        unsigned* bar = b.bar; asm volatile("" : "+v"(bar));
        const unsigned want = b.st[1] * layer1;
        XB_SPIN(xb_ld(&bar[XB_PTOP]) < want, bar);
        __builtin_amdgcn_fence(__ATOMIC_ACQUIRE, "agent");
        asm volatile("s_waitcnt vmcnt(0)" ::: "memory");
    }
    __syncthreads();
}
__device__ __forceinline__ float bf2f(bf16 v) { return __uint_as_float(((unsigned)v) << 16); }
__device__ __forceinline__ bf16 f2bf_s(float f) { return (bf16)f2bf(f); }
__device__ __forceinline__ float wave_sum(float v, int lane) {
#pragma unroll
    for (int o = 1; o < 64; o <<= 1) v += pg8::shx(v, o, lane);
    return v;
}
__device__ __forceinline__ float sigmoidf_(float z) { return __builtin_amdgcn_rcpf(1.0f + __expf(-z)); }
__device__ __forceinline__ float tanh_fast(float x) { return 1.0f - 2.0f * __builtin_amdgcn_rcpf(__expf(2.0f * x) + 1.0f); }

struct Args { const float* in[N_IN]; float* out; unsigned char* ws; };
typedef const __attribute__((address_space(4))) Args CArgs;
__device__ __forceinline__ const CArgs* kargs() { const CArgs* p = (const CArgs*)__builtin_amdgcn_kernarg_segment_ptr(); asm volatile("" : "+s"(p)); return p; }
__device__ __forceinline__ unsigned char* kws() { return kargs()->ws; }
__device__ __forceinline__ float* kout() { return kargs()->out; }
__device__ __forceinline__ const float* karg(int i) { return kargs()->in[i]; }
__device__ __forceinline__ int lane_id() { int l; asm volatile("v_mbcnt_lo_u32_b32 %0, -1, 0\n\tv_mbcnt_hi_u32_b32 %0, -1, %0" : "=v"(l)); return l; }
__device__ __forceinline__ bf16* pre_item(unsigned char* ws, int item) { return (item < 2048) ? (bf16*)(ws + R_PRE) + (size_t)item * 16384 : (bf16*)kout() + (size_t)(item - 2048) * 16384; }
struct Frame {
    LAS unsigned char* lds;
    volatile LAS unsigned* MISC;
    gu32* ctl;
    int vcu, G, wv;
};

__device__ __forceinline__ float ushift(const bf16* buf, int ldc, int col, int row, int t, float sp, float sn) {
    const bf16* p = buf + (size_t)row * ldc + col;
    const float u0 = bf2f(p[0]);
    const float up = (t > 0) ? bf2f(p[-ldc]) : 0.f;
    const float un = (t < SEQ - 1) ? bf2f(p[ldc]) : 0.f;
    return u0 + sp * (up - u0) + sn * (un - u0);
}

__device__ __forceinline__ unsigned pkw(bool f16, float lo, float hi) { return f16 ? pg8::pkh(lo, hi) : pk2(lo, hi); }
__device__ __forceinline__ void transpose_item(const float* W, int K, int N, bf16* WT, const float* gain, bool headperm, LAS float* scr, int item, int lane, bool f16 = false, int fragbase = -1) {
    const int nblk = N / 32, kb = item / nblk, nb = item % nblk, k0 = 64 * kb, n0 = 32 * nb;
    { const int r = lane >> 3, c4 = lane & 7;
      f32x4 v[8];
#pragma unroll
      for (int i = 0; i < 8; ++i) v[i] = *(const f32x4*)(W + (size_t)(k0 + 8 * i + r) * N + n0 + 4 * c4);
#pragma unroll
      for (int i = 0; i < 8; ++i) { f32x4 w = v[i]; if (gain) w = w * gain[k0 + 8 * i + r]; *(LAS f32x4*)(scr + (8 * i + r) * 36 + 4 * c4) = w; } }
    LDS_WAIT(); asm volatile("" ::: "memory");
    const int c = lane & 7;
    const int p0 = headperm ? ((n0 & ~255) + 128 * ((n0 >> 5) & 1) + 32 * ((n0 >> 6) & 3)) : n0;
#pragma unroll
    for (int j = 0; j < 4; ++j) { const int n = (lane >> 3) + 8 * j; const LAS float* s = scr + (8 * c) * 36 + n;
        v4u o; o.x = pkw(f16, s[0 * 36], s[1 * 36]); o.y = pkw(f16, s[2 * 36], s[3 * 36]); o.z = pkw(f16, s[4 * 36], s[5 * 36]); o.w = pkw(f16, s[6 * 36], s[7 * 36]);
        if (fragbase >= 0 && p0 >= fragbase) *(GAS v4u*)(WT + (size_t)fragbase * K + ((size_t)(((p0 - fragbase) >> 5) * (K >> 4) + (k0 >> 4) + (c >> 1)) * 64 + 32 * (c & 1) + n) * 8) = o;
        else *(GAS v4u*)(WT + (size_t)(p0 + n) * K + k0 + 8 * c) = o; }
    LDS_WAIT(); asm volatile("" ::: "memory");
}
struct WcDesc { const float* W; bf16* WT; const float* gain; int K, N, item, fragbase; bool headperm, f16; };
__device__ __forceinline__ WcDesc wc_decode(int it, int nA, int layerA, int layerB) {
    unsigned char* const ws = kws();
    constexpr int I_1 = (D / 64) * (NPROJ / 32), I_2 = (D / 64) * (D / 32), I_3 = (D / 64) * (FF / 32), I_4 = (FF / 64) * (D / 32);
    WcDesc d; d.gain = nullptr; d.headperm = false; d.f16 = false; d.fragbase = -1;
    int r = it;
    if (r < nA) { const int layer = layerA;
        if (r < I_1) { d.W = karg(I_WIN) + (size_t)layer * D * NPROJ; d.K = D; d.N = NPROJ; d.WT = (bf16*)(ws + WS_WIN); d.gain = karg(I_LN1) + layer * D; d.headperm = true; d.item = r; d.f16 = true; d.fragbase = 3072; return d; }
        r -= I_1; const int mat = r >> 4;
        d.W = (mat < 2 ? karg(I_W2) : karg(I_A2)) + (size_t)(layer * 2 + (mat & 1)) * 64 * 512; d.K = 64; d.N = 512; d.WT = (bf16*)(ws + WS_LORA) + (size_t)mat * 512 * 64; d.item = r & 15; d.fragbase = 0; return d; }
    r -= nA; const int layer = layerB;
    if (r < I_2) { d.W = karg(I_WOUT) + (size_t)layer * D * D; d.K = D; d.N = D; d.WT = (bf16*)(ws + WS_WOUT); d.item = r; return d; } r -= I_2;
    if (r < I_3) { d.W = karg(I_WUP) + (size_t)layer * D * FF; d.K = D; d.N = FF; d.WT = (bf16*)(ws + WS_WUP); d.gain = karg(I_LN2) + layer * D; d.item = r; d.f16 = true; return d; } r -= I_3;
    if (r < I_4) { d.W = karg(I_WDN) + (size_t)layer * FF * D; d.K = FF; d.N = D; d.WT = (bf16*)(ws + WS_WDN); d.item = r; return d; } r -= I_4;
    d.W = karg(I_G2) + (size_t)layer * 128 * 512; d.K = 128; d.N = 512; d.WT = (bf16*)(ws + WS_G2T); d.item = r; d.fragbase = 0; return d;
}
__device__ __forceinline__ void wc_load(const WcDesc& d, int lane, f32x4 (&v)[8], float (&g)[8]) {
    const int nblk = d.N / 32, kb = d.item / nblk, nb = d.item % nblk, k0 = 64 * kb, n0 = 32 * nb, r = lane >> 3, c4 = lane & 7;
#pragma unroll
    for (int i = 0; i < 8; ++i) v[i] = __builtin_nontemporal_load((const f32x4*)(d.W + (size_t)(k0 + 8 * i + r) * d.N + n0 + 4 * c4));
#pragma unroll
    for (int i = 0; i < 8; ++i) g[i] = d.gain ? d.gain[k0 + 8 * i + r] : 1.0f;
}
__device__ __forceinline__ void wc_finish(const WcDesc& d, LAS float* scr, int lane, const f32x4 (&v)[8], const float (&g)[8]) {
    const int K = d.K, nblk = d.N / 32, kb = d.item / nblk, nb = d.item % nblk, k0 = 64 * kb, n0 = 32 * nb;
    { const int r = lane >> 3, c4 = lane & 7;
#pragma unroll
      for (int i = 0; i < 8; ++i) *(LAS f32x4*)(scr + (8 * i + r) * 36 + 4 * c4) = v[i] * g[i]; }
    LDS_WAIT(); asm volatile("" ::: "memory");
    const int c = lane & 7; const bool f16 = d.f16; const int fragbase = d.fragbase; bf16* const WT = d.WT;
    const int p0 = d.headperm ? ((n0 & ~255) + 128 * ((n0 >> 5) & 1) + 32 * ((n0 >> 6) & 3)) : n0;
#pragma unroll
    for (int j = 0; j < 4; ++j) { const int n = (lane >> 3) + 8 * j; const LAS float* s = scr + (8 * c) * 36 + n;
        v4u o; o.x = pkw(f16, s[0 * 36], s[1 * 36]); o.y = pkw(f16, s[2 * 36], s[3 * 36]); o.z = pkw(f16, s[4 * 36], s[5 * 36]); o.w = pkw(f16, s[6 * 36], s[7 * 36]);
        if (fragbase >= 0 && p0 >= fragbase) *(GAS v4u*)(WT + (size_t)fragbase * K + ((size_t)(((p0 - fragbase) >> 5) * (K >> 4) + (k0 >> 4) + (c >> 1)) * 64 + 32 * (c & 1) + n) * 8) = o;
        else *(GAS v4u*)(WT + (size_t)(p0 + n) * K + k0 + 8 * c) = o; }
    LDS_WAIT(); asm volatile("" ::: "memory");
}
__device__ __forceinline__ void wconv_items(int layerA, int layerB, int wi, int nw, LAS float* scr, int lane_) {
    constexpr int I_1 = (D / 64) * (NPROJ / 32), I_2 = (D / 64) * (D / 32), I_3 = (D / 64) * (FF / 32), I_4 = (FF / 64) * (D / 32);
    constexpr int NA = I_1 + 64, NB = I_2 + I_3 + I_4 + 32;
    const int nA = (layerA >= 0 && layerA < DEPTH) ? NA : 0, nB = (layerB >= 0) ? NB : 0, total = nA + nB;
    if (wi >= total) return;
    WcDesc d0 = wc_decode(wi, nA, layerA, layerB); f32x4 v[8]; float g[8];
    wc_load(d0, lane_, v, g);
#pragma unroll 1
    for (int it = wi; it < total; it += nw) {
        const bool has = it + nw < total; WcDesc d1 = d0; f32x4 vn[8]; float gn[8];
        if (has) { d1 = wc_decode(it + nw, nA, layerA, layerB); wc_load(d1, lane_, vn, gn); }
        wc_finish(d0, scr, lane_, v, g);
        if (has) { d0 = d1;
#pragma unroll
            for (int i = 0; i < 8; ++i) { v[i] = vn[i]; g[i] = gn[i]; } }
    }
}
__device__ __forceinline__ void x_prologue(Frame& F) {
    unsigned char* const ws = kws();
    int lane_ = lane_id(); asm volatile("" : "+v"(lane_)); int wave_o = F.wv; asm volatile("" : "+s"(wave_o)); const int wave_ = wave_o, tid_ = wave_ * 64 + lane_;
    const int gw = F.vcu * NWAVES + wave_, NGW = F.G * NWAVES;
    const float* x = karg(I_X); bf16* xb = (bf16*)(ws + R_XB); float* ss = (float*)(ws + WS_SS1);
    for (int m0 = gw; m0 < M; m0 += 4 * NGW) {
        f32x4 v[4][4];
#pragma unroll
        for (int r = 0; r < 4; ++r) { const int m = m0 + r * NGW; if (m < M) { const GAS f32x4* xr = (const GAS f32x4*)(x + (size_t)m * D) + lane_;
#pragma unroll
            for (int j = 0; j < 4; ++j) v[r][j] = __builtin_nontemporal_load((const f32x4*)&xr[64 * j]); } }
#pragma unroll
        for (int r = 0; r < 4; ++r) { const int m = m0 + r * NGW; if (m < M) { GAS unsigned long long* o8 = (GAS unsigned long long*)(xb + (size_t)m * D) + lane_; float s = 0.f;
#pragma unroll
            for (int j = 0; j < 4; ++j) { const f32x4 w = v[r][j]; s += (w.x * w.x + w.y * w.y) + (w.z * w.z + w.w * w.w);
                o8[64 * j] = (unsigned long long)pg8::pkh(w.x, w.y) | ((unsigned long long)pg8::pkh(w.z, w.w) << 32); }
            s = wave_sum(s, lane_);
            if (lane_ < 16) ss[(size_t)m * 16 + lane_] = (lane_ == 0) ? s : 0.f; } }
    }
}

typedef float f32x16 __attribute__((ext_vector_type(16)));
typedef short s16x4 __attribute__((ext_vector_type(4)));
typedef short v4i16_t __attribute__((ext_vector_type(4)));
typedef unsigned u32x2_t __attribute__((ext_vector_type(2)));
typedef float f32x2_t __attribute__((ext_vector_type(2))); typedef __bf16 bf16x2_t __attribute__((ext_vector_type(2)));
__device__ __forceinline__ unsigned cvtpk(float lo, float hi) { f32x2_t v = {lo, hi}; bf16x2_t b = __builtin_convertvector(v, bf16x2_t); return __builtin_bit_cast(unsigned, b); }
typedef _Float16 h16x2_t __attribute__((ext_vector_type(2))); typedef _Float16 h16x8 __attribute__((ext_vector_type(8)));
__device__ __forceinline__ unsigned cvtpk_h(float lo, float hi) { f32x2_t v = {lo, hi}; h16x2_t b = __builtin_convertvector(v, h16x2_t); return __builtin_bit_cast(unsigned, b); }
__device__ __forceinline__ f32x2_t unpk_h(unsigned w) { return __builtin_convertvector(__builtin_bit_cast(h16x2_t, w), f32x2_t); }
#define MFMA32H(nf, mf, acc) __builtin_amdgcn_mfma_f32_32x32x16_f16(__builtin_bit_cast(h16x8, (nf)), __builtin_bit_cast(h16x8, (mf)), (acc), 0, 0, 0)
constexpr int TSB = 144, TILE_B = 64 * TSB;
constexpr int PRE_TW = 14 * TILE_B, PRE_XA = 15 * TILE_B, PRE_INVN = 16 * TILE_B, PRE_GC = PRE_INVN + 256, PRE_BON = PRE_GC + 512, PRE_LDS_END = PRE_BON + 1024;
static_assert(PRE_LDS_END <= LDSCTL_OFF, "PRE LDS map");
__device__ __forceinline__ bf16x8 frag_row(const LAS unsigned char* tile, int row, int ks, int hi) {
    return *(const LAS bf16x8*)(tile + row * TSB + (16 * ks + 8 * hi) * 2);
}
__device__ __forceinline__ s16x4 tr4(const LAS unsigned char* p) { return __builtin_bit_cast(s16x4, __builtin_amdgcn_ds_read_tr16_b64_v4i16((LAS v4i16_t*)p)); }
__device__ __forceinline__ bf16x8 frag_tr(const LAS unsigned char* tile, int idx0, int ks, int lane) {
    const int hi = lane >> 5, g1 = (lane >> 4) & 1, i = lane & 15;
    const LAS unsigned char* p = tile + (16 * ks + 8 * hi + (i >> 2)) * TSB + (idx0 + 16 * g1 + 4 * (i & 3)) * 2;
    const s16x4 lo = tr4(p), h4 = tr4(p + 4 * TSB);
    return (bf16x8){lo[0], lo[1], lo[2], lo[3], h4[0], h4[1], h4[2], h4[3]};
}
__device__ __forceinline__ void store_quad(LAS unsigned char* tile, int row, int n0, int hi, const f32x16& a) {
#pragma unroll
    for (int q = 0; q < 4; ++q) { u32x2_t w; w.x = cvtpk(a[4 * q], a[4 * q + 1]); w.y = cvtpk(a[4 * q + 2], a[4 * q + 3]); *(LAS u32x2_t*)(tile + row * TSB + (n0 + 8 * q + 4 * hi) * 2) = w; }
}
__device__ __forceinline__ void store_quad_h(LAS unsigned char* tile, int row, int n0, int hi, const f32x16& a) {
#pragma unroll
    for (int q = 0; q < 4; ++q) { u32x2_t w; w.x = cvtpk_h(a[4 * q], a[4 * q + 1]); w.y = cvtpk_h(a[4 * q + 2], a[4 * q + 3]); *(LAS u32x2_t*)(tile + row * TSB + (n0 + 8 * q + 4 * hi) * 2) = w; }
}
__device__ __forceinline__ f32x16 load_quad(const LAS unsigned char* tile, int row, int n0, int hi) {
    f32x16 a;
#pragma unroll
    for (int q = 0; q < 4; ++q) { const u32x2_t w = *(const LAS u32x2_t*)(tile + row * TSB + (n0 + 8 * q + 4 * hi) * 2);
        a[4 * q] = __uint_as_float(w.x << 16); a[4 * q + 1] = __uint_as_float(w.x & 0xffff0000u); a[4 * q + 2] = __uint_as_float(w.y << 16); a[4 * q + 3] = __uint_as_float(w.y & 0xffff0000u); }
    return a;
}
#define MFMA32(nf, mf, acc) __builtin_amdgcn_mfma_f32_32x32x16_bf16((nf), (mf), (acc), 0, 0, 0)
#define LD4_ROW(dst, tile, row) _Pragma("unroll") for (int ks_ = 0; ks_ < 4; ++ks_) dst[ks_] = frag_row(tile, row, ks_, hi)
#define LD4_TR(dst, tile, idx0) _Pragma("unroll") for (int ks_ = 0; ks_ < 4; ++ks_) dst[ks_] = frag_tr(tile, idx0, ks_, lane)
#define SBAR0() __builtin_amdgcn_sched_barrier(0)
#define WG_BARL() do { asm volatile("s_waitcnt lgkmcnt(0)" ::: "memory"); __builtin_amdgcn_s_barrier(); asm volatile("" ::: "memory"); } while (0)
#define WG_BAR() do { asm volatile("s_waitcnt vmcnt(0) lgkmcnt(0)" ::: "memory"); __builtin_amdgcn_s_barrier(); asm volatile("" ::: "memory"); } while (0)
__device__ __forceinline__ void shift8(const bf16* buf, int ldc, int col, int row, int t, const float* sp, const float* sn, float (&out)[8]) {
    const bf16* p = buf + (size_t)row * ldc + col;
    const v4u c = *(const v4u*)p; v4u pv = (v4u){0u, 0u, 0u, 0u}, nv = (v4u){0u, 0u, 0u, 0u};
    if (t > 0) pv = *(const v4u*)(p - ldc);
    if (t < SEQ - 1) nv = *(const v4u*)(p + ldc);
    const f32x4 sp0 = *(const f32x4*)sp, sp1 = *(const f32x4*)(sp + 4), sn0 = *(const f32x4*)sn, sn1 = *(const f32x4*)(sn + 4);
#pragma unroll
    for (int j = 0; j < 8; ++j) { const unsigned cw = c[j >> 1], pw = pv[j >> 1], nw = nv[j >> 1];
        const float u0 = (j & 1) ? __uint_as_float(cw & 0xffff0000u) : __uint_as_float(cw << 16), up = (j & 1) ? __uint_as_float(pw & 0xffff0000u) : __uint_as_float(pw << 16), un = (j & 1) ? __uint_as_float(nw & 0xffff0000u) : __uint_as_float(nw << 16);
        const float a = (j < 4) ? sp0[j & 3] : sp1[j & 3], bq = (j < 4) ? sn0[j & 3] : sn1[j & 3];
        out[j] = u0 + a * (up - u0) + bq * (un - u0); }
}
__device__ __forceinline__ f32x4 shift4(const bf16* buf, int ldc, int col, int row, int t, const float* sp, const float* sn) {
    const bf16* p = buf + (size_t)row * ldc + col;
    const u32x2_t c = *(const u32x2_t*)p; u32x2_t pv = (u32x2_t){0u, 0u}, nv = (u32x2_t){0u, 0u};
    if (t > 0) pv = *(const u32x2_t*)(p - ldc);
    if (t < SEQ - 1) nv = *(const u32x2_t*)(p + ldc);
    const f32x4 a = *(const f32x4*)sp, bq = *(const f32x4*)sn;
    const f32x4 u0 = (f32x4){__uint_as_float(c.x << 16), __uint_as_float(c.x & 0xffff0000u), __uint_as_float(c.y << 16), __uint_as_float(c.y & 0xffff0000u)};
    const f32x4 up = (f32x4){__uint_as_float(pv.x << 16), __uint_as_float(pv.x & 0xffff0000u), __uint_as_float(pv.y << 16), __uint_as_float(pv.y & 0xffff0000u)};
    const f32x4 un = (f32x4){__uint_as_float(nv.x << 16), __uint_as_float(nv.x & 0xffff0000u), __uint_as_float(nv.y << 16), __uint_as_float(nv.y & 0xffff0000u)};
    return u0 + a * (up - u0) + bq * (un - u0);
}

struct R16 { v4u c, p, n; };
struct R8 { u32x2_t c, p, n; };
__device__ __forceinline__ R16 ld3x16(const bf16* buf, int ldc, int col, int row, int t) {
    const bf16* q = buf + (size_t)row * ldc + col; R16 r; r.c = *(const v4u*)q; r.p = (v4u){0u, 0u, 0u, 0u}; r.n = (v4u){0u, 0u, 0u, 0u};
    if (t > 0) r.p = *(const v4u*)(q - ldc);
    if (t < SEQ - 1) r.n = *(const v4u*)(q + ldc);
    return r;
}
__device__ __forceinline__ R8 ld3x8(const bf16* buf, int ldc, int col, int row, int t) {
    const bf16* q = buf + (size_t)row * ldc + col; R8 r; r.c = *(const u32x2_t*)q; r.p = (u32x2_t){0u, 0u}; r.n = (u32x2_t){0u, 0u};
    if (t > 0) r.p = *(const u32x2_t*)(q - ldc);
    if (t < SEQ - 1) r.n = *(const u32x2_t*)(q + ldc);
    return r;
}
__device__ __forceinline__ void sh8(const R16& r, const LAS float* sp, const LAS float* sn, float (&out)[8]) {
    const f32x4 sp0 = *(const LAS f32x4*)sp, sp1 = *(const LAS f32x4*)(sp + 4), sn0 = *(const LAS f32x4*)sn, sn1 = *(const LAS f32x4*)(sn + 4);
#pragma unroll
    for (int j = 0; j < 8; ++j) { const unsigned cw = r.c[j >> 1], pw = r.p[j >> 1], nw = r.n[j >> 1];
        const float u0 = (j & 1) ? __uint_as_float(cw & 0xffff0000u) : __uint_as_float(cw << 16), up = (j & 1) ? __uint_as_float(pw & 0xffff0000u) : __uint_as_float(pw << 16), un = (j & 1) ? __uint_as_float(nw & 0xffff0000u) : __uint_as_float(nw << 16);
        const float a = (j < 4) ? sp0[j & 3] : sp1[j & 3], bq = (j < 4) ? sn0[j & 3] : sn1[j & 3];
        out[j] = u0 + a * (up - u0) + bq * (un - u0); }
}
__device__ __forceinline__ f32x4 sh4(const R8& r, const f32x4 a, const f32x4 bq) {
    const f32x4 u0 = (f32x4){__uint_as_float(r.c.x << 16), __uint_as_float(r.c.x & 0xffff0000u), __uint_as_float(r.c.y << 16), __uint_as_float(r.c.y & 0xffff0000u)};
    const f32x4 up = (f32x4){__uint_as_float(r.p.x << 16), __uint_as_float(r.p.x & 0xffff0000u), __uint_as_float(r.p.y << 16), __uint_as_float(r.p.y & 0xffff0000u)};
    const f32x4 un = (f32x4){__uint_as_float(r.n.x << 16), __uint_as_float(r.n.x & 0xffff0000u), __uint_as_float(r.n.y << 16), __uint_as_float(r.n.y & 0xffff0000u)};
    return u0 + a * (up - u0) + bq * (un - u0);
}
constexpr int PRE_CT = PRE_LDS_END;
enum { CT_KK = 0, CT_KA = 64, CT_RK = 128, CT_W0 = 192  , CT_A0 = 320  , CT_SPR = 448, CT_SNR = 512, CT_SPK = 576, CT_SNK = 640, CT_SPV = 704, CT_SNV = 768, CT_SPX = 832  , CT_SNX = 960  , CT_N = 1088 };
static_assert(PRE_CT + CT_N * 4 <= LDSCTL_OFF, "PRE constant table");
__device__ __forceinline__ void rwkv_pre_phase(Frame& F, int layer) {
    unsigned char* const ws = kws();
    int lane_ = lane_id(); asm volatile("" : "+v"(lane_)); int wave_o = F.wv; asm volatile("" : "+s"(wave_o)); const int wave_ = wave_o;
    const int d = wave_ >> 2, qm = (wave_ >> 1) & 1, qn = wave_ & 1, m0 = 32 * qm, n0 = 32 * qn;
#define LANE_VARS int lane = lane_; asm volatile("" : "+v"(lane)); const int hi = lane >> 5, l31 = lane & 31, mrow = m0 + l31; (void)hi; (void)l31; (void)mrow;
    LAS unsigned char* const L = F.lds;
    LAS unsigned char* const T0 = L + (d * 7 + 0) * TILE_B; LAS unsigned char* const T1 = L + (d * 7 + 1) * TILE_B; LAS unsigned char* const T2 = L + (d * 7 + 2) * TILE_B; LAS unsigned char* const T3 = L + (d * 7 + 3) * TILE_B;
    LAS unsigned char* const T4 = L + (d * 7 + 4) * TILE_B; LAS unsigned char* const T5 = L + (d * 7 + 5) * TILE_B; LAS unsigned char* const T6 = L + (d * 7 + 6) * TILE_B;
    LAS unsigned char* const TWt = L + PRE_TW; LAS unsigned char* const XAt = L + PRE_XA;
    LAS float* const invn = (LAS float*)(L + PRE_INVN); LAS float* const gcs = (LAS float*)(L + PRE_GC) + d * 64; LAS float* const bon = (LAS float*)(L + PRE_BON); LAS float* const ct = (LAS float*)(L + PRE_CT);
    const bf16* Rr = (const bf16*)(ws + R_RR); const bf16* Kr = (const bf16*)(ws + R_KR); const bf16* Vr = (const bf16*)(ws + R_VR); const bf16* XL = (const bf16*)(ws + R_XL);
    const bf16* W2T = (const bf16*)(ws + WS_LORA) + (size_t)d * 512 * 64; const bf16* A2T = (const bf16*)(ws + WS_LORA) + (size_t)(2 + d) * 512 * 64;
    float* BN = (float*)(ws + R_BN) + (size_t)d * M * 8;
    const int h = F.vcu & 7, hc = h * HD; const bool scanwg = (int)blockIdx.x < 128; const int idx16 = ((int)blockIdx.x & 7) * 2 + (((int)blockIdx.x >> 6) & 1);
    const int bc0 = scanwg ? idx16 : 160 + idx16, bcs = 16, bend = scanwg ? 160 : BATCH * (SEQ / 64);
    { LANE_VARS; const float* sp = karg(I_TSP) + layer * RPROJ; const float* sn = karg(I_TSN) + layer * RPROJ;
      for (int idx = wave_ * 64 + lane; idx < CT_N; idx += NTHR) { const int seg = idx >> 6, c = idx & 63; float v;
          if (seg == 0) v = karg(I_KK)[layer * 512 + hc + c]; else if (seg == 1) v = karg(I_KA)[layer * 512 + hc + c]; else if (seg == 2) v = karg(I_RK)[layer * 512 + hc + c];
          else if (seg < 5) v = karg(I_W0)[(layer * 2 + seg - 3) * 512 + hc + c]; else if (seg < 7) v = karg(I_A0)[(layer * 2 + seg - 5) * 512 + hc + c];
          else if (seg < 13) { const int j = seg - 7; v = ((j & 1) ? sn : sp)[(j >> 1) * 512 + hc + c]; }
          else if (seg < 15) v = sp[1536 + (idx - CT_SPX)]; else v = sn[1536 + (idx - CT_SNX)];
          ct[idx] = v; } }
    WG_BARL();
    R16 xw3, xa3, kk3, rr3;
    { LANE_VARS; const int tidl = wave_ * 64 + lane, tok = tidl >> 3, oct = tidl & 7; const int b = bc0 >> 6, t = (bc0 & 63) * 64 + tok, row = b * SEQ + t;
      xw3 = ld3x16(XL, 256, 8 * oct, row, t); xa3 = ld3x16(XL, 256, 64 + 8 * oct, row, t); kk3 = ld3x16(Kr, 512, hc + 8 * oct, row, t); rr3 = ld3x16(Rr, 512, hc + 8 * oct, row, t); }
    LAS unsigned char* const RF0 = L + 6 * TILE_B; LAS unsigned char* const RF1 = L + 13 * TILE_B;
    for (int bc = bc0; bc < bend; bc += bcs) {
        const int cn = bc & 63, b = bc >> 6, t0 = cn * 64;
#define SNAT (d ? 63 - mrow : mrow)
        bf16x8 wfr[4], afr[4];
        { LANE_VARS;
#pragma unroll
          for (int ks = 0; ks < 4; ++ks) { const size_t wo = (size_t)(((2 * h + qn) * 4 + ks) * 64 + lane) * 8; wfr[ks] = *(const bf16x8*)(W2T + wo); afr[ks] = *(const bf16x8*)(A2T + wo); }
        }
        float ksh[8];
        { LANE_VARS; const int tidl = wave_ * 64 + lane; const int tok = tidl >> 3, oct = tidl & 7; float v8[8];
          sh8(xw3, ct + CT_SPX + 8 * oct, ct + CT_SNX + 8 * oct, v8);
          { v4u w; w.x = cvtpk(tanh_fast(v8[0]), tanh_fast(v8[1])); w.y = cvtpk(tanh_fast(v8[2]), tanh_fast(v8[3])); w.z = cvtpk(tanh_fast(v8[4]), tanh_fast(v8[5])); w.w = cvtpk(tanh_fast(v8[6]), tanh_fast(v8[7])); *(LAS v4u*)(TWt + tok * TSB + 16 * oct) = w; }
          sh8(xa3, ct + CT_SPX + 64 + 8 * oct, ct + CT_SNX + 64 + 8 * oct, v8);
          { v4u w; w.x = cvtpk(v8[0], v8[1]); w.y = cvtpk(v8[2], v8[3]); w.z = cvtpk(v8[4], v8[5]); w.w = cvtpk(v8[6], v8[7]); *(LAS v4u*)(XAt + tok * TSB + 16 * oct) = w; }
          sh8(rr3, ct + CT_SPR + 8 * oct, ct + CT_SNR + 8 * oct, v8);
          { LAS f32x4* rp_ = (LAS f32x4*)((tok < 32 ? RF0 : RF1) + (tok & 31) * 256 + 32 * oct); rp_[0] = (f32x4){v8[0], v8[1], v8[2], v8[3]}; rp_[1] = (f32x4){v8[4], v8[5], v8[6], v8[7]}; }
          sh8(kk3, ct + CT_SPK + 8 * oct, ct + CT_SNK + 8 * oct, ksh);
          const f32x4 k0 = *(const LAS f32x4*)(ct + CT_KK + 8 * oct), k1 = *(const LAS f32x4*)(ct + CT_KK + 8 * oct + 4); float ssq = 0.f;
#pragma unroll
          for (int j = 0; j < 8; ++j) { const float kx = ksh[j] * ((j < 4) ? k0[j & 3] : k1[j & 3]); ssq += kx * kx; }
          ssq += pg8::shx(ssq, 1, lane); ssq += pg8::shx(ssq, 2, lane); ssq += pg8::shx(ssq, 4, lane);
          if (oct == 0) invn[tok] = 1.0f / sqrtf(ssq + 1e-12f); }
        WG_BARL();
        f32x16 zw, za, lw, av, cum;
        { LANE_VARS; const int snat = SNAT;
#pragma unroll
        for (int r = 0; r < 16; ++r) { zw[r] = 0.f; za[r] = 0.f; }
        { bf16x8 f0[4], f1[4]; LD4_ROW(f0, TWt, snat); LD4_ROW(f1, XAt, snat); SBAR0();
#pragma unroll
          for (int ks = 0; ks < 4; ++ks) { zw = MFMA32(wfr[ks], f0[ks], zw); za = MFMA32(afr[ks], f1[ks], za); } }
#pragma unroll
        for (int q = 0; q < 4; ++q) { const f32x4 w0v = *(const LAS f32x4*)(ct + CT_W0 + 64 * d + n0 + 8 * q + 4 * hi), a0v = *(const LAS f32x4*)(ct + CT_A0 + 64 * d + n0 + 8 * q + 4 * hi);
#pragma unroll
            for (int i = 0; i < 4; ++i) { lw[4 * q + i] = -0.8750510130f * sigmoidf_(zw[4 * q + i] + w0v[i]);     av[4 * q + i] = sigmoidf_(za[4 * q + i] + a0v[i]); } }
        { f32x16 lh, ll;
#pragma unroll
          for (int r = 0; r < 16; ++r) { lh[r] = __uint_as_float(cvtpk(lw[r], 0.f) << 16); ll[r] = lw[r] - lh[r]; }
          store_quad(T4, mrow, n0, hi, lh); store_quad(T5, mrow, n0, hi, ll); } }
        WG_BARL();
        { LANE_VARS; const int tidl = wave_ * 64 + lane, tok = tidl >> 3, oct = tidl & 7;
          LAS f32x4* kp_ = (LAS f32x4*)((tok < 32 ? TWt : XAt) + (tok & 31) * 256 + 32 * oct); kp_[0] = (f32x4){ksh[0], ksh[1], ksh[2], ksh[3]}; kp_[1] = (f32x4){ksh[4], ksh[5], ksh[6], ksh[7]}; }
        { LANE_VARS;
#pragma unroll
        for (int r = 0; r < 16; ++r) cum[r] = 0.f;
        { bf16x8 f0[4], f1[4]; LD4_TR(f0, T4, n0); LD4_TR(f1, T5, n0); SBAR0();
#pragma unroll
        for (int ks = 0; ks < 4; ++ks) { bf16x8 tf;
#pragma unroll
            for (int j = 0; j < 8; ++j) tf[j] = (16 * ks + 8 * hi + j <= mrow) ? (short)0x3f80 : (short)0;
            cum = MFMA32(f0[ks], tf, cum); cum = MFMA32(f1[ks], tf, cum); } } }
        WG_BARL();
        f32x16 rh, kc, mrk;
        { LANE_VARS; const int snat = SNAT; const float inv = invn[snat];
          f32x4 bs4 = {0.f, 0.f, 0.f, 0.f};
#pragma unroll
          for (int q = 0; q < 4; ++q) { const int cl = n0 + 8 * q + 4 * hi;
              const f32x4 r4 = *(const LAS f32x4*)((snat < 32 ? RF0 : RF1) + (snat & 31) * 256 + 4 * cl), k4 = *(const LAS f32x4*)((snat < 32 ? TWt : XAt) + (snat & 31) * 256 + 4 * cl);
              const f32x4 kk4 = *(const LAS f32x4*)(ct + CT_KK + cl), ka4 = *(const LAS f32x4*)(ct + CT_KA + cl), rk4 = *(const LAS f32x4*)(ct + CT_RK + cl);
              const f32x4 a4 = {av[4 * q], av[4 * q + 1], av[4 * q + 2], av[4 * q + 3]}, cs4 = {cum[4 * q], cum[4 * q + 1], cum[4 * q + 2], cum[4 * q + 3]}, lw4 = {lw[4 * q], lw[4 * q + 1], lw[4 * q + 2], lw[4 * q + 3]};
              const f32x4 cx4 = cs4 - lw4; f32x4 g4, gx4, gi4;
#pragma unroll
              for (int i = 0; i < 4; ++i) { g4[i] = __builtin_amdgcn_exp2f(cs4[i]); gx4[i] = __builtin_amdgcn_exp2f(cx4[i]); gi4[i] = __builtin_amdgcn_exp2f(-cs4[i]); }
              const f32x4 kkn4 = k4 * kk4 * inv, kt4 = k4 * (1.0f + (a4 - 1.0f) * ka4);
              const f32x4 kh4 = gx4 * kkn4, rh4 = g4 * r4, bc4 = a4 * kkn4 * gi4, kc4 = kt4 * gi4; bs4 += r4 * kt4 * rk4;
#pragma unroll
              for (int i = 0; i < 4; ++i) { rh[4 * q + i] = rh4[i]; kc[4 * q + i] = kc4[i]; }
              const int off = mrow * TSB + (n0 + 8 * q + 4 * hi) * 2; u32x2_t w;
              w.x = cvtpk(kh4[0], kh4[1]); w.y = cvtpk(kh4[2], kh4[3]); *(LAS u32x2_t*)(T0 + off) = w;
              w.x = cvtpk(rh4[0], rh4[1]); w.y = cvtpk(rh4[2], rh4[3]); *(LAS u32x2_t*)(T1 + off) = w;
              w.x = cvtpk(bc4[0], bc4[1]); w.y = cvtpk(bc4[2], bc4[3]); *(LAS u32x2_t*)(T2 + off) = w;
              w.x = cvtpk(kc4[0], kc4[1]); w.y = cvtpk(kc4[2], kc4[3]); *(LAS u32x2_t*)(T3 + off) = w;
            }
          if (qm == 1 && l31 == 31) {
#pragma unroll
              for (int e = 0; e < 16; ++e) gcs[n0 + 8 * (e >> 2) + 4 * hi + (e & 3)] = __builtin_amdgcn_exp2f(cum[e]); }
          float bsum = (bs4[0] + bs4[1]) + (bs4[2] + bs4[3]);
          bsum += pg8::shx(bsum, 32, lane);
          if (hi == 0) bon[(d * 2 + qn) * 64 + snat] = bsum; }
        if (bc + bcs < bend) { LANE_VARS; const int tidl = wave_ * 64 + lane, tok = tidl >> 3, oct = tidl & 7; const int bn = bc + bcs, b2 = bn >> 6, t = (bn & 63) * 64 + tok, row = b2 * SEQ + t;
            xw3 = ld3x16(XL, 256, 8 * oct, row, t); xa3 = ld3x16(XL, 256, 64 + 8 * oct, row, t); kk3 = ld3x16(Kr, 512, hc + 8 * oct, row, t); rr3 = ld3x16(Rr, 512, hc + 8 * oct, row, t); }
        WG_BARL();
        { LANE_VARS; const int snat = SNAT; if (qn == 0 && hi == 0) BN[(size_t)(b * SEQ + t0 + snat) * 8 + h] = bon[(d * 2) * 64 + snat] + bon[(d * 2 + 1) * 64 + snat]; }
        { LANE_VARS; f32x16 x, mk, zz;
          float z0 = 0.f; asm volatile("" : "+v"(z0));
#pragma unroll
          for (int r = 0; r < 16; ++r) { x[r] = 0.f; mk[r] = 0.f; zz[r] = z0; }
          { bf16x8 f0[4], f1[4], f2[4]; LD4_ROW(f0, T0, mrow); LD4_ROW(f1, T2, n0 + l31); LD4_ROW(f2, T3, n0 + l31); SBAR0();
#pragma unroll
            for (int ks = 0; ks < 4; ++ks) { x = MFMA32(f1[ks], f0[ks], x); mk = MFMA32(f2[ks], f0[ks], mk); } }
#pragma unroll
          for (int q = 0; q < 4; ++q)
#pragma unroll
              for (int i = 0; i < 4; ++i) { const int e = 4 * q + i, n = n0 + 8 * q + 4 * hi + i; const bool lo = n < mrow; x[e] = lo ? -x[e] : 0.f; mk[e] = lo ? mk[e] : 0.f; }
          store_quad(T4, mrow, n0, hi, x); store_quad(T5, mrow, n0, hi, zz); store_quad(T6, mrow, n0, hi, mk); }
        WG_BARL();
        R16 vr3[2];
        { LANE_VARS; const int tt = (wave_ * 64 + lane) & 255, s = tt >> 2, cg4 = (tt & 3) * 16, sn_ = d ? 63 - s : s, t = t0 + sn_, row = b * SEQ + t;
          vr3[0] = ld3x16(Vr, 512, hc + cg4, row, t); vr3[1] = ld3x16(Vr, 512, hc + cg4 + 8, row, t); }
        LAS unsigned char* const RBt = d ? XAt : TWt;
#define PRE_S13() { LANE_VARS; f32x16 rb; \
          _Pragma("unroll") for (int r = 0; r < 16; ++r) { rb[r] = 0.f; mrk[r] = 0.f; } \
          { bf16x8 f0[4], f1[4], f2[4]; LD4_ROW(f0, T2, n0 + l31); LD4_ROW(f1, T1, mrow); LD4_ROW(f2, T3, n0 + l31); SBAR0(); \
            _Pragma("unroll") for (int ks = 0; ks < 4; ++ks) { rb = MFMA32(f0[ks], f1[ks], rb); mrk = MFMA32(f2[ks], f1[ks], mrk); } } \
          _Pragma("unroll") for (int q = 0; q < 4; ++q) _Pragma("unroll") for (int i = 0; i < 4; ++i) { const int e = 4 * q + i, n = n0 + 8 * q + 4 * hi + i; const bool lo = n <= mrow; rb[e] = lo ? rb[e] : 0.f; mrk[e] = lo ? mrk[e] : 0.f; } \
          store_quad(RBt, mrow, n0, hi, rb); }
        if ((wave_ & 3) == 0) { LANE_VARS; const int blk = lane >> 4, c = lane & 15; float t[16];
#pragma unroll
            for (int r = 0; r < 16; ++r) { const LAS unsigned char* xr = T4 + (16 * blk + r) * TSB + 32 * blk; const v4u w0_ = *(const LAS v4u*)xr, w1_ = *(const LAS v4u*)(xr + 16);
                float acc0 = (r == c) ? 1.0f : 0.f, acc1 = 0.f;
#pragma unroll
                for (int j = 0; j < r; ++j) { const unsigned w = (j < 8) ? w0_[j >> 1] : w1_[(j - 8) >> 1]; const float xv = (j & 1) ? __uint_as_float(w & 0xffff0000u) : __uint_as_float(w << 16);
                    if (j & 1) acc1 += xv * t[j]; else acc0 += xv * t[j]; }
                t[r] = acc0 + acc1; }
#pragma unroll
            for (int r = 0; r < 16; ++r) *(LAS unsigned short*)(T5 + (16 * blk + r) * TSB + (16 * blk + c) * 2) = (unsigned short)(cvtpk(t[r], 0.f) & 0xffffu); }
        else PRE_S13()
        WG_BARL();
        { LANE_VARS; LAS unsigned char* const scr = qm ? T5 : T4;
          if (qm == qn) {
              f32x16 w;
#pragma unroll
              for (int r = 0; r < 16; ++r) w[r] = 0.f;
              bf16x8 mf = frag_row(T4, m0 + l31, 2 * qm, hi);
              if (l31 < 16) mf = (bf16x8){0, 0, 0, 0, 0, 0, 0, 0};
              w = MFMA32(frag_tr(T5, m0, 2 * qm, lane), mf, w);
              store_quad(scr, l31, 32, hi, w); } }
        WG_BARL();
        { LANE_VARS; LAS unsigned char* const scr = qm ? T5 : T4;
          if (qm == qn) {
              f32x16 tq = load_quad(T5, mrow, m0, hi);
#pragma unroll
              for (int ks = 0; ks < 2; ++ks) tq = MFMA32(frag_tr(scr, 32, ks, lane), frag_row(T5, mrow, 2 * qm + ks, hi), tq);
              store_quad(T5, mrow, m0, hi, tq); } }
        WG_BARL();
        { LANE_VARS;
          if (qm == 1 && qn == 0) {
              f32x16 w;
#pragma unroll
              for (int r = 0; r < 16; ++r) w[r] = 0.f;
#pragma unroll
              for (int ks = 0; ks < 2; ++ks) w = MFMA32(frag_tr(T5, 0, ks, lane), frag_row(T4, 32 + l31, ks, hi), w);
              store_quad(T4, l31, 32, hi, w); }
          if (qm == 0 && qn == 1) { f32x16 zz; float z0 = 0.f; asm volatile("" : "+v"(z0));
#pragma unroll
              for (int r = 0; r < 16; ++r) zz[r] = z0;
              store_quad(T5, l31, 32, hi, zz); } }
        if ((wave_ & 3) == 0) PRE_S13()
        WG_BARL();
        { LANE_VARS;
          if (qm == 1 && qn == 0) {
              f32x16 t21;
#pragma unroll
              for (int r = 0; r < 16; ++r) t21[r] = 0.f;
#pragma unroll
              for (int ks = 0; ks < 2; ++ks) t21 = MFMA32(frag_tr(T4, 32, ks, lane), frag_row(T5, 32 + l31, 2 + ks, hi), t21);
              store_quad(T5, 32 + l31, 0, hi, t21); } }
        { LANE_VARS; const int tt = (wave_ * 64 + lane) & 255, s = tt >> 2, cg4 = (tt & 3) * 16; float v8[8];
#pragma unroll
          for (int hlf = 0; hlf < 2; ++hlf) { const int c8 = cg4 + 8 * hlf;
              sh8(vr3[hlf], ct + CT_SPV + c8, ct + CT_SNV + c8, v8);
              v4u w; w.x = cvtpk_h(v8[0], v8[1]); w.y = cvtpk_h(v8[2], v8[3]); w.z = cvtpk_h(v8[4], v8[5]); w.w = cvtpk_h(v8[6], v8[7]); *(LAS v4u*)(T1 + s * TSB + 2 * c8) = w; } }
        WG_BARL();
        { LANE_VARS; f32x16 kp, tk;
#pragma unroll
          for (int r = 0; r < 16; ++r) { kp[r] = 0.f; tk[r] = 0.f; }
          { bf16x8 f0[4], f1[4], f2[4]; LD4_ROW(f0, T5, mrow); LD4_TR(f1, T0, n0); LD4_TR(f2, T6, n0); SBAR0();
#pragma unroll
            for (int ks = 0; ks < 4; ++ks) { kp = MFMA32(f1[ks], f0[ks], kp); tk = MFMA32(f2[ks], f0[ks], tk); } }
          store_quad(T4, mrow, n0, hi, kp); store_quad(T3, mrow, n0, hi, tk); }
        WG_BARL();
        const int cd = d ? 63 - cn : cn;
        bf16* const pre = pre_item(ws, ((b * 8 + h) * 2 + d) * 64 + cd);
        { LANE_VARS; f32x16 rp, ml, pm, kq;
#pragma unroll
          for (int r = 0; r < 16; ++r) { rp[r] = 0.f; ml[r] = 0.f; pm[r] = 0.f; kq[r] = 0.f; }
#pragma unroll
          for (int kh = 0; kh < 2; ++kh) { bf16x8 mrbf[2], khn[2], bcn[2], tkn[2], bcm[2], tkm[2];
#pragma unroll
              for (int k2 = 0; k2 < 2; ++k2) { const int ks = 2 * kh + k2; mrbf[k2] = frag_row(RBt, mrow, ks, hi); khn[k2] = frag_tr(T4, n0, ks, lane); bcn[k2] = frag_tr(T2, n0, ks, lane); tkn[k2] = frag_tr(T3, n0, ks, lane); bcm[k2] = frag_tr(T2, m0, ks, lane); tkm[k2] = frag_tr(T3, m0, ks, lane); }
              SBAR0();
#pragma unroll
              for (int k2 = 0; k2 < 2; ++k2) { rp = MFMA32(khn[k2], mrbf[k2], rp); ml = MFMA32(tkn[k2], mrbf[k2], ml); pm = MFMA32(khn[k2], bcm[k2], pm); kq = MFMA32(bcn[k2], tkm[k2], kq); }
              SBAR0(); }
          const float gm = gcs[mrow];
#pragma unroll
          for (int q = 0; q < 4; ++q)
#pragma unroll
              for (int i = 0; i < 4; ++i) { const int e = 4 * q + i, n = n0 + 8 * q + 4 * hi + i;
                  rp[e] = rh[e] - rp[e]; ml[e] = mrk[e] - ml[e]; pm[e] = gm * (((n == mrow) ? 1.0f : 0.f) - pm[e]); kq[e] = (kc[e] - kq[e]) * gcs[n]; }
          { const int tn = d ? 63 - mrow : mrow;
#pragma unroll
          for (int s2 = 0; s2 < 2; ++s2) { v4u w;
              w.x = cvtpk_h(pm[8 * s2], pm[8 * s2 + 1]); w.y = cvtpk_h(pm[8 * s2 + 2], pm[8 * s2 + 3]); w.z = cvtpk_h(pm[8 * s2 + 4], pm[8 * s2 + 5]); w.w = cvtpk_h(pm[8 * s2 + 6], pm[8 * s2 + 7]);
              __builtin_nontemporal_store(w, (v4u*)(pre + ((4 * qm + 2 * qn + s2) * 64 + lane) * 8));
              w.x = cvtpk_h(rp[8 * s2], rp[8 * s2 + 1]); w.y = cvtpk_h(rp[8 * s2 + 2], rp[8 * s2 + 3]); w.z = cvtpk_h(rp[8 * s2 + 4], rp[8 * s2 + 5]); w.w = cvtpk_h(rp[8 * s2 + 6], rp[8 * s2 + 7]);
              __builtin_nontemporal_store(w, (v4u*)(pre + 4096 + ((2 * (2 * qn + s2) + (tn >> 5)) * 64 + 32 * hi + (tn & 31)) * 8)); } }
          store_quad_h(T0, mrow, n0, hi, ml); store_quad_h(T6, mrow, n0, hi, kq); }
        WG_BARL();
        { LANE_VARS; f32x16 qt, yt;
#pragma unroll
          for (int r = 0; r < 16; ++r) { qt[r] = 0.f; yt[r] = 0.f; }
          { bf16x8 f0[4], f1[4], f2[4], f3[4]; LD4_TR(f0, T1, m0); LD4_TR(f1, T6, n0); LD4_TR(f2, T1, n0); LD4_ROW(f3, T0, mrow); SBAR0();
#pragma unroll
            for (int ks = 0; ks < 4; ++ks) { qt = MFMA32H(f1[ks], f0[ks], qt); yt = MFMA32H(f2[ks], f3[ks], yt); } }
          v4u w0_, w1_;
          w0_.x = cvtpk_h(qt[0], qt[1]); w0_.y = cvtpk_h(qt[2], qt[3]); w0_.z = cvtpk_h(qt[4], qt[5]); w0_.w = cvtpk_h(qt[6], qt[7]); w1_.x = cvtpk_h(qt[8], qt[9]); w1_.y = cvtpk_h(qt[10], qt[11]); w1_.z = cvtpk_h(qt[12], qt[13]); w1_.w = cvtpk_h(qt[14], qt[15]);
          { bf16* dst = pre + 8192 + ((qn * 64 + mrow) * 2 + hi) * 16; __builtin_nontemporal_store(w0_, (v4u*)dst); __builtin_nontemporal_store(w1_, (v4u*)(dst + 8)); }
          w0_.x = cvtpk_h(yt[0], yt[1]); w0_.y = cvtpk_h(yt[2], yt[3]); w0_.z = cvtpk_h(yt[4], yt[5]); w0_.w = cvtpk_h(yt[6], yt[7]); w1_.x = cvtpk_h(yt[8], yt[9]); w1_.y = cvtpk_h(yt[10], yt[11]); w1_.z = cvtpk_h(yt[12], yt[13]); w1_.w = cvtpk_h(yt[14], yt[15]);
          { bf16* dst = pre + 12288 + ((qn * 64 + (d ? 63 - mrow : mrow)) * 2 + hi) * 16; __builtin_nontemporal_store(w0_, (v4u*)dst); __builtin_nontemporal_store(w1_, (v4u*)(dst + 8)); } }
        WG_BARL();
    }
#undef PRE_S13
#undef LANE_VARS
#undef SNAT
}

constexpr int SCAN_SLOT = 12 * 1024, SCAN_NS = 6, SCAN_AHEAD = 5;
__device__ __forceinline__ void scan_issue(const bf16* pre, LAS unsigned char* slot, int l31, int hi, int v) {
#pragma unroll
    for (int i = 0; i < 8; ++i) { const int mt = i >> 2, kt = (i >> 1) & 1, s = i & 1;
        (void)mt; (void)kt; (void)s; __builtin_amdgcn_global_load_lds((const unsigned*)(pre + (i * 64 + 32 * hi + l31) * 8), (LAS unsigned*)(slot + i * 1024), 16, 0, 2); }
#pragma unroll
    for (int i = 0; i < 4; ++i) { const int mt = i >> 1, hf = i & 1;
        __builtin_amdgcn_global_load_lds((const unsigned*)(pre + 8192 + ((mt * 64 + v) * 2 + hi) * 16 + 8 * hf), (LAS unsigned*)(slot + (8 + i) * 1024), 16, 0, 2); }
}
__device__ __forceinline__ void rwkv_scan_chunk(Frame& F, int unit) {
    unsigned char* const ws = kws();
    int lane_ = lane_id(); asm volatile("" : "+v"(lane_));
    const int lane = lane_, hi = lane >> 5, l31 = lane & 31;
    const int chain = unit >> 1, vh = unit & 1, v = 32 * vh + l31;
    const bf16* pre = pre_item(ws, chain * 64);
    bf16* sd = (bf16*)(ws + R_SD) + (size_t)chain * 64 * 4096;
    LAS unsigned char* const ring = F.lds;
    f32x16 X0, X1;
#pragma unroll
    for (int r = 0; r < 16; ++r) { X0[r] = 0.f; X1[r] = 0.f; }
#pragma unroll
    for (int i0 = 0; i0 < SCAN_AHEAD; ++i0) scan_issue(pre + (size_t)i0 * 16384, ring + i0 * SCAN_SLOT, l31, hi, v);
    bf16x8 pfA[8], pfB[8]; f32x16 qA[2], qB[2];
#define SCAN_FETCH(PF, QI, STEP) do { const LAS unsigned char* sl_ = ring + ((STEP) % SCAN_NS) * SCAN_SLOT + lane * 16; \
        _Pragma("unroll") for (int mt = 0; mt < 2; ++mt) { const v4u w0_ = *(const LAS v4u*)(sl_ + (8 + 2 * mt) * 1024), w1_ = *(const LAS v4u*)(sl_ + (9 + 2 * mt) * 1024); \
            _Pragma("unroll") for (int j = 0; j < 4; ++j) { const f32x2_t u0 = unpk_h(w0_[j]), u1 = unpk_h(w1_[j]); QI[mt][2 * j] = u0.x; QI[mt][2 * j + 1] = u0.y; QI[mt][8 + 2 * j] = u1.x; QI[mt][8 + 2 * j + 1] = u1.y; } } \
        _Pragma("unroll") for (int i = 0; i < 8; ++i) PF[i] = *(const LAS bf16x8*)(sl_ + i * 1024); } while (0)
    asm volatile("s_waitcnt vmcnt(48)" ::: "memory");
    SCAN_FETCH(pfA, qA, 0);
#define SCAN_STEP(C, PF, QI, PFN, QIN) do { const int c_ = (C); \
          \
        bf16x8 xb[2][2]; \
        _Pragma("unroll") for (int kt = 0; kt < 2; ++kt) _Pragma("unroll") for (int s = 0; s < 2; ++s) { v4u w; \
            _Pragma("unroll") for (int j = 0; j < 4; ++j) { const float a0 = kt ? X1[8 * s + 2 * j] : X0[8 * s + 2 * j], a1 = kt ? X1[8 * s + 2 * j + 1] : X0[8 * s + 2 * j + 1]; w[j] = cvtpk_h(a0, a1); } \
            xb[kt][s] = __builtin_bit_cast(bf16x8, w); \
            __builtin_nontemporal_store(w, (v4u*)(sd + (size_t)c_ * 4096 + ((kt * 64 + v) * 2 + hi) * 16 + 8 * s)); } \
        f32x16 acc0 = QI[0], acc1 = QI[1]; \
        SBAR0(); \
        _Pragma("unroll") for (int kt = 0; kt < 2; ++kt) _Pragma("unroll") for (int s = 0; s < 2; ++s) { acc0 = MFMA32H(PF[2 * kt + s], xb[kt][s], acc0); acc1 = MFMA32H(PF[4 + 2 * kt + s], xb[kt][s], acc1); } \
        SBAR0(); \
          \
        if (c_ + SCAN_AHEAD < 64) scan_issue(pre + (size_t)(c_ + SCAN_AHEAD) * 16384, ring + ((c_ + SCAN_AHEAD) % SCAN_NS) * SCAN_SLOT, l31, hi, v); \
        if (c_ + 1 < 64) { if (c_ + SCAN_AHEAD < 64) asm volatile("s_waitcnt vmcnt(48)" ::: "memory"); else asm volatile("s_waitcnt vmcnt(0)" ::: "memory"); \
            SCAN_FETCH(PFN, QIN, c_ + 1); } \
        SBAR0(); \
        X0 = acc0; X1 = acc1; } while (0)
#pragma unroll 1
    for (int c = 0; c < 64; c += 2) { SCAN_STEP(c, pfA, qA, pfB, qB); SCAN_STEP(c + 1, pfB, qB, pfA, qA); }
#undef SCAN_STEP
#undef SCAN_FETCH
}

constexpr int FIN_SGS = 272, FIN_VSS = 1040;
__device__ __forceinline__ void rwkv_finalize_mfma(Frame& F, int layer) {
    unsigned char* const ws = kws();
    int lane_ = lane_id(); asm volatile("" : "+v"(lane_)); int wave_o = F.wv; asm volatile("" : "+s"(wave_o)); const int wave_ = wave_o, h = wave_, hc = h * HD;
#define FIN_LANE int lane = lane_; asm volatile("" : "+v"(lane)); const int hi = lane >> 5, l31 = lane & 31; (void)hi; (void)l31;
    LAS unsigned char* const sgt = F.lds; LAS unsigned char* const vst = F.lds + 64 * FIN_SGS;
    const bf16* Vr = (const bf16*)(ws + R_VR); const bf16* XL = (const bf16*)(ws + R_XL); bf16* MIX = (bf16*)(ws + R_MIX); const bf16* G2T = (const bf16*)(ws + WS_G2T);
    const float* BN0 = (const float*)(ws + R_BN); const float* BN1 = BN0 + (size_t)M * 8;
    const float* sp = karg(I_TSP) + layer * RPROJ; const float* sn = karg(I_TSN) + layer * RPROJ;
    const float* gnw = karg(I_GNW) + layer * 512 + hc; const float* gnb = karg(I_GNB) + layer * 512 + hc;
    for (int unit = F.vcu; unit < BATCH * (SEQ / 64); unit += F.G) {
        const int cn = unit & 63, b = unit >> 6, t0 = cn * 64;
        { FIN_LANE; const int tid = wave_ * 64 + lane, tok = tid >> 3, oct = tid & 7, t = t0 + tok, row = b * SEQ + t; float v8[8];
#pragma unroll
          for (int hf = 0; hf < 2; ++hf) { const int k0 = 16 * oct + 8 * hf;
              shift8(XL, 256, 128 + k0, row, t, sp + 1664 + k0, sn + 1664 + k0, v8);
              v4u w; w.x = cvtpk(sigmoidf_(v8[0]), sigmoidf_(v8[1])); w.y = cvtpk(sigmoidf_(v8[2]), sigmoidf_(v8[3])); w.z = cvtpk(sigmoidf_(v8[4]), sigmoidf_(v8[5])); w.w = cvtpk(sigmoidf_(v8[6]), sigmoidf_(v8[7]));
              *(LAS v4u*)(sgt + tok * FIN_SGS + 2 * k0) = w; }
#pragma unroll 2
          for (int j = 0; j < 8; ++j) { const int c0 = 64 * j + 8 * oct; float v8[8];
              shift8(Vr, 512, c0, row, t, sp + 1024 + c0, sn + 1024 + c0, v8);
              v4u w; w.x = cvtpk(v8[0], v8[1]); w.y = cvtpk(v8[2], v8[3]); w.z = cvtpk(v8[4], v8[5]); w.w = cvtpk(v8[6], v8[7]);
              *(LAS v4u*)(vst + tok * FIN_VSS + 2 * c0) = w; } }
        WG_BARL();
        { FIN_LANE;
        f32x16 acc[2][2], gg[2][2];
#pragma unroll
        for (int tt = 0; tt < 2; ++tt)
#pragma unroll
            for (int vt = 0; vt < 2; ++vt)
#pragma unroll
                for (int r = 0; r < 16; ++r) { acc[tt][vt][r] = 0.f; gg[tt][vt][r] = 0.f; }
#pragma unroll
        for (int d = 0; d < 2; ++d) { const size_t item = (size_t)(((b * 8 + h) * 2 + d) * 64 + (d ? 63 - cn : cn));
            const bf16* pre = pre_item(ws, (int)item); const bf16* sd = (const bf16*)(ws + R_SD) + item * 4096;
#pragma unroll
            for (int tt = 0; tt < 2; ++tt)
#pragma unroll
                for (int vt = 0; vt < 2; ++vt) { const bf16* src = pre + 12288 + ((vt * 64 + 32 * tt + l31) * 2 + hi) * 16; const v4u w0_ = __builtin_nontemporal_load((const v4u*)src), w1_ = __builtin_nontemporal_load((const v4u*)(src + 8));
#pragma unroll
                    for (int j = 0; j < 4; ++j) { const f32x2_t u0 = unpk_h(w0_[j]), u1 = unpk_h(w1_[j]); acc[tt][vt][2 * j] += u0.x; acc[tt][vt][2 * j + 1] += u0.y; acc[tt][vt][8 + 2 * j] += u1.x; acc[tt][vt][8 + 2 * j + 1] += u1.y; } }
            bf16x8 sf[4][2], rf[4][2];
#pragma unroll
            for (int ks = 0; ks < 4; ++ks) { const int kt = ks >> 1, s = ks & 1;
#pragma unroll
                for (int vt = 0; vt < 2; ++vt) sf[ks][vt] = __builtin_nontemporal_load((const bf16x8*)(sd + ((kt * 64 + 32 * vt + l31) * 2 + hi) * 16 + 8 * s));
#pragma unroll
                for (int tt = 0; tt < 2; ++tt) rf[ks][tt] = __builtin_nontemporal_load((const bf16x8*)(pre + 4096 + ((2 * ks + tt) * 64 + 32 * hi + l31) * 8)); }
            SBAR0();
#pragma unroll
            for (int ks = 0; ks < 4; ++ks)
#pragma unroll
                for (int tt = 0; tt < 2; ++tt)
#pragma unroll
                    for (int vt = 0; vt < 2; ++vt) acc[tt][vt] = MFMA32H(sf[ks][vt], rf[ks][tt], acc[tt][vt]); }
#pragma unroll
        for (int kh = 0; kh < 2; ++kh) { bf16x8 gf[4][2], tf[4][2];
#pragma unroll
            for (int k4 = 0; k4 < 4; ++k4) { const int ks = 4 * kh + k4;
#pragma unroll
                for (int vt = 0; vt < 2; ++vt) gf[k4][vt] = *(const bf16x8*)(G2T + (size_t)(((2 * h + vt) * 8 + ks) * 64 + lane) * 8);
#pragma unroll
                for (int tt = 0; tt < 2; ++tt) tf[k4][tt] = *(const LAS bf16x8*)(sgt + (32 * tt + l31) * FIN_SGS + (16 * ks + 8 * hi) * 2); }
            SBAR0();
#pragma unroll
            for (int k4 = 0; k4 < 4; ++k4)
#pragma unroll
                for (int tt = 0; tt < 2; ++tt)
#pragma unroll
                    for (int vt = 0; vt < 2; ++vt) gg[tt][vt] = MFMA32(gf[k4][vt], tf[k4][tt], gg[tt][vt]);
            SBAR0(); }
#pragma unroll
        for (int tt = 0; tt < 2; ++tt) { const int t = t0 + 32 * tt + l31, row = b * SEQ + t;
            float sm = 0.f;
#pragma unroll
            for (int vt = 0; vt < 2; ++vt)
#pragma unroll
                for (int r = 0; r < 16; ++r) sm += acc[tt][vt][r];
            sm += pg8::shx(sm, 32, lane); const float mu = sm * (1.0f / 64.0f); float sq = 0.f;
#pragma unroll
            for (int vt = 0; vt < 2; ++vt)
#pragma unroll
                for (int r = 0; r < 16; ++r) { const float dl = acc[tt][vt][r] - mu; sq += dl * dl; }
            sq += pg8::shx(sq, 32, lane); const float rstd = 1.0f / sqrtf(sq * (1.0f / 64.0f) + GN_EPS);
            const float bon = BN0[(size_t)row * 8 + h] + BN1[(size_t)row * 8 + h];
#pragma unroll
            for (int vt = 0; vt < 2; ++vt)
#pragma unroll
                for (int q = 0; q < 4; ++q) { const int v0 = 32 * vt + 8 * q + 4 * hi;
                    LAS u32x2_t* const vp = (LAS u32x2_t*)(vst + (32 * tt + l31) * FIN_VSS + 2 * (hc + v0)); const u32x2_t vw = *vp;
                    const f32x4 vs = (f32x4){__uint_as_float(vw.x << 16), __uint_as_float(vw.x & 0xffff0000u), __uint_as_float(vw.y << 16), __uint_as_float(vw.y & 0xffff0000u)}, w4 = *(const f32x4*)(gnw + v0), b4 = *(const f32x4*)(gnb + v0);
                    float o4[4];
#pragma unroll
                    for (int i = 0; i < 4; ++i) o4[i] = ((acc[tt][vt][4 * q + i] - mu) * rstd * w4[i] + b4[i] + bon * vs[i]) * gg[tt][vt][4 * q + i];
                    u32x2_t w; w.x = cvtpk(o4[0], o4[1]); w.y = cvtpk(o4[2], o4[3]); *vp = w; } } }
        WG_BARL();
        { FIN_LANE; const int tid = wave_ * 64 + lane, tok = tid >> 3, oct = tid & 7; bf16* orow = MIX + (size_t)(b * SEQ + t0 + tok) * 1024 + 512;
#pragma unroll
          for (int j = 0; j < 8; ++j) { const int c0 = 64 * j + 8 * oct; *(v4u*)(orow + c0) = *(const LAS v4u*)(vst + tok * FIN_VSS + 2 * c0); } }
        WG_BARL();
    }
}
#undef FIN_LANE

constexpr int ATT_O = 0, ATT_L = 65536, ATT_V = 67584, ATT_VT = 2 * 32 * TSB;
static_assert(ATT_V + NWAVES * ATT_VT <= LDSCTL_OFF, "attention LDS map");
__device__ __forceinline__ bf16x8 frag_tr_pv(const LAS unsigned char* tile, int d0, int s, int lane) {
    const int hi = lane >> 5, g1 = (lane >> 4) & 1, i = lane & 15;
    const LAS unsigned char* p = tile + (16 * s + 4 * hi + (i >> 2)) * TSB + (d0 + 16 * g1 + 4 * (i & 3)) * 2;
    const s16x4 lo = tr4(p), h4 = tr4(p + 8 * TSB);
    return (bf16x8){lo[0], lo[1], lo[2], lo[3], h4[0], h4[1], h4[2], h4[3]};
}
template <int NQH> struct AttPre { bf16x8 qf[NQH][4]; v4u vraw[4], kraw[4]; };
template <> struct AttPre<0> { };
template <int NQH> __device__ __forceinline__ void attn_begin(AttPre<NQH>& P, const bf16* MIX, const bf16* V, int b, int h, int tq0, int d, int lane_in) {
    int lane = lane_in; asm volatile("" : "+v"(lane)); const int hi = lane >> 5, l31 = lane & 31;
#pragma unroll
    for (int qh = 0; qh < NQH; ++qh) { const bf16* qp = MIX + ((size_t)b * SEQ + tq0 + d * (32 * qh + l31)) * 1024 + h * HD + 8 * hi;
#pragma unroll
        for (int ks = 0; ks < 4; ++ks) P.qf[qh][ks] = *(const bf16x8*)(qp + 16 * ks); }
#pragma unroll
    for (int j = 0; j < 4; ++j) { int pos = tq0 + d * (8 * j + (lane >> 3) - 64); pos = pos < 0 ? 0 : (pos > SEQ - 1 ? SEQ - 1 : pos);
        P.vraw[j] = *(const v4u*)(V + ((size_t)b * SEQ + pos) * 512 + h * HD + 8 * (lane & 7)); P.kraw[j] = *(const v4u*)(MIX + ((size_t)b * SEQ + pos) * 1024 + 512 + h * HD + 8 * (lane & 7)); }
}
template <> __device__ __forceinline__ void attn_begin<0>(AttPre<0>&, const bf16*, const bf16*, int, int, int, int, int) {}
template <int NQH, int NQN>
__device__ __forceinline__ void attn_block(AttPre<NQH>& P, AttPre<NQN>& PN, int tqn, int dn, const bf16* MIX, const bf16* V, LAS unsigned char* lds, LAS unsigned char* vt, int b, int h, int T0, int tq0, int d, float slope_d, float bound, bool first, int lane_in) {
    int lane = lane_in; asm volatile("" : "+v"(lane));
    const int hi = lane >> 5, l31 = lane & 31;
    const int jlo = -(tq0 / d), jhi = (SEQ - 1 - tq0) / d;
    bf16x8 (&qf)[NQH][4] = P.qf;
    f32x16 o[NQH][2]; float lsum[NQH];
#pragma unroll
    for (int qh = 0; qh < NQH; ++qh) { lsum[qh] = 0.f;
#pragma unroll
        for (int r = 0; r < 16; ++r) { o[qh][0][r] = 0.f; o[qh][1][r] = 0.f; } }
    constexpr int NT = NQH == 2 ? 6 : 5;
    v4u (&vraw)[4] = P.vraw; v4u (&kraw)[4] = P.kraw; LAS unsigned char* const kt = vt + 32 * TSB;
#define ATT_LOAD(JT) do { _Pragma("unroll") for (int j_ = 0; j_ < 4; ++j_) { int pos_ = tq0 + d * (32 * (JT) + 8 * j_ + (lane >> 3) - 64); pos_ = pos_ < 0 ? 0 : (pos_ > SEQ - 1 ? SEQ - 1 : pos_); \
          vraw[j_] = *(const v4u*)(V + ((size_t)b * SEQ + pos_) * 512 + h * HD + 8 * (lane & 7)); kraw[j_] = *(const v4u*)(MIX + ((size_t)b * SEQ + pos_) * 1024 + 512 + h * HD + 8 * (lane & 7)); } } while (0)
#pragma unroll 1
    for (int jt = 0; jt < NT; ++jt) {
#pragma unroll
        for (int j = 0; j < 4; ++j) { *(LAS v4u*)(vt + (8 * j + (lane >> 3)) * TSB + 16 * (lane & 7)) = vraw[j]; *(LAS v4u*)(kt + (8 * j + (lane >> 3)) * TSB + 16 * (lane & 7)) = kraw[j]; }
        if (jt + 1 < NT) ATT_LOAD(jt + 1);
        asm volatile("" ::: "memory");
        bf16x8 kf[4];
#pragma unroll
        for (int ks = 0; ks < 4; ++ks) kf[ks] = *(const LAS bf16x8*)(kt + l31 * TSB + (16 * ks + 8 * hi) * 2);
        bf16x8 vfr[2][2];
#pragma unroll
        for (int dt = 0; dt < 2; ++dt)
#pragma unroll
            for (int s2 = 0; s2 < 2; ++s2) vfr[dt][s2] = frag_tr_pv(vt, 32 * dt, s2, lane);
        const bool inseq = (32 * jt - 64 >= jlo) && (32 * jt - 33 <= jhi);
#pragma unroll
        for (int qh = 0; qh < NQH; ++qh) {
            if (NQH == 2 && ((qh == 0 && jt == 5) || (qh == 1 && jt == 0))) continue;
            const float fb = (float)(32 * qh + l31 - (32 * jt + 4 * hi - 64)); const int rel = jt - qh;
            f32x16 s;
            if (inseq && rel == 1) { const float A = fmaf(-slope_d, fb, -bound);
#pragma unroll
                for (int r = 0; r < 16; ++r) s[r] = fmaf(slope_d, (float)((r & 3) + 8 * (r >> 2)), A);
            } else if (inseq && rel == 3) { const float A = fmaf(slope_d, fb, -bound);
#pragma unroll
                for (int r = 0; r < 16; ++r) s[r] = fmaf(-slope_d, (float)((r & 3) + 8 * (r >> 2)), A);
            } else if (inseq && rel == 2) {
#pragma unroll
                for (int r = 0; r < 16; ++r) s[r] = fmaf(-slope_d, fabsf(fb - (float)((r & 3) + 8 * (r >> 2))), -bound);
            } else if (inseq) {
#pragma unroll
                for (int r = 0; r < 16; ++r) { const float t = fabsf(fb - (float)((r & 3) + 8 * (r >> 2))); s[r] = (t <= 64.0f) ? fmaf(-slope_d, t, -bound) : -1e30f; }
            } else {
#pragma unroll
                for (int r = 0; r < 16; ++r) { const int cr = (r & 3) + 8 * (r >> 2), jj = 32 * jt + cr + 4 * hi - 64; const float t = fabsf(fb - (float)cr);
                    s[r] = ((t <= 64.0f) && (jj >= jlo) && (jj <= jhi)) ? fmaf(-slope_d, t, -bound) : -1e30f; }
            }
#pragma unroll
            for (int ks = 0; ks < 4; ++ks) s = MFMA32(kf[ks], qf[qh][ks], s);
            v4u pk[2];
#pragma unroll
            for (int r = 0; r < 16; r += 2) { const float p0 = __builtin_amdgcn_exp2f(s[r]), p1 = __builtin_amdgcn_exp2f(s[r + 1]); lsum[qh] += p0 + p1; pk[r >> 3][(r >> 1) & 3] = cvtpk(p0, p1); }
#pragma unroll
            for (int dt = 0; dt < 2; ++dt)
#pragma unroll
                for (int s2 = 0; s2 < 2; ++s2) o[qh][dt] = MFMA32(vfr[dt][s2], __builtin_bit_cast(bf16x8, pk[s2]), o[qh][dt]);
        }
    }
#undef ATT_LOAD
    attn_begin<NQN>(PN, MIX, V, b, h, tqn, dn, lane);
    int lane2 = lane; asm volatile("" : "+v"(lane2));
#pragma unroll
    for (int qh = 0; qh < NQH; ++qh) { const int hi = lane2 >> 5, l31 = lane2 & 31, lane = lane2;
        const int qi = (tq0 - T0) + d * (32 * qh + l31);
        const float lt = lsum[qh] + pg8::shx(lsum[qh], 32, lane);
        if (hi == 0) { LAS float* lp = (LAS float*)(lds + ATT_L) + qi; *lp = first ? lt : (*lp + lt); }
#pragma unroll
        for (int dt = 0; dt < 2; ++dt)
#pragma unroll
            for (int q = 0; q < 4; ++q) { const int d0 = 32 * dt + 8 * q + 4 * hi; LAS u32x2_t* op = (LAS u32x2_t*)(lds + ATT_O + qi * 128 + ((((d0 >> 3) ^ (qi & 7)) << 4) | ((d0 & 4) << 1)));
                float v0 = o[qh][dt][4 * q], v1 = o[qh][dt][4 * q + 1], v2 = o[qh][dt][4 * q + 2], v3 = o[qh][dt][4 * q + 3];
                if (!first) { const u32x2_t w = *op; v0 += __uint_as_float(w.x << 16); v1 += __uint_as_float(w.x & 0xffff0000u); v2 += __uint_as_float(w.y << 16); v3 += __uint_as_float(w.y & 0xffff0000u); }
                u32x2_t w; w.x = cvtpk(v0, v1); w.y = cvtpk(v2, v3); *op = w; }
    }
}
__device__ __forceinline__ void attn_phase_mfma(Frame& F, int layer, int unit0, int nunit, int ustride) {
    unsigned char* const ws = kws();
    int lane_ = lane_id(); asm volatile("" : "+v"(lane_)); int wave_o = F.wv; asm volatile("" : "+s"(wave_o)); const int wave_ = wave_o, lane = lane_;
    bf16* MIX = (bf16*)(ws + R_MIX); const bf16* V = (const bf16*)(ws + R_V);
    LAS unsigned char* const lds = F.lds; LAS unsigned char* const vt = lds + ATT_V + wave_ * ATT_VT;
    float bound;
    { float mq = fabsf(karg(I_QG)[layer * HD + lane]), mk = fabsf(karg(I_KG)[layer * HD + lane]);
#pragma unroll
      for (int o = 1; o < 64; o <<= 1) { mq = fmaxf(mq, pg8::shx(mq, o, lane)); mk = fmaxf(mk, pg8::shx(mk, o, lane)); }
      bound = (8.0f * mq * mk + 0.25f) * 1.4426950408889634f; }
    for (int unit = unit0; unit < nunit; unit += ustride) {
        const int st = unit & 7, h = (unit >> 3) & 7, b = unit >> 6, T0 = st * 512;
        const float slope = exp2f(-(float)(h + 1)) * 1.4426950408889634f;
        const int tq1 = T0 + 64 * wave_, tq2 = T0 + (wave_ & 3) + 256 * (wave_ >> 2), tq3 = T0 + 2 * wave_;
        AttPre<2> p1, p2; AttPre<1> p3, p4; AttPre<0> p0;
        attn_begin<2>(p1, MIX, V, b, h, tq1, 1, lane);
        attn_block<2, 2>(p1, p2, tq2, 4, MIX, V, lds, vt, b, h, T0, tq1, 1, slope, bound, true, lane);
        WG_BAR();
        attn_block<2, 1>(p2, p3, tq3, 16, MIX, V, lds, vt, b, h, T0, tq2, 4, slope * 4.f, bound, false, lane);
        WG_BAR();
        attn_block<1, 1>(p3, p4, tq3 + 1, 16, MIX, V, lds, vt, b, h, T0, tq3, 16, slope * 16.f, bound, false, lane);
        attn_block<1, 0>(p4, p0, 0, 1, MIX, V, lds, vt, b, h, T0, tq3 + 1, 16, slope * 16.f, bound, false, lane);
        WG_BAR();
        { int lane3 = lane; asm volatile("" : "+v"(lane3)); const int tid = wave_ * 64 + lane3;
#pragma unroll
          for (int k = 0; k < 8; ++k) { const int item = tid + 512 * k, qi = item >> 3, c16 = item & 7;
              const v4u w = *(const LAS v4u*)(lds + ATT_O + qi * 128 + ((c16 ^ (qi & 7)) << 4)); const float il = __builtin_amdgcn_rcpf(((const LAS float*)(lds + ATT_L))[qi]);
              v4u o;
#pragma unroll
              for (int j = 0; j < 4; ++j) o[j] = cvtpk(__uint_as_float(w[j] << 16) * il, __uint_as_float(w[j] & 0xffff0000u) * il);
              *(v4u*)(MIX + ((size_t)b * SEQ + T0 + qi) * 1024 + h * HD + 8 * c16) = o; } }
        WG_BAR();
    }
}

constexpr int XLG_AS = 2064;
__device__ __forceinline__ void xl_minigemm(Frame& F) {
    unsigned char* const ws = kws();
    int lane_ = lane_id(); asm volatile("" : "+v"(lane_)); int wave_o = F.wv; asm volatile("" : "+s"(wave_o)); const int wave_ = wave_o, lane = lane_, hi = lane >> 5, l31 = lane & 31;
    const bf16* XBp = (const bf16*)(ws + R_XB); const bf16* W = (const bf16*)(ws + WS_WIN) + (size_t)3072 * 1024 + ((size_t)wave_ * 64 * 64 + lane) * 8;
    bf16* XL = (bf16*)(ws + R_XL); const float* ss = (const float*)(ws + WS_SS1);
    LAS unsigned char* const At = F.lds;
    for (int unit = F.vcu; unit < M / 64; unit += F.G) { const int r0 = unit * 64;
        bf16x8 wf[8], wn[8], wnn[8];
        { const int tid = wave_ * 64 + lane, row = tid >> 3, seg = tid & 7; const v4u* src = (const v4u*)(XBp + (size_t)(r0 + row) * 1024); LAS unsigned char* dst = At + row * XLG_AS;
          v4u av[16];
#pragma unroll
          for (int j = 0; j < 16; ++j) av[j] = src[seg + 8 * j];
#pragma unroll
          for (int k = 0; k < 8; ++k) { wf[k] = *(const bf16x8*)(W + 512 * k); wn[k] = *(const bf16x8*)(W + 512 * (8 + k)); }
          SBAR0();
#pragma unroll
          for (int j = 0; j < 16; ++j) *(LAS v4u*)(dst + (seg + 8 * j) * 16) = av[j]; }
        WG_BARL();
        f32x16 acc[2];
#pragma unroll
        for (int r = 0; r < 16; ++r) { acc[0][r] = 0.f; acc[1][r] = 0.f; }
#pragma unroll 1
        for (int kg = 0; kg < 8; ++kg) {
            if (kg < 6) {
#pragma unroll
                for (int k = 0; k < 8; ++k) wnn[k] = *(const bf16x8*)(W + 512 * (8 * (kg + 2) + k)); }
            bf16x8 af[2][8];
#pragma unroll
            for (int rt = 0; rt < 2; ++rt)
#pragma unroll
                for (int k = 0; k < 8; ++k) af[rt][k] = *(const LAS bf16x8*)(At + (32 * rt + l31) * XLG_AS + (16 * (8 * kg + k) + 8 * hi) * 2);
            SBAR0();
#pragma unroll
            for (int k = 0; k < 8; ++k) { acc[0] = MFMA32H(wf[k], af[0][k], acc[0]); acc[1] = MFMA32H(wf[k], af[1][k], acc[1]); }
#pragma unroll
            for (int k = 0; k < 8; ++k) { wf[k] = wn[k]; wn[k] = wnn[k]; }
        }
        const int lbase = 64 * (wave_ & 3) + 32 * (wave_ >> 2);
#pragma unroll
        for (int rt = 0; rt < 2; ++rt) { const int row = r0 + 32 * rt + l31; const float* sr = ss + (size_t)row * 16;
            const f32x4 s0 = *(const f32x4*)sr, s1 = *(const f32x4*)(sr + 4), s2 = *(const f32x4*)(sr + 8), s3 = *(const f32x4*)(sr + 12);
            const float sum = ((s0[0] + s0[1]) + (s0[2] + s0[3])) + ((s1[0] + s1[1]) + (s1[2] + s1[3])) + ((s2[0] + s2[1]) + (s2[2] + s2[3])) + ((s3[0] + s3[1]) + (s3[2] + s3[3]));
            const float rs = __builtin_amdgcn_rsqf(sum * (1.0f / 1024.0f) + 1e-6f);
#pragma unroll
            for (int q = 0; q < 4; ++q) { u32x2_t w; w.x = cvtpk(acc[rt][4 * q] * rs, acc[rt][4 * q + 1] * rs); w.y = cvtpk(acc[rt][4 * q + 2] * rs, acc[rt][4 * q + 3] * rs);
                *(u32x2_t*)(XL + (size_t)row * 256 + lbase + 8 * q + 4 * hi) = w; } }
        WG_BAR();
    }
}

__global__ void __launch_bounds__(NTHR, 2) mk_fwd(Args args) {
    extern __shared__ __attribute__((aligned(16))) unsigned char lds[];
    Frame F;
    F.lds = (LAS unsigned char*)lds;
    F.MISC = (volatile LAS unsigned*)(F.lds + MISC_OFF);
    F.wv = __builtin_amdgcn_readfirstlane((int)threadIdx.x >> 6);
    F.G = gridDim.x; { const int bx = blockIdx.x; F.vcu = (F.G % 8 == 0) ? (bx % 8) * (F.G / 8) + bx / 8 : bx; }
    F.ctl = (gu32*)(kws() + WS_CTL);
    for (int u = F.wv * 64 + lane_id(); u < (LDS_BYTES - LDSCTL_OFF) / 4; u += NTHR) ((LAS unsigned*)(F.lds + LDSCTL_OFF))[u] = 0u;
    __syncthreads();
    XcdBarrier bar = xcd_barrier_post((unsigned*)(F.ctl + CW_BAR), F.MISC + 8, F.wv == 0 && lane_id() == 0);
#define GRID_BAR() xcd_barrier(bar, F.wv == 0 && lane_id() == 0)
#define XB ((bf16*)(ws + R_XB))
#define MIXB ((bf16*)(ws + R_MIX))
#define HID ((bf16*)(ws + R_HID))
#define SS1 ((float*)(ws + WS_SS1))
#define SS2 ((float*)(ws + WS_SS2))

    for (int step = 0; step < 8 * DEPTH; ++step) {
        const int layer = step >> 3, kind = step & 7;
        if (kind == 0) {
            if (layer > 0) continue;
            x_prologue(F);
            { int lane_ = lane_id(); asm volatile("" : "+v"(lane_)); wconv_items(0, -1, F.vcu * NWAVES + F.wv, F.G * NWAVES, (LAS float*)(F.lds + RING_OFF + F.wv * 16384), lane_); }
        } else if (kind == 1) {
            unsigned char* const ws = kws();
            xl_minigemm(F);
            pg8::Gemm g{XB, (const bf16*)(ws + WS_WIN), M, NPROJ - 256, D}; pg8::StaticOrder S; S.init(M, NPROJ - 256, F.G, (int)blockIdx.x);
            pg8::EpiProj E; E.base0 = (bf16*)(ws + WS_R0); E.ss = SS1; E.qg = karg(I_QG) + layer * HD; E.kg = karg(I_KG) + layer * HD;
            pg8::gemm_phase<pg8::EpiProj, pg8::StaticOrder, true, true, true>(F.lds + RING_OFF, g, S, E, F.wv, lane_id());
        } else if (kind == 2) {
            rwkv_pre_phase(F, layer);
            pre_done_signal(bar, F.wv == 0 && lane_id() == 0);
            const int bx = (int)blockIdx.x;
            if (bx < 128) { pre_done_wait(bar, F.wv == 0 && lane_id() == 0, (unsigned)layer + 1u); if (F.wv == 0) rwkv_scan_chunk(F, bx);
                            else { int lane_ = lane_id(); asm volatile("" : "+v"(lane_)); wconv_items(layer + 1, layer, bx * 7 + F.wv - 1, 128 * 7, (LAS float*)(F.lds + SCAN_NS * SCAN_SLOT + (F.wv - 1) * 9216), lane_); } }
            else attn_phase_mfma(F, layer, bx - 128, BATCH * H * 8, F.G - 128);
        } else if (kind == 3) { continue;
        } else if (kind == 4) {
            rwkv_finalize_mfma(F, layer);
        } else if (kind == 5 || kind == 7) {
            unsigned char* const ws = kws(); float* const xo = (step == 8 * DEPTH - 1) ? kout() : nullptr;
            pg8::Gemm g{kind == 5 ? MIXB : HID, (const bf16*)(ws + (kind == 5 ? WS_WOUT : WS_WDN)), M, D, kind == 5 ? D : FF}; pg8::StaticOrder S; S.init(M, D, F.G, (int)blockIdx.x);
            pg8::EpiRes E{XB, xo, kind == 5 ? SS2 : SS1};
            pg8::gemm_phase<pg8::EpiRes, pg8::StaticOrder, false, true>(F.lds + RING_OFF, g, S, E, F.wv, lane_id());
        } else {
            unsigned char* const ws = kws();
            pg8::Gemm g{XB, (const bf16*)(ws + WS_WUP), M, FF, D}; pg8::StaticOrder S; S.init(M, FF, F.G, (int)blockIdx.x);
            pg8::EpiUp E{HID, SS2};
            pg8::gemm_phase<pg8::EpiUp, pg8::StaticOrder, true, true, true>(F.lds + RING_OFF, g, S, E, F.wv, lane_id());
        }
        if (step + 1 < 8 * DEPTH) GRID_BAR();
    }
}

extern "C" void kernel_launch(void* const* d_in, const int* in_sizes, int n_in, void* d_out, int out_size, void* d_ws, size_t ws_size, hipStream_t stream) {
    static int grid = 0;
    if (grid == 0) {
        if (n_in != N_IN || in_sizes[0] != M * D || out_size != M * D || ws_size < WS_END) { fprintf(stderr, "kernel_launch: unexpected shapes (n_in %d, in0 %d, out %d, ws %zu)\n", n_in, n_in > 0 ? in_sizes[0] : -1, out_size, ws_size); grid = -1; return; }
        int dev = 0, cus = 0;
        if (hipGetDevice(&dev) != hipSuccess || hipDeviceGetAttribute(&cus, hipDeviceAttributeMultiprocessorCount, dev) != hipSuccess) { grid = -1; return; }
        if (hipFuncSetAttribute((const void*)mk_fwd, hipFuncAttributeMaxDynamicSharedMemorySize, LDS_BYTES) != hipSuccess) { fprintf(stderr, "kernel_launch: hipFuncSetAttribute failed\n"); grid = -1; return; }
        int per_cu = 0;
        (void)hipOccupancyMaxActiveBlocksPerMultiprocessor(&per_cu, (const void*)mk_fwd, NTHR, LDS_BYTES);
        (void)hipGetLastError();
        if (cus != 256) { fprintf(stderr, "kernel_launch: the phase program is laid out for 256 CUs (found %d)\n", cus); grid = -1; return; }
        grid = cus;
    }
    if (grid < 0) return;
    (void)hipMemsetAsync((char*)d_ws + WS_CTL, 0, CTL_ZERO_BYTES, stream);
    Args a{};
    for (int i = 0; i < N_IN; ++i) a.in[i] = (const float*)d_in[i];
    a.out = (float*)d_out; a.ws = (unsigned char*)d_ws;
    hipLaunchKernelGGL(mk_fwd, dim3(grid), dim3(NTHR), LDS_BYTES, stream, a);
}
```

```cpp
#include <hip/hip_runtime.h>
#include <cstdio>
#include <cstdint>
namespace pg8 {
#define PG8_LAS __attribute__((address_space(3)))
typedef unsigned short bf16_t;
typedef short bf16x8 __attribute__((ext_vector_type(8)));
typedef float f32x4 __attribute__((ext_vector_type(4)));
typedef unsigned u32x4 __attribute__((ext_vector_type(4)));
constexpr int BM = 256, BK = 64, HALF = 128, HTB = HALF * BK * 2  , STAGE_BYTES = 8 * HTB, NXCD = 8, WGM = 8;

__host__ __device__ __forceinline__ int lds_byte(int r, int c) { const int st = (r >> 4) * 2 + (c >> 5), rr = r & 15, cc = c & 31, ob = rr * 64 + cc * 2; return st * 1024 + (ob ^ (((ob >> 9) & 1) << 5)); }
__host__ __device__ __forceinline__ void stage_rc(int b, int& R, int& C) { const int st = b / 1024, sb = b % 1024, swz = sb ^ (((sb >> 9) & 1) << 5); R = (st >> 1) * 16 + swz / 64; C = (st & 1) * 32 + (swz % 64) / 2; }
__host__ __device__ __forceinline__ int perm32(int rho) { const int n = rho >> 4, i = rho & 15; return 8 * (i >> 2) + 4 * n + (i & 3); }

struct Unit { int pm, pn; };
struct Gemm { const bf16_t* A; const bf16_t* Bt; int M, N, K; };

struct StaticOrder {
    int nM, nN, nwg, G, c;
    __host__ __device__ void init(int M, int N, int G_, int c_) { nM = M / BM; nN = N / BM; nwg = nM * nN; G = G_; c = c_; }
    __host__ __device__ bool next(int i, Unit& u) const {
        const long L = (long)i * G + c; if (L >= nwg) return false;
        int wgid = (int)L; { const int q = nwg / NXCD, r = nwg % NXCD, xcd = wgid % NXCD, off = wgid / NXCD; wgid = (xcd < r ? xcd * (q + 1) : r * (q + 1) + (xcd - r) * q) + off; }
        const int nig = WGM * nN, gid = wgid / nig, fm = gid * WGM, gsz = (nM - fm) < WGM ? (nM - fm) : WGM;
        u.pm = fm + ((wgid % nig) % gsz); u.pn = (wgid % nig) / gsz; return true;
    }
    __device__ __forceinline__ void a_ready(const Unit&) const {}
    __device__ __forceinline__ void done(const Unit&) const {}
};

__device__ __forceinline__ unsigned cvt_pk_bf16(float lo, float hi) { unsigned r; asm volatile("v_cvt_pk_bf16_f32 %0, %1, %2" : "=v"(r) : "v"(lo), "v"(hi)); return r; }
typedef unsigned u32x2 __attribute__((ext_vector_type(2)));
typedef float f32x2 __attribute__((ext_vector_type(2))); typedef _Float16 h16x2 __attribute__((ext_vector_type(2))); typedef _Float16 f16x8 __attribute__((ext_vector_type(8)));
__device__ __forceinline__ unsigned pkh(float lo, float hi) { f32x2 v = {lo, hi}; return __builtin_bit_cast(unsigned, __builtin_convertvector(v, h16x2)); }
__device__ __forceinline__ f32x2 unpkh(unsigned w) { return __builtin_convertvector(__builtin_bit_cast(h16x2, w), f32x2); }

__device__ __forceinline__ float shx(float v, int m, int lane) { return __int_as_float(__builtin_amdgcn_ds_bpermute((lane ^ m) << 2, __float_as_int(v))); }
__device__ __forceinline__ float row_rs(const float* ss, int row, int fq, int lane) {
    const f32x4 p = *(const f32x4*)(ss + (size_t)row * 16 + 4 * fq);
    float s = (p[0] + p[1]) + (p[2] + p[3]);
    s += shx(s, 16, lane); s += shx(s, 32, lane);
    return __builtin_amdgcn_rsqf(s * (1.0f / 1024.0f) + 1e-6f);
}

struct EpiProj {
    static constexpr bool PERM = true, AFTER_DRAIN = false, RS_LDS = true;
    bf16_t* base0; const float* ss; const float* qg; const float* kg;
    __device__ __forceinline__ void operator()(const f32x4 (&acc)[2][2][4][2], const Unit& u, int wr, int wc, int fr, int fq, const PG8_LAS float* rsl) const {
        const int tile = u.pn, di = tile >> 1;
        bf16_t* base = base0 + (di < 2 ? (size_t)di * 512 : (size_t)di * (8u << 20)); const int ldc = (di < 2) ? 1024 : ((di == 6) ? 256 : 512); const int cb = (di == 6) ? 0 : (tile & 1) * 256;
        const bool nrm = tile < 4; const float* gsrc = (tile < 2) ? qg : kg; const float post = (tile < 2) ? 0.125f * 1.4426950408889634f : 1.0f;
        f32x4 g[2][2];
#pragma unroll
        for (int bj = 0; bj < 2; ++bj)
#pragma unroll
            for (int n = 0; n < 2; ++n) g[bj][n] = nrm ? *(const f32x4*)(gsrc + 32 * bj + 8 * fq + 4 * n) * post : (f32x4){1.f, 1.f, 1.f, 1.f};
#pragma unroll
        for (int ai = 0; ai < 2; ++ai)
#pragma unroll
            for (int m = 0; m < 4; ++m) {
                const int row = u.pm * BM + ai * HALF + wr * 64 + m * 16 + fr;
                const float rs = rsl[ai * HALF + wr * 64 + m * 16 + fr];
                f32x4 v[2][2]; float q = 0.f;
#pragma unroll
                for (int bj = 0; bj < 2; ++bj)
#pragma unroll
                    for (int n = 0; n < 2; ++n) { v[bj][n] = acc[ai][bj][m][n] * rs; const f32x4 t = v[bj][n]; q += (t[0] * t[0] + t[1] * t[1]) + (t[2] * t[2] + t[3] * t[3]); }
                q += shx(q, 16, 16 * fq + fr); q += shx(q, 32, 16 * fq + fr);
                const float inv = nrm ? __builtin_amdgcn_rsqf(q * (1.0f / 64.0f) + 1e-6f) : 1.0f;
                bf16_t* rowp = base + (size_t)row * ldc + cb + 64 * wc + 8 * fq;
#pragma unroll
                for (int bj = 0; bj < 2; ++bj) { const f32x4 v0 = v[bj][0] * inv * g[bj][0], v1 = v[bj][1] * inv * g[bj][1];
                    u32x4 w; w.x = cvt_pk_bf16(v0[0], v0[1]); w.y = cvt_pk_bf16(v0[2], v0[3]); w.z = cvt_pk_bf16(v1[0], v1[1]); w.w = cvt_pk_bf16(v1[2], v1[3]);
                    *(u32x4*)(rowp + 32 * bj) = w; }
                asm volatile("" ::: "memory");
            }
    }
};
struct EpiUp {
    static constexpr bool PERM = true, AFTER_DRAIN = false, RS_LDS = true;
    bf16_t* O; const float* ss;
    __device__ __forceinline__ void operator()(const f32x4 (&acc)[2][2][4][2], const Unit& u, int wr, int wc, int fr, int fq, const PG8_LAS float* rsl) const {
#pragma unroll
        for (int ai = 0; ai < 2; ++ai)
#pragma unroll
            for (int m = 0; m < 4; ++m) {
                const int row = u.pm * BM + ai * HALF + wr * 64 + m * 16 + fr;
                const float rs = rsl[ai * HALF + wr * 64 + m * 16 + fr];
                bf16_t* rowp = O + (size_t)row * 4096 + u.pn * BM + wc * 32 + 8 * fq;
#pragma unroll
                for (int bj = 0; bj < 2; ++bj) { f32x4 v0 = acc[ai][bj][m][0] * rs, v1 = acc[ai][bj][m][1] * rs;
                    v0 = __builtin_elementwise_max(v0, (f32x4){0.f, 0.f, 0.f, 0.f}); v1 = __builtin_elementwise_max(v1, (f32x4){0.f, 0.f, 0.f, 0.f}); v0 = v0 * v0; v1 = v1 * v1;
                    u32x4 w; w.x = cvt_pk_bf16(v0[0], v0[1]); w.y = cvt_pk_bf16(v0[2], v0[3]); w.z = cvt_pk_bf16(v1[0], v1[1]); w.w = cvt_pk_bf16(v1[2], v1[3]);
                    *(u32x4*)(rowp + bj * HALF) = w; }
                asm volatile("" ::: "memory");
            }
    }
};
struct EpiRes {
    static constexpr bool PERM = true, AFTER_DRAIN = false, RS_LDS = false;
    bf16_t* xh; float* out; float* ss;
    __device__ __forceinline__ void operator()(const f32x4 (&acc)[2][2][4][2], const Unit& u, int wr, int wc, int fr, int fq) const {
        const int col0 = u.pn * BM + wc * 32 + 8 * fq;
#pragma unroll
        for (int ai = 0; ai < 2; ++ai) {
            u32x4 rawv[4][2];
#pragma unroll
            for (int m = 0; m < 4; ++m)
#pragma unroll
                for (int bj = 0; bj < 2; ++bj) rawv[m][bj] = *(const u32x4*)(xh + (size_t)(u.pm * BM + ai * HALF + wr * 64 + m * 16 + fr) * 1024 + col0 + bj * HALF);
#pragma unroll
            for (int m = 0; m < 4; ++m) {
                const int row = u.pm * BM + ai * HALF + wr * 64 + m * 16 + fr; const size_t off = (size_t)row * 1024 + col0; float q = 0.f;
#pragma unroll
                for (int bj = 0; bj < 2; ++bj) { const size_t o = off + bj * HALF; const u32x4 raw = rawv[m][bj];
                    const f32x2 a0 = unpkh(raw.x), a1 = unpkh(raw.y), a2 = unpkh(raw.z), a3 = unpkh(raw.w);
                    const f32x4 t0 = (f32x4){a0[0], a0[1], a1[0], a1[1]} + acc[ai][bj][m][0], t1 = (f32x4){a2[0], a2[1], a3[0], a3[1]} + acc[ai][bj][m][1];
                    if (out) { *(f32x4*)(out + o) = t0; *(f32x4*)(out + o + 4) = t1; }
                    else { u32x4 w; w.x = pkh(t0[0], t0[1]); w.y = pkh(t0[2], t0[3]); w.z = pkh(t1[0], t1[1]); w.w = pkh(t1[2], t1[3]); *(u32x4*)(xh + o) = w; }
                    q += ((t0[0] * t0[0] + t0[1] * t0[1]) + (t0[2] * t0[2] + t0[3] * t0[3])) + ((t1[0] * t1[0] + t1[1] * t1[1]) + (t1[2] * t1[2] + t1[3] * t1[3])); }
                q += shx(q, 16, 16 * fq + fr); q += shx(q, 32, 16 * fq + fr);
                if (fq == 0) ss[(size_t)row * 16 + 4 * u.pn + wc] = q;
            }
            asm volatile("" ::: "memory");
        }
    }
};

template <class Epi, class Sched, bool ALIGN_EPI = false, bool SP2 = false, bool F16 = false>
__device__ __forceinline__ void gemm_phase(PG8_LAS unsigned char* lds, const Gemm g, const Sched& S, const Epi& E, int wave_in, int lane_in) {
    int lane_o = lane_in, wave_o = wave_in; asm volatile("" : "+v"(lane_o)); asm volatile("" : "+s"(wave_o)); const int tid_ = wave_o * 64 + lane_o;
    const int tid = tid_, wid = wave_o, lane = lane_o, wr = wid >> 2, wc = wid & 3, fr = lane & 15, fq = lane >> 4;
    const int K = g.K, nt = K / BK;
    unsigned voffA[2], voffB[2];
#pragma unroll
    for (int i = 0; i < 2; ++i) { int R, C; stage_rc(tid * 16 + i * 8192, R, C); const int Rb = Epi::PERM ? ((R & ~31) + perm32(R & 31)) : R;
        voffA[i] = (unsigned)(R * K + C) * 2u; voffB[i] = (unsigned)(Rb * K + C) * 2u; }
    const size_t kstep = (size_t)(BK * 2);
    const size_t hstep = (size_t)HALF * K * 2;
    const size_t tstep = 2 * hstep;
    const unsigned ldsw = (unsigned)wid * 1024u;
    const int aoff = lds_byte(wr * 64 + fr, fq * 8), boff = lds_byte(wc * 32 + fr, fq * 8);
#define PG8_SA(b, h) (((b) * 2 + (h)) * HTB)
#define PG8_SB(b, h) ((4 + (b) * 2 + (h)) * HTB)
#define PG8_STAGE(bufoff, gbase, voff) do { _Pragma("unroll") for (int _i = 0; _i < 2; ++_i) \
        __builtin_amdgcn_global_load_lds((const unsigned*)((const char*)(gbase) + (voff)[_i]), (PG8_LAS unsigned*)(lds + (bufoff) + ldsw + _i * 8192), 16, 0, 0); } while (0)
#define PG8_LDA(dst, b, h) do { _Pragma("unroll") for (int m = 0; m < 4; ++m) _Pragma("unroll") for (int k = 0; k < 2; ++k) dst[m][k] = *(const PG8_LAS bf16x8*)(lds + PG8_SA(b, h) + aoff + m * 2048 + k * 1024); } while (0)
#define PG8_LDB(dst, b, h) do { _Pragma("unroll") for (int n = 0; n < 2; ++n) _Pragma("unroll") for (int k = 0; k < 2; ++k) dst[n][k] = *(const PG8_LAS bf16x8*)(lds + PG8_SB(b, h) + boff + n * 2048 + k * 1024); } while (0)
#define PG8_MMA(ai, bj, At, Bt) do { __builtin_amdgcn_s_setprio(1); _Pragma("unroll") for (int m = 0; m < 4; ++m) _Pragma("unroll") for (int n = 0; n < 2; ++n) _Pragma("unroll") for (int k = 0; k < 2; ++k) \
        { if constexpr (F16) acc[ai][bj][m][n] = __builtin_amdgcn_mfma_f32_16x16x32_f16(__builtin_bit_cast(f16x8, Bt[n][k]), __builtin_bit_cast(f16x8, At[m][k]), acc[ai][bj][m][n], 0, 0, 0); \
          else acc[ai][bj][m][n] = __builtin_amdgcn_mfma_f32_16x16x32_bf16(Bt[n][k], At[m][k], acc[ai][bj][m][n], 0, 0, 0); } __builtin_amdgcn_s_setprio(0); } while (0)
#define PG8_WAIT_V(n) asm volatile("s_waitcnt vmcnt(" #n ")" ::: "memory")
#define PG8_WAIT_L(n) asm volatile("s_waitcnt lgkmcnt(" #n ")" ::: "memory")
#define PG8_BAR __builtin_amdgcn_s_barrier()
#define PG8_SCHED __builtin_amdgcn_sched_barrier(0)
    Unit cur, nxt; int ui = 0;
    if (!S.next(0, cur)) return;
    f32x4 acc[2][2][4][2];
#pragma unroll
    for (int a = 0; a < 2; ++a)
#pragma unroll
        for (int b = 0; b < 2; ++b)
#pragma unroll
            for (int m = 0; m < 4; ++m)
#pragma unroll
                for (int n = 0; n < 2; ++n) acc[a][b][m][n] = (f32x4){0.f, 0.f, 0.f, 0.f};
    bf16x8 At[4][2], B0[2][2], B1[2][2];
    PG8_LAS float* const rsb = (PG8_LAS float*)(lds + STAGE_BYTES);
    f32x4 rq0, rq1;
#define PG8_RS_LOAD(pm_) do { const float* sp_ = E.ss + ((size_t)(pm_) * BM + (tid >> 1)) * 16 + 8 * (tid & 1); rq0 = *(const f32x4*)sp_; rq1 = *(const f32x4*)(sp_ + 4); } while (0)
#define PG8_RS_PUT(buf_) do { float sm_ = ((rq0[0] + rq0[1]) + (rq0[2] + rq0[3])) + ((rq1[0] + rq1[1]) + (rq1[2] + rq1[3])); sm_ += shx(sm_, 1, lane); \
        if ((tid & 1) == 0) rsb[(buf_) * BM + (tid >> 1)] = __builtin_amdgcn_rsqf(sm_ * (1.0f / 1024.0f) + 1e-6f); } while (0)
    if constexpr (Epi::RS_LDS) PG8_RS_LOAD(cur.pm);
    const char* cA = (const char*)g.A + (size_t)cur.pm * tstep; const char* cB = (const char*)g.Bt + (size_t)cur.pn * tstep;
    S.a_ready(cur);
    if constexpr (SP2) {
        PG8_STAGE(PG8_SB(0, 0), cB, voffB); PG8_STAGE(PG8_SB(0, 1), cB + hstep, voffB); PG8_STAGE(PG8_SA(0, 0), cA, voffA); PG8_STAGE(PG8_SA(0, 1), cA + hstep, voffA);
        if (wr == 1) PG8_BAR;
        PG8_WAIT_V(2); PG8_BAR;
        PG8_STAGE(PG8_SB(1, 0), cB + kstep, voffB); PG8_STAGE(PG8_SA(1, 0), cA + kstep, voffA); PG8_STAGE(PG8_SB(1, 1), cB + hstep + kstep, voffB);
        PG8_WAIT_V(6); PG8_BAR;
    } else {
        PG8_STAGE(PG8_SB(0, 0), cB, voffB); PG8_STAGE(PG8_SA(0, 0), cA, voffA); PG8_STAGE(PG8_SB(0, 1), cB + hstep, voffB); PG8_STAGE(PG8_SA(0, 1), cA + hstep, voffA);
        if (wr == 1) PG8_BAR;
        PG8_WAIT_V(4); PG8_BAR;
        PG8_STAGE(PG8_SB(1, 0), cB + kstep, voffB); PG8_STAGE(PG8_SA(1, 0), cA + kstep, voffA); PG8_STAGE(PG8_SB(1, 1), cB + hstep + kstep, voffB);
        PG8_WAIT_V(6); PG8_BAR;
    }
    if constexpr (Epi::RS_LDS) PG8_RS_PUT(0);
    for (;;) {
        const bool has_next = S.next(ui + 1, nxt);
        const char* nA = has_next ? (const char*)g.A + (size_t)nxt.pm * tstep : cA; const char* nB = has_next ? (const char*)g.Bt + (size_t)nxt.pn * tstep : cB;
        for (int t = 0; t < nt; t += 2) {
            const bool last = (t == nt - 2);
            const char* a1 = cA + (size_t)(t + 1) * kstep;
            const char* a2 = last ? nA : cA + (size_t)(t + 2) * kstep; const char* b2 = last ? nB : cB + (size_t)(t + 2) * kstep;
            const char* a3 = a2 + kstep; const char* b3 = b2 + kstep;
            if (last && has_next) S.a_ready(nxt);
            if constexpr (SP2) {
            PG8_LDB(B0, 0, 0); PG8_LDB(B1, 0, 1); PG8_SCHED; PG8_LDA(At, 0, 0); PG8_STAGE(PG8_SA(1, 1), a1 + hstep, voffA);
            PG8_WAIT_V(8); PG8_WAIT_L(0); PG8_BAR; PG8_MMA(0, 0, At, B0); PG8_MMA(0, 1, At, B1); PG8_BAR; PG8_SCHED;
            PG8_LDA(At, 0, 1); PG8_STAGE(PG8_SB(0, 0), b2, voffB); PG8_STAGE(PG8_SB(0, 1), b2 + hstep, voffB); PG8_STAGE(PG8_SA(0, 0), a2, voffA);
            PG8_WAIT_V(8); PG8_WAIT_L(0); PG8_BAR; PG8_MMA(1, 0, At, B0); PG8_MMA(1, 1, At, B1); PG8_BAR; PG8_SCHED;
            PG8_LDB(B0, 1, 0); PG8_LDB(B1, 1, 1); PG8_SCHED; PG8_LDA(At, 1, 0); PG8_STAGE(PG8_SA(0, 1), a2 + hstep, voffA);
            PG8_WAIT_V(8); PG8_WAIT_L(0); PG8_BAR; PG8_MMA(0, 0, At, B0); PG8_MMA(0, 1, At, B1); PG8_BAR; PG8_SCHED;
            PG8_LDA(At, 1, 1); PG8_STAGE(PG8_SB(1, 0), b3, voffB); PG8_STAGE(PG8_SB(1, 1), b3 + hstep, voffB); PG8_STAGE(PG8_SA(1, 0), a3, voffA);
            PG8_WAIT_V(8); PG8_WAIT_L(0); PG8_BAR; PG8_MMA(1, 0, At, B0); PG8_MMA(1, 1, At, B1); PG8_BAR; PG8_SCHED;
            } else {
            PG8_LDB(B0, 0, 0); PG8_SCHED; PG8_LDA(At, 0, 0); PG8_STAGE(PG8_SA(1, 1), a1 + hstep, voffA);
            PG8_WAIT_L(8); PG8_BAR; PG8_WAIT_L(0); PG8_MMA(0, 0, At, B0); PG8_BAR; PG8_SCHED;
            PG8_LDB(B1, 0, 1); PG8_STAGE(PG8_SB(0, 0), b2, voffB);
            PG8_BAR; PG8_WAIT_L(0); PG8_MMA(0, 1, At, B1); PG8_BAR;
            PG8_LDA(At, 0, 1); PG8_STAGE(PG8_SA(0, 0), a2, voffA);
            PG8_BAR; PG8_WAIT_L(0); PG8_MMA(1, 0, At, B0); PG8_BAR; PG8_SCHED;
            PG8_STAGE(PG8_SB(0, 1), b2 + hstep, voffB);
            PG8_WAIT_V(6); PG8_BAR; PG8_MMA(1, 1, At, B1); PG8_BAR;
            PG8_LDB(B0, 1, 0); PG8_SCHED; PG8_LDA(At, 1, 0); PG8_STAGE(PG8_SA(0, 1), a2 + hstep, voffA);
            PG8_WAIT_L(8); PG8_BAR; PG8_WAIT_L(0); PG8_MMA(0, 0, At, B0); PG8_BAR; PG8_SCHED;
            PG8_LDB(B1, 1, 1); PG8_STAGE(PG8_SB(1, 0), b3, voffB);
            PG8_BAR; PG8_WAIT_L(0); PG8_MMA(0, 1, At, B1); PG8_BAR;
            PG8_LDA(At, 1, 1); PG8_STAGE(PG8_SA(1, 0), a3, voffA);
            PG8_BAR; PG8_WAIT_L(0); PG8_MMA(1, 0, At, B0); PG8_BAR; PG8_SCHED;
            PG8_STAGE(PG8_SB(1, 1), b3 + hstep, voffB);
            PG8_WAIT_V(6); PG8_BAR; PG8_MMA(1, 1, At, B1); PG8_BAR;
            }
        }
        if constexpr (ALIGN_EPI) { if (wr == 0) PG8_BAR; }
        if constexpr (Epi::RS_LDS) { if (has_next) PG8_RS_LOAD(nxt.pm); E(acc, cur, wr, wc, fr, fq, rsb + (ui & 1) * BM); if (has_next) PG8_RS_PUT((ui + 1) & 1); S.done(cur); }
        else if constexpr (!Epi::AFTER_DRAIN) { E(acc, cur, wr, wc, fr, fq); S.done(cur); }
        if (!has_next) break;
#pragma unroll
        for (int a = 0; a < 2; ++a)
#pragma unroll
            for (int b = 0; b < 2; ++b)
#pragma unroll
                for (int m = 0; m < 4; ++m)
#pragma unroll
                    for (int n = 0; n < 2; ++n) acc[a][b][m][n] = (f32x4){0.f, 0.f, 0.f, 0.f};
        cur = nxt; cA = nA; cB = nB; ++ui;
        if constexpr (ALIGN_EPI) { if (wr == 1) PG8_BAR; }
    }
    PG8_WAIT_V(0);
    if constexpr (!ALIGN_EPI) { if (wr == 0) PG8_BAR; }
    PG8_BAR;
    if constexpr (Epi::AFTER_DRAIN) { E.fused(acc, cur, wr, wc, fr, fq, lds, wid, lane); S.done(cur); }
#undef PG8_RS_LOAD
#undef PG8_RS_PUT
#undef PG8_SA
#undef PG8_SB
#undef PG8_STAGE
#undef PG8_LDA
#undef PG8_LDB
#undef PG8_MMA
#undef PG8_WAIT_V
#undef PG8_WAIT_L
#undef PG8_BAR
#undef PG8_SCHED
}
}
constexpr int NWAVES = 8, NTHR = 512;
constexpr int BATCH = 4, SEQ = 4096, D = 1024, DEPTH = 4, H = 8, HD = 64, FF = 4096, NPROJ = 3328, RPROJ = 1792;
constexpr int M = BATCH * SEQ;
constexpr float GN_EPS = 64e-5f;
enum { I_X = 0, I_LN1, I_WIN, I_QG, I_KG, I_TSP, I_TSN, I_W0, I_W2, I_A0, I_A2, I_G2, I_KK, I_KA, I_RK, I_GNW, I_GNB, I_WOUT, I_LN2, I_WUP, I_WDN, N_IN };
constexpr size_t MiB = 1u << 20;
constexpr size_t WS_CTL = 0, CTL_ZERO_BYTES = 64 * 1024;
constexpr size_t WS_SS1 = 1 * MiB, WS_SS2 = 2 * MiB;
constexpr size_t WS_WIN = 3 * MiB, WS_WOUT = WS_WIN + (size_t)NPROJ * D * 2, WS_WUP = WS_WOUT + (size_t)D * D * 2, WS_WDN = WS_WUP + (size_t)FF * D * 2;
constexpr size_t WS_R0 = 28 * MiB;
constexpr size_t R_MIX = WS_R0 + 0 * MiB;
constexpr size_t R_V = WS_R0 + 32 * MiB;
constexpr size_t R_RR = WS_R0 + 48 * MiB, R_KR = WS_R0 + 64 * MiB, R_VR = WS_R0 + 80 * MiB, R_XL = WS_R0 + 96 * MiB;
constexpr size_t R_SD = R_RR;
constexpr size_t R_PRE = WS_R0 + 160 * MiB;
constexpr size_t R_HID = WS_R0;
constexpr size_t R_XB = WS_R0 + 128 * MiB;
constexpr size_t R_BN = WS_R0 + 232 * MiB;
constexpr size_t WS_END = WS_R0 + 233 * MiB;
constexpr size_t WS_LORA = WS_WDN + (size_t)D * FF * 2;
constexpr size_t WS_G2T = WS_LORA + 4 * 512 * 64 * 2;
static_assert(WS_G2T + 512 * 128 * 2 <= WS_R0, "lora");
constexpr int CW_BAR = 1024;
constexpr int RING_OFF = 0, RING_BYTES = 131072;
constexpr int LDSCTL_OFF = 155648, MISC_OFF = LDSCTL_OFF + 320;
constexpr int LDS_BYTES = 163840;
#define GAS __attribute__((address_space(1)))
#define LAS __attribute__((address_space(3)))
typedef unsigned short bf16;
typedef unsigned v4u __attribute__((ext_vector_type(4)));
typedef float f32x4 __attribute__((ext_vector_type(4)));
typedef short bf16x8 __attribute__((ext_vector_type(8)));
typedef GAS unsigned gu32;
typedef GAS unsigned long long gu64;
#define RLX_AGENT __ATOMIC_RELAXED, __HIP_MEMORY_SCOPE_AGENT
#define LDS_WAIT() asm volatile("s_waitcnt lgkmcnt(0)" ::: "memory")
#define VM_WAIT() asm volatile("s_waitcnt vmcnt(0)" ::: "memory")
__device__ __forceinline__ unsigned long long rt() { return __builtin_amdgcn_s_memrealtime(); }
__device__ __forceinline__ unsigned f2bf(float f) { unsigned u = __builtin_bit_cast(unsigned, f); return (u + 0x7fffu + ((u >> 16) & 1u)) >> 16; }
__device__ __forceinline__ unsigned pk2(float lo, float hi) { return f2bf(lo) | (f2bf(hi) << 16); }

#define XB_TMO      128
#define XB_XCNT(j)  (256  + 64 * (j))
#define XB_XSUB(j)  (1280 + 64 * (j))
#define XB_XGEN(j)  (2304 + 64 * (j))
#define XB_TOP      3328
#define XB_TOPGEN   3392
#define XCD_BAR_WORDS 3456
#define XB_PSUB(j)  (3520 + 64 * (j))
#define XB_PTOP     4608
#define XB_SPIN_CAP (1u << 18)

__device__ __forceinline__ unsigned xb_ld(unsigned* p)              { return __hip_atomic_load(p, __ATOMIC_RELAXED, __HIP_MEMORY_SCOPE_AGENT); }
__device__ __forceinline__ unsigned xb_add(unsigned* p, unsigned v) { return __hip_atomic_fetch_add(p, v, __ATOMIC_RELAXED, __HIP_MEMORY_SCOPE_AGENT); }
__device__ __forceinline__ unsigned xb_xcc_id() { return (unsigned)__builtin_amdgcn_s_getreg((3 << 11) | 20) & 0xFu; }
#define XB_SPIN(cond, bar) do { unsigned _sp = 0; while (cond) { __builtin_amdgcn_s_sleep(1); \
    if ((++_sp & 255u) == 0u) { if (xb_ld(&(bar)[XB_TMO])) break; if (_sp > XB_SPIN_CAP) { atomicAdd(&(bar)[XB_TMO], 1u); break; } } } } while (0)

struct XcdBarrier {
    unsigned* bar; unsigned x;
    volatile LAS unsigned* st;
};

__device__ __forceinline__ XcdBarrier xcd_barrier_post(unsigned* bar, volatile LAS unsigned* st, bool tid0) {
    XcdBarrier b; b.bar = bar; b.x = xb_xcc_id(); b.st = st;
    if (tid0) (void)xb_add(&bar[XB_XCNT(b.x)], 1u);
    return b;
}
__device__ __forceinline__ void xcd_barrier_complete(unsigned* bar, unsigned x, unsigned& nloc, unsigned& nx) {
    const unsigned G = gridDim.x * gridDim.y * gridDim.z;
    unsigned sum, cnt, mine, sp = 0u;
    for (;;) {
        sum = 0u; cnt = 0u; mine = 0u;
#pragma unroll
        for (unsigned j = 0; j < 16; ++j) { const unsigned c = xb_ld(&bar[XB_XCNT(j)]); sum += c; cnt += (c > 0u) ? 1u : 0u; mine = (j == x) ? c : mine; }
        if (sum == G) break;
        __builtin_amdgcn_s_sleep(1);
        if ((++sp & 255u) == 0u) { if (xb_ld(&bar[XB_TMO])) break; if (sp > XB_SPIN_CAP) { atomicAdd(&bar[XB_TMO], 1u); break; } }
    }
    nloc = mine > 0u ? mine : 1u; nx = cnt > 0u ? cnt : 1u;
}

__device__ __forceinline__ void xcd_barrier(const XcdBarrier& b, bool tid0) {
    asm volatile("s_waitcnt vmcnt(0)" ::: "memory");
    __syncthreads();
    if (tid0) {
        unsigned* bar = b.bar; asm volatile("" : "+v"(bar));
        __builtin_amdgcn_s_waitcnt(0);
        unsigned nloc = b.st[0], nx = b.st[1];
        if (nloc == 0u) { xcd_barrier_complete(bar, b.x, nloc, nx); b.st[0] = nloc; b.st[1] = nx; }
        const unsigned old = xb_add(&bar[XB_XSUB(b.x)], 1u);
        const unsigned gen = old / nloc;
        if (old + 1u == (gen + 1u) * nloc) {
            __builtin_amdgcn_fence(__ATOMIC_RELEASE, "agent");
            asm volatile("s_waitcnt vmcnt(0)" ::: "memory");
            const unsigned og = xb_add(&bar[XB_TOP], 1u);
            const unsigned tg = og / nx;
            if (og + 1u == (tg + 1u) * nx) xb_add(&bar[XB_TOPGEN], 1u);
            else XB_SPIN(xb_ld(&bar[XB_TOPGEN]) == tg, bar);
            __builtin_amdgcn_fence(__ATOMIC_ACQUIRE, "agent");
            xb_add(&bar[XB_XGEN(b.x)], 1u);
            asm volatile("s_waitcnt vmcnt(0)" ::: "memory");
        } else {
            XB_SPIN(xb_ld(&bar[XB_XGEN(b.x)]) == gen, bar);
            __builtin_amdgcn_fence(__ATOMIC_ACQUIRE, "agent");
            asm volatile("s_waitcnt vmcnt(0)" ::: "memory");
        }
    }
    __syncthreads();
}
__device__ __forceinline__ void pre_done_signal(const XcdBarrier& b, bool tid0) {
    asm volatile("s_waitcnt vmcnt(0)" ::: "memory");
    __syncthreads();
    if (tid0) {
        unsigned* bar = b.bar; asm volatile("" : "+v"(bar));
        __builtin_amdgcn_s_waitcnt(0);
        const unsigned nloc = b.st[0];
        const unsigned old = xb_add(&bar[XB_PSUB(b.x)], 1u);
        if ((old + 1u) % nloc == 0u) {
            __builtin_amdgcn_fence(__ATOMIC_RELEASE, "agent");
            asm volatile("s_waitcnt vmcnt(0)" ::: "memory");
            xb_add(&bar[XB_PTOP], 1u);
        }
    }
}
__device__ __forceinline__ void pre_done_wait(const XcdBarrier& b, bool tid0, unsigned layer1) {
    if (tid0) {
        unsigned* bar = b.bar; asm volatile("" : "+v"(bar));
        const unsigned want = b.st[1] * layer1;
        XB_SPIN(xb_ld(&bar[XB_PTOP]) < want, bar);
        __builtin_amdgcn_fence(__ATOMIC_ACQUIRE, "agent");
        asm volatile("s_waitcnt vmcnt(0)" ::: "memory");
    }
    __syncthreads();
}
__device__ __forceinline__ float bf2f(bf16 v) { return __uint_as_float(((unsigned)v) << 16); }
__device__ __forceinline__ bf16 f2bf_s(float f) { return (bf16)f2bf(f); }
__device__ __forceinline__ float wave_sum(float v, int lane) {
#pragma unroll
    for (int o = 1; o < 64; o <<= 1) v += pg8::shx(v, o, lane);
    return v;
}
__device__ __forceinline__ float sigmoidf_(float z) { return __builtin_amdgcn_rcpf(1.0f + __expf(-z)); }
__device__ __forceinline__ float tanh_fast(float x) { return 1.0f - 2.0f * __builtin_amdgcn_rcpf(__expf(2.0f * x) + 1.0f); }

struct Args { const float* in[N_IN]; float* out; unsigned char* ws; };
typedef const __attribute__((address_space(4))) Args CArgs;
__device__ __forceinline__ const CArgs* kargs() { const CArgs* p = (const CArgs*)__builtin_amdgcn_kernarg_segment_ptr(); asm volatile("" : "+s"(p)); return p; }
__device__ __forceinline__ unsigned char* kws() { return kargs()->ws; }
__device__ __forceinline__ float* kout() { return kargs()->out; }
__device__ __forceinline__ const float* karg(int i) { return kargs()->in[i]; }
__device__ __forceinline__ int lane_id() { int l; asm volatile("v_mbcnt_lo_u32_b32 %0, -1, 0\n\tv_mbcnt_hi_u32_b32 %0, -1, %0" : "=v"(l)); return l; }
__device__ __forceinline__ bf16* pre_item(unsigned char* ws, int item) { return (item < 2048) ? (bf16*)(ws + R_PRE) + (size_t)item * 16384 : (bf16*)kout() + (size_t)(item - 2048) * 16384; }
struct Frame {
    LAS unsigned char* lds;
    volatile LAS unsigned* MISC;
    gu32* ctl;
    int vcu, G, wv;
};

__device__ __forceinline__ float ushift(const bf16* buf, int ldc, int col, int row, int t, float sp, float sn) {
    const bf16* p = buf + (size_t)row * ldc + col;
    const float u0 = bf2f(p[0]);
    const float up = (t > 0) ? bf2f(p[-ldc]) : 0.f;
    const float un = (t < SEQ - 1) ? bf2f(p[ldc]) : 0.f;
    return u0 + sp * (up - u0) + sn * (un - u0);
}

__device__ __forceinline__ float rbf(float x) { return __uint_as_float(f2bf(x) << 16); }
__device__ __forceinline__ unsigned pkw(bool f16, float lo, float hi) { return f16 ? pg8::pkh(rbf(lo), rbf(hi)) : pk2(lo, hi); }
__device__ __forceinline__ void transpose_item(const float* W, int K, int N, bf16* WT, const float* gain, bool headperm, LAS float* scr, int item, int lane, bool f16 = false, int fragbase = -1) {
    const int nblk = N / 32, kb = item / nblk, nb = item % nblk, k0 = 64 * kb, n0 = 32 * nb;
    { const int r = lane >> 3, c4 = lane & 7;
      f32x4 v[8];
#pragma unroll
      for (int i = 0; i < 8; ++i) v[i] = *(const f32x4*)(W + (size_t)(k0 + 8 * i + r) * N + n0 + 4 * c4);
#pragma unroll
      for (int i = 0; i < 8; ++i) { f32x4 w = v[i]; if (gain) w = w * gain[k0 + 8 * i + r]; *(LAS f32x4*)(scr + (8 * i + r) * 36 + 4 * c4) = w; } }
    LDS_WAIT(); asm volatile("" ::: "memory");
    const int c = lane & 7;
    const int p0 = headperm ? ((n0 & ~255) + 128 * ((n0 >> 5) & 1) + 32 * ((n0 >> 6) & 3)) : n0;
#pragma unroll
    for (int j = 0; j < 4; ++j) { const int n = (lane >> 3) + 8 * j; const LAS float* s = scr + (8 * c) * 36 + n;
        v4u o; o.x = pkw(f16, s[0 * 36], s[1 * 36]); o.y = pkw(f16, s[2 * 36], s[3 * 36]); o.z = pkw(f16, s[4 * 36], s[5 * 36]); o.w = pkw(f16, s[6 * 36], s[7 * 36]);
        if (fragbase >= 0 && p0 >= fragbase) *(GAS v4u*)(WT + (size_t)fragbase * K + ((size_t)(((p0 - fragbase) >> 5) * (K >> 4) + (k0 >> 4) + (c >> 1)) * 64 + 32 * (c & 1) + n) * 8) = o;
        else *(GAS v4u*)(WT + (size_t)(p0 + n) * K + k0 + 8 * c) = o; }
    LDS_WAIT(); asm volatile("" ::: "memory");
}
struct WcDesc { const float* W; bf16* WT; const float* gain; int K, N, item, fragbase; bool headperm, f16; };
__device__ __forceinline__ WcDesc wc_decode(int it, int nA, int layerA, int layerB) {
    unsigned char* const ws = kws();
    constexpr int I_1 = (D / 64) * (NPROJ / 32), I_2 = (D / 64) * (D / 32), I_3 = (D / 64) * (FF / 32), I_4 = (FF / 64) * (D / 32);
    WcDesc d; d.gain = nullptr; d.headperm = false; d.f16 = false; d.fragbase = -1;
    int r = it;
    if (r < nA) { const int layer = layerA;
        if (r < I_1) { d.W = karg(I_WIN) + (size_t)layer * D * NPROJ; d.K = D; d.N = NPROJ; d.WT = (bf16*)(ws + WS_WIN); d.gain = karg(I_LN1) + layer * D; d.headperm = true; d.item = r; d.f16 = true; d.fragbase = 3072; return d; }
        r -= I_1; const int mat = r >> 4;
        d.W = (mat < 2 ? karg(I_W2) : karg(I_A2)) + (size_t)(layer * 2 + (mat & 1)) * 64 * 512; d.K = 64; d.N = 512; d.WT = (bf16*)(ws + WS_LORA) + (size_t)mat * 512 * 64; d.item = r & 15; d.fragbase = 0; return d; }
    r -= nA; const int layer = layerB;
    if (r < I_2) { d.W = karg(I_WOUT) + (size_t)layer * D * D; d.K = D; d.N = D; d.WT = (bf16*)(ws + WS_WOUT); d.item = r; return d; } r -= I_2;
    if (r < I_3) { d.W = karg(I_WUP) + (size_t)layer * D * FF; d.K = D; d.N = FF; d.WT = (bf16*)(ws + WS_WUP); d.gain = karg(I_LN2) + layer * D; d.item = r; d.f16 = true; return d; } r -= I_3;
    if (r < I_4) { d.W = karg(I_WDN) + (size_t)layer * FF * D; d.K = FF; d.N = D; d.WT = (bf16*)(ws + WS_WDN); d.item = r; return d; } r -= I_4;
    d.W = karg(I_G2) + (size_t)layer * 128 * 512; d.K = 128; d.N = 512; d.WT = (bf16*)(ws + WS_G2T); d.item = r; d.fragbase = 0; return d;
}
__device__ __forceinline__ void wc_load(const WcDesc& d, int lane, f32x4 (&v)[8], float (&g)[8]) {
    const int nblk = d.N / 32, kb = d.item / nblk, nb = d.item % nblk, k0 = 64 * kb, n0 = 32 * nb, r = lane >> 3, c4 = lane & 7;
#pragma unroll
    for (int i = 0; i < 8; ++i) v[i] = __builtin_nontemporal_load((const f32x4*)(d.W + (size_t)(k0 + 8 * i + r) * d.N + n0 + 4 * c4));
#pragma unroll
    for (int i = 0; i < 8; ++i) g[i] = d.gain ? d.gain[k0 + 8 * i + r] : 1.0f;
}
__device__ __forceinline__ void wc_finish(const WcDesc& d, LAS float* scr, int lane, const f32x4 (&v)[8], const float (&g)[8]) {
    const int K = d.K, nblk = d.N / 32, kb = d.item / nblk, nb = d.item % nblk, k0 = 64 * kb, n0 = 32 * nb;
    { const int r = lane >> 3, c4 = lane & 7;
#pragma unroll
      for (int i = 0; i < 8; ++i) *(LAS f32x4*)(scr + (8 * i + r) * 36 + 4 * c4) = v[i] * g[i]; }
    LDS_WAIT(); asm volatile("" ::: "memory");
    const int c = lane & 7; const bool f16 = d.f16; const int fragbase = d.fragbase; bf16* const WT = d.WT;
    const int p0 = d.headperm ? ((n0 & ~255) + 128 * ((n0 >> 5) & 1) + 32 * ((n0 >> 6) & 3)) : n0;
#pragma unroll
    for (int j = 0; j < 4; ++j) { const int n = (lane >> 3) + 8 * j; const LAS float* s = scr + (8 * c) * 36 + n;
        v4u o; o.x = pkw(f16, s[0 * 36], s[1 * 36]); o.y = pkw(f16, s[2 * 36], s[3 * 36]); o.z = pkw(f16, s[4 * 36], s[5 * 36]); o.w = pkw(f16, s[6 * 36], s[7 * 36]);
        if (fragbase >= 0 && p0 >= fragbase) *(GAS v4u*)(WT + (size_t)fragbase * K + ((size_t)(((p0 - fragbase) >> 5) * (K >> 4) + (k0 >> 4) + (c >> 1)) * 64 + 32 * (c & 1) + n) * 8) = o;
        else *(GAS v4u*)(WT + (size_t)(p0 + n) * K + k0 + 8 * c) = o; }
    LDS_WAIT(); asm volatile("" ::: "memory");
}
__device__ __forceinline__ void wconv_items(int layerA, int layerB, int wi, int nw, LAS float* scr, int lane_) {
    constexpr int I_1 = (D / 64) * (NPROJ / 32), I_2 = (D / 64) * (D / 32), I_3 = (D / 64) * (FF / 32), I_4 = (FF / 64) * (D / 32);
    constexpr int NA = I_1 + 64, NB = I_2 + I_3 + I_4 + 32;
    const int nA = (layerA >= 0 && layerA < DEPTH) ? NA : 0, nB = (layerB >= 0) ? NB : 0, total = nA + nB;
    if (wi >= total) return;
    WcDesc d0 = wc_decode(wi, nA, layerA, layerB); f32x4 v[8]; float g[8];
    wc_load(d0, lane_, v, g);
#pragma unroll 1
    for (int it = wi; it < total; it += nw) {
        const bool has = it + nw < total; WcDesc d1 = d0; f32x4 vn[8]; float gn[8];
        if (has) { d1 = wc_decode(it + nw, nA, layerA, layerB); wc_load(d1, lane_, vn, gn); }
        wc_finish(d0, scr, lane_, v, g);
        if (has) { d0 = d1;
#pragma unroll
            for (int i = 0; i < 8; ++i) { v[i] = vn[i]; g[i] = gn[i]; } }
    }
}
__device__ __forceinline__ void x_prologue(Frame& F) {
    unsigned char* const ws = kws();
    int lane_ = lane_id(); asm volatile("" : "+v"(lane_)); int wave_o = F.wv; asm volatile("" : "+s"(wave_o)); const int wave_ = wave_o, tid_ = wave_ * 64 + lane_;
    const int gw = F.vcu * NWAVES + wave_, NGW = F.G * NWAVES;
    const float* x = karg(I_X); bf16* xb = (bf16*)(ws + R_XB); float* ss = (float*)(ws + WS_SS1);
    for (int m0 = gw; m0 < M; m0 += 4 * NGW) {
        f32x4 v[4][4];
#pragma unroll
        for (int r = 0; r < 4; ++r) { const int m = m0 + r * NGW; if (m < M) { const GAS f32x4* xr = (const GAS f32x4*)(x + (size_t)m * D) + lane_;
#pragma unroll
            for (int j = 0; j < 4; ++j) v[r][j] = __builtin_nontemporal_load((const f32x4*)&xr[64 * j]); } }
#pragma unroll
        for (int r = 0; r < 4; ++r) { const int m = m0 + r * NGW; if (m < M) { GAS unsigned long long* o8 = (GAS unsigned long long*)(xb + (size_t)m * D) + lane_; float s = 0.f;
#pragma unroll
            for (int j = 0; j < 4; ++j) { const f32x4 w = v[r][j]; s += (w.x * w.x + w.y * w.y) + (w.z * w.z + w.w * w.w);
                o8[64 * j] = (unsigned long long)pg8::pkh(w.x, w.y) | ((unsigned long long)pg8::pkh(w.z, w.w) << 32); }
            s = wave_sum(s, lane_);
            if (lane_ < 16) ss[(size_t)m * 16 + lane_] = (lane_ == 0) ? s : 0.f; } }
    }
}

typedef float f32x16 __attribute__((ext_vector_type(16)));
typedef short s16x4 __attribute__((ext_vector_type(4)));
typedef short v4i16_t __attribute__((ext_vector_type(4)));
typedef unsigned u32x2_t __attribute__((ext_vector_type(2)));
typedef float f32x2_t __attribute__((ext_vector_type(2))); typedef __bf16 bf16x2_t __attribute__((ext_vector_type(2)));
__device__ __forceinline__ unsigned cvtpk(float lo, float hi) { f32x2_t v = {lo, hi}; bf16x2_t b = __builtin_convertvector(v, bf16x2_t); return __builtin_bit_cast(unsigned, b); }
typedef _Float16 h16x2_t __attribute__((ext_vector_type(2))); typedef _Float16 h16x8 __attribute__((ext_vector_type(8)));
__device__ __forceinline__ unsigned cvtpk_h(float lo, float hi) { f32x2_t v = {lo, hi}; h16x2_t b = __builtin_convertvector(v, h16x2_t); return __builtin_bit_cast(unsigned, b); }
__device__ __forceinline__ f32x2_t unpk_h(unsigned w) { return __builtin_convertvector(__builtin_bit_cast(h16x2_t, w), f32x2_t); }
#define MFMA32H(nf, mf, acc) __builtin_amdgcn_mfma_f32_32x32x16_f16(__builtin_bit_cast(h16x8, (nf)), __builtin_bit_cast(h16x8, (mf)), (acc), 0, 0, 0)
constexpr int TSB = 144, TILE_B = 64 * TSB;
constexpr int PRE_TW = 14 * TILE_B, PRE_XA = 15 * TILE_B, PRE_INVN = 16 * TILE_B, PRE_GC = PRE_INVN + 256, PRE_BON = PRE_GC + 512, PRE_LDS_END = PRE_BON + 1024;
static_assert(PRE_LDS_END <= LDSCTL_OFF, "PRE LDS map");
__device__ __forceinline__ bf16x8 frag_row(const LAS unsigned char* tile, int row, int ks, int hi) {
    return *(const LAS bf16x8*)(tile + row * TSB + (16 * ks + 8 * hi) * 2);
}
__device__ __forceinline__ s16x4 tr4(const LAS unsigned char* p) { return __builtin_bit_cast(s16x4, __builtin_amdgcn_ds_read_tr16_b64_v4i16((LAS v4i16_t*)p)); }
__device__ __forceinline__ bf16x8 frag_tr(const LAS unsigned char* tile, int idx0, int ks, int lane) {
    const int hi = lane >> 5, g1 = (lane >> 4) & 1, i = lane & 15;
    const LAS unsigned char* p = tile + (16 * ks + 8 * hi + (i >> 2)) * TSB + (idx0 + 16 * g1 + 4 * (i & 3)) * 2;
    const s16x4 lo = tr4(p), h4 = tr4(p + 4 * TSB);
    return (bf16x8){lo[0], lo[1], lo[2], lo[3], h4[0], h4[1], h4[2], h4[3]};
}
__device__ __forceinline__ void store_quad(LAS unsigned char* tile, int row, int n0, int hi, const f32x16& a) {
#pragma unroll
    for (int q = 0; q < 4; ++q) { u32x2_t w; w.x = cvtpk(a[4 * q], a[4 * q + 1]); w.y = cvtpk(a[4 * q + 2], a[4 * q + 3]); *(LAS u32x2_t*)(tile + row * TSB + (n0 + 8 * q + 4 * hi) * 2) = w; }
}
__device__ __forceinline__ void store_quad_h(LAS unsigned char* tile, int row, int n0, int hi, const f32x16& a) {
#pragma unroll
    for (int q = 0; q < 4; ++q) { u32x2_t w; w.x = cvtpk_h(a[4 * q], a[4 * q + 1]); w.y = cvtpk_h(a[4 * q + 2], a[4 * q + 3]); *(LAS u32x2_t*)(tile + row * TSB + (n0 + 8 * q + 4 * hi) * 2) = w; }
}
__device__ __forceinline__ f32x16 load_quad(const LAS unsigned char* tile, int row, int n0, int hi) {
    f32x16 a;
#pragma unroll
    for (int q = 0; q < 4; ++q) { const u32x2_t w = *(const LAS u32x2_t*)(tile + row * TSB + (n0 + 8 * q + 4 * hi) * 2);
        a[4 * q] = __uint_as_float(w.x << 16); a[4 * q + 1] = __uint_as_float(w.x & 0xffff0000u); a[4 * q + 2] = __uint_as_float(w.y << 16); a[4 * q + 3] = __uint_as_float(w.y & 0xffff0000u); }
    return a;
}
#define MFMA32(nf, mf, acc) __builtin_amdgcn_mfma_f32_32x32x16_bf16((nf), (mf), (acc), 0, 0, 0)
#define LD4_ROW(dst, tile, row) _Pragma("unroll") for (int ks_ = 0; ks_ < 4; ++ks_) dst[ks_] = frag_row(tile, row, ks_, hi)
#define LD4_TR(dst, tile, idx0) _Pragma("unroll") for (int ks_ = 0; ks_ < 4; ++ks_) dst[ks_] = frag_tr(tile, idx0, ks_, lane)
#define SBAR0() __builtin_amdgcn_sched_barrier(0)
#define WG_BARL() do { asm volatile("s_waitcnt lgkmcnt(0)" ::: "memory"); __builtin_amdgcn_s_barrier(); asm volatile("" ::: "memory"); } while (0)
#define WG_BAR() do { asm volatile("s_waitcnt vmcnt(0) lgkmcnt(0)" ::: "memory"); __builtin_amdgcn_s_barrier(); asm volatile("" ::: "memory"); } while (0)
__device__ __forceinline__ void shift8(const bf16* buf, int ldc, int col, int row, int t, const float* sp, const float* sn, float (&out)[8]) {
    const bf16* p = buf + (size_t)row * ldc + col;
    const v4u c = *(const v4u*)p; v4u pv = (v4u){0u, 0u, 0u, 0u}, nv = (v4u){0u, 0u, 0u, 0u};
    if (t > 0) pv = *(const v4u*)(p - ldc);
    if (t < SEQ - 1) nv = *(const v4u*)(p + ldc);
    const f32x4 sp0 = *(const f32x4*)sp, sp1 = *(const f32x4*)(sp + 4), sn0 = *(const f32x4*)sn, sn1 = *(const f32x4*)(sn + 4);
#pragma unroll
    for (int j = 0; j < 8; ++j) { const unsigned cw = c[j >> 1], pw = pv[j >> 1], nw = nv[j >> 1];
        const float u0 = (j & 1) ? __uint_as_float(cw & 0xffff0000u) : __uint_as_float(cw << 16), up = (j & 1) ? __uint_as_float(pw & 0xffff0000u) : __uint_as_float(pw << 16), un = (j & 1) ? __uint_as_float(nw & 0xffff0000u) : __uint_as_float(nw << 16);
        const float a = (j < 4) ? sp0[j & 3] : sp1[j & 3], bq = (j < 4) ? sn0[j & 3] : sn1[j & 3];
        out[j] = u0 + a * (up - u0) + bq * (un - u0); }
}
__device__ __forceinline__ f32x4 shift4(const bf16* buf, int ldc, int col, int row, int t, const float* sp, const float* sn) {
    const bf16* p = buf + (size_t)row * ldc + col;
    const u32x2_t c = *(const u32x2_t*)p; u32x2_t pv = (u32x2_t){0u, 0u}, nv = (u32x2_t){0u, 0u};
    if (t > 0) pv = *(const u32x2_t*)(p - ldc);
    if (t < SEQ - 1) nv = *(const u32x2_t*)(p + ldc);
    const f32x4 a = *(const f32x4*)sp, bq = *(const f32x4*)sn;
    const f32x4 u0 = (f32x4){__uint_as_float(c.x << 16), __uint_as_float(c.x & 0xffff0000u), __uint_as_float(c.y << 16), __uint_as_float(c.y & 0xffff0000u)};
    const f32x4 up = (f32x4){__uint_as_float(pv.x << 16), __uint_as_float(pv.x & 0xffff0000u), __uint_as_float(pv.y << 16), __uint_as_float(pv.y & 0xffff0000u)};
    const f32x4 un = (f32x4){__uint_as_float(nv.x << 16), __uint_as_float(nv.x & 0xffff0000u), __uint_as_float(nv.y << 16), __uint_as_float(nv.y & 0xffff0000u)};
    return u0 + a * (up - u0) + bq * (un - u0);
}

struct R16 { v4u c, p, n; };
struct R8 { u32x2_t c, p, n; };
__device__ __forceinline__ R16 ld3x16(const bf16* buf, int ldc, int col, int row, int t) {
    const bf16* q = buf + (size_t)row * ldc + col; R16 r; r.c = *(const v4u*)q; r.p = (v4u){0u, 0u, 0u, 0u}; r.n = (v4u){0u, 0u, 0u, 0u};
    if (t > 0) r.p = *(const v4u*)(q - ldc);
    if (t < SEQ - 1) r.n = *(const v4u*)(q + ldc);
    return r;
}
__device__ __forceinline__ R8 ld3x8(const bf16* buf, int ldc, int col, int row, int t) {
    const bf16* q = buf + (size_t)row * ldc + col; R8 r; r.c = *(const u32x2_t*)q; r.p = (u32x2_t){0u, 0u}; r.n = (u32x2_t){0u, 0u};
    if (t > 0) r.p = *(const u32x2_t*)(q - ldc);
    if (t < SEQ - 1) r.n = *(const u32x2_t*)(q + ldc);
    return r;
}
__device__ __forceinline__ void sh8(const R16& r, const LAS float* sp, const LAS float* sn, float (&out)[8]) {
    const f32x4 sp0 = *(const LAS f32x4*)sp, sp1 = *(const LAS f32x4*)(sp + 4), sn0 = *(const LAS f32x4*)sn, sn1 = *(const LAS f32x4*)(sn + 4);
#pragma unroll
    for (int j = 0; j < 8; ++j) { const unsigned cw = r.c[j >> 1], pw = r.p[j >> 1], nw = r.n[j >> 1];
        const float u0 = (j & 1) ? __uint_as_float(cw & 0xffff0000u) : __uint_as_float(cw << 16), up = (j & 1) ? __uint_as_float(pw & 0xffff0000u) : __uint_as_float(pw << 16), un = (j & 1) ? __uint_as_float(nw & 0xffff0000u) : __uint_as_float(nw << 16);
        const float a = (j < 4) ? sp0[j & 3] : sp1[j & 3], bq = (j < 4) ? sn0[j & 3] : sn1[j & 3];
        out[j] = u0 + a * (up - u0) + bq * (un - u0); }
}
__device__ __forceinline__ f32x4 sh4(const R8& r, const f32x4 a, const f32x4 bq) {
    const f32x4 u0 = (f32x4){__uint_as_float(r.c.x << 16), __uint_as_float(r.c.x & 0xffff0000u), __uint_as_float(r.c.y << 16), __uint_as_float(r.c.y & 0xffff0000u)};
    const f32x4 up = (f32x4){__uint_as_float(r.p.x << 16), __uint_as_float(r.p.x & 0xffff0000u), __uint_as_float(r.p.y << 16), __uint_as_float(r.p.y & 0xffff0000u)};
    const f32x4 un = (f32x4){__uint_as_float(r.n.x << 16), __uint_as_float(r.n.x & 0xffff0000u), __uint_as_float(r.n.y << 16), __uint_as_float(r.n.y & 0xffff0000u)};
    return u0 + a * (up - u0) + bq * (un - u0);
}
constexpr int PRE_CT = PRE_LDS_END;
enum { CT_KK = 0, CT_KA = 64, CT_RK = 128, CT_W0 = 192  , CT_A0 = 320  , CT_SPR = 448, CT_SNR = 512, CT_SPK = 576, CT_SNK = 640, CT_SPV = 704, CT_SNV = 768, CT_SPX = 832  , CT_SNX = 960  , CT_N = 1088 };
static_assert(PRE_CT + CT_N * 4 <= LDSCTL_OFF, "PRE constant table");
__device__ __forceinline__ void rwkv_pre_phase(Frame& F, int layer) {
    unsigned char* const ws = kws();
    int lane_ = lane_id(); asm volatile("" : "+v"(lane_)); int wave_o = F.wv; asm volatile("" : "+s"(wave_o)); const int wave_ = wave_o;
    const int d = wave_ >> 2, qm = (wave_ >> 1) & 1, qn = wave_ & 1, m0 = 32 * qm, n0 = 32 * qn;
#define LANE_VARS int lane = lane_; asm volatile("" : "+v"(lane)); const int hi = lane >> 5, l31 = lane & 31, mrow = m0 + l31; (void)hi; (void)l31; (void)mrow;
    LAS unsigned char* const L = F.lds;
    LAS unsigned char* const T0 = L + (d * 7 + 0) * TILE_B; LAS unsigned char* const T1 = L + (d * 7 + 1) * TILE_B; LAS unsigned char* const T2 = L + (d * 7 + 2) * TILE_B; LAS unsigned char* const T3 = L + (d * 7 + 3) * TILE_B;
    LAS unsigned char* const T4 = L + (d * 7 + 4) * TILE_B; LAS unsigned char* const T5 = L + (d * 7 + 5) * TILE_B; LAS unsigned char* const T6 = L + (d * 7 + 6) * TILE_B;
    LAS unsigned char* const TWt = L + PRE_TW; LAS unsigned char* const XAt = L + PRE_XA;
    LAS float* const invn = (LAS float*)(L + PRE_INVN); LAS float* const gcs = (LAS float*)(L + PRE_GC) + d * 64; LAS float* const bon = (LAS float*)(L + PRE_BON); LAS float* const ct = (LAS float*)(L + PRE_CT);
    const bf16* Rr = (const bf16*)(ws + R_RR); const bf16* Kr = (const bf16*)(ws + R_KR); const bf16* Vr = (const bf16*)(ws + R_VR); const bf16* XL = (const bf16*)(ws + R_XL);
    const bf16* W2T = (const bf16*)(ws + WS_LORA) + (size_t)d * 512 * 64; const bf16* A2T = (const bf16*)(ws + WS_LORA) + (size_t)(2 + d) * 512 * 64;
    float* BN = (float*)(ws + R_BN) + (size_t)d * M * 8;
    const int h = F.vcu & 7, hc = h * HD; const bool scanwg = (int)blockIdx.x < 128; const int idx16 = ((int)blockIdx.x & 7) * 2 + (((int)blockIdx.x >> 6) & 1);
    const int bc0 = scanwg ? idx16 : 144 + idx16, bcs = 16, bend = scanwg ? 144 : BATCH * (SEQ / 64);
    { LANE_VARS; const float* sp = karg(I_TSP) + layer * RPROJ; const float* sn = karg(I_TSN) + layer * RPROJ;
      for (int idx = wave_ * 64 + lane; idx < CT_N; idx += NTHR) { const int seg = idx >> 6, c = idx & 63; float v;
          if (seg == 0) v = karg(I_KK)[layer * 512 + hc + c]; else if (seg == 1) v = karg(I_KA)[layer * 512 + hc + c]; else if (seg == 2) v = karg(I_RK)[layer * 512 + hc + c];
          else if (seg < 5) v = karg(I_W0)[(layer * 2 + seg - 3) * 512 + hc + c]; else if (seg < 7) v = karg(I_A0)[(layer * 2 + seg - 5) * 512 + hc + c];
          else if (seg < 13) { const int j = seg - 7; v = ((j & 1) ? sn : sp)[(j >> 1) * 512 + hc + c]; }
          else if (seg < 15) v = sp[1536 + (idx - CT_SPX)]; else v = sn[1536 + (idx - CT_SNX)];
          ct[idx] = v; } }
    WG_BARL();
    R16 xw3, xa3, kk3, rr3;
    { LANE_VARS; const int tidl = wave_ * 64 + lane, tok = tidl >> 3, oct = tidl & 7; const int b = bc0 >> 6, t = (bc0 & 63) * 64 + tok, row = b * SEQ + t;
      xw3 = ld3x16(XL, 256, 8 * oct, row, t); xa3 = ld3x16(XL, 256, 64 + 8 * oct, row, t); kk3 = ld3x16(Kr, 512, hc + 8 * oct, row, t); rr3 = ld3x16(Rr, 512, hc + 8 * oct, row, t); }
    LAS unsigned char* const RF0 = L + 6 * TILE_B; LAS unsigned char* const RF1 = L + 13 * TILE_B;
    for (int bc = bc0; bc < bend; bc += bcs) {
        const int cn = bc & 63, b = bc >> 6, t0 = cn * 64;
#define SNAT (d ? 63 - mrow : mrow)
        bf16x8 wfr[4], afr[4];
        { LANE_VARS;
#pragma unroll
          for (int ks = 0; ks < 4; ++ks) { const size_t wo = (size_t)(((2 * h + qn) * 4 + ks) * 64 + lane) * 8; wfr[ks] = *(const bf16x8*)(W2T + wo); afr[ks] = *(const bf16x8*)(A2T + wo); }
        }
        float ksh[8];
        { LANE_VARS; const int tidl = wave_ * 64 + lane; const int tok = tidl >> 3, oct = tidl & 7; float v8[8];
          sh8(xw3, ct + CT_SPX + 8 * oct, ct + CT_SNX + 8 * oct, v8);
          { v4u w; w.x = cvtpk(tanh_fast(v8[0]), tanh_fast(v8[1])); w.y = cvtpk(tanh_fast(v8[2]), tanh_fast(v8[3])); w.z = cvtpk(tanh_fast(v8[4]), tanh_fast(v8[5])); w.w = cvtpk(tanh_fast(v8[6]), tanh_fast(v8[7])); *(LAS v4u*)(TWt + tok * TSB + 16 * oct) = w; }
          sh8(xa3, ct + CT_SPX + 64 + 8 * oct, ct + CT_SNX + 64 + 8 * oct, v8);
          { v4u w; w.x = cvtpk(v8[0], v8[1]); w.y = cvtpk(v8[2], v8[3]); w.z = cvtpk(v8[4], v8[5]); w.w = cvtpk(v8[6], v8[7]); *(LAS v4u*)(XAt + tok * TSB + 16 * oct) = w; }
          sh8(rr3, ct + CT_SPR + 8 * oct, ct + CT_SNR + 8 * oct, v8);
          { LAS f32x4* rp_ = (LAS f32x4*)((tok < 32 ? RF0 : RF1) + (tok & 31) * 256 + 32 * oct); rp_[0] = (f32x4){v8[0], v8[1], v8[2], v8[3]}; rp_[1] = (f32x4){v8[4], v8[5], v8[6], v8[7]}; }
          sh8(kk3, ct + CT_SPK + 8 * oct, ct + CT_SNK + 8 * oct, ksh);
          const f32x4 k0 = *(const LAS f32x4*)(ct + CT_KK + 8 * oct), k1 = *(const LAS f32x4*)(ct + CT_KK + 8 * oct + 4); float ssq = 0.f;
#pragma unroll
          for (int j = 0; j < 8; ++j) { const float kx = ksh[j] * ((j < 4) ? k0[j & 3] : k1[j & 3]); ssq += kx * kx; }
          ssq += pg8::shx(ssq, 1, lane); ssq += pg8::shx(ssq, 2, lane); ssq += pg8::shx(ssq, 4, lane);
          if (oct == 0) invn[tok] = 1.0f / sqrtf(ssq + 1e-12f); }
        WG_BARL();
        f32x16 zw, za, lw, av, cum;
        { LANE_VARS; const int snat = SNAT;
#pragma unroll
        for (int r = 0; r < 16; ++r) { zw[r] = 0.f; za[r] = 0.f; }
        { bf16x8 f0[4], f1[4]; LD4_ROW(f0, TWt, snat); LD4_ROW(f1, XAt, snat); SBAR0();
#pragma unroll
          for (int ks = 0; ks < 4; ++ks) { zw = MFMA32(wfr[ks], f0[ks], zw); za = MFMA32(afr[ks], f1[ks], za); } }
#pragma unroll
        for (int q = 0; q < 4; ++q) { const f32x4 w0v = *(const LAS f32x4*)(ct + CT_W0 + 64 * d + n0 + 8 * q + 4 * hi), a0v = *(const LAS f32x4*)(ct + CT_A0 + 64 * d + n0 + 8 * q + 4 * hi);
#pragma unroll
            for (int i = 0; i < 4; ++i) { lw[4 * q + i] = -0.8750510130f * sigmoidf_(zw[4 * q + i] + w0v[i]);     av[4 * q + i] = sigmoidf_(za[4 * q + i] + a0v[i]); } }
        { f32x16 lh, ll;
#pragma unroll
          for (int r = 0; r < 16; ++r) { lh[r] = __uint_as_float(cvtpk(lw[r], 0.f) << 16); ll[r] = lw[r] - lh[r]; }
          store_quad(T4, mrow, n0, hi, lh); store_quad(T5, mrow, n0, hi, ll); } }
        WG_BARL();
        { LANE_VARS; const int tidl = wave_ * 64 + lane, tok = tidl >> 3, oct = tidl & 7;
          LAS f32x4* kp_ = (LAS f32x4*)((tok < 32 ? TWt : XAt) + (tok & 31) * 256 + 32 * oct); kp_[0] = (f32x4){ksh[0], ksh[1], ksh[2], ksh[3]}; kp_[1] = (f32x4){ksh[4], ksh[5], ksh[6], ksh[7]}; }
        { LANE_VARS;
#pragma unroll
        for (int r = 0; r < 16; ++r) cum[r] = 0.f;
        { bf16x8 f0[4], f1[4]; LD4_TR(f0, T4, n0); LD4_TR(f1, T5, n0); SBAR0();
#pragma unroll
        for (int ks = 0; ks < 4; ++ks) { bf16x8 tf;
#pragma unroll
            for (int j = 0; j < 8; ++j) tf[j] = (16 * ks + 8 * hi + j <= mrow) ? (short)0x3f80 : (short)0;
            cum = MFMA32(f0[ks], tf, cum); cum = MFMA32(f1[ks], tf, cum); } } }
        WG_BARL();
        f32x16 rh, kc, mrk;
        { LANE_VARS; const int snat = SNAT; const float inv = invn[snat];
          f32x4 bs4 = {0.f, 0.f, 0.f, 0.f};
#pragma unroll
          for (int q = 0; q < 4; ++q) { const int cl = n0 + 8 * q + 4 * hi;
              const f32x4 r4 = *(const LAS f32x4*)((snat < 32 ? RF0 : RF1) + (snat & 31) * 256 + 4 * cl), k4 = *(const LAS f32x4*)((snat < 32 ? TWt : XAt) + (snat & 31) * 256 + 4 * cl);
              const f32x4 kk4 = *(const LAS f32x4*)(ct + CT_KK + cl), ka4 = *(const LAS f32x4*)(ct + CT_KA + cl), rk4 = *(const LAS f32x4*)(ct + CT_RK + cl);
              const f32x4 a4 = {av[4 * q], av[4 * q + 1], av[4 * q + 2], av[4 * q + 3]}, cs4 = {cum[4 * q], cum[4 * q + 1], cum[4 * q + 2], cum[4 * q + 3]}, lw4 = {lw[4 * q], lw[4 * q + 1], lw[4 * q + 2], lw[4 * q + 3]};
              const f32x4 cx4 = cs4 - lw4; f32x4 g4, gx4, gi4;
#pragma unroll
              for (int i = 0; i < 4; ++i) { g4[i] = __builtin_amdgcn_exp2f(cs4[i]); gx4[i] = __builtin_amdgcn_exp2f(cx4[i]); gi4[i] = __builtin_amdgcn_exp2f(-cs4[i]); }
              const f32x4 kkn4 = k4 * kk4 * inv, kt4 = k4 * (1.0f + (a4 - 1.0f) * ka4);
              const f32x4 kh4 = gx4 * kkn4, rh4 = g4 * r4, bc4 = a4 * kkn4 * gi4, kc4 = kt4 * gi4; bs4 += r4 * kt4 * rk4;
#pragma unroll
              for (int i = 0; i < 4; ++i) { rh[4 * q + i] = rh4[i]; kc[4 * q + i] = kc4[i]; }
              const int off = mrow * TSB + (n0 + 8 * q + 4 * hi) * 2; u32x2_t w;
              w.x = cvtpk(kh4[0], kh4[1]); w.y = cvtpk(kh4[2], kh4[3]); *(LAS u32x2_t*)(T0 + off) = w;
              w.x = cvtpk(rh4[0], rh4[1]); w.y = cvtpk(rh4[2], rh4[3]); *(LAS u32x2_t*)(T1 + off) = w;
              w.x = cvtpk(bc4[0], bc4[1]); w.y = cvtpk(bc4[2], bc4[3]); *(LAS u32x2_t*)(T2 + off) = w;
              w.x = cvtpk(kc4[0], kc4[1]); w.y = cvtpk(kc4[2], kc4[3]); *(LAS u32x2_t*)(T3 + off) = w;
            }
          if (qm == 1 && l31 == 31) {
#pragma unroll
              for (int e = 0; e < 16; ++e) gcs[n0 + 8 * (e >> 2) + 4 * hi + (e & 3)] = __builtin_amdgcn_exp2f(cum[e]); }
          float bsum = (bs4[0] + bs4[1]) + (bs4[2] + bs4[3]);
          bsum += pg8::shx(bsum, 32, lane);
          if (hi == 0) bon[(d * 2 + qn) * 64 + snat] = bsum; }
        if (bc + bcs < bend) { LANE_VARS; const int tidl = wave_ * 64 + lane, tok = tidl >> 3, oct = tidl & 7; const int bn = bc + bcs, b2 = bn >> 6, t = (bn & 63) * 64 + tok, row = b2 * SEQ + t;
            xw3 = ld3x16(XL, 256, 8 * oct, row, t); xa3 = ld3x16(XL, 256, 64 + 8 * oct, row, t); kk3 = ld3x16(Kr, 512, hc + 8 * oct, row, t); rr3 = ld3x16(Rr, 512, hc + 8 * oct, row, t); }
        WG_BARL();
        { LANE_VARS; const int snat = SNAT; if (qn == 0 && hi == 0) BN[(size_t)(b * SEQ + t0 + snat) * 8 + h] = bon[(d * 2) * 64 + snat] + bon[(d * 2 + 1) * 64 + snat]; }
        { LANE_VARS; f32x16 x, mk, zz;
          float z0 = 0.f; asm volatile("" : "+v"(z0));
#pragma unroll
          for (int r = 0; r < 16; ++r) { x[r] = 0.f; mk[r] = 0.f; zz[r] = z0; }
          { bf16x8 f0[4], f1[4], f2[4]; LD4_ROW(f0, T0, mrow); LD4_ROW(f1, T2, n0 + l31); LD4_ROW(f2, T3, n0 + l31); SBAR0();
#pragma unroll
            for (int ks = 0; ks < 4; ++ks) { x = MFMA32(f1[ks], f0[ks], x); mk = MFMA32(f2[ks], f0[ks], mk); } }
#pragma unroll
          for (int q = 0; q < 4; ++q)
#pragma unroll
              for (int i = 0; i < 4; ++i) { const int e = 4 * q + i, n = n0 + 8 * q + 4 * hi + i; const bool lo = n < mrow; x[e] = lo ? -x[e] : 0.f; mk[e] = lo ? mk[e] : 0.f; }
          store_quad(T4, mrow, n0, hi, x); store_quad(T5, mrow, n0, hi, zz); store_quad(T6, mrow, n0, hi, mk); }
        WG_BARL();
        R16 vr3[2];
        { LANE_VARS; const int tt = (wave_ * 64 + lane) & 255, s = tt >> 2, cg4 = (tt & 3) * 16, sn_ = d ? 63 - s : s, t = t0 + sn_, row = b * SEQ + t;
          vr3[0] = ld3x16(Vr, 512, hc + cg4, row, t); vr3[1] = ld3x16(Vr, 512, hc + cg4 + 8, row, t); }
        LAS unsigned char* const RBt = d ? XAt : TWt;
#define PRE_S13() { LANE_VARS; f32x16 rb; \
          _Pragma("unroll") for (int r = 0; r < 16; ++r) { rb[r] = 0.f; mrk[r] = 0.f; } \
          { bf16x8 f0[4], f1[4], f2[4]; LD4_ROW(f0, T2, n0 + l31); LD4_ROW(f1, T1, mrow); LD4_ROW(f2, T3, n0 + l31); SBAR0(); \
            _Pragma("unroll") for (int ks = 0; ks < 4; ++ks) { rb = MFMA32(f0[ks], f1[ks], rb); mrk = MFMA32(f2[ks], f1[ks], mrk); } } \
          _Pragma("unroll") for (int q = 0; q < 4; ++q) _Pragma("unroll") for (int i = 0; i < 4; ++i) { const int e = 4 * q + i, n = n0 + 8 * q + 4 * hi + i; const bool lo = n <= mrow; rb[e] = lo ? rb[e] : 0.f; mrk[e] = lo ? mrk[e] : 0.f; } \
          store_quad(RBt, mrow, n0, hi, rb); }
        if ((wave_ & 3) == 0) { LANE_VARS; const int blk = lane >> 4, c = lane & 15; float t[16];
#pragma unroll
            for (int r = 0; r < 16; ++r) { const LAS unsigned char* xr = T4 + (16 * blk + r) * TSB + 32 * blk; const v4u w0_ = *(const LAS v4u*)xr, w1_ = *(const LAS v4u*)(xr + 16);
                float acc0 = (r == c) ? 1.0f : 0.f, acc1 = 0.f;
#pragma unroll
                for (int j = 0; j < r; ++j) { const unsigned w = (j < 8) ? w0_[j >> 1] : w1_[(j - 8) >> 1]; const float xv = (j & 1) ? __uint_as_float(w & 0xffff0000u) : __uint_as_float(w << 16);
                    if (j & 1) acc1 += xv * t[j]; else acc0 += xv * t[j]; }
                t[r] = acc0 + acc1; }
#pragma unroll
            for (int r = 0; r < 16; ++r) *(LAS unsigned short*)(T5 + (16 * blk + r) * TSB + (16 * blk + c) * 2) = (unsigned short)(cvtpk(t[r], 0.f) & 0xffffu); }
        else PRE_S13()
        WG_BARL();
        { LANE_VARS; LAS unsigned char* const scr = qm ? T5 : T4;
          if (qm == qn) {
              f32x16 w;
#pragma unroll
              for (int r = 0; r < 16; ++r) w[r] = 0.f;
              bf16x8 mf = frag_row(T4, m0 + l31, 2 * qm, hi);
              if (l31 < 16) mf = (bf16x8){0, 0, 0, 0, 0, 0, 0, 0};
              w = MFMA32(frag_tr(T5, m0, 2 * qm, lane), mf, w);
              store_quad(scr, l31, 32, hi, w); } }
        WG_BARL();
        { LANE_VARS; LAS unsigned char* const scr = qm ? T5 : T4;
          if (qm == qn) {
              f32x16 tq = load_quad(T5, mrow, m0, hi);
#pragma unroll
              for (int ks = 0; ks < 2; ++ks) tq = MFMA32(frag_tr(scr, 32, ks, lane), frag_row(T5, mrow, 2 * qm + ks, hi), tq);
              store_quad(T5, mrow, m0, hi, tq); } }
        WG_BARL();
        { LANE_VARS;
          if (qm == 1 && qn == 0) {
              f32x16 w;
#pragma unroll
              for (int r = 0; r < 16; ++r) w[r] = 0.f;
#pragma unroll
              for (int ks = 0; ks < 2; ++ks) w = MFMA32(frag_tr(T5, 0, ks, lane), frag_row(T4, 32 + l31, ks, hi), w);
              store_quad(T4, l31, 32, hi, w); }
          if (qm == 0 && qn == 1) { f32x16 zz; float z0 = 0.f; asm volatile("" : "+v"(z0));
#pragma unroll
              for (int r = 0; r < 16; ++r) zz[r] = z0;
              store_quad(T5, l31, 32, hi, zz); } }
        if ((wave_ & 3) == 0) PRE_S13()
        WG_BARL();
        { LANE_VARS;
          if (qm == 1 && qn == 0) {
              f32x16 t21;
#pragma unroll
              for (int r = 0; r < 16; ++r) t21[r] = 0.f;
#pragma unroll
              for (int ks = 0; ks < 2; ++ks) t21 = MFMA32(frag_tr(T4, 32, ks, lane), frag_row(T5, 32 + l31, 2 + ks, hi), t21);
              store_quad(T5, 32 + l31, 0, hi, t21); } }
        { LANE_VARS; const int tt = (wave_ * 64 + lane) & 255, s = tt >> 2, cg4 = (tt & 3) * 16; float v8[8];
#pragma unroll
          for (int hlf = 0; hlf < 2; ++hlf) { const int c8 = cg4 + 8 * hlf;
              sh8(vr3[hlf], ct + CT_SPV + c8, ct + CT_SNV + c8, v8);
              v4u w; w.x = cvtpk_h(v8[0], v8[1]); w.y = cvtpk_h(v8[2], v8[3]); w.z = cvtpk_h(v8[4], v8[5]); w.w = cvtpk_h(v8[6], v8[7]); *(LAS v4u*)(T1 + s * TSB + 2 * c8) = w; } }
        WG_BARL();
        { LANE_VARS; f32x16 kp, tk;
#pragma unroll
          for (int r = 0; r < 16; ++r) { kp[r] = 0.f; tk[r] = 0.f; }
          { bf16x8 f0[4], f1[4], f2[4]; LD4_ROW(f0, T5, mrow); LD4_TR(f1, T0, n0); LD4_TR(f2, T6, n0); SBAR0();
#pragma unroll
            for (int ks = 0; ks < 4; ++ks) { kp = MFMA32(f1[ks], f0[ks], kp); tk = MFMA32(f2[ks], f0[ks], tk); } }
          store_quad(T4, mrow, n0, hi, kp); store_quad(T3, mrow, n0, hi, tk); }
        WG_BARL();
        const int cd = d ? 63 - cn : cn;
        bf16* const pre = pre_item(ws, ((b * 8 + h) * 2 + d) * 64 + cd);
        { LANE_VARS; f32x16 rp, ml, pm, kq;
#pragma unroll
          for (int r = 0; r < 16; ++r) { rp[r] = 0.f; ml[r] = 0.f; pm[r] = 0.f; kq[r] = 0.f; }
#pragma unroll
          for (int kh = 0; kh < 2; ++kh) { bf16x8 mrbf[2], khn[2], bcn[2], tkn[2], bcm[2], tkm[2];
#pragma unroll
              for (int k2 = 0; k2 < 2; ++k2) { const int ks = 2 * kh + k2; mrbf[k2] = frag_row(RBt, mrow, ks, hi); khn[k2] = frag_tr(T4, n0, ks, lane); bcn[k2] = frag_tr(T2, n0, ks, lane); tkn[k2] = frag_tr(T3, n0, ks, lane); bcm[k2] = frag_tr(T2, m0, ks, lane); tkm[k2] = frag_tr(T3, m0, ks, lane); }
              SBAR0();
#pragma unroll
              for (int k2 = 0; k2 < 2; ++k2) { rp = MFMA32(khn[k2], mrbf[k2], rp); ml = MFMA32(tkn[k2], mrbf[k2], ml); pm = MFMA32(khn[k2], bcm[k2], pm); kq = MFMA32(bcn[k2], tkm[k2], kq); }
              SBAR0(); }
          const float gm = gcs[mrow];
#pragma unroll
          for (int q = 0; q < 4; ++q)
#pragma unroll
              for (int i = 0; i < 4; ++i) { const int e = 4 * q + i, n = n0 + 8 * q + 4 * hi + i;
                  rp[e] = rh[e] - rp[e]; ml[e] = mrk[e] - ml[e]; pm[e] = gm * (((n == mrow) ? 1.0f : 0.f) - pm[e]); kq[e] = (kc[e] - kq[e]) * gcs[n]; }
          { const int tn = d ? 63 - mrow : mrow;
#pragma unroll
          for (int s2 = 0; s2 < 2; ++s2) { v4u w;
              w.x = cvtpk_h(pm[8 * s2], pm[8 * s2 + 1]); w.y = cvtpk_h(pm[8 * s2 + 2], pm[8 * s2 + 3]); w.z = cvtpk_h(pm[8 * s2 + 4], pm[8 * s2 + 5]); w.w = cvtpk_h(pm[8 * s2 + 6], pm[8 * s2 + 7]);
              __builtin_nontemporal_store(w, (v4u*)(pre + ((4 * qm + 2 * qn + s2) * 64 + lane) * 8));
              w.x = cvtpk_h(rp[8 * s2], rp[8 * s2 + 1]); w.y = cvtpk_h(rp[8 * s2 + 2], rp[8 * s2 + 3]); w.z = cvtpk_h(rp[8 * s2 + 4], rp[8 * s2 + 5]); w.w = cvtpk_h(rp[8 * s2 + 6], rp[8 * s2 + 7]);
              __builtin_nontemporal_store(w, (v4u*)(pre + 4096 + ((2 * (2 * qn + s2) + (tn >> 5)) * 64 + 32 * hi + (tn & 31)) * 8)); } }
          store_quad_h(T0, mrow, n0, hi, ml); store_quad_h(T6, mrow, n0, hi, kq); }
        WG_BARL();
        v4u ylw0, ylw1; bf16* yldst = nullptr;
        { LANE_VARS; f32x16 qt, yt;
#pragma unroll
          for (int r = 0; r < 16; ++r) { qt[r] = 0.f; yt[r] = 0.f; }
          { bf16x8 f0[4], f1[4], f2[4], f3[4]; LD4_TR(f0, T1, m0); LD4_TR(f1, T6, n0); LD4_TR(f2, T1, n0); LD4_ROW(f3, T0, mrow); SBAR0();
#pragma unroll
            for (int ks = 0; ks < 4; ++ks) { qt = MFMA32H(f1[ks], f0[ks], qt); yt = MFMA32H(f2[ks], f3[ks], yt); } }
          v4u w0_, w1_;
          w0_.x = cvtpk_h(qt[0], qt[1]); w0_.y = cvtpk_h(qt[2], qt[3]); w0_.z = cvtpk_h(qt[4], qt[5]); w0_.w = cvtpk_h(qt[6], qt[7]); w1_.x = cvtpk_h(qt[8], qt[9]); w1_.y = cvtpk_h(qt[10], qt[11]); w1_.z = cvtpk_h(qt[12], qt[13]); w1_.w = cvtpk_h(qt[14], qt[15]);
          { bf16* dst = pre + 8192 + ((qn * 64 + mrow) * 2 + hi) * 16; __builtin_nontemporal_store(w0_, (v4u*)dst); __builtin_nontemporal_store(w1_, (v4u*)(dst + 8)); }
          ylw0.x = cvtpk_h(yt[0], yt[1]); ylw0.y = cvtpk_h(yt[2], yt[3]); ylw0.z = cvtpk_h(yt[4], yt[5]); ylw0.w = cvtpk_h(yt[6], yt[7]); ylw1.x = cvtpk_h(yt[8], yt[9]); ylw1.y = cvtpk_h(yt[10], yt[11]); ylw1.z = cvtpk_h(yt[12], yt[13]); ylw1.w = cvtpk_h(yt[14], yt[15]);
          if (d) { LAS unsigned char* xe = L + 9 * TILE_B + ((qn * 64 + (63 - mrow)) * 2 + hi) * 32; *(LAS v4u*)xe = ylw0; *(LAS v4u*)(xe + 16) = ylw1; }
          else yldst = pre + 12288 + ((qn * 64 + mrow) * 2 + hi) * 16; }
        WG_BARL();
        if (d == 0) { LANE_VARS; const LAS unsigned char* xe = L + 9 * TILE_B + ((qn * 64 + mrow) * 2 + hi) * 32; const v4u o0 = *(const LAS v4u*)xe, o1 = *(const LAS v4u*)(xe + 16); v4u r0, r1;
#pragma unroll
            for (int j = 0; j < 4; ++j) { const f32x2_t a0 = unpk_h(ylw0[j]), b0 = unpk_h(o0[j]), a1 = unpk_h(ylw1[j]), b1 = unpk_h(o1[j]); r0[j] = cvtpk_h(a0.x + b0.x, a0.y + b0.y); r1[j] = cvtpk_h(a1.x + b1.x, a1.y + b1.y); }
            __builtin_nontemporal_store(r0, (v4u*)yldst); __builtin_nontemporal_store(r1, (v4u*)(yldst + 8)); }
    }
#undef PRE_S13
#undef LANE_VARS
#undef SNAT
}

constexpr int SCAN_SLOT = 12 * 1024, SCAN_NS = 6, SCAN_AHEAD = 5;
__device__ __forceinline__ void scan_issue(const bf16* pre, LAS unsigned char* slot, int l31, int hi, int v) {
#pragma unroll
    for (int i = 0; i < 8; ++i) { const int mt = i >> 2, kt = (i >> 1) & 1, s = i & 1;
        (void)mt; (void)kt; (void)s; __builtin_amdgcn_global_load_lds((const unsigned*)(pre + (i * 64 + 32 * hi + l31) * 8), (LAS unsigned*)(slot + i * 1024), 16, 0, 2); }
#pragma unroll
    for (int i = 0; i < 4; ++i) { const int mt = i >> 1, hf = i & 1;
        __builtin_amdgcn_global_load_lds((const unsigned*)(pre + 8192 + ((mt * 64 + v) * 2 + hi) * 16 + 8 * hf), (LAS unsigned*)(slot + (8 + i) * 1024), 16, 0, 2); }
}
__device__ __forceinline__ void rwkv_scan_chunk(Frame& F, int unit) {
    unsigned char* const ws = kws();
    int lane_ = lane_id(); asm volatile("" : "+v"(lane_));
    const int lane = lane_, hi = lane >> 5, l31 = lane & 31;
    const int chain = unit >> 1, vh = unit & 1, v = 32 * vh + l31;
    const bf16* pre = pre_item(ws, chain * 64);
    bf16* sd = (bf16*)(ws + R_SD) + (size_t)chain * 64 * 4096;
    LAS unsigned char* const ring = F.lds;
    f32x16 X0, X1;
#pragma unroll
    for (int r = 0; r < 16; ++r) { X0[r] = 0.f; X1[r] = 0.f; }
#pragma unroll
    for (int i0 = 0; i0 < SCAN_AHEAD; ++i0) scan_issue(pre + (size_t)i0 * 16384, ring + i0 * SCAN_SLOT, l31, hi, v);
    bf16x8 pfA[8], pfB[8]; f32x16 qA[2], qB[2];
#define SCAN_FETCH(PF, QI, STEP) do { const LAS unsigned char* sl_ = ring + ((STEP) % SCAN_NS) * SCAN_SLOT + lane * 16; \
        _Pragma("unroll") for (int mt = 0; mt < 2; ++mt) { const v4u w0_ = *(const LAS v4u*)(sl_ + (8 + 2 * mt) * 1024), w1_ = *(const LAS v4u*)(sl_ + (9 + 2 * mt) * 1024); \
            _Pragma("unroll") for (int j = 0; j < 4; ++j) { const f32x2_t u0 = unpk_h(w0_[j]), u1 = unpk_h(w1_[j]); QI[mt][2 * j] = u0.x; QI[mt][2 * j + 1] = u0.y; QI[mt][8 + 2 * j] = u1.x; QI[mt][8 + 2 * j + 1] = u1.y; } } \
        _Pragma("unroll") for (int i = 0; i < 8; ++i) PF[i] = *(const LAS bf16x8*)(sl_ + i * 1024); } while (0)
    asm volatile("s_waitcnt vmcnt(48)" ::: "memory");
    SCAN_FETCH(pfA, qA, 0);
#define SCAN_STEP(C, PF, QI, PFN, QIN) do { const int c_ = (C); \
          \
        bf16x8 xb[2][2]; \
        _Pragma("unroll") for (int kt = 0; kt < 2; ++kt) _Pragma("unroll") for (int s = 0; s < 2; ++s) { v4u w; \
            _Pragma("unroll") for (int j = 0; j < 4; ++j) { const float a0 = kt ? X1[8 * s + 2 * j] : X0[8 * s + 2 * j], a1 = kt ? X1[8 * s + 2 * j + 1] : X0[8 * s + 2 * j + 1]; w[j] = cvtpk_h(a0, a1); } \
            xb[kt][s] = __builtin_bit_cast(bf16x8, w); \
            __builtin_nontemporal_store(w, (v4u*)(sd + (size_t)c_ * 4096 + ((kt * 64 + v) * 2 + hi) * 16 + 8 * s)); } \
        f32x16 acc0 = QI[0], acc1 = QI[1]; \
        SBAR0(); \
        _Pragma("unroll") for (int kt = 0; kt < 2; ++kt) _Pragma("unroll") for (int s = 0; s < 2; ++s) { acc0 = MFMA32H(PF[2 * kt + s], xb[kt][s], acc0); acc1 = MFMA32H(PF[4 + 2 * kt + s], xb[kt][s], acc1); } \
        SBAR0(); \
          \
        if (c_ + SCAN_AHEAD < 64) scan_issue(pre + (size_t)(c_ + SCAN_AHEAD) * 16384, ring + ((c_ + SCAN_AHEAD) % SCAN_NS) * SCAN_SLOT, l31, hi, v); \
        if (c_ + 1 < 64) { if (c_ + SCAN_AHEAD < 64) asm volatile("s_waitcnt vmcnt(48)" ::: "memory"); else asm volatile("s_waitcnt vmcnt(0)" ::: "memory"); \
            SCAN_FETCH(PFN, QIN, c_ + 1); } \
        SBAR0(); \
        X0 = acc0; X1 = acc1; } while (0)
#pragma unroll 1
    for (int c = 0; c < 64; c += 2) { SCAN_STEP(c, pfA, qA, pfB, qB); SCAN_STEP(c + 1, pfB, qB, pfA, qA); }
#undef SCAN_STEP
#undef SCAN_FETCH
}

constexpr int FIN_SGS = 272, FIN_VSS = 1040;
__device__ __forceinline__ void rwkv_finalize_mfma(Frame& F, int layer) {
    unsigned char* const ws = kws();
    int lane_ = lane_id(); asm volatile("" : "+v"(lane_)); int wave_o = F.wv; asm volatile("" : "+s"(wave_o)); const int wave_ = wave_o, h = wave_, hc = h * HD;
#define FIN_LANE int lane = lane_; asm volatile("" : "+v"(lane)); const int hi = lane >> 5, l31 = lane & 31; (void)hi; (void)l31;
    LAS unsigned char* const sgt = F.lds; LAS unsigned char* const vst = F.lds + 64 * FIN_SGS;
    const bf16* Vr = (const bf16*)(ws + R_VR); const bf16* XL = (const bf16*)(ws + R_XL); bf16* MIX = (bf16*)(ws + R_MIX); const bf16* G2T = (const bf16*)(ws + WS_G2T);
    const float* BN0 = (const float*)(ws + R_BN); const float* BN1 = BN0 + (size_t)M * 8;
    const float* sp = karg(I_TSP) + layer * RPROJ; const float* sn = karg(I_TSN) + layer * RPROJ;
    const float* gnw = karg(I_GNW) + layer * 512 + hc; const float* gnb = karg(I_GNB) + layer * 512 + hc;
    for (int unit = F.vcu; unit < BATCH * (SEQ / 64); unit += F.G) {
        const int cn = unit & 63, b = unit >> 6, t0 = cn * 64;
        { FIN_LANE; const int tid = wave_ * 64 + lane, tok = tid >> 3, oct = tid & 7, t = t0 + tok, row = b * SEQ + t; float v8[8];
#pragma unroll
          for (int hf = 0; hf < 2; ++hf) { const int k0 = 16 * oct + 8 * hf;
              shift8(XL, 256, 128 + k0, row, t, sp + 1664 + k0, sn + 1664 + k0, v8);
              v4u w; w.x = cvtpk(sigmoidf_(v8[0]), sigmoidf_(v8[1])); w.y = cvtpk(sigmoidf_(v8[2]), sigmoidf_(v8[3])); w.z = cvtpk(sigmoidf_(v8[4]), sigmoidf_(v8[5])); w.w = cvtpk(sigmoidf_(v8[6]), sigmoidf_(v8[7]));
              *(LAS v4u*)(sgt + tok * FIN_SGS + 2 * k0) = w; }
#pragma unroll 2
          for (int j = 0; j < 8; ++j) { const int c0 = 64 * j + 8 * oct; float v8[8];
              shift8(Vr, 512, c0, row, t, sp + 1024 + c0, sn + 1024 + c0, v8);
              v4u w; w.x = cvtpk(v8[0], v8[1]); w.y = cvtpk(v8[2], v8[3]); w.z = cvtpk(v8[4], v8[5]); w.w = cvtpk(v8[6], v8[7]);
              *(LAS v4u*)(vst + tok * FIN_VSS + 2 * c0) = w; } }
        WG_BARL();
        { FIN_LANE;
        f32x16 acc[2][2], gg[2][2];
#pragma unroll
        for (int tt = 0; tt < 2; ++tt)
#pragma unroll
            for (int vt = 0; vt < 2; ++vt)
#pragma unroll
                for (int r = 0; r < 16; ++r) { acc[tt][vt][r] = 0.f; gg[tt][vt][r] = 0.f; }
#pragma unroll
        for (int d = 0; d < 2; ++d) { const size_t item = (size_t)(((b * 8 + h) * 2 + d) * 64 + (d ? 63 - cn : cn));
            const bf16* pre = pre_item(ws, (int)item); const bf16* sd = (const bf16*)(ws + R_SD) + item * 4096;
            if (d == 0)
#pragma unroll
            for (int tt = 0; tt < 2; ++tt)
#pragma unroll
                for (int vt = 0; vt < 2; ++vt) { const bf16* src = pre + 12288 + ((vt * 64 + 32 * tt + l31) * 2 + hi) * 16; const v4u w0_ = __builtin_nontemporal_load((const v4u*)src), w1_ = __builtin_nontemporal_load((const v4u*)(src + 8));
#pragma unroll
                    for (int j = 0; j < 4; ++j) { const f32x2_t u0 = unpk_h(w0_[j]), u1 = unpk_h(w1_[j]); acc[tt][vt][2 * j] += u0.x; acc[tt][vt][2 * j + 1] += u0.y; acc[tt][vt][8 + 2 * j] += u1.x; acc[tt][vt][8 + 2 * j + 1] += u1.y; } }
            bf16x8 sf[4][2], rf[4][2];
#pragma unroll
            for (int ks = 0; ks < 4; ++ks) { const int kt = ks >> 1, s = ks & 1;
#pragma unroll
                for (int vt = 0; vt < 2; ++vt) sf[ks][vt] = __builtin_nontemporal_load((const bf16x8*)(sd + ((kt * 64 + 32 * vt + l31) * 2 + hi) * 16 + 8 * s));
#pragma unroll
                for (int tt = 0; tt < 2; ++tt) rf[ks][tt] = __builtin_nontemporal_load((const bf16x8*)(pre + 4096 + ((2 * ks + tt) * 64 + 32 * hi + l31) * 8)); }
            SBAR0();
#pragma unroll
            for (int ks = 0; ks < 4; ++ks)
#pragma unroll
                for (int tt = 0; tt < 2; ++tt)
#pragma unroll
                    for (int vt = 0; vt < 2; ++vt) acc[tt][vt] = MFMA32H(sf[ks][vt], rf[ks][tt], acc[tt][vt]); }
#pragma unroll
        for (int kh = 0; kh < 2; ++kh) { bf16x8 gf[4][2], tf[4][2];
#pragma unroll
            for (int k4 = 0; k4 < 4; ++k4) { const int ks = 4 * kh + k4;
#pragma unroll
                for (int vt = 0; vt < 2; ++vt) gf[k4][vt] = *(const bf16x8*)(G2T + (size_t)(((2 * h + vt) * 8 + ks) * 64 + lane) * 8);
#pragma unroll
                for (int tt = 0; tt < 2; ++tt) tf[k4][tt] = *(const LAS bf16x8*)(sgt + (32 * tt + l31) * FIN_SGS + (16 * ks + 8 * hi) * 2); }
            SBAR0();
#pragma unroll
            for (int k4 = 0; k4 < 4; ++k4)
#pragma unroll
                for (int tt = 0; tt < 2; ++tt)
#pragma unroll
                    for (int vt = 0; vt < 2; ++vt) gg[tt][vt] = MFMA32(gf[k4][vt], tf[k4][tt], gg[tt][vt]);
            SBAR0(); }
#pragma unroll
        for (int tt = 0; tt < 2; ++tt) { const int t = t0 + 32 * tt + l31, row = b * SEQ + t;
            float sm = 0.f;
#pragma unroll
            for (int vt = 0; vt < 2; ++vt)
#pragma unroll
                for (int r = 0; r < 16; ++r) sm += acc[tt][vt][r];
            sm += pg8::shx(sm, 32, lane); const float mu = sm * (1.0f / 64.0f); float sq = 0.f;
#pragma unroll
            for (int vt = 0; vt < 2; ++vt)
#pragma unroll
                for (int r = 0; r < 16; ++r) { const float dl = acc[tt][vt][r] - mu; sq += dl * dl; }
            sq += pg8::shx(sq, 32, lane); const float rstd = 1.0f / sqrtf(sq * (1.0f / 64.0f) + GN_EPS);
            const float bon = BN0[(size_t)row * 8 + h] + BN1[(size_t)row * 8 + h];
#pragma unroll
            for (int vt = 0; vt < 2; ++vt)
#pragma unroll
                for (int q = 0; q < 4; ++q) { const int v0 = 32 * vt + 8 * q + 4 * hi;
                    LAS u32x2_t* const vp = (LAS u32x2_t*)(vst + (32 * tt + l31) * FIN_VSS + 2 * (hc + v0)); const u32x2_t vw = *vp;
                    const f32x4 vs = (f32x4){__uint_as_float(vw.x << 16), __uint_as_float(vw.x & 0xffff0000u), __uint_as_float(vw.y << 16), __uint_as_float(vw.y & 0xffff0000u)}, w4 = *(const f32x4*)(gnw + v0), b4 = *(const f32x4*)(gnb + v0);
                    float o4[4];
#pragma unroll
                    for (int i = 0; i < 4; ++i) o4[i] = ((acc[tt][vt][4 * q + i] - mu) * rstd * w4[i] + b4[i] + bon * vs[i]) * gg[tt][vt][4 * q + i];
                    u32x2_t w; w.x = cvtpk(o4[0], o4[1]); w.y = cvtpk(o4[2], o4[3]); *vp = w; } } }
        WG_BARL();
        { FIN_LANE; const int tid = wave_ * 64 + lane, tok = tid >> 3, oct = tid & 7; bf16* orow = MIX + (size_t)(b * SEQ + t0 + tok) * 1024 + 512;
#pragma unroll
          for (int j = 0; j < 8; ++j) { const int c0 = 64 * j + 8 * oct; *(v4u*)(orow + c0) = *(const LAS v4u*)(vst + tok * FIN_VSS + 2 * c0); } }
        WG_BARL();
    }
}
#undef FIN_LANE

constexpr int ATT_O = 0, ATT_L = 65536, ATT_V = 67584, ATT_VT = 2 * 32 * TSB;
static_assert(ATT_V + NWAVES * ATT_VT <= LDSCTL_OFF, "attention LDS map");
__device__ __forceinline__ bf16x8 frag_tr_pv(const LAS unsigned char* tile, int d0, int s, int lane) {
    const int hi = lane >> 5, g1 = (lane >> 4) & 1, i = lane & 15;
    const LAS unsigned char* p = tile + (16 * s + 4 * hi + (i >> 2)) * TSB + (d0 + 16 * g1 + 4 * (i & 3)) * 2;
    const s16x4 lo = tr4(p), h4 = tr4(p + 8 * TSB);
    return (bf16x8){lo[0], lo[1], lo[2], lo[3], h4[0], h4[1], h4[2], h4[3]};
}
template <int NQH> struct AttPre { bf16x8 qf[NQH][4]; v4u vraw[4], kraw[4]; };
template <> struct AttPre<0> { };
template <int NQH> __device__ __forceinline__ void attn_begin(AttPre<NQH>& P, const bf16* MIX, const bf16* V, int b, int h, int tq0, int d, int lane_in) {
    int lane = lane_in; asm volatile("" : "+v"(lane)); const int hi = lane >> 5, l31 = lane & 31;
#pragma unroll
    for (int qh = 0; qh < NQH; ++qh) { const bf16* qp = MIX + ((size_t)b * SEQ + tq0 + d * (32 * qh + l31)) * 1024 + h * HD + 8 * hi;
#pragma unroll
        for (int ks = 0; ks < 4; ++ks) P.qf[qh][ks] = *(const bf16x8*)(qp + 16 * ks); }
#pragma unroll
    for (int j = 0; j < 4; ++j) { int pos = tq0 + d * (8 * j + (lane >> 3) - 64); pos = pos < 0 ? 0 : (pos > SEQ - 1 ? SEQ - 1 : pos);
        P.vraw[j] = *(const v4u*)(V + ((size_t)b * SEQ + pos) * 512 + h * HD + 8 * (lane & 7)); P.kraw[j] = *(const v4u*)(MIX + ((size_t)b * SEQ + pos) * 1024 + 512 + h * HD + 8 * (lane & 7)); }
}
template <> __device__ __forceinline__ void attn_begin<0>(AttPre<0>&, const bf16*, const bf16*, int, int, int, int, int) {}
template <int NQH, int NQN>
__device__ __forceinline__ void attn_block(AttPre<NQH>& P, AttPre<NQN>& PN, int tqn, int dn, const bf16* MIX, const bf16* V, LAS unsigned char* lds, LAS unsigned char* vt, int b, int h, int T0, int tq0, int d, float slope_d, float bound, bool first, int lane_in) {
    int lane = lane_in; asm volatile("" : "+v"(lane));
    const int hi = lane >> 5, l31 = lane & 31;
    const int jlo = -(tq0 / d), jhi = (SEQ - 1 - tq0) / d;
    bf16x8 (&qf)[NQH][4] = P.qf;
    f32x16 o[NQH][2]; float lsum[NQH];
#pragma unroll
    for (int qh = 0; qh < NQH; ++qh) { lsum[qh] = 0.f;
#pragma unroll
        for (int r = 0; r < 16; ++r) { o[qh][0][r] = 0.f; o[qh][1][r] = 0.f; } }
    constexpr int NT = NQH == 2 ? 6 : 5;
    v4u (&vraw)[4] = P.vraw; v4u (&kraw)[4] = P.kraw; LAS unsigned char* const kt = vt + 32 * TSB;
#define ATT_LOAD(JT) do { _Pragma("unroll") for (int j_ = 0; j_ < 4; ++j_) { int pos_ = tq0 + d * (32 * (JT) + 8 * j_ + (lane >> 3) - 64); pos_ = pos_ < 0 ? 0 : (pos_ > SEQ - 1 ? SEQ - 1 : pos_); \
          vraw[j_] = *(const v4u*)(V + ((size_t)b * SEQ + pos_) * 512 + h * HD + 8 * (lane & 7)); kraw[j_] = *(const v4u*)(MIX + ((size_t)b * SEQ + pos_) * 1024 + 512 + h * HD + 8 * (lane & 7)); } } while (0)
#pragma unroll 1
    for (int jt = 0; jt < NT - 1; ++jt) {
#pragma unroll
        for (int j = 0; j < 4; ++j) { *(LAS v4u*)(vt + (8 * j + (lane >> 3)) * TSB + 16 * (lane & 7)) = vraw[j]; *(LAS v4u*)(kt + (8 * j + (lane >> 3)) * TSB + 16 * (lane & 7)) = kraw[j]; }
        ATT_LOAD(jt + 1);
        asm volatile("" ::: "memory");
        bf16x8 kf[4];
#pragma unroll
        for (int ks = 0; ks < 4; ++ks) kf[ks] = *(const LAS bf16x8*)(kt + l31 * TSB + (16 * ks + 8 * hi) * 2);
        bf16x8 vfr[2][2];
#pragma unroll
        for (int dt = 0; dt < 2; ++dt)
#pragma unroll
            for (int s2 = 0; s2 < 2; ++s2) vfr[dt][s2] = frag_tr_pv(vt, 32 * dt, s2, lane);
        const bool inseq = (32 * jt - 64 >= jlo) && (32 * jt - 33 <= jhi);
#pragma unroll
        for (int qh = 0; qh < NQH; ++qh) {
            if (NQH == 2 && ((qh == 0 && jt == 5) || (qh == 1 && jt == 0))) continue;
            const float fb = (float)(32 * qh + l31 - (32 * jt + 4 * hi - 64)); const int rel = jt - qh;
            f32x16 s;
            if (inseq && rel == 1) { const float A = fmaf(-slope_d, fb, -bound);
#pragma unroll
                for (int r = 0; r < 16; ++r) s[r] = fmaf(slope_d, (float)((r & 3) + 8 * (r >> 2)), A);
            } else if (inseq && rel == 3) { const float A = fmaf(slope_d, fb, -bound);
#pragma unroll
                for (int r = 0; r < 16; ++r) s[r] = fmaf(-slope_d, (float)((r & 3) + 8 * (r >> 2)), A);
            } else if (inseq && rel == 2) {
#pragma unroll
                for (int r = 0; r < 16; ++r) s[r] = fmaf(-slope_d, fabsf(fb - (float)((r & 3) + 8 * (r >> 2))), -bound);
            } else if (inseq) {
#pragma unroll
                for (int r = 0; r < 16; ++r) { const float t = fabsf(fb - (float)((r & 3) + 8 * (r >> 2))); s[r] = (t <= 64.0f) ? fmaf(-slope_d, t, -bound) : -1e30f; }
            } else {
#pragma unroll
                for (int r = 0; r < 16; ++r) { const int cr = (r & 3) + 8 * (r >> 2), jj = 32 * jt + cr + 4 * hi - 64; const float t = fabsf(fb - (float)cr);
                    s[r] = ((t <= 64.0f) && (jj >= jlo) && (jj <= jhi)) ? fmaf(-slope_d, t, -bound) : -1e30f; }
            }
#pragma unroll
            for (int ks = 0; ks < 4; ++ks) s = MFMA32(kf[ks], qf[qh][ks], s);
            v4u pk[2];
#pragma unroll
            for (int r = 0; r < 16; r += 2) { const float p0 = __builtin_amdgcn_exp2f(s[r]), p1 = __builtin_amdgcn_exp2f(s[r + 1]); lsum[qh] += p0 + p1; pk[r >> 3][(r >> 1) & 3] = cvtpk(p0, p1); }
#pragma unroll
            for (int dt = 0; dt < 2; ++dt)
#pragma unroll
                for (int s2 = 0; s2 < 2; ++s2) o[qh][dt] = MFMA32(vfr[dt][s2], __builtin_bit_cast(bf16x8, pk[s2]), o[qh][dt]);
        }
    }
    { const int jt = NT - 1;
#pragma unroll
        for (int j = 0; j < 4; ++j) { *(LAS v4u*)(vt + (8 * j + (lane >> 3)) * TSB + 16 * (lane & 7)) = vraw[j]; *(LAS v4u*)(kt + (8 * j + (lane >> 3)) * TSB + 16 * (lane & 7)) = kraw[j]; }
        attn_begin<NQN>(PN, MIX, V, b, h, tqn, dn, lane);
        asm volatile("" ::: "memory");
        bf16x8 kf[4];
#pragma unroll
        for (int ks = 0; ks < 4; ++ks) kf[ks] = *(const LAS bf16x8*)(kt + l31 * TSB + (16 * ks + 8 * hi) * 2);
        bf16x8 vfr[2][2];
#pragma unroll
        for (int dt = 0; dt < 2; ++dt)
#pragma unroll
            for (int s2 = 0; s2 < 2; ++s2) vfr[dt][s2] = frag_tr_pv(vt, 32 * dt, s2, lane);
        const bool inseq = (32 * jt - 64 >= jlo) && (32 * jt - 33 <= jhi);
#pragma unroll
        for (int qh = 0; qh < NQH; ++qh) {
            if (NQH == 2 && ((qh == 0 && jt == 5) || (qh == 1 && jt == 0))) continue;
            const float fb = (float)(32 * qh + l31 - (32 * jt + 4 * hi - 64)); const int rel = jt - qh;
            f32x16 s;
            if (inseq && rel == 1) { const float A = fmaf(-slope_d, fb, -bound);
#pragma unroll
                for (int r = 0; r < 16; ++r) s[r] = fmaf(slope_d, (float)((r & 3) + 8 * (r >> 2)), A);
            } else if (inseq && rel == 3) { const float A = fmaf(slope_d, fb, -bound);
#pragma unroll
                for (int r = 0; r < 16; ++r) s[r] = fmaf(-slope_d, (float)((r & 3) + 8 * (r >> 2)), A);
            } else if (inseq && rel == 2) {
#pragma unroll
                for (int r = 0; r < 16; ++r) s[r] = fmaf(-slope_d, fabsf(fb - (float)((r & 3) + 8 * (r >> 2))), -bound);
            } else if (inseq) {
#pragma unroll
                for (int r = 0; r < 16; ++r) { const float t = fabsf(fb - (float)((r & 3) + 8 * (r >> 2))); s[r] = (t <= 64.0f) ? fmaf(-slope_d, t, -bound) : -1e30f; }
            } else {
#pragma unroll
                for (int r = 0; r < 16; ++r) { const int cr = (r & 3) + 8 * (r >> 2), jj = 32 * jt + cr + 4 * hi - 64; const float t = fabsf(fb - (float)cr);
                    s[r] = ((t <= 64.0f) && (jj >= jlo) && (jj <= jhi)) ? fmaf(-slope_d, t, -bound) : -1e30f; }
            }
#pragma unroll
            for (int ks = 0; ks < 4; ++ks) s = MFMA32(kf[ks], qf[qh][ks], s);
            v4u pk[2];
#pragma unroll
            for (int r = 0; r < 16; r += 2) { const float p0 = __builtin_amdgcn_exp2f(s[r]), p1 = __builtin_amdgcn_exp2f(s[r + 1]); lsum[qh] += p0 + p1; pk[r >> 3][(r >> 1) & 3] = cvtpk(p0, p1); }
#pragma unroll
            for (int dt = 0; dt < 2; ++dt)
#pragma unroll
                for (int s2 = 0; s2 < 2; ++s2) o[qh][dt] = MFMA32(vfr[dt][s2], __builtin_bit_cast(bf16x8, pk[s2]), o[qh][dt]);
        }
    }
#undef ATT_LOAD
    int lane2 = lane; asm volatile("" : "+v"(lane2));
#pragma unroll
    for (int qh = 0; qh < NQH; ++qh) { const int hi = lane2 >> 5, l31 = lane2 & 31, lane = lane2;
        const int qi = (tq0 - T0) + d * (32 * qh + l31);
        const float lt = lsum[qh] + pg8::shx(lsum[qh], 32, lane);
        if (hi == 0) { LAS float* lp = (LAS float*)(lds + ATT_L) + qi; *lp = first ? lt : (*lp + lt); }
#pragma unroll
        for (int dt = 0; dt < 2; ++dt)
#pragma unroll
            for (int q = 0; q < 4; ++q) { const int d0 = 32 * dt + 8 * q + 4 * hi; LAS u32x2_t* op = (LAS u32x2_t*)(lds + ATT_O + qi * 128 + ((((d0 >> 3) ^ (qi & 7)) << 4) | ((d0 & 4) << 1)));
                float v0 = o[qh][dt][4 * q], v1 = o[qh][dt][4 * q + 1], v2 = o[qh][dt][4 * q + 2], v3 = o[qh][dt][4 * q + 3];
                if (!first) { const u32x2_t w = *op; v0 += __uint_as_float(w.x << 16); v1 += __uint_as_float(w.x & 0xffff0000u); v2 += __uint_as_float(w.y << 16); v3 += __uint_as_float(w.y & 0xffff0000u); }
                u32x2_t w; w.x = cvtpk(v0, v1); w.y = cvtpk(v2, v3); *op = w; }
    }
}
__device__ __forceinline__ void attn_phase_mfma(Frame& F, int layer, int unit0, int nunit, int ustride) {
    unsigned char* const ws = kws();
    int lane_ = lane_id(); asm volatile("" : "+v"(lane_)); int wave_o = F.wv; asm volatile("" : "+s"(wave_o)); const int wave_ = wave_o, lane = lane_;
    bf16* MIX = (bf16*)(ws + R_MIX); const bf16* V = (const bf16*)(ws + R_V);
    LAS unsigned char* const lds = F.lds; LAS unsigned char* const vt = lds + ATT_V + wave_ * ATT_VT;
    float bound;
    { float mq = fabsf(karg(I_QG)[layer * HD + lane]), mk = fabsf(karg(I_KG)[layer * HD + lane]);
#pragma unroll
      for (int o = 1; o < 64; o <<= 1) { mq = fmaxf(mq, pg8::shx(mq, o, lane)); mk = fmaxf(mk, pg8::shx(mk, o, lane)); }
      bound = (8.0f * mq * mk + 0.25f) * 1.4426950408889634f; }
    for (int unit = unit0; unit < nunit; unit += ustride) {
        const int h = unit & 7, st = (unit >> 3) & 7, b = unit >> 6, T0 = st * 512;
        const float slope = exp2f(-(float)(h + 1)) * 1.4426950408889634f;
        const int tq1 = T0 + 64 * wave_, tq2 = T0 + (wave_ & 3) + 256 * (wave_ >> 2), tq3 = T0 + 2 * wave_;
        AttPre<2> p1, p2; AttPre<1> p3, p4; AttPre<0> p0;
        attn_begin<2>(p1, MIX, V, b, h, tq1, 1, lane);
        attn_block<2, 2>(p1, p2, tq2, 4, MIX, V, lds, vt, b, h, T0, tq1, 1, slope, bound, true, lane);
        WG_BAR();
        attn_block<2, 1>(p2, p3, tq3, 16, MIX, V, lds, vt, b, h, T0, tq2, 4, slope * 4.f, bound, false, lane);
        WG_BAR();
        attn_block<1, 1>(p3, p4, tq3 + 1, 16, MIX, V, lds, vt, b, h, T0, tq3, 16, slope * 16.f, bound, false, lane);
        attn_block<1, 0>(p4, p0, 0, 1, MIX, V, lds, vt, b, h, T0, tq3 + 1, 16, slope * 16.f, bound, false, lane);
        WG_BAR();
        { int lane3 = lane; asm volatile("" : "+v"(lane3)); const int tid = wave_ * 64 + lane3;
#pragma unroll
          for (int k = 0; k < 8; ++k) { const int item = tid + 512 * k, qi = item >> 3, c16 = item & 7;
              const v4u w = *(const LAS v4u*)(lds + ATT_O + qi * 128 + ((c16 ^ (qi & 7)) << 4)); const float il = __builtin_amdgcn_rcpf(((const LAS float*)(lds + ATT_L))[qi]);
              v4u o;
#pragma unroll
              for (int j = 0; j < 4; ++j) o[j] = cvtpk(__uint_as_float(w[j] << 16) * il, __uint_as_float(w[j] & 0xffff0000u) * il);
              *(v4u*)(MIX + ((size_t)b * SEQ + T0 + qi) * 1024 + h * HD + 8 * c16) = o; } }
        WG_BAR();
    }
}

constexpr int XLG_AS = 2064;
__device__ __forceinline__ void xl_minigemm(Frame& F) {
    unsigned char* const ws = kws();
    int lane_ = lane_id(); asm volatile("" : "+v"(lane_)); int wave_o = F.wv; asm volatile("" : "+s"(wave_o)); const int wave_ = wave_o, lane = lane_, hi = lane >> 5, l31 = lane & 31;
    const bf16* XBp = (const bf16*)(ws + R_XB); const bf16* W = (const bf16*)(ws + WS_WIN) + (size_t)3072 * 1024 + ((size_t)wave_ * 64 * 64 + lane) * 8;
    bf16* XL = (bf16*)(ws + R_XL); const float* ss = (const float*)(ws + WS_SS1);
    LAS unsigned char* const At = F.lds;
    for (int unit = F.vcu; unit < M / 64; unit += F.G) { const int r0 = unit * 64;
        bf16x8 wf[8], wn[8], wnn[8];
        { const int tid = wave_ * 64 + lane, row = tid >> 3, seg = tid & 7; const v4u* src = (const v4u*)(XBp + (size_t)(r0 + row) * 1024); LAS unsigned char* dst = At + row * XLG_AS;
          v4u av[16];
#pragma unroll
          for (int j = 0; j < 16; ++j) av[j] = src[seg + 8 * j];
#pragma unroll
          for (int k = 0; k < 8; ++k) { wf[k] = *(const bf16x8*)(W + 512 * k); wn[k] = *(const bf16x8*)(W + 512 * (8 + k)); }
          SBAR0();
#pragma unroll
          for (int j = 0; j < 16; ++j) *(LAS v4u*)(dst + (seg + 8 * j) * 16) = av[j]; }
        WG_BARL();
        f32x16 acc[2];
#pragma unroll
        for (int r = 0; r < 16; ++r) { acc[0][r] = 0.f; acc[1][r] = 0.f; }
#pragma unroll 1
        for (int kg = 0; kg < 8; ++kg) {
            if (kg < 6) {
#pragma unroll
                for (int k = 0; k < 8; ++k) wnn[k] = *(const bf16x8*)(W + 512 * (8 * (kg + 2) + k)); }
            bf16x8 af[2][8];
#pragma unroll
            for (int rt = 0; rt < 2; ++rt)
#pragma unroll
                for (int k = 0; k < 8; ++k) af[rt][k] = *(const LAS bf16x8*)(At + (32 * rt + l31) * XLG_AS + (16 * (8 * kg + k) + 8 * hi) * 2);
            SBAR0();
#pragma unroll
            for (int k = 0; k < 8; ++k) { acc[0] = MFMA32H(wf[k], af[0][k], acc[0]); acc[1] = MFMA32H(wf[k], af[1][k], acc[1]); }
#pragma unroll
            for (int k = 0; k < 8; ++k) { wf[k] = wn[k]; wn[k] = wnn[k]; }
        }
        const int lbase = 64 * (wave_ & 3) + 32 * (wave_ >> 2);
#pragma unroll
        for (int rt = 0; rt < 2; ++rt) { const int row = r0 + 32 * rt + l31; const float* sr = ss + (size_t)row * 16;
            const f32x4 s0 = *(const f32x4*)sr, s1 = *(const f32x4*)(sr + 4), s2 = *(const f32x4*)(sr + 8), s3 = *(const f32x4*)(sr + 12);
            const float sum = ((s0[0] + s0[1]) + (s0[2] + s0[3])) + ((s1[0] + s1[1]) + (s1[2] + s1[3])) + ((s2[0] + s2[1]) + (s2[2] + s2[3])) + ((s3[0] + s3[1]) + (s3[2] + s3[3]));
            const float rs = __builtin_amdgcn_rsqf(sum * (1.0f / 1024.0f) + 1e-6f);
#pragma unroll
            for (int q = 0; q < 4; ++q) { u32x2_t w; w.x = cvtpk(acc[rt][4 * q] * rs, acc[rt][4 * q + 1] * rs); w.y = cvtpk(acc[rt][4 * q + 2] * rs, acc[rt][4 * q + 3] * rs);
                *(u32x2_t*)(XL + (size_t)row * 256 + lbase + 8 * q + 4 * hi) = w; } }
        WG_BAR();
    }
}

__global__ void __launch_bounds__(NTHR, 2) mk_fwd(Args args) {
    extern __shared__ __attribute__((aligned(16))) unsigned char lds[];
    Frame F;
    F.lds = (LAS unsigned char*)lds;
    F.MISC = (volatile LAS unsigned*)(F.lds + MISC_OFF);
    F.wv = __builtin_amdgcn_readfirstlane((int)threadIdx.x >> 6);
    F.G = gridDim.x; { const int bx = blockIdx.x; F.vcu = (F.G % 8 == 0) ? (bx % 8) * (F.G / 8) + bx / 8 : bx; }
    F.ctl = (gu32*)(kws() + WS_CTL);
    for (int u = F.wv * 64 + lane_id(); u < (LDS_BYTES - LDSCTL_OFF) / 4; u += NTHR) ((LAS unsigned*)(F.lds + LDSCTL_OFF))[u] = 0u;
    __syncthreads();
    XcdBarrier bar = xcd_barrier_post((unsigned*)(F.ctl + CW_BAR), F.MISC + 8, F.wv == 0 && lane_id() == 0);
#define GRID_BAR() xcd_barrier(bar, F.wv == 0 && lane_id() == 0)
#define XB ((bf16*)(ws + R_XB))
#define MIXB ((bf16*)(ws + R_MIX))
#define HID ((bf16*)(ws + R_HID))
#define SS1 ((float*)(ws + WS_SS1))
#define SS2 ((float*)(ws + WS_SS2))

    for (int step = 0; step < 8 * DEPTH; ++step) {
        const int layer = step >> 3, kind = step & 7;
        if (kind == 0) {
            if (layer > 0) continue;
            x_prologue(F);
            { int lane_ = lane_id(); asm volatile("" : "+v"(lane_)); wconv_items(0, -1, F.vcu * NWAVES + F.wv, F.G * NWAVES, (LAS float*)(F.lds + RING_OFF + F.wv * 16384), lane_); }
        } else if (kind == 1) {
            unsigned char* const ws = kws();
            xl_minigemm(F);
            pg8::Gemm g{XB, (const bf16*)(ws + WS_WIN), M, NPROJ - 256, D}; pg8::StaticOrder S; S.init(M, NPROJ - 256, F.G, (int)blockIdx.x);
            pg8::EpiProj E; E.base0 = (bf16*)(ws + WS_R0); E.ss = SS1; E.qg = karg(I_QG) + layer * HD; E.kg = karg(I_KG) + layer * HD;
            pg8::gemm_phase<pg8::EpiProj, pg8::StaticOrder, true, true, true>(F.lds + RING_OFF, g, S, E, F.wv, lane_id());
        } else if (kind == 2) {
            rwkv_pre_phase(F, layer);
            pre_done_signal(bar, F.wv == 0 && lane_id() == 0);
            const int bx = (int)blockIdx.x;
            if (bx < 128) { pre_done_wait(bar, F.wv == 0 && lane_id() == 0, (unsigned)layer + 1u); if (F.wv == 0) rwkv_scan_chunk(F, bx);
                            else { int lane_ = lane_id(); asm volatile("" : "+v"(lane_)); wconv_items(layer + 1, layer, bx * 7 + F.wv - 1, 128 * 7, (LAS float*)(F.lds + SCAN_NS * SCAN_SLOT + (F.wv - 1) * 9216), lane_); } }
            else attn_phase_mfma(F, layer, bx - 128, BATCH * H * 8, F.G - 128);
        } else if (kind == 3) { continue;
        } else if (kind == 4) {
            rwkv_finalize_mfma(F, layer);
        } else if (kind == 5 || kind == 7) {
            unsigned char* const ws = kws(); float* const xo = (step == 8 * DEPTH - 1) ? kout() : nullptr;
            pg8::Gemm g{kind == 5 ? MIXB : HID, (const bf16*)(ws + (kind == 5 ? WS_WOUT : WS_WDN)), M, D, kind == 5 ? D : FF}; pg8::StaticOrder S; S.init(M, D, F.G, (int)blockIdx.x);
            pg8::EpiRes E{XB, xo, kind == 5 ? SS2 : SS1};
            pg8::gemm_phase<pg8::EpiRes, pg8::StaticOrder, false, true>(F.lds + RING_OFF, g, S, E, F.wv, lane_id());
        } else {
            unsigned char* const ws = kws();
            pg8::Gemm g{XB, (const bf16*)(ws + WS_WUP), M, FF, D}; pg8::StaticOrder S; S.init(M, FF, F.G, (int)blockIdx.x);
            pg8::EpiUp E{HID, SS2};
            pg8::gemm_phase<pg8::EpiUp, pg8::StaticOrder, true, true, true>(F.lds + RING_OFF, g, S, E, F.wv, lane_id());
        }
        if (step + 1 < 8 * DEPTH) GRID_BAR();
    }
}

extern "C" void kernel_launch(void* const* d_in, const int* in_sizes, int n_in, void* d_out, int out_size, void* d_ws, size_t ws_size, hipStream_t stream) {
    static int grid = 0;
    if (grid == 0) {
        if (n_in != N_IN || in_sizes[0] != M * D || out_size != M * D || ws_size < WS_END) { fprintf(stderr, "kernel_launch: unexpected shapes (n_in %d, in0 %d, out %d, ws %zu)\n", n_in, n_in > 0 ? in_sizes[0] : -1, out_size, ws_size); grid = -1; return; }
        int dev = 0, cus = 0;
        if (hipGetDevice(&dev) != hipSuccess || hipDeviceGetAttribute(&cus, hipDeviceAttributeMultiprocessorCount, dev) != hipSuccess) { grid = -1; return; }
        if (hipFuncSetAttribute((const void*)mk_fwd, hipFuncAttributeMaxDynamicSharedMemorySize, LDS_BYTES) != hipSuccess) { fprintf(stderr, "kernel_launch: hipFuncSetAttribute failed\n"); grid = -1; return; }
        int per_cu = 0;
        (void)hipOccupancyMaxActiveBlocksPerMultiprocessor(&per_cu, (const void*)mk_fwd, NTHR, LDS_BYTES);
        (void)hipGetLastError();
        if (cus != 256) { fprintf(stderr, "kernel_launch: the phase program is laid out for 256 CUs (found %d)\n", cus); grid = -1; return; }
        grid = cus;
    }
    if (grid < 0) return;
    (void)hipMemsetAsync((char*)d_ws + WS_CTL, 0, CTL_ZERO_BYTES, stream);
    Args a{};
    for (int i = 0; i < N_IN; ++i) a.in[i] = (const float*)d_in[i];
    a.out = (float*)d_out; a.ws = (unsigned char*)d_ws;
    hipLaunchKernelGGL(mk_fwd, dim3(grid), dim3(NTHR), LDS_BYTES, stream, a);
}
```
